# Optimizing an MI355X kernel written in HIP

```python
import math
import jax, jax.numpy as jnp
from jax import lax
import numpy as np

D_MODEL = 2048
BATCH = 32
SEQ = 256
DEPTH = 4
DEC_BATCH = 4
DEC_SEQ = 2048
PAST_LEN = 256

GRID_W = 64
WIN_R = 8
WIN_C = 16
N_HEADS_A = 16
HEAD_DIM_A = 64
W_A = N_HEADS_A * HEAD_DIM_A
Q_BLOCK = 128
N_HEADS_R = 16
HEAD_DIM_R = 64
W_R = N_HEADS_R * HEAD_DIM_R
LORA_W = 64
LORA_A = 64
LORA_G = 128
GN_EPS = 64e-5
W_C = 1024
POS_BANDS = 16
POS_EMB = 1 + 2 * POS_BANDS
FILTER_HIDDEN = 64
HY_TARGET = 1e-2
HY_FAST = 0.3
HY_SLOW = 1.5
D_FF = 4 * D_MODEL
N_MOD = 6
N_IN = 3 * W_A + 3 * W_R + 3 * W_C + 3 * D_MODEL
NORM_EPS = 1e-6
NEG_INF = -1e30

kernel_name = 'hybrid_natten_rwkv7_hyena_flow_step'


def rms_norm(x, g):
    xf = x.astype(jnp.float32)
    y = xf * lax.rsqrt(jnp.mean(xf * xf, -1, keepdims=True) + NORM_EPS)
    return (y * g.astype(jnp.float32)).astype(x.dtype)


def ada_modulation(cvec, w_mod, b_mod):
    m = jax.nn.silu(cvec) @ w_mod + b_mod
    return jnp.split(m[:, None, :], N_MOD, axis=-1)


def short_conv3(x, w, b):
    xp = jnp.pad(x, ((0, 0), (1, 1), (0, 0)))
    return xp[:, :-2] * w[0] + xp[:, 1:-1] * w[1] + xp[:, 2:] * w[2] + b


def attn_context(q, k, v):
    B, S, H, dh = q.shape
    nb = S // Q_BLOCK
    qb = jnp.moveaxis(q.reshape(B, nb, Q_BLOCK, H, dh), 1, 0)
    scale = HEAD_DIM_A ** -0.5

    def block(qi):
        s = jnp.einsum('bqhd,bkhd->bhqk', qi, k).astype(jnp.float32) * scale
        p = jax.nn.softmax(s, axis=-1).astype(v.dtype)
        return jnp.einsum('bhqk,bkhd->bqhd', p, v)

    o = lax.map(block, qb)
    return jnp.moveaxis(o, 0, 1).reshape(B, S, H * dh)


def na_indices(rows):
    wr = min(WIN_R, rows)
    r = np.arange(rows)
    r0 = np.clip(r - wr // 2, 0, rows - wr)
    key_rows = r0[:, None] + np.arange(wr)[None, :]
    dr = key_rows - r[:, None] + (WIN_R - 1)
    cq = np.arange(GRID_W)
    c0 = np.clip(cq - WIN_C // 2, 0, GRID_W - WIN_C)
    ck = np.arange(GRID_W)
    col_ok = (ck[None, :] >= c0[:, None]) & (ck[None, :] < c0[:, None] + WIN_C)
    dc = np.clip(ck[None, :] - cq[:, None], -(WIN_C - 1), WIN_C - 1) + (WIN_C - 1)
    mask = np.broadcast_to(col_ok[:, None, :], (GRID_W, wr, GRID_W)).reshape(GRID_W, wr * GRID_W)
    return wr, key_rows, dr, dc, mask


def attn_latent(q, k, v, k_ctx, v_ctx, rpb):
    B, L, H, dh = q.shape
    rows = L // GRID_W
    wr, key_rows, dr, dc, mask = na_indices(rows)
    nl = wr * GRID_W
    qg = q.reshape(B, rows, GRID_W, H, dh)
    kg = k.reshape(B, rows, GRID_W, H, dh)[:, key_rows].reshape(B, rows, nl, H, dh)
    vg = v.reshape(B, rows, GRID_W, H, dh)[:, key_rows].reshape(B, rows, nl, H, dh)
    scale = HEAD_DIM_A ** -0.5
    s_loc = jnp.einsum('brqhd,brkhd->bhrqk', qg, kg).astype(jnp.float32) * scale
    bias = rpb[:, dr[:, None, :, None], dc[None, :, None, :]]
    bias = bias.reshape(H, rows, GRID_W, nl).astype(jnp.float32)
    s_loc = jnp.where(mask, s_loc + bias[None], NEG_INF)
    s_ctx = jnp.einsum('brqhd,bkhd->bhrqk', qg, k_ctx).astype(jnp.float32) * scale
    p = jax.nn.softmax(jnp.concatenate([s_loc, s_ctx], -1), axis=-1).astype(v.dtype)
    o = (jnp.einsum('bhrqk,brkhd->brqhd', p[..., :nl], vg)
         + jnp.einsum('bhrqk,bkhd->brqhd', p[..., nl:], v_ctx))
    return o.reshape(B, L, H * dh)


def wkv_step(S, inp):
    r_t, w_t, k_t, v_t, kk_t, b_t = inp
    sa = jnp.einsum('behvk,behk->behv', S, -kk_t)
    S = S * w_t[..., None, :] + sa[..., None] * b_t[..., None, :] + v_t[..., None] * k_t[..., None, :]
    y = jnp.einsum('behvk,behk->behv', S, r_t)
    return S, y


def rwkv_branch(h, rkv, S0, lp):
    B, L, _ = h.shape
    f32 = jnp.float32
    heads = lambda t: t.reshape(t.shape[:-1] + (N_HEADS_R, HEAD_DIM_R))
    rkv = short_conv3(rkv, lp['wkv_conv_w'], lp['wkv_conv_b']).astype(f32)
    r, k, v = [heads(t) for t in jnp.split(rkv, 3, -1)]
    kk = k * heads(lp['wkv_k_k'].astype(f32))
    kk = kk * lax.rsqrt(jnp.sum(kk * kk, -1, keepdims=True) + 1e-12)
    lw = jnp.tanh(jnp.einsum('bld,edr->bler', h, lp['wkv_w1']).astype(f32))
    w_log = lp['wkv_w0'].astype(f32) + jnp.einsum('bler,erc->blec', lw, lp['wkv_w2'].astype(f32))
    decay = heads(jnp.exp(-jnp.exp(-jax.nn.softplus(-w_log) - 0.5)))
    la = jnp.einsum('bld,edr->bler', h, lp['wkv_a1']).astype(f32)
    a = heads(jax.nn.sigmoid(lp['wkv_a0'].astype(f32)
                             + jnp.einsum('bler,erc->blec', la, lp['wkv_a2'].astype(f32))))
    k_dir = k[:, :, None] * (1.0 + (a - 1.0) * heads(lp['wkv_k_a'].astype(f32)))
    kk_dir = jnp.broadcast_to(kk[:, :, None], a.shape)
    r_dir = jnp.broadcast_to(r[:, :, None], a.shape)
    v_dir = jnp.broadcast_to(v[:, :, None], a.shape)

    def orient(t):
        return jnp.stack([t[:, :, 0], jnp.flip(t[:, :, 1], 1)], 2)

    xs = tuple(jnp.moveaxis(orient(t), 1, 0)
               for t in (r_dir, decay, k_dir, v_dir, kk_dir, kk_dir * a))
    S_fin, ys = lax.scan(wkv_step, S0.astype(f32), xs)
    ys = jnp.moveaxis(ys, 0, 1)
    y = ys[:, :, 0] + jnp.flip(ys[:, :, 1], 1)
    mu = jnp.mean(y, -1, keepdims=True)
    var = jnp.mean(jnp.square(y - mu), -1, keepdims=True)
    yn = ((y - mu) * lax.rsqrt(var + GN_EPS)).reshape(B, L, W_R)
    yn = yn * lp['wkv_gn_g'].astype(f32) + lp['wkv_gn_b'].astype(f32)
    bonus = (jnp.sum(r * k * lp['wkv_r_k'].astype(f32), -1, keepdims=True) * v).reshape(B, L, W_R)
    g = (jax.nn.sigmoid(h @ lp['wkv_g1']) @ lp['wkv_g2']).astype(f32)
    return ((yn + bonus) * g).astype(h.dtype), S_fin


def hyena_pos_features(L):
    t = np.linspace(0.0, 1.0, L, dtype=np.float32)[:, None]
    w = 2.0 * np.pi * np.arange(L, dtype=np.float32)[:, None] / L
    f = np.linspace(1e-4, POS_BANDS - 1, POS_BANDS, dtype=np.float32)[None, :]
    z = np.concatenate([t, np.cos(f * w), -np.sin(f * w)], -1).astype(np.float32)
    dist = (np.abs(np.arange(L) - L // 2).astype(np.float32) / L)[:, None]
    deltas = np.abs(np.linspace(math.log(HY_TARGET) / HY_SLOW, math.log(HY_TARGET) / HY_FAST,
                                W_C, dtype=np.float32))[None, :]
    window = np.exp(-dist * deltas).astype(np.float32)
    return z, window


def hyena_branch(u, lp):
    B, L, _ = u.shape
    f32 = jnp.float32
    u = short_conv3(u, lp['hy_conv_w'], lp['hy_conv_b'])
    x0, x1, vv = jnp.split(u, 3, -1)
    z_pos, window = hyena_pos_features(L)
    freq = lp['hy_freq'].astype(f32)
    t = jnp.sin(freq * (z_pos @ lp['hy_f1'].astype(f32) + lp['hy_fb1'].astype(f32)))
    t = jnp.sin(freq * (t @ lp['hy_f2'].astype(f32) + lp['hy_fb2'].astype(f32)))
    filt = (t @ lp['hy_f3'].astype(f32)) * window
    filt = filt / (jnp.sum(jnp.abs(filt), 0, keepdims=True) + 1e-6)
    z = (vv * x1).astype(f32)
    n = 2 * L
    y = jnp.fft.irfft(jnp.fft.rfft(z, n=n, axis=1) * jnp.fft.rfft(filt, n=n, axis=0)[None],
                      n=n, axis=1)[:, L // 2: L // 2 + L]
    y = y + z * lp['hy_d'].astype(f32)
    return (x0.astype(f32) * y).astype(u.dtype)


def trunk_layer(x, cvec, lp, ctx_k=None, ctx_v=None, S0=None):
    B, L, _ = x.shape
    sh1, sc1, ga1, sh2, sc2, ga2 = ada_modulation(cvec, lp['w_mod'], lp['b_mod'])
    h = rms_norm(x, lp['ln1']) * (1.0 + sc1) + sh1
    proj = h @ lp['w_in']
    s1 = 3 * W_A
    s2 = s1 + 3 * W_R
    s3 = s2 + 3 * W_C
    qkv, rkv, hyu, gl = jnp.split(proj, [s1, s2, s3], -1)
    q, k, v = [t.reshape(B, L, N_HEADS_A, HEAD_DIM_A) for t in jnp.split(qkv, 3, -1)]
    if ctx_k is None:
        o_a = attn_context(q, k, v)
        S0 = jnp.zeros((B, 2, N_HEADS_R, HEAD_DIM_R, HEAD_DIM_R), jnp.float32)
    else:
        o_a = attn_latent(q, k, v, ctx_k, ctx_v, lp['rpb'])
    o_r, S_fin = rwkv_branch(h, rkv, S0, lp)
    o_c = hyena_branch(hyu, lp)
    g_a, g_r, g_c = jnp.split(jax.nn.sigmoid(gl), 3, -1)
    merged = g_a * (o_a @ lp['w_pa']) + g_r * (o_r @ lp['w_pr']) + g_c * (o_c @ lp['w_pc'])
    x = x + ga1 * (merged @ lp['w_out'])
    h2 = rms_norm(x, lp['ln2']) * (1.0 + sc2) + sh2
    f = jnp.square(jax.nn.relu(h2 @ lp['w_ff1'] + lp['b_ff1'])) @ lp['w_ff2'] + lp['b_ff2']
    x = x + ga2 * f
    return x, k, v, S_fin.astype(x.dtype)


def setup_inputs(seed: int = 0) -> dict:
    key = jax.random.key(seed)
    keys = iter(jax.random.split(key, 96))

    def nrm(shape, scale):
        return scale * jax.random.normal(next(keys), shape, jnp.float32)

    D = D_MODEL
    inp = {}
    inp['x_prompt'] = nrm((BATCH, SEQ, D), 1.0)
    inp['x_sample'] = nrm((DEC_BATCH, DEC_SEQ, D), 1.0)
    inp['cache_k'] = nrm((DEC_BATCH, DEPTH, PAST_LEN, N_HEADS_A, HEAD_DIM_A), 1.0)
    inp['cache_v'] = nrm((DEC_BATCH, DEPTH, PAST_LEN, N_HEADS_A, HEAD_DIM_A), 1.0)
    inp['state_wkv'] = nrm((DEC_BATCH, DEPTH, 2, N_HEADS_R, HEAD_DIM_R, HEAD_DIM_R), 0.5)
    inp['c'] = nrm((DEC_BATCH, D), 1.0)
    inp['c_ctx'] = nrm((D,), 1.0)
    inp['ln1_g'] = 1.0 + nrm((DEPTH, D), 0.01)
    inp['ln2_g'] = 1.0 + nrm((DEPTH, D), 0.01)
    inp['w_mod'] = nrm((DEPTH, D, N_MOD * D), 0.5 * D ** -0.5)
    inp['b_mod'] = nrm((DEPTH, N_MOD * D), 0.01)
    inp['w_in'] = nrm((DEPTH, D, N_IN), D ** -0.5)
    inp['rpb'] = nrm((DEPTH, N_HEADS_A, 2 * WIN_R - 1, 2 * WIN_C - 1), 0.1)
    inp['wkv_conv_w'] = nrm((DEPTH, 3, 3 * W_R), 0.5)
    inp['wkv_conv_b'] = nrm((DEPTH, 3 * W_R), 0.01)
    inp['wkv_w0'] = -1.0 + nrm((DEPTH, 2, W_R), 0.5)
    inp['wkv_w1'] = nrm((DEPTH, 2, D, LORA_W), D ** -0.5)
    inp['wkv_w2'] = nrm((DEPTH, 2, LORA_W, W_R), 0.1 * LORA_W ** -0.5)
    inp['wkv_a0'] = nrm((DEPTH, 2, W_R), 0.1)
    inp['wkv_a1'] = nrm((DEPTH, 2, D, LORA_A), D ** -0.5)
    inp['wkv_a2'] = nrm((DEPTH, 2, LORA_A, W_R), 0.1 * LORA_A ** -0.5)
    inp['wkv_g1'] = nrm((DEPTH, D, LORA_G), D ** -0.5)
    inp['wkv_g2'] = nrm((DEPTH, LORA_G, W_R), LORA_G ** -0.5)
    inp['wkv_k_k'] = 1.0 + nrm((DEPTH, W_R), 0.1)
    inp['wkv_k_a'] = 1.0 + nrm((DEPTH, W_R), 0.1)
    inp['wkv_r_k'] = nrm((DEPTH, N_HEADS_R, HEAD_DIM_R), 0.1)
    inp['wkv_gn_g'] = 1.0 + nrm((DEPTH, W_R), 0.01)
    inp['wkv_gn_b'] = nrm((DEPTH, W_R), 0.01)
    inp['hy_conv_w'] = nrm((DEPTH, 3, 3 * W_C), 0.5)
    inp['hy_conv_b'] = nrm((DEPTH, 3 * W_C), 0.01)
    inp['hy_f1'] = nrm((DEPTH, POS_EMB, FILTER_HIDDEN), POS_EMB ** -0.5)
    inp['hy_fb1'] = nrm((DEPTH, FILTER_HIDDEN), 0.1)
    inp['hy_f2'] = nrm((DEPTH, FILTER_HIDDEN, FILTER_HIDDEN), FILTER_HIDDEN ** -0.5)
    inp['hy_fb2'] = nrm((DEPTH, FILTER_HIDDEN), 0.1)
    inp['hy_freq'] = 1.0 + nrm((DEPTH, FILTER_HIDDEN), 0.1)
    inp['hy_f3'] = nrm((DEPTH, FILTER_HIDDEN, W_C), FILTER_HIDDEN ** -0.5)
    inp['hy_d'] = nrm((DEPTH, W_C), 1.0)
    inp['w_pa'] = nrm((DEPTH, W_A, D), W_A ** -0.5)
    inp['w_pr'] = nrm((DEPTH, W_R, D), W_R ** -0.5)
    inp['w_pc'] = nrm((DEPTH, W_C, D), W_C ** -0.5)
    inp['w_out'] = nrm((DEPTH, D, D), D ** -0.5)
    inp['w_ff1'] = nrm((DEPTH, D, D_FF), D ** -0.5)
    inp['b_ff1'] = nrm((DEPTH, D_FF), 0.01)
    inp['w_ff2'] = nrm((DEPTH, D_FF, D), D_FF ** -0.5)
    inp['b_ff2'] = nrm((DEPTH, D), 0.01)
    inp['final_g'] = 1.0 + nrm((D,), 0.01)
    return inp


def reference(x_prompt, x_sample, cache_k, cache_v, state_wkv, c, c_ctx,
              ln1_g, ln2_g, w_mod, b_mod, w_in, rpb,
              wkv_conv_w, wkv_conv_b, wkv_w0, wkv_w1, wkv_w2, wkv_a0, wkv_a1, wkv_a2,
              wkv_g1, wkv_g2, wkv_k_k, wkv_k_a, wkv_r_k, wkv_gn_g, wkv_gn_b,
              hy_conv_w, hy_conv_b, hy_f1, hy_fb1, hy_f2, hy_fb2, hy_freq, hy_f3, hy_d,
              w_pa, w_pr, w_pc, w_out, w_ff1, b_ff1, w_ff2, b_ff2, final_g):
    stacked = {
        'ln1': ln1_g, 'ln2': ln2_g, 'w_mod': w_mod, 'b_mod': b_mod, 'w_in': w_in, 'rpb': rpb,
        'wkv_conv_w': wkv_conv_w, 'wkv_conv_b': wkv_conv_b, 'wkv_w0': wkv_w0, 'wkv_w1': wkv_w1,
        'wkv_w2': wkv_w2, 'wkv_a0': wkv_a0, 'wkv_a1': wkv_a1, 'wkv_a2': wkv_a2,
        'wkv_g1': wkv_g1, 'wkv_g2': wkv_g2, 'wkv_k_k': wkv_k_k, 'wkv_k_a': wkv_k_a,
        'wkv_r_k': wkv_r_k, 'wkv_gn_g': wkv_gn_g, 'wkv_gn_b': wkv_gn_b,
        'hy_conv_w': hy_conv_w, 'hy_conv_b': hy_conv_b, 'hy_f1': hy_f1, 'hy_fb1': hy_fb1,
        'hy_f2': hy_f2, 'hy_fb2': hy_fb2, 'hy_freq': hy_freq, 'hy_f3': hy_f3, 'hy_d': hy_d,
        'w_pa': w_pa, 'w_pr': w_pr, 'w_pc': w_pc, 'w_out': w_out,
        'w_ff1': w_ff1, 'b_ff1': b_ff1, 'w_ff2': w_ff2, 'b_ff2': b_ff2,
    }
    yp = x_prompt
    ys = x_sample
    c_context = c_ctx[None, :]
    ks, vs, ss = [], [], []
    for l in range(DEPTH):
        lp = {name: arr[l] for name, arr in stacked.items()}
        yp, k_l, v_l, s_l = trunk_layer(yp, c_context, lp)
        ks.append(k_l)
        vs.append(v_l)
        ss.append(s_l)
        ys = trunk_layer(ys, c, lp, cache_k[:, l], cache_v[:, l], state_wkv[:, l])[0]
    y_prompt = rms_norm(yp, final_g)
    y_sample = rms_norm(ys, final_g)
    new_cache_k = jnp.stack(ks, 1)
    new_cache_v = jnp.stack(vs, 1)
    new_state_wkv = jnp.stack(ss, 1)
    return (y_prompt, y_sample, new_cache_k, new_cache_v, new_state_wkv)
```

```cpp
#include <hip/hip_runtime.h>
#include <cstdio>
#include <cstdint>

#ifndef MK_MULTI
#define MK_MULTI 0
#endif

#define GAS __attribute__((address_space(1)))
#define LAS __attribute__((address_space(3)))
typedef unsigned short bf16;
typedef short bf16x8 __attribute__((ext_vector_type(8)));
typedef short s16x4 __attribute__((ext_vector_type(4)));
typedef float f32x4 __attribute__((ext_vector_type(4)));
typedef float f32x2 __attribute__((ext_vector_type(2)));
typedef float f32x16 __attribute__((ext_vector_type(16)));
typedef unsigned u32x4 __attribute__((ext_vector_type(4)));
typedef unsigned u32x2 __attribute__((ext_vector_type(2)));
typedef __bf16 bf16x2_t __attribute__((ext_vector_type(2)));

constexpr int D = 2048, DEPTH = 4, NPR = 8192  , M = 16384, DFF = 8192;
constexpr int NPROJ = 15872;
constexpr int COL_K = 1024, COL_V = 2048, COL_R = 3072, COL_X0 = 6144, COL_X1 = 7168, COL_VV = 8192, COL_GL = 9216, COL_LW = 15360, COL_G1A = 15488;
constexpr int L_P = 256, L_S = 2048;

enum { I_XP = 0, I_XS, I_CK, I_CV, I_ST, I_C, I_CCTX, I_LN1, I_LN2, I_WMOD, I_BMOD, I_WIN, I_RPB, I_CW, I_CB, I_W0, I_W1, I_W2, I_A0, I_A1, I_A2, I_G1, I_G2,
       I_KK, I_KA, I_RK, I_GNG, I_GNB, I_HCW, I_HCB, I_F1, I_FB1, I_F2, I_FB2, I_FREQ, I_F3, I_HD, I_WPA, I_WPR, I_WPC, I_WOUT, I_FF1, I_BFF1, I_FF2, I_BFF2, I_FING, N_INPUTS };

constexpr size_t OUT_X = 0, OUT_CK = 33554432, OUT_CV = 67108864, OUT_ST = 100663296, OUT_TOTAL = 117440512;

constexpr size_t MiB = 1u << 20;
constexpr size_t WS_CTL = 0, CTL_ZERO_BYTES = 1 * MiB;
constexpr size_t WS_WIN = 2 * MiB;
constexpr size_t WS_W2T = 250 * MiB;
constexpr size_t WS_WP = 260 * MiB;
constexpr size_t WS_WOUT = 308 * MiB;
constexpr size_t WS_WFF1 = 340 * MiB;
constexpr size_t WS_WFF2 = 468 * MiB;
constexpr size_t WS_H = 596 * MiB;
constexpr size_t WS_A = 660 * MiB;
constexpr size_t WS_PROJ = 724 * MiB;
constexpr size_t WS_OALL = 1220 * MiB;
constexpr size_t WS_DEC = 1316 * MiB;
constexpr size_t WS_G = 1444 * MiB;
constexpr size_t WS_OPS = 1476 * MiB;
constexpr size_t WS_CK = 1700 * MiB;
constexpr size_t WS_CV = 1708 * MiB;
constexpr size_t WS_FS = 1716 * MiB;
constexpr size_t WS_FP = 1733 * MiB;
constexpr size_t WS_ZT = 1736 * MiB;
constexpr size_t WS_MOD = 1768 * MiB;
constexpr size_t WS_T2 = 1769 * MiB;
constexpr size_t WS_BONUS = 1773 * MiB;
constexpr size_t WS_END = 1774 * MiB;
constexpr int LPS = 2120, LPP = 328;

constexpr int CW_BAR = 4096;
constexpr int CW_FNORM = 32768;

constexpr int LDS_SCRATCH = 131072, LDSCTL_OFF = 131072, LDS_BYTES = 147456;

#define LDS_WAIT() asm volatile("s_waitcnt lgkmcnt(0)" ::: "memory")
#define VM_WAIT() asm volatile("s_waitcnt vmcnt(0)" ::: "memory")
__device__ __forceinline__ unsigned cvtpk(float lo, float hi) { f32x2 v = {lo, hi}; bf16x2_t b = __builtin_convertvector(v, bf16x2_t); return __builtin_bit_cast(unsigned, b); }
__device__ __forceinline__ bf16 f2bf(float f) { return (bf16)(cvtpk(f, 0.f) & 0xffffu); }
__device__ __forceinline__ float bf2f(bf16 b) { return __uint_as_float(((unsigned)b) << 16); }
__device__ __forceinline__ float bflo(unsigned w) { return __uint_as_float(w << 16); }
__device__ __forceinline__ float bfhi(unsigned w) { return __uint_as_float(w & 0xffff0000u); }
#define DPPF(v, ctrl) __int_as_float(__builtin_amdgcn_update_dpp(0, __float_as_int(v), (ctrl), 0xf, 0xf, false))
__device__ __forceinline__ float wave_sum(float v) {
    v += DPPF(v, 0xB1); v += DPPF(v, 0x4E); v += DPPF(v, 0x141); v += DPPF(v, 0x140);
    const float a = __int_as_float(__builtin_amdgcn_readlane(__float_as_int(v), 0)), b = __int_as_float(__builtin_amdgcn_readlane(__float_as_int(v), 16)),
                c = __int_as_float(__builtin_amdgcn_readlane(__float_as_int(v), 32)), d = __int_as_float(__builtin_amdgcn_readlane(__float_as_int(v), 48));
    return (a + b) + (c + d);
}
__device__ __forceinline__ float xor32(float v, int lane) { return __int_as_float(__builtin_amdgcn_ds_bpermute((lane ^ 32) << 2, __float_as_int(v))); }
__device__ __forceinline__ float sigmoidf_(float x) { return 1.0f / (1.0f + __expf(-x)); }

#define XB_TMO      128
#define XB_XCNT(j)  (256  + 64 * (j))
#define XB_XSUB(j)  (1280 + 64 * (j))
#define XB_XGEN(j)  (2304 + 64 * (j))
#define XB_TOP      3328
#define XB_TOPGEN   3392
#define XCD_BAR_WORDS 3456
#define XB_SPIN_CAP (1u << 20)
__device__ __forceinline__ unsigned xb_ld(unsigned* p)              { return __hip_atomic_load(p, __ATOMIC_RELAXED, __HIP_MEMORY_SCOPE_AGENT); }
__device__ __forceinline__ unsigned xb_add(unsigned* p, unsigned v) { return __hip_atomic_fetch_add(p, v, __ATOMIC_RELAXED, __HIP_MEMORY_SCOPE_AGENT); }
__device__ __forceinline__ unsigned xb_xcc_id() { return (unsigned)__builtin_amdgcn_s_getreg((3 << 11) | 20) & 0xFu; }
#define XB_SPIN(cond, bar) do { unsigned _sp = 0; while (cond) { __builtin_amdgcn_s_sleep(1); \
    if ((++_sp & 255u) == 0u) { if (xb_ld(&(bar)[XB_TMO])) break; if (_sp > XB_SPIN_CAP) { atomicAdd(&(bar)[XB_TMO], 1u); break; } } } } while (0)
struct XcdBarrier { unsigned* bar; unsigned x; volatile LAS unsigned* st; };
__device__ __forceinline__ XcdBarrier xcd_barrier_post(unsigned* bar, volatile LAS unsigned* st) {
    XcdBarrier b; b.bar = bar; b.x = xb_xcc_id(); b.st = st;
    if (threadIdx.x == 0) (void)xb_add(&bar[XB_XCNT(b.x)], 1u);
    return b;
}
__device__ __forceinline__ void xcd_barrier_complete(unsigned* bar, unsigned x, unsigned& nloc, unsigned& nx) {
    const unsigned G = gridDim.x * gridDim.y * gridDim.z;
    unsigned sum, cnt, mine, sp = 0u;
    for (;;) {
        sum = 0u; cnt = 0u; mine = 0u;
#pragma unroll
        for (unsigned j = 0; j < 16; ++j) { const unsigned c = xb_ld(&bar[XB_XCNT(j)]); sum += c; cnt += (c > 0u) ? 1u : 0u; mine = (j == x) ? c : mine; }
        if (sum == G) break;
        __builtin_amdgcn_s_sleep(1);
        if ((++sp & 255u) == 0u) { if (xb_ld(&bar[XB_TMO])) break; if (sp > XB_SPIN_CAP) { atomicAdd(&bar[XB_TMO], 1u); break; } }
    }
    nloc = mine > 0u ? mine : 1u; nx = cnt > 0u ? cnt : 1u;
}
__device__ __forceinline__ void xcd_barrier(const XcdBarrier& b) {
    asm volatile("s_waitcnt vmcnt(0)" ::: "memory");
    __syncthreads();
    if (threadIdx.x == 0) {
        unsigned* bar = b.bar; asm volatile("" : "+s"(bar));
        __builtin_amdgcn_s_waitcnt(0);
        unsigned nloc = b.st[0], nx = b.st[1];
        if (nloc == 0u) { xcd_barrier_complete(bar, b.x, nloc, nx); b.st[0] = nloc; b.st[1] = nx; }
        const unsigned old = xb_add(&bar[XB_XSUB(b.x)], 1u);
        const unsigned gen = old / nloc;
        if (old + 1u == (gen + 1u) * nloc) {
            __builtin_amdgcn_fence(__ATOMIC_RELEASE, "agent");
            asm volatile("s_waitcnt vmcnt(0)" ::: "memory");
            const unsigned og = xb_add(&bar[XB_TOP], 1u);
            const unsigned tg = og / nx;
            if (og + 1u == (tg + 1u) * nx) xb_add(&bar[XB_TOPGEN], 1u);
            else XB_SPIN(xb_ld(&bar[XB_TOPGEN]) == tg, bar);
            __builtin_amdgcn_fence(__ATOMIC_ACQUIRE, "agent");
            xb_add(&bar[XB_XGEN(b.x)], 1u);
            asm volatile("s_waitcnt vmcnt(0)" ::: "memory");
        } else {
            XB_SPIN(xb_ld(&bar[XB_XGEN(b.x)]) == gen, bar);
            __builtin_amdgcn_fence(__ATOMIC_ACQUIRE, "agent");
            asm volatile("s_waitcnt vmcnt(0)" ::: "memory");
        }
    }
    __syncthreads();
}

struct Args { const float* in[N_INPUTS]; float* out; unsigned char* ws; int ph_lo, ph_hi; };
struct Frame {
    LAS unsigned char* lds;
    int tid, lane, wave, G, bid;
};
constexpr int LDS_ARGT = 131072 + 1024;
__device__ __forceinline__ const float* INP(const Frame& F, int k) {
    const LAS unsigned* t = (const LAS unsigned*)(F.lds + LDS_ARGT) + 2 * k;
    const unsigned lo = __builtin_amdgcn_readfirstlane(t[0]), hi = __builtin_amdgcn_readfirstlane(t[1]);
    return (const float*)(((unsigned long long)hi << 32) | lo);
}
__device__ __forceinline__ float* OUTP(const Frame& F) { return (float*)INP(F, 46); }
__device__ __forceinline__ unsigned char* WSP(const Frame& F) { return (unsigned char*)INP(F, 47); }

namespace pg8 {
constexpr int BM = 256, BK = 64, HALF = 128, HTB = HALF * BK * 2, STAGE_BYTES = 8 * HTB, NXCD = 8, WGM = 8;
__host__ __device__ __forceinline__ int lds_byte(int r, int c) { const int st = (r >> 4) * 2 + (c >> 5), rr = r & 15, cc = c & 31, ob = rr * 64 + cc * 2; return st * 1024 + (ob ^ (((ob >> 9) & 1) << 5)); }
__host__ __device__ __forceinline__ void stage_rc(int b, int& R, int& C) { const int st = b / 1024, sb = b % 1024, swz = sb ^ (((sb >> 9) & 1) << 5); R = (st >> 1) * 16 + swz / 64; C = (st & 1) * 32 + (swz % 64) / 2; }
__host__ __device__ __forceinline__ int perm32(int rho) { const int n = rho >> 4, i = rho & 15; return 8 * (i >> 2) + 4 * n + (i & 3); }

struct Unit { int pm, pn, br; };
struct Gemm { const bf16* A; const bf16* Bt; int lda, ldb, K; int a_br_stride  , a_br4_off  , b_br_tiles  ; };

struct Order {
    int nM, nN, nwg, G, c, nbr;
    __device__ void init(int Mrows, int N, int G_, int c_, int nbr_) { nM = Mrows / BM; nN = N / BM; nwg = nM * nN; G = G_; c = c_; nbr = nbr_; }
    __device__ bool next(int i, Unit& u) const {
        const int it = i / nbr; u.br = i - it * nbr;
        const long L = (long)it * G + c; if (L >= nwg) return false;
        int wgid = (int)L; { const int q = nwg / NXCD, r = nwg % NXCD, xcd = wgid % NXCD, off = wgid / NXCD; wgid = (xcd < r ? xcd * (q + 1) : r * (q + 1) + (xcd - r) * q) + off; }
        const int nig = WGM * nN, gid = wgid / nig, fm = gid * WGM, gsz = (nM - fm) < WGM ? (nM - fm) : WGM;
        u.pm = fm + ((wgid % nig) % gsz); u.pn = (wgid % nig) / gsz; return true;
    }
};
struct Order5 {
    Order o;
    __device__ void init(int Mrows, int G_, int c_) { o.init(Mrows, 20 * BM, G_, c_, 1); }
    __device__ bool next(int i, Unit& u) const { if (!o.next(i, u)) return false; u.br = u.pn >> 2; u.pn &= 3; return true; }
};

template <class Epi, class Sched>
__device__ __forceinline__ void gemm_phase(LAS unsigned char* lds, const Gemm g, const Sched& S, const Epi& E) {
    int tid = threadIdx.x; asm volatile("" : "+v"(tid));
    const int wid = __builtin_amdgcn_readfirstlane(tid >> 6), lane = tid & 63, wr = wid >> 2, wc = wid & 3, fr = lane & 15, fq = lane >> 4;
    const int K = g.K, nt = K / BK;
    unsigned voffA[2], voffB[2];
#pragma unroll
    for (int i = 0; i < 2; ++i) { int R, C; stage_rc(tid * 16 + i * 8192, R, C); const int Rb = Epi::PERM ? ((R & ~31) + perm32(R & 31)) : R;
        voffA[i] = (unsigned)(R * g.lda + C) * 2u; voffB[i] = (unsigned)(Rb * g.ldb + C) * 2u; }
    const size_t kstep = (size_t)(BK * 2);
    const size_t hstepA = (size_t)HALF * g.lda * 2, hstepB = (size_t)HALF * g.ldb * 2;
    const unsigned ldsw = (unsigned)wid * 1024u;
    const int aoff = lds_byte(wr * 64 + fr, fq * 8), boff = lds_byte(wc * 32 + fr, fq * 8);
#define PG8_APTR(u) ((const char*)g.A + ((size_t)(u).pm * 256 * g.lda + (size_t)(u).br * g.a_br_stride + ((u).br == 4 ? g.a_br4_off : 0)) * 2)
#define PG8_BPTR(u) ((const char*)g.Bt + ((size_t)((u).br * g.b_br_tiles + (u).pn) * 256 * g.ldb) * 2)
#define PG8_SA(b, h) (((b) * 2 + (h)) * HTB)
#define PG8_SB(b, h) ((4 + (b) * 2 + (h)) * HTB)
#define PG8_STAGE(bufoff, gbase, voff) do { _Pragma("unroll") for (int _i = 0; _i < 2; ++_i) \
        __builtin_amdgcn_global_load_lds((const unsigned*)((const char*)(gbase) + (voff)[_i]), (LAS unsigned*)(lds + (bufoff) + ldsw + _i * 8192), 16, 0, 0); } while (0)
#define PG8_LDA(dst, b, h) do { _Pragma("unroll") for (int m = 0; m < 4; ++m) _Pragma("unroll") for (int k = 0; k < 2; ++k) dst[m][k] = *(const LAS bf16x8*)(lds + PG8_SA(b, h) + aoff + m * 2048 + k * 1024); } while (0)
#define PG8_LDB(dst, b, h) do { _Pragma("unroll") for (int n = 0; n < 2; ++n) _Pragma("unroll") for (int k = 0; k < 2; ++k) dst[n][k] = *(const LAS bf16x8*)(lds + PG8_SB(b, h) + boff + n * 2048 + k * 1024); } while (0)
#define PG8_MMA(ai, bj, At, Bt) do { __builtin_amdgcn_s_setprio(1); _Pragma("unroll") for (int m = 0; m < 4; ++m) _Pragma("unroll") for (int n = 0; n < 2; ++n) _Pragma("unroll") for (int k = 0; k < 2; ++k) \
        acc[ai][bj][m][n] = __builtin_amdgcn_mfma_f32_16x16x32_bf16(Bt[n][k], At[m][k], acc[ai][bj][m][n], 0, 0, 0); __builtin_amdgcn_s_setprio(0); } while (0)
#define PG8_WAIT_V(n) asm volatile("s_waitcnt vmcnt(" #n ")" ::: "memory")
#define PG8_WAIT_L(n) asm volatile("s_waitcnt lgkmcnt(" #n ")" ::: "memory")
#define PG8_BAR __builtin_amdgcn_s_barrier()
#define PG8_SCHED __builtin_amdgcn_sched_barrier(0)
    Unit cur, nxt; int ui = 0;
    if (!S.next(0, cur)) return;
    f32x4 acc[2][2][4][2];
#pragma unroll
    for (int a = 0; a < 2; ++a)
#pragma unroll
        for (int b = 0; b < 2; ++b)
#pragma unroll
            for (int m = 0; m < 4; ++m)
#pragma unroll
                for (int n = 0; n < 2; ++n) acc[a][b][m][n] = (f32x4){0.f, 0.f, 0.f, 0.f};
    bf16x8 At[4][2], B0[2][2], B1[2][2];
    const char* cA = PG8_APTR(cur); const char* cB = PG8_BPTR(cur);
    PG8_STAGE(PG8_SB(0, 0), cB, voffB); PG8_STAGE(PG8_SB(0, 1), cB + hstepB, voffB); PG8_STAGE(PG8_SA(0, 0), cA, voffA); PG8_STAGE(PG8_SA(0, 1), cA + hstepA, voffA);
    if (wr == 1) PG8_BAR;
    PG8_WAIT_V(2); PG8_BAR;
    PG8_STAGE(PG8_SB(1, 0), cB + kstep, voffB); PG8_STAGE(PG8_SA(1, 0), cA + kstep, voffA); PG8_STAGE(PG8_SB(1, 1), cB + hstepB + kstep, voffB);
    PG8_WAIT_V(6); PG8_BAR;
    for (;;) {
        const bool has_next = S.next(ui + 1, nxt);
        const char* nA = has_next ? PG8_APTR(nxt) : cA; const char* nB = has_next ? PG8_BPTR(nxt) : cB;
#pragma unroll 1
        for (int t = 0; t < nt; t += 2) {
            const bool last = (t == nt - 2);
            const char* a1 = cA + (size_t)(t + 1) * kstep;
            const char* a2 = last ? nA : cA + (size_t)(t + 2) * kstep; const char* b2 = last ? nB : cB + (size_t)(t + 2) * kstep;
            const char* a3 = a2 + kstep; const char* b3 = b2 + kstep;
            PG8_LDB(B0, 0, 0); PG8_LDB(B1, 0, 1); PG8_SCHED; PG8_LDA(At, 0, 0); PG8_STAGE(PG8_SA(1, 1), a1 + hstepA, voffA);
            PG8_WAIT_V(8); PG8_WAIT_L(0); PG8_BAR; PG8_MMA(0, 0, At, B0); PG8_MMA(0, 1, At, B1); PG8_BAR; PG8_SCHED;
            PG8_LDA(At, 0, 1); PG8_STAGE(PG8_SB(0, 0), b2, voffB); PG8_STAGE(PG8_SB(0, 1), b2 + hstepB, voffB); PG8_STAGE(PG8_SA(0, 0), a2, voffA);
            PG8_WAIT_V(8); PG8_WAIT_L(0); PG8_BAR; PG8_MMA(1, 0, At, B0); PG8_MMA(1, 1, At, B1); PG8_BAR; PG8_SCHED;
            PG8_LDB(B0, 1, 0); PG8_LDB(B1, 1, 1); PG8_SCHED; PG8_LDA(At, 1, 0); PG8_STAGE(PG8_SA(0, 1), a2 + hstepA, voffA);
            PG8_WAIT_V(8); PG8_WAIT_L(0); PG8_BAR; PG8_MMA(0, 0, At, B0); PG8_MMA(0, 1, At, B1); PG8_BAR; PG8_SCHED;
            PG8_LDA(At, 1, 1); PG8_STAGE(PG8_SB(1, 0), b3, voffB); PG8_STAGE(PG8_SB(1, 1), b3 + hstepB, voffB); PG8_STAGE(PG8_SA(1, 0), a3, voffA);
            PG8_WAIT_V(8); PG8_WAIT_L(0); PG8_BAR; PG8_MMA(1, 0, At, B0); PG8_MMA(1, 1, At, B1); PG8_BAR; PG8_SCHED;
        }
        if (wr == 0) PG8_BAR;
        E(acc, cur, wr, wc, fr, fq);
        if (!has_next) break;
#pragma unroll
        for (int a = 0; a < 2; ++a)
#pragma unroll
            for (int b = 0; b < 2; ++b)
#pragma unroll
                for (int m = 0; m < 4; ++m)
#pragma unroll
                    for (int n = 0; n < 2; ++n) acc[a][b][m][n] = (f32x4){0.f, 0.f, 0.f, 0.f};
        cur = nxt; cA = nA; cB = nB; ++ui;
        if (wr == 1) PG8_BAR;
    }
    PG8_WAIT_V(0);
    PG8_BAR;
#undef PG8_APTR
#undef PG8_BPTR
#undef PG8_SA
#undef PG8_SB
#undef PG8_STAGE
#undef PG8_LDA
#undef PG8_LDB
#undef PG8_MMA
#undef PG8_WAIT_V
#undef PG8_WAIT_L
#undef PG8_BAR
#undef PG8_SCHED
}

__device__ __forceinline__ float mrow_sel(int row) { return 0.f; }
__device__ __forceinline__ int modrow(int row) { return row < NPR ? 0 : 1 + ((row - NPR) >> 11); }

struct EpiProj {
    static constexpr bool PERM = true;
    bf16* proj; float* outk; float* outv; int layer;
    __device__ __forceinline__ void operator()(const f32x4 (&acc)[2][2][4][2], const Unit& u, int wr, int wc, int fr, int fq) const {
        { int t_ = threadIdx.x; asm volatile("" : "+v"(t_)); fr = t_ & 15; fq = (t_ >> 4) & 3; }
        const int row0 = u.pm * BM + wr * 64 + fr, colb = u.pn * BM + wc * 32 + 8 * fq;
        const int mode = (u.pn == 60) ? 1 : (u.pn == 61 ? 2 : 0);
        const bool kv = (u.pm < 32) && (u.pn >= 4) && (u.pn < 12);
#pragma unroll
        for (int ai = 0; ai < 2; ++ai)
#pragma unroll
            for (int m = 0; m < 4; ++m) {
                const int row = row0 + ai * HALF + m * 16;
                bf16* rowp = proj + (size_t)row * NPROJ + colb;
#pragma unroll
                for (int bj = 0; bj < 2; ++bj) {
                    f32x4 v0 = acc[ai][bj][m][0], v1 = acc[ai][bj][m][1];
                    if (mode == 1) { if (colb + bj * HALF < COL_G1A) {
#pragma unroll
                        for (int j = 0; j < 4; ++j) { v0[j] = tanhf(v0[j]); v1[j] = tanhf(v1[j]); } } }
                    else if (mode == 2) { const bool act = (colb + bj * HALF) < 15744;
#pragma unroll
                        for (int j = 0; j < 4; ++j) { v0[j] = act ? sigmoidf_(v0[j]) : 0.f; v1[j] = act ? sigmoidf_(v1[j]) : 0.f; } }
                    u32x4 w; w.x = cvtpk(v0[0], v0[1]); w.y = cvtpk(v0[2], v0[3]); w.z = cvtpk(v1[0], v1[1]); w.w = cvtpk(v1[2], v1[3]);
                    *(u32x4*)(rowp + bj * HALF) = w;
                    if (kv) { const int col = colb + bj * HALF; float* ob = (u.pn < 8) ? outk : outv; const int ch = col - ((u.pn < 8) ? COL_K : COL_V);
                        float* dst = ob + ((size_t)(((row >> 8) * 4 + layer) * 256 + (row & 255))) * 1024 + ch;
                        *(f32x4*)dst = v0; *(f32x4*)(dst + 4) = v1; }
                }
            }
    }
};
struct EpiLora2 {
    static constexpr bool PERM = true;
    float* dec; bf16* abuf; bf16* gbuf; const float* w0; const float* a0;
    __device__ __forceinline__ void operator()(const f32x4 (&acc)[2][2][4][2], const Unit& u, int wr, int wc, int fr, int fq) const {
        { int t_ = threadIdx.x; asm volatile("" : "+v"(t_)); fr = t_ & 15; fq = (t_ >> 4) & 3; }
        const int row0 = u.pm * BM + wr * 64 + fr, colb = u.pn * BM + wc * 32 + 8 * fq;
        const int br = u.br, e = br & 1;
        const float* bsrc = (br < 2) ? w0 + e * 1024 : a0 + e * 1024;
#pragma unroll
        for (int bj = 0; bj < 2; ++bj)
#pragma unroll
            for (int n = 0; n < 2; ++n) {
                const int ch = colb + bj * HALF + 4 * n;
                f32x4 b0 = (f32x4){0.f, 0.f, 0.f, 0.f};
                if (br < 4) b0 = *(const f32x4*)(bsrc + ch);
#pragma unroll
                for (int ai = 0; ai < 2; ++ai)
#pragma unroll
                    for (int m = 0; m < 4; ++m) {
                        const int row = row0 + ai * HALF + m * 16;
                        f32x4 v0 = acc[ai][bj][m][n] + b0;
                        if (br < 2) {
#pragma unroll
                            for (int j = 0; j < 4; ++j) v0[j] = __expf(-0.6065306597126334f * sigmoidf_(v0[j]));
                            *(f32x4*)(dec + ((size_t)row * 2 + e) * 1024 + ch) = v0;
                        } else {
                            if (br < 4) {
#pragma unroll
                                for (int j = 0; j < 4; ++j) v0[j] = sigmoidf_(v0[j]); }
                            bf16* dst = (br < 4) ? abuf + ((size_t)row * 2 + e) * 1024 + ch : gbuf + (size_t)row * 1024 + ch;
                            *(u32x2*)dst = (u32x2){cvtpk(v0[0], v0[1]), cvtpk(v0[2], v0[3])};
                        }
                        __builtin_amdgcn_sched_barrier(0);
                    }
            }
    }
};
struct EpiMerge {
    static constexpr bool PERM = true;
    const bf16* proj; bf16* merged;
    __device__ __forceinline__ void operator()(const f32x4 (&acc)[2][2][4][2], const Unit& u, int wr, int wc, int fr, int fq) const {
        { int t_ = threadIdx.x; asm volatile("" : "+v"(t_)); fr = t_ & 15; fq = (t_ >> 4) & 3; }
        const int row0 = u.pm * BM + wr * 64 + fr, colb = u.pn * BM + wc * 32 + 8 * fq;
        const int br = u.br;
#pragma unroll
        for (int ai = 0; ai < 2; ++ai)
#pragma unroll
            for (int m = 0; m < 4; ++m) {
                const int row = row0 + ai * HALF + m * 16;
#pragma unroll
                for (int bj = 0; bj < 2; ++bj) {
                    const int col = colb + bj * HALF;
                    const u32x4 gw = *(const u32x4*)(proj + (size_t)row * NPROJ + COL_GL + br * 2048 + col);
                    bf16* dst = merged + (size_t)row * D + col;
                    f32x4 v0 = acc[ai][bj][m][0], v1 = acc[ai][bj][m][1];
                    v0[0] *= sigmoidf_(bflo(gw.x)); v0[1] *= sigmoidf_(bfhi(gw.x)); v0[2] *= sigmoidf_(bflo(gw.y)); v0[3] *= sigmoidf_(bfhi(gw.y));
                    v1[0] *= sigmoidf_(bflo(gw.z)); v1[1] *= sigmoidf_(bfhi(gw.z)); v1[2] *= sigmoidf_(bflo(gw.w)); v1[3] *= sigmoidf_(bfhi(gw.w));
                    if (br > 0) { const u32x4 pw = *(const u32x4*)dst;
                        v0[0] += bflo(pw.x); v0[1] += bfhi(pw.x); v0[2] += bflo(pw.y); v0[3] += bfhi(pw.y);
                        v1[0] += bflo(pw.z); v1[1] += bfhi(pw.z); v1[2] += bflo(pw.w); v1[3] += bfhi(pw.w); }
                    u32x4 w; w.x = cvtpk(v0[0], v0[1]); w.y = cvtpk(v0[2], v0[3]); w.z = cvtpk(v1[0], v1[1]); w.w = cvtpk(v1[2], v1[3]);
                    *(u32x4*)dst = w;
                }
            }
    }
};
struct EpiResid {
    static constexpr bool PERM = false;
    float* x; const float* gate;   const float* bias;
    __device__ __forceinline__ void operator()(const f32x4 (&acc)[2][2][4][2], const Unit& u, int wr, int wc, int fr, int fq) const {
        { int t_ = threadIdx.x; asm volatile("" : "+v"(t_)); fr = t_ & 15; fq = (t_ >> 4) & 3; }
        const int row0 = u.pm * BM + wr * 64 + fr, col0 = u.pn * BM + wc * 32 + 4 * fq;
        const int mr = modrow(u.pm * BM);
        const float* gp = gate + (size_t)mr * 12288;
        f32x4 gv[2][2], bv[2][2];
#pragma unroll
        for (int bj = 0; bj < 2; ++bj)
#pragma unroll
            for (int n = 0; n < 2; ++n) { gv[bj][n] = *(const f32x4*)(gp + col0 + bj * HALF + n * 16);
                bv[bj][n] = bias ? *(const f32x4*)(bias + col0 + bj * HALF + n * 16) : (f32x4){0.f, 0.f, 0.f, 0.f}; }
#pragma unroll
        for (int ai = 0; ai < 2; ++ai)
#pragma unroll
            for (int m = 0; m < 4; ++m) { float* rowp = x + (size_t)(row0 + ai * HALF + m * 16) * D + col0;
#pragma unroll
                for (int bj = 0; bj < 2; ++bj)
#pragma unroll
                    for (int n = 0; n < 2; ++n) { f32x4* p = (f32x4*)(rowp + bj * HALF + n * 16); const f32x4 xo = *p; *p = xo + gv[bj][n] * (acc[ai][bj][m][n] + bv[bj][n]); }
                asm volatile("" ::: "memory"); }
    }
};
struct EpiFF1 {
    static constexpr bool PERM = true;
    bf16* U; const float* bias;
    __device__ __forceinline__ void operator()(const f32x4 (&acc)[2][2][4][2], const Unit& u, int wr, int wc, int fr, int fq) const {
        { int t_ = threadIdx.x; asm volatile("" : "+v"(t_)); fr = t_ & 15; fq = (t_ >> 4) & 3; }
        const int row0 = u.pm * BM + wr * 64 + fr, colb = u.pn * BM + wc * 32 + 8 * fq;
        f32x4 bv[2][2];
#pragma unroll
        for (int bj = 0; bj < 2; ++bj)
#pragma unroll
            for (int n = 0; n < 2; ++n) bv[bj][n] = *(const f32x4*)(bias + colb + bj * HALF + 4 * n);
#pragma unroll
        for (int ai = 0; ai < 2; ++ai)
#pragma unroll
            for (int m = 0; m < 4; ++m) { bf16* rowp = U + (size_t)(row0 + ai * HALF + m * 16) * DFF + colb;
#pragma unroll
                for (int bj = 0; bj < 2; ++bj) { f32x4 v0 = acc[ai][bj][m][0] + bv[bj][0], v1 = acc[ai][bj][m][1] + bv[bj][1];
#pragma unroll
                    for (int j = 0; j < 4; ++j) { const float a = fmaxf(v0[j], 0.f), b = fmaxf(v1[j], 0.f); v0[j] = a * a; v1[j] = b * b; }
                    u32x4 w; w.x = cvtpk(v0[0], v0[1]); w.y = cvtpk(v0[2], v0[3]); w.z = cvtpk(v1[0], v1[1]); w.w = cvtpk(v1[2], v1[3]);
                    *(u32x4*)(rowp + bj * HALF) = w; } }
    }
};
}

__device__ __forceinline__ void transpose_item(const float* W, int K, int N, bf16* WT, int ldk, int row_off, LAS float* scr, int item, int lane) {
    const int nblk = N / 32, kb = item / nblk, nb = item % nblk, k0 = 64 * kb, n0 = 32 * nb;
#pragma unroll 8
    for (int i = 0; i < 32; ++i) { const int kk = 2 * i + (lane >> 5); scr[kk * 33 + (lane & 31)] = W[(size_t)(k0 + kk) * N + n0 + (lane & 31)]; }
    LDS_WAIT(); asm volatile("" ::: "memory");
    const int c = lane & 7;
#pragma unroll
    for (int j = 0; j < 4; ++j) { const int n = (lane >> 3) + 8 * j; const LAS float* s = scr + (8 * c) * 33 + n;
        u32x4 o; o.x = cvtpk(s[0 * 33], s[1 * 33]); o.y = cvtpk(s[2 * 33], s[3 * 33]); o.z = cvtpk(s[4 * 33], s[5 * 33]); o.w = cvtpk(s[6 * 33], s[7 * 33]);
        *(u32x4*)(WT + (size_t)(row_off + n0 + n) * ldk + k0 + 8 * c) = o; }
    LDS_WAIT(); asm volatile("" ::: "memory");
}

__device__ __forceinline__ void prologue0(const Frame& F, const Args& a) {
    unsigned char* ws = WSP(F);
    LAS float* scr = (LAS float*)(F.lds + F.wave * 16384);
    const int gw = F.bid * 8 + F.wave, NGW = F.G * 8;
    for (int l = 0; l < DEPTH; ++l) {
        bf16* WinT = (bf16*)(ws + WS_WIN) + (size_t)l * NPROJ * D;
        {   const int n_items = (D / 64) * (15360 / 32); const float* W = INP(F, I_WIN) + (size_t)l * D * 15360;
            for (int it = gw; it < n_items; it += NGW) transpose_item(W, D, 15360, WinT, D, 0, scr, it, F.lane); }
        for (int e = 0; e < 2; ++e) {
            const int n_items = (D / 64) * (64 / 32);
            const float* W1 = INP(F, I_W1) + ((size_t)l * 2 + e) * D * 64; const float* A1 = INP(F, I_A1) + ((size_t)l * 2 + e) * D * 64;
            for (int it = gw; it < n_items; it += NGW) { transpose_item(W1, D, 64, WinT, D, COL_LW + e * 64, scr, it, F.lane); transpose_item(A1, D, 64, WinT, D, COL_LW + 128 + e * 64, scr, it, F.lane); }
        }
        {   const int n_items = (D / 64) * (128 / 32); const float* W = INP(F, I_G1) + (size_t)l * D * 128;
            for (int it = gw; it < n_items; it += NGW) transpose_item(W, D, 128, WinT, D, COL_LW + 256, scr, it, F.lane); }
        for (int i = gw * 64 + F.lane; i < 128 * D / 8; i += NGW * 64) ((u32x4*)(WinT + (size_t)15744 * D))[i] = (u32x4){0u, 0u, 0u, 0u};
        for (int br = 0; br < 3; ++br) { const float* W = INP(F, I_WPA + br) + (size_t)l * 1024 * D; bf16* WT = (bf16*)(ws + WS_WP) + ((size_t)l * 3 + br) * D * 1024;
            const int n_items = (1024 / 64) * (D / 32);
            for (int it = gw; it < n_items; it += NGW) transpose_item(W, 1024, D, WT, 1024, 0, scr, it, F.lane); }
        {   const float* W = INP(F, I_WOUT) + (size_t)l * D * D; bf16* WT = (bf16*)(ws + WS_WOUT) + (size_t)l * D * D; const int n_items = (D / 64) * (D / 32);
            for (int it = gw; it < n_items; it += NGW) transpose_item(W, D, D, WT, D, 0, scr, it, F.lane); }
        {   const float* W = INP(F, I_FF1) + (size_t)l * D * DFF; bf16* WT = (bf16*)(ws + WS_WFF1) + (size_t)l * D * DFF; const int n_items = (D / 64) * (DFF / 32);
            for (int it = gw; it < n_items; it += NGW) transpose_item(W, D, DFF, WT, D, 0, scr, it, F.lane); }
        {   const float* W = INP(F, I_FF2) + (size_t)l * D * DFF; bf16* WT = (bf16*)(ws + WS_WFF2) + (size_t)l * D * DFF; const int n_items = (DFF / 64) * (D / 32);
            for (int it = gw; it < n_items; it += NGW) transpose_item(W, DFF, D, WT, DFF, 0, scr, it, F.lane); }
        {   bf16* W2T = (bf16*)(ws + WS_W2T) + (size_t)l * 5120 * 256;
            const float* w2 = INP(F, I_W2) + (size_t)l * 2 * 64 * 1024; const float* a2 = INP(F, I_A2) + (size_t)l * 2 * 64 * 1024; const float* g2 = INP(F, I_G2) + (size_t)l * 128 * 1024;
            for (int i = gw * 64 + F.lane; i < 5120 * 256; i += NGW * 64) {
                const int n = i >> 8, kk = i & 255, br = n >> 10, c = n & 1023; float v = 0.f;
                if (br == 0) { if (kk < 64) v = w2[(size_t)(0 * 64 + kk) * 1024 + c]; }
                else if (br == 1) { if (kk >= 64 && kk < 128) v = w2[(size_t)(1 * 64 + kk - 64) * 1024 + c]; }
                else if (br == 2) { if (kk >= 128 && kk < 192) v = a2[(size_t)(0 * 64 + kk - 128) * 1024 + c]; }
                else if (br == 3) { if (kk >= 192) v = a2[(size_t)(1 * 64 + kk - 192) * 1024 + c]; }
                else { if (kk >= 128) v = g2[(size_t)(kk - 128) * 1024 + c]; }
                W2T[i] = f2bf(v);
            }
        }
    }
    {   const float* ck = INP(F, I_CK); const float* cv = INP(F, I_CV); bf16* ok = (bf16*)(ws + WS_CK); bf16* ov = (bf16*)(ws + WS_CV);
        const int n4 = 4 * 4 * 256 * 1024 / 4;
        for (int i = gw * 64 + F.lane; i < n4; i += NGW * 64) { const f32x4 x = ((const f32x4*)ck)[i], y = ((const f32x4*)cv)[i];
            ((u32x2*)ok)[i] = (u32x2){cvtpk(x[0], x[1]), cvtpk(x[2], x[3])}; ((u32x2*)ov)[i] = (u32x2){cvtpk(y[0], y[1]), cvtpk(y[2], y[3])}; }
    }
    {   LAS float* sv = (LAS float*)(F.lds + 65536 + 8192 * 0);
        __syncthreads();
        for (int i = F.tid; i < 5 * D; i += 512) { const int r = i / D, d = i - r * D; const float x = (r == 0) ? INP(F, I_CCTX)[d] : INP(F, I_C)[(r - 1) * D + d]; sv[i] = x / (1.0f + __expf(-x)); }
        __syncthreads();
        float* MOD = (float*)(ws + WS_MOD);
        const int n_items = DEPTH * (12288 / 64);
        for (int it = gw; it < n_items; it += NGW) {
            const int l = it / 192, j = (it % 192) * 64 + F.lane;
            const float* W = INP(F, I_WMOD) + (size_t)l * D * 12288 + j;
            float acc[5] = {0.f, 0.f, 0.f, 0.f, 0.f};
#pragma unroll 8
            for (int d = 0; d < D; ++d) { const float w = W[(size_t)d * 12288];
#pragma unroll
                for (int r = 0; r < 5; ++r) acc[r] += sv[r * D + d] * w; }
            const float b = INP(F, I_BMOD)[l * 12288 + j];
#pragma unroll
            for (int r = 0; r < 5; ++r) MOD[((size_t)l * 5 + r) * 12288 + j] = acc[r] + b;
        }
        __syncthreads();
    }
    {   float* T2 = (float*)(ws + WS_T2);
        const int n_items = DEPTH * (L_S + L_P);
        for (int it = gw; it < n_items; it += NGW) {
            const int l = it / (L_S + L_P), rr = it % (L_S + L_P), sel = rr < L_S ? 0 : 1, t = sel ? rr - L_S : rr, L = sel ? L_P : L_S;
            float zf = 0.f;
            {   const float tt = (float)t / (float)(L - 1);
                const float w = (6.283185307179586f * (float)t) / (float)L;
                const int band = (F.lane - 1) & 15;
                const float f = 1e-4f + (float)band * ((15.0f - 1e-4f) / 15.0f);
                const float fw = f * w;
                const double rd = (double)fw - 6.283185307179586 * rint((double)fw * 0.15915494309189535);
                const float rf = (float)rd;
                zf = (F.lane == 0) ? tt : (F.lane <= 16 ? __cosf(rf) : -__sinf(rf));
            }
            const float* f1 = INP(F, I_F1) + (size_t)l * 33 * 64; const float* f2 = INP(F, I_F2) + (size_t)l * 64 * 64;
            const float fq = INP(F, I_FREQ)[l * 64 + F.lane];
            float s = INP(F, I_FB1)[l * 64 + F.lane];
            for (int i = 0; i < 33; ++i) s += __int_as_float(__builtin_amdgcn_readlane(__float_as_int(zf), i)) * f1[i * 64 + F.lane];
            float x = fq * s; { const double rd = (double)x - 6.283185307179586 * rint((double)x * 0.15915494309189535); x = (float)rd; }
            const float t1 = __sinf(x);
            float s2 = INP(F, I_FB2)[l * 64 + F.lane];
            for (int i = 0; i < 64; ++i) s2 += __int_as_float(__builtin_amdgcn_readlane(__float_as_int(t1), i)) * f2[i * 64 + F.lane];
            float y = fq * s2; { const double rd = (double)y - 6.283185307179586 * rint((double)y * 0.15915494309189535); y = (float)rd; }
            T2[(((size_t)l * 2 + sel) * L_S + t) * 64 + F.lane] = __sinf(y);
        }
    }
    {   bf16* FS = (bf16*)(ws + WS_FS); bf16* FP = (bf16*)(ws + WS_FP);
        for (int i = gw * 64 + F.lane; i < DEPTH * 1024 * 72; i += NGW * 64) { const int row = i / 72, p = i % 72; const int m = p < 32 ? p : p - 32 + 32;
            FS[(size_t)row * LPS + (p < 32 ? p : L_S + p)] = 0; FP[(size_t)row * LPP + (p < 32 ? p : L_P + p)] = 0; (void)m; }
    }
}

__device__ __forceinline__ void prologue1(const Frame& F, const Args& a) {
    unsigned char* ws = WSP(F);
    const int gw = F.bid * 8 + F.wave, NGW = F.G * 8;
    const float* T2 = (const float*)(ws + WS_T2);
    float* FNORM = (float*)(ws + WS_CTL) + CW_FNORM;
    const int items_s = DEPTH * 16 * (L_S / 64), items_p = DEPTH * 16 * (L_P / 64);
    for (int it = gw; it < items_s + items_p; it += NGW) {
        int sel, l, cg, tc;
        if (it < items_s) { sel = 0; l = it / (16 * 32); cg = (it / 32) % 16; tc = it % 32; } else { const int r = it - items_s; sel = 1; l = r / (16 * 4); cg = (r / 4) % 16; tc = r % 4; }
        const int L = sel ? L_P : L_S, c = cg * 64 + F.lane;
        const float* f3 = INP(F, I_F3) + (size_t)l * 64 * 1024 + c;
        float w3[64];
#pragma unroll
        for (int j = 0; j < 64; ++j) w3[j] = f3[(size_t)j * 1024];
        const float delta = fabsf(-3.0701134573253946f + (float)c * ((-15.350567286626973f + 3.0701134573253946f) / 1023.0f));
        bf16* dst = sel ? (bf16*)(ws + WS_FP) + ((size_t)l * 1024 + c) * LPP : (bf16*)(ws + WS_FS) + ((size_t)l * 1024 + c) * LPS;
        float asum = 0.f;
        for (int tt = 0; tt < 64; ++tt) {
            const int t = tc * 64 + tt;
            const float tv = T2[(((size_t)l * 2 + sel) * L_S + t) * 64 + F.lane];
            float s = 0.f;
#pragma unroll
            for (int j = 0; j < 64; ++j) s += __int_as_float(__builtin_amdgcn_readlane(__float_as_int(tv), j)) * w3[j];
            const float dist = fabsf((float)(t - L / 2)) / (float)L;
            const float fv = s * __expf(-dist * delta);
            asum += fabsf(fv);
            dst[32 + (L - 1 - t)] = f2bf(fv);
        }
        atomicAdd(FNORM + ((size_t)l * 2 + sel) * 1024 + c, asum);
    }
}

__device__ __forceinline__ void norm_phase(const Frame& F, const float* xp, const float* xs, float* xcopy, const float* g, const float* mod, int i_sh, int i_sc, bf16* hout) {
    const int gw = F.bid * 8 + F.wave, NGW = F.G * 8;
    for (int row = gw; row < M; row += NGW) {
        const float* xr = row < NPR ? xp + (size_t)row * D : xs + (size_t)(row - NPR) * D;
        const float* mr = mod + (size_t)pg8::modrow(row) * 12288;
        f32x4 v[8]; float ss = 0.f;
#pragma unroll
        for (int j = 0; j < 8; ++j) { v[j] = ((const f32x4*)xr)[F.lane + 64 * j]; ss += (v[j][0] * v[j][0] + v[j][1] * v[j][1]) + (v[j][2] * v[j][2] + v[j][3] * v[j][3]); }
        const float rstd = 1.0f / sqrtf(wave_sum(ss) * (1.0f / D) + 1e-6f);
        if (xcopy) {
#pragma unroll
            for (int j = 0; j < 8; ++j) ((f32x4*)(xcopy + (size_t)row * D))[F.lane + 64 * j] = v[j]; }
#pragma unroll
        for (int j = 0; j < 8; ++j) {
            const f32x4 gg = ((const f32x4*)g)[F.lane + 64 * j], sc = ((const f32x4*)(mr + i_sc * D))[F.lane + 64 * j], sh = ((const f32x4*)(mr + i_sh * D))[F.lane + 64 * j];
            const f32x4 o = v[j] * rstd * gg * (1.0f + sc) + sh;
            ((u32x2*)(hout + (size_t)row * D))[F.lane + 64 * j] = (u32x2){cvtpk(o[0], o[1]), cvtpk(o[2], o[3])};
        }
    }
}
__device__ __forceinline__ void final_norm_phase(const Frame& F, float* x, const float* g) {
    const int gw = F.bid * 8 + F.wave, NGW = F.G * 8;
    for (int row = gw; row < M; row += NGW) {
        float* xr = x + (size_t)row * D;
        f32x4 v[8]; float ss = 0.f;
#pragma unroll
        for (int j = 0; j < 8; ++j) { v[j] = ((const f32x4*)xr)[F.lane + 64 * j]; ss += (v[j][0] * v[j][0] + v[j][1] * v[j][1]) + (v[j][2] * v[j][2] + v[j][3] * v[j][3]); }
        const float rstd = 1.0f / sqrtf(wave_sum(ss) * (1.0f / D) + 1e-6f);
#pragma unroll
        for (int j = 0; j < 8; ++j) { const f32x4 gg = ((const f32x4*)g)[F.lane + 64 * j]; ((f32x4*)xr)[F.lane + 64 * j] = v[j] * rstd * gg; }
    }
}

__device__ __forceinline__ s16x4 vtr(const LAS unsigned char* p) { return __builtin_bit_cast(s16x4, __builtin_amdgcn_ds_read_tr16_b64_v4i16((LAS s16x4*)p)); }

struct AttnState { float m, l; f32x16 o[2]; };

template <int NT, bool HASB, class KT, class VL, class BIAS>
__device__ __forceinline__ void attendN(AttnState& st, const bf16x8 (&qf)[4], const KT& ktp, size_t kstride, const LAS unsigned char* lds, const VL& vlo, const BIAS& bias, int lane) {
    const int r = lane & 31, h = lane >> 5;
    f32x16 s[NT];
#pragma unroll
    for (int kt = 0; kt < NT; ++kt) {
        const bf16* kp = ktp(kt) + (size_t)r * kstride + 8 * h;
        bf16x8 kf[4];
#pragma unroll
        for (int ks = 0; ks < 4; ++ks) kf[ks] = *(const bf16x8*)(kp + 16 * ks);
        f32x16 acc;
#pragma unroll
        for (int i = 0; i < 16; ++i) acc[i] = 0.f;
#pragma unroll
        for (int ks = 0; ks < 4; ++ks) acc = __builtin_amdgcn_mfma_f32_32x32x16_bf16(kf[ks], qf[ks], acc, 0, 0, 0);
        s[kt] = acc;
    }
    float gm = -3.0e38f;
#pragma unroll
    for (int kt = 0; kt < NT; ++kt)
#pragma unroll
        for (int i = 0; i < 16; ++i) {
            float v = s[kt][i] * 0.125f;
            if (HASB) v = bias(kt, (i & 3) + 8 * (i >> 2) + 4 * h, v);
            s[kt][i] = v; gm = fmaxf(gm, v);
        }
    gm = fmaxf(gm, xor32(gm, lane));
    const float mnew = fmaxf(st.m, gm);
    const float alpha = __expf(st.m - mnew);
    float ps = 0.f;
#pragma unroll
    for (int kt = 0; kt < NT; ++kt)
#pragma unroll
        for (int i = 0; i < 16; ++i) { const float p = __expf(s[kt][i] - mnew); s[kt][i] = p; ps += p; }
    st.l = st.l * alpha + ps; st.m = mnew;
#pragma unroll
    for (int i = 0; i < 16; ++i) { st.o[0][i] *= alpha; st.o[1][i] *= alpha; }
    const int i16 = lane & 15, tq = i16 >> 2, tp = i16 & 3, blk = (lane >> 4) & 1;
#pragma unroll
    for (int kt = 0; kt < NT; ++kt) {
        const LAS unsigned char* vb = lds + vlo(kt);
#pragma unroll
        for (int ss = 0; ss < 2; ++ss) {
            u32x4 pw; pw.x = cvtpk(s[kt][8 * ss + 0], s[kt][8 * ss + 1]); pw.y = cvtpk(s[kt][8 * ss + 2], s[kt][8 * ss + 3]); pw.z = cvtpk(s[kt][8 * ss + 4], s[kt][8 * ss + 5]); pw.w = cvtpk(s[kt][8 * ss + 6], s[kt][8 * ss + 7]);
            const bf16x8 pf = __builtin_bit_cast(bf16x8, pw);
#pragma unroll
            for (int dt = 0; dt < 2; ++dt) {
                const LAS unsigned char* p0 = vb + (16 * ss + 4 * h + tq) * 128 + (dt * 32 + 16 * blk + 4 * tp) * 2;
                const s16x4 lo = vtr(p0), hi = vtr(p0 + 8 * 128);
                const bf16x8 vf = __builtin_shufflevector(lo, hi, 0, 1, 2, 3, 4, 5, 6, 7);
                st.o[dt] = __builtin_amdgcn_mfma_f32_32x32x16_bf16(vf, pf, st.o[dt], 0, 0, 0);
            }
        }
    }
}

__device__ __forceinline__ void attn_store(const AttnState& st, bf16* orow  , int lane) {
    const int h = lane >> 5;
    const float lt = st.l + xor32(st.l, lane);
    const float inv = 1.0f / lt;
#pragma unroll
    for (int dt = 0; dt < 2; ++dt)
#pragma unroll
        for (int g = 0; g < 4; ++g) {
            const u32x2 w = (u32x2){cvtpk(st.o[dt][4 * g] * inv, st.o[dt][4 * g + 1] * inv), cvtpk(st.o[dt][4 * g + 2] * inv, st.o[dt][4 * g + 3] * inv)};
            *(u32x2*)(orow + dt * 32 + 8 * g + 4 * h) = w;
        }
}

__device__ __forceinline__ void attention_phase(const Frame& F, const Args& a, int layer) {
    unsigned char* ws = WSP(F);
    const bf16* proj = (const bf16*)(ws + WS_PROJ);
    bf16* oall = (bf16*)(ws + WS_OALL);
    const int lane = F.lane, w = F.wave, r = lane & 31, h = lane >> 5;
    LAS unsigned char* lds = F.lds;
    LAS float* rpbl = (LAS float*)(lds + 122880);
    for (int u = F.bid; u < 1024; u += F.G) {
        __syncthreads();
        if (u < 512) {
            const int b = u >> 4, hd = u & 15;
            const int tok0 = b * 256;
            for (int i = F.tid; i < 256 * 8; i += 512) { const int key = i >> 3, pc = i & 7;
                *(LAS u32x4*)(lds + key * 128 + pc * 16) = *(const u32x4*)(proj + (size_t)(tok0 + key) * NPROJ + COL_V + hd * 64 + pc * 8); }
            __syncthreads();
            bf16x8 qf[4];
            { const bf16* qp = proj + (size_t)(tok0 + 32 * w + r) * NPROJ + hd * 64 + 8 * h;
#pragma unroll
              for (int ks = 0; ks < 4; ++ks) qf[ks] = *(const bf16x8*)(qp + 16 * ks); }
            AttnState st; st.m = -3.0e38f; st.l = 0.f;
#pragma unroll
            for (int i = 0; i < 16; ++i) { st.o[0][i] = 0.f; st.o[1][i] = 0.f; }
            const bf16* kbase = proj + (size_t)tok0 * NPROJ + COL_K + hd * 64;
#pragma unroll 1
            for (int kg = 0; kg < 2; ++kg)
                attendN<4, false>(st, qf, [&](int kt) { return kbase + (size_t)((kg * 4 + kt) * 32) * NPROJ; }, (size_t)NPROJ, lds, [&](int kt) { return (kg * 4 + kt) * 4096; }, [&](int, int, float v) { return v; }, lane);
            attn_store(st, oall + (size_t)(tok0 + 32 * w + r) * 3072 + hd * 64, lane);
        } else {
            const int uu = u - 512, b = uu >> 7, hd = (uu >> 3) & 15, rg = uu & 7;
            const int tokb = NPR + b * 2048;
            int rlo = 4 * rg - 4; rlo = rlo < 0 ? 0 : (rlo > 24 ? 24 : rlo);
            int rhi0 = 4 * rg + 3 - 4; rhi0 = rhi0 < 0 ? 0 : (rhi0 > 24 ? 24 : rhi0); const int nr = rhi0 + 8 - rlo;
            for (int i = F.tid; i < nr * 64 * 8; i += 512) { const int key = i >> 3, pc = i & 7;
                *(LAS u32x4*)(lds + key * 128 + pc * 16) = *(const u32x4*)(proj + (size_t)(tokb + rlo * 64 + key) * NPROJ + COL_V + hd * 64 + pc * 8); }
            const bf16* cv = (const bf16*)(ws + WS_CV) + ((size_t)(b * 4 + layer) * 256) * 1024 + hd * 64;
            const bf16* ck = (const bf16*)(ws + WS_CK) + ((size_t)(b * 4 + layer) * 256) * 1024 + hd * 64;
            for (int i = F.tid; i < 256 * 8; i += 512) { const int key = i >> 3, pc = i & 7;
                *(LAS u32x4*)(lds + 90112 + key * 128 + pc * 16) = *(const u32x4*)(cv + (size_t)key * 1024 + pc * 8); }
            for (int i = F.tid; i < 465; i += 512) rpbl[i] = INP(F, I_RPB)[((size_t)layer * 16 + hd) * 465 + i];
            __syncthreads();
            const int qrow = 4 * rg + (w >> 1), qc = (w & 1) * 32 + r;
            int r0 = qrow - 4; r0 = r0 < 0 ? 0 : (r0 > 24 ? 24 : r0);
            int c0 = qc - 8; c0 = c0 < 0 ? 0 : (c0 > 48 ? 48 : c0);
            const int qtok = tokb + qrow * 64 + (w & 1) * 32 + r;
            bf16x8 qf[4];
            { const bf16* qp = proj + (size_t)qtok * NPROJ + hd * 64 + 8 * h;
#pragma unroll
              for (int ks = 0; ks < 4; ++ks) qf[ks] = *(const bf16x8*)(qp + 16 * ks); }
            AttnState st; st.m = -3.0e38f; st.l = 0.f;
#pragma unroll
            for (int i = 0; i < 16; ++i) { st.o[0][i] = 0.f; st.o[1][i] = 0.f; }
            const bf16* kloc = proj + (size_t)tokb * NPROJ + COL_K + hd * 64;
#pragma unroll 1
            for (int grp = 0; grp < 4; ++grp) {
                const int krb = r0 + 2 * grp;
                attendN<4, true>(st, qf, [&](int kt) { return kloc + (size_t)((krb + (kt >> 1)) * 64 + (kt & 1) * 32) * NPROJ; }, (size_t)NPROJ, lds,
                    [&](int kt) { return ((krb + (kt >> 1) - rlo) * 64 + (kt & 1) * 32) * 128; },
                    [&](int kt, int kin, float v) { const int kr = krb + (kt >> 1), kc = (kt & 1) * 32 + kin; const bool ok = (kc >= c0) && (kc < c0 + 16);
                        const int dr = kr - qrow + 7, dc = kc - qc + 15; const int idx = ok ? dr * 31 + dc : 0; return ok ? v + rpbl[idx] : -1.0e30f; }, lane);
            }
#pragma unroll 1
            for (int kg = 0; kg < 2; ++kg)
                attendN<4, false>(st, qf, [&](int kt) { return ck + (size_t)((kg * 4 + kt) * 32) * 1024; }, (size_t)1024, lds, [&](int kt) { return 90112 + (kg * 4 + kt) * 4096; }, [&](int, int, float v) { return v; }, lane);
            attn_store(st, oall + (size_t)qtok * 3072 + hd * 64, lane);
        }
    }
    __syncthreads();
}

__device__ __forceinline__ void rwkv_prep_phase(const Frame& F, const Args& a, int layer) {
    unsigned char* ws = WSP(F);
    const bf16* proj = (const bf16*)(ws + WS_PROJ);
    const bf16* abuf = (const bf16*)(ws + WS_A);
    bf16* ops = (bf16*)(ws + WS_OPS);
    float* bonus = (float*)(ws + WS_BONUS);
    const float* cw = INP(F, I_CW) + (size_t)layer * 3 * 3072; const float* cb = INP(F, I_CB) + (size_t)layer * 3072;
    const float* kkw = INP(F, I_KK) + layer * 1024; const float* kaw = INP(F, I_KA) + layer * 1024; const float* rkw = INP(F, I_RK) + layer * 1024;
    const int gw = F.bid * 8 + F.wave, NGW = F.G * 8, lane = F.lane;
    for (int tok = gw; tok < M; tok += NGW) {
        const int t = tok < NPR ? (tok & 255) : ((tok - NPR) & 2047), L = tok < NPR ? L_P : L_S;
        const bool hp = t > 0, hn = t < L - 1;
        const bf16* p0 = proj + (size_t)tok * NPROJ + COL_R;
        for (int hh = 0; hh < 16; ++hh) {
            const int c = hh * 64 + lane;
            float x[3];
#pragma unroll
            for (int s = 0; s < 3; ++s) {
                const int cc = s * 1024 + c;
                const float xm = hp ? bf2f(p0[cc - NPROJ]) : 0.f, x0 = bf2f(p0[cc]), xp = hn ? bf2f(p0[cc + NPROJ]) : 0.f;
                x[s] = xm * cw[cc] + x0 * cw[3072 + cc] + xp * cw[6144 + cc] + cb[cc];
            }
            const float rr = x[0], kk0 = x[1], vv = x[2];
            float kk = kk0 * kkw[c];
            const float ssq = wave_sum(kk * kk);
            kk *= 1.0f / sqrtf(ssq + 1e-12f);
            const float a0 = bf2f(abuf[((size_t)tok * 2 + 0) * 1024 + c]), a1 = bf2f(abuf[((size_t)tok * 2 + 1) * 1024 + c]);
            const float ka = kaw[c];
            const float kd0 = kk0 * (1.0f + (a0 - 1.0f) * ka), kd1 = kk0 * (1.0f + (a1 - 1.0f) * ka);
            const float bs = wave_sum(rr * kk0 * rkw[c]);
            bf16* o = ops + ((size_t)tok * 16 + hh) * 448 + lane;
            o[0] = f2bf(rr); o[64] = f2bf(vv); o[128] = f2bf(-kk); o[192] = f2bf(kd0); o[256] = f2bf(kk * a0); o[320] = f2bf(kd1); o[384] = f2bf(kk * a1);
            if (lane == 0) bonus[tok * 16 + hh] = bs;
        }
    }
}

__device__ __forceinline__ float quad_x1(float v) { return __int_as_float(__builtin_amdgcn_update_dpp(0, __float_as_int(v), 0xB1, 0xf, 0xf, false)); }
__device__ __forceinline__ float quad_x2(float v) { return __int_as_float(__builtin_amdgcn_update_dpp(0, __float_as_int(v), 0x4E, 0xf, 0xf, false)); }
constexpr int SC_TC = 4;
__device__ __forceinline__ void rwkv_scan_phase(const Frame& F, const Args& a, int layer) {
    unsigned char* ws = WSP(F);
    const bf16* ops = (const bf16*)(ws + WS_OPS);
    const float* dec = (const float*)(ws + WS_DEC);
    float* Y = (float*)(ws + WS_H);
    const int lane = F.lane, vr = lane >> 2, kq = lane & 3;
    LAS float* wl = (LAS float*)(F.lds + F.wave * 16384);
    LAS float* yl = wl + SC_TC * 384;
    for (int item = F.wave * F.G + F.bid; item < 1152; item += 8 * F.G) {
        int b, e, hd, L, tokb; bool sample;
        if (item < 128) { sample = true; b = item >> 5; e = (item >> 4) & 1; hd = item & 15; L = L_S; tokb = NPR + b * L_S; }
        else { const int r = item - 128; sample = false; b = r >> 5; e = (r >> 4) & 1; hd = r & 15; L = L_P; tokb = b * L_P; }
        float S[4][16];
        if (sample) { const float* s0 = INP(F, I_ST) + ((((size_t)b * 4 + layer) * 2 + e) * 16 + hd) * 4096;
#pragma unroll
            for (int i = 0; i < 4; ++i)
#pragma unroll
                for (int j4 = 0; j4 < 4; ++j4) { const f32x4 v = *(const f32x4*)(s0 + (vr + 16 * i) * 64 + 16 * kq + 4 * j4); S[i][4 * j4] = v[0]; S[i][4 * j4 + 1] = v[1]; S[i][4 * j4 + 2] = v[2]; S[i][4 * j4 + 3] = v[3]; }
        } else {
#pragma unroll
            for (int i = 0; i < 4; ++i)
#pragma unroll
                for (int j = 0; j < 16; ++j) S[i][j] = 0.f;
        }
        float pw[SC_TC]; bf16 pv[SC_TC], pn[SC_TC], pk[SC_TC], pb[SC_TC], pr[SC_TC];
#define SC_LOAD(T0) do { _Pragma("unroll") for (int s = 0; s < SC_TC; ++s) { \
            const int tau = e ? (L - 1 - ((T0) + s)) : ((T0) + s); const size_t tok = (size_t)(tokb + tau); \
            const bf16* o = ops + (tok * 16 + hd) * 448 + lane; \
            pw[s] = dec[(tok * 2 + e) * 1024 + hd * 64 + lane]; pv[s] = o[64]; pn[s] = o[128]; pk[s] = o[192 + 128 * e]; pb[s] = o[256 + 128 * e]; pr[s] = o[0]; } } while (0)
        SC_LOAD(0);
        for (int t0 = 0; t0 < L; t0 += SC_TC) {
#pragma unroll
            for (int s = 0; s < SC_TC; ++s) {
                wl[s * 384 + 0 * 64 + lane] = pw[s]; wl[s * 384 + 1 * 64 + lane] = bf2f(pv[s]); wl[s * 384 + 2 * 64 + lane] = bf2f(pn[s]);
                wl[s * 384 + 3 * 64 + lane] = bf2f(pk[s]); wl[s * 384 + 4 * 64 + lane] = bf2f(pb[s]); wl[s * 384 + 5 * 64 + lane] = bf2f(pr[s]);
            }
            if (t0 + SC_TC < L) SC_LOAD(t0 + SC_TC);
            LDS_WAIT(); asm volatile("" ::: "memory");
#pragma unroll
            for (int s = 0; s < SC_TC; ++s) {
                const LAS float* q = wl + s * 384 + 16 * kq;
                float w_[16], nk[16], kd[16], bb[16], rr[16];
#pragma unroll
                for (int j4 = 0; j4 < 4; ++j4) {
                    const f32x4 a0 = *(const LAS f32x4*)(q + 0 * 64 + 4 * j4), a2 = *(const LAS f32x4*)(q + 2 * 64 + 4 * j4), a3 = *(const LAS f32x4*)(q + 3 * 64 + 4 * j4),
                                a4 = *(const LAS f32x4*)(q + 4 * 64 + 4 * j4), a5 = *(const LAS f32x4*)(q + 5 * 64 + 4 * j4);
#pragma unroll
                    for (int j = 0; j < 4; ++j) { w_[4 * j4 + j] = a0[j]; nk[4 * j4 + j] = a2[j]; kd[4 * j4 + j] = a3[j]; bb[4 * j4 + j] = a4[j]; rr[4 * j4 + j] = a5[j]; }
                }
#pragma unroll
                for (int i = 0; i < 4; ++i) {
                    const float vv = wl[s * 384 + 64 + vr + 16 * i];
                    float sa0 = 0.f, sa1 = 0.f;
#pragma unroll
                    for (int j = 0; j < 16; j += 2) { sa0 += S[i][j] * nk[j]; sa1 += S[i][j + 1] * nk[j + 1]; }
                    float sa = sa0 + sa1;
                    sa += quad_x1(sa); sa += quad_x2(sa);
                    float y0 = 0.f, y1 = 0.f;
#pragma unroll
                    for (int j = 0; j < 16; j += 2) {
                        S[i][j] = S[i][j] * w_[j] + (sa * bb[j] + vv * kd[j]); y0 += S[i][j] * rr[j];
                        S[i][j + 1] = S[i][j + 1] * w_[j + 1] + (sa * bb[j + 1] + vv * kd[j + 1]); y1 += S[i][j + 1] * rr[j + 1];
                    }
                    float y = y0 + y1;
                    y += quad_x1(y); y += quad_x2(y);
                    if (kq == 0) yl[s * 64 + vr + 16 * i] = y;
                }
            }
            LDS_WAIT(); asm volatile("" ::: "memory");
#pragma unroll
            for (int s = 0; s < SC_TC; ++s) {
                const int tau = e ? (L - 1 - (t0 + s)) : (t0 + s);
                Y[((size_t)e * M + tokb + tau) * 1024 + hd * 64 + lane] = yl[s * 64 + lane];
            }
            LDS_WAIT(); asm volatile("" ::: "memory");
        }
        if (!sample) { float* so = OUTP(F) + OUT_ST + ((((size_t)b * 4 + layer) * 2 + e) * 16 + hd) * 4096;
#pragma unroll
            for (int i = 0; i < 4; ++i)
#pragma unroll
                for (int j4 = 0; j4 < 4; ++j4) *(f32x4*)(so + (vr + 16 * i) * 64 + 16 * kq + 4 * j4) = (f32x4){S[i][4 * j4], S[i][4 * j4 + 1], S[i][4 * j4 + 2], S[i][4 * j4 + 3]};
        }
    }
}

__device__ __forceinline__ void rwkv_post_phase(const Frame& F, const Args& a, int layer) {
    unsigned char* ws = WSP(F);
    const float* Y = (const float*)(ws + WS_H);
    const bf16* ops = (const bf16*)(ws + WS_OPS); const bf16* gbuf = (const bf16*)(ws + WS_G); const float* bonus = (const float*)(ws + WS_BONUS);
    bf16* oall = (bf16*)(ws + WS_OALL);
    const float* gng = INP(F, I_GNG) + layer * 1024; const float* gnb = INP(F, I_GNB) + layer * 1024;
    const int gw = F.bid * 8 + F.wave, NGW = F.G * 8, lane = F.lane;
    for (int tok = gw; tok < M; tok += NGW) {
        for (int hh = 0; hh < 16; ++hh) {
            const int c = hh * 64 + lane;
            const float y = Y[(size_t)tok * 1024 + c] + Y[((size_t)M + tok) * 1024 + c];
            const float mu = wave_sum(y) * (1.0f / 64.0f);
            const float dd = y - mu;
            const float var = wave_sum(dd * dd) * (1.0f / 64.0f);
            const float yn = dd * (1.0f / sqrtf(var + 64e-5f)) * gng[c] + gnb[c];
            const float v = bf2f(ops[((size_t)tok * 16 + hh) * 448 + 64 + lane]);
            const float g = bf2f(gbuf[(size_t)tok * 1024 + c]);
            oall[(size_t)tok * 3072 + 1024 + c] = f2bf((yn + bonus[tok * 16 + hh] * v) * g);
        }
    }
}

__device__ __forceinline__ void hyena_prep_phase(const Frame& F, const Args& a, int layer) {
    unsigned char* ws = WSP(F);
    const bf16* proj = (const bf16*)(ws + WS_PROJ);
    bf16* zT = (bf16*)(ws + WS_ZT);
    const float* cw = INP(F, I_HCW) + (size_t)layer * 3 * 3072; const float* cb = INP(F, I_HCB) + (size_t)layer * 3072;
    const int gw = F.bid * 8 + F.wave, NGW = F.G * 8, lane = F.lane;
    LAS bf16* tl = (LAS bf16*)(F.lds + F.wave * 16384);
    for (int it = gw; it < 256 * 16; it += NGW) {
        const int tt0 = (it >> 4) * 64, c0 = (it & 15) * 64, c = c0 + lane;
        const int t0 = tt0 < NPR ? (tt0 & 255) : ((tt0 - NPR) & 2047), L = tt0 < NPR ? L_P : L_S;
        const float w1a = cw[1024 + c], w1b = cw[3072 + 1024 + c], w1c = cw[6144 + 1024 + c], b1 = cb[1024 + c];
        const float w2a = cw[2048 + c], w2b = cw[3072 + 2048 + c], w2c = cw[6144 + 2048 + c], b2 = cb[2048 + c];
        const bf16* px = proj + (size_t)tt0 * NPROJ + COL_X1 + c; const bf16* pv = proj + (size_t)tt0 * NPROJ + COL_VV + c;
        float xm = (t0 > 0) ? bf2f(px[-NPROJ]) : 0.f, x0 = bf2f(px[0]);
        float vm = (t0 > 0) ? bf2f(pv[-NPROJ]) : 0.f, v0 = bf2f(pv[0]);
        for (int tt = 0; tt < 64; ++tt) {
            const bool hn = (t0 + tt) < L - 1;
            const float xp = hn ? bf2f(px[(size_t)(tt + 1) * NPROJ]) : 0.f, vp = hn ? bf2f(pv[(size_t)(tt + 1) * NPROJ]) : 0.f;
            const float x1c = xm * w1a + x0 * w1b + xp * w1c + b1, vvc = vm * w2a + v0 * w2b + vp * w2c + b2;
            tl[tt * 66 + lane] = f2bf(vvc * x1c);
            xm = x0; x0 = xp; vm = v0; v0 = vp;
        }
        LDS_WAIT(); asm volatile("" ::: "memory");
        for (int cc = 0; cc < 64; ++cc) zT[(size_t)(c0 + cc) * M + tt0 + lane] = tl[lane * 66 + cc];
        LDS_WAIT(); asm volatile("" ::: "memory");
    }
}

__device__ __forceinline__ void hyena_conv_phase(const Frame& F, const Args& a, int layer) {
    unsigned char* ws = WSP(F);
    bf16* zT = (bf16*)(ws + WS_ZT);
    const float* FNORM = (const float*)(ws + WS_CTL) + CW_FNORM;
    const int lane = F.lane, w = F.wave, r = lane & 31, h = lane >> 5;
    LAS unsigned char* lds = F.lds;
    for (int u = F.bid; u < 2048; u += F.G) {
        const bool sample = u < 1024; const int c = u & 1023;
        const int L = sample ? L_S : L_P, LP = sample ? LPS : LPP, FCS = LP * 2;
        const int ZROW = (L + 448) * 2, ZOFF = 8 * FCS;
        const int NB = sample ? 4 : 32, tokb = sample ? NPR : 0;
        const bf16* fsrc = sample ? (const bf16*)(ws + WS_FS) + ((size_t)layer * 1024 + c) * LPS : (const bf16*)(ws + WS_FP) + ((size_t)layer * 1024 + c) * LPP;
        __syncthreads();
        for (int i = F.tid; i < 8 * LP; i += 512) { const int s = i / LP, m = i - s * LP; *(LAS bf16*)(lds + s * FCS + m * 2) = (m + s < LP) ? fsrc[m + s] : (bf16)0; }
        { const int rowel = L + 448;
          for (int i = F.tid; i < NB * rowel; i += 512) { const int b = i / rowel, p = i - b * rowel, t = p - 224;
              *(LAS bf16*)(lds + ZOFF + b * ZROW + p * 2) = (t >= 0 && t < L) ? zT[(size_t)c * M + tokb + b * L + t] : (bf16)0; } }
        __syncthreads();
        const int nbl = sample ? 2 : 5;
        const int I0 = sample ? 8 * w : w;
        const int b = r & (NB - 1), I = I0 + (r >> nbl);
        int dlo = (sample ? I0 - 63 : I0 - 7), dhi = (sample ? I0 + 7 : I0);
        const int dmax = L / 64;
        dlo = dlo < -dmax ? -dmax : dlo; dhi = dhi > dmax ? dmax : dhi;
        f32x16 acc;
#pragma unroll
        for (int i = 0; i < 16; ++i) acc[i] = 0.f;
        const LAS unsigned char* zb = lds + ZOFF + b * ZROW + (224 + 8 * h) * 2;
        for (int d = dlo; d <= dhi; ++d) {
#pragma unroll
            for (int ks = 0; ks < 2; ++ks) {
                const int st = (L / 2 - 1) - 32 * d - r + 16 * ks + 8 * h + 32;
                const int sft = st & 7;
                const bf16x8 af = *(const LAS bf16x8*)(lds + sft * FCS + (st - sft) * 2);
                const bf16x8 bfr = *(const LAS bf16x8*)(zb + (32 * (I - d) + 16 * ks) * 2);
                acc = __builtin_amdgcn_mfma_f32_32x32x16_bf16(af, bfr, acc, 0, 0, 0);
            }
        }
        const float inv = 1.0f / (FNORM[((size_t)layer * 2 + (sample ? 0 : 1)) * 1024 + c] + 1e-6f);
        const float dco = INP(F, I_HD)[layer * 1024 + c];
        __syncthreads();
#pragma unroll
        for (int g = 0; g < 4; ++g) {
            const int t = 32 * I + 8 * g + 4 * h;
            const LAS bf16* zp = (const LAS bf16*)(lds + ZOFF + b * ZROW + (224 + t) * 2);
            float o[4];
#pragma unroll
            for (int j = 0; j < 4; ++j) o[j] = acc[4 * g + j] * inv + bf2f(zp[j]) * dco;
            *(u32x2*)(zT + (size_t)c * M + tokb + b * L + t) = (u32x2){cvtpk(o[0], o[1]), cvtpk(o[2], o[3])};
        }
    }
    __syncthreads();
}

__device__ __forceinline__ void hyena_post_phase(const Frame& F, const Args& a, int layer) {
    unsigned char* ws = WSP(F);
    const bf16* proj = (const bf16*)(ws + WS_PROJ);
    const bf16* yT = (const bf16*)(ws + WS_ZT);
    bf16* oall = (bf16*)(ws + WS_OALL);
    const float* cw = INP(F, I_HCW) + (size_t)layer * 3 * 3072; const float* cb = INP(F, I_HCB) + (size_t)layer * 3072;
    const int gw = F.bid * 8 + F.wave, NGW = F.G * 8, lane = F.lane;
    LAS bf16* tl = (LAS bf16*)(F.lds + F.wave * 16384);
    for (int it = gw; it < 256 * 16; it += NGW) {
        const int tt0 = (it >> 4) * 64, c0 = (it & 15) * 64, c = c0 + lane;
        const int t0 = tt0 < NPR ? (tt0 & 255) : ((tt0 - NPR) & 2047), L = tt0 < NPR ? L_P : L_S;
        for (int cc = 0; cc < 64; ++cc) tl[cc * 66 + lane] = yT[(size_t)(c0 + cc) * M + tt0 + lane];
        LDS_WAIT(); asm volatile("" ::: "memory");
        const float wa = cw[c], wb = cw[3072 + c], wc = cw[6144 + c], b0 = cb[c];
        const bf16* px = proj + (size_t)tt0 * NPROJ + COL_X0 + c;
        float xm = (t0 > 0) ? bf2f(px[-NPROJ]) : 0.f, x0 = bf2f(px[0]);
        for (int tt = 0; tt < 64; ++tt) {
            const bool hn = (t0 + tt) < L - 1;
            const float xp = hn ? bf2f(px[(size_t)(tt + 1) * NPROJ]) : 0.f;
            const float x0c = xm * wa + x0 * wb + xp * wc + b0;
            oall[(size_t)(tt0 + tt) * 3072 + 2048 + c] = f2bf(x0c * bf2f(tl[lane * 66 + tt]));
            xm = x0; x0 = xp;
        }
        LDS_WAIT(); asm volatile("" ::: "memory");
    }
}

constexpr int NPL = 12, PH_LAYER0 = 2, PH_FINAL = PH_LAYER0 + DEPTH * NPL, N_PHASES = PH_FINAL + 1;

__global__ void __launch_bounds__(512, 2) mega(Args args) {
    extern __shared__ __attribute__((aligned(16))) unsigned char lds_raw[];
    Frame F;
    F.lds = (LAS unsigned char*)lds_raw;
    F.tid = threadIdx.x; F.lane = F.tid & 63; F.wave = __builtin_amdgcn_readfirstlane(F.tid >> 6);
    F.G = gridDim.x; F.bid = blockIdx.x;
    for (int u = F.tid; u < (LDS_BYTES - LDSCTL_OFF) / 4; u += 512) ((LAS unsigned*)(F.lds + LDSCTL_OFF))[u] = 0u;
    __syncthreads();
    if (F.tid < 48) { const unsigned long long p = F.tid < 46 ? (unsigned long long)args.in[F.tid] : (F.tid == 46 ? (unsigned long long)args.out : (unsigned long long)args.ws);
        ((LAS unsigned*)(F.lds + LDS_ARGT))[2 * F.tid] = (unsigned)p; ((LAS unsigned*)(F.lds + LDS_ARGT))[2 * F.tid + 1] = (unsigned)(p >> 32); }
    __syncthreads();
    unsigned char* ws = WSP(F);
    unsigned* ctl = (unsigned*)(ws + WS_CTL);
    int lo = args.ph_lo, hi = args.ph_hi;
    const bool single = (hi - lo) > 1;
    XcdBarrier bar; bar.bar = ctl + CW_BAR; bar.x = 0; bar.st = (volatile LAS unsigned*)(F.lds + LDSCTL_OFF + 64);
    if (single) bar = xcd_barrier_post(ctl + CW_BAR, (volatile LAS unsigned*)(F.lds + LDSCTL_OFF + 64));
#ifndef MK_EN
#define MK_EN 0xFFFFF
#endif
#define IN(k) (lo <= (k) && (k) < hi)
#define EN(b) ((MK_EN >> (b)) & 1)
#define FRESH() asm volatile("" : "+v"(F.tid), "+v"(F.lane), "+s"(F.bid), "+s"(F.wave), "+s"(F.G))
#define SEAM(k) do { if (IN(k) && IN((k) + 1)) xcd_barrier(bar); } while (0)

    if (EN(12) && IN(0)) { FRESH(); prologue0(F, args); SEAM(0); }
    if (EN(13) && IN(1)) { FRESH(); prologue1(F, args); SEAM(1); }

    bf16* Hb = (bf16*)(ws + WS_H); bf16* proj = (bf16*)(ws + WS_PROJ); bf16* oall = (bf16*)(ws + WS_OALL);
    float* x = OUTP(F);
#pragma unroll 1
    for (int l = 0; l < DEPTH; ++l) {
        const int pb = PH_LAYER0 + l * NPL;
        asm volatile("" : "+s"(lo), "+s"(hi));
        const float* mod = (const float*)(ws + WS_MOD) + (size_t)l * 5 * 12288;
        if (EN(0) && IN(pb + 0)) { FRESH();
            norm_phase(F, l == 0 ? INP(F, I_XP) : x, l == 0 ? INP(F, I_XS) : x + (size_t)NPR * D, l == 0 ? x : nullptr, INP(F, I_LN1) + l * D, mod, 0, 1, Hb);
            SEAM(pb + 0);
        }
        if (EN(1) && IN(pb + 1)) { FRESH();
            pg8::Gemm g{Hb, (const bf16*)(ws + WS_WIN) + (size_t)l * NPROJ * D, D, D, D, 0, 0, 0};
            pg8::Order S; S.init(M, NPROJ, F.G, F.bid, 1);
            pg8::EpiProj E{proj, x + OUT_CK, x + OUT_CV, l};
            pg8::gemm_phase(F.lds, g, S, E);
            SEAM(pb + 1);
        }
        if (EN(2) && IN(pb + 2)) { FRESH();
            pg8::Gemm g{proj + COL_LW, (const bf16*)(ws + WS_W2T) + (size_t)l * 5120 * 256, NPROJ, 256, 256, 0, 128, 4};
            pg8::Order5 S; S.init(M, F.G, F.bid);
            pg8::EpiLora2 E{(float*)(ws + WS_DEC), (bf16*)(ws + WS_A), (bf16*)(ws + WS_G), INP(F, I_W0) + l * 2048, INP(F, I_A0) + l * 2048};
            pg8::gemm_phase(F.lds, g, S, E);
            SEAM(pb + 2);
        }
        if (EN(3) && IN(pb + 3)) { FRESH();
            attention_phase(F, args, l); FRESH();
            hyena_prep_phase(F, args, l); FRESH();
            rwkv_prep_phase(F, args, l);
            SEAM(pb + 3);
        }
        if (EN(4) && IN(pb + 4)) { FRESH(); rwkv_scan_phase(F, args, l); SEAM(pb + 4); }
        if (EN(5) && IN(pb + 5)) { FRESH(); hyena_conv_phase(F, args, l); SEAM(pb + 5); }
        if (EN(6) && IN(pb + 6)) { FRESH(); rwkv_post_phase(F, args, l); FRESH(); hyena_post_phase(F, args, l); SEAM(pb + 6); }
        if (EN(7) && IN(pb + 7)) { FRESH();
            pg8::Gemm g{oall, (const bf16*)(ws + WS_WP) + (size_t)l * 3 * D * 1024, 3072, 1024, 1024, 1024, 0, 8};
            pg8::Order S; S.init(M, D, F.G, F.bid, 3);
            pg8::EpiMerge E{proj, Hb};
            pg8::gemm_phase(F.lds, g, S, E);
            SEAM(pb + 7);
        }
        if (EN(8) && IN(pb + 8)) { FRESH();
            pg8::Gemm g{Hb, (const bf16*)(ws + WS_WOUT) + (size_t)l * D * D, D, D, D, 0, 0, 0};
            pg8::Order S; S.init(M, D, F.G, F.bid, 1);
            pg8::EpiResid E{x, mod + 2 * D, nullptr};
            pg8::gemm_phase(F.lds, g, S, E);
            SEAM(pb + 8);
        }
        if (EN(9) && IN(pb + 9)) { FRESH(); norm_phase(F, x, x + (size_t)NPR * D, nullptr, INP(F, I_LN2) + l * D, mod, 3, 4, Hb); SEAM(pb + 9); }
        if (EN(10) && IN(pb + 10)) { FRESH();
            pg8::Gemm g{Hb, (const bf16*)(ws + WS_WFF1) + (size_t)l * D * DFF, D, D, D, 0, 0, 0};
            pg8::Order S; S.init(M, DFF, F.G, F.bid, 1);
            pg8::EpiFF1 E{proj, INP(F, I_BFF1) + l * DFF};
            pg8::gemm_phase(F.lds, g, S, E);
            SEAM(pb + 10);
        }
        if (EN(11) && IN(pb + 11)) { FRESH();
            pg8::Gemm g{proj, (const bf16*)(ws + WS_WFF2) + (size_t)l * D * DFF, DFF, DFF, DFF, 0, 0, 0};
            pg8::Order S; S.init(M, D, F.G, F.bid, 1);
            pg8::EpiResid E{x, mod + 5 * D, INP(F, I_BFF2) + l * D};
            pg8::gemm_phase(F.lds, g, S, E);
            SEAM(pb + 11);
        }
    }
    asm volatile("" : "+s"(lo), "+s"(hi));
    if (EN(14) && IN(PH_FINAL)) { FRESH(); final_norm_phase(F, OUTP(F), INP(F, I_FING)); }
#undef IN
#undef SEAM
}

extern "C" void kernel_launch(void* const* d_in, const int* in_sizes, int n_in, void* d_out, int out_size, void* d_ws, size_t ws_size, hipStream_t stream) {
    static int grid = 0;
    if (grid == 0) {
        if (n_in != N_INPUTS || (size_t)out_size != OUT_TOTAL || ws_size < WS_END) { fprintf(stderr, "kernel_launch: unexpected shapes: n_in %d out %d ws %zu\n", n_in, out_size, ws_size); grid = -1; return; }
        int dev = 0, cus = 0, per_cu = 0;
        if (hipGetDevice(&dev) != hipSuccess || hipDeviceGetAttribute(&cus, hipDeviceAttributeMultiprocessorCount, dev) != hipSuccess) { grid = -1; return; }
        if (hipFuncSetAttribute((const void*)mega, hipFuncAttributeMaxDynamicSharedMemorySize, LDS_BYTES) != hipSuccess) { fprintf(stderr, "kernel_launch: hipFuncSetAttribute failed\n"); grid = -1; return; }
        if (hipOccupancyMaxActiveBlocksPerMultiprocessor(&per_cu, (const void*)mega, 512, LDS_BYTES) != hipSuccess || per_cu < 1) { fprintf(stderr, "kernel_launch: occupancy query says %d\n", per_cu); }
        (void)hipGetLastError();
        grid = cus;
    }
    if (grid < 0) return;
    (void)hipMemsetAsync((char*)d_ws + WS_CTL, 0, CTL_ZERO_BYTES, stream);
    Args a{};
    for (int i = 0; i < N_INPUTS; ++i) a.in[i] = (const float*)d_in[i];
    a.out = (float*)d_out; a.ws = (unsigned char*)d_ws;
#if MK_MULTI
    for (int ph = 0; ph < N_PHASES; ++ph) { a.ph_lo = ph; a.ph_hi = ph + 1; hipLaunchKernelGGL(mega, dim3(grid), dim3(512), LDS_BYTES, stream, a); }
#else
    a.ph_lo = 0; a.ph_hi = N_PHASES;
    hipLaunchKernelGGL(mega, dim3(grid), dim3(512), LDS_BYTES, stream, a);
#endif
    const hipError_t le = hipPeekAtLastError();
    if (le != hipSuccess) fprintf(stderr, "kernel_launch: launch failed: %s\n", hipGetErrorName(le));
}
```

```cpp
#include <hip/hip_runtime.h>
#include <cstdio>
#include <cstdint>

#ifndef MK_MULTI
#define MK_MULTI 0
#endif

#define GAS __attribute__((address_space(1)))
#define LAS __attribute__((address_space(3)))
typedef unsigned short bf16;
typedef short bf16x8 __attribute__((ext_vector_type(8)));
typedef short s16x4 __attribute__((ext_vector_type(4)));
typedef float f32x4 __attribute__((ext_vector_type(4)));
typedef float f32x2 __attribute__((ext_vector_type(2)));
typedef float f32x16 __attribute__((ext_vector_type(16)));
typedef unsigned u32x4 __attribute__((ext_vector_type(4)));
typedef unsigned u32x2 __attribute__((ext_vector_type(2)));
typedef __bf16 bf16x2_t __attribute__((ext_vector_type(2)));

constexpr int D = 2048, DEPTH = 4, NPR = 8192  , M = 16384, DFF = 8192;
constexpr int NPROJ = 15872;
constexpr int COL_K = 1024, COL_V = 2048, COL_R = 3072, COL_X0 = 6144, COL_X1 = 7168, COL_VV = 8192, COL_GL = 9216, COL_LW = 15360, COL_G1A = 15488;
constexpr int L_P = 256, L_S = 2048;

enum { I_XP = 0, I_XS, I_CK, I_CV, I_ST, I_C, I_CCTX, I_LN1, I_LN2, I_WMOD, I_BMOD, I_WIN, I_RPB, I_CW, I_CB, I_W0, I_W1, I_W2, I_A0, I_A1, I_A2, I_G1, I_G2,
       I_KK, I_KA, I_RK, I_GNG, I_GNB, I_HCW, I_HCB, I_F1, I_FB1, I_F2, I_FB2, I_FREQ, I_F3, I_HD, I_WPA, I_WPR, I_WPC, I_WOUT, I_FF1, I_BFF1, I_FF2, I_BFF2, I_FING, N_INPUTS };

constexpr size_t OUT_X = 0, OUT_CK = 33554432, OUT_CV = 67108864, OUT_ST = 100663296, OUT_TOTAL = 117440512;

constexpr size_t MiB = 1u << 20;
constexpr size_t WS_CTL = 0, CTL_ZERO_BYTES = 1 * MiB;
constexpr size_t WS_WIN = 2 * MiB;
constexpr size_t WS_W2T = 250 * MiB;
constexpr size_t WS_WP = 260 * MiB;
constexpr size_t WS_WOUT = 308 * MiB;
constexpr size_t WS_WFF1 = 340 * MiB;
constexpr size_t WS_WFF2 = 468 * MiB;
constexpr size_t WS_H = 596 * MiB;
constexpr size_t WS_A = 660 * MiB;
constexpr size_t WS_PROJ = 724 * MiB;
constexpr size_t WS_OALL = 1220 * MiB;
constexpr size_t WS_DEC = 1316 * MiB;
constexpr size_t WS_G = 1444 * MiB;
constexpr size_t WS_OPS = 1476 * MiB;
constexpr size_t WS_CK = 1700 * MiB;
constexpr size_t WS_CV = 1708 * MiB;
constexpr size_t WS_FS = 1716 * MiB;
constexpr size_t WS_FP = 1733 * MiB;
constexpr size_t WS_ZT = 1736 * MiB;
constexpr size_t WS_MOD = 1768 * MiB;
constexpr size_t WS_T2 = 1769 * MiB;
constexpr size_t WS_BONUS = 1773 * MiB;
constexpr size_t WS_Q = 1774 * MiB;
constexpr size_t WS_CEND = 1838 * MiB;
constexpr size_t WS_PEND = 1854 * MiB;
constexpr size_t WS_SS = 1870 * MiB;
constexpr size_t WS_END = 1886 * MiB;
constexpr int LPS = 2120, LPP = 328;

constexpr int CW_BAR = 4096;
constexpr int CW_FNORM = 32768;

constexpr int LDS_SCRATCH = 131072, LDSCTL_OFF = 131072, LDS_BYTES = 147456;

#define LDS_WAIT() asm volatile("s_waitcnt lgkmcnt(0)" ::: "memory")
#define VM_WAIT() asm volatile("s_waitcnt vmcnt(0)" ::: "memory")
__device__ __forceinline__ unsigned cvtpk(float lo, float hi) { f32x2 v = {lo, hi}; bf16x2_t b = __builtin_convertvector(v, bf16x2_t); return __builtin_bit_cast(unsigned, b); }
__device__ __forceinline__ bf16 f2bf(float f) { return (bf16)(cvtpk(f, 0.f) & 0xffffu); }
__device__ __forceinline__ float bf2f(bf16 b) { return __uint_as_float(((unsigned)b) << 16); }
__device__ __forceinline__ float bflo(unsigned w) { return __uint_as_float(w << 16); }
__device__ __forceinline__ float bfhi(unsigned w) { return __uint_as_float(w & 0xffff0000u); }
#define DPPF(v, ctrl) __int_as_float(__builtin_amdgcn_update_dpp(0, __float_as_int(v), (ctrl), 0xf, 0xf, false))
__device__ __forceinline__ float wave_sum(float v) {
    v += DPPF(v, 0xB1); v += DPPF(v, 0x4E); v += DPPF(v, 0x141); v += DPPF(v, 0x140);
    const float a = __int_as_float(__builtin_amdgcn_readlane(__float_as_int(v), 0)), b = __int_as_float(__builtin_amdgcn_readlane(__float_as_int(v), 16)),
                c = __int_as_float(__builtin_amdgcn_readlane(__float_as_int(v), 32)), d = __int_as_float(__builtin_amdgcn_readlane(__float_as_int(v), 48));
    return (a + b) + (c + d);
}
__device__ __forceinline__ float xor32(float v, int lane) { return __int_as_float(__builtin_amdgcn_ds_bpermute((lane ^ 32) << 2, __float_as_int(v))); }
__device__ __forceinline__ float sigmoidf_(float x) { return 1.0f / (1.0f + __expf(-x)); }

#define XB_TMO      128
#define XB_XCNT(j)  (256  + 64 * (j))
#define XB_XSUB(j)  (1280 + 64 * (j))
#define XB_XGEN(j)  (2304 + 64 * (j))
#define XB_TOP      3328
#define XB_TOPGEN   3392
#define XCD_BAR_WORDS 3456
#define XB_SPIN_CAP (1u << 20)
__device__ __forceinline__ unsigned xb_ld(unsigned* p)              { return __hip_atomic_load(p, __ATOMIC_RELAXED, __HIP_MEMORY_SCOPE_AGENT); }
__device__ __forceinline__ unsigned xb_add(unsigned* p, unsigned v) { return __hip_atomic_fetch_add(p, v, __ATOMIC_RELAXED, __HIP_MEMORY_SCOPE_AGENT); }
__device__ __forceinline__ unsigned xb_xcc_id() { return (unsigned)__builtin_amdgcn_s_getreg((3 << 11) | 20) & 0xFu; }
#define XB_SPIN(cond, bar) do { unsigned _sp = 0; while (cond) { __builtin_amdgcn_s_sleep(1); \
    if ((++_sp & 255u) == 0u) { if (xb_ld(&(bar)[XB_TMO])) break; if (_sp > XB_SPIN_CAP) { atomicAdd(&(bar)[XB_TMO], 1u); break; } } } } while (0)
struct XcdBarrier { unsigned* bar; unsigned x; volatile LAS unsigned* st; };
__device__ __forceinline__ XcdBarrier xcd_barrier_post(unsigned* bar, volatile LAS unsigned* st) {
    XcdBarrier b; b.bar = bar; b.x = xb_xcc_id(); b.st = st;
    if (threadIdx.x == 0) (void)xb_add(&bar[XB_XCNT(b.x)], 1u);
    return b;
}
__device__ __forceinline__ void xcd_barrier_complete(unsigned* bar, unsigned x, unsigned& nloc, unsigned& nx) {
    const unsigned G = gridDim.x * gridDim.y * gridDim.z;
    unsigned sum, cnt, mine, sp = 0u;
    for (;;) {
        sum = 0u; cnt = 0u; mine = 0u;
#pragma unroll
        for (unsigned j = 0; j < 16; ++j) { const unsigned c = xb_ld(&bar[XB_XCNT(j)]); sum += c; cnt += (c > 0u) ? 1u : 0u; mine = (j == x) ? c : mine; }
        if (sum == G) break;
        __builtin_amdgcn_s_sleep(1);
        if ((++sp & 255u) == 0u) { if (xb_ld(&bar[XB_TMO])) break; if (sp > XB_SPIN_CAP) { atomicAdd(&bar[XB_TMO], 1u); break; } }
    }
    nloc = mine > 0u ? mine : 1u; nx = cnt > 0u ? cnt : 1u;
}
__device__ __forceinline__ void xcd_barrier(const XcdBarrier& b) {
    asm volatile("s_waitcnt vmcnt(0)" ::: "memory");
    __syncthreads();
    if (threadIdx.x == 0) {
        unsigned* bar = b.bar; asm volatile("" : "+s"(bar));
        __builtin_amdgcn_s_waitcnt(0);
        unsigned nloc = b.st[0], nx = b.st[1];
        if (nloc == 0u) { xcd_barrier_complete(bar, b.x, nloc, nx); b.st[0] = nloc; b.st[1] = nx; }
        const unsigned old = xb_add(&bar[XB_XSUB(b.x)], 1u);
        const unsigned gen = old / nloc;
        if (old + 1u == (gen + 1u) * nloc) {
            __builtin_amdgcn_fence(__ATOMIC_RELEASE, "agent");
            asm volatile("s_waitcnt vmcnt(0)" ::: "memory");
            const unsigned og = xb_add(&bar[XB_TOP], 1u);
            const unsigned tg = og / nx;
            if (og + 1u == (tg + 1u) * nx) xb_add(&bar[XB_TOPGEN], 1u);
            else XB_SPIN(xb_ld(&bar[XB_TOPGEN]) == tg, bar);
            __builtin_amdgcn_fence(__ATOMIC_ACQUIRE, "agent");
            xb_add(&bar[XB_XGEN(b.x)], 1u);
            asm volatile("s_waitcnt vmcnt(0)" ::: "memory");
        } else {
            XB_SPIN(xb_ld(&bar[XB_XGEN(b.x)]) == gen, bar);
            __builtin_amdgcn_fence(__ATOMIC_ACQUIRE, "agent");
            asm volatile("s_waitcnt vmcnt(0)" ::: "memory");
        }
    }
    __syncthreads();
}

struct Args { const float* in[N_INPUTS]; float* out; unsigned char* ws; int ph_lo, ph_hi; };
struct Frame {
    LAS unsigned char* lds;
    int tid, lane, wave, G, bid;
};
constexpr int LDS_ARGT = 131072 + 1024;
__device__ __forceinline__ const float* INP(const Frame& F, int k) {
    const LAS unsigned* t = (const LAS unsigned*)(F.lds + LDS_ARGT) + 2 * k;
    const unsigned lo = __builtin_amdgcn_readfirstlane(t[0]), hi = __builtin_amdgcn_readfirstlane(t[1]);
    return (const float*)(((unsigned long long)hi << 32) | lo);
}
__device__ __forceinline__ float* OUTP(const Frame& F) { return (float*)INP(F, 46); }
__device__ __forceinline__ unsigned char* WSP(const Frame& F) { return (unsigned char*)INP(F, 47); }

namespace pg8 {
constexpr int BM = 256, BK = 64, HALF = 128, HTB = HALF * BK * 2, STAGE_BYTES = 8 * HTB, NXCD = 8, WGM = 8;
__host__ __device__ __forceinline__ int lds_byte(int r, int c) { const int st = (r >> 4) * 2 + (c >> 5), rr = r & 15, cc = c & 31, ob = rr * 64 + cc * 2; return st * 1024 + (ob ^ (((ob >> 9) & 1) << 5)); }
__host__ __device__ __forceinline__ void stage_rc(int b, int& R, int& C) { const int st = b / 1024, sb = b % 1024, swz = sb ^ (((sb >> 9) & 1) << 5); R = (st >> 1) * 16 + swz / 64; C = (st & 1) * 32 + (swz % 64) / 2; }
__host__ __device__ __forceinline__ int perm32(int rho) { const int n = rho >> 4, i = rho & 15; return 8 * (i >> 2) + 4 * n + (i & 3); }

struct Unit { int pm, pn, br; };
struct Gemm { const bf16* A; const bf16* Bt; int lda, ldb, K; int a_br_stride  , a_br4_off  , b_br_tiles  ; };

struct Order {
    int nM, nN, nwg, G, c, nbr;
    __device__ void init(int Mrows, int N, int G_, int c_, int nbr_) { nM = Mrows / BM; nN = N / BM; nwg = nM * nN; G = G_; c = c_; nbr = nbr_; }
    __device__ bool next(int i, Unit& u) const {
        const int it = i / nbr; u.br = i - it * nbr;
        const long L = (long)it * G + c; if (L >= nwg) return false;
        int wgid = (int)L; { const int q = nwg / NXCD, r = nwg % NXCD, xcd = wgid % NXCD, off = wgid / NXCD; wgid = (xcd < r ? xcd * (q + 1) : r * (q + 1) + (xcd - r) * q) + off; }
        const int nig = WGM * nN, gid = wgid / nig, fm = gid * WGM, gsz = (nM - fm) < WGM ? (nM - fm) : WGM;
        u.pm = fm + ((wgid % nig) % gsz); u.pn = (wgid % nig) / gsz; return true;
    }
};
struct Order5 {
    Order o;
    __device__ void init(int Mrows, int G_, int c_) { o.init(Mrows, 20 * BM, G_, c_, 1); }
    __device__ bool next(int i, Unit& u) const { if (!o.next(i, u)) return false; u.br = u.pn >> 2; u.pn &= 3; return true; }
};

template <class Epi, class Sched>
__device__ __forceinline__ void gemm_phase(LAS unsigned char* lds, const Gemm g, const Sched& S, const Epi& E) {
    int tid = threadIdx.x; asm volatile("" : "+v"(tid));
    const int wid = __builtin_amdgcn_readfirstlane(tid >> 6), lane = tid & 63, wr = wid >> 2, wc = wid & 3, fr = lane & 15, fq = lane >> 4;
    const int K = g.K, nt = K / BK;
    unsigned voffA[2], voffB[2];
#pragma unroll
    for (int i = 0; i < 2; ++i) { int R, C; stage_rc(tid * 16 + i * 8192, R, C); const int Rb = Epi::PERM ? ((R & ~31) + perm32(R & 31)) : R;
        voffA[i] = (unsigned)(R * g.lda + C) * 2u; voffB[i] = (unsigned)(Rb * g.ldb + C) * 2u; }
    const size_t kstep = (size_t)(BK * 2);
    const size_t hstepA = (size_t)HALF * g.lda * 2, hstepB = (size_t)HALF * g.ldb * 2;
    const unsigned ldsw = (unsigned)wid * 1024u;
    const int aoff = lds_byte(wr * 64 + fr, fq * 8), boff = lds_byte(wc * 32 + fr, fq * 8);
#define PG8_APTR(u) ((const char*)g.A + ((size_t)(u).pm * 256 * g.lda + (size_t)(u).br * g.a_br_stride + ((u).br == 4 ? g.a_br4_off : 0)) * 2)
#define PG8_BPTR(u) ((const char*)g.Bt + ((size_t)((u).br * g.b_br_tiles + (u).pn) * 256 * g.ldb) * 2)
#define PG8_SA(b, h) (((b) * 2 + (h)) * HTB)
#define PG8_SB(b, h) ((4 + (b) * 2 + (h)) * HTB)
#define PG8_STAGE(bufoff, gbase, voff) do { _Pragma("unroll") for (int _i = 0; _i < 2; ++_i) \
        __builtin_amdgcn_global_load_lds((const unsigned*)((const char*)(gbase) + (voff)[_i]), (LAS unsigned*)(lds + (bufoff) + ldsw + _i * 8192), 16, 0, 0); } while (0)
#define PG8_LDA(dst, b, h) do { _Pragma("unroll") for (int m = 0; m < 4; ++m) _Pragma("unroll") for (int k = 0; k < 2; ++k) dst[m][k] = *(const LAS bf16x8*)(lds + PG8_SA(b, h) + aoff + m * 2048 + k * 1024); } while (0)
#define PG8_LDB(dst, b, h) do { _Pragma("unroll") for (int n = 0; n < 2; ++n) _Pragma("unroll") for (int k = 0; k < 2; ++k) dst[n][k] = *(const LAS bf16x8*)(lds + PG8_SB(b, h) + boff + n * 2048 + k * 1024); } while (0)
#define PG8_MMA(ai, bj, At, Bt) do { __builtin_amdgcn_s_setprio(1); _Pragma("unroll") for (int m = 0; m < 4; ++m) _Pragma("unroll") for (int n = 0; n < 2; ++n) _Pragma("unroll") for (int k = 0; k < 2; ++k) \
        acc[ai][bj][m][n] = __builtin_amdgcn_mfma_f32_16x16x32_bf16(Bt[n][k], At[m][k], acc[ai][bj][m][n], 0, 0, 0); __builtin_amdgcn_s_setprio(0); } while (0)
#define PG8_WAIT_V(n) asm volatile("s_waitcnt vmcnt(" #n ")" ::: "memory")
#define PG8_WAIT_L(n) asm volatile("s_waitcnt lgkmcnt(" #n ")" ::: "memory")
#define PG8_BAR __builtin_amdgcn_s_barrier()
#define PG8_SCHED __builtin_amdgcn_sched_barrier(0)
    Unit cur, nxt; int ui = 0;
    if (!S.next(0, cur)) return;
    f32x4 acc[2][2][4][2];
#pragma unroll
    for (int a = 0; a < 2; ++a)
#pragma unroll
        for (int b = 0; b < 2; ++b)
#pragma unroll
            for (int m = 0; m < 4; ++m)
#pragma unroll
                for (int n = 0; n < 2; ++n) acc[a][b][m][n] = (f32x4){0.f, 0.f, 0.f, 0.f};
    bf16x8 At[4][2], B0[2][2], B1[2][2];
    const char* cA = PG8_APTR(cur); const char* cB = PG8_BPTR(cur);
    PG8_STAGE(PG8_SB(0, 0), cB, voffB); PG8_STAGE(PG8_SB(0, 1), cB + hstepB, voffB); PG8_STAGE(PG8_SA(0, 0), cA, voffA); PG8_STAGE(PG8_SA(0, 1), cA + hstepA, voffA);
    if (wr == 1) PG8_BAR;
    PG8_WAIT_V(2); PG8_BAR;
    PG8_STAGE(PG8_SB(1, 0), cB + kstep, voffB); PG8_STAGE(PG8_SA(1, 0), cA + kstep, voffA); PG8_STAGE(PG8_SB(1, 1), cB + hstepB + kstep, voffB);
    PG8_WAIT_V(6); PG8_BAR;
    for (;;) {
        const bool has_next = S.next(ui + 1, nxt);
        const char* nA = has_next ? PG8_APTR(nxt) : cA; const char* nB = has_next ? PG8_BPTR(nxt) : cB;
#pragma unroll 1
        for (int t = 0; t < nt; t += 2) {
            const bool last = (t == nt - 2);
            const char* a1 = cA + (size_t)(t + 1) * kstep;
            const char* a2 = last ? nA : cA + (size_t)(t + 2) * kstep; const char* b2 = last ? nB : cB + (size_t)(t + 2) * kstep;
            const char* a3 = a2 + kstep; const char* b3 = b2 + kstep;
            PG8_LDB(B0, 0, 0); PG8_LDB(B1, 0, 1); PG8_SCHED; PG8_LDA(At, 0, 0); PG8_STAGE(PG8_SA(1, 1), a1 + hstepA, voffA);
            PG8_WAIT_V(8); PG8_WAIT_L(0); PG8_BAR; PG8_MMA(0, 0, At, B0); PG8_MMA(0, 1, At, B1); PG8_BAR; PG8_SCHED;
            PG8_LDA(At, 0, 1); PG8_STAGE(PG8_SB(0, 0), b2, voffB); PG8_STAGE(PG8_SB(0, 1), b2 + hstepB, voffB); PG8_STAGE(PG8_SA(0, 0), a2, voffA);
            PG8_WAIT_V(8); PG8_WAIT_L(0); PG8_BAR; PG8_MMA(1, 0, At, B0); PG8_MMA(1, 1, At, B1); PG8_BAR; PG8_SCHED;
            PG8_LDB(B0, 1, 0); PG8_LDB(B1, 1, 1); PG8_SCHED; PG8_LDA(At, 1, 0); PG8_STAGE(PG8_SA(0, 1), a2 + hstepA, voffA);
            PG8_WAIT_V(8); PG8_WAIT_L(0); PG8_BAR; PG8_MMA(0, 0, At, B0); PG8_MMA(0, 1, At, B1); PG8_BAR; PG8_SCHED;
            PG8_LDA(At, 1, 1); PG8_STAGE(PG8_SB(1, 0), b3, voffB); PG8_STAGE(PG8_SB(1, 1), b3 + hstepB, voffB); PG8_STAGE(PG8_SA(1, 0), a3, voffA);
            PG8_WAIT_V(8); PG8_WAIT_L(0); PG8_BAR; PG8_MMA(1, 0, At, B0); PG8_MMA(1, 1, At, B1); PG8_BAR; PG8_SCHED;
        }
        if (wr == 0) PG8_BAR;
        E(acc, cur, wr, wc, fr, fq);
        if (!has_next) break;
#pragma unroll
        for (int a = 0; a < 2; ++a)
#pragma unroll
            for (int b = 0; b < 2; ++b)
#pragma unroll
                for (int m = 0; m < 4; ++m)
#pragma unroll
                    for (int n = 0; n < 2; ++n) acc[a][b][m][n] = (f32x4){0.f, 0.f, 0.f, 0.f};
        cur = nxt; cA = nA; cB = nB; ++ui;
        if (wr == 1) PG8_BAR;
    }
    PG8_WAIT_V(0);
    PG8_BAR;
#undef PG8_APTR
#undef PG8_BPTR
#undef PG8_SA
#undef PG8_SB
#undef PG8_STAGE
#undef PG8_LDA
#undef PG8_LDB
#undef PG8_MMA
#undef PG8_WAIT_V
#undef PG8_WAIT_L
#undef PG8_BAR
#undef PG8_SCHED
}

__device__ __forceinline__ float mrow_sel(int row) { return 0.f; }
__device__ __forceinline__ int modrow(int row) { return row < NPR ? 0 : 1 + ((row - NPR) >> 11); }

struct EpiProj {
    static constexpr bool PERM = true;
    bf16* proj; float* outk; float* outv; int layer;
    __device__ __forceinline__ void operator()(const f32x4 (&acc)[2][2][4][2], const Unit& u, int wr, int wc, int fr, int fq) const {
        { int t_ = threadIdx.x; asm volatile("" : "+v"(t_)); fr = t_ & 15; fq = (t_ >> 4) & 3; }
        const int row0 = u.pm * BM + wr * 64 + fr, colb = u.pn * BM + wc * 32 + 8 * fq;
        const int mode = (u.pn == 60) ? 1 : (u.pn == 61 ? 2 : 0);
        const bool kv = (u.pm < 32) && (u.pn >= 4) && (u.pn < 12);
#pragma unroll
        for (int ai = 0; ai < 2; ++ai)
#pragma unroll
            for (int m = 0; m < 4; ++m) {
                const int row = row0 + ai * HALF + m * 16;
                bf16* rowp = proj + (size_t)row * NPROJ + colb;
#pragma unroll
                for (int bj = 0; bj < 2; ++bj) {
                    f32x4 v0 = acc[ai][bj][m][0], v1 = acc[ai][bj][m][1];
                    if (mode == 1) { if (colb + bj * HALF < COL_G1A) {
#pragma unroll
                        for (int j = 0; j < 4; ++j) { v0[j] = tanhf(v0[j]); v1[j] = tanhf(v1[j]); } } }
                    else if (mode == 2) { const bool act = (colb + bj * HALF) < 15744;
#pragma unroll
                        for (int j = 0; j < 4; ++j) { v0[j] = act ? sigmoidf_(v0[j]) : 0.f; v1[j] = act ? sigmoidf_(v1[j]) : 0.f; } }
                    u32x4 w; w.x = cvtpk(v0[0], v0[1]); w.y = cvtpk(v0[2], v0[3]); w.z = cvtpk(v1[0], v1[1]); w.w = cvtpk(v1[2], v1[3]);
                    *(u32x4*)(rowp + bj * HALF) = w;
                    if (kv) { const int col = colb + bj * HALF; float* ob = (u.pn < 8) ? outk : outv; const int ch = col - ((u.pn < 8) ? COL_K : COL_V);
                        float* dst = ob + ((size_t)(((row >> 8) * 4 + layer) * 256 + (row & 255))) * 1024 + ch;
                        *(f32x4*)dst = v0; *(f32x4*)(dst + 4) = v1; }
                }
            }
    }
};
struct EpiLora2 {
    static constexpr bool PERM = true;
    float* dec; bf16* abuf; bf16* gbuf; const float* w0; const float* a0;
    __device__ __forceinline__ void operator()(const f32x4 (&acc)[2][2][4][2], const Unit& u, int wr, int wc, int fr, int fq) const {
        { int t_ = threadIdx.x; asm volatile("" : "+v"(t_)); fr = t_ & 15; fq = (t_ >> 4) & 3; }
        const int row0 = u.pm * BM + wr * 64 + fr, colb = u.pn * BM + wc * 32 + 8 * fq;
        const int br = u.br, e = br & 1;
        const float* bsrc = (br < 2) ? w0 + e * 1024 : a0 + e * 1024;
#pragma unroll
        for (int bj = 0; bj < 2; ++bj)
#pragma unroll
            for (int n = 0; n < 2; ++n) {
                const int ch = colb + bj * HALF + 4 * n;
                f32x4 b0 = (f32x4){0.f, 0.f, 0.f, 0.f};
                if (br < 4) b0 = *(const f32x4*)(bsrc + ch);
#pragma unroll
                for (int ai = 0; ai < 2; ++ai)
#pragma unroll
                    for (int m = 0; m < 4; ++m) {
                        const int row = row0 + ai * HALF + m * 16;
                        f32x4 v0 = acc[ai][bj][m][n] + b0;
                        if (br < 2) {
#pragma unroll
                            for (int j = 0; j < 4; ++j) v0[j] = __expf(-0.6065306597126334f * sigmoidf_(v0[j]));
                            *(f32x4*)(dec + ((size_t)row * 2 + e) * 1024 + ch) = v0;
                        } else {
                            if (br < 4) {
#pragma unroll
                                for (int j = 0; j < 4; ++j) v0[j] = sigmoidf_(v0[j]); }
                            bf16* dst = (br < 4) ? abuf + ((size_t)row * 2 + e) * 1024 + ch : gbuf + (size_t)row * 1024 + ch;
                            *(u32x2*)dst = (u32x2){cvtpk(v0[0], v0[1]), cvtpk(v0[2], v0[3])};
                        }
                        __builtin_amdgcn_sched_barrier(0);
                    }
            }
    }
};
struct EpiMerge {
    static constexpr bool PERM = true;
    const bf16* proj; bf16* merged;
    __device__ __forceinline__ void operator()(const f32x4 (&acc)[2][2][4][2], const Unit& u, int wr, int wc, int fr, int fq) const {
        { int t_ = threadIdx.x; asm volatile("" : "+v"(t_)); fr = t_ & 15; fq = (t_ >> 4) & 3; }
        const int row0 = u.pm * BM + wr * 64 + fr, colb = u.pn * BM + wc * 32 + 8 * fq;
        const int br = u.br;
#pragma unroll
        for (int ai = 0; ai < 2; ++ai)
#pragma unroll
            for (int m = 0; m < 4; ++m) {
                const int row = row0 + ai * HALF + m * 16;
#pragma unroll
                for (int bj = 0; bj < 2; ++bj) {
                    const int col = colb + bj * HALF;
                    const u32x4 gw = *(const u32x4*)(proj + (size_t)row * NPROJ + COL_GL + br * 2048 + col);
                    bf16* dst = merged + (size_t)row * D + col;
                    f32x4 v0 = acc[ai][bj][m][0], v1 = acc[ai][bj][m][1];
                    v0[0] *= sigmoidf_(bflo(gw.x)); v0[1] *= sigmoidf_(bfhi(gw.x)); v0[2] *= sigmoidf_(bflo(gw.y)); v0[3] *= sigmoidf_(bfhi(gw.y));
                    v1[0] *= sigmoidf_(bflo(gw.z)); v1[1] *= sigmoidf_(bfhi(gw.z)); v1[2] *= sigmoidf_(bflo(gw.w)); v1[3] *= sigmoidf_(bfhi(gw.w));
                    if (br > 0) { const u32x4 pw = *(const u32x4*)dst;
                        v0[0] += bflo(pw.x); v0[1] += bfhi(pw.x); v0[2] += bflo(pw.y); v0[3] += bfhi(pw.y);
                        v1[0] += bflo(pw.z); v1[1] += bfhi(pw.z); v1[2] += bflo(pw.w); v1[3] += bfhi(pw.w); }
                    u32x4 w; w.x = cvtpk(v0[0], v0[1]); w.y = cvtpk(v0[2], v0[3]); w.z = cvtpk(v1[0], v1[1]); w.w = cvtpk(v1[2], v1[3]);
                    *(u32x4*)dst = w;
                }
            }
    }
};
struct EpiResid {
    static constexpr bool PERM = false;
    float* x; const float* gate;   const float* bias;
    __device__ __forceinline__ void operator()(const f32x4 (&acc)[2][2][4][2], const Unit& u, int wr, int wc, int fr, int fq) const {
        { int t_ = threadIdx.x; asm volatile("" : "+v"(t_)); fr = t_ & 15; fq = (t_ >> 4) & 3; }
        const int row0 = u.pm * BM + wr * 64 + fr, col0 = u.pn * BM + wc * 32 + 4 * fq;
        const int mr = modrow(u.pm * BM);
        const float* gp = gate + (size_t)mr * 12288;
        f32x4 gv[2][2], bv[2][2];
#pragma unroll
        for (int bj = 0; bj < 2; ++bj)
#pragma unroll
            for (int n = 0; n < 2; ++n) { gv[bj][n] = *(const f32x4*)(gp + col0 + bj * HALF + n * 16);
                bv[bj][n] = bias ? *(const f32x4*)(bias + col0 + bj * HALF + n * 16) : (f32x4){0.f, 0.f, 0.f, 0.f}; }
#pragma unroll
        for (int ai = 0; ai < 2; ++ai)
#pragma unroll
            for (int m = 0; m < 4; ++m) { float* rowp = x + (size_t)(row0 + ai * HALF + m * 16) * D + col0;
#pragma unroll
                for (int bj = 0; bj < 2; ++bj)
#pragma unroll
                    for (int n = 0; n < 2; ++n) { f32x4* p = (f32x4*)(rowp + bj * HALF + n * 16); const f32x4 xo = *p; *p = xo + gv[bj][n] * (acc[ai][bj][m][n] + bv[bj][n]); }
                asm volatile("" ::: "memory"); }
    }
};
struct EpiFF1 {
    static constexpr bool PERM = true;
    bf16* U; const float* bias;
    __device__ __forceinline__ void operator()(const f32x4 (&acc)[2][2][4][2], const Unit& u, int wr, int wc, int fr, int fq) const {
        { int t_ = threadIdx.x; asm volatile("" : "+v"(t_)); fr = t_ & 15; fq = (t_ >> 4) & 3; }
        const int row0 = u.pm * BM + wr * 64 + fr, colb = u.pn * BM + wc * 32 + 8 * fq;
        f32x4 bv[2][2];
#pragma unroll
        for (int bj = 0; bj < 2; ++bj)
#pragma unroll
            for (int n = 0; n < 2; ++n) bv[bj][n] = *(const f32x4*)(bias + colb + bj * HALF + 4 * n);
#pragma unroll
        for (int ai = 0; ai < 2; ++ai)
#pragma unroll
            for (int m = 0; m < 4; ++m) { bf16* rowp = U + (size_t)(row0 + ai * HALF + m * 16) * DFF + colb;
#pragma unroll
                for (int bj = 0; bj < 2; ++bj) { f32x4 v0 = acc[ai][bj][m][0] + bv[bj][0], v1 = acc[ai][bj][m][1] + bv[bj][1];
#pragma unroll
                    for (int j = 0; j < 4; ++j) { const float a = fmaxf(v0[j], 0.f), b = fmaxf(v1[j], 0.f); v0[j] = a * a; v1[j] = b * b; }
                    u32x4 w; w.x = cvtpk(v0[0], v0[1]); w.y = cvtpk(v0[2], v0[3]); w.z = cvtpk(v1[0], v1[1]); w.w = cvtpk(v1[2], v1[3]);
                    *(u32x4*)(rowp + bj * HALF) = w; } }
    }
};
}

__device__ __forceinline__ void transpose_item(const float* W, int K, int N, bf16* WT, int ldk, int row_off, LAS bf16* scr, int item, int lane) {
    const int nblk = N / 64, kb = item / nblk, nb = item % nblk, k0 = 64 * kb, n0 = 64 * nb;
    const float* src = W + (size_t)k0 * N + n0 + lane;
#pragma unroll 1
    for (int h = 0; h < 2; ++h) { float v[32];
#pragma unroll
        for (int i = 0; i < 32; ++i) v[i] = src[(size_t)(h * 32 + i) * N];
#pragma unroll
        for (int i = 0; i < 32; ++i) scr[(h * 32 + i) * 66 + lane] = f2bf(v[i]); }
    LDS_WAIT(); asm volatile("" ::: "memory");
    const int kc = lane & 7, ns = lane >> 3;
#pragma unroll
    for (int j = 0; j < 8; ++j) { const int n = 8 * j + ns; const LAS bf16* s = scr + (8 * kc) * 66 + n;
        u32x4 o; o.x = (unsigned)s[0] | ((unsigned)s[66] << 16); o.y = (unsigned)s[2 * 66] | ((unsigned)s[3 * 66] << 16); o.z = (unsigned)s[4 * 66] | ((unsigned)s[5 * 66] << 16); o.w = (unsigned)s[6 * 66] | ((unsigned)s[7 * 66] << 16);
        *(u32x4*)(WT + (size_t)(row_off + n0 + n) * ldk + k0 + 8 * kc) = o; }
    LDS_WAIT(); asm volatile("" ::: "memory");
}

__device__ __forceinline__ void prologue0(const Frame& F, const Args& a) {
    unsigned char* ws = WSP(F);
    LAS bf16* scr = (LAS bf16*)(F.lds + F.wave * 16384);
    const int gw = F.bid * 8 + F.wave, NGW = F.G * 8;
    for (int l = 0; l < DEPTH; ++l) {
        bf16* WinT = (bf16*)(ws + WS_WIN) + (size_t)l * NPROJ * D;
        {   const int n_items = (D / 64) * (15360 / 64); const float* W = INP(F, I_WIN) + (size_t)l * D * 15360;
            for (int it = gw; it < n_items; it += NGW) transpose_item(W, D, 15360, WinT, D, 0, scr, it, F.lane); }
        for (int e = 0; e < 2; ++e) {
            const int n_items = (D / 64);
            const float* W1 = INP(F, I_W1) + ((size_t)l * 2 + e) * D * 64; const float* A1 = INP(F, I_A1) + ((size_t)l * 2 + e) * D * 64;
            for (int it = gw; it < n_items; it += NGW) { transpose_item(W1, D, 64, WinT, D, COL_LW + e * 64, scr, it, F.lane); transpose_item(A1, D, 64, WinT, D, COL_LW + 128 + e * 64, scr, it, F.lane); }
        }
        {   const int n_items = (D / 64) * 2; const float* W = INP(F, I_G1) + (size_t)l * D * 128;
            for (int it = gw; it < n_items; it += NGW) transpose_item(W, D, 128, WinT, D, COL_LW + 256, scr, it, F.lane); }
        for (int i = gw * 64 + F.lane; i < 128 * D / 8; i += NGW * 64) ((u32x4*)(WinT + (size_t)15744 * D))[i] = (u32x4){0u, 0u, 0u, 0u};
        for (int br = 0; br < 3; ++br) { const float* W = INP(F, I_WPA + br) + (size_t)l * 1024 * D; bf16* WT = (bf16*)(ws + WS_WP) + ((size_t)l * 3 + br) * D * 1024;
            const int n_items = (1024 / 64) * (D / 64);
            for (int it = gw; it < n_items; it += NGW) transpose_item(W, 1024, D, WT, 1024, 0, scr, it, F.lane); }
        {   const float* W = INP(F, I_WOUT) + (size_t)l * D * D; bf16* WT = (bf16*)(ws + WS_WOUT) + (size_t)l * D * D; const int n_items = (D / 64) * (D / 64);
            for (int it = gw; it < n_items; it += NGW) transpose_item(W, D, D, WT, D, 0, scr, it, F.lane); }
        {   const float* W = INP(F, I_FF1) + (size_t)l * D * DFF; bf16* WT = (bf16*)(ws + WS_WFF1) + (size_t)l * D * DFF; const int n_items = (D / 64) * (DFF / 64);
            for (int it = gw; it < n_items; it += NGW) transpose_item(W, D, DFF, WT, D, 0, scr, it, F.lane); }
        {   const float* W = INP(F, I_FF2) + (size_t)l * D * DFF; bf16* WT = (bf16*)(ws + WS_WFF2) + (size_t)l * D * DFF; const int n_items = (DFF / 64) * (D / 64);
            for (int it = gw; it < n_items; it += NGW) transpose_item(W, DFF, D, WT, DFF, 0, scr, it, F.lane); }
        {   bf16* W2T = (bf16*)(ws + WS_W2T) + (size_t)l * 5120 * 256;
            const float* w2 = INP(F, I_W2) + (size_t)l * 2 * 64 * 1024; const float* a2 = INP(F, I_A2) + (size_t)l * 2 * 64 * 1024; const float* g2 = INP(F, I_G2) + (size_t)l * 128 * 1024;
            for (int it = gw; it < 16 * 6; it += NGW) { const int m = it / 16, sub = it % 16;
                const float* W = m == 0 ? w2 : (m == 1 ? w2 + 65536 : (m == 2 ? a2 : (m == 3 ? a2 + 65536 : (m == 4 ? g2 : g2 + 65536))));
                const int br = m < 4 ? m : 4, koff = m < 4 ? 64 * m : (m == 4 ? 128 : 192);
                transpose_item(W, 64, 1024, W2T + (size_t)br * 1024 * 256 + koff, 256, 0, scr, sub, F.lane); }
            for (int i = gw * 64 + F.lane; i < 5120 * 32; i += NGW * 64) { const int n = i >> 5, k8 = (i & 31) * 8, br = n >> 10;
                const bool nz = br == 4 ? (k8 >= 128) : (k8 >= 64 * br && k8 < 64 * br + 64);
                if (!nz) *(u32x4*)(W2T + (size_t)n * 256 + k8) = (u32x4){0u, 0u, 0u, 0u}; }
        }
    }
    {   const float* ck = INP(F, I_CK); const float* cv = INP(F, I_CV); bf16* ok = (bf16*)(ws + WS_CK); bf16* ov = (bf16*)(ws + WS_CV);
        const int n4 = 4 * 4 * 256 * 1024 / 4;
        for (int i = gw * 64 + F.lane; i < n4; i += NGW * 64) { const f32x4 x = ((const f32x4*)ck)[i], y = ((const f32x4*)cv)[i];
            ((u32x2*)ok)[i] = (u32x2){cvtpk(x[0], x[1]), cvtpk(x[2], x[3])}; ((u32x2*)ov)[i] = (u32x2){cvtpk(y[0], y[1]), cvtpk(y[2], y[3])}; }
    }
    {   LAS float* sv = (LAS float*)(F.lds + 65536);
        __syncthreads();
        for (int i = F.tid; i < 5 * D; i += 512) { const int r = i / D, d = i - r * D; const float x = (r == 0) ? INP(F, I_CCTX)[d] : INP(F, I_C)[(r - 1) * D + d]; sv[i] = x / (1.0f + __expf(-x)); }
        __syncthreads();
        float* PART = (float*)(ws + WS_Q);
        const int n_items = DEPTH * 48 * 8;
        for (int it = gw; it < n_items; it += NGW) {
            const int l = it / 384, rem = it % 384, jc = rem >> 3, ds = rem & 7, j4 = jc * 256 + 4 * F.lane;
            const float* W = INP(F, I_WMOD) + (size_t)l * D * 12288 + (size_t)(ds * 256) * 12288 + j4;
            f32x4 acc[5];
#pragma unroll
            for (int r = 0; r < 5; ++r) acc[r] = (f32x4){0.f, 0.f, 0.f, 0.f};
#pragma unroll 4
            for (int d = 0; d < 256; d += 4) {
                f32x4 w[4];
#pragma unroll
                for (int q = 0; q < 4; ++q) w[q] = *(const f32x4*)(W + (size_t)(d + q) * 12288);
#pragma unroll
                for (int r = 0; r < 5; ++r) { const f32x4 s = *(const LAS f32x4*)(sv + r * D + ds * 256 + d);
#pragma unroll
                    for (int q = 0; q < 4; ++q) acc[r] += w[q] * s[q]; }
            }
#pragma unroll
            for (int r = 0; r < 5; ++r) *(f32x4*)(PART + (((size_t)ds * 4 + l) * 5 + r) * 12288 + j4) = acc[r];
        }
        __syncthreads();
    }
    {   float* T2 = (float*)(ws + WS_T2);
        const int n_items = DEPTH * (L_S + L_P);
        for (int it = gw; it < n_items; it += NGW) {
            const int l = it / (L_S + L_P), rr = it % (L_S + L_P), sel = rr < L_S ? 0 : 1, t = sel ? rr - L_S : rr, L = sel ? L_P : L_S;
            float zf = 0.f;
            {   const float tt = (float)t / (float)(L - 1);
                const float w = (6.283185307179586f * (float)t) / (float)L;
                const int band = (F.lane - 1) & 15;
                const float f = 1e-4f + (float)band * ((15.0f - 1e-4f) / 15.0f);
                const float fw = f * w;
                const double rd = (double)fw - 6.283185307179586 * rint((double)fw * 0.15915494309189535);
                const float rf = (float)rd;
                zf = (F.lane == 0) ? tt : (F.lane <= 16 ? __cosf(rf) : -__sinf(rf));
            }
            const float* f1 = INP(F, I_F1) + (size_t)l * 33 * 64; const float* f2 = INP(F, I_F2) + (size_t)l * 64 * 64;
            const float fq = INP(F, I_FREQ)[l * 64 + F.lane];
            float s = INP(F, I_FB1)[l * 64 + F.lane];
            for (int i = 0; i < 33; ++i) s += __int_as_float(__builtin_amdgcn_readlane(__float_as_int(zf), i)) * f1[i * 64 + F.lane];
            float x = fq * s; { const double rd = (double)x - 6.283185307179586 * rint((double)x * 0.15915494309189535); x = (float)rd; }
            const float t1 = __sinf(x);
            float s2 = INP(F, I_FB2)[l * 64 + F.lane];
            for (int i = 0; i < 64; ++i) s2 += __int_as_float(__builtin_amdgcn_readlane(__float_as_int(t1), i)) * f2[i * 64 + F.lane];
            float y = fq * s2; { const double rd = (double)y - 6.283185307179586 * rint((double)y * 0.15915494309189535); y = (float)rd; }
            T2[(((size_t)l * 2 + sel) * L_S + t) * 64 + F.lane] = __sinf(y);
        }
    }
    {   bf16* FS = (bf16*)(ws + WS_FS); bf16* FP = (bf16*)(ws + WS_FP);
        for (int i = gw * 64 + F.lane; i < DEPTH * 1024 * 72; i += NGW * 64) { const int row = i / 72, p = i % 72; const int m = p < 32 ? p : p - 32 + 32;
            FS[(size_t)row * LPS + (p < 32 ? p : L_S + p)] = 0; FP[(size_t)row * LPP + (p < 32 ? p : L_P + p)] = 0; (void)m; }
    }
}

__device__ __forceinline__ void prologue1(const Frame& F, const Args& a) {
    unsigned char* ws = WSP(F);
    const int gw = F.bid * 8 + F.wave, NGW = F.G * 8;
    {   const float* PART = (const float*)(ws + WS_Q); float* MOD = (float*)(ws + WS_MOD);
        for (int i = (F.bid * 8 + F.wave) * 64 + F.lane; i < DEPTH * 5 * 12288 / 4; i += F.G * 8 * 64) {
            const int l = i / (5 * 3072), j4 = (i % 3072) * 4;
            f32x4 s = *(const f32x4*)(INP(F, I_BMOD) + l * 12288 + j4);
#pragma unroll
            for (int ds = 0; ds < 8; ++ds) s += ((const f32x4*)PART)[(size_t)ds * (DEPTH * 5 * 3072) + i];
            ((f32x4*)MOD)[i] = s; }
    }
    const float* T2 = (const float*)(ws + WS_T2);
    float* FNORM = (float*)(ws + WS_CTL) + CW_FNORM;
    const int items_s = DEPTH * 16 * (L_S / 64), items_p = DEPTH * 16 * (L_P / 64);
    for (int it = gw; it < items_s + items_p; it += NGW) {
        int sel, l, cg, tc;
        if (it < items_s) { sel = 0; l = it / (16 * 32); cg = (it / 32) % 16; tc = it % 32; } else { const int r = it - items_s; sel = 1; l = r / (16 * 4); cg = (r / 4) % 16; tc = r % 4; }
        const int L = sel ? L_P : L_S, c = cg * 64 + F.lane;
        const float* f3 = INP(F, I_F3) + (size_t)l * 64 * 1024 + c;
        float w3[64];
#pragma unroll
        for (int j = 0; j < 64; ++j) w3[j] = f3[(size_t)j * 1024];
        const float delta = fabsf(-3.0701134573253946f + (float)c * ((-15.350567286626973f + 3.0701134573253946f) / 1023.0f));
        bf16* dst = sel ? (bf16*)(ws + WS_FP) + ((size_t)l * 1024 + c) * LPP : (bf16*)(ws + WS_FS) + ((size_t)l * 1024 + c) * LPS;
        float asum = 0.f;
        for (int tt = 0; tt < 64; ++tt) {
            const int t = tc * 64 + tt;
            const float tv = T2[(((size_t)l * 2 + sel) * L_S + t) * 64 + F.lane];
            float s = 0.f;
#pragma unroll
            for (int j = 0; j < 64; ++j) s += __int_as_float(__builtin_amdgcn_readlane(__float_as_int(tv), j)) * w3[j];
            const float dist = fabsf((float)(t - L / 2)) / (float)L;
            const float fv = s * __expf(-dist * delta);
            asum += fabsf(fv);
            dst[32 + (L - 1 - t)] = f2bf(fv);
        }
        atomicAdd(FNORM + ((size_t)l * 2 + sel) * 1024 + c, asum);
    }
}

__device__ __forceinline__ void norm_phase(const Frame& F, const float* xp, const float* xs, float* xcopy, const float* g, const float* mod, int i_sh, int i_sc, bf16* hout) {
    const int gw = F.bid * 8 + F.wave, NGW = F.G * 8;
    for (int row = gw; row < M; row += NGW) {
        const float* xr = row < NPR ? xp + (size_t)row * D : xs + (size_t)(row - NPR) * D;
        const float* mr = mod + (size_t)pg8::modrow(row) * 12288;
        f32x4 v[8]; float ss = 0.f;
#pragma unroll
        for (int j = 0; j < 8; ++j) { v[j] = ((const f32x4*)xr)[F.lane + 64 * j]; ss += (v[j][0] * v[j][0] + v[j][1] * v[j][1]) + (v[j][2] * v[j][2] + v[j][3] * v[j][3]); }
        const float rstd = 1.0f / sqrtf(wave_sum(ss) * (1.0f / D) + 1e-6f);
        if (xcopy) {
#pragma unroll
            for (int j = 0; j < 8; ++j) ((f32x4*)(xcopy + (size_t)row * D))[F.lane + 64 * j] = v[j]; }
#pragma unroll
        for (int j = 0; j < 8; ++j) {
            const f32x4 gg = ((const f32x4*)g)[F.lane + 64 * j], sc = ((const f32x4*)(mr + i_sc * D))[F.lane + 64 * j], sh = ((const f32x4*)(mr + i_sh * D))[F.lane + 64 * j];
            const f32x4 o = v[j] * rstd * gg * (1.0f + sc) + sh;
            ((u32x2*)(hout + (size_t)row * D))[F.lane + 64 * j] = (u32x2){cvtpk(o[0], o[1]), cvtpk(o[2], o[3])};
        }
    }
}
__device__ __forceinline__ void final_norm_phase(const Frame& F, float* x, const float* g) {
    const int gw = F.bid * 8 + F.wave, NGW = F.G * 8;
    for (int row = gw; row < M; row += NGW) {
        float* xr = x + (size_t)row * D;
        f32x4 v[8]; float ss = 0.f;
#pragma unroll
        for (int j = 0; j < 8; ++j) { v[j] = ((const f32x4*)xr)[F.lane + 64 * j]; ss += (v[j][0] * v[j][0] + v[j][1] * v[j][1]) + (v[j][2] * v[j][2] + v[j][3] * v[j][3]); }
        const float rstd = 1.0f / sqrtf(wave_sum(ss) * (1.0f / D) + 1e-6f);
#pragma unroll
        for (int j = 0; j < 8; ++j) { const f32x4 gg = ((const f32x4*)g)[F.lane + 64 * j]; ((f32x4*)xr)[F.lane + 64 * j] = v[j] * rstd * gg; }
    }
}

__device__ __forceinline__ s16x4 vtr(const LAS unsigned char* p) { return __builtin_bit_cast(s16x4, __builtin_amdgcn_ds_read_tr16_b64_v4i16((LAS s16x4*)p)); }

struct AttnState { float m, l; f32x16 o[2]; };

template <int NT, bool HASB, class KT, class VL, class BIAS>
__device__ __forceinline__ void attendN(AttnState& st, const bf16x8 (&qf)[4], const KT& ktp, size_t kstride, const LAS unsigned char* lds, const VL& vlo, const BIAS& bias, int lane) {
    const int r = lane & 31, h = lane >> 5;
    f32x16 s[NT];
#pragma unroll
    for (int kt = 0; kt < NT; ++kt) {
        const bf16* kp = ktp(kt) + (size_t)r * kstride + 8 * h;
        bf16x8 kf[4];
#pragma unroll
        for (int ks = 0; ks < 4; ++ks) kf[ks] = *(const bf16x8*)(kp + 16 * ks);
        f32x16 acc;
#pragma unroll
        for (int i = 0; i < 16; ++i) acc[i] = 0.f;
#pragma unroll
        for (int ks = 0; ks < 4; ++ks) acc = __builtin_amdgcn_mfma_f32_32x32x16_bf16(kf[ks], qf[ks], acc, 0, 0, 0);
        s[kt] = acc;
    }
    float gm = -3.0e38f;
#pragma unroll
    for (int kt = 0; kt < NT; ++kt)
#pragma unroll
        for (int i = 0; i < 16; ++i) {
            float v = s[kt][i] * 0.125f;
            if (HASB) v = bias(kt, (i & 3) + 8 * (i >> 2) + 4 * h, v);
            s[kt][i] = v; gm = fmaxf(gm, v);
        }
    gm = fmaxf(gm, xor32(gm, lane));
    const float mnew = fmaxf(st.m, gm);
    const float alpha = __expf(st.m - mnew);
    float ps = 0.f;
#pragma unroll
    for (int kt = 0; kt < NT; ++kt)
#pragma unroll
        for (int i = 0; i < 16; ++i) { const float p = __expf(s[kt][i] - mnew); s[kt][i] = p; ps += p; }
    st.l = st.l * alpha + ps; st.m = mnew;
#pragma unroll
    for (int i = 0; i < 16; ++i) { st.o[0][i] *= alpha; st.o[1][i] *= alpha; }
    const int i16 = lane & 15, tq = i16 >> 2, tp = i16 & 3, blk = (lane >> 4) & 1;
#pragma unroll
    for (int kt = 0; kt < NT; ++kt) {
        const LAS unsigned char* vb = lds + vlo(kt);
#pragma unroll
        for (int ss = 0; ss < 2; ++ss) {
            u32x4 pw; pw.x = cvtpk(s[kt][8 * ss + 0], s[kt][8 * ss + 1]); pw.y = cvtpk(s[kt][8 * ss + 2], s[kt][8 * ss + 3]); pw.z = cvtpk(s[kt][8 * ss + 4], s[kt][8 * ss + 5]); pw.w = cvtpk(s[kt][8 * ss + 6], s[kt][8 * ss + 7]);
            const bf16x8 pf = __builtin_bit_cast(bf16x8, pw);
#pragma unroll
            for (int dt = 0; dt < 2; ++dt) {
                const LAS unsigned char* p0 = vb + (16 * ss + 4 * h + tq) * 128 + (dt * 32 + 16 * blk + 4 * tp) * 2;
                const s16x4 lo = vtr(p0), hi = vtr(p0 + 8 * 128);
                const bf16x8 vf = __builtin_shufflevector(lo, hi, 0, 1, 2, 3, 4, 5, 6, 7);
                st.o[dt] = __builtin_amdgcn_mfma_f32_32x32x16_bf16(vf, pf, st.o[dt], 0, 0, 0);
            }
        }
    }
}

__device__ __forceinline__ void attn_store(const AttnState& st, bf16* orow  , int lane) {
    const int h = lane >> 5;
    const float lt = st.l + xor32(st.l, lane);
    const float inv = 1.0f / lt;
#pragma unroll
    for (int dt = 0; dt < 2; ++dt)
#pragma unroll
        for (int g = 0; g < 4; ++g) {
            const u32x2 w = (u32x2){cvtpk(st.o[dt][4 * g] * inv, st.o[dt][4 * g + 1] * inv), cvtpk(st.o[dt][4 * g + 2] * inv, st.o[dt][4 * g + 3] * inv)};
            *(u32x2*)(orow + dt * 32 + 8 * g + 4 * h) = w;
        }
}

__device__ __forceinline__ void attention_phase(const Frame& F, const Args& a, int layer) {
    unsigned char* ws = WSP(F);
    const bf16* proj = (const bf16*)(ws + WS_PROJ);
    bf16* oall = (bf16*)(ws + WS_OALL);
    const int lane = F.lane, w = F.wave, r = lane & 31, h = lane >> 5;
    LAS unsigned char* lds = F.lds;
    LAS float* rpbl = (LAS float*)(lds + 122880);
    for (int u = F.bid; u < 1024; u += F.G) {
        __syncthreads();
        if (u < 512) {
            const int b = u >> 4, hd = u & 15;
            const int tok0 = b * 256;
            for (int i = F.tid; i < 256 * 8; i += 512) { const int key = i >> 3, pc = i & 7;
                *(LAS u32x4*)(lds + key * 128 + pc * 16) = *(const u32x4*)(proj + (size_t)(tok0 + key) * NPROJ + COL_V + hd * 64 + pc * 8); }
            __syncthreads();
            bf16x8 qf[4];
            { const bf16* qp = proj + (size_t)(tok0 + 32 * w + r) * NPROJ + hd * 64 + 8 * h;
#pragma unroll
              for (int ks = 0; ks < 4; ++ks) qf[ks] = *(const bf16x8*)(qp + 16 * ks); }
            AttnState st; st.m = -3.0e38f; st.l = 0.f;
#pragma unroll
            for (int i = 0; i < 16; ++i) { st.o[0][i] = 0.f; st.o[1][i] = 0.f; }
            const bf16* kbase = proj + (size_t)tok0 * NPROJ + COL_K + hd * 64;
#pragma unroll 1
            for (int kg = 0; kg < 2; ++kg)
                attendN<4, false>(st, qf, [&](int kt) { return kbase + (size_t)((kg * 4 + kt) * 32) * NPROJ; }, (size_t)NPROJ, lds, [&](int kt) { return (kg * 4 + kt) * 4096; }, [&](int, int, float v) { return v; }, lane);
            attn_store(st, oall + (size_t)(tok0 + 32 * w + r) * 3072 + hd * 64, lane);
        } else {
            const int uu = u - 512, b = uu >> 7, hd = (uu >> 3) & 15, rg = uu & 7;
            const int tokb = NPR + b * 2048;
            int rlo = 4 * rg - 4; rlo = rlo < 0 ? 0 : (rlo > 24 ? 24 : rlo);
            int rhi0 = 4 * rg + 3 - 4; rhi0 = rhi0 < 0 ? 0 : (rhi0 > 24 ? 24 : rhi0); const int nr = rhi0 + 8 - rlo;
            for (int i = F.tid; i < nr * 64 * 8; i += 512) { const int key = i >> 3, pc = i & 7;
                *(LAS u32x4*)(lds + key * 128 + pc * 16) = *(const u32x4*)(proj + (size_t)(tokb + rlo * 64 + key) * NPROJ + COL_V + hd * 64 + pc * 8); }
            const bf16* cv = (const bf16*)(ws + WS_CV) + ((size_t)(b * 4 + layer) * 256) * 1024 + hd * 64;
            const bf16* ck = (const bf16*)(ws + WS_CK) + ((size_t)(b * 4 + layer) * 256) * 1024 + hd * 64;
            for (int i = F.tid; i < 256 * 8; i += 512) { const int key = i >> 3, pc = i & 7;
                *(LAS u32x4*)(lds + 90112 + key * 128 + pc * 16) = *(const u32x4*)(cv + (size_t)key * 1024 + pc * 8); }
            for (int i = F.tid; i < 465; i += 512) rpbl[i] = INP(F, I_RPB)[((size_t)layer * 16 + hd) * 465 + i];
            __syncthreads();
            const int qrow = 4 * rg + (w >> 1), qc = (w & 1) * 32 + r;
            int r0 = qrow - 4; r0 = r0 < 0 ? 0 : (r0 > 24 ? 24 : r0);
            int c0 = qc - 8; c0 = c0 < 0 ? 0 : (c0 > 48 ? 48 : c0);
            const int qtok = tokb + qrow * 64 + (w & 1) * 32 + r;
            bf16x8 qf[4];
            { const bf16* qp = proj + (size_t)qtok * NPROJ + hd * 64 + 8 * h;
#pragma unroll
              for (int ks = 0; ks < 4; ++ks) qf[ks] = *(const bf16x8*)(qp + 16 * ks); }
            AttnState st; st.m = -3.0e38f; st.l = 0.f;
#pragma unroll
            for (int i = 0; i < 16; ++i) { st.o[0][i] = 0.f; st.o[1][i] = 0.f; }
            const bf16* kloc = proj + (size_t)tokb * NPROJ + COL_K + hd * 64;
#pragma unroll 1
            for (int grp = 0; grp < 4; ++grp) {
                const int krb = r0 + 2 * grp;
                attendN<4, true>(st, qf, [&](int kt) { return kloc + (size_t)((krb + (kt >> 1)) * 64 + (kt & 1) * 32) * NPROJ; }, (size_t)NPROJ, lds,
                    [&](int kt) { return ((krb + (kt >> 1) - rlo) * 64 + (kt & 1) * 32) * 128; },
                    [&](int kt, int kin, float v) { const int kr = krb + (kt >> 1), kc = (kt & 1) * 32 + kin; const bool ok = (kc >= c0) && (kc < c0 + 16);
                        const int dr = kr - qrow + 7, dc = kc - qc + 15; const int idx = ok ? dr * 31 + dc : 0; return ok ? v + rpbl[idx] : -1.0e30f; }, lane);
            }
#pragma unroll 1
            for (int kg = 0; kg < 2; ++kg)
                attendN<4, false>(st, qf, [&](int kt) { return ck + (size_t)((kg * 4 + kt) * 32) * 1024; }, (size_t)1024, lds, [&](int kt) { return 90112 + (kg * 4 + kt) * 4096; }, [&](int, int, float v) { return v; }, lane);
            attn_store(st, oall + (size_t)qtok * 3072 + hd * 64, lane);
        }
    }
    __syncthreads();
}

__device__ __forceinline__ float row_sum16(float v) { v += DPPF(v, 0xB1); v += DPPF(v, 0x4E); v += DPPF(v, 0x141); v += DPPF(v, 0x140); return v; }
__device__ __forceinline__ f32x4 unpack4(u32x2 w) { return (f32x4){bflo(w.x), bfhi(w.x), bflo(w.y), bfhi(w.y)}; }
__device__ __forceinline__ u32x2 pack4(f32x4 v) { return (u32x2){cvtpk(v[0], v[1]), cvtpk(v[2], v[3])}; }
__device__ __forceinline__ void rwkv_prep_phase(const Frame& F, const Args& a, int layer) {
    unsigned char* ws = WSP(F);
    const bf16* proj = (const bf16*)(ws + WS_PROJ);
    const bf16* abuf = (const bf16*)(ws + WS_A);
    bf16* ops = (bf16*)(ws + WS_OPS);
    float* bonus = (float*)(ws + WS_BONUS);
    const float* cw = INP(F, I_CW) + (size_t)layer * 3 * 3072; const float* cb = INP(F, I_CB) + (size_t)layer * 3072;
    const int lane = F.lane;
    for (int item = F.wave * F.G + F.bid; item < 2048; item += 8 * F.G) {
        const int tok0 = (item >> 2) * 32, cg = item & 3, c4 = cg * 256 + 4 * lane, head = cg * 4 + (lane >> 4), hl = 4 * (lane & 15);
        const int t0 = tok0 < NPR ? (tok0 & 255) : ((tok0 - NPR) & 2047), L = tok0 < NPR ? L_P : L_S;
        f32x4 w[3][3], bs[3];
#pragma unroll
        for (int s = 0; s < 3; ++s) { bs[s] = *(const f32x4*)(cb + s * 1024 + c4);
#pragma unroll
            for (int tp = 0; tp < 3; ++tp) w[s][tp] = *(const f32x4*)(cw + tp * 3072 + s * 1024 + c4); }
        const f32x4 kkw = *(const f32x4*)(INP(F, I_KK) + layer * 1024 + c4), kaw = *(const f32x4*)(INP(F, I_KA) + layer * 1024 + c4), rkw = *(const f32x4*)(INP(F, I_RK) + layer * 1024 + c4);
        const bf16* pbase = proj + (size_t)tok0 * NPROJ + COL_R + c4;
#pragma unroll 1
        for (int ch = 0; ch < 4; ++ch) {
            u32x2 rows[10][3], av[8][2];
#pragma unroll
            for (int i = 0; i < 10; ++i) { const int tt = ch * 8 + i - 1, t = t0 + tt; const bool ok = (t >= 0) && (t < L);
#pragma unroll
                for (int s = 0; s < 3; ++s) rows[i][s] = ok ? *(const u32x2*)(pbase + (long)tt * NPROJ + s * 1024) : (u32x2){0u, 0u}; }
#pragma unroll
            for (int i = 0; i < 8; ++i) { const size_t tok = (size_t)(tok0 + ch * 8 + i); av[i][0] = *(const u32x2*)(abuf + (tok * 2 + 0) * 1024 + c4); av[i][1] = *(const u32x2*)(abuf + (tok * 2 + 1) * 1024 + c4); }
#pragma unroll
            for (int i = 0; i < 8; ++i) {
                const size_t tok = (size_t)(tok0 + ch * 8 + i);
                f32x4 x[3];
#pragma unroll
                for (int s = 0; s < 3; ++s) x[s] = unpack4(rows[i][s]) * w[s][0] + unpack4(rows[i + 1][s]) * w[s][1] + unpack4(rows[i + 2][s]) * w[s][2] + bs[s];
                const f32x4 rr = x[0], k0 = x[1], vv = x[2];
                f32x4 kk = k0 * kkw;
                const float ssq = row_sum16((kk[0] * kk[0] + kk[1] * kk[1]) + (kk[2] * kk[2] + kk[3] * kk[3]));
                kk = kk * (1.0f / sqrtf(ssq + 1e-12f));
                const f32x4 a0 = unpack4(av[i][0]), a1 = unpack4(av[i][1]);
                const f32x4 kd0 = k0 * (1.0f + (a0 - 1.0f) * kaw), kd1 = k0 * (1.0f + (a1 - 1.0f) * kaw);
                const f32x4 rk = rr * k0 * rkw;
                const float bsum = row_sum16((rk[0] + rk[1]) + (rk[2] + rk[3]));
                bf16* o = ops + (tok * 16 + head) * 448 + hl;
                *(u32x2*)(o) = pack4(rr); *(u32x2*)(o + 64) = pack4(vv); *(u32x2*)(o + 128) = pack4(-kk); *(u32x2*)(o + 192) = pack4(kd0); *(u32x2*)(o + 256) = pack4(kk * a0);
                *(u32x2*)(o + 320) = pack4(kd1); *(u32x2*)(o + 384) = pack4(kk * a1);
                if ((lane & 15) == 0) bonus[tok * 16 + head] = bsum;
            }
        }
    }
}

__device__ __forceinline__ float quad_x1(float v) { return __int_as_float(__builtin_amdgcn_update_dpp(0, __float_as_int(v), 0xB1, 0xf, 0xf, false)); }
__device__ __forceinline__ float quad_x2(float v) { return __int_as_float(__builtin_amdgcn_update_dpp(0, __float_as_int(v), 0x4E, 0xf, 0xf, false)); }
constexpr int SC_TC = 4;
constexpr int SEG = 256, NSEG = 8;
__device__ __forceinline__ void rwkv_scan_phase(const Frame& F, const Args& a, int layer) {
    unsigned char* ws = WSP(F);
    const bf16* ops = (const bf16*)(ws + WS_OPS);
    const float* dec = (const float*)(ws + WS_DEC);
    float* Y = (float*)(ws + WS_H);
    float* Q = (float*)(ws + WS_Q);
    const int lane = F.lane, vr = lane >> 2, kq = lane & 3;
    LAS float* wl = (LAS float*)(F.lds + F.wave * 16384);
    LAS float* yl = wl + SC_TC * 384;
    for (int item = F.wave * F.G + F.bid; item < 2944; item += 8 * F.G) {
        int chain, g, kind;
        if (item < 1024) { kind = 0; chain = item >> 3; g = item & 7; }
        else if (item < 1920) { kind = 1; const int r = item - 1024; chain = r / 7; g = r - chain * 7 + 1; }
        else { kind = 2; chain = item - 1920; g = 0; }
        const int hd = chain & 15, e = (chain >> 4) & 1, b = chain >> 5;
        const int L = kind == 2 ? L_P : L_S, tokb = kind == 2 ? b * L_P : NPR + b * L_S;
        const int s_lo = g * SEG;
        f32x2 S[4][8];
        if (kind == 0 && g == 0) { const float* s0 = INP(F, I_ST) + ((((size_t)b * 4 + layer) * 2 + e) * 16 + hd) * 4096;
#pragma unroll
            for (int i = 0; i < 4; ++i)
#pragma unroll
                for (int j4 = 0; j4 < 4; ++j4) { const f32x4 v = *(const f32x4*)(s0 + (vr + 16 * i) * 64 + 16 * kq + 4 * j4); S[i][2 * j4] = (f32x2){v[0], v[1]}; S[i][2 * j4 + 1] = (f32x2){v[2], v[3]}; }
        } else {
#pragma unroll
            for (int i = 0; i < 4; ++i)
#pragma unroll
                for (int p = 0; p < 8; ++p) { const int col = 16 * kq + 2 * p, row = vr + 16 * i; S[i][p] = (f32x2){(kind == 1 && row == col) ? 1.f : 0.f, (kind == 1 && row == col + 1) ? 1.f : 0.f}; }
        }
        const float vmask = kind == 1 ? 0.f : 1.f;
        float* yout = kind == 1 ? Q : Y; const long rowadd = kind == 1 ? (long)e * 8192 - NPR : (long)e * M;
        float pw[SC_TC]; bf16 pv[SC_TC], pn[SC_TC], pk[SC_TC], pb[SC_TC], pr[SC_TC];
#define SC_LOAD(T0) do { _Pragma("unroll") for (int s = 0; s < SC_TC; ++s) { \
            const int st_ = s_lo + (T0) + s; const int tau = e ? (L - 1 - st_) : st_; const size_t tok = (size_t)(tokb + tau); \
            const bf16* o = ops + (tok * 16 + hd) * 448 + lane; \
            pw[s] = dec[(tok * 2 + e) * 1024 + hd * 64 + lane]; pv[s] = o[64]; pn[s] = o[128]; pk[s] = o[192 + 128 * e]; pb[s] = o[256 + 128 * e]; pr[s] = o[0]; } } while (0)
        SC_LOAD(0);
        for (int t0 = 0; t0 < SEG; t0 += SC_TC) {
#pragma unroll
            for (int s = 0; s < SC_TC; ++s) {
                wl[s * 384 + 0 * 64 + lane] = pw[s]; wl[s * 384 + 1 * 64 + lane] = bf2f(pv[s]) * vmask; wl[s * 384 + 2 * 64 + lane] = bf2f(pn[s]);
                wl[s * 384 + 3 * 64 + lane] = bf2f(pk[s]); wl[s * 384 + 4 * 64 + lane] = bf2f(pb[s]); wl[s * 384 + 5 * 64 + lane] = bf2f(pr[s]);
            }
            if (t0 + SC_TC < SEG) SC_LOAD(t0 + SC_TC);
            LDS_WAIT(); asm volatile("" ::: "memory");
#pragma unroll
            for (int s = 0; s < SC_TC; ++s) {
                const LAS float* q = wl + s * 384 + 16 * kq;
                f32x2 w2[8], nk[8], kd[8], bb[8], rr[8];
#pragma unroll
                for (int j4 = 0; j4 < 4; ++j4) {
                    const f32x4 a0 = *(const LAS f32x4*)(q + 0 * 64 + 4 * j4), a2 = *(const LAS f32x4*)(q + 2 * 64 + 4 * j4), a3 = *(const LAS f32x4*)(q + 3 * 64 + 4 * j4),
                                a4 = *(const LAS f32x4*)(q + 4 * 64 + 4 * j4), a5 = *(const LAS f32x4*)(q + 5 * 64 + 4 * j4);
                    w2[2 * j4] = (f32x2){a0[0], a0[1]}; w2[2 * j4 + 1] = (f32x2){a0[2], a0[3]}; nk[2 * j4] = (f32x2){a2[0], a2[1]}; nk[2 * j4 + 1] = (f32x2){a2[2], a2[3]};
                    kd[2 * j4] = (f32x2){a3[0], a3[1]}; kd[2 * j4 + 1] = (f32x2){a3[2], a3[3]}; bb[2 * j4] = (f32x2){a4[0], a4[1]}; bb[2 * j4 + 1] = (f32x2){a4[2], a4[3]};
                    rr[2 * j4] = (f32x2){a5[0], a5[1]}; rr[2 * j4 + 1] = (f32x2){a5[2], a5[3]};
                }
#pragma unroll
                for (int i = 0; i < 4; ++i) {
                    const float vv = wl[s * 384 + 64 + vr + 16 * i];
                    f32x2 sa2 = S[i][0] * nk[0];
#pragma unroll
                    for (int p = 1; p < 8; ++p) sa2 += S[i][p] * nk[p];
                    float sa = sa2[0] + sa2[1];
                    sa += quad_x1(sa); sa += quad_x2(sa);
                    const f32x2 sav = (f32x2){sa, sa}, vvv = (f32x2){vv, vv};
                    f32x2 y2 = (f32x2){0.f, 0.f};
#pragma unroll
                    for (int p = 0; p < 8; ++p) { S[i][p] = S[i][p] * w2[p] + (sav * bb[p] + vvv * kd[p]); y2 += S[i][p] * rr[p]; }
                    float y = y2[0] + y2[1];
                    y += quad_x1(y); y += quad_x2(y);
                    if (kq == 0) yl[s * 64 + vr + 16 * i] = y;
                }
            }
            LDS_WAIT(); asm volatile("" ::: "memory");
#pragma unroll
            for (int s = 0; s < SC_TC; ++s) {
                const int st_ = s_lo + t0 + s; const int tau = e ? (L - 1 - st_) : st_;
                yout[(size_t)(rowadd + tokb + tau) * 1024 + hd * 64 + lane] = yl[s * 64 + lane];
            }
            LDS_WAIT(); asm volatile("" ::: "memory");
        }
#undef SC_LOAD
        float* so = nullptr;
        if (kind == 2) so = OUTP(F) + OUT_ST + ((((size_t)b * 4 + layer) * 2 + e) * 16 + hd) * 4096;
        else if (g < NSEG - 1) so = (float*)(ws + (kind == 0 ? WS_CEND : WS_PEND)) + ((size_t)chain * NSEG + g) * 4096;
        if (so) {
#pragma unroll
            for (int i = 0; i < 4; ++i)
#pragma unroll
                for (int j4 = 0; j4 < 4; ++j4) *(f32x4*)(so + (vr + 16 * i) * 64 + 16 * kq + 4 * j4) = (f32x4){S[i][2 * j4][0], S[i][2 * j4][1], S[i][2 * j4 + 1][0], S[i][2 * j4 + 1][1]};
        }
    }
}

__device__ __forceinline__ void rwkv_fix1_phase(const Frame& F) {
    unsigned char* ws = WSP(F);
    const float* CE = (const float*)(ws + WS_CEND); const float* PE = (const float*)(ws + WS_PEND); float* SS = (float*)(ws + WS_SS);
    const int lane = F.lane;
    for (int item = F.wave * F.G + F.bid; item < 128 * 16; item += 8 * F.G) {
        const int chain = item >> 4, r0 = (item & 15) * 4;
        float s[4];
#pragma unroll
        for (int r = 0; r < 4; ++r) { s[r] = CE[((size_t)chain * NSEG + 0) * 4096 + (r0 + r) * 64 + lane]; SS[((size_t)chain * NSEG + 1) * 4096 + (r0 + r) * 64 + lane] = s[r]; }
        for (int g = 1; g < NSEG - 1; ++g) {
            const float* P = PE + ((size_t)chain * NSEG + g) * 4096 + lane;
            float acc[4];
#pragma unroll
            for (int r = 0; r < 4; ++r) acc[r] = CE[((size_t)chain * NSEG + g) * 4096 + (r0 + r) * 64 + lane];
#pragma unroll 16
            for (int i = 0; i < 64; ++i) { const float p = P[i * 64];
#pragma unroll
                for (int r = 0; r < 4; ++r) acc[r] += __int_as_float(__builtin_amdgcn_readlane(__float_as_int(s[r]), i)) * p; }
#pragma unroll
            for (int r = 0; r < 4; ++r) { s[r] = acc[r]; SS[((size_t)chain * NSEG + g + 1) * 4096 + (r0 + r) * 64 + lane] = s[r]; }
        }
    }
}
__device__ __forceinline__ void rwkv_fix2_phase(const Frame& F) {
    unsigned char* ws = WSP(F);
    const float* SS = (const float*)(ws + WS_SS); const float* Q = (const float*)(ws + WS_Q); float* Y = (float*)(ws + WS_H);
    const int lane = F.lane;
    LAS float* ql = (LAS float*)(F.lds + F.wave * 16384);
    for (int item = F.wave * F.G + F.bid; item < 128 * 7 * 4; item += 8 * F.G) {
        const int chain = item / 28, r = item - chain * 28, g = (r >> 2) + 1, qt = r & 3;
        const int hd = chain & 15, e = (chain >> 4) & 1, b = chain >> 5;
        const int tokb = NPR + b * L_S;
        float srow[64];
        { const float* sp = SS + ((size_t)chain * NSEG + g) * 4096 + lane * 64;
#pragma unroll
          for (int j4 = 0; j4 < 16; ++j4) { const f32x4 v = *(const f32x4*)(sp + 4 * j4); srow[4 * j4] = v[0]; srow[4 * j4 + 1] = v[1]; srow[4 * j4 + 2] = v[2]; srow[4 * j4 + 3] = v[3]; } }
        for (int t0 = 0; t0 < 64; t0 += 8) {
#pragma unroll
            for (int s = 0; s < 8; ++s) { const int st_ = g * SEG + qt * 64 + t0 + s; const int tau = e ? (L_S - 1 - st_) : st_;
                ql[s * 64 + lane] = Q[((size_t)e * 8192 + (tokb - NPR) + tau) * 1024 + hd * 64 + lane]; }
            LDS_WAIT(); asm volatile("" ::: "memory");
#pragma unroll
            for (int s = 0; s < 8; ++s) {
                float acc0 = 0.f, acc1 = 0.f;
#pragma unroll
                for (int j4 = 0; j4 < 16; ++j4) { const f32x4 qv = *(const LAS f32x4*)(ql + s * 64 + 4 * j4);
                    acc0 += srow[4 * j4] * qv[0] + srow[4 * j4 + 2] * qv[2]; acc1 += srow[4 * j4 + 1] * qv[1] + srow[4 * j4 + 3] * qv[3]; }
                const int st_ = g * SEG + qt * 64 + t0 + s; const int tau = e ? (L_S - 1 - st_) : st_;
                float* yp = Y + ((size_t)e * M + tokb + tau) * 1024 + hd * 64 + lane;
                *yp += acc0 + acc1;
            }
            LDS_WAIT(); asm volatile("" ::: "memory");
        }
    }
}

__device__ __forceinline__ void rwkv_post_phase(const Frame& F, const Args& a, int layer) {
    unsigned char* ws = WSP(F);
    const float* Y = (const float*)(ws + WS_H);
    const bf16* ops = (const bf16*)(ws + WS_OPS); const bf16* gbuf = (const bf16*)(ws + WS_G); const float* bonus = (const float*)(ws + WS_BONUS);
    bf16* oall = (bf16*)(ws + WS_OALL);
    const int lane = F.lane;
    for (int item = F.wave * F.G + F.bid; item < 2048; item += 8 * F.G) {
        const int tok0 = (item >> 2) * 32, cg = item & 3, c4 = cg * 256 + 4 * lane, head = cg * 4 + (lane >> 4), hl = 4 * (lane & 15);
        const f32x4 gng = *(const f32x4*)(INP(F, I_GNG) + layer * 1024 + c4), gnb = *(const f32x4*)(INP(F, I_GNB) + layer * 1024 + c4);
#pragma unroll 1
        for (int ch = 0; ch < 4; ++ch) {
            f32x4 y0[8], y1[8]; u32x2 vw[8], gw[8]; float bn[8];
#pragma unroll
            for (int i = 0; i < 8; ++i) { const size_t tok = (size_t)(tok0 + ch * 8 + i);
                y0[i] = *(const f32x4*)(Y + tok * 1024 + c4); y1[i] = *(const f32x4*)(Y + ((size_t)M + tok) * 1024 + c4);
                vw[i] = *(const u32x2*)(ops + (tok * 16 + head) * 448 + 64 + hl); gw[i] = *(const u32x2*)(gbuf + tok * 1024 + c4); bn[i] = bonus[tok * 16 + head]; }
#pragma unroll
            for (int i = 0; i < 8; ++i) { const size_t tok = (size_t)(tok0 + ch * 8 + i);
                const f32x4 y = y0[i] + y1[i];
                const float mu = row_sum16((y[0] + y[1]) + (y[2] + y[3])) * (1.0f / 64.0f);
                const f32x4 dd = y - mu;
                const float var = row_sum16((dd[0] * dd[0] + dd[1] * dd[1]) + (dd[2] * dd[2] + dd[3] * dd[3])) * (1.0f / 64.0f);
                const f32x4 yn = dd * (1.0f / sqrtf(var + 64e-5f)) * gng + gnb;
                const f32x4 o = (yn + bn[i] * unpack4(vw[i])) * unpack4(gw[i]);
                *(u32x2*)(oall + tok * 3072 + 1024 + c4) = pack4(o);
            }
        }
    }
}

__device__ __forceinline__ void hyena_prep_phase(const Frame& F, const Args& a, int layer) {
    unsigned char* ws = WSP(F);
    const bf16* proj = (const bf16*)(ws + WS_PROJ);
    bf16* zT = (bf16*)(ws + WS_ZT);
    const float* cw = INP(F, I_HCW) + (size_t)layer * 3 * 3072; const float* cb = INP(F, I_HCB) + (size_t)layer * 3072;
    const int gw = F.bid * 8 + F.wave, NGW = F.G * 8, lane = F.lane, tsub = lane >> 4, cq = lane & 15;
    LAS bf16* tl = (LAS bf16*)(F.lds + F.wave * 16384);
    for (int it = gw; it < 256 * 16; it += NGW) {
        const int tt0 = (it >> 4) * 64, c0 = (it & 15) * 64, c4 = c0 + 4 * cq;
        const int t0 = tt0 < NPR ? (tt0 & 255) : ((tt0 - NPR) & 2047), L = tt0 < NPR ? L_P : L_S;
        f32x4 w1[3], w2[3];
#pragma unroll
        for (int tp = 0; tp < 3; ++tp) { w1[tp] = *(const f32x4*)(cw + tp * 3072 + 1024 + c4); w2[tp] = *(const f32x4*)(cw + tp * 3072 + 2048 + c4); }
        const f32x4 b1 = *(const f32x4*)(cb + 1024 + c4), b2 = *(const f32x4*)(cb + 2048 + c4);
        const bf16* px = proj + (size_t)tt0 * NPROJ + COL_X1 + c4;
#pragma unroll 1
        for (int hf = 0; hf < 2; ++hf) {
            u32x2 xr[8][3], vr[8][3];
#pragma unroll
            for (int i = 0; i < 8; ++i) { const int tt = 4 * (hf * 8 + i) + tsub;
#pragma unroll
                for (int d = 0; d < 3; ++d) { const int t = t0 + tt + d - 1; const bool ok = (t >= 0) && (t < L); const bf16* p = px + (long)(tt + d - 1) * NPROJ;
                    xr[i][d] = ok ? *(const u32x2*)p : (u32x2){0u, 0u}; vr[i][d] = ok ? *(const u32x2*)(p + 1024) : (u32x2){0u, 0u}; } }
#pragma unroll
            for (int i = 0; i < 8; ++i) { const int tt = 4 * (hf * 8 + i) + tsub;
                const f32x4 x1c = unpack4(xr[i][0]) * w1[0] + unpack4(xr[i][1]) * w1[1] + unpack4(xr[i][2]) * w1[2] + b1;
                const f32x4 vvc = unpack4(vr[i][0]) * w2[0] + unpack4(vr[i][1]) * w2[1] + unpack4(vr[i][2]) * w2[2] + b2;
                *(LAS u32x2*)(tl + tt * 68 + 4 * cq) = pack4(x1c * vvc); }
        }
        LDS_WAIT(); asm volatile("" ::: "memory");
#pragma unroll 16
        for (int cc = 0; cc < 64; ++cc) zT[(size_t)(c0 + cc) * M + tt0 + lane] = tl[lane * 68 + cc];
        LDS_WAIT(); asm volatile("" ::: "memory");
    }
}

__device__ __forceinline__ void hyena_conv_phase(const Frame& F, const Args& a, int layer) {
    unsigned char* ws = WSP(F);
    bf16* zT = (bf16*)(ws + WS_ZT);
    const float* FNORM = (const float*)(ws + WS_CTL) + CW_FNORM;
    const int lane = F.lane, w = F.wave, r = lane & 31, h = lane >> 5;
    LAS unsigned char* lds = F.lds;
    for (int u = F.bid; u < 2048; u += F.G) {
        const bool sample = u < 1024; const int c = u & 1023;
        const int L = sample ? L_S : L_P, LP = sample ? LPS : LPP, FCS = LP * 2;
        const int ZROW = (L + 448) * 2, ZOFF = 8 * FCS;
        const int NB = sample ? 4 : 32, tokb = sample ? NPR : 0;
        const bf16* fsrc = sample ? (const bf16*)(ws + WS_FS) + ((size_t)layer * 1024 + c) * LPS : (const bf16*)(ws + WS_FP) + ((size_t)layer * 1024 + c) * LPP;
        __syncthreads();
        for (int i = F.tid; i < 8 * LP; i += 512) { const int s = i / LP, m = i - s * LP; *(LAS bf16*)(lds + s * FCS + m * 2) = (m + s < LP) ? fsrc[m + s] : (bf16)0; }
        { const int rowel = L + 448;
          for (int i = F.tid; i < NB * rowel; i += 512) { const int b = i / rowel, p = i - b * rowel, t = p - 224;
              *(LAS bf16*)(lds + ZOFF + b * ZROW + p * 2) = (t >= 0 && t < L) ? zT[(size_t)c * M + tokb + b * L + t] : (bf16)0; } }
        __syncthreads();
        const int nbl = sample ? 2 : 5;
        const int I0 = sample ? 8 * w : w;
        const int b = r & (NB - 1), I = I0 + (r >> nbl);
        int dlo = (sample ? I0 - 63 : I0 - 7), dhi = (sample ? I0 + 7 : I0);
        const int dmax = L / 64;
        dlo = dlo < -dmax ? -dmax : dlo; dhi = dhi > dmax ? dmax : dhi;
        f32x16 acc;
#pragma unroll
        for (int i = 0; i < 16; ++i) acc[i] = 0.f;
        const LAS unsigned char* zb = lds + ZOFF + b * ZROW + (224 + 8 * h) * 2;
        for (int d = dlo; d <= dhi; ++d) {
#pragma unroll
            for (int ks = 0; ks < 2; ++ks) {
                const int st = (L / 2 - 1) - 32 * d - r + 16 * ks + 8 * h + 32;
                const int sft = st & 7;
                const bf16x8 af = *(const LAS bf16x8*)(lds + sft * FCS + (st - sft) * 2);
                const bf16x8 bfr = *(const LAS bf16x8*)(zb + (32 * (I - d) + 16 * ks) * 2);
                acc = __builtin_amdgcn_mfma_f32_32x32x16_bf16(af, bfr, acc, 0, 0, 0);
            }
        }
        const float inv = 1.0f / (FNORM[((size_t)layer * 2 + (sample ? 0 : 1)) * 1024 + c] + 1e-6f);
        const float dco = INP(F, I_HD)[layer * 1024 + c];
        __syncthreads();
#pragma unroll
        for (int g = 0; g < 4; ++g) {
            const int t = 32 * I + 8 * g + 4 * h;
            const LAS bf16* zp = (const LAS bf16*)(lds + ZOFF + b * ZROW + (224 + t) * 2);
            float o[4];
#pragma unroll
            for (int j = 0; j < 4; ++j) o[j] = acc[4 * g + j] * inv + bf2f(zp[j]) * dco;
            *(u32x2*)(zT + (size_t)c * M + tokb + b * L + t) = (u32x2){cvtpk(o[0], o[1]), cvtpk(o[2], o[3])};
        }
    }
    __syncthreads();
}

__device__ __forceinline__ void hyena_post_phase(const Frame& F, const Args& a, int layer) {
    unsigned char* ws = WSP(F);
    const bf16* proj = (const bf16*)(ws + WS_PROJ);
    const bf16* yT = (const bf16*)(ws + WS_ZT);
    bf16* oall = (bf16*)(ws + WS_OALL);
    const float* cw = INP(F, I_HCW) + (size_t)layer * 3 * 3072; const float* cb = INP(F, I_HCB) + (size_t)layer * 3072;
    const int gw = F.bid * 8 + F.wave, NGW = F.G * 8, lane = F.lane, tsub = lane >> 4, cq = lane & 15;
    LAS bf16* tl = (LAS bf16*)(F.lds + F.wave * 16384);
    for (int it = gw; it < 256 * 16; it += NGW) {
        const int tt0 = (it >> 4) * 64, c0 = (it & 15) * 64, c4 = c0 + 4 * cq;
        const int t0 = tt0 < NPR ? (tt0 & 255) : ((tt0 - NPR) & 2047), L = tt0 < NPR ? L_P : L_S;
#pragma unroll 1
        for (int q = 0; q < 4; ++q) { bf16 tmp[16];
#pragma unroll
            for (int j = 0; j < 16; ++j) tmp[j] = yT[(size_t)(c0 + q * 16 + j) * M + tt0 + lane];
#pragma unroll
            for (int j = 0; j < 16; ++j) tl[(q * 16 + j) * 68 + lane] = tmp[j]; }
        LDS_WAIT(); asm volatile("" ::: "memory");
        f32x4 w0[3];
#pragma unroll
        for (int tp = 0; tp < 3; ++tp) w0[tp] = *(const f32x4*)(cw + tp * 3072 + c4);
        const f32x4 b0 = *(const f32x4*)(cb + c4);
        const bf16* px = proj + (size_t)tt0 * NPROJ + COL_X0 + c4;
#pragma unroll 1
        for (int hf = 0; hf < 2; ++hf) {
            u32x2 xr[8][3];
#pragma unroll
            for (int i = 0; i < 8; ++i) { const int tt = 4 * (hf * 8 + i) + tsub;
#pragma unroll
                for (int d = 0; d < 3; ++d) { const int t = t0 + tt + d - 1; const bool ok = (t >= 0) && (t < L); xr[i][d] = ok ? *(const u32x2*)(px + (long)(tt + d - 1) * NPROJ) : (u32x2){0u, 0u}; } }
#pragma unroll
            for (int i = 0; i < 8; ++i) { const int tt = 4 * (hf * 8 + i) + tsub;
                const f32x4 x0c = unpack4(xr[i][0]) * w0[0] + unpack4(xr[i][1]) * w0[1] + unpack4(xr[i][2]) * w0[2] + b0;
                const f32x4 yv = (f32x4){bf2f(tl[(4 * cq + 0) * 68 + tt]), bf2f(tl[(4 * cq + 1) * 68 + tt]), bf2f(tl[(4 * cq + 2) * 68 + tt]), bf2f(tl[(4 * cq + 3) * 68 + tt])};
                *(u32x2*)(oall + (size_t)(tt0 + tt) * 3072 + 2048 + c4) = pack4(x0c * yv); }
        }
        LDS_WAIT(); asm volatile("" ::: "memory");
    }
}

constexpr int NPL = 13, PH_LAYER0 = 2, PH_FINAL = PH_LAYER0 + DEPTH * NPL, N_PHASES = PH_FINAL + 1;

__global__ void __launch_bounds__(512, 2) mega(Args args) {
    extern __shared__ __attribute__((aligned(16))) unsigned char lds_raw[];
    Frame F;
    F.lds = (LAS unsigned char*)lds_raw;
    F.tid = threadIdx.x; F.lane = F.tid & 63; F.wave = __builtin_amdgcn_readfirstlane(F.tid >> 6);
    F.G = gridDim.x; F.bid = blockIdx.x;
    for (int u = F.tid; u < (LDS_BYTES - LDSCTL_OFF) / 4; u += 512) ((LAS unsigned*)(F.lds + LDSCTL_OFF))[u] = 0u;
    __syncthreads();
    if (F.tid < 48) { const unsigned long long p = F.tid < 46 ? (unsigned long long)args.in[F.tid] : (F.tid == 46 ? (unsigned long long)args.out : (unsigned long long)args.ws);
        ((LAS unsigned*)(F.lds + LDS_ARGT))[2 * F.tid] = (unsigned)p; ((LAS unsigned*)(F.lds + LDS_ARGT))[2 * F.tid + 1] = (unsigned)(p >> 32); }
    __syncthreads();
    unsigned char* ws = WSP(F);
    unsigned* ctl = (unsigned*)(ws + WS_CTL);
    int lo = args.ph_lo, hi = args.ph_hi;
    const bool single = (hi - lo) > 1;
    XcdBarrier bar; bar.bar = ctl + CW_BAR; bar.x = 0; bar.st = (volatile LAS unsigned*)(F.lds + LDSCTL_OFF + 64);
    if (single) bar = xcd_barrier_post(ctl + CW_BAR, (volatile LAS unsigned*)(F.lds + LDSCTL_OFF + 64));
#ifndef MK_EN
#define MK_EN 0xFFFFFF
#endif
#define IN(k) (lo <= (k) && (k) < hi)
#define EN(b) ((MK_EN >> (b)) & 1)
#ifndef MK_DUP
#define MK_DUP -1
#endif
#define REPS(k) ((MK_DUP == (k)) ? 2 : 1)
#define FRESH() asm volatile("" : "+v"(F.tid), "+v"(F.lane), "+s"(F.bid), "+s"(F.wave), "+s"(F.G))
#define SEAM(k) do { if (IN(k) && IN((k) + 1)) xcd_barrier(bar); } while (0)

    if (EN(20) && IN(0)) { for (int rep = 0; rep < REPS(100); ++rep) { FRESH(); prologue0(F, args); if (rep + 1 < REPS(100)) xcd_barrier(bar); } SEAM(0); }
    if (EN(21) && IN(1)) { FRESH(); prologue1(F, args); SEAM(1); }

    bf16* Hb = (bf16*)(ws + WS_H); bf16* proj = (bf16*)(ws + WS_PROJ); bf16* oall = (bf16*)(ws + WS_OALL);
    float* x = OUTP(F);
#pragma unroll 1
    for (int l = 0; l < DEPTH; ++l) {
        const int pb = PH_LAYER0 + l * NPL;
        asm volatile("" : "+s"(lo), "+s"(hi));
        const float* mod = (const float*)(ws + WS_MOD) + (size_t)l * 5 * 12288;
        if (EN(0) && IN(pb + 0)) { for (int rep = 0; rep < REPS(0); ++rep) { FRESH();
            norm_phase(F, l == 0 ? INP(F, I_XP) : x, l == 0 ? INP(F, I_XS) : x + (size_t)NPR * D, l == 0 ? x : nullptr, INP(F, I_LN1) + l * D, mod, 0, 1, Hb);
            if (rep + 1 < REPS(0)) xcd_barrier(bar); }
            SEAM(pb + 0);
        }
        if (EN(1) && IN(pb + 1)) { for (int rep = 0; rep < REPS(1); ++rep) { FRESH();
            pg8::Gemm g{Hb, (const bf16*)(ws + WS_WIN) + (size_t)l * NPROJ * D, D, D, D, 0, 0, 0};
            pg8::Order S; S.init(M, NPROJ, F.G, F.bid, 1);
            pg8::EpiProj E{proj, x + OUT_CK, x + OUT_CV, l};
            pg8::gemm_phase(F.lds, g, S, E);
            if (rep + 1 < REPS(1)) xcd_barrier(bar); }
            SEAM(pb + 1);
        }
        if (EN(2) && IN(pb + 2)) { for (int rep = 0; rep < REPS(2); ++rep) { FRESH();
            pg8::Gemm g{proj + COL_LW, (const bf16*)(ws + WS_W2T) + (size_t)l * 5120 * 256, NPROJ, 256, 256, 0, 128, 4};
            pg8::Order5 S; S.init(M, F.G, F.bid);
            pg8::EpiLora2 E{(float*)(ws + WS_DEC), (bf16*)(ws + WS_A), (bf16*)(ws + WS_G), INP(F, I_W0) + l * 2048, INP(F, I_A0) + l * 2048};
            pg8::gemm_phase(F.lds, g, S, E);
            if (rep + 1 < REPS(2)) xcd_barrier(bar); }
            SEAM(pb + 2);
        }
        if (EN(3) && IN(pb + 3)) { for (int rep = 0; rep < REPS(3); ++rep) { FRESH();
            attention_phase(F, args, l); FRESH();
            hyena_prep_phase(F, args, l); FRESH();
            rwkv_prep_phase(F, args, l);
            if (rep + 1 < REPS(3)) xcd_barrier(bar); }
            SEAM(pb + 3);
        }
        if (EN(4) && IN(pb + 4)) { for (int rep = 0; rep < REPS(4); ++rep) { FRESH(); rwkv_scan_phase(F, args, l); if (rep + 1 < REPS(4)) xcd_barrier(bar); } SEAM(pb + 4); }
        if (EN(5) && IN(pb + 5)) { FRESH(); rwkv_fix1_phase(F); SEAM(pb + 5); }
        if (EN(6) && IN(pb + 6)) { for (int rep = 0; rep < REPS(6); ++rep) { FRESH(); rwkv_fix2_phase(F); FRESH(); hyena_conv_phase(F, args, l); if (rep + 1 < REPS(6)) xcd_barrier(bar); } SEAM(pb + 6); }
        if (EN(7) && IN(pb + 7)) { for (int rep = 0; rep < REPS(7); ++rep) { FRESH(); rwkv_post_phase(F, args, l); FRESH(); hyena_post_phase(F, args, l); if (rep + 1 < REPS(7)) xcd_barrier(bar); } SEAM(pb + 7); }
        if (EN(8) && IN(pb + 8)) { for (int rep = 0; rep < REPS(8); ++rep) { FRESH();
            pg8::Gemm g{oall, (const bf16*)(ws + WS_WP) + (size_t)l * 3 * D * 1024, 3072, 1024, 1024, 1024, 0, 8};
            pg8::Order S; S.init(M, D, F.G, F.bid, 3);
            pg8::EpiMerge E{proj, Hb};
            pg8::gemm_phase(F.lds, g, S, E);
            if (rep + 1 < REPS(8)) xcd_barrier(bar); }
            SEAM(pb + 8);
        }
        if (EN(9) && IN(pb + 9)) { for (int rep = 0; rep < REPS(9); ++rep) { FRESH();
            pg8::Gemm g{Hb, (const bf16*)(ws + WS_WOUT) + (size_t)l * D * D, D, D, D, 0, 0, 0};
            pg8::Order S; S.init(M, D, F.G, F.bid, 1);
            pg8::EpiResid E{x, mod + 2 * D, nullptr};
            pg8::gemm_phase(F.lds, g, S, E);
            if (rep + 1 < REPS(9)) xcd_barrier(bar); }
            SEAM(pb + 9);
        }
        if (EN(10) && IN(pb + 10)) { for (int rep = 0; rep < REPS(10); ++rep) { FRESH(); norm_phase(F, x, x + (size_t)NPR * D, nullptr, INP(F, I_LN2) + l * D, mod, 3, 4, Hb); if (rep + 1 < REPS(10)) xcd_barrier(bar); } SEAM(pb + 10); }
        if (EN(11) && IN(pb + 11)) { for (int rep = 0; rep < REPS(11); ++rep) { FRESH();
            pg8::Gemm g{Hb, (const bf16*)(ws + WS_WFF1) + (size_t)l * D * DFF, D, D, D, 0, 0, 0};
            pg8::Order S; S.init(M, DFF, F.G, F.bid, 1);
            pg8::EpiFF1 E{proj, INP(F, I_BFF1) + l * DFF};
            pg8::gemm_phase(F.lds, g, S, E);
            if (rep + 1 < REPS(11)) xcd_barrier(bar); }
            SEAM(pb + 11);
        }
        if (EN(12) && IN(pb + 12)) { for (int rep = 0; rep < REPS(12); ++rep) { FRESH();
            pg8::Gemm g{proj, (const bf16*)(ws + WS_WFF2) + (size_t)l * D * DFF, DFF, DFF, DFF, 0, 0, 0};
            pg8::Order S; S.init(M, D, F.G, F.bid, 1);
            pg8::EpiResid E{x, mod + 5 * D, INP(F, I_BFF2) + l * D};
            pg8::gemm_phase(F.lds, g, S, E);
            if (rep + 1 < REPS(12)) xcd_barrier(bar); }
            SEAM(pb + 12);
        }
    }
    asm volatile("" : "+s"(lo), "+s"(hi));
    if (EN(22) && IN(PH_FINAL)) { FRESH(); final_norm_phase(F, OUTP(F), INP(F, I_FING)); }
#undef IN
#undef SEAM
}

extern "C" void kernel_launch(void* const* d_in, const int* in_sizes, int n_in, void* d_out, int out_size, void* d_ws, size_t ws_size, hipStream_t stream) {
    static int grid = 0;
    if (grid == 0) {
        if (n_in != N_INPUTS || (size_t)out_size != OUT_TOTAL || ws_size < WS_END) { fprintf(stderr, "kernel_launch: unexpected shapes: n_in %d out %d ws %zu\n", n_in, out_size, ws_size); grid = -1; return; }
        int dev = 0, cus = 0, per_cu = 0;
        if (hipGetDevice(&dev) != hipSuccess || hipDeviceGetAttribute(&cus, hipDeviceAttributeMultiprocessorCount, dev) != hipSuccess) { grid = -1; return; }
        if (hipFuncSetAttribute((const void*)mega, hipFuncAttributeMaxDynamicSharedMemorySize, LDS_BYTES) != hipSuccess) { fprintf(stderr, "kernel_launch: hipFuncSetAttribute failed\n"); grid = -1; return; }
        if (hipOccupancyMaxActiveBlocksPerMultiprocessor(&per_cu, (const void*)mega, 512, LDS_BYTES) != hipSuccess || per_cu < 1) { fprintf(stderr, "kernel_launch: occupancy query says %d\n", per_cu); }
        (void)hipGetLastError();
        grid = cus;
    }
    if (grid < 0) return;
    (void)hipMemsetAsync((char*)d_ws + WS_CTL, 0, CTL_ZERO_BYTES, stream);
    Args a{};
    for (int i = 0; i < N_INPUTS; ++i) a.in[i] = (const float*)d_in[i];
    a.out = (float*)d_out; a.ws = (unsigned char*)d_ws;
#if MK_MULTI
    for (int ph = 0; ph < N_PHASES; ++ph) { a.ph_lo = ph; a.ph_hi = ph + 1; hipLaunchKernelGGL(mega, dim3(grid), dim3(512), LDS_BYTES, stream, a); }
#else
    a.ph_lo = 0; a.ph_hi = N_PHASES;
    hipLaunchKernelGGL(mega, dim3(grid), dim3(512), LDS_BYTES, stream, a);
#endif
    const hipError_t le = hipPeekAtLastError();
    if (le != hipSuccess) fprintf(stderr, "kernel_launch: launch failed: %s\n", hipGetErrorName(le));
}
```

```cpp
#include <hip/hip_runtime.h>
#include <cstdio>
#include <cstdint>

#ifndef MK_MULTI
#define MK_MULTI 0
#endif

#define GAS __attribute__((address_space(1)))
#define LAS __attribute__((address_space(3)))
typedef unsigned short bf16;
typedef short bf16x8 __attribute__((ext_vector_type(8)));
typedef short s16x4 __attribute__((ext_vector_type(4)));
typedef float f32x4 __attribute__((ext_vector_type(4)));
typedef float f32x2 __attribute__((ext_vector_type(2)));
typedef float f32x16 __attribute__((ext_vector_type(16)));
typedef unsigned u32x4 __attribute__((ext_vector_type(4)));
typedef unsigned u32x2 __attribute__((ext_vector_type(2)));
typedef __bf16 bf16x2_t __attribute__((ext_vector_type(2)));

constexpr int D = 2048, DEPTH = 4, NPR = 8192  , M = 16384, DFF = 8192;
constexpr int NPROJ = 15872;
constexpr int COL_K = 1024, COL_V = 2048, COL_R = 3072, COL_X0 = 6144, COL_X1 = 7168, COL_VV = 8192, COL_GL = 9216, COL_LW = 15360, COL_G1A = 15488;
constexpr int L_P = 256, L_S = 2048;

enum { I_XP = 0, I_XS, I_CK, I_CV, I_ST, I_C, I_CCTX, I_LN1, I_LN2, I_WMOD, I_BMOD, I_WIN, I_RPB, I_CW, I_CB, I_W0, I_W1, I_W2, I_A0, I_A1, I_A2, I_G1, I_G2,
       I_KK, I_KA, I_RK, I_GNG, I_GNB, I_HCW, I_HCB, I_F1, I_FB1, I_F2, I_FB2, I_FREQ, I_F3, I_HD, I_WPA, I_WPR, I_WPC, I_WOUT, I_FF1, I_BFF1, I_FF2, I_BFF2, I_FING, N_INPUTS };

constexpr size_t OUT_X = 0, OUT_CK = 33554432, OUT_CV = 67108864, OUT_ST = 100663296, OUT_TOTAL = 117440512;

constexpr size_t MiB = 1u << 20;
constexpr size_t WS_CTL = 0, CTL_ZERO_BYTES = 1 * MiB;
constexpr size_t WS_WIN = 2 * MiB;
constexpr size_t WS_W2T = 250 * MiB;
constexpr size_t WS_WP = 260 * MiB;
constexpr size_t WS_WOUT = 308 * MiB;
constexpr size_t WS_WFF1 = 340 * MiB;
constexpr size_t WS_WFF2 = 468 * MiB;
constexpr size_t WS_H = 596 * MiB;
constexpr size_t WS_A = 660 * MiB;
constexpr size_t WS_PROJ = 724 * MiB;
constexpr size_t WS_OALL = 1220 * MiB;
constexpr size_t WS_DEC = 1316 * MiB;
constexpr size_t WS_G = 1444 * MiB;
constexpr size_t WS_OPS = 1476 * MiB;
constexpr size_t WS_CK = 1700 * MiB;
constexpr size_t WS_CV = 1708 * MiB;
constexpr size_t WS_FS = 1716 * MiB;
constexpr size_t WS_FP = 1733 * MiB;
constexpr size_t WS_ZT = 1736 * MiB;
constexpr size_t WS_MOD = 1768 * MiB;
constexpr size_t WS_T2 = 1769 * MiB;
constexpr size_t WS_BONUS = 1773 * MiB;
constexpr size_t WS_Q = 1774 * MiB;
constexpr size_t WS_CEND = 1838 * MiB;
constexpr size_t WS_PEND = 1854 * MiB;
constexpr size_t WS_SS = 1870 * MiB;
constexpr size_t WS_END = 1886 * MiB;
constexpr int LPS = 2120, LPP = 328;

constexpr int CW_BAR = 4096;
constexpr int CW_FNORM = 32768;

constexpr int LDS_SCRATCH = 131072, LDSCTL_OFF = 131072, LDS_BYTES = 147456;

#define LDS_WAIT() asm volatile("s_waitcnt lgkmcnt(0)" ::: "memory")
#define VM_WAIT() asm volatile("s_waitcnt vmcnt(0)" ::: "memory")
__device__ __forceinline__ unsigned cvtpk(float lo, float hi) { f32x2 v = {lo, hi}; bf16x2_t b = __builtin_convertvector(v, bf16x2_t); return __builtin_bit_cast(unsigned, b); }
__device__ __forceinline__ bf16 f2bf(float f) { return (bf16)(cvtpk(f, 0.f) & 0xffffu); }
__device__ __forceinline__ float bf2f(bf16 b) { return __uint_as_float(((unsigned)b) << 16); }
__device__ __forceinline__ float bflo(unsigned w) { return __uint_as_float(w << 16); }
__device__ __forceinline__ float bfhi(unsigned w) { return __uint_as_float(w & 0xffff0000u); }
#define DPPF(v, ctrl) __int_as_float(__builtin_amdgcn_update_dpp(0, __float_as_int(v), (ctrl), 0xf, 0xf, false))
__device__ __forceinline__ float wave_sum(float v) {
    v += DPPF(v, 0xB1); v += DPPF(v, 0x4E); v += DPPF(v, 0x141); v += DPPF(v, 0x140);
    const float a = __int_as_float(__builtin_amdgcn_readlane(__float_as_int(v), 0)), b = __int_as_float(__builtin_amdgcn_readlane(__float_as_int(v), 16)),
                c = __int_as_float(__builtin_amdgcn_readlane(__float_as_int(v), 32)), d = __int_as_float(__builtin_amdgcn_readlane(__float_as_int(v), 48));
    return (a + b) + (c + d);
}
__device__ __forceinline__ float xor32(float v, int lane) { return __int_as_float(__builtin_amdgcn_ds_bpermute((lane ^ 32) << 2, __float_as_int(v))); }
__device__ __forceinline__ float sigmoidf_(float x) { return 1.0f / (1.0f + __expf(-x)); }

#define XB_TMO      128
#define XB_XCNT(j)  (256  + 64 * (j))
#define XB_XSUB(j)  (1280 + 64 * (j))
#define XB_XGEN(j)  (2304 + 64 * (j))
#define XB_TOP      3328
#define XB_TOPGEN   3392
#define XCD_BAR_WORDS 3456
#define XB_SPIN_CAP (1u << 20)
__device__ __forceinline__ unsigned xb_ld(unsigned* p)              { return __hip_atomic_load(p, __ATOMIC_RELAXED, __HIP_MEMORY_SCOPE_AGENT); }
__device__ __forceinline__ unsigned xb_add(unsigned* p, unsigned v) { return __hip_atomic_fetch_add(p, v, __ATOMIC_RELAXED, __HIP_MEMORY_SCOPE_AGENT); }
__device__ __forceinline__ unsigned xb_xcc_id() { return (unsigned)__builtin_amdgcn_s_getreg((3 << 11) | 20) & 0xFu; }
#define XB_SPIN(cond, bar) do { unsigned _sp = 0; while (cond) { __builtin_amdgcn_s_sleep(1); \
    if ((++_sp & 255u) == 0u) { if (xb_ld(&(bar)[XB_TMO])) break; if (_sp > XB_SPIN_CAP) { atomicAdd(&(bar)[XB_TMO], 1u); break; } } } } while (0)
struct XcdBarrier { unsigned* bar; unsigned x; volatile LAS unsigned* st; };
__device__ __forceinline__ XcdBarrier xcd_barrier_post(unsigned* bar, volatile LAS unsigned* st) {
    XcdBarrier b; b.bar = bar; b.x = xb_xcc_id(); b.st = st;
    if (threadIdx.x == 0) (void)xb_add(&bar[XB_XCNT(b.x)], 1u);
    return b;
}
__device__ __forceinline__ void xcd_barrier_complete(unsigned* bar, unsigned x, unsigned& nloc, unsigned& nx) {
    const unsigned G = gridDim.x * gridDim.y * gridDim.z;
    unsigned sum, cnt, mine, sp = 0u;
    for (;;) {
        sum = 0u; cnt = 0u; mine = 0u;
#pragma unroll
        for (unsigned j = 0; j < 16; ++j) { const unsigned c = xb_ld(&bar[XB_XCNT(j)]); sum += c; cnt += (c > 0u) ? 1u : 0u; mine = (j == x) ? c : mine; }
        if (sum == G) break;
        __builtin_amdgcn_s_sleep(1);
        if ((++sp & 255u) == 0u) { if (xb_ld(&bar[XB_TMO])) break; if (sp > XB_SPIN_CAP) { atomicAdd(&bar[XB_TMO], 1u); break; } }
    }
    nloc = mine > 0u ? mine : 1u; nx = cnt > 0u ? cnt : 1u;
}
__device__ __forceinline__ void xcd_barrier(const XcdBarrier& b) {
    asm volatile("s_waitcnt vmcnt(0)" ::: "memory");
    __syncthreads();
    if (threadIdx.x == 0) {
        unsigned* bar = b.bar; asm volatile("" : "+s"(bar));
        __builtin_amdgcn_s_waitcnt(0);
        unsigned nloc = b.st[0], nx = b.st[1];
        if (nloc == 0u) { xcd_barrier_complete(bar, b.x, nloc, nx); b.st[0] = nloc; b.st[1] = nx; }
        const unsigned old = xb_add(&bar[XB_XSUB(b.x)], 1u);
        const unsigned gen = old / nloc;
        if (old + 1u == (gen + 1u) * nloc) {
            __builtin_amdgcn_fence(__ATOMIC_RELEASE, "agent");
            asm volatile("s_waitcnt vmcnt(0)" ::: "memory");
            const unsigned og = xb_add(&bar[XB_TOP], 1u);
            const unsigned tg = og / nx;
            if (og + 1u == (tg + 1u) * nx) xb_add(&bar[XB_TOPGEN], 1u);
            else XB_SPIN(xb_ld(&bar[XB_TOPGEN]) == tg, bar);
            __builtin_amdgcn_fence(__ATOMIC_ACQUIRE, "agent");
            xb_add(&bar[XB_XGEN(b.x)], 1u);
            asm volatile("s_waitcnt vmcnt(0)" ::: "memory");
        } else {
            XB_SPIN(xb_ld(&bar[XB_XGEN(b.x)]) == gen, bar);
            __builtin_amdgcn_fence(__ATOMIC_ACQUIRE, "agent");
            asm volatile("s_waitcnt vmcnt(0)" ::: "memory");
        }
    }
    __syncthreads();
}

struct Args { const float* in[N_INPUTS]; float* out; unsigned char* ws; int ph_lo, ph_hi; };
struct Frame {
    LAS unsigned char* lds;
    int tid, lane, wave, G, bid;
};
constexpr int LDS_ARGT = 131072 + 1024;
__device__ __forceinline__ const float* INP(const Frame& F, int k) {
    const LAS unsigned* t = (const LAS unsigned*)(F.lds + LDS_ARGT) + 2 * k;
    const unsigned lo = __builtin_amdgcn_readfirstlane(t[0]), hi = __builtin_amdgcn_readfirstlane(t[1]);
    return (const float*)(((unsigned long long)hi << 32) | lo);
}
__device__ __forceinline__ float* OUTP(const Frame& F) { return (float*)INP(F, 46); }
__device__ __forceinline__ unsigned char* WSP(const Frame& F) { return (unsigned char*)INP(F, 47); }

namespace pg8 {
constexpr int BM = 256, BK = 64, HALF = 128, HTB = HALF * BK * 2, STAGE_BYTES = 8 * HTB, NXCD = 8, WGM = 8;
__host__ __device__ __forceinline__ int lds_byte(int r, int c) { const int st = (r >> 4) * 2 + (c >> 5), rr = r & 15, cc = c & 31, ob = rr * 64 + cc * 2; return st * 1024 + (ob ^ (((ob >> 9) & 1) << 5)); }
__host__ __device__ __forceinline__ void stage_rc(int b, int& R, int& C) { const int st = b / 1024, sb = b % 1024, swz = sb ^ (((sb >> 9) & 1) << 5); R = (st >> 1) * 16 + swz / 64; C = (st & 1) * 32 + (swz % 64) / 2; }
__host__ __device__ __forceinline__ int perm32(int rho) { const int n = rho >> 4, i = rho & 15; return 8 * (i >> 2) + 4 * n + (i & 3); }

struct Unit { int pm, pn, br; };
struct Gemm { const bf16* A; const bf16* Bt; int lda, ldb, K; int a_br_stride  , a_br4_off  , b_br_tiles  ; };

struct Order {
    int nM, nN, nwg, G, c, nbr;
    __device__ void init(int Mrows, int N, int G_, int c_, int nbr_) { nM = Mrows / BM; nN = N / BM; nwg = nM * nN; G = G_; c = c_; nbr = nbr_; }
    __device__ bool next(int i, Unit& u) const {
        const int it = i / nbr; u.br = i - it * nbr;
        const long L = (long)it * G + c; if (L >= nwg) return false;
        int wgid = (int)L; { const int q = nwg / NXCD, r = nwg % NXCD, xcd = wgid % NXCD, off = wgid / NXCD; wgid = (xcd < r ? xcd * (q + 1) : r * (q + 1) + (xcd - r) * q) + off; }
        const int nig = WGM * nN, gid = wgid / nig, fm = gid * WGM, gsz = (nM - fm) < WGM ? (nM - fm) : WGM;
        u.pm = fm + ((wgid % nig) % gsz); u.pn = (wgid % nig) / gsz; return true;
    }
};
struct Order5 {
    Order o;
    __device__ void init(int Mrows, int G_, int c_) { o.init(Mrows, 20 * BM, G_, c_, 1); }
    __device__ bool next(int i, Unit& u) const { if (!o.next(i, u)) return false; u.br = u.pn >> 2; u.pn &= 3; return true; }
};

template <class Epi, class Sched>
__device__ __forceinline__ void gemm_phase(LAS unsigned char* lds, const Gemm g, const Sched& S, const Epi& E) {
    int tid = threadIdx.x; asm volatile("" : "+v"(tid));
    const int wid = __builtin_amdgcn_readfirstlane(tid >> 6), lane = tid & 63, wr = wid >> 2, wc = wid & 3, fr = lane & 15, fq = lane >> 4;
    const int K = g.K, nt = K / BK;
    unsigned voffA[2], voffB[2];
#pragma unroll
    for (int i = 0; i < 2; ++i) { int R, C; stage_rc(tid * 16 + i * 8192, R, C); const int Rb = Epi::PERM ? ((R & ~31) + perm32(R & 31)) : R;
        voffA[i] = (unsigned)(R * g.lda + C) * 2u; voffB[i] = (unsigned)(Rb * g.ldb + C) * 2u; }
    const size_t kstep = (size_t)(BK * 2);
    const size_t hstepA = (size_t)HALF * g.lda * 2, hstepB = (size_t)HALF * g.ldb * 2;
    const unsigned ldsw = (unsigned)wid * 1024u;
    const int aoff = lds_byte(wr * 64 + fr, fq * 8), boff = lds_byte(wc * 32 + fr, fq * 8);
#define PG8_APTR(u) ((const char*)g.A + ((size_t)(u).pm * 256 * g.lda + (size_t)(u).br * g.a_br_stride + ((u).br == 4 ? g.a_br4_off : 0)) * 2)
#define PG8_BPTR(u) ((const char*)g.Bt + ((size_t)((u).br * g.b_br_tiles + (u).pn) * 256 * g.ldb) * 2)
#define PG8_SA(b, h) (((b) * 2 + (h)) * HTB)
#define PG8_SB(b, h) ((4 + (b) * 2 + (h)) * HTB)
#define PG8_STAGE(bufoff, gbase, voff) do { _Pragma("unroll") for (int _i = 0; _i < 2; ++_i) \
        __builtin_amdgcn_global_load_lds((const unsigned*)((const char*)(gbase) + (voff)[_i]), (LAS unsigned*)(lds + (bufoff) + ldsw + _i * 8192), 16, 0, 0); } while (0)
#define PG8_LDA(dst, b, h) do { _Pragma("unroll") for (int m = 0; m < 4; ++m) _Pragma("unroll") for (int k = 0; k < 2; ++k) dst[m][k] = *(const LAS bf16x8*)(lds + PG8_SA(b, h) + aoff + m * 2048 + k * 1024); } while (0)
#define PG8_LDB(dst, b, h) do { _Pragma("unroll") for (int n = 0; n < 2; ++n) _Pragma("unroll") for (int k = 0; k < 2; ++k) dst[n][k] = *(const LAS bf16x8*)(lds + PG8_SB(b, h) + boff + n * 2048 + k * 1024); } while (0)
#define PG8_MMA(ai, bj, At, Bt) do { __builtin_amdgcn_s_setprio(1); _Pragma("unroll") for (int m = 0; m < 4; ++m) _Pragma("unroll") for (int n = 0; n < 2; ++n) _Pragma("unroll") for (int k = 0; k < 2; ++k) \
        acc[ai][bj][m][n] = __builtin_amdgcn_mfma_f32_16x16x32_bf16(Bt[n][k], At[m][k], acc[ai][bj][m][n], 0, 0, 0); __builtin_amdgcn_s_setprio(0); } while (0)
#define PG8_WAIT_V(n) asm volatile("s_waitcnt vmcnt(" #n ")" ::: "memory")
#define PG8_WAIT_L(n) asm volatile("s_waitcnt lgkmcnt(" #n ")" ::: "memory")
#define PG8_BAR __builtin_amdgcn_s_barrier()
#define PG8_SCHED __builtin_amdgcn_sched_barrier(0)
    Unit cur, nxt; int ui = 0;
    if (!S.next(0, cur)) return;
    f32x4 acc[2][2][4][2];
#pragma unroll
    for (int a = 0; a < 2; ++a)
#pragma unroll
        for (int b = 0; b < 2; ++b)
#pragma unroll
            for (int m = 0; m < 4; ++m)
#pragma unroll
                for (int n = 0; n < 2; ++n) acc[a][b][m][n] = (f32x4){0.f, 0.f, 0.f, 0.f};
    bf16x8 At[4][2], B0[2][2], B1[2][2];
    const char* cA = PG8_APTR(cur); const char* cB = PG8_BPTR(cur);
    PG8_STAGE(PG8_SB(0, 0), cB, voffB); PG8_STAGE(PG8_SB(0, 1), cB + hstepB, voffB); PG8_STAGE(PG8_SA(0, 0), cA, voffA); PG8_STAGE(PG8_SA(0, 1), cA + hstepA, voffA);
    if (wr == 1) PG8_BAR;
    PG8_WAIT_V(2); PG8_BAR;
    PG8_STAGE(PG8_SB(1, 0), cB + kstep, voffB); PG8_STAGE(PG8_SA(1, 0), cA + kstep, voffA); PG8_STAGE(PG8_SB(1, 1), cB + hstepB + kstep, voffB);
    PG8_WAIT_V(6); PG8_BAR;
    for (;;) {
        const bool has_next = S.next(ui + 1, nxt);
        const char* nA = has_next ? PG8_APTR(nxt) : cA; const char* nB = has_next ? PG8_BPTR(nxt) : cB;
#pragma unroll 1
        for (int t = 0; t < nt; t += 2) {
            const bool last = (t == nt - 2);
            const char* a1 = cA + (size_t)(t + 1) * kstep;
            const char* a2 = last ? nA : cA + (size_t)(t + 2) * kstep; const char* b2 = last ? nB : cB + (size_t)(t + 2) * kstep;
            const char* a3 = a2 + kstep; const char* b3 = b2 + kstep;
            PG8_LDB(B0, 0, 0); PG8_LDB(B1, 0, 1); PG8_SCHED; PG8_LDA(At, 0, 0); PG8_STAGE(PG8_SA(1, 1), a1 + hstepA, voffA);
            PG8_WAIT_V(8); PG8_WAIT_L(0); PG8_BAR; PG8_MMA(0, 0, At, B0); PG8_MMA(0, 1, At, B1); PG8_BAR; PG8_SCHED;
            PG8_LDA(At, 0, 1); PG8_STAGE(PG8_SB(0, 0), b2, voffB); PG8_STAGE(PG8_SB(0, 1), b2 + hstepB, voffB); PG8_STAGE(PG8_SA(0, 0), a2, voffA);
            PG8_WAIT_V(8); PG8_WAIT_L(0); PG8_BAR; PG8_MMA(1, 0, At, B0); PG8_MMA(1, 1, At, B1); PG8_BAR; PG8_SCHED;
            PG8_LDB(B0, 1, 0); PG8_LDB(B1, 1, 1); PG8_SCHED; PG8_LDA(At, 1, 0); PG8_STAGE(PG8_SA(0, 1), a2 + hstepA, voffA);
            PG8_WAIT_V(8); PG8_WAIT_L(0); PG8_BAR; PG8_MMA(0, 0, At, B0); PG8_MMA(0, 1, At, B1); PG8_BAR; PG8_SCHED;
            PG8_LDA(At, 1, 1); PG8_STAGE(PG8_SB(1, 0), b3, voffB); PG8_STAGE(PG8_SB(1, 1), b3 + hstepB, voffB); PG8_STAGE(PG8_SA(1, 0), a3, voffA);
            PG8_WAIT_V(8); PG8_WAIT_L(0); PG8_BAR; PG8_MMA(1, 0, At, B0); PG8_MMA(1, 1, At, B1); PG8_BAR; PG8_SCHED;
        }
        if (wr == 0) PG8_BAR;
        E(acc, cur, wr, wc, fr, fq);
        if (!has_next) break;
#pragma unroll
        for (int a = 0; a < 2; ++a)
#pragma unroll
            for (int b = 0; b < 2; ++b)
#pragma unroll
                for (int m = 0; m < 4; ++m)
#pragma unroll
                    for (int n = 0; n < 2; ++n) acc[a][b][m][n] = (f32x4){0.f, 0.f, 0.f, 0.f};
        cur = nxt; cA = nA; cB = nB; ++ui;
        if (wr == 1) PG8_BAR;
    }
    PG8_WAIT_V(0);
    PG8_BAR;
#undef PG8_APTR
#undef PG8_BPTR
#undef PG8_SA
#undef PG8_SB
#undef PG8_STAGE
#undef PG8_LDA
#undef PG8_LDB
#undef PG8_MMA
#undef PG8_WAIT_V
#undef PG8_WAIT_L
#undef PG8_BAR
#undef PG8_SCHED
}

__device__ __forceinline__ float mrow_sel(int row) { return 0.f; }
__device__ __forceinline__ int modrow(int row) { return row < NPR ? 0 : 1 + ((row - NPR) >> 11); }

struct EpiProj {
    static constexpr bool PERM = true;
    bf16* proj; float* outk; float* outv; int layer;
    __device__ __forceinline__ void operator()(const f32x4 (&acc)[2][2][4][2], const Unit& u, int wr, int wc, int fr, int fq) const {
        { int t_ = threadIdx.x; asm volatile("" : "+v"(t_)); fr = t_ & 15; fq = (t_ >> 4) & 3; }
        const int row0 = u.pm * BM + wr * 64 + fr, colb = u.pn * BM + wc * 32 + 8 * fq;
        const int mode = (u.pn == 60) ? 1 : (u.pn == 61 ? 2 : ((u.pn >= 36) ? 3 : 0));
        const bool kv = (u.pm < 32) && (u.pn >= 4) && (u.pn < 12);
#pragma unroll
        for (int ai = 0; ai < 2; ++ai)
#pragma unroll
            for (int m = 0; m < 4; ++m) {
                const int row = row0 + ai * HALF + m * 16;
                bf16* rowp = proj + (size_t)row * NPROJ + colb;
#pragma unroll
                for (int bj = 0; bj < 2; ++bj) {
                    f32x4 v0 = acc[ai][bj][m][0], v1 = acc[ai][bj][m][1];
                    if (mode == 1) { if (colb + bj * HALF < COL_G1A) {
#pragma unroll
                        for (int j = 0; j < 4; ++j) { v0[j] = tanhf(v0[j]); v1[j] = tanhf(v1[j]); } } }
                    else if (mode == 3) {
#pragma unroll
                        for (int j = 0; j < 4; ++j) { v0[j] = sigmoidf_(v0[j]); v1[j] = sigmoidf_(v1[j]); } }
                    else if (mode == 2) { const bool act = (colb + bj * HALF) < 15744;
#pragma unroll
                        for (int j = 0; j < 4; ++j) { v0[j] = act ? sigmoidf_(v0[j]) : 0.f; v1[j] = act ? sigmoidf_(v1[j]) : 0.f; } }
                    u32x4 w; w.x = cvtpk(v0[0], v0[1]); w.y = cvtpk(v0[2], v0[3]); w.z = cvtpk(v1[0], v1[1]); w.w = cvtpk(v1[2], v1[3]);
                    *(u32x4*)(rowp + bj * HALF) = w;
                    if (kv) { const int col = colb + bj * HALF; float* ob = (u.pn < 8) ? outk : outv; const int ch = col - ((u.pn < 8) ? COL_K : COL_V);
                        float* dst = ob + ((size_t)(((row >> 8) * 4 + layer) * 256 + (row & 255))) * 1024 + ch;
                        *(f32x4*)dst = v0; *(f32x4*)(dst + 4) = v1; }
                }
            }
    }
};
struct EpiLora2 {
    static constexpr bool PERM = true;
    float* dec; bf16* abuf; bf16* gbuf; const float* w0; const float* a0;
    __device__ __forceinline__ void operator()(const f32x4 (&acc)[2][2][4][2], const Unit& u, int wr, int wc, int fr, int fq) const {
        { int t_ = threadIdx.x; asm volatile("" : "+v"(t_)); fr = t_ & 15; fq = (t_ >> 4) & 3; }
        const int row0 = u.pm * BM + wr * 64 + fr, colb = u.pn * BM + wc * 32 + 8 * fq;
        const int br = u.br, e = br & 1;
        const float* bsrc = (br < 2) ? w0 + e * 1024 : a0 + e * 1024;
#pragma unroll
        for (int bj = 0; bj < 2; ++bj)
#pragma unroll
            for (int n = 0; n < 2; ++n) {
                const int ch = colb + bj * HALF + 4 * n;
                f32x4 b0 = (f32x4){0.f, 0.f, 0.f, 0.f};
                if (br < 4) b0 = *(const f32x4*)(bsrc + ch);
#pragma unroll
                for (int ai = 0; ai < 2; ++ai)
#pragma unroll
                    for (int m = 0; m < 4; ++m) {
                        const int row = row0 + ai * HALF + m * 16;
                        f32x4 v0 = acc[ai][bj][m][n] + b0;
                        if (br < 2) {
#pragma unroll
                            for (int j = 0; j < 4; ++j) v0[j] = __expf(-0.6065306597126334f * sigmoidf_(v0[j]));
                            *(f32x4*)(dec + ((size_t)row * 2 + e) * 1024 + ch) = v0;
                        } else {
                            if (br < 4) {
#pragma unroll
                                for (int j = 0; j < 4; ++j) v0[j] = sigmoidf_(v0[j]); }
                            bf16* dst = (br < 4) ? abuf + ((size_t)row * 2 + e) * 1024 + ch : gbuf + (size_t)row * 1024 + ch;
                            *(u32x2*)dst = (u32x2){cvtpk(v0[0], v0[1]), cvtpk(v0[2], v0[3])};
                        }
                        __builtin_amdgcn_sched_barrier(0);
                    }
            }
    }
};
struct EpiMerge {
    static constexpr bool PERM = true;
    const bf16* proj; bf16* merged;
    __device__ __forceinline__ void operator()(const f32x4 (&acc)[2][2][4][2], const Unit& u, int wr, int wc, int fr, int fq) const {
        { int t_ = threadIdx.x; asm volatile("" : "+v"(t_)); fr = t_ & 15; fq = (t_ >> 4) & 3; }
        const int row0 = u.pm * BM + wr * 64 + fr, colb = u.pn * BM + wc * 32 + 8 * fq;
        const int br = u.br;
#pragma unroll
        for (int ai = 0; ai < 2; ++ai)
#pragma unroll
            for (int m = 0; m < 4; ++m) {
                const int row = row0 + ai * HALF + m * 16;
#pragma unroll
                for (int bj = 0; bj < 2; ++bj) {
                    const int col = colb + bj * HALF;
                    const u32x4 gw = *(const u32x4*)(proj + (size_t)row * NPROJ + COL_GL + br * 2048 + col);
                    bf16* dst = merged + (size_t)row * D + col;
                    f32x4 v0 = acc[ai][bj][m][0], v1 = acc[ai][bj][m][1];
                    v0[0] *= bflo(gw.x); v0[1] *= bfhi(gw.x); v0[2] *= bflo(gw.y); v0[3] *= bfhi(gw.y);
                    v1[0] *= bflo(gw.z); v1[1] *= bfhi(gw.z); v1[2] *= bflo(gw.w); v1[3] *= bfhi(gw.w);
                    if (br > 0) { const u32x4 pw = *(const u32x4*)dst;
                        v0[0] += bflo(pw.x); v0[1] += bfhi(pw.x); v0[2] += bflo(pw.y); v0[3] += bfhi(pw.y);
                        v1[0] += bflo(pw.z); v1[1] += bfhi(pw.z); v1[2] += bflo(pw.w); v1[3] += bfhi(pw.w); }
                    u32x4 w; w.x = cvtpk(v0[0], v0[1]); w.y = cvtpk(v0[2], v0[3]); w.z = cvtpk(v1[0], v1[1]); w.w = cvtpk(v1[2], v1[3]);
                    *(u32x4*)dst = w;
                }
            }
    }
};
struct EpiResid {
    static constexpr bool PERM = false;
    float* x; const float* gate;   const float* bias;
    __device__ __forceinline__ void operator()(const f32x4 (&acc)[2][2][4][2], const Unit& u, int wr, int wc, int fr, int fq) const {
        { int t_ = threadIdx.x; asm volatile("" : "+v"(t_)); fr = t_ & 15; fq = (t_ >> 4) & 3; }
        const int row0 = u.pm * BM + wr * 64 + fr, col0 = u.pn * BM + wc * 32 + 4 * fq;
        const int mr = modrow(u.pm * BM);
        const float* gp = gate + (size_t)mr * 12288;
        f32x4 gv[2][2], bv[2][2];
#pragma unroll
        for (int bj = 0; bj < 2; ++bj)
#pragma unroll
            for (int n = 0; n < 2; ++n) { gv[bj][n] = *(const f32x4*)(gp + col0 + bj * HALF + n * 16);
                bv[bj][n] = bias ? *(const f32x4*)(bias + col0 + bj * HALF + n * 16) : (f32x4){0.f, 0.f, 0.f, 0.f}; }
#pragma unroll
        for (int ai = 0; ai < 2; ++ai)
#pragma unroll
            for (int m = 0; m < 4; ++m) { float* rowp = x + (size_t)(row0 + ai * HALF + m * 16) * D + col0;
#pragma unroll
                for (int bj = 0; bj < 2; ++bj)
#pragma unroll
                    for (int n = 0; n < 2; ++n) { f32x4* p = (f32x4*)(rowp + bj * HALF + n * 16); const f32x4 xo = *p; *p = xo + gv[bj][n] * (acc[ai][bj][m][n] + bv[bj][n]); }
                asm volatile("" ::: "memory"); }
    }
};
struct EpiFF1 {
    static constexpr bool PERM = true;
    bf16* U; const float* bias;
    __device__ __forceinline__ void operator()(const f32x4 (&acc)[2][2][4][2], const Unit& u, int wr, int wc, int fr, int fq) const {
        { int t_ = threadIdx.x; asm volatile("" : "+v"(t_)); fr = t_ & 15; fq = (t_ >> 4) & 3; }
        const int row0 = u.pm * BM + wr * 64 + fr, colb = u.pn * BM + wc * 32 + 8 * fq;
        f32x4 bv[2][2];
#pragma unroll
        for (int bj = 0; bj < 2; ++bj)
#pragma unroll
            for (int n = 0; n < 2; ++n) bv[bj][n] = *(const f32x4*)(bias + colb + bj * HALF + 4 * n);
#pragma unroll
        for (int ai = 0; ai < 2; ++ai)
#pragma unroll
            for (int m = 0; m < 4; ++m) { bf16* rowp = U + (size_t)(row0 + ai * HALF + m * 16) * DFF + colb;
#pragma unroll
                for (int bj = 0; bj < 2; ++bj) { f32x4 v0 = acc[ai][bj][m][0] + bv[bj][0], v1 = acc[ai][bj][m][1] + bv[bj][1];
#pragma unroll
                    for (int j = 0; j < 4; ++j) { const float a = fmaxf(v0[j], 0.f), b = fmaxf(v1[j], 0.f); v0[j] = a * a; v1[j] = b * b; }
                    u32x4 w; w.x = cvtpk(v0[0], v0[1]); w.y = cvtpk(v0[2], v0[3]); w.z = cvtpk(v1[0], v1[1]); w.w = cvtpk(v1[2], v1[3]);
                    *(u32x4*)(rowp + bj * HALF) = w; } }
    }
};
}

__device__ __forceinline__ void transpose_item(const float* W, int K, int N, bf16* WT, int ldk, int row_off, LAS bf16* scr, int item, int lane) {
    const int nblk = N / 64, kb = item / nblk, nb = item % nblk, k0 = 64 * kb, n0 = 64 * nb;
    const float* src = W + (size_t)k0 * N + n0 + lane;
#pragma unroll 1
    for (int h = 0; h < 2; ++h) { float v[32];
#pragma unroll
        for (int i = 0; i < 32; ++i) v[i] = src[(size_t)(h * 32 + i) * N];
#pragma unroll
        for (int i = 0; i < 32; ++i) scr[(h * 32 + i) * 66 + lane] = f2bf(v[i]); }
    LDS_WAIT(); asm volatile("" ::: "memory");
    const int kc = lane & 7, ns = lane >> 3;
#pragma unroll
    for (int j = 0; j < 8; ++j) { const int n = 8 * j + ns; const LAS bf16* s = scr + (8 * kc) * 66 + n;
        u32x4 o; o.x = (unsigned)s[0] | ((unsigned)s[66] << 16); o.y = (unsigned)s[2 * 66] | ((unsigned)s[3 * 66] << 16); o.z = (unsigned)s[4 * 66] | ((unsigned)s[5 * 66] << 16); o.w = (unsigned)s[6 * 66] | ((unsigned)s[7 * 66] << 16);
        *(u32x4*)(WT + (size_t)(row_off + n0 + n) * ldk + k0 + 8 * kc) = o; }
    LDS_WAIT(); asm volatile("" ::: "memory");
}

__device__ __forceinline__ void prologue0(const Frame& F, const Args& a) {
    unsigned char* ws = WSP(F);
    LAS bf16* scr = (LAS bf16*)(F.lds + F.wave * 16384);
    const int gw = F.bid * 8 + F.wave, NGW = F.G * 8;
    for (int l = 0; l < DEPTH; ++l) {
        bf16* WinT = (bf16*)(ws + WS_WIN) + (size_t)l * NPROJ * D;
        {   const int n_items = (D / 64) * (15360 / 64); const float* W = INP(F, I_WIN) + (size_t)l * D * 15360;
            for (int it = gw; it < n_items; it += NGW) transpose_item(W, D, 15360, WinT, D, 0, scr, it, F.lane); }
        for (int e = 0; e < 2; ++e) {
            const int n_items = (D / 64);
            const float* W1 = INP(F, I_W1) + ((size_t)l * 2 + e) * D * 64; const float* A1 = INP(F, I_A1) + ((size_t)l * 2 + e) * D * 64;
            for (int it = gw; it < n_items; it += NGW) { transpose_item(W1, D, 64, WinT, D, COL_LW + e * 64, scr, it, F.lane); transpose_item(A1, D, 64, WinT, D, COL_LW + 128 + e * 64, scr, it, F.lane); }
        }
        {   const int n_items = (D / 64) * 2; const float* W = INP(F, I_G1) + (size_t)l * D * 128;
            for (int it = gw; it < n_items; it += NGW) transpose_item(W, D, 128, WinT, D, COL_LW + 256, scr, it, F.lane); }
        for (int i = gw * 64 + F.lane; i < 128 * D / 8; i += NGW * 64) ((u32x4*)(WinT + (size_t)15744 * D))[i] = (u32x4){0u, 0u, 0u, 0u};
        for (int br = 0; br < 3; ++br) { const float* W = INP(F, I_WPA + br) + (size_t)l * 1024 * D; bf16* WT = (bf16*)(ws + WS_WP) + ((size_t)l * 3 + br) * D * 1024;
            const int n_items = (1024 / 64) * (D / 64);
            for (int it = gw; it < n_items; it += NGW) transpose_item(W, 1024, D, WT, 1024, 0, scr, it, F.lane); }
        {   const float* W = INP(F, I_WOUT) + (size_t)l * D * D; bf16* WT = (bf16*)(ws + WS_WOUT) + (size_t)l * D * D; const int n_items = (D / 64) * (D / 64);
            for (int it = gw; it < n_items; it += NGW) transpose_item(W, D, D, WT, D, 0, scr, it, F.lane); }
        {   const float* W = INP(F, I_FF1) + (size_t)l * D * DFF; bf16* WT = (bf16*)(ws + WS_WFF1) + (size_t)l * D * DFF; const int n_items = (D / 64) * (DFF / 64);
            for (int it = gw; it < n_items; it += NGW) transpose_item(W, D, DFF, WT, D, 0, scr, it, F.lane); }
        {   const float* W = INP(F, I_FF2) + (size_t)l * D * DFF; bf16* WT = (bf16*)(ws + WS_WFF2) + (size_t)l * D * DFF; const int n_items = (DFF / 64) * (D / 64);
            for (int it = gw; it < n_items; it += NGW) transpose_item(W, DFF, D, WT, DFF, 0, scr, it, F.lane); }
        {   bf16* W2T = (bf16*)(ws + WS_W2T) + (size_t)l * 5120 * 256;
            const float* w2 = INP(F, I_W2) + (size_t)l * 2 * 64 * 1024; const float* a2 = INP(F, I_A2) + (size_t)l * 2 * 64 * 1024; const float* g2 = INP(F, I_G2) + (size_t)l * 128 * 1024;
            for (int it = gw; it < 16 * 6; it += NGW) { const int m = it / 16, sub = it % 16;
                const float* W = m == 0 ? w2 : (m == 1 ? w2 + 65536 : (m == 2 ? a2 : (m == 3 ? a2 + 65536 : (m == 4 ? g2 : g2 + 65536))));
                const int br = m < 4 ? m : 4, koff = m < 4 ? 64 * m : (m == 4 ? 128 : 192);
                transpose_item(W, 64, 1024, W2T + (size_t)br * 1024 * 256 + koff, 256, 0, scr, sub, F.lane); }
            for (int i = gw * 64 + F.lane; i < 5120 * 32; i += NGW * 64) { const int n = i >> 5, k8 = (i & 31) * 8, br = n >> 10;
                const bool nz = br == 4 ? (k8 >= 128) : (k8 >= 64 * br && k8 < 64 * br + 64);
                if (!nz) *(u32x4*)(W2T + (size_t)n * 256 + k8) = (u32x4){0u, 0u, 0u, 0u}; }
        }
    }
    {   const float* ck = INP(F, I_CK); const float* cv = INP(F, I_CV); bf16* ok = (bf16*)(ws + WS_CK); bf16* ov = (bf16*)(ws + WS_CV);
        const int n4 = 4 * 4 * 256 * 1024 / 4;
        for (int i = gw * 64 + F.lane; i < n4; i += NGW * 64) { const f32x4 x = ((const f32x4*)ck)[i], y = ((const f32x4*)cv)[i];
            ((u32x2*)ok)[i] = (u32x2){cvtpk(x[0], x[1]), cvtpk(x[2], x[3])}; ((u32x2*)ov)[i] = (u32x2){cvtpk(y[0], y[1]), cvtpk(y[2], y[3])}; }
    }
    {   LAS float* sv = (LAS float*)(F.lds + 65536);
        __syncthreads();
        for (int i = F.tid; i < 5 * D; i += 512) { const int r = i / D, d = i - r * D; const float x = (r == 0) ? INP(F, I_CCTX)[d] : INP(F, I_C)[(r - 1) * D + d]; sv[i] = x / (1.0f + __expf(-x)); }
        __syncthreads();
        float* PART = (float*)(ws + WS_Q);
        const int n_items = DEPTH * 48 * 8;
        for (int it = gw; it < n_items; it += NGW) {
            const int l = it / 384, rem = it % 384, jc = rem >> 3, ds = rem & 7, j4 = jc * 256 + 4 * F.lane;
            const float* W = INP(F, I_WMOD) + (size_t)l * D * 12288 + (size_t)(ds * 256) * 12288 + j4;
            f32x4 acc[5];
#pragma unroll
            for (int r = 0; r < 5; ++r) acc[r] = (f32x4){0.f, 0.f, 0.f, 0.f};
#pragma unroll 4
            for (int d = 0; d < 256; d += 4) {
                f32x4 w[4];
#pragma unroll
                for (int q = 0; q < 4; ++q) w[q] = *(const f32x4*)(W + (size_t)(d + q) * 12288);
#pragma unroll
                for (int r = 0; r < 5; ++r) { const f32x4 s = *(const LAS f32x4*)(sv + r * D + ds * 256 + d);
#pragma unroll
                    for (int q = 0; q < 4; ++q) acc[r] += w[q] * s[q]; }
            }
#pragma unroll
            for (int r = 0; r < 5; ++r) *(f32x4*)(PART + (((size_t)ds * 4 + l) * 5 + r) * 12288 + j4) = acc[r];
        }
        __syncthreads();
    }
    {   float* T2 = (float*)(ws + WS_T2);
        const int n_items = DEPTH * (L_S + L_P);
        for (int it = gw; it < n_items; it += NGW) {
            const int l = it / (L_S + L_P), rr = it % (L_S + L_P), sel = rr < L_S ? 0 : 1, t = sel ? rr - L_S : rr, L = sel ? L_P : L_S;
            float zf = 0.f;
            {   const float tt = (float)t / (float)(L - 1);
                const float w = (6.283185307179586f * (float)t) / (float)L;
                const int band = (F.lane - 1) & 15;
                const float f = 1e-4f + (float)band * ((15.0f - 1e-4f) / 15.0f);
                const float fw = f * w;
                const double rd = (double)fw - 6.283185307179586 * rint((double)fw * 0.15915494309189535);
                const float rf = (float)rd;
                zf = (F.lane == 0) ? tt : (F.lane <= 16 ? __cosf(rf) : -__sinf(rf));
            }
            const float* f1 = INP(F, I_F1) + (size_t)l * 33 * 64; const float* f2 = INP(F, I_F2) + (size_t)l * 64 * 64;
            const float fq = INP(F, I_FREQ)[l * 64 + F.lane];
            float s = INP(F, I_FB1)[l * 64 + F.lane];
            for (int i = 0; i < 33; ++i) s += __int_as_float(__builtin_amdgcn_readlane(__float_as_int(zf), i)) * f1[i * 64 + F.lane];
            float x = fq * s; { const double rd = (double)x - 6.283185307179586 * rint((double)x * 0.15915494309189535); x = (float)rd; }
            const float t1 = __sinf(x);
            float s2 = INP(F, I_FB2)[l * 64 + F.lane];
            for (int i = 0; i < 64; ++i) s2 += __int_as_float(__builtin_amdgcn_readlane(__float_as_int(t1), i)) * f2[i * 64 + F.lane];
            float y = fq * s2; { const double rd = (double)y - 6.283185307179586 * rint((double)y * 0.15915494309189535); y = (float)rd; }
            T2[(((size_t)l * 2 + sel) * L_S + t) * 64 + F.lane] = __sinf(y);
        }
    }
    {   bf16* FS = (bf16*)(ws + WS_FS); bf16* FP = (bf16*)(ws + WS_FP);
        for (int i = gw * 64 + F.lane; i < DEPTH * 1024 * 72; i += NGW * 64) { const int row = i / 72, p = i % 72; const int m = p < 32 ? p : p - 32 + 32;
            FS[(size_t)row * LPS + (p < 32 ? p : L_S + p)] = 0; FP[(size_t)row * LPP + (p < 32 ? p : L_P + p)] = 0; (void)m; }
    }
}

__device__ __forceinline__ void prologue1(const Frame& F, const Args& a) {
    unsigned char* ws = WSP(F);
    const int gw = F.bid * 8 + F.wave, NGW = F.G * 8;
    {   const float* PART = (const float*)(ws + WS_Q); float* MOD = (float*)(ws + WS_MOD);
        for (int i = (F.bid * 8 + F.wave) * 64 + F.lane; i < DEPTH * 5 * 12288 / 4; i += F.G * 8 * 64) {
            const int l = i / (5 * 3072), j4 = (i % 3072) * 4;
            f32x4 s = *(const f32x4*)(INP(F, I_BMOD) + l * 12288 + j4);
#pragma unroll
            for (int ds = 0; ds < 8; ++ds) s += ((const f32x4*)PART)[(size_t)ds * (DEPTH * 5 * 3072) + i];
            ((f32x4*)MOD)[i] = s; }
    }
    const float* T2 = (const float*)(ws + WS_T2);
    float* FNORM = (float*)(ws + WS_CTL) + CW_FNORM;
    const int items_s = DEPTH * 16 * (L_S / 64), items_p = DEPTH * 16 * (L_P / 64);
    for (int it = gw; it < items_s + items_p; it += NGW) {
        int sel, l, cg, tc;
        if (it < items_s) { sel = 0; l = it / (16 * 32); cg = (it / 32) % 16; tc = it % 32; } else { const int r = it - items_s; sel = 1; l = r / (16 * 4); cg = (r / 4) % 16; tc = r % 4; }
        const int L = sel ? L_P : L_S, c = cg * 64 + F.lane;
        const float* f3 = INP(F, I_F3) + (size_t)l * 64 * 1024 + c;
        float w3[64];
#pragma unroll
        for (int j = 0; j < 64; ++j) w3[j] = f3[(size_t)j * 1024];
        const float delta = fabsf(-3.0701134573253946f + (float)c * ((-15.350567286626973f + 3.0701134573253946f) / 1023.0f));
        bf16* dst = sel ? (bf16*)(ws + WS_FP) + ((size_t)l * 1024 + c) * LPP : (bf16*)(ws + WS_FS) + ((size_t)l * 1024 + c) * LPS;
        float asum = 0.f;
        for (int tt = 0; tt < 64; ++tt) {
            const int t = tc * 64 + tt;
            const float tv = T2[(((size_t)l * 2 + sel) * L_S + t) * 64 + F.lane];
            float s = 0.f;
#pragma unroll
            for (int j = 0; j < 64; ++j) s += __int_as_float(__builtin_amdgcn_readlane(__float_as_int(tv), j)) * w3[j];
            const float dist = fabsf((float)(t - L / 2)) / (float)L;
            const float fv = s * __expf(-dist * delta);
            asum += fabsf(fv);
            dst[32 + (L - 1 - t)] = f2bf(fv);
        }
        atomicAdd(FNORM + ((size_t)l * 2 + sel) * 1024 + c, asum);
    }
}

__device__ __forceinline__ void norm_phase(const Frame& F, const float* xp, const float* xs, float* xcopy, const float* g, const float* mod, int i_sh, int i_sc, bf16* hout) {
    const int gw = F.bid * 8 + F.wave, NGW = F.G * 8;
    for (int row = gw; row < M; row += NGW) {
        const float* xr = row < NPR ? xp + (size_t)row * D : xs + (size_t)(row - NPR) * D;
        const float* mr = mod + (size_t)pg8::modrow(row) * 12288;
        f32x4 v[8]; float ss = 0.f;
#pragma unroll
        for (int j = 0; j < 8; ++j) { v[j] = ((const f32x4*)xr)[F.lane + 64 * j]; ss += (v[j][0] * v[j][0] + v[j][1] * v[j][1]) + (v[j][2] * v[j][2] + v[j][3] * v[j][3]); }
        const float rstd = 1.0f / sqrtf(wave_sum(ss) * (1.0f / D) + 1e-6f);
        if (xcopy) {
#pragma unroll
            for (int j = 0; j < 8; ++j) ((f32x4*)(xcopy + (size_t)row * D))[F.lane + 64 * j] = v[j]; }
#pragma unroll
        for (int j = 0; j < 8; ++j) {
            const f32x4 gg = ((const f32x4*)g)[F.lane + 64 * j], sc = ((const f32x4*)(mr + i_sc * D))[F.lane + 64 * j], sh = ((const f32x4*)(mr + i_sh * D))[F.lane + 64 * j];
            const f32x4 o = v[j] * rstd * gg * (1.0f + sc) + sh;
            ((u32x2*)(hout + (size_t)row * D))[F.lane + 64 * j] = (u32x2){cvtpk(o[0], o[1]), cvtpk(o[2], o[3])};
        }
    }
}
__device__ __forceinline__ void final_norm_phase(const Frame& F, float* x, const float* g) {
    const int gw = F.bid * 8 + F.wave, NGW = F.G * 8;
    for (int row = gw; row < M; row += NGW) {
        float* xr = x + (size_t)row * D;
        f32x4 v[8]; float ss = 0.f;
#pragma unroll
        for (int j = 0; j < 8; ++j) { v[j] = ((const f32x4*)xr)[F.lane + 64 * j]; ss += (v[j][0] * v[j][0] + v[j][1] * v[j][1]) + (v[j][2] * v[j][2] + v[j][3] * v[j][3]); }
        const float rstd = 1.0f / sqrtf(wave_sum(ss) * (1.0f / D) + 1e-6f);
#pragma unroll
        for (int j = 0; j < 8; ++j) { const f32x4 gg = ((const f32x4*)g)[F.lane + 64 * j]; ((f32x4*)xr)[F.lane + 64 * j] = v[j] * rstd * gg; }
    }
}

__device__ __forceinline__ s16x4 vtr(const LAS unsigned char* p) { return __builtin_bit_cast(s16x4, __builtin_amdgcn_ds_read_tr16_b64_v4i16((LAS s16x4*)p)); }

struct AttnState { float m, l; f32x16 o[2]; };

template <int NT, bool HASB, class KT, class VL, class BIAS>
__device__ __forceinline__ void attendN(AttnState& st, const bf16x8 (&qf)[4], const KT& ktp, size_t kstride, const LAS unsigned char* lds, const VL& vlo, const BIAS& bias, int lane) {
    const int r = lane & 31, h = lane >> 5;
    f32x16 s[NT];
#pragma unroll
    for (int kt = 0; kt < NT; ++kt) {
        const bf16* kp = ktp(kt) + (size_t)r * kstride + 8 * h;
        bf16x8 kf[4];
#pragma unroll
        for (int ks = 0; ks < 4; ++ks) kf[ks] = *(const bf16x8*)(kp + 16 * ks);
        f32x16 acc;
#pragma unroll
        for (int i = 0; i < 16; ++i) acc[i] = 0.f;
#pragma unroll
        for (int ks = 0; ks < 4; ++ks) acc = __builtin_amdgcn_mfma_f32_32x32x16_bf16(kf[ks], qf[ks], acc, 0, 0, 0);
        s[kt] = acc;
    }
    float gm = -3.0e38f;
#pragma unroll
    for (int kt = 0; kt < NT; ++kt)
#pragma unroll
        for (int i = 0; i < 16; ++i) {
            float v = s[kt][i] * 0.125f;
            if (HASB) v = bias(kt, (i & 3) + 8 * (i >> 2) + 4 * h, v);
            s[kt][i] = v; gm = fmaxf(gm, v);
        }
    gm = fmaxf(gm, xor32(gm, lane));
    const float mnew = fmaxf(st.m, gm);
    const float alpha = __expf(st.m - mnew);
    float ps = 0.f;
#pragma unroll
    for (int kt = 0; kt < NT; ++kt)
#pragma unroll
        for (int i = 0; i < 16; ++i) { const float p = __expf(s[kt][i] - mnew); s[kt][i] = p; ps += p; }
    st.l = st.l * alpha + ps; st.m = mnew;
#pragma unroll
    for (int i = 0; i < 16; ++i) { st.o[0][i] *= alpha; st.o[1][i] *= alpha; }
    const int i16 = lane & 15, tq = i16 >> 2, tp = i16 & 3, blk = (lane >> 4) & 1;
#pragma unroll
    for (int kt = 0; kt < NT; ++kt) {
        const LAS unsigned char* vb = lds + vlo(kt);
#pragma unroll
        for (int ss = 0; ss < 2; ++ss) {
            u32x4 pw; pw.x = cvtpk(s[kt][8 * ss + 0], s[kt][8 * ss + 1]); pw.y = cvtpk(s[kt][8 * ss + 2], s[kt][8 * ss + 3]); pw.z = cvtpk(s[kt][8 * ss + 4], s[kt][8 * ss + 5]); pw.w = cvtpk(s[kt][8 * ss + 6], s[kt][8 * ss + 7]);
            const bf16x8 pf = __builtin_bit_cast(bf16x8, pw);
#pragma unroll
            for (int dt = 0; dt < 2; ++dt) {
                const LAS unsigned char* p0 = vb + (16 * ss + 4 * h + tq) * 128 + (dt * 32 + 16 * blk + 4 * tp) * 2;
                const s16x4 lo = vtr(p0), hi = vtr(p0 + 8 * 128);
                const bf16x8 vf = __builtin_shufflevector(lo, hi, 0, 1, 2, 3, 4, 5, 6, 7);
                st.o[dt] = __builtin_amdgcn_mfma_f32_32x32x16_bf16(vf, pf, st.o[dt], 0, 0, 0);
            }
        }
    }
}

__device__ __forceinline__ void attn_store(const AttnState& st, bf16* orow  , int lane) {
    const int h = lane >> 5;
    const float lt = st.l + xor32(st.l, lane);
    const float inv = 1.0f / lt;
#pragma unroll
    for (int dt = 0; dt < 2; ++dt)
#pragma unroll
        for (int g = 0; g < 4; ++g) {
            const u32x2 w = (u32x2){cvtpk(st.o[dt][4 * g] * inv, st.o[dt][4 * g + 1] * inv), cvtpk(st.o[dt][4 * g + 2] * inv, st.o[dt][4 * g + 3] * inv)};
            *(u32x2*)(orow + dt * 32 + 8 * g + 4 * h) = w;
        }
}

__device__ __forceinline__ void attention_phase(const Frame& F, const Args& a, int layer) {
    unsigned char* ws = WSP(F);
    const bf16* proj = (const bf16*)(ws + WS_PROJ);
    bf16* oall = (bf16*)(ws + WS_OALL);
    const int lane = F.lane, w = F.wave, r = lane & 31, h = lane >> 5;
    LAS unsigned char* lds = F.lds;
    LAS float* rpbl = (LAS float*)(lds + 122880);
    for (int u = F.bid; u < 1024; u += F.G) {
        __syncthreads();
        if (u < 512) {
            const int b = u >> 4, hd = u & 15;
            const int tok0 = b * 256;
            for (int i = F.tid; i < 256 * 8; i += 512) { const int key = i >> 3, pc = i & 7;
                *(LAS u32x4*)(lds + key * 128 + pc * 16) = *(const u32x4*)(proj + (size_t)(tok0 + key) * NPROJ + COL_V + hd * 64 + pc * 8); }
            __syncthreads();
            bf16x8 qf[4];
            { const bf16* qp = proj + (size_t)(tok0 + 32 * w + r) * NPROJ + hd * 64 + 8 * h;
#pragma unroll
              for (int ks = 0; ks < 4; ++ks) qf[ks] = *(const bf16x8*)(qp + 16 * ks); }
            AttnState st; st.m = -3.0e38f; st.l = 0.f;
#pragma unroll
            for (int i = 0; i < 16; ++i) { st.o[0][i] = 0.f; st.o[1][i] = 0.f; }
            const bf16* kbase = proj + (size_t)tok0 * NPROJ + COL_K + hd * 64;
#pragma unroll 1
            for (int kg = 0; kg < 2; ++kg)
                attendN<4, false>(st, qf, [&](int kt) { return kbase + (size_t)((kg * 4 + kt) * 32) * NPROJ; }, (size_t)NPROJ, lds, [&](int kt) { return (kg * 4 + kt) * 4096; }, [&](int, int, float v) { return v; }, lane);
            attn_store(st, oall + (size_t)(tok0 + 32 * w + r) * 3072 + hd * 64, lane);
        } else {
            const int uu = u - 512, b = uu >> 7, hd = (uu >> 3) & 15, rg = uu & 7;
            const int tokb = NPR + b * 2048;
            int rlo = 4 * rg - 4; rlo = rlo < 0 ? 0 : (rlo > 24 ? 24 : rlo);
            int rhi0 = 4 * rg + 3 - 4; rhi0 = rhi0 < 0 ? 0 : (rhi0 > 24 ? 24 : rhi0); const int nr = rhi0 + 8 - rlo;
            for (int i = F.tid; i < nr * 64 * 8; i += 512) { const int key = i >> 3, pc = i & 7;
                *(LAS u32x4*)(lds + key * 128 + pc * 16) = *(const u32x4*)(proj + (size_t)(tokb + rlo * 64 + key) * NPROJ + COL_V + hd * 64 + pc * 8); }
            const bf16* cv = (const bf16*)(ws + WS_CV) + ((size_t)(b * 4 + layer) * 256) * 1024 + hd * 64;
            const bf16* ck = (const bf16*)(ws + WS_CK) + ((size_t)(b * 4 + layer) * 256) * 1024 + hd * 64;
            for (int i = F.tid; i < 256 * 8; i += 512) { const int key = i >> 3, pc = i & 7;
                *(LAS u32x4*)(lds + 90112 + key * 128 + pc * 16) = *(const u32x4*)(cv + (size_t)key * 1024 + pc * 8); }
            for (int i = F.tid; i < 465; i += 512) rpbl[i] = INP(F, I_RPB)[((size_t)layer * 16 + hd) * 465 + i];
            __syncthreads();
            const int qrow = 4 * rg + (w >> 1), qc = (w & 1) * 32 + r;
            int r0 = qrow - 4; r0 = r0 < 0 ? 0 : (r0 > 24 ? 24 : r0);
            int c0 = qc - 8; c0 = c0 < 0 ? 0 : (c0 > 48 ? 48 : c0);
            const int qtok = tokb + qrow * 64 + (w & 1) * 32 + r;
            bf16x8 qf[4];
            { const bf16* qp = proj + (size_t)qtok * NPROJ + hd * 64 + 8 * h;
#pragma unroll
              for (int ks = 0; ks < 4; ++ks) qf[ks] = *(const bf16x8*)(qp + 16 * ks); }
            AttnState st; st.m = -3.0e38f; st.l = 0.f;
#pragma unroll
            for (int i = 0; i < 16; ++i) { st.o[0][i] = 0.f; st.o[1][i] = 0.f; }
            const bf16* kloc = proj + (size_t)tokb * NPROJ + COL_K + hd * 64;
#pragma unroll 1
            for (int grp = 0; grp < 4; ++grp) {
                const int krb = r0 + 2 * grp;
                attendN<4, true>(st, qf, [&](int kt) { return kloc + (size_t)((krb + (kt >> 1)) * 64 + (kt & 1) * 32) * NPROJ; }, (size_t)NPROJ, lds,
                    [&](int kt) { return ((krb + (kt >> 1) - rlo) * 64 + (kt & 1) * 32) * 128; },
                    [&](int kt, int kin, float v) { const int kr = krb + (kt >> 1), kc = (kt & 1) * 32 + kin; const bool ok = (kc >= c0) && (kc < c0 + 16);
                        const int dr = kr - qrow + 7, dc = kc - qc + 15; const int idx = ok ? dr * 31 + dc : 0; return ok ? v + rpbl[idx] : -1.0e30f; }, lane);
            }
#pragma unroll 1
            for (int kg = 0; kg < 2; ++kg)
                attendN<4, false>(st, qf, [&](int kt) { return ck + (size_t)((kg * 4 + kt) * 32) * 1024; }, (size_t)1024, lds, [&](int kt) { return 90112 + (kg * 4 + kt) * 4096; }, [&](int, int, float v) { return v; }, lane);
            attn_store(st, oall + (size_t)qtok * 3072 + hd * 64, lane);
        }
    }
    __syncthreads();
}

__device__ __forceinline__ float row_sum16(float v) { v += DPPF(v, 0xB1); v += DPPF(v, 0x4E); v += DPPF(v, 0x141); v += DPPF(v, 0x140); return v; }
__device__ __forceinline__ f32x4 unpack4(u32x2 w) { return (f32x4){bflo(w.x), bfhi(w.x), bflo(w.y), bfhi(w.y)}; }
__device__ __forceinline__ u32x2 pack4(f32x4 v) { return (u32x2){cvtpk(v[0], v[1]), cvtpk(v[2], v[3])}; }
__device__ __forceinline__ void rwkv_prep_phase(const Frame& F, const Args& a, int layer) {
    unsigned char* ws = WSP(F);
    const bf16* proj = (const bf16*)(ws + WS_PROJ);
    const bf16* abuf = (const bf16*)(ws + WS_A);
    bf16* ops = (bf16*)(ws + WS_OPS);
    float* bonus = (float*)(ws + WS_BONUS);
    const float* cw = INP(F, I_CW) + (size_t)layer * 3 * 3072; const float* cb = INP(F, I_CB) + (size_t)layer * 3072;
    const int lane = F.lane;
    for (int item = F.wave * F.G + F.bid; item < 2048; item += 8 * F.G) {
        const int tok0 = (item >> 2) * 32, cg = item & 3, c4 = cg * 256 + 4 * lane, head = cg * 4 + (lane >> 4), hl = 4 * (lane & 15);
        const int t0 = tok0 < NPR ? (tok0 & 255) : ((tok0 - NPR) & 2047), L = tok0 < NPR ? L_P : L_S;
        f32x4 w[3][3], bs[3];
#pragma unroll
        for (int s = 0; s < 3; ++s) { bs[s] = *(const f32x4*)(cb + s * 1024 + c4);
#pragma unroll
            for (int tp = 0; tp < 3; ++tp) w[s][tp] = *(const f32x4*)(cw + tp * 3072 + s * 1024 + c4); }
        const f32x4 kkw = *(const f32x4*)(INP(F, I_KK) + layer * 1024 + c4), kaw = *(const f32x4*)(INP(F, I_KA) + layer * 1024 + c4), rkw = *(const f32x4*)(INP(F, I_RK) + layer * 1024 + c4);
        const bf16* pbase = proj + (size_t)tok0 * NPROJ + COL_R + c4;
#pragma unroll 1
        for (int ch = 0; ch < 4; ++ch) {
            u32x2 rows[10][3], av[8][2];
#pragma unroll
            for (int i = 0; i < 10; ++i) { const int tt = ch * 8 + i - 1, t = t0 + tt; const bool ok = (t >= 0) && (t < L);
#pragma unroll
                for (int s = 0; s < 3; ++s) rows[i][s] = ok ? *(const u32x2*)(pbase + (long)tt * NPROJ + s * 1024) : (u32x2){0u, 0u}; }
#pragma unroll
            for (int i = 0; i < 8; ++i) { const size_t tok = (size_t)(tok0 + ch * 8 + i); av[i][0] = *(const u32x2*)(abuf + (tok * 2 + 0) * 1024 + c4); av[i][1] = *(const u32x2*)(abuf + (tok * 2 + 1) * 1024 + c4); }
#pragma unroll
            for (int i = 0; i < 8; ++i) {
                const size_t tok = (size_t)(tok0 + ch * 8 + i);
                f32x4 x[3];
#pragma unroll
                for (int s = 0; s < 3; ++s) x[s] = unpack4(rows[i][s]) * w[s][0] + unpack4(rows[i + 1][s]) * w[s][1] + unpack4(rows[i + 2][s]) * w[s][2] + bs[s];
                const f32x4 rr = x[0], k0 = x[1], vv = x[2];
                f32x4 kk = k0 * kkw;
                const float ssq = row_sum16((kk[0] * kk[0] + kk[1] * kk[1]) + (kk[2] * kk[2] + kk[3] * kk[3]));
                kk = kk * (1.0f / sqrtf(ssq + 1e-12f));
                const f32x4 a0 = unpack4(av[i][0]), a1 = unpack4(av[i][1]);
                const f32x4 kd0 = k0 * (1.0f + (a0 - 1.0f) * kaw), kd1 = k0 * (1.0f + (a1 - 1.0f) * kaw);
                const f32x4 rk = rr * k0 * rkw;
                const float bsum = row_sum16((rk[0] + rk[1]) + (rk[2] + rk[3]));
                bf16* o = ops + (tok * 16 + head) * 448 + hl;
                *(u32x2*)(o) = pack4(rr); *(u32x2*)(o + 64) = pack4(vv); *(u32x2*)(o + 128) = pack4(-kk); *(u32x2*)(o + 192) = pack4(kd0); *(u32x2*)(o + 256) = pack4(kk * a0);
                *(u32x2*)(o + 320) = pack4(kd1); *(u32x2*)(o + 384) = pack4(kk * a1);
                if ((lane & 15) == 0) bonus[tok * 16 + head] = bsum;
            }
        }
    }
}

__device__ __forceinline__ float quad_x1(float v) { return __int_as_float(__builtin_amdgcn_update_dpp(0, __float_as_int(v), 0xB1, 0xf, 0xf, false)); }
__device__ __forceinline__ float quad_x2(float v) { return __int_as_float(__builtin_amdgcn_update_dpp(0, __float_as_int(v), 0x4E, 0xf, 0xf, false)); }
constexpr int SC_TC = 4;
constexpr int SEG = 256, NSEG = 8;
__device__ __forceinline__ void rwkv_scan_phase(const Frame& F, const Args& a, int layer) {
    unsigned char* ws = WSP(F);
    const bf16* ops = (const bf16*)(ws + WS_OPS);
    const float* dec = (const float*)(ws + WS_DEC);
    float* Y = (float*)(ws + WS_H);
    float* Q = (float*)(ws + WS_Q);
    const int lane = F.lane, vr = lane >> 2, kq = lane & 3;
    LAS float* wl = (LAS float*)(F.lds + F.wave * 16384);
    LAS float* yl = wl + SC_TC * 384;
    for (int item = F.wave * F.G + F.bid; item < 2944; item += 8 * F.G) {
        int chain, g, kind;
        if (item < 1024) { kind = 0; chain = item >> 3; g = item & 7; }
        else if (item < 1920) { kind = 1; const int r = item - 1024; chain = r / 7; g = r - chain * 7 + 1; }
        else { kind = 2; chain = item - 1920; g = 0; }
        const int hd = chain & 15, e = (chain >> 4) & 1, b = chain >> 5;
        const int L = kind == 2 ? L_P : L_S, tokb = kind == 2 ? b * L_P : NPR + b * L_S;
        const int s_lo = g * SEG;
        f32x2 S[4][8];
        if (kind == 0 && g == 0) { const float* s0 = INP(F, I_ST) + ((((size_t)b * 4 + layer) * 2 + e) * 16 + hd) * 4096;
#pragma unroll
            for (int i = 0; i < 4; ++i)
#pragma unroll
                for (int j4 = 0; j4 < 4; ++j4) { const f32x4 v = *(const f32x4*)(s0 + (vr + 16 * i) * 64 + 16 * kq + 4 * j4); S[i][2 * j4] = (f32x2){v[0], v[1]}; S[i][2 * j4 + 1] = (f32x2){v[2], v[3]}; }
        } else {
#pragma unroll
            for (int i = 0; i < 4; ++i)
#pragma unroll
                for (int p = 0; p < 8; ++p) { const int col = 16 * kq + 2 * p, row = vr + 16 * i; S[i][p] = (f32x2){(kind == 1 && row == col) ? 1.f : 0.f, (kind == 1 && row == col + 1) ? 1.f : 0.f}; }
        }
        const float vmask = kind == 1 ? 0.f : 1.f;
        float* yout = kind == 1 ? Q : Y; const long rowadd = kind == 1 ? (long)e * 8192 - NPR : (long)e * M;
        float pw[SC_TC]; bf16 pv[SC_TC], pn[SC_TC], pk[SC_TC], pb[SC_TC], pr[SC_TC];
#define SC_LOAD(T0) do { _Pragma("unroll") for (int s = 0; s < SC_TC; ++s) { \
            const int st_ = s_lo + (T0) + s; const int tau = e ? (L - 1 - st_) : st_; const size_t tok = (size_t)(tokb + tau); \
            const bf16* o = ops + (tok * 16 + hd) * 448 + lane; \
            pw[s] = dec[(tok * 2 + e) * 1024 + hd * 64 + lane]; pv[s] = o[64]; pn[s] = o[128]; pk[s] = o[192 + 128 * e]; pb[s] = o[256 + 128 * e]; pr[s] = o[0]; } } while (0)
        SC_LOAD(0);
        for (int t0 = 0; t0 < SEG; t0 += SC_TC) {
#pragma unroll
            for (int s = 0; s < SC_TC; ++s) {
                wl[s * 384 + 0 * 64 + lane] = pw[s]; wl[s * 384 + 1 * 64 + lane] = bf2f(pv[s]) * vmask; wl[s * 384 + 2 * 64 + lane] = bf2f(pn[s]);
                wl[s * 384 + 3 * 64 + lane] = bf2f(pk[s]); wl[s * 384 + 4 * 64 + lane] = bf2f(pb[s]); wl[s * 384 + 5 * 64 + lane] = bf2f(pr[s]);
            }
            if (t0 + SC_TC < SEG) SC_LOAD(t0 + SC_TC);
            LDS_WAIT(); asm volatile("" ::: "memory");
#pragma unroll
            for (int s = 0; s < SC_TC; ++s) {
                const LAS float* q = wl + s * 384 + 16 * kq;
                f32x2 w2[8], nk[8], kd[8], bb[8], rr[8];
#pragma unroll
                for (int j4 = 0; j4 < 4; ++j4) {
                    const f32x4 a0 = *(const LAS f32x4*)(q + 0 * 64 + 4 * j4), a2 = *(const LAS f32x4*)(q + 2 * 64 + 4 * j4), a3 = *(const LAS f32x4*)(q + 3 * 64 + 4 * j4),
                                a4 = *(const LAS f32x4*)(q + 4 * 64 + 4 * j4), a5 = *(const LAS f32x4*)(q + 5 * 64 + 4 * j4);
                    w2[2 * j4] = (f32x2){a0[0], a0[1]}; w2[2 * j4 + 1] = (f32x2){a0[2], a0[3]}; nk[2 * j4] = (f32x2){a2[0], a2[1]}; nk[2 * j4 + 1] = (f32x2){a2[2], a2[3]};
                    kd[2 * j4] = (f32x2){a3[0], a3[1]}; kd[2 * j4 + 1] = (f32x2){a3[2], a3[3]}; bb[2 * j4] = (f32x2){a4[0], a4[1]}; bb[2 * j4 + 1] = (f32x2){a4[2], a4[3]};
                    rr[2 * j4] = (f32x2){a5[0], a5[1]}; rr[2 * j4 + 1] = (f32x2){a5[2], a5[3]};
                }
#pragma unroll
                for (int i = 0; i < 4; ++i) {
                    const float vv = wl[s * 384 + 64 + vr + 16 * i];
                    f32x2 sa2 = S[i][0] * nk[0];
#pragma unroll
                    for (int p = 1; p < 8; ++p) sa2 += S[i][p] * nk[p];
                    float sa = sa2[0] + sa2[1];
                    sa += quad_x1(sa); sa += quad_x2(sa);
                    const f32x2 sav = (f32x2){sa, sa}, vvv = (f32x2){vv, vv};
                    f32x2 y2 = (f32x2){0.f, 0.f};
#pragma unroll
                    for (int p = 0; p < 8; ++p) { S[i][p] = S[i][p] * w2[p] + (sav * bb[p] + vvv * kd[p]); y2 += S[i][p] * rr[p]; }
                    float y = y2[0] + y2[1];
                    y += quad_x1(y); y += quad_x2(y);
                    if (kq == 0) yl[s * 64 + vr + 16 * i] = y;
                }
            }
            LDS_WAIT(); asm volatile("" ::: "memory");
#pragma unroll
            for (int s = 0; s < SC_TC; ++s) {
                const int st_ = s_lo + t0 + s; const int tau = e ? (L - 1 - st_) : st_;
                yout[(size_t)(rowadd + tokb + tau) * 1024 + hd * 64 + lane] = yl[s * 64 + lane];
            }
            LDS_WAIT(); asm volatile("" ::: "memory");
        }
#undef SC_LOAD
        float* so = nullptr;
        if (kind == 2) so = OUTP(F) + OUT_ST + ((((size_t)b * 4 + layer) * 2 + e) * 16 + hd) * 4096;
        else if (g < NSEG - 1) so = (float*)(ws + (kind == 0 ? WS_CEND : WS_PEND)) + ((size_t)chain * NSEG + g) * 4096;
        if (so) {
#pragma unroll
            for (int i = 0; i < 4; ++i)
#pragma unroll
                for (int j4 = 0; j4 < 4; ++j4) *(f32x4*)(so + (vr + 16 * i) * 64 + 16 * kq + 4 * j4) = (f32x4){S[i][2 * j4][0], S[i][2 * j4][1], S[i][2 * j4 + 1][0], S[i][2 * j4 + 1][1]};
        }
    }
}

__device__ __forceinline__ void rwkv_fix1_phase(const Frame& F) {
    unsigned char* ws = WSP(F);
    const float* CE = (const float*)(ws + WS_CEND); const float* PE = (const float*)(ws + WS_PEND); float* SS = (float*)(ws + WS_SS);
    const int lane = F.lane;
    for (int item = F.wave * F.G + F.bid; item < 128 * 16; item += 8 * F.G) {
        const int chain = item >> 4, r0 = (item & 15) * 4;
        float s[4];
#pragma unroll
        for (int r = 0; r < 4; ++r) { s[r] = CE[((size_t)chain * NSEG + 0) * 4096 + (r0 + r) * 64 + lane]; SS[((size_t)chain * NSEG + 1) * 4096 + (r0 + r) * 64 + lane] = s[r]; }
        for (int g = 1; g < NSEG - 1; ++g) {
            const float* P = PE + ((size_t)chain * NSEG + g) * 4096 + lane;
            float acc[4];
#pragma unroll
            for (int r = 0; r < 4; ++r) acc[r] = CE[((size_t)chain * NSEG + g) * 4096 + (r0 + r) * 64 + lane];
            float pv[64];
#pragma unroll
            for (int i = 0; i < 64; ++i) pv[i] = P[i * 64];
#pragma unroll
            for (int i = 0; i < 64; ++i) {
#pragma unroll
                for (int r = 0; r < 4; ++r) acc[r] += __int_as_float(__builtin_amdgcn_readlane(__float_as_int(s[r]), i)) * pv[i]; }
#pragma unroll
            for (int r = 0; r < 4; ++r) { s[r] = acc[r]; SS[((size_t)chain * NSEG + g + 1) * 4096 + (r0 + r) * 64 + lane] = s[r]; }
        }
    }
}
__device__ __forceinline__ void rwkv_fix2_phase(const Frame& F) {
    unsigned char* ws = WSP(F);
    const float* SS = (const float*)(ws + WS_SS); const float* Q = (const float*)(ws + WS_Q); float* Y = (float*)(ws + WS_H);
    const int lane = F.lane;
    LAS float* ql = (LAS float*)(F.lds + F.wave * 16384);
    for (int item = F.wave * F.G + F.bid; item < 128 * 7 * 4; item += 8 * F.G) {
        const int chain = item / 28, r = item - chain * 28, g = (r >> 2) + 1, qt = r & 3;
        const int hd = chain & 15, e = (chain >> 4) & 1, b = chain >> 5;
        const int tokb = NPR + b * L_S;
        float srow[64];
        { const float* sp = SS + ((size_t)chain * NSEG + g) * 4096 + lane * 64;
#pragma unroll
          for (int j4 = 0; j4 < 16; ++j4) { const f32x4 v = *(const f32x4*)(sp + 4 * j4); srow[4 * j4] = v[0]; srow[4 * j4 + 1] = v[1]; srow[4 * j4 + 2] = v[2]; srow[4 * j4 + 3] = v[3]; } }
        for (int t0 = 0; t0 < 64; t0 += 8) {
            float yv[8];
#pragma unroll
            for (int s = 0; s < 8; ++s) { const int st_ = g * SEG + qt * 64 + t0 + s; const int tau = e ? (L_S - 1 - st_) : st_;
                ql[s * 64 + lane] = Q[((size_t)e * 8192 + (tokb - NPR) + tau) * 1024 + hd * 64 + lane];
                yv[s] = Y[((size_t)e * M + tokb + tau) * 1024 + hd * 64 + lane]; }
            LDS_WAIT(); asm volatile("" ::: "memory");
#pragma unroll
            for (int s = 0; s < 8; ++s) {
                float acc0 = 0.f, acc1 = 0.f;
#pragma unroll
                for (int j4 = 0; j4 < 16; ++j4) { const f32x4 qv = *(const LAS f32x4*)(ql + s * 64 + 4 * j4);
                    acc0 += srow[4 * j4] * qv[0] + srow[4 * j4 + 2] * qv[2]; acc1 += srow[4 * j4 + 1] * qv[1] + srow[4 * j4 + 3] * qv[3]; }
                const int st_ = g * SEG + qt * 64 + t0 + s; const int tau = e ? (L_S - 1 - st_) : st_;
                Y[((size_t)e * M + tokb + tau) * 1024 + hd * 64 + lane] = yv[s] + (acc0 + acc1);
            }
            LDS_WAIT(); asm volatile("" ::: "memory");
        }
    }
}

__device__ __forceinline__ void rwkv_post_phase(const Frame& F, const Args& a, int layer) {
    unsigned char* ws = WSP(F);
    const float* Y = (const float*)(ws + WS_H);
    const bf16* ops = (const bf16*)(ws + WS_OPS); const bf16* gbuf = (const bf16*)(ws + WS_G); const float* bonus = (const float*)(ws + WS_BONUS);
    bf16* oall = (bf16*)(ws + WS_OALL);
    const int lane = F.lane;
    for (int item = F.wave * F.G + F.bid; item < 2048; item += 8 * F.G) {
        const int tok0 = (item >> 2) * 32, cg = item & 3, c4 = cg * 256 + 4 * lane, head = cg * 4 + (lane >> 4), hl = 4 * (lane & 15);
        const f32x4 gng = *(const f32x4*)(INP(F, I_GNG) + layer * 1024 + c4), gnb = *(const f32x4*)(INP(F, I_GNB) + layer * 1024 + c4);
#pragma unroll 1
        for (int ch = 0; ch < 4; ++ch) {
            f32x4 y0[8], y1[8]; u32x2 vw[8], gw[8]; float bn[8];
#pragma unroll
            for (int i = 0; i < 8; ++i) { const size_t tok = (size_t)(tok0 + ch * 8 + i);
                y0[i] = *(const f32x4*)(Y + tok * 1024 + c4); y1[i] = *(const f32x4*)(Y + ((size_t)M + tok) * 1024 + c4);
                vw[i] = *(const u32x2*)(ops + (tok * 16 + head) * 448 + 64 + hl); gw[i] = *(const u32x2*)(gbuf + tok * 1024 + c4); bn[i] = bonus[tok * 16 + head]; }
#pragma unroll
            for (int i = 0; i < 8; ++i) { const size_t tok = (size_t)(tok0 + ch * 8 + i);
                const f32x4 y = y0[i] + y1[i];
                const float mu = row_sum16((y[0] + y[1]) + (y[2] + y[3])) * (1.0f / 64.0f);
                const f32x4 dd = y - mu;
                const float var = row_sum16((dd[0] * dd[0] + dd[1] * dd[1]) + (dd[2] * dd[2] + dd[3] * dd[3])) * (1.0f / 64.0f);
                const f32x4 yn = dd * (1.0f / sqrtf(var + 64e-5f)) * gng + gnb;
                const f32x4 o = (yn + bn[i] * unpack4(vw[i])) * unpack4(gw[i]);
                *(u32x2*)(oall + tok * 3072 + 1024 + c4) = pack4(o);
            }
        }
    }
}

__device__ __forceinline__ void hyena_prep_phase(const Frame& F, const Args& a, int layer) {
    unsigned char* ws = WSP(F);
    const bf16* proj = (const bf16*)(ws + WS_PROJ);
    bf16* zT = (bf16*)(ws + WS_ZT);
    const float* cw = INP(F, I_HCW) + (size_t)layer * 3 * 3072; const float* cb = INP(F, I_HCB) + (size_t)layer * 3072;
    const int gw = F.bid * 8 + F.wave, NGW = F.G * 8, lane = F.lane, tsub = lane >> 4, cq = lane & 15;
    LAS bf16* tl = (LAS bf16*)(F.lds + F.wave * 16384);
    for (int it = gw; it < 256 * 16; it += NGW) {
        const int tt0 = (it >> 4) * 64, c0 = (it & 15) * 64, c4 = c0 + 4 * cq;
        const int t0 = tt0 < NPR ? (tt0 & 255) : ((tt0 - NPR) & 2047), L = tt0 < NPR ? L_P : L_S;
        f32x4 w1[3], w2[3];
#pragma unroll
        for (int tp = 0; tp < 3; ++tp) { w1[tp] = *(const f32x4*)(cw + tp * 3072 + 1024 + c4); w2[tp] = *(const f32x4*)(cw + tp * 3072 + 2048 + c4); }
        const f32x4 b1 = *(const f32x4*)(cb + 1024 + c4), b2 = *(const f32x4*)(cb + 2048 + c4);
        const bf16* px = proj + (size_t)tt0 * NPROJ + COL_X1 + c4;
#pragma unroll 1
        for (int hf = 0; hf < 2; ++hf) {
            u32x2 xr[8][3], vr[8][3];
#pragma unroll
            for (int i = 0; i < 8; ++i) { const int tt = 4 * (hf * 8 + i) + tsub;
#pragma unroll
                for (int d = 0; d < 3; ++d) { const int t = t0 + tt + d - 1; const bool ok = (t >= 0) && (t < L); const bf16* p = px + (long)(tt + d - 1) * NPROJ;
                    xr[i][d] = ok ? *(const u32x2*)p : (u32x2){0u, 0u}; vr[i][d] = ok ? *(const u32x2*)(p + 1024) : (u32x2){0u, 0u}; } }
#pragma unroll
            for (int i = 0; i < 8; ++i) { const int tt = 4 * (hf * 8 + i) + tsub;
                const f32x4 x1c = unpack4(xr[i][0]) * w1[0] + unpack4(xr[i][1]) * w1[1] + unpack4(xr[i][2]) * w1[2] + b1;
                const f32x4 vvc = unpack4(vr[i][0]) * w2[0] + unpack4(vr[i][1]) * w2[1] + unpack4(vr[i][2]) * w2[2] + b2;
                *(LAS u32x2*)(tl + tt * 68 + 4 * cq) = pack4(x1c * vvc); }
        }
        LDS_WAIT(); asm volatile("" ::: "memory");
#pragma unroll 16
        for (int cc = 0; cc < 64; ++cc) zT[(size_t)(c0 + cc) * M + tt0 + lane] = tl[lane * 68 + cc];
        LDS_WAIT(); asm volatile("" ::: "memory");
    }
}

__device__ __forceinline__ void hyena_conv_phase(const Frame& F, const Args& a, int layer) {
    unsigned char* ws = WSP(F);
    bf16* zT = (bf16*)(ws + WS_ZT);
    const float* FNORM = (const float*)(ws + WS_CTL) + CW_FNORM;
    const int lane = F.lane, w = F.wave, r = lane & 31, h = lane >> 5;
    LAS unsigned char* lds = F.lds;
    for (int u = F.bid; u < 2048; u += F.G) {
        const bool sample = u < 1024; const int c = u & 1023;
        const int L = sample ? L_S : L_P, LP = sample ? LPS : LPP, FCS = LP * 2;
        const int ZROW = (L + 448) * 2, ZOFF = 2 * FCS;
        const int NB = sample ? 4 : 32, tokb = sample ? NPR : 0;
        const bf16* fsrc = sample ? (const bf16*)(ws + WS_FS) + ((size_t)layer * 1024 + c) * LPS : (const bf16*)(ws + WS_FP) + ((size_t)layer * 1024 + c) * LPP;
        __syncthreads();
        for (int i = F.tid; i < LP / 8; i += 512) *(LAS u32x4*)(lds + i * 16) = *(const u32x4*)(fsrc + i * 8);
        for (int i = F.tid; i < LP; i += 512) *(LAS bf16*)(lds + FCS + i * 2) = (i + 1 < LP) ? fsrc[i + 1] : (bf16)0;
        { const int cpr = L / 8;
          for (int i = F.tid; i < NB * cpr; i += 512) { const int b = i / cpr, q = i - b * cpr;
              *(LAS u32x4*)(lds + ZOFF + b * ZROW + 448 + q * 16) = *(const u32x4*)(zT + (size_t)c * M + tokb + b * L + q * 8); }
          if (sample) for (int i = F.tid; i < NB * 56; i += 512) { const int b = i / 56, q = i - b * 56;
              *(LAS u32x4*)(lds + ZOFF + b * ZROW + (q < 28 ? q * 16 : 448 + L * 2 + (q - 28) * 16)) = (u32x4){0u, 0u, 0u, 0u}; } }
        __syncthreads();
        const int nbl = sample ? 2 : 5;
        const int I0 = sample ? 8 * w : w;
        const int b = r & (NB - 1), I = I0 + (r >> nbl);
        int dlo = (sample ? I0 - 63 : I0 - 7), dhi = (sample ? I0 + 7 : I0);
        const int dmax = L / 64;
        dlo = dlo < -dmax ? -dmax : dlo; dhi = dhi > dmax ? dmax : dhi;
        f32x16 acc;
#pragma unroll
        for (int i = 0; i < 16; ++i) acc[i] = 0.f;
        const LAS unsigned char* zb = lds + ZOFF + b * ZROW + (224 + 8 * h) * 2;
#pragma unroll 2
        for (int d = dlo; d <= dhi; ++d) {
#pragma unroll
            for (int ks = 0; ks < 2; ++ks) {
                const int st = (L / 2 - 1) - 32 * d - r + 16 * ks + 8 * h + 32;
                const int par = st & 1;
                const LAS unsigned* ap = (const LAS unsigned*)(lds + par * FCS + (st - par) * 2);
                const u32x4 aw = (u32x4){ap[0], ap[1], ap[2], ap[3]};
                const bf16x8 af = __builtin_bit_cast(bf16x8, aw);
                const bf16x8 bfr = *(const LAS bf16x8*)(zb + (32 * (I - d) + 16 * ks) * 2);
                acc = __builtin_amdgcn_mfma_f32_32x32x16_bf16(af, bfr, acc, 0, 0, 0);
            }
        }
        const float inv = 1.0f / (FNORM[((size_t)layer * 2 + (sample ? 0 : 1)) * 1024 + c] + 1e-6f);
        const float dco = INP(F, I_HD)[layer * 1024 + c];
        __syncthreads();
#pragma unroll
        for (int g = 0; g < 4; ++g) {
            const int t = 32 * I + 8 * g + 4 * h;
            const LAS bf16* zp = (const LAS bf16*)(lds + ZOFF + b * ZROW + (224 + t) * 2);
            float o[4];
#pragma unroll
            for (int j = 0; j < 4; ++j) o[j] = acc[4 * g + j] * inv + bf2f(zp[j]) * dco;
            *(u32x2*)(zT + (size_t)c * M + tokb + b * L + t) = (u32x2){cvtpk(o[0], o[1]), cvtpk(o[2], o[3])};
        }
    }
    __syncthreads();
}

__device__ __forceinline__ void hyena_post_phase(const Frame& F, const Args& a, int layer) {
    unsigned char* ws = WSP(F);
    const bf16* proj = (const bf16*)(ws + WS_PROJ);
    const bf16* yT = (const bf16*)(ws + WS_ZT);
    bf16* oall = (bf16*)(ws + WS_OALL);
    const float* cw = INP(F, I_HCW) + (size_t)layer * 3 * 3072; const float* cb = INP(F, I_HCB) + (size_t)layer * 3072;
    const int gw = F.bid * 8 + F.wave, NGW = F.G * 8, lane = F.lane, tsub = lane >> 4, cq = lane & 15;
    LAS bf16* tl = (LAS bf16*)(F.lds + F.wave * 16384);
    for (int it = gw; it < 256 * 16; it += NGW) {
        const int tt0 = (it >> 4) * 64, c0 = (it & 15) * 64, c4 = c0 + 4 * cq;
        const int t0 = tt0 < NPR ? (tt0 & 255) : ((tt0 - NPR) & 2047), L = tt0 < NPR ? L_P : L_S;
#pragma unroll 1
        for (int q = 0; q < 4; ++q) { bf16 tmp[16];
#pragma unroll
            for (int j = 0; j < 16; ++j) tmp[j] = yT[(size_t)(c0 + q * 16 + j) * M + tt0 + lane];
#pragma unroll
            for (int j = 0; j < 16; ++j) tl[(q * 16 + j) * 68 + lane] = tmp[j]; }
        LDS_WAIT(); asm volatile("" ::: "memory");
        f32x4 w0[3];
#pragma unroll
        for (int tp = 0; tp < 3; ++tp) w0[tp] = *(const f32x4*)(cw + tp * 3072 + c4);
        const f32x4 b0 = *(const f32x4*)(cb + c4);
        const bf16* px = proj + (size_t)tt0 * NPROJ + COL_X0 + c4;
#pragma unroll 1
        for (int hf = 0; hf < 2; ++hf) {
            u32x2 xr[8][3];
#pragma unroll
            for (int i = 0; i < 8; ++i) { const int tt = 4 * (hf * 8 + i) + tsub;
#pragma unroll
                for (int d = 0; d < 3; ++d) { const int t = t0 + tt + d - 1; const bool ok = (t >= 0) && (t < L); xr[i][d] = ok ? *(const u32x2*)(px + (long)(tt + d - 1) * NPROJ) : (u32x2){0u, 0u}; } }
#pragma unroll
            for (int i = 0; i < 8; ++i) { const int tt = 4 * (hf * 8 + i) + tsub;
                const f32x4 x0c = unpack4(xr[i][0]) * w0[0] + unpack4(xr[i][1]) * w0[1] + unpack4(xr[i][2]) * w0[2] + b0;
                const f32x4 yv = (f32x4){bf2f(tl[(4 * cq + 0) * 68 + tt]), bf2f(tl[(4 * cq + 1) * 68 + tt]), bf2f(tl[(4 * cq + 2) * 68 + tt]), bf2f(tl[(4 * cq + 3) * 68 + tt])};
                *(u32x2*)(oall + (size_t)(tt0 + tt) * 3072 + 2048 + c4) = pack4(x0c * yv); }
        }
        LDS_WAIT(); asm volatile("" ::: "memory");
    }
}

constexpr int NPL = 13, PH_LAYER0 = 2, PH_FINAL = PH_LAYER0 + DEPTH * NPL, N_PHASES = PH_FINAL + 1;

__global__ void __launch_bounds__(512, 2) mega(Args args) {
    extern __shared__ __attribute__((aligned(16))) unsigned char lds_raw[];
    Frame F;
    F.lds = (LAS unsigned char*)lds_raw;
    F.tid = threadIdx.x; F.lane = F.tid & 63; F.wave = __builtin_amdgcn_readfirstlane(F.tid >> 6);
    F.G = gridDim.x; F.bid = blockIdx.x;
    for (int u = F.tid; u < (LDS_BYTES - LDSCTL_OFF) / 4; u += 512) ((LAS unsigned*)(F.lds + LDSCTL_OFF))[u] = 0u;
    __syncthreads();
    if (F.tid < 48) { const unsigned long long p = F.tid < 46 ? (unsigned long long)args.in[F.tid] : (F.tid == 46 ? (unsigned long long)args.out : (unsigned long long)args.ws);
        ((LAS unsigned*)(F.lds + LDS_ARGT))[2 * F.tid] = (unsigned)p; ((LAS unsigned*)(F.lds + LDS_ARGT))[2 * F.tid + 1] = (unsigned)(p >> 32); }
    __syncthreads();
    unsigned char* ws = WSP(F);
    unsigned* ctl = (unsigned*)(ws + WS_CTL);
    int lo = args.ph_lo, hi = args.ph_hi;
    const bool single = (hi - lo) > 1;
    XcdBarrier bar; bar.bar = ctl + CW_BAR; bar.x = 0; bar.st = (volatile LAS unsigned*)(F.lds + LDSCTL_OFF + 64);
    if (single) bar = xcd_barrier_post(ctl + CW_BAR, (volatile LAS unsigned*)(F.lds + LDSCTL_OFF + 64));
#ifndef MK_EN
#define MK_EN 0xFFFFFF
#endif
#define IN(k) (lo <= (k) && (k) < hi)
#define EN(b) ((MK_EN >> (b)) & 1)
#ifndef MK_DUP
#define MK_DUP -1
#endif
#define REPS(k) ((MK_DUP == (k)) ? 2 : 1)
#define FRESH() asm volatile("" : "+v"(F.tid), "+v"(F.lane), "+s"(F.bid), "+s"(F.wave), "+s"(F.G))
#define SEAM(k) do { if (IN(k) && IN((k) + 1)) xcd_barrier(bar); } while (0)

    if (EN(20) && IN(0)) { for (int rep = 0; rep < REPS(100); ++rep) { FRESH(); prologue0(F, args); if (rep + 1 < REPS(100)) xcd_barrier(bar); } SEAM(0); }
    if (EN(21) && IN(1)) { FRESH(); prologue1(F, args); SEAM(1); }

    bf16* Hb = (bf16*)(ws + WS_H); bf16* proj = (bf16*)(ws + WS_PROJ); bf16* oall = (bf16*)(ws + WS_OALL);
    float* x = OUTP(F);
#pragma unroll 1
    for (int l = 0; l < DEPTH; ++l) {
        const int pb = PH_LAYER0 + l * NPL;
        asm volatile("" : "+s"(lo), "+s"(hi));
        const float* mod = (const float*)(ws + WS_MOD) + (size_t)l * 5 * 12288;
        if (EN(0) && IN(pb + 0)) { for (int rep = 0; rep < REPS(0); ++rep) { FRESH();
            norm_phase(F, l == 0 ? INP(F, I_XP) : x, l == 0 ? INP(F, I_XS) : x + (size_t)NPR * D, l == 0 ? x : nullptr, INP(F, I_LN1) + l * D, mod, 0, 1, Hb);
            if (rep + 1 < REPS(0)) xcd_barrier(bar); }
            SEAM(pb + 0);
        }
        if (EN(1) && IN(pb + 1)) { for (int rep = 0; rep < REPS(1); ++rep) { FRESH();
            pg8::Gemm g{Hb, (const bf16*)(ws + WS_WIN) + (size_t)l * NPROJ * D, D, D, D, 0, 0, 0};
            pg8::Order S; S.init(M, NPROJ, F.G, F.bid, 1);
            pg8::EpiProj E{proj, x + OUT_CK, x + OUT_CV, l};
            pg8::gemm_phase(F.lds, g, S, E);
            if (rep + 1 < REPS(1)) xcd_barrier(bar); }
            SEAM(pb + 1);
        }
        if (EN(2) && IN(pb + 2)) { for (int rep = 0; rep < REPS(2); ++rep) { FRESH();
            pg8::Gemm g{proj + COL_LW, (const bf16*)(ws + WS_W2T) + (size_t)l * 5120 * 256, NPROJ, 256, 256, 0, 128, 4};
            pg8::Order5 S; S.init(M, F.G, F.bid);
            pg8::EpiLora2 E{(float*)(ws + WS_DEC), (bf16*)(ws + WS_A), (bf16*)(ws + WS_G), INP(F, I_W0) + l * 2048, INP(F, I_A0) + l * 2048};
            pg8::gemm_phase(F.lds, g, S, E);
            if (rep + 1 < REPS(2)) xcd_barrier(bar); }
            SEAM(pb + 2);
        }
        if (EN(3) && IN(pb + 3)) { for (int rep = 0; rep < REPS(3); ++rep) { FRESH();
            attention_phase(F, args, l); FRESH();
            hyena_prep_phase(F, args, l); FRESH();
            rwkv_prep_phase(F, args, l);
            if (rep + 1 < REPS(3)) xcd_barrier(bar); }
            SEAM(pb + 3);
        }
        if (EN(4) && IN(pb + 4)) { for (int rep = 0; rep < REPS(4); ++rep) { FRESH(); rwkv_scan_phase(F, args, l); if (rep + 1 < REPS(4)) xcd_barrier(bar); } SEAM(pb + 4); }
        if (EN(5) && IN(pb + 5)) { FRESH(); rwkv_fix1_phase(F); SEAM(pb + 5); }
        if (EN(6) && IN(pb + 6)) { for (int rep = 0; rep < REPS(6); ++rep) { FRESH(); rwkv_fix2_phase(F); FRESH(); hyena_conv_phase(F, args, l); if (rep + 1 < REPS(6)) xcd_barrier(bar); } SEAM(pb + 6); }
        if (EN(7) && IN(pb + 7)) { for (int rep = 0; rep < REPS(7); ++rep) { FRESH(); rwkv_post_phase(F, args, l); FRESH(); hyena_post_phase(F, args, l); if (rep + 1 < REPS(7)) xcd_barrier(bar); } SEAM(pb + 7); }
        if (EN(8) && IN(pb + 8)) { for (int rep = 0; rep < REPS(8); ++rep) { FRESH();
            pg8::Gemm g{oall, (const bf16*)(ws + WS_WP) + (size_t)l * 3 * D * 1024, 3072, 1024, 1024, 1024, 0, 8};
            pg8::Order S; S.init(M, D, F.G, F.bid, 3);
            pg8::EpiMerge E{proj, Hb};
            pg8::gemm_phase(F.lds, g, S, E);
            if (rep + 1 < REPS(8)) xcd_barrier(bar); }
            SEAM(pb + 8);
        }
        if (EN(9) && IN(pb + 9)) { for (int rep = 0; rep < REPS(9); ++rep) { FRESH();
            pg8::Gemm g{Hb, (const bf16*)(ws + WS_WOUT) + (size_t)l * D * D, D, D, D, 0, 0, 0};
            pg8::Order S; S.init(M, D, F.G, F.bid, 1);
            pg8::EpiResid E{x, mod + 2 * D, nullptr};
            pg8::gemm_phase(F.lds, g, S, E);
            if (rep + 1 < REPS(9)) xcd_barrier(bar); }
            SEAM(pb + 9);
        }
        if (EN(10) && IN(pb + 10)) { for (int rep = 0; rep < REPS(10); ++rep) { FRESH(); norm_phase(F, x, x + (size_t)NPR * D, nullptr, INP(F, I_LN2) + l * D, mod, 3, 4, Hb); if (rep + 1 < REPS(10)) xcd_barrier(bar); } SEAM(pb + 10); }
        if (EN(11) && IN(pb + 11)) { for (int rep = 0; rep < REPS(11); ++rep) { FRESH();
            pg8::Gemm g{Hb, (const bf16*)(ws + WS_WFF1) + (size_t)l * D * DFF, D, D, D, 0, 0, 0};
            pg8::Order S; S.init(M, DFF, F.G, F.bid, 1);
            pg8::EpiFF1 E{proj, INP(F, I_BFF1) + l * DFF};
            pg8::gemm_phase(F.lds, g, S, E);
            if (rep + 1 < REPS(11)) xcd_barrier(bar); }
            SEAM(pb + 11);
        }
        if (EN(12) && IN(pb + 12)) { for (int rep = 0; rep < REPS(12); ++rep) { FRESH();
            pg8::Gemm g{proj, (const bf16*)(ws + WS_WFF2) + (size_t)l * D * DFF, DFF, DFF, DFF, 0, 0, 0};
            pg8::Order S; S.init(M, D, F.G, F.bid, 1);
            pg8::EpiResid E{x, mod + 5 * D, INP(F, I_BFF2) + l * D};
            pg8::gemm_phase(F.lds, g, S, E);
            if (rep + 1 < REPS(12)) xcd_barrier(bar); }
            SEAM(pb + 12);
        }
    }
    asm volatile("" : "+s"(lo), "+s"(hi));
    if (EN(22) && IN(PH_FINAL)) { FRESH(); final_norm_phase(F, OUTP(F), INP(F, I_FING)); }
#undef IN
#undef SEAM
}

extern "C" void kernel_launch(void* const* d_in, const int* in_sizes, int n_in, void* d_out, int out_size, void* d_ws, size_t ws_size, hipStream_t stream) {
    static int grid = 0;
    if (grid == 0) {
        if (n_in != N_INPUTS || (size_t)out_size != OUT_TOTAL || ws_size < WS_END) { fprintf(stderr, "kernel_launch: unexpected shapes: n_in %d out %d ws %zu\n", n_in, out_size, ws_size); grid = -1; return; }
        int dev = 0, cus = 0, per_cu = 0;
        if (hipGetDevice(&dev) != hipSuccess || hipDeviceGetAttribute(&cus, hipDeviceAttributeMultiprocessorCount, dev) != hipSuccess) { grid = -1; return; }
        if (hipFuncSetAttribute((const void*)mega, hipFuncAttributeMaxDynamicSharedMemorySize, LDS_BYTES) != hipSuccess) { fprintf(stderr, "kernel_launch: hipFuncSetAttribute failed\n"); grid = -1; return; }
        if (hipOccupancyMaxActiveBlocksPerMultiprocessor(&per_cu, (const void*)mega, 512, LDS_BYTES) != hipSuccess || per_cu < 1) { fprintf(stderr, "kernel_launch: occupancy query says %d\n", per_cu); }
        (void)hipGetLastError();
        grid = cus;
    }
    if (grid < 0) return;
    (void)hipMemsetAsync((char*)d_ws + WS_CTL, 0, CTL_ZERO_BYTES, stream);
    Args a{};
    for (int i = 0; i < N_INPUTS; ++i) a.in[i] = (const float*)d_in[i];
    a.out = (float*)d_out; a.ws = (unsigned char*)d_ws;
#if MK_MULTI
    for (int ph = 0; ph < N_PHASES; ++ph) { a.ph_lo = ph; a.ph_hi = ph + 1; hipLaunchKernelGGL(mega, dim3(grid), dim3(512), LDS_BYTES, stream, a); }
#else
    a.ph_lo = 0; a.ph_hi = N_PHASES;
    hipLaunchKernelGGL(mega, dim3(grid), dim3(512), LDS_BYTES, stream, a);
#endif
    const hipError_t le = hipPeekAtLastError();
    if (le != hipSuccess) fprintf(stderr, "kernel_launch: launch failed: %s\n", hipGetErrorName(le));
}
```

```cpp
#include <hip/hip_runtime.h>
#include <cstdio>
#include <cstdint>

#ifndef MK_MULTI
#define MK_MULTI 0
#endif

#define GAS __attribute__((address_space(1)))
#define LAS __attribute__((address_space(3)))
typedef unsigned short bf16;
typedef short bf16x8 __attribute__((ext_vector_type(8)));
typedef short s16x4 __attribute__((ext_vector_type(4)));
typedef float f32x4 __attribute__((ext_vector_type(4)));
typedef float f32x2 __attribute__((ext_vector_type(2)));
typedef float f32x16 __attribute__((ext_vector_type(16)));
typedef unsigned u32x4 __attribute__((ext_vector_type(4)));
typedef unsigned u32x2 __attribute__((ext_vector_type(2)));
typedef __bf16 bf16x2_t __attribute__((ext_vector_type(2)));

constexpr int D = 2048, DEPTH = 4, NPR = 8192  , M = 16384, DFF = 8192;
constexpr int NPROJ = 15872;
constexpr int COL_K = 1024, COL_V = 2048, COL_R = 3072, COL_X0 = 6144, COL_X1 = 7168, COL_VV = 8192, COL_GL = 9216, COL_LW = 15360, COL_G1A = 15488;
constexpr int L_P = 256, L_S = 2048;

enum { I_XP = 0, I_XS, I_CK, I_CV, I_ST, I_C, I_CCTX, I_LN1, I_LN2, I_WMOD, I_BMOD, I_WIN, I_RPB, I_CW, I_CB, I_W0, I_W1, I_W2, I_A0, I_A1, I_A2, I_G1, I_G2,
       I_KK, I_KA, I_RK, I_GNG, I_GNB, I_HCW, I_HCB, I_F1, I_FB1, I_F2, I_FB2, I_FREQ, I_F3, I_HD, I_WPA, I_WPR, I_WPC, I_WOUT, I_FF1, I_BFF1, I_FF2, I_BFF2, I_FING, N_INPUTS };

constexpr size_t OUT_X = 0, OUT_CK = 33554432, OUT_CV = 67108864, OUT_ST = 100663296, OUT_TOTAL = 117440512;

constexpr size_t MiB = 1u << 20;
constexpr size_t WS_CTL = 0, CTL_ZERO_BYTES = 1 * MiB;
constexpr size_t WS_WIN = 2 * MiB;
constexpr size_t WS_W2T = 250 * MiB;
constexpr size_t WS_WP = 260 * MiB;
constexpr size_t WS_WOUT = 308 * MiB;
constexpr size_t WS_WFF1 = 340 * MiB;
constexpr size_t WS_WFF2 = 468 * MiB;
constexpr size_t WS_H = 596 * MiB;
constexpr size_t WS_A = 660 * MiB;
constexpr size_t WS_PROJ = 724 * MiB;
constexpr size_t WS_OALL = 1220 * MiB;
constexpr size_t WS_DEC = 1316 * MiB;
constexpr size_t WS_G = 1444 * MiB;
constexpr size_t WS_TIL = 1476 * MiB;
constexpr size_t WS_CK = 1764 * MiB;
constexpr size_t WS_CV = 1772 * MiB;
constexpr size_t WS_FS = 1780 * MiB;
constexpr size_t WS_FP = 1797 * MiB;
constexpr size_t WS_ZT = 1800 * MiB;
constexpr size_t WS_MOD = 1832 * MiB;
constexpr size_t WS_T2 = 1833 * MiB;
constexpr size_t WS_BONUS = 1837 * MiB;
constexpr size_t WS_TINV = 1838 * MiB;
constexpr size_t WS_Q = WS_TINV;
constexpr size_t WS_WTB = 1870 * MiB;
constexpr size_t WS_END = 1874 * MiB;
constexpr int TILP = 576;
constexpr int LPS = 2120, LPP = 328;

constexpr int CW_BAR = 4096;
constexpr int CW_FNORM = 32768;

constexpr int LDS_SCRATCH = 131072, LDSCTL_OFF = 131072, LDS_BYTES = 147456;

#define LDS_WAIT() asm volatile("s_waitcnt lgkmcnt(0)" ::: "memory")
#define VM_WAIT() asm volatile("s_waitcnt vmcnt(0)" ::: "memory")
__device__ __forceinline__ unsigned cvtpk(float lo, float hi) { f32x2 v = {lo, hi}; bf16x2_t b = __builtin_convertvector(v, bf16x2_t); return __builtin_bit_cast(unsigned, b); }
__device__ __forceinline__ bf16 f2bf(float f) { return (bf16)(cvtpk(f, 0.f) & 0xffffu); }
__device__ __forceinline__ float bf2f(bf16 b) { return __uint_as_float(((unsigned)b) << 16); }
__device__ __forceinline__ float bflo(unsigned w) { return __uint_as_float(w << 16); }
__device__ __forceinline__ float bfhi(unsigned w) { return __uint_as_float(w & 0xffff0000u); }
#define DPPF(v, ctrl) __int_as_float(__builtin_amdgcn_update_dpp(0, __float_as_int(v), (ctrl), 0xf, 0xf, false))
__device__ __forceinline__ float wave_sum(float v) {
    v += DPPF(v, 0xB1); v += DPPF(v, 0x4E); v += DPPF(v, 0x141); v += DPPF(v, 0x140);
    const float a = __int_as_float(__builtin_amdgcn_readlane(__float_as_int(v), 0)), b = __int_as_float(__builtin_amdgcn_readlane(__float_as_int(v), 16)),
                c = __int_as_float(__builtin_amdgcn_readlane(__float_as_int(v), 32)), d = __int_as_float(__builtin_amdgcn_readlane(__float_as_int(v), 48));
    return (a + b) + (c + d);
}
__device__ __forceinline__ float xor32(float v, int lane) { return __int_as_float(__builtin_amdgcn_ds_bpermute((lane ^ 32) << 2, __float_as_int(v))); }
__device__ __forceinline__ int lane_id() { return (int)__builtin_amdgcn_mbcnt_hi(~0u, __builtin_amdgcn_mbcnt_lo(~0u, 0u)); }
__device__ __forceinline__ float sigmoidf_(float x) { return 1.0f / (1.0f + __expf(-x)); }

#define XB_TMO      128
#define XB_XCNT(j)  (256  + 64 * (j))
#define XB_XSUB(j)  (1280 + 64 * (j))
#define XB_XGEN(j)  (2304 + 64 * (j))
#define XB_TOP      3328
#define XB_TOPGEN   3392
#define XCD_BAR_WORDS 3456
#define XB_SPIN_CAP (1u << 20)
__device__ __forceinline__ unsigned xb_ld(unsigned* p)              { return __hip_atomic_load(p, __ATOMIC_RELAXED, __HIP_MEMORY_SCOPE_AGENT); }
__device__ __forceinline__ unsigned xb_add(unsigned* p, unsigned v) { return __hip_atomic_fetch_add(p, v, __ATOMIC_RELAXED, __HIP_MEMORY_SCOPE_AGENT); }
__device__ __forceinline__ unsigned xb_xcc_id() { return (unsigned)__builtin_amdgcn_s_getreg((3 << 11) | 20) & 0xFu; }
#define XB_SPIN(cond, bar) do { unsigned _sp = 0; while (cond) { __builtin_amdgcn_s_sleep(1); \
    if ((++_sp & 255u) == 0u) { if (xb_ld(&(bar)[XB_TMO])) break; if (_sp > XB_SPIN_CAP) { atomicAdd(&(bar)[XB_TMO], 1u); break; } } } } while (0)
struct XcdBarrier { unsigned* bar; unsigned x; volatile LAS unsigned* st; };
__device__ __forceinline__ XcdBarrier xcd_barrier_post(unsigned* bar, volatile LAS unsigned* st) {
    XcdBarrier b; b.bar = bar; b.x = xb_xcc_id(); b.st = st;
    if (threadIdx.x == 0) (void)xb_add(&bar[XB_XCNT(b.x)], 1u);
    return b;
}
__device__ __forceinline__ void xcd_barrier_complete(unsigned* bar, unsigned x, unsigned& nloc, unsigned& nx) {
    const unsigned G = gridDim.x * gridDim.y * gridDim.z;
    unsigned sum, cnt, mine, sp = 0u;
    for (;;) {
        sum = 0u; cnt = 0u; mine = 0u;
#pragma unroll
        for (unsigned j = 0; j < 16; ++j) { const unsigned c = xb_ld(&bar[XB_XCNT(j)]); sum += c; cnt += (c > 0u) ? 1u : 0u; mine = (j == x) ? c : mine; }
        if (sum == G) break;
        __builtin_amdgcn_s_sleep(1);
        if ((++sp & 255u) == 0u) { if (xb_ld(&bar[XB_TMO])) break; if (sp > XB_SPIN_CAP) { atomicAdd(&bar[XB_TMO], 1u); break; } }
    }
    nloc = mine > 0u ? mine : 1u; nx = cnt > 0u ? cnt : 1u;
}
__device__ __forceinline__ void xcd_barrier(const XcdBarrier& b) {
    asm volatile("s_waitcnt vmcnt(0)" ::: "memory");
    __syncthreads();
    if (threadIdx.x == 0) {
        unsigned* bar = b.bar; asm volatile("" : "+s"(bar));
        __builtin_amdgcn_s_waitcnt(0);
        unsigned nloc = b.st[0], nx = b.st[1];
        if (nloc == 0u) { xcd_barrier_complete(bar, b.x, nloc, nx); b.st[0] = nloc; b.st[1] = nx; }
        const unsigned old = xb_add(&bar[XB_XSUB(b.x)], 1u);
        const unsigned gen = old / nloc;
        if (old + 1u == (gen + 1u) * nloc) {
            __builtin_amdgcn_fence(__ATOMIC_RELEASE, "agent");
            asm volatile("s_waitcnt vmcnt(0)" ::: "memory");
            const unsigned og = xb_add(&bar[XB_TOP], 1u);
            const unsigned tg = og / nx;
            if (og + 1u == (tg + 1u) * nx) xb_add(&bar[XB_TOPGEN], 1u);
            else XB_SPIN(xb_ld(&bar[XB_TOPGEN]) == tg, bar);
            __builtin_amdgcn_fence(__ATOMIC_ACQUIRE, "agent");
            xb_add(&bar[XB_XGEN(b.x)], 1u);
            asm volatile("s_waitcnt vmcnt(0)" ::: "memory");
        } else {
            XB_SPIN(xb_ld(&bar[XB_XGEN(b.x)]) == gen, bar);
            __builtin_amdgcn_fence(__ATOMIC_ACQUIRE, "agent");
            asm volatile("s_waitcnt vmcnt(0)" ::: "memory");
        }
    }
    __syncthreads();
}

struct Args { const float* in[N_INPUTS]; float* out; unsigned char* ws; int ph_lo, ph_hi; };
struct Frame {
    LAS unsigned char* lds;
    int tid, lane, wave, G, bid;
};
constexpr int LDS_ARGT = 131072 + 1024;
__device__ __forceinline__ const float* INP(const Frame& F, int k) {
    const LAS unsigned* t = (const LAS unsigned*)(F.lds + LDS_ARGT) + 2 * k;
    const unsigned lo = __builtin_amdgcn_readfirstlane(t[0]), hi = __builtin_amdgcn_readfirstlane(t[1]);
    return (const float*)(((unsigned long long)hi << 32) | lo);
}
__device__ __forceinline__ float* OUTP(const Frame& F) { return (float*)INP(F, 46); }
__device__ __forceinline__ unsigned char* WSP(const Frame& F) { return (unsigned char*)INP(F, 47); }

namespace pg8 {
constexpr int BM = 256, BK = 64, HALF = 128, HTB = HALF * BK * 2, STAGE_BYTES = 8 * HTB, NXCD = 8, WGM = 8;
__host__ __device__ __forceinline__ int lds_byte(int r, int c) { const int st = (r >> 4) * 2 + (c >> 5), rr = r & 15, cc = c & 31, ob = rr * 64 + cc * 2; return st * 1024 + (ob ^ (((ob >> 9) & 1) << 5)); }
__host__ __device__ __forceinline__ void stage_rc(int b, int& R, int& C) { const int st = b / 1024, sb = b % 1024, swz = sb ^ (((sb >> 9) & 1) << 5); R = (st >> 1) * 16 + swz / 64; C = (st & 1) * 32 + (swz % 64) / 2; }
__host__ __device__ __forceinline__ int perm32(int rho) { const int n = rho >> 4, i = rho & 15; return 8 * (i >> 2) + 4 * n + (i & 3); }

struct Unit { int pm, pn, br; };
struct Gemm { const bf16* A; const bf16* Bt; int lda, ldb, K; int a_br_stride  , a_br4_off  , b_br_tiles  ; };

struct Order {
    int nM, nN, nwg, G, c, nbr;
    __device__ void init(int Mrows, int N, int G_, int c_, int nbr_) { nM = Mrows / BM; nN = N / BM; nwg = nM * nN; G = G_; c = c_; nbr = nbr_; }
    __device__ bool next(int i, Unit& u) const {
        const int it = i / nbr; u.br = i - it * nbr;
        const long L = (long)it * G + c; if (L >= nwg) return false;
        int wgid = (int)L; { const int q = nwg / NXCD, r = nwg % NXCD, xcd = wgid % NXCD, off = wgid / NXCD; wgid = (xcd < r ? xcd * (q + 1) : r * (q + 1) + (xcd - r) * q) + off; }
        const int nig = WGM * nN, gid = wgid / nig, fm = gid * WGM, gsz = (nM - fm) < WGM ? (nM - fm) : WGM;
        u.pm = fm + ((wgid % nig) % gsz); u.pn = (wgid % nig) / gsz; return true;
    }
};
struct Order5 {
    Order o;
    __device__ void init(int Mrows, int G_, int c_) { o.init(Mrows, 20 * BM, G_, c_, 1); }
    __device__ bool next(int i, Unit& u) const { if (!o.next(i, u)) return false; u.br = u.pn >> 2; u.pn &= 3; return true; }
};

template <class Epi, class Sched>
__device__ __forceinline__ void gemm_phase(LAS unsigned char* lds, const Gemm g, const Sched& S, const Epi& E, int wave) {
    int tid = wave * 64 + lane_id(); asm volatile("" : "+v"(tid));
    const int wid = __builtin_amdgcn_readfirstlane(tid >> 6), lane = tid & 63, wr = wid >> 2, wc = wid & 3, fr = lane & 15, fq = lane >> 4;
    const int K = g.K, nt = K / BK;
    unsigned voffA[2], voffB[2];
#pragma unroll
    for (int i = 0; i < 2; ++i) { int R, C; stage_rc(tid * 16 + i * 8192, R, C); const int Rb = Epi::PERM ? ((R & ~31) + perm32(R & 31)) : R;
        voffA[i] = (unsigned)(R * g.lda + C) * 2u; voffB[i] = (unsigned)(Rb * g.ldb + C) * 2u; }
    const size_t kstep = (size_t)(BK * 2);
    const size_t hstepA = (size_t)HALF * g.lda * 2, hstepB = (size_t)HALF * g.ldb * 2;
    const unsigned ldsw = (unsigned)wid * 1024u;
    const int aoff = lds_byte(wr * 64 + fr, fq * 8), boff = lds_byte(wc * 32 + fr, fq * 8);
#define PG8_APTR(u) ((const char*)g.A + ((size_t)(u).pm * 256 * g.lda + (size_t)(u).br * g.a_br_stride + ((u).br == 4 ? g.a_br4_off : 0)) * 2)
#define PG8_BPTR(u) ((const char*)g.Bt + ((size_t)((u).br * g.b_br_tiles + (u).pn) * 256 * g.ldb) * 2)
#define PG8_SA(b, h) (((b) * 2 + (h)) * HTB)
#define PG8_SB(b, h) ((4 + (b) * 2 + (h)) * HTB)
#define PG8_STAGE(bufoff, gbase, voff) do { _Pragma("unroll") for (int _i = 0; _i < 2; ++_i) \
        __builtin_amdgcn_global_load_lds((const unsigned*)((const char*)(gbase) + (voff)[_i]), (LAS unsigned*)(lds + (bufoff) + ldsw + _i * 8192), 16, 0, 0); } while (0)
#define PG8_LDA(dst, b, h) do { _Pragma("unroll") for (int m = 0; m < 4; ++m) _Pragma("unroll") for (int k = 0; k < 2; ++k) dst[m][k] = *(const LAS bf16x8*)(lds + PG8_SA(b, h) + aoff + m * 2048 + k * 1024); } while (0)
#define PG8_LDB(dst, b, h) do { _Pragma("unroll") for (int n = 0; n < 2; ++n) _Pragma("unroll") for (int k = 0; k < 2; ++k) dst[n][k] = *(const LAS bf16x8*)(lds + PG8_SB(b, h) + boff + n * 2048 + k * 1024); } while (0)
#define PG8_MMA(ai, bj, At, Bt) do { __builtin_amdgcn_s_setprio(1); _Pragma("unroll") for (int m = 0; m < 4; ++m) _Pragma("unroll") for (int n = 0; n < 2; ++n) _Pragma("unroll") for (int k = 0; k < 2; ++k) \
        acc[ai][bj][m][n] = __builtin_amdgcn_mfma_f32_16x16x32_bf16(Bt[n][k], At[m][k], acc[ai][bj][m][n], 0, 0, 0); __builtin_amdgcn_s_setprio(0); } while (0)
#define PG8_WAIT_V(n) asm volatile("s_waitcnt vmcnt(" #n ")" ::: "memory")
#define PG8_WAIT_L(n) asm volatile("s_waitcnt lgkmcnt(" #n ")" ::: "memory")
#define PG8_BAR __builtin_amdgcn_s_barrier()
#define PG8_SCHED __builtin_amdgcn_sched_barrier(0)
    Unit cur, nxt; int ui = 0;
    if (!S.next(0, cur)) return;
    f32x4 acc[2][2][4][2];
#pragma unroll
    for (int a = 0; a < 2; ++a)
#pragma unroll
        for (int b = 0; b < 2; ++b)
#pragma unroll
            for (int m = 0; m < 4; ++m)
#pragma unroll
                for (int n = 0; n < 2; ++n) acc[a][b][m][n] = (f32x4){0.f, 0.f, 0.f, 0.f};
    bf16x8 At[4][2], B0[2][2], B1[2][2];
    const char* cA = PG8_APTR(cur); const char* cB = PG8_BPTR(cur);
    PG8_STAGE(PG8_SB(0, 0), cB, voffB); PG8_STAGE(PG8_SB(0, 1), cB + hstepB, voffB); PG8_STAGE(PG8_SA(0, 0), cA, voffA); PG8_STAGE(PG8_SA(0, 1), cA + hstepA, voffA);
    if (wr == 1) PG8_BAR;
    PG8_WAIT_V(2); PG8_BAR;
    PG8_STAGE(PG8_SB(1, 0), cB + kstep, voffB); PG8_STAGE(PG8_SA(1, 0), cA + kstep, voffA); PG8_STAGE(PG8_SB(1, 1), cB + hstepB + kstep, voffB);
    PG8_WAIT_V(6); PG8_BAR;
    for (;;) {
        const bool has_next = S.next(ui + 1, nxt);
        const char* nA = has_next ? PG8_APTR(nxt) : cA; const char* nB = has_next ? PG8_BPTR(nxt) : cB;
#pragma unroll 1
        for (int t = 0; t < nt; t += 2) {
            const bool last = (t == nt - 2);
            const char* a1 = cA + (size_t)(t + 1) * kstep;
            const char* a2 = last ? nA : cA + (size_t)(t + 2) * kstep; const char* b2 = last ? nB : cB + (size_t)(t + 2) * kstep;
            const char* a3 = a2 + kstep; const char* b3 = b2 + kstep;
            PG8_LDB(B0, 0, 0); PG8_LDB(B1, 0, 1); PG8_SCHED; PG8_LDA(At, 0, 0); PG8_STAGE(PG8_SA(1, 1), a1 + hstepA, voffA);
            PG8_WAIT_V(8); PG8_WAIT_L(0); PG8_BAR; PG8_MMA(0, 0, At, B0); PG8_MMA(0, 1, At, B1); PG8_BAR; PG8_SCHED;
            PG8_LDA(At, 0, 1); PG8_STAGE(PG8_SB(0, 0), b2, voffB); PG8_STAGE(PG8_SB(0, 1), b2 + hstepB, voffB); PG8_STAGE(PG8_SA(0, 0), a2, voffA);
            PG8_WAIT_V(8); PG8_WAIT_L(0); PG8_BAR; PG8_MMA(1, 0, At, B0); PG8_MMA(1, 1, At, B1); PG8_BAR; PG8_SCHED;
            PG8_LDB(B0, 1, 0); PG8_LDB(B1, 1, 1); PG8_SCHED; PG8_LDA(At, 1, 0); PG8_STAGE(PG8_SA(0, 1), a2 + hstepA, voffA);
            PG8_WAIT_V(8); PG8_WAIT_L(0); PG8_BAR; PG8_MMA(0, 0, At, B0); PG8_MMA(0, 1, At, B1); PG8_BAR; PG8_SCHED;
            PG8_LDA(At, 1, 1); PG8_STAGE(PG8_SB(1, 0), b3, voffB); PG8_STAGE(PG8_SB(1, 1), b3 + hstepB, voffB); PG8_STAGE(PG8_SA(1, 0), a3, voffA);
            PG8_WAIT_V(8); PG8_WAIT_L(0); PG8_BAR; PG8_MMA(1, 0, At, B0); PG8_MMA(1, 1, At, B1); PG8_BAR; PG8_SCHED;
        }
        if (wr == 0) PG8_BAR;
        E(acc, cur, wr, wc, fr, fq);
        if (!has_next) break;
#pragma unroll
        for (int a = 0; a < 2; ++a)
#pragma unroll
            for (int b = 0; b < 2; ++b)
#pragma unroll
                for (int m = 0; m < 4; ++m)
#pragma unroll
                    for (int n = 0; n < 2; ++n) acc[a][b][m][n] = (f32x4){0.f, 0.f, 0.f, 0.f};
        cur = nxt; cA = nA; cB = nB; ++ui;
        if (wr == 1) PG8_BAR;
    }
    PG8_WAIT_V(0);
    PG8_BAR;
#undef PG8_APTR
#undef PG8_BPTR
#undef PG8_SA
#undef PG8_SB
#undef PG8_STAGE
#undef PG8_LDA
#undef PG8_LDB
#undef PG8_MMA
#undef PG8_WAIT_V
#undef PG8_WAIT_L
#undef PG8_BAR
#undef PG8_SCHED
}

__device__ __forceinline__ float mrow_sel(int row) { return 0.f; }
__device__ __forceinline__ int modrow(int row) { return row < NPR ? 0 : 1 + ((row - NPR) >> 11); }

struct EpiProj {
    static constexpr bool PERM = true;
    bf16* proj; float* outk; float* outv; int layer;
    __device__ __forceinline__ void operator()(const f32x4 (&acc)[2][2][4][2], const Unit& u, int wr, int wc, int fr, int fq) const {
        { int t_ = lane_id(); asm volatile("" : "+v"(t_)); fr = t_ & 15; fq = (t_ >> 4) & 3; }
        const int row0 = u.pm * BM + wr * 64 + fr, colb = u.pn * BM + wc * 32 + 8 * fq;
        const int mode = (u.pn == 60) ? 1 : (u.pn == 61 ? 2 : ((u.pn >= 36) ? 3 : 0));
        const bool kv = (u.pm < 32) && (u.pn >= 4) && (u.pn < 12);
#pragma unroll
        for (int ai = 0; ai < 2; ++ai)
#pragma unroll
            for (int m = 0; m < 4; ++m) {
                const int row = row0 + ai * HALF + m * 16;
                bf16* rowp = proj + (size_t)row * NPROJ + colb;
#pragma unroll
                for (int bj = 0; bj < 2; ++bj) {
                    f32x4 v0 = acc[ai][bj][m][0], v1 = acc[ai][bj][m][1];
                    if (mode == 1) { if (colb + bj * HALF < COL_G1A) {
#pragma unroll
                        for (int j = 0; j < 4; ++j) { v0[j] = tanhf(v0[j]); v1[j] = tanhf(v1[j]); } } }
                    else if (mode == 3) {
#pragma unroll
                        for (int j = 0; j < 4; ++j) { v0[j] = sigmoidf_(v0[j]); v1[j] = sigmoidf_(v1[j]); } }
                    else if (mode == 2) { const bool act = (colb + bj * HALF) < 15744;
#pragma unroll
                        for (int j = 0; j < 4; ++j) { v0[j] = act ? sigmoidf_(v0[j]) : 0.f; v1[j] = act ? sigmoidf_(v1[j]) : 0.f; } }
                    u32x4 w; w.x = cvtpk(v0[0], v0[1]); w.y = cvtpk(v0[2], v0[3]); w.z = cvtpk(v1[0], v1[1]); w.w = cvtpk(v1[2], v1[3]);
                    *(u32x4*)(rowp + bj * HALF) = w;
                    if (kv) { const int col = colb + bj * HALF; float* ob = (u.pn < 8) ? outk : outv; const int ch = col - ((u.pn < 8) ? COL_K : COL_V);
                        float* dst = ob + ((size_t)(((row >> 8) * 4 + layer) * 256 + (row & 255))) * 1024 + ch;
                        *(f32x4*)dst = v0; *(f32x4*)(dst + 4) = v1; }
                }
            }
    }
};
struct EpiLora2 {
    static constexpr bool PERM = true;
    float* dec; bf16* abuf; bf16* gbuf; const float* w0; const float* a0;
    __device__ __forceinline__ void operator()(const f32x4 (&acc)[2][2][4][2], const Unit& u, int wr, int wc, int fr, int fq) const {
        { int t_ = lane_id(); asm volatile("" : "+v"(t_)); fr = t_ & 15; fq = (t_ >> 4) & 3; }
        const int row0 = u.pm * BM + wr * 64 + fr, colb = u.pn * BM + wc * 32 + 8 * fq;
        const int br = u.br, e = br & 1;
        const float* bsrc = (br < 2) ? w0 + e * 1024 : a0 + e * 1024;
#pragma unroll
        for (int bj = 0; bj < 2; ++bj)
#pragma unroll
            for (int n = 0; n < 2; ++n) {
                const int ch = colb + bj * HALF + 4 * n;
                f32x4 b0 = (f32x4){0.f, 0.f, 0.f, 0.f};
                if (br < 4) b0 = *(const f32x4*)(bsrc + ch);
#pragma unroll
                for (int ai = 0; ai < 2; ++ai)
#pragma unroll
                    for (int m = 0; m < 4; ++m) {
                        const int row = row0 + ai * HALF + m * 16;
                        f32x4 v0 = acc[ai][bj][m][n] + b0;
                        if (br < 2) {
#pragma unroll
                            for (int j = 0; j < 4; ++j) v0[j] = -0.6065306597126334f * sigmoidf_(v0[j]);
                            *(f32x4*)(dec + ((size_t)row * 2 + e) * 1024 + ch) = v0;
                        } else {
                            if (br < 4) {
#pragma unroll
                                for (int j = 0; j < 4; ++j) v0[j] = sigmoidf_(v0[j]); }
                            bf16* dst = (br < 4) ? abuf + ((size_t)row * 2 + e) * 1024 + ch : gbuf + (size_t)row * 1024 + ch;
                            *(u32x2*)dst = (u32x2){cvtpk(v0[0], v0[1]), cvtpk(v0[2], v0[3])};
                        }
                        __builtin_amdgcn_sched_barrier(0);
                    }
            }
    }
};
struct EpiMerge {
    static constexpr bool PERM = true;
    const bf16* proj; bf16* merged;
    __device__ __forceinline__ void operator()(const f32x4 (&acc)[2][2][4][2], const Unit& u, int wr, int wc, int fr, int fq) const {
        { int t_ = lane_id(); asm volatile("" : "+v"(t_)); fr = t_ & 15; fq = (t_ >> 4) & 3; }
        const int row0 = u.pm * BM + wr * 64 + fr, colb = u.pn * BM + wc * 32 + 8 * fq;
        const int br = u.br;
#pragma unroll
        for (int ai = 0; ai < 2; ++ai)
#pragma unroll
            for (int m = 0; m < 4; ++m) {
                const int row = row0 + ai * HALF + m * 16;
#pragma unroll
                for (int bj = 0; bj < 2; ++bj) {
                    const int col = colb + bj * HALF;
                    const u32x4 gw = *(const u32x4*)(proj + (size_t)row * NPROJ + COL_GL + br * 2048 + col);
                    bf16* dst = merged + (size_t)row * D + col;
                    f32x4 v0 = acc[ai][bj][m][0], v1 = acc[ai][bj][m][1];
                    v0[0] *= bflo(gw.x); v0[1] *= bfhi(gw.x); v0[2] *= bflo(gw.y); v0[3] *= bfhi(gw.y);
                    v1[0] *= bflo(gw.z); v1[1] *= bfhi(gw.z); v1[2] *= bflo(gw.w); v1[3] *= bfhi(gw.w);
                    if (br > 0) { const u32x4 pw = *(const u32x4*)dst;
                        v0[0] += bflo(pw.x); v0[1] += bfhi(pw.x); v0[2] += bflo(pw.y); v0[3] += bfhi(pw.y);
                        v1[0] += bflo(pw.z); v1[1] += bfhi(pw.z); v1[2] += bflo(pw.w); v1[3] += bfhi(pw.w); }
                    u32x4 w; w.x = cvtpk(v0[0], v0[1]); w.y = cvtpk(v0[2], v0[3]); w.z = cvtpk(v1[0], v1[1]); w.w = cvtpk(v1[2], v1[3]);
                    *(u32x4*)dst = w;
                }
            }
    }
};
struct EpiResid {
    static constexpr bool PERM = false;
    float* x; const float* gate;   const float* bias;
    __device__ __forceinline__ void operator()(const f32x4 (&acc)[2][2][4][2], const Unit& u, int wr, int wc, int fr, int fq) const {
        { int t_ = lane_id(); asm volatile("" : "+v"(t_)); fr = t_ & 15; fq = (t_ >> 4) & 3; }
        const int row0 = u.pm * BM + wr * 64 + fr, col0 = u.pn * BM + wc * 32 + 4 * fq;
        const int mr = modrow(u.pm * BM);
        const float* gp = gate + (size_t)mr * 12288;
        f32x4 gv[2][2], bv[2][2];
#pragma unroll
        for (int bj = 0; bj < 2; ++bj)
#pragma unroll
            for (int n = 0; n < 2; ++n) { gv[bj][n] = *(const f32x4*)(gp + col0 + bj * HALF + n * 16);
                bv[bj][n] = bias ? *(const f32x4*)(bias + col0 + bj * HALF + n * 16) : (f32x4){0.f, 0.f, 0.f, 0.f}; }
#pragma unroll
        for (int ai = 0; ai < 2; ++ai)
#pragma unroll
            for (int m = 0; m < 4; ++m) { float* rowp = x + (size_t)(row0 + ai * HALF + m * 16) * D + col0;
#pragma unroll
                for (int bj = 0; bj < 2; ++bj)
#pragma unroll
                    for (int n = 0; n < 2; ++n) { f32x4* p = (f32x4*)(rowp + bj * HALF + n * 16); const f32x4 xo = *p; *p = xo + gv[bj][n] * (acc[ai][bj][m][n] + bv[bj][n]); }
                asm volatile("" ::: "memory"); }
    }
};
struct EpiFF1 {
    static constexpr bool PERM = true;
    bf16* U; const float* bias;
    __device__ __forceinline__ void operator()(const f32x4 (&acc)[2][2][4][2], const Unit& u, int wr, int wc, int fr, int fq) const {
        { int t_ = lane_id(); asm volatile("" : "+v"(t_)); fr = t_ & 15; fq = (t_ >> 4) & 3; }
        const int row0 = u.pm * BM + wr * 64 + fr, colb = u.pn * BM + wc * 32 + 8 * fq;
        f32x4 bv[2][2];
#pragma unroll
        for (int bj = 0; bj < 2; ++bj)
#pragma unroll
            for (int n = 0; n < 2; ++n) bv[bj][n] = *(const f32x4*)(bias + colb + bj * HALF + 4 * n);
#pragma unroll
        for (int ai = 0; ai < 2; ++ai)
#pragma unroll
            for (int m = 0; m < 4; ++m) { bf16* rowp = U + (size_t)(row0 + ai * HALF + m * 16) * DFF + colb;
#pragma unroll
                for (int bj = 0; bj < 2; ++bj) { f32x4 v0 = acc[ai][bj][m][0] + bv[bj][0], v1 = acc[ai][bj][m][1] + bv[bj][1];
#pragma unroll
                    for (int j = 0; j < 4; ++j) { const float a = fmaxf(v0[j], 0.f), b = fmaxf(v1[j], 0.f); v0[j] = a * a; v1[j] = b * b; }
                    u32x4 w; w.x = cvtpk(v0[0], v0[1]); w.y = cvtpk(v0[2], v0[3]); w.z = cvtpk(v1[0], v1[1]); w.w = cvtpk(v1[2], v1[3]);
                    *(u32x4*)(rowp + bj * HALF) = w; } }
    }
};
}

__device__ __forceinline__ void transpose_item(const float* W, int K, int N, bf16* WT, int ldk, int row_off, LAS bf16* scr, int item, int lane) {
    const int nblk = N / 64, kb = item / nblk, nb = item % nblk, k0 = 64 * kb, n0 = 64 * nb;
    const float* src = W + (size_t)k0 * N + n0 + lane;
#pragma unroll 1
    for (int h = 0; h < 2; ++h) { float v[32];
#pragma unroll
        for (int i = 0; i < 32; ++i) v[i] = src[(size_t)(h * 32 + i) * N];
#pragma unroll
        for (int i = 0; i < 32; ++i) scr[(h * 32 + i) * 66 + lane] = f2bf(v[i]); }
    LDS_WAIT(); asm volatile("" ::: "memory");
    const int kc = lane & 7, ns = lane >> 3;
#pragma unroll
    for (int j = 0; j < 8; ++j) { const int n = 8 * j + ns; const LAS bf16* s = scr + (8 * kc) * 66 + n;
        u32x4 o; o.x = (unsigned)s[0] | ((unsigned)s[66] << 16); o.y = (unsigned)s[2 * 66] | ((unsigned)s[3 * 66] << 16); o.z = (unsigned)s[4 * 66] | ((unsigned)s[5 * 66] << 16); o.w = (unsigned)s[6 * 66] | ((unsigned)s[7 * 66] << 16);
        *(u32x4*)(WT + (size_t)(row_off + n0 + n) * ldk + k0 + 8 * kc) = o; }
    LDS_WAIT(); asm volatile("" ::: "memory");
}

__device__ __forceinline__ void prologue0(const Frame& F, const Args& a) {
    unsigned char* ws = WSP(F);
    LAS bf16* scr = (LAS bf16*)(F.lds + F.wave * 16384);
    const int gw = F.bid * 8 + F.wave, NGW = F.G * 8;
    for (int l = 0; l < DEPTH; ++l) {
        bf16* WinT = (bf16*)(ws + WS_WIN) + (size_t)l * NPROJ * D;
        {   const int n_items = (D / 64) * (15360 / 64); const float* W = INP(F, I_WIN) + (size_t)l * D * 15360;
            for (int it = gw; it < n_items; it += NGW) transpose_item(W, D, 15360, WinT, D, 0, scr, it, F.lane); }
        for (int e = 0; e < 2; ++e) {
            const int n_items = (D / 64);
            const float* W1 = INP(F, I_W1) + ((size_t)l * 2 + e) * D * 64; const float* A1 = INP(F, I_A1) + ((size_t)l * 2 + e) * D * 64;
            for (int it = gw; it < n_items; it += NGW) { transpose_item(W1, D, 64, WinT, D, COL_LW + e * 64, scr, it, F.lane); transpose_item(A1, D, 64, WinT, D, COL_LW + 128 + e * 64, scr, it, F.lane); }
        }
        {   const int n_items = (D / 64) * 2; const float* W = INP(F, I_G1) + (size_t)l * D * 128;
            for (int it = gw; it < n_items; it += NGW) transpose_item(W, D, 128, WinT, D, COL_LW + 256, scr, it, F.lane); }
        for (int i = gw * 64 + F.lane; i < 128 * D / 8; i += NGW * 64) ((u32x4*)(WinT + (size_t)15744 * D))[i] = (u32x4){0u, 0u, 0u, 0u};
        for (int br = 0; br < 3; ++br) { const float* W = INP(F, I_WPA + br) + (size_t)l * 1024 * D; bf16* WT = (bf16*)(ws + WS_WP) + ((size_t)l * 3 + br) * D * 1024;
            const int n_items = (1024 / 64) * (D / 64);
            for (int it = gw; it < n_items; it += NGW) transpose_item(W, 1024, D, WT, 1024, 0, scr, it, F.lane); }
        {   const float* W = INP(F, I_WOUT) + (size_t)l * D * D; bf16* WT = (bf16*)(ws + WS_WOUT) + (size_t)l * D * D; const int n_items = (D / 64) * (D / 64);
            for (int it = gw; it < n_items; it += NGW) transpose_item(W, D, D, WT, D, 0, scr, it, F.lane); }
        {   const float* W = INP(F, I_FF1) + (size_t)l * D * DFF; bf16* WT = (bf16*)(ws + WS_WFF1) + (size_t)l * D * DFF; const int n_items = (D / 64) * (DFF / 64);
            for (int it = gw; it < n_items; it += NGW) transpose_item(W, D, DFF, WT, D, 0, scr, it, F.lane); }
        {   const float* W = INP(F, I_FF2) + (size_t)l * D * DFF; bf16* WT = (bf16*)(ws + WS_WFF2) + (size_t)l * D * DFF; const int n_items = (DFF / 64) * (D / 64);
            for (int it = gw; it < n_items; it += NGW) transpose_item(W, DFF, D, WT, DFF, 0, scr, it, F.lane); }
        {   bf16* W2T = (bf16*)(ws + WS_W2T) + (size_t)l * 5120 * 256;
            const float* w2 = INP(F, I_W2) + (size_t)l * 2 * 64 * 1024; const float* a2 = INP(F, I_A2) + (size_t)l * 2 * 64 * 1024; const float* g2 = INP(F, I_G2) + (size_t)l * 128 * 1024;
            for (int it = gw; it < 16 * 6; it += NGW) { const int m = it / 16, sub = it % 16;
                const float* W = m == 0 ? w2 : (m == 1 ? w2 + 65536 : (m == 2 ? a2 : (m == 3 ? a2 + 65536 : (m == 4 ? g2 : g2 + 65536))));
                const int br = m < 4 ? m : 4, koff = m < 4 ? 64 * m : (m == 4 ? 128 : 192);
                transpose_item(W, 64, 1024, W2T + (size_t)br * 1024 * 256 + koff, 256, 0, scr, sub, F.lane); }
            for (int i = gw * 64 + F.lane; i < 5120 * 32; i += NGW * 64) { const int n = i >> 5, k8 = (i & 31) * 8, br = n >> 10;
                const bool nz = br == 4 ? (k8 >= 128) : (k8 >= 64 * br && k8 < 64 * br + 64);
                if (!nz) *(u32x4*)(W2T + (size_t)n * 256 + k8) = (u32x4){0u, 0u, 0u, 0u}; }
        }
    }
    {   const float* ck = INP(F, I_CK); const float* cv = INP(F, I_CV); bf16* ok = (bf16*)(ws + WS_CK); bf16* ov = (bf16*)(ws + WS_CV);
        const int n4 = 4 * 4 * 256 * 1024 / 4;
        for (int i = gw * 64 + F.lane; i < n4; i += NGW * 64) { const f32x4 x = ((const f32x4*)ck)[i], y = ((const f32x4*)cv)[i];
            ((u32x2*)ok)[i] = (u32x2){cvtpk(x[0], x[1]), cvtpk(x[2], x[3])}; ((u32x2*)ov)[i] = (u32x2){cvtpk(y[0], y[1]), cvtpk(y[2], y[3])}; }
    }
    {   LAS float* sv = (LAS float*)(F.lds + 65536);
        __syncthreads();
        for (int i = F.tid; i < 5 * D; i += 512) { const int r = i / D, d = i - r * D; const float x = (r == 0) ? INP(F, I_CCTX)[d] : INP(F, I_C)[(r - 1) * D + d]; sv[i] = x / (1.0f + __expf(-x)); }
        __syncthreads();
        float* PART = (float*)(ws + WS_Q);
        const int n_items = DEPTH * 48 * 8;
        for (int it = gw; it < n_items; it += NGW) {
            const int l = it / 384, rem = it % 384, jc = rem >> 3, ds = rem & 7, j4 = jc * 256 + 4 * F.lane;
            const float* W = INP(F, I_WMOD) + (size_t)l * D * 12288 + (size_t)(ds * 256) * 12288 + j4;
            f32x4 acc[5];
#pragma unroll
            for (int r = 0; r < 5; ++r) acc[r] = (f32x4){0.f, 0.f, 0.f, 0.f};
#pragma unroll 4
            for (int d = 0; d < 256; d += 4) {
                f32x4 w[4];
#pragma unroll
                for (int q = 0; q < 4; ++q) w[q] = *(const f32x4*)(W + (size_t)(d + q) * 12288);
#pragma unroll
                for (int r = 0; r < 5; ++r) { const f32x4 s = *(const LAS f32x4*)(sv + r * D + ds * 256 + d);
#pragma unroll
                    for (int q = 0; q < 4; ++q) acc[r] += w[q] * s[q]; }
            }
#pragma unroll
            for (int r = 0; r < 5; ++r) *(f32x4*)(PART + (((size_t)ds * 4 + l) * 5 + r) * 12288 + j4) = acc[r];
        }
        __syncthreads();
    }
    {   float* T2 = (float*)(ws + WS_T2);
        const int n_items = DEPTH * (L_S + L_P);
        for (int it = gw; it < n_items; it += NGW) {
            const int l = it / (L_S + L_P), rr = it % (L_S + L_P), sel = rr < L_S ? 0 : 1, t = sel ? rr - L_S : rr, L = sel ? L_P : L_S;
            float zf = 0.f;
            {   const float tt = (float)t / (float)(L - 1);
                const float w = (6.283185307179586f * (float)t) / (float)L;
                const int band = (F.lane - 1) & 15;
                const float f = 1e-4f + (float)band * ((15.0f - 1e-4f) / 15.0f);
                const float fw = f * w;
                const double rd = (double)fw - 6.283185307179586 * rint((double)fw * 0.15915494309189535);
                const float rf = (float)rd;
                zf = (F.lane == 0) ? tt : (F.lane <= 16 ? __cosf(rf) : -__sinf(rf));
            }
            const float* f1 = INP(F, I_F1) + (size_t)l * 33 * 64; const float* f2 = INP(F, I_F2) + (size_t)l * 64 * 64;
            const float fq = INP(F, I_FREQ)[l * 64 + F.lane];
            float s = INP(F, I_FB1)[l * 64 + F.lane];
            for (int i = 0; i < 33; ++i) s += __int_as_float(__builtin_amdgcn_readlane(__float_as_int(zf), i)) * f1[i * 64 + F.lane];
            float x = fq * s; { const double rd = (double)x - 6.283185307179586 * rint((double)x * 0.15915494309189535); x = (float)rd; }
            const float t1 = __sinf(x);
            float s2 = INP(F, I_FB2)[l * 64 + F.lane];
            for (int i = 0; i < 64; ++i) s2 += __int_as_float(__builtin_amdgcn_readlane(__float_as_int(t1), i)) * f2[i * 64 + F.lane];
            float y = fq * s2; { const double rd = (double)y - 6.283185307179586 * rint((double)y * 0.15915494309189535); y = (float)rd; }
            T2[(((size_t)l * 2 + sel) * L_S + t) * 64 + F.lane] = __sinf(y);
        }
    }
    {   bf16* FS = (bf16*)(ws + WS_FS); bf16* FP = (bf16*)(ws + WS_FP);
        for (int i = gw * 64 + F.lane; i < DEPTH * 1024 * 72; i += NGW * 64) { const int row = i / 72, p = i % 72; const int m = p < 32 ? p : p - 32 + 32;
            FS[(size_t)row * LPS + (p < 32 ? p : L_S + p)] = 0; FP[(size_t)row * LPP + (p < 32 ? p : L_P + p)] = 0; (void)m; }
    }
}

__device__ __forceinline__ void prologue1(const Frame& F, const Args& a) {
    unsigned char* ws = WSP(F);
    const int gw = F.bid * 8 + F.wave, NGW = F.G * 8;
    {   const float* PART = (const float*)(ws + WS_Q); float* MOD = (float*)(ws + WS_MOD);
        for (int i = (F.bid * 8 + F.wave) * 64 + F.lane; i < DEPTH * 5 * 12288 / 4; i += F.G * 8 * 64) {
            const int l = i / (5 * 3072), j4 = (i % 3072) * 4;
            f32x4 s = *(const f32x4*)(INP(F, I_BMOD) + l * 12288 + j4);
#pragma unroll
            for (int ds = 0; ds < 8; ++ds) s += ((const f32x4*)PART)[(size_t)ds * (DEPTH * 5 * 3072) + i];
            ((f32x4*)MOD)[i] = s; }
    }
    const float* T2 = (const float*)(ws + WS_T2);
    float* FNORM = (float*)(ws + WS_CTL) + CW_FNORM;
    const int items_s = DEPTH * 16 * (L_S / 64), items_p = DEPTH * 16 * (L_P / 64);
    for (int it = gw; it < items_s + items_p; it += NGW) {
        int sel, l, cg, tc;
        if (it < items_s) { sel = 0; l = it / (16 * 32); cg = (it / 32) % 16; tc = it % 32; } else { const int r = it - items_s; sel = 1; l = r / (16 * 4); cg = (r / 4) % 16; tc = r % 4; }
        const int L = sel ? L_P : L_S, c = cg * 64 + F.lane;
        const float* f3 = INP(F, I_F3) + (size_t)l * 64 * 1024 + c;
        float w3[64];
#pragma unroll
        for (int j = 0; j < 64; ++j) w3[j] = f3[(size_t)j * 1024];
        const float delta = fabsf(-3.0701134573253946f + (float)c * ((-15.350567286626973f + 3.0701134573253946f) / 1023.0f));
        bf16* dst = sel ? (bf16*)(ws + WS_FP) + ((size_t)l * 1024 + c) * LPP : (bf16*)(ws + WS_FS) + ((size_t)l * 1024 + c) * LPS;
        float asum = 0.f;
        for (int tt = 0; tt < 64; ++tt) {
            const int t = tc * 64 + tt;
            const float tv = T2[(((size_t)l * 2 + sel) * L_S + t) * 64 + F.lane];
            float s = 0.f;
#pragma unroll
            for (int j = 0; j < 64; ++j) s += __int_as_float(__builtin_amdgcn_readlane(__float_as_int(tv), j)) * w3[j];
            const float dist = fabsf((float)(t - L / 2)) / (float)L;
            const float fv = s * __expf(-dist * delta);
            asum += fabsf(fv);
            dst[32 + (L - 1 - t)] = f2bf(fv);
        }
        atomicAdd(FNORM + ((size_t)l * 2 + sel) * 1024 + c, asum);
    }
}

__device__ __forceinline__ void norm_phase(const Frame& F, const float* xp, const float* xs, float* xcopy, const float* g, const float* mod, int i_sh, int i_sc, bf16* hout) {
    const int gw = F.bid * 8 + F.wave, NGW = F.G * 8;
    for (int row = gw; row < M; row += NGW) {
        const float* xr = row < NPR ? xp + (size_t)row * D : xs + (size_t)(row - NPR) * D;
        const float* mr = mod + (size_t)pg8::modrow(row) * 12288;
        f32x4 v[8]; float ss = 0.f;
#pragma unroll
        for (int j = 0; j < 8; ++j) { v[j] = ((const f32x4*)xr)[F.lane + 64 * j]; ss += (v[j][0] * v[j][0] + v[j][1] * v[j][1]) + (v[j][2] * v[j][2] + v[j][3] * v[j][3]); }
        const float rstd = 1.0f / sqrtf(wave_sum(ss) * (1.0f / D) + 1e-6f);
        if (xcopy) {
#pragma unroll
            for (int j = 0; j < 8; ++j) ((f32x4*)(xcopy + (size_t)row * D))[F.lane + 64 * j] = v[j]; }
#pragma unroll
        for (int j = 0; j < 8; ++j) {
            const f32x4 gg = ((const f32x4*)g)[F.lane + 64 * j], sc = ((const f32x4*)(mr + i_sc * D))[F.lane + 64 * j], sh = ((const f32x4*)(mr + i_sh * D))[F.lane + 64 * j];
            const f32x4 o = v[j] * rstd * gg * (1.0f + sc) + sh;
            ((u32x2*)(hout + (size_t)row * D))[F.lane + 64 * j] = (u32x2){cvtpk(o[0], o[1]), cvtpk(o[2], o[3])};
        }
    }
}
__device__ __forceinline__ void final_norm_phase(const Frame& F, float* x, const float* g) {
    const int gw = F.bid * 8 + F.wave, NGW = F.G * 8;
    for (int row = gw; row < M; row += NGW) {
        float* xr = x + (size_t)row * D;
        f32x4 v[8]; float ss = 0.f;
#pragma unroll
        for (int j = 0; j < 8; ++j) { v[j] = ((const f32x4*)xr)[F.lane + 64 * j]; ss += (v[j][0] * v[j][0] + v[j][1] * v[j][1]) + (v[j][2] * v[j][2] + v[j][3] * v[j][3]); }
        const float rstd = 1.0f / sqrtf(wave_sum(ss) * (1.0f / D) + 1e-6f);
#pragma unroll
        for (int j = 0; j < 8; ++j) { const f32x4 gg = ((const f32x4*)g)[F.lane + 64 * j]; ((f32x4*)xr)[F.lane + 64 * j] = v[j] * rstd * gg; }
    }
}

__device__ __forceinline__ s16x4 vtr(const LAS unsigned char* p) { return __builtin_bit_cast(s16x4, __builtin_amdgcn_ds_read_tr16_b64_v4i16((LAS s16x4*)p)); }

struct AttnState { float m, l; f32x16 o[2]; };

template <int NT, bool HASB, class KT, class VL, class BIAS>
__device__ __forceinline__ void attendN(AttnState& st, const bf16x8 (&qf)[4], const KT& ktp, size_t kstride, const LAS unsigned char* lds, const VL& vlo, const BIAS& bias, int lane) {
    const int r = lane & 31, h = lane >> 5;
    f32x16 s[NT];
#pragma unroll
    for (int kt = 0; kt < NT; ++kt) {
        const bf16* kp = ktp(kt) + (size_t)r * kstride + 8 * h;
        bf16x8 kf[4];
#pragma unroll
        for (int ks = 0; ks < 4; ++ks) kf[ks] = *(const bf16x8*)(kp + 16 * ks);
        f32x16 acc;
#pragma unroll
        for (int i = 0; i < 16; ++i) acc[i] = 0.f;
#pragma unroll
        for (int ks = 0; ks < 4; ++ks) acc = __builtin_amdgcn_mfma_f32_32x32x16_bf16(kf[ks], qf[ks], acc, 0, 0, 0);
        s[kt] = acc;
    }
    float gm = -3.0e38f;
#pragma unroll
    for (int kt = 0; kt < NT; ++kt)
#pragma unroll
        for (int i = 0; i < 16; ++i) {
            float v = s[kt][i] * 0.125f;
            if (HASB) v = bias(kt, (i & 3) + 8 * (i >> 2) + 4 * h, v);
            s[kt][i] = v; gm = fmaxf(gm, v);
        }
    gm = fmaxf(gm, xor32(gm, lane));
    const float mnew = fmaxf(st.m, gm);
    const float alpha = __expf(st.m - mnew);
    float ps = 0.f;
#pragma unroll
    for (int kt = 0; kt < NT; ++kt)
#pragma unroll
        for (int i = 0; i < 16; ++i) { const float p = __expf(s[kt][i] - mnew); s[kt][i] = p; ps += p; }
    st.l = st.l * alpha + ps; st.m = mnew;
#pragma unroll
    for (int i = 0; i < 16; ++i) { st.o[0][i] *= alpha; st.o[1][i] *= alpha; }
    const int i16 = lane & 15, tq = i16 >> 2, tp = i16 & 3, blk = (lane >> 4) & 1;
#pragma unroll
    for (int kt = 0; kt < NT; ++kt) {
        const LAS unsigned char* vb = lds + vlo(kt);
#pragma unroll
        for (int ss = 0; ss < 2; ++ss) {
            u32x4 pw; pw.x = cvtpk(s[kt][8 * ss + 0], s[kt][8 * ss + 1]); pw.y = cvtpk(s[kt][8 * ss + 2], s[kt][8 * ss + 3]); pw.z = cvtpk(s[kt][8 * ss + 4], s[kt][8 * ss + 5]); pw.w = cvtpk(s[kt][8 * ss + 6], s[kt][8 * ss + 7]);
            const bf16x8 pf = __builtin_bit_cast(bf16x8, pw);
#pragma unroll
            for (int dt = 0; dt < 2; ++dt) {
                const LAS unsigned char* p0 = vb + (16 * ss + 4 * h + tq) * 128 + (dt * 32 + 16 * blk + 4 * tp) * 2;
                const s16x4 lo = vtr(p0), hi = vtr(p0 + 8 * 128);
                const bf16x8 vf = __builtin_shufflevector(lo, hi, 0, 1, 2, 3, 4, 5, 6, 7);
                st.o[dt] = __builtin_amdgcn_mfma_f32_32x32x16_bf16(vf, pf, st.o[dt], 0, 0, 0);
            }
        }
    }
}

__device__ __forceinline__ void attn_store(const AttnState& st, bf16* orow  , int lane) {
    const int h = lane >> 5;
    const float lt = st.l + xor32(st.l, lane);
    const float inv = 1.0f / lt;
#pragma unroll
    for (int dt = 0; dt < 2; ++dt)
#pragma unroll
        for (int g = 0; g < 4; ++g) {
            const u32x2 w = (u32x2){cvtpk(st.o[dt][4 * g] * inv, st.o[dt][4 * g + 1] * inv), cvtpk(st.o[dt][4 * g + 2] * inv, st.o[dt][4 * g + 3] * inv)};
            *(u32x2*)(orow + dt * 32 + 8 * g + 4 * h) = w;
        }
}

__device__ __forceinline__ void attention_phase(const Frame& F, const Args& a, int layer) {
    unsigned char* ws = WSP(F);
    const bf16* proj = (const bf16*)(ws + WS_PROJ);
    bf16* oall = (bf16*)(ws + WS_OALL);
    const int lane = F.lane, w = F.wave, r = lane & 31, h = lane >> 5;
    LAS unsigned char* lds = F.lds;
    LAS float* rpbl = (LAS float*)(lds + 122880);
    for (int u = F.bid; u < 1024; u += F.G) {
        __syncthreads();
        if (u < 512) {
            const int b = u >> 4, hd = u & 15;
            const int tok0 = b * 256;
            for (int i = F.tid; i < 256 * 8; i += 512) { const int key = i >> 3, pc = i & 7;
                *(LAS u32x4*)(lds + key * 128 + pc * 16) = *(const u32x4*)(proj + (size_t)(tok0 + key) * NPROJ + COL_V + hd * 64 + pc * 8); }
            __syncthreads();
            bf16x8 qf[4];
            { const bf16* qp = proj + (size_t)(tok0 + 32 * w + r) * NPROJ + hd * 64 + 8 * h;
#pragma unroll
              for (int ks = 0; ks < 4; ++ks) qf[ks] = *(const bf16x8*)(qp + 16 * ks); }
            AttnState st; st.m = -3.0e38f; st.l = 0.f;
#pragma unroll
            for (int i = 0; i < 16; ++i) { st.o[0][i] = 0.f; st.o[1][i] = 0.f; }
            const bf16* kbase = proj + (size_t)tok0 * NPROJ + COL_K + hd * 64;
#pragma unroll 1
            for (int kg = 0; kg < 2; ++kg)
                attendN<4, false>(st, qf, [&](int kt) { return kbase + (size_t)((kg * 4 + kt) * 32) * NPROJ; }, (size_t)NPROJ, lds, [&](int kt) { return (kg * 4 + kt) * 4096; }, [&](int, int, float v) { return v; }, lane);
            attn_store(st, oall + (size_t)(tok0 + 32 * w + r) * 3072 + hd * 64, lane);
        } else {
            const int uu = u - 512, b = uu >> 7, hd = (uu >> 3) & 15, rg = uu & 7;
            const int tokb = NPR + b * 2048;
            int rlo = 4 * rg - 4; rlo = rlo < 0 ? 0 : (rlo > 24 ? 24 : rlo);
            int rhi0 = 4 * rg + 3 - 4; rhi0 = rhi0 < 0 ? 0 : (rhi0 > 24 ? 24 : rhi0); const int nr = rhi0 + 8 - rlo;
            for (int i = F.tid; i < nr * 64 * 8; i += 512) { const int key = i >> 3, pc = i & 7;
                *(LAS u32x4*)(lds + key * 128 + pc * 16) = *(const u32x4*)(proj + (size_t)(tokb + rlo * 64 + key) * NPROJ + COL_V + hd * 64 + pc * 8); }
            const bf16* cv = (const bf16*)(ws + WS_CV) + ((size_t)(b * 4 + layer) * 256) * 1024 + hd * 64;
            const bf16* ck = (const bf16*)(ws + WS_CK) + ((size_t)(b * 4 + layer) * 256) * 1024 + hd * 64;
            for (int i = F.tid; i < 256 * 8; i += 512) { const int key = i >> 3, pc = i & 7;
                *(LAS u32x4*)(lds + 90112 + key * 128 + pc * 16) = *(const u32x4*)(cv + (size_t)key * 1024 + pc * 8); }
            for (int i = F.tid; i < 465; i += 512) rpbl[i] = INP(F, I_RPB)[((size_t)layer * 16 + hd) * 465 + i];
            __syncthreads();
            const int qrow = 4 * rg + (w >> 1), qc = (w & 1) * 32 + r;
            int r0 = qrow - 4; r0 = r0 < 0 ? 0 : (r0 > 24 ? 24 : r0);
            int c0 = qc - 8; c0 = c0 < 0 ? 0 : (c0 > 48 ? 48 : c0);
            const int qtok = tokb + qrow * 64 + (w & 1) * 32 + r;
            bf16x8 qf[4];
            { const bf16* qp = proj + (size_t)qtok * NPROJ + hd * 64 + 8 * h;
#pragma unroll
              for (int ks = 0; ks < 4; ++ks) qf[ks] = *(const bf16x8*)(qp + 16 * ks); }
            AttnState st; st.m = -3.0e38f; st.l = 0.f;
#pragma unroll
            for (int i = 0; i < 16; ++i) { st.o[0][i] = 0.f; st.o[1][i] = 0.f; }
            const bf16* kloc = proj + (size_t)tokb * NPROJ + COL_K + hd * 64;
#pragma unroll 1
            for (int grp = 0; grp < 4; ++grp) {
                const int krb = r0 + 2 * grp;
                attendN<4, true>(st, qf, [&](int kt) { return kloc + (size_t)((krb + (kt >> 1)) * 64 + (kt & 1) * 32) * NPROJ; }, (size_t)NPROJ, lds,
                    [&](int kt) { return ((krb + (kt >> 1) - rlo) * 64 + (kt & 1) * 32) * 128; },
                    [&](int kt, int kin, float v) { const int kr = krb + (kt >> 1), kc = (kt & 1) * 32 + kin; const bool ok = (kc >= c0) && (kc < c0 + 16);
                        const int dr = kr - qrow + 7, dc = kc - qc + 15; const int idx = ok ? dr * 31 + dc : 0; return ok ? v + rpbl[idx] : -1.0e30f; }, lane);
            }
#pragma unroll 1
            for (int kg = 0; kg < 2; ++kg)
                attendN<4, false>(st, qf, [&](int kt) { return ck + (size_t)((kg * 4 + kt) * 32) * 1024; }, (size_t)1024, lds, [&](int kt) { return 90112 + (kg * 4 + kt) * 4096; }, [&](int, int, float v) { return v; }, lane);
            attn_store(st, oall + (size_t)qtok * 3072 + hd * 64, lane);
        }
    }
    __syncthreads();
}

__device__ __forceinline__ float row_sum16(float v) { v += DPPF(v, 0xB1); v += DPPF(v, 0x4E); v += DPPF(v, 0x141); v += DPPF(v, 0x140); return v; }
__device__ __forceinline__ f32x4 unpack4(u32x2 w) { return (f32x4){bflo(w.x), bfhi(w.x), bflo(w.y), bfhi(w.y)}; }
__device__ __forceinline__ u32x2 pack4(f32x4 v) { return (u32x2){cvtpk(v[0], v[1]), cvtpk(v[2], v[3])}; }
__device__ __forceinline__ f32x4 exp4(f32x4 x) { return (f32x4){__expf(x[0]), __expf(x[1]), __expf(x[2]), __expf(x[3])}; }
__device__ __forceinline__ f32x4 rcp4(f32x4 x) { return (f32x4){__builtin_amdgcn_rcpf(x[0]), __builtin_amdgcn_rcpf(x[1]), __builtin_amdgcn_rcpf(x[2]), __builtin_amdgcn_rcpf(x[3])}; }
__device__ __forceinline__ void rwkv_prep_phase(const Frame& F, const Args& a, int layer) {
    unsigned char* ws = WSP(F);
    const bf16* proj = (const bf16*)(ws + WS_PROJ);
    const bf16* abuf = (const bf16*)(ws + WS_A);
    const float* logw = (const float*)(ws + WS_DEC);
    bf16* til = (bf16*)(ws + WS_TIL);
    float* bonus = (float*)(ws + WS_BONUS);
    float* wtb = (float*)(ws + WS_WTB);
    const float* cw = INP(F, I_CW) + (size_t)layer * 3 * 3072; const float* cb = INP(F, I_CB) + (size_t)layer * 3072;
    const int lane = F.lane;
    for (int item = F.wave * F.G + F.bid; item < 2048; item += 8 * F.G) {
        const int run = item >> 2, tok0 = run * 32, cg = item & 3, c4 = cg * 256 + 4 * lane, head = cg * 4 + (lane >> 4), hl = 4 * (lane & 15);
        const int t0 = tok0 < NPR ? (tok0 & 255) : ((tok0 - NPR) & 2047), L = tok0 < NPR ? L_P : L_S;
        const f32x4 kkw = *(const f32x4*)(INP(F, I_KK) + layer * 1024 + c4), kaw = *(const f32x4*)(INP(F, I_KA) + layer * 1024 + c4), rkw = *(const f32x4*)(INP(F, I_RK) + layer * 1024 + c4);
        f32x4 tot1 = (f32x4){0.f, 0.f, 0.f, 0.f};
#pragma unroll 1
        for (int q = 0; q < 4; ++q) { f32x4 t[8];
#pragma unroll
          for (int i = 0; i < 8; ++i) t[i] = *(const f32x4*)(logw + ((size_t)(tok0 + 8 * q + i) * 2 + 1) * 1024 + c4);
#pragma unroll
          for (int i = 0; i < 8; ++i) tot1 += t[i]; }
        f32x4 pre0 = (f32x4){0.f, 0.f, 0.f, 0.f}, pre1 = pre0, e0prev = (f32x4){1.f, 1.f, 1.f, 1.f};
        const bf16* pbase = proj + (size_t)tok0 * NPROJ + COL_R + c4;
#pragma unroll 1
        for (int ch = 0; ch < 8; ++ch) {
            const float* cwp = cw; const float* cbp = cb; asm volatile("" : "+s"(cwp), "+s"(cbp));
            f32x4 w[3][3], bs[3];
#pragma unroll
            for (int s = 0; s < 3; ++s) { bs[s] = *(const f32x4*)(cbp + s * 1024 + c4);
#pragma unroll
                for (int tp = 0; tp < 3; ++tp) w[s][tp] = *(const f32x4*)(cwp + tp * 3072 + s * 1024 + c4); }
            u32x2 rows[6][3], av[4][2]; f32x4 lw[4][2];
#pragma unroll
            for (int i = 0; i < 6; ++i) { const int tt = ch * 4 + i - 1, t = t0 + tt; const bool ok = (t >= 0) && (t < L);
#pragma unroll
                for (int s = 0; s < 3; ++s) rows[i][s] = ok ? *(const u32x2*)(pbase + (long)tt * NPROJ + s * 1024) : (u32x2){0u, 0u}; }
#pragma unroll
            for (int i = 0; i < 4; ++i) { const size_t tok = (size_t)(tok0 + ch * 4 + i); av[i][0] = *(const u32x2*)(abuf + (tok * 2 + 0) * 1024 + c4); av[i][1] = *(const u32x2*)(abuf + (tok * 2 + 1) * 1024 + c4);
                lw[i][0] = *(const f32x4*)(logw + (tok * 2 + 0) * 1024 + c4); lw[i][1] = *(const f32x4*)(logw + (tok * 2 + 1) * 1024 + c4); }
#pragma unroll
            for (int i = 0; i < 4; ++i) {
                const size_t tok = (size_t)(tok0 + ch * 4 + i);
                f32x4 x[3];
#pragma unroll
                for (int s = 0; s < 3; ++s) x[s] = unpack4(rows[i][s]) * w[s][0] + unpack4(rows[i + 1][s]) * w[s][1] + unpack4(rows[i + 2][s]) * w[s][2] + bs[s];
                const f32x4 rr = x[0], k0 = x[1], vv = x[2];
                f32x4 kk = k0 * kkw;
                const float ssq = row_sum16((kk[0] * kk[0] + kk[1] * kk[1]) + (kk[2] * kk[2] + kk[3] * kk[3]));
                kk = kk * (1.0f / sqrtf(ssq + 1e-12f));
                const f32x4 a0 = unpack4(av[i][0]), a1 = unpack4(av[i][1]);
                const f32x4 kd0 = k0 * (1.0f + (a0 - 1.0f) * kaw), kd1 = k0 * (1.0f + (a1 - 1.0f) * kaw);
                const f32x4 rk = rr * k0 * rkw;
                const float bsum = row_sum16((rk[0] + rk[1]) + (rk[2] + rk[3]));
                pre0 += lw[i][0];
                const f32x4 e0 = exp4(pre0), ie0 = rcp4(e0);
                const f32x4 l1 = tot1 - pre1; pre1 += lw[i][1];
                const f32x4 e1 = exp4(l1), ie1 = rcp4(e1), e1prev = exp4(l1 - lw[i][1]);
                bf16* o = til + (tok * 16 + head) * TILP + hl;
                *(u32x2*)(o) = pack4(-kk * e0prev); *(u32x2*)(o + 64) = pack4(kk * a0 * ie0); *(u32x2*)(o + 128) = pack4(kd0 * ie0); *(u32x2*)(o + 192) = pack4(rr * e0);
                *(u32x2*)(o + 256) = pack4(-kk * e1prev); *(u32x2*)(o + 320) = pack4(kk * a1 * ie1); *(u32x2*)(o + 384) = pack4(kd1 * ie1); *(u32x2*)(o + 448) = pack4(rr * e1);
                *(u32x2*)(o + 512) = pack4(vv);
                e0prev = e0;
                if ((lane & 15) == 0) bonus[tok * 16 + head] = bsum;
            }
        }
        *(f32x4*)(wtb + (((size_t)run * 2 + 0) * 16 + head) * 64 + hl) = exp4(pre0);
        *(f32x4*)(wtb + (((size_t)run * 2 + 1) * 16 + head) * 64 + hl) = exp4(tot1);
    }
}

__device__ __forceinline__ bf16x8 packf(const f32x16& x, int s) {
    u32x4 p; p.x = cvtpk(x[8 * s + 0], x[8 * s + 1]); p.y = cvtpk(x[8 * s + 2], x[8 * s + 3]); p.z = cvtpk(x[8 * s + 4], x[8 * s + 5]); p.w = cvtpk(x[8 * s + 6], x[8 * s + 7]);
    return __builtin_bit_cast(bf16x8, p);
}
#define MFMA32(a, b, c) __builtin_amdgcn_mfma_f32_32x32x16_bf16((a), (b), (c), 0, 0, 0)

__device__ __forceinline__ void rwkv_tinv_phase(const Frame& F) {
    unsigned char* ws = WSP(F);
    const bf16* til = (const bf16*)(ws + WS_TIL);
    bf16* tinv = (bf16*)(ws + WS_TINV);
    const int lane = F.lane, r = lane & 31, h = lane >> 5;
    LAS float* Lw = (LAS float*)(F.lds + F.wave * 16384);
    for (int unit = F.wave * F.G + F.bid; unit < 16384; unit += 8 * F.G) {
        const int run = unit >> 5, e = (unit >> 4) & 1, hd = unit & 15;
        const size_t tok = (size_t)(run * 32 + (e ? 31 - r : r));
        const bf16* rowp = til + (tok * 16 + hd) * TILP + e * 256 + 8 * h;
        f32x16 acc;
#pragma unroll
        for (int i = 0; i < 16; ++i) acc[i] = 0.f;
        bf16x8 bfr[4], afr[4];
#pragma unroll
        for (int ks = 0; ks < 4; ++ks) { afr[ks] = *(const bf16x8*)(rowp + 16 * ks); bfr[ks] = *(const bf16x8*)(rowp + 64 + 16 * ks); }
#pragma unroll
        for (int ks = 0; ks < 4; ++ks) acc = MFMA32(bfr[ks], afr[ks], acc);
#pragma unroll
        for (int g = 0; g < 4; ++g) { const int j0 = 8 * g + 4 * h; f32x4 v;
#pragma unroll
            for (int q = 0; q < 4; ++q) v[q] = (j0 + q < r) ? acc[4 * g + q] : 0.f;
            *(LAS f32x4*)(Lw + r * 36 + j0) = v; }
        LDS_WAIT(); asm volatile("" ::: "memory");
        float X[32];
#pragma unroll
        for (int i = 0; i < 32; ++i) {
            float s = (i == r) ? 1.f : 0.f;
#pragma unroll
            for (int jq = 0; jq < (i + 3) / 4; ++jq) { const f32x4 lv = *(const LAS f32x4*)(Lw + i * 36 + 4 * jq);
#pragma unroll
                for (int q = 0; q < 4; ++q) if (4 * jq + q < i) s += lv[q] * X[4 * jq + q]; }
            X[i] = s;
        }
        if (h == 0) { bf16* o = tinv + (size_t)unit * 1024 + r;
#pragma unroll
            for (int i = 0; i < 32; ++i) o[i * 32] = f2bf(X[i]); }
        LDS_WAIT(); asm volatile("" ::: "memory");
    }
}

constexpr int CS_BUF = 23552, CS_AT = 0, CS_BT = 4096, CS_KT = 8192, CS_RT = 12288, CS_VV = 16384, CS_TI = 20480, CS_WT = 22528;
__device__ __forceinline__ void rwkv_cscan_phase(const Frame& F, int layer) {
    if (F.wave >= 2) return;
    unsigned char* ws = WSP(F);
    const bf16* til = (const bf16*)(ws + WS_TIL);
    const bf16* tinv = (const bf16*)(ws + WS_TINV);
    const float* wtb = (const float*)(ws + WS_WTB);
    float* Y = (float*)(ws + WS_H);
    const int lane = F.lane, r = lane & 31, h = lane >> 5;
    const int i16 = lane & 15, tq = i16 >> 2, tp = i16 & 3, blk = (lane >> 4) & 1;
    LAS unsigned char* lbase = F.lds + F.wave * (2 * CS_BUF);
    const int slot = F.wave * F.G + F.bid, nslot = 2 * F.G;
    const int nsamp = 128;
    for (int item = (slot < nsamp) ? slot : nsamp + (slot - nsamp); item < 1152; item += (slot < nsamp) ? 1152 : (nslot - nsamp)) {
        const bool sample = item < 128; const int chain = sample ? item : item - 128;
        const int hd = chain & 15, e = (chain >> 4) & 1, b = chain >> 5;
        const int NC = sample ? (L_S / 32) : (L_P / 32), tokb = sample ? NPR + b * L_S : b * L_P;
        f32x16 ST[2][2];
        if (sample) { const float* s0 = INP(F, I_ST) + ((((size_t)b * 4 + layer) * 2 + e) * 16 + hd) * 4096;
#pragma unroll
            for (int kt = 0; kt < 2; ++kt)
#pragma unroll
                for (int vt = 0; vt < 2; ++vt)
#pragma unroll
                    for (int g = 0; g < 4; ++g) { const f32x4 v = *(const f32x4*)(s0 + (32 * vt + r) * 64 + 32 * kt + 8 * g + 4 * h);
                        ST[kt][vt][4 * g] = v[0]; ST[kt][vt][4 * g + 1] = v[1]; ST[kt][vt][4 * g + 2] = v[2]; ST[kt][vt][4 * g + 3] = v[3]; }
        } else {
#pragma unroll
            for (int kt = 0; kt < 2; ++kt)
#pragma unroll
                for (int vt = 0; vt < 2; ++vt)
#pragma unroll
                    for (int i = 0; i < 16; ++i) ST[kt][vt][i] = 0.f;
        }
#define CS_DMA(C, BUFP) do { const int run_ = (tokb >> 5) + (e ? NC - 1 - (C) : (C)); \
            _Pragma("unroll") for (int i_ = 0; i_ < 4; ++i_) { const int q_ = lane + 64 * i_, p_ = q_ >> 3, cc_ = q_ & 7; \
                const bf16* g_ = til + ((size_t)(run_ * 32 + (e ? 31 - p_ : p_)) * 16 + hd) * TILP + e * 256 + 8 * cc_; \
                __builtin_amdgcn_global_load_lds((const unsigned*)(g_), (LAS unsigned*)((BUFP) + CS_AT + i_ * 1024), 16, 0, 0); \
                __builtin_amdgcn_global_load_lds((const unsigned*)(g_ + 64), (LAS unsigned*)((BUFP) + CS_BT + i_ * 1024), 16, 0, 0); \
                __builtin_amdgcn_global_load_lds((const unsigned*)(g_ + 128), (LAS unsigned*)((BUFP) + CS_KT + i_ * 1024), 16, 0, 0); \
                __builtin_amdgcn_global_load_lds((const unsigned*)(g_ + 192), (LAS unsigned*)((BUFP) + CS_RT + i_ * 1024), 16, 0, 0); \
                __builtin_amdgcn_global_load_lds((const unsigned*)(g_ - e * 256 + 512), (LAS unsigned*)((BUFP) + CS_VV + i_ * 1024), 16, 0, 0); } \
            const size_t unit_ = ((size_t)run_ * 2 + e) * 16 + hd; \
            _Pragma("unroll") for (int i_ = 0; i_ < 2; ++i_) __builtin_amdgcn_global_load_lds((const unsigned*)(tinv + unit_ * 1024 + (lane + 64 * i_) * 8), (LAS unsigned*)((BUFP) + CS_TI + i_ * 1024), 16, 0, 0); \
            __builtin_amdgcn_global_load_lds((const unsigned*)(wtb + unit_ * 64 + (lane & 15) * 4), (LAS unsigned*)((BUFP) + CS_WT), 16, 0, 0); } while (0)
        CS_DMA(0, lbase);
#pragma unroll 1
        for (int c = 0; c < NC; ++c) {
            const LAS unsigned char* B = lbase + (c & 1) * CS_BUF;
            asm volatile("s_waitcnt vmcnt(0)" ::: "memory");
            if (c + 1 < NC) CS_DMA(c + 1, lbase + ((c + 1) & 1) * CS_BUF);
            bf16x8 nkaF[2], nbrF[2], nkrF[2];
            {
#define CS_NMAT(OUTF, OFFA, OFFB, STRICT) do { f32x16 n_; _Pragma("unroll") for (int i = 0; i < 16; ++i) n_[i] = 0.f; \
                    _Pragma("unroll") for (int ks = 0; ks < 4; ++ks) { const int o = r * 128 + (16 * ks + 8 * h) * 2; \
                        n_ = MFMA32(*(const LAS bf16x8*)(B + (OFFA) + o), *(const LAS bf16x8*)(B + (OFFB) + o), n_); } \
                    _Pragma("unroll") for (int i = 0; i < 16; ++i) { const int row = (i & 3) + 8 * (i >> 2) + 4 * h; n_[i] = ((STRICT) ? (row < r) : (row <= r)) ? n_[i] : 0.f; } \
                    OUTF[0] = packf(n_, 0); OUTF[1] = packf(n_, 1); } while (0)
                CS_NMAT(nkaF, CS_KT, CS_AT, true);
                CS_NMAT(nbrF, CS_BT, CS_RT, false);
                CS_NMAT(nkrF, CS_KT, CS_RT, false);
#undef CS_NMAT
                asm volatile("" ::: "memory");
            }
#define CS_VVF(VT, S) ({ const LAS unsigned char* p0_ = B + CS_VV + (16 * (S) + 4 * h + tq) * 128 + (32 * (VT) + 16 * blk + 4 * tp) * 2; \
                const s16x4 lo_ = vtr(p0_), hi_ = vtr(p0_ + 8 * 128); (bf16x8)__builtin_shufflevector(lo_, hi_, 0, 1, 2, 3, 4, 5, 6, 7); })
#define CS_APERM(OFF, KT, S) ({ const LAS unsigned char* p_ = B + (OFF) + r * 128 + (32 * (KT) + 16 * (S) + 4 * h) * 2; \
                const u32x2 lo_ = *(const LAS u32x2*)p_, hi_ = *(const LAS u32x2*)(p_ + 16); __builtin_bit_cast(bf16x8, (u32x4){lo_.x, lo_.y, hi_.x, hi_.y}); })
            bf16x8 uF[2][2];
#pragma unroll
            for (int vt = 0; vt < 2; ++vt) {
                f32x16 rhs;
#pragma unroll
                for (int i = 0; i < 16; ++i) rhs[i] = 0.f;
#pragma unroll
                for (int kt = 0; kt < 2; ++kt)
#pragma unroll
                    for (int s = 0; s < 2; ++s) rhs = MFMA32(CS_APERM(CS_AT, kt, s), packf(ST[kt][vt], s), rhs);
#pragma unroll
                for (int s = 0; s < 2; ++s) rhs = MFMA32(nkaF[s], CS_VVF(vt, s), rhs);
                f32x16 u;
#pragma unroll
                for (int i = 0; i < 16; ++i) u[i] = 0.f;
#pragma unroll
                for (int s = 0; s < 2; ++s) { const LAS unsigned char* p_ = B + CS_TI + r * 64 + (16 * s + 4 * h) * 2;
                    const u32x2 lo_ = *(const LAS u32x2*)p_, hi_ = *(const LAS u32x2*)(p_ + 16);
                    u = MFMA32(__builtin_bit_cast(bf16x8, (u32x4){lo_.x, lo_.y, hi_.x, hi_.y}), packf(rhs, s), u); }
                uF[vt][0] = packf(u, 0); uF[vt][1] = packf(u, 1);
            }
            {   const int run = (tokb >> 5) + (e ? NC - 1 - c : c);
#pragma unroll
                for (int vt = 0; vt < 2; ++vt) {
                    f32x16 y;
#pragma unroll
                    for (int i = 0; i < 16; ++i) y[i] = 0.f;
#pragma unroll
                    for (int kt = 0; kt < 2; ++kt)
#pragma unroll
                        for (int s = 0; s < 2; ++s) y = MFMA32(CS_APERM(CS_RT, kt, s), packf(ST[kt][vt], s), y);
#pragma unroll
                    for (int s = 0; s < 2; ++s) { y = MFMA32(nbrF[s], uF[vt][s], y); y = MFMA32(nkrF[s], CS_VVF(vt, s), y); }
#pragma unroll
                    for (int i = 0; i < 16; ++i) { const int p = (i & 3) + 8 * (i >> 2) + 4 * h; const size_t tok = (size_t)(run * 32 + (e ? 31 - p : p));
                        Y[((size_t)e * M + tok) * 1024 + hd * 64 + 32 * vt + r] = y[i]; }
                }
            }
#pragma unroll
            for (int kt = 0; kt < 2; ++kt) {
                bf16x8 btF[2], ktF[2];
#pragma unroll
                for (int s = 0; s < 2; ++s) { const int o = (16 * s + 4 * h + tq) * 128 + (32 * kt + 16 * blk + 4 * tp) * 2;
                    { const s16x4 lo = vtr(B + CS_BT + o), hi = vtr(B + CS_BT + o + 8 * 128); btF[s] = __builtin_shufflevector(lo, hi, 0, 1, 2, 3, 4, 5, 6, 7); }
                    { const s16x4 lo = vtr(B + CS_KT + o), hi = vtr(B + CS_KT + o + 8 * 128); ktF[s] = __builtin_shufflevector(lo, hi, 0, 1, 2, 3, 4, 5, 6, 7); } }
                f32x4 wt[4];
#pragma unroll
                for (int g = 0; g < 4; ++g) wt[g] = *(const LAS f32x4*)(B + CS_WT + (32 * kt + 8 * g + 4 * h) * 4);
#pragma unroll
                for (int vt = 0; vt < 2; ++vt) {
#pragma unroll
                    for (int s = 0; s < 2; ++s) { ST[kt][vt] = MFMA32(btF[s], uF[vt][s], ST[kt][vt]); ST[kt][vt] = MFMA32(ktF[s], CS_VVF(vt, s), ST[kt][vt]); }
#pragma unroll
                    for (int i = 0; i < 16; ++i) ST[kt][vt][i] *= wt[i >> 2][i & 3];
                }
            }
        }
#undef CS_APERM
#undef CS_VVF
#undef CS_DMA
        if (!sample) { float* so = OUTP(F) + OUT_ST + ((((size_t)b * 4 + layer) * 2 + e) * 16 + hd) * 4096;
#pragma unroll
            for (int kt = 0; kt < 2; ++kt)
#pragma unroll
                for (int vt = 0; vt < 2; ++vt)
#pragma unroll
                    for (int g = 0; g < 4; ++g) *(f32x4*)(so + (32 * vt + r) * 64 + 32 * kt + 8 * g + 4 * h) = (f32x4){ST[kt][vt][4 * g], ST[kt][vt][4 * g + 1], ST[kt][vt][4 * g + 2], ST[kt][vt][4 * g + 3]};
        }
    }
    asm volatile("s_waitcnt vmcnt(0)" ::: "memory");
}

__device__ __forceinline__ void rwkv_post_phase(const Frame& F, const Args& a, int layer) {
    unsigned char* ws = WSP(F);
    const float* Y = (const float*)(ws + WS_H);
    const bf16* til = (const bf16*)(ws + WS_TIL); const bf16* gbuf = (const bf16*)(ws + WS_G); const float* bonus = (const float*)(ws + WS_BONUS);
    bf16* oall = (bf16*)(ws + WS_OALL);
    const int lane = F.lane;
    for (int item = F.wave * F.G + F.bid; item < 2048; item += 8 * F.G) {
        const int tok0 = (item >> 2) * 32, cg = item & 3, c4 = cg * 256 + 4 * lane, head = cg * 4 + (lane >> 4), hl = 4 * (lane & 15);
        const f32x4 gng = *(const f32x4*)(INP(F, I_GNG) + layer * 1024 + c4), gnb = *(const f32x4*)(INP(F, I_GNB) + layer * 1024 + c4);
#pragma unroll 1
        for (int ch = 0; ch < 4; ++ch) {
            f32x4 y0[8], y1[8]; u32x2 vw[8], gw[8]; float bn[8];
#pragma unroll
            for (int i = 0; i < 8; ++i) { const size_t tok = (size_t)(tok0 + ch * 8 + i);
                y0[i] = *(const f32x4*)(Y + tok * 1024 + c4); y1[i] = *(const f32x4*)(Y + ((size_t)M + tok) * 1024 + c4);
                vw[i] = *(const u32x2*)(til + (tok * 16 + head) * TILP + 512 + hl); gw[i] = *(const u32x2*)(gbuf + tok * 1024 + c4); bn[i] = bonus[tok * 16 + head]; }
#pragma unroll
            for (int i = 0; i < 8; ++i) { const size_t tok = (size_t)(tok0 + ch * 8 + i);
                const f32x4 y = y0[i] + y1[i];
                const float mu = row_sum16((y[0] + y[1]) + (y[2] + y[3])) * (1.0f / 64.0f);
                const f32x4 dd = y - mu;
                const float var = row_sum16((dd[0] * dd[0] + dd[1] * dd[1]) + (dd[2] * dd[2] + dd[3] * dd[3])) * (1.0f / 64.0f);
                const f32x4 yn = dd * (1.0f / sqrtf(var + 64e-5f)) * gng + gnb;
                const f32x4 o = (yn + bn[i] * unpack4(vw[i])) * unpack4(gw[i]);
                *(u32x2*)(oall + tok * 3072 + 1024 + c4) = pack4(o);
            }
        }
    }
}

__device__ __forceinline__ void hyena_prep_phase(const Frame& F, const Args& a, int layer) {
    unsigned char* ws = WSP(F);
    const bf16* proj = (const bf16*)(ws + WS_PROJ);
    bf16* zT = (bf16*)(ws + WS_ZT);
    const float* cw = INP(F, I_HCW) + (size_t)layer * 3 * 3072; const float* cb = INP(F, I_HCB) + (size_t)layer * 3072;
    const int gw = F.bid * 8 + F.wave, NGW = F.G * 8, lane = F.lane, tsub = lane >> 4, cq = lane & 15;
    LAS bf16* tl = (LAS bf16*)(F.lds + F.wave * 16384);
    for (int it = gw; it < 256 * 16; it += NGW) {
        const int tt0 = (it >> 4) * 64, c0 = (it & 15) * 64, c4 = c0 + 4 * cq;
        const int t0 = tt0 < NPR ? (tt0 & 255) : ((tt0 - NPR) & 2047), L = tt0 < NPR ? L_P : L_S;
        f32x4 w1[3], w2[3];
#pragma unroll
        for (int tp = 0; tp < 3; ++tp) { w1[tp] = *(const f32x4*)(cw + tp * 3072 + 1024 + c4); w2[tp] = *(const f32x4*)(cw + tp * 3072 + 2048 + c4); }
        const f32x4 b1 = *(const f32x4*)(cb + 1024 + c4), b2 = *(const f32x4*)(cb + 2048 + c4);
        const bf16* px = proj + (size_t)tt0 * NPROJ + COL_X1 + c4;
#pragma unroll 1
        for (int hf = 0; hf < 2; ++hf) {
            u32x2 xr[8][3], vr[8][3];
#pragma unroll
            for (int i = 0; i < 8; ++i) { const int tt = 4 * (hf * 8 + i) + tsub;
#pragma unroll
                for (int d = 0; d < 3; ++d) { const int t = t0 + tt + d - 1; const bool ok = (t >= 0) && (t < L); const bf16* p = px + (long)(tt + d - 1) * NPROJ;
                    xr[i][d] = ok ? *(const u32x2*)p : (u32x2){0u, 0u}; vr[i][d] = ok ? *(const u32x2*)(p + 1024) : (u32x2){0u, 0u}; } }
#pragma unroll
            for (int i = 0; i < 8; ++i) { const int tt = 4 * (hf * 8 + i) + tsub;
                const f32x4 x1c = unpack4(xr[i][0]) * w1[0] + unpack4(xr[i][1]) * w1[1] + unpack4(xr[i][2]) * w1[2] + b1;
                const f32x4 vvc = unpack4(vr[i][0]) * w2[0] + unpack4(vr[i][1]) * w2[1] + unpack4(vr[i][2]) * w2[2] + b2;
                *(LAS u32x2*)(tl + tt * 68 + 4 * cq) = pack4(x1c * vvc); }
        }
        LDS_WAIT(); asm volatile("" ::: "memory");
#pragma unroll 16
        for (int cc = 0; cc < 64; ++cc) zT[(size_t)(c0 + cc) * M + tt0 + lane] = tl[lane * 68 + cc];
        LDS_WAIT(); asm volatile("" ::: "memory");
    }
}

__device__ __forceinline__ void hyena_conv_phase(const Frame& F, const Args& a, int layer) {
    unsigned char* ws = WSP(F);
    bf16* zT = (bf16*)(ws + WS_ZT);
    const float* FNORM = (const float*)(ws + WS_CTL) + CW_FNORM;
    const int lane = F.lane, w = F.wave, r = lane & 31, h = lane >> 5;
    LAS unsigned char* lds = F.lds;
    for (int u = F.bid; u < 2048; u += F.G) {
        const bool sample = u < 1024; const int c = u & 1023;
        const int L = sample ? L_S : L_P, LP = sample ? LPS : LPP, FCS = LP * 2;
        const int ZROW = (L + 448) * 2, ZOFF = 2 * FCS;
        const int NB = sample ? 4 : 32, tokb = sample ? NPR : 0;
        const bf16* fsrc = sample ? (const bf16*)(ws + WS_FS) + ((size_t)layer * 1024 + c) * LPS : (const bf16*)(ws + WS_FP) + ((size_t)layer * 1024 + c) * LPP;
        __syncthreads();
        for (int i = F.tid; i < LP / 8; i += 512) *(LAS u32x4*)(lds + i * 16) = *(const u32x4*)(fsrc + i * 8);
        for (int i = F.tid; i < LP; i += 512) *(LAS bf16*)(lds + FCS + i * 2) = (i + 1 < LP) ? fsrc[i + 1] : (bf16)0;
        { const int cpr = L / 8;
          for (int i = F.tid; i < NB * cpr; i += 512) { const int b = i / cpr, q = i - b * cpr;
              *(LAS u32x4*)(lds + ZOFF + b * ZROW + 448 + q * 16) = *(const u32x4*)(zT + (size_t)c * M + tokb + b * L + q * 8); }
          if (sample) for (int i = F.tid; i < NB * 56; i += 512) { const int b = i / 56, q = i - b * 56;
              *(LAS u32x4*)(lds + ZOFF + b * ZROW + (q < 28 ? q * 16 : 448 + L * 2 + (q - 28) * 16)) = (u32x4){0u, 0u, 0u, 0u}; } }
        __syncthreads();
        const int nbl = sample ? 2 : 5;
        const int I0 = sample ? 8 * w : w;
        const int b = r & (NB - 1), I = I0 + (r >> nbl);
        int dlo = (sample ? I0 - 63 : I0 - 7), dhi = (sample ? I0 + 7 : I0);
        const int dmax = L / 64;
        dlo = dlo < -dmax ? -dmax : dlo; dhi = dhi > dmax ? dmax : dhi;
        f32x16 acc;
#pragma unroll
        for (int i = 0; i < 16; ++i) acc[i] = 0.f;
        const LAS unsigned char* zb = lds + ZOFF + b * ZROW + (224 + 8 * h) * 2;
#pragma unroll 2
        for (int d = dlo; d <= dhi; ++d) {
#pragma unroll
            for (int ks = 0; ks < 2; ++ks) {
                const int st = (L / 2 - 1) - 32 * d - r + 16 * ks + 8 * h + 32;
                const int par = st & 1;
                const LAS unsigned* ap = (const LAS unsigned*)(lds + par * FCS + (st - par) * 2);
                const u32x4 aw = (u32x4){ap[0], ap[1], ap[2], ap[3]};
                const bf16x8 af = __builtin_bit_cast(bf16x8, aw);
                const bf16x8 bfr = *(const LAS bf16x8*)(zb + (32 * (I - d) + 16 * ks) * 2);
                acc = __builtin_amdgcn_mfma_f32_32x32x16_bf16(af, bfr, acc, 0, 0, 0);
            }
        }
        const float inv = 1.0f / (FNORM[((size_t)layer * 2 + (sample ? 0 : 1)) * 1024 + c] + 1e-6f);
        const float dco = INP(F, I_HD)[layer * 1024 + c];
        __syncthreads();
#pragma unroll
        for (int g = 0; g < 4; ++g) {
            const int t = 32 * I + 8 * g + 4 * h;
            const LAS bf16* zp = (const LAS bf16*)(lds + ZOFF + b * ZROW + (224 + t) * 2);
            float o[4];
#pragma unroll
            for (int j = 0; j < 4; ++j) o[j] = acc[4 * g + j] * inv + bf2f(zp[j]) * dco;
            *(u32x2*)(zT + (size_t)c * M + tokb + b * L + t) = (u32x2){cvtpk(o[0], o[1]), cvtpk(o[2], o[3])};
        }
    }
    __syncthreads();
}

__device__ __forceinline__ void hyena_post_phase(const Frame& F, const Args& a, int layer) {
    unsigned char* ws = WSP(F);
    const bf16* proj = (const bf16*)(ws + WS_PROJ);
    const bf16* yT = (const bf16*)(ws + WS_ZT);
    bf16* oall = (bf16*)(ws + WS_OALL);
    const float* cw = INP(F, I_HCW) + (size_t)layer * 3 * 3072; const float* cb = INP(F, I_HCB) + (size_t)layer * 3072;
    const int gw = F.bid * 8 + F.wave, NGW = F.G * 8, lane = F.lane, tsub = lane >> 4, cq = lane & 15;
    LAS bf16* tl = (LAS bf16*)(F.lds + F.wave * 16384);
    for (int it = gw; it < 256 * 16; it += NGW) {
        const int tt0 = (it >> 4) * 64, c0 = (it & 15) * 64, c4 = c0 + 4 * cq;
        const int t0 = tt0 < NPR ? (tt0 & 255) : ((tt0 - NPR) & 2047), L = tt0 < NPR ? L_P : L_S;
#pragma unroll 1
        for (int q = 0; q < 4; ++q) { bf16 tmp[16];
#pragma unroll
            for (int j = 0; j < 16; ++j) tmp[j] = yT[(size_t)(c0 + q * 16 + j) * M + tt0 + lane];
#pragma unroll
            for (int j = 0; j < 16; ++j) tl[(q * 16 + j) * 68 + lane] = tmp[j]; }
        LDS_WAIT(); asm volatile("" ::: "memory");
        f32x4 w0[3];
#pragma unroll
        for (int tp = 0; tp < 3; ++tp) w0[tp] = *(const f32x4*)(cw + tp * 3072 + c4);
        const f32x4 b0 = *(const f32x4*)(cb + c4);
        const bf16* px = proj + (size_t)tt0 * NPROJ + COL_X0 + c4;
#pragma unroll 1
        for (int hf = 0; hf < 2; ++hf) {
            u32x2 xr[8][3];
#pragma unroll
            for (int i = 0; i < 8; ++i) { const int tt = 4 * (hf * 8 + i) + tsub;
#pragma unroll
                for (int d = 0; d < 3; ++d) { const int t = t0 + tt + d - 1; const bool ok = (t >= 0) && (t < L); xr[i][d] = ok ? *(const u32x2*)(px + (long)(tt + d - 1) * NPROJ) : (u32x2){0u, 0u}; } }
#pragma unroll
            for (int i = 0; i < 8; ++i) { const int tt = 4 * (hf * 8 + i) + tsub;
                const f32x4 x0c = unpack4(xr[i][0]) * w0[0] + unpack4(xr[i][1]) * w0[1] + unpack4(xr[i][2]) * w0[2] + b0;
                const f32x4 yv = (f32x4){bf2f(tl[(4 * cq + 0) * 68 + tt]), bf2f(tl[(4 * cq + 1) * 68 + tt]), bf2f(tl[(4 * cq + 2) * 68 + tt]), bf2f(tl[(4 * cq + 3) * 68 + tt])};
                *(u32x2*)(oall + (size_t)(tt0 + tt) * 3072 + 2048 + c4) = pack4(x0c * yv); }
        }
        LDS_WAIT(); asm volatile("" ::: "memory");
    }
}

constexpr int NPL = 13, PH_LAYER0 = 2, PH_FINAL = PH_LAYER0 + DEPTH * NPL, N_PHASES = PH_FINAL + 1;

__global__ void __launch_bounds__(512, 2) mega(Args args) {
    extern __shared__ __attribute__((aligned(16))) unsigned char lds_raw[];
    Frame F;
    F.lds = (LAS unsigned char*)lds_raw;
    F.tid = threadIdx.x; F.lane = F.tid & 63; F.wave = __builtin_amdgcn_readfirstlane(F.tid >> 6);
    F.G = gridDim.x; F.bid = blockIdx.x;
    for (int u = F.tid; u < (LDS_BYTES - LDSCTL_OFF) / 4; u += 512) ((LAS unsigned*)(F.lds + LDSCTL_OFF))[u] = 0u;
    __syncthreads();
    if (F.tid < 48) { const unsigned long long p = F.tid < 46 ? (unsigned long long)args.in[F.tid] : (F.tid == 46 ? (unsigned long long)args.out : (unsigned long long)args.ws);
        ((LAS unsigned*)(F.lds + LDS_ARGT))[2 * F.tid] = (unsigned)p; ((LAS unsigned*)(F.lds + LDS_ARGT))[2 * F.tid + 1] = (unsigned)(p >> 32); }
    __syncthreads();
    unsigned char* ws = WSP(F);
    unsigned* ctl = (unsigned*)(ws + WS_CTL);
    int lo = args.ph_lo, hi = args.ph_hi;
    const bool single = (hi - lo) > 1;
    XcdBarrier bar; bar.bar = ctl + CW_BAR; bar.x = 0; bar.st = (volatile LAS unsigned*)(F.lds + LDSCTL_OFF + 64);
    if (single) bar = xcd_barrier_post(ctl + CW_BAR, (volatile LAS unsigned*)(F.lds + LDSCTL_OFF + 64));
#ifndef MK_EN
#define MK_EN 0xFFFFFF
#endif
#define IN(k) (lo <= (k) && (k) < hi)
#define EN(b) ((MK_EN >> (b)) & 1)
#ifndef MK_DUP
#define MK_DUP -1
#endif
#define REPS(k) ((MK_DUP == (k)) ? 2 : 1)
#define FRESH() do { F.lane = lane_id(); asm volatile("" : "+v"(F.lane), "+s"(F.bid), "+s"(F.wave), "+s"(F.G)); F.tid = F.wave * 64 + F.lane; } while (0)
#define SEAM(k) do { if (IN(k) && IN((k) + 1)) xcd_barrier(bar); } while (0)

    if (EN(20) && IN(0)) { for (int rep = 0; rep < REPS(100); ++rep) { FRESH(); prologue0(F, args); if (rep + 1 < REPS(100)) xcd_barrier(bar); } SEAM(0); }
    if (EN(21) && IN(1)) { FRESH(); prologue1(F, args); SEAM(1); }

    bf16* Hb = (bf16*)(ws + WS_H); bf16* proj = (bf16*)(ws + WS_PROJ); bf16* oall = (bf16*)(ws + WS_OALL);
    float* x = OUTP(F);
#pragma unroll 1
    for (int l = 0; l < DEPTH; ++l) {
        const int pb = PH_LAYER0 + l * NPL;
        asm volatile("" : "+s"(lo), "+s"(hi));
        const float* mod = (const float*)(ws + WS_MOD) + (size_t)l * 5 * 12288;
        if (EN(0) && IN(pb + 0)) { for (int rep = 0; rep < REPS(0); ++rep) { FRESH();
            norm_phase(F, l == 0 ? INP(F, I_XP) : x, l == 0 ? INP(F, I_XS) : x + (size_t)NPR * D, l == 0 ? x : nullptr, INP(F, I_LN1) + l * D, mod, 0, 1, Hb);
            if (rep + 1 < REPS(0)) xcd_barrier(bar); }
            SEAM(pb + 0);
        }
        if (EN(1) && IN(pb + 1)) { for (int rep = 0; rep < REPS(1); ++rep) { FRESH();
            pg8::Gemm g{Hb, (const bf16*)(ws + WS_WIN) + (size_t)l * NPROJ * D, D, D, D, 0, 0, 0};
            pg8::Order S; S.init(M, NPROJ, F.G, F.bid, 1);
            pg8::EpiProj E{proj, x + OUT_CK, x + OUT_CV, l};
            pg8::gemm_phase(F.lds, g, S, E, F.wave);
            if (rep + 1 < REPS(1)) xcd_barrier(bar); }
            SEAM(pb + 1);
        }
        if (EN(2) && IN(pb + 2)) { for (int rep = 0; rep < REPS(2); ++rep) { FRESH();
            pg8::Gemm g{proj + COL_LW, (const bf16*)(ws + WS_W2T) + (size_t)l * 5120 * 256, NPROJ, 256, 256, 0, 128, 4};
            pg8::Order5 S; S.init(M, F.G, F.bid);
            pg8::EpiLora2 E{(float*)(ws + WS_DEC), (bf16*)(ws + WS_A), (bf16*)(ws + WS_G), INP(F, I_W0) + l * 2048, INP(F, I_A0) + l * 2048};
            pg8::gemm_phase(F.lds, g, S, E, F.wave);
            if (rep + 1 < REPS(2)) xcd_barrier(bar); }
            SEAM(pb + 2);
        }
        if (EN(3) && IN(pb + 3)) { for (int rep = 0; rep < REPS(3); ++rep) { FRESH();
            attention_phase(F, args, l); FRESH();
            hyena_prep_phase(F, args, l); FRESH();
            rwkv_prep_phase(F, args, l);
            if (rep + 1 < REPS(3)) xcd_barrier(bar); }
            SEAM(pb + 3);
        }
        if (EN(4) && IN(pb + 4)) { for (int rep = 0; rep < REPS(4); ++rep) { FRESH(); rwkv_tinv_phase(F); FRESH(); hyena_conv_phase(F, args, l); if (rep + 1 < REPS(4)) xcd_barrier(bar); } SEAM(pb + 4); }
        if (EN(5) && IN(pb + 5)) { for (int rep = 0; rep < REPS(5); ++rep) { FRESH(); rwkv_cscan_phase(F, l); if (rep + 1 < REPS(5)) xcd_barrier(bar); } SEAM(pb + 5); }
        if (EN(7) && IN(pb + 7)) { for (int rep = 0; rep < REPS(7); ++rep) { FRESH(); rwkv_post_phase(F, args, l); FRESH(); hyena_post_phase(F, args, l); if (rep + 1 < REPS(7)) xcd_barrier(bar); } SEAM(pb + 7); }
        if (EN(8) && IN(pb + 8)) { for (int rep = 0; rep < REPS(8); ++rep) { FRESH();
            pg8::Gemm g{oall, (const bf16*)(ws + WS_WP) + (size_t)l * 3 * D * 1024, 3072, 1024, 1024, 1024, 0, 8};
            pg8::Order S; S.init(M, D, F.G, F.bid, 3);
            pg8::EpiMerge E{proj, Hb};
            pg8::gemm_phase(F.lds, g, S, E, F.wave);
            if (rep + 1 < REPS(8)) xcd_barrier(bar); }
            SEAM(pb + 8);
        }
        if (EN(9) && IN(pb + 9)) { for (int rep = 0; rep < REPS(9); ++rep) { FRESH();
            pg8::Gemm g{Hb, (const bf16*)(ws + WS_WOUT) + (size_t)l * D * D, D, D, D, 0, 0, 0};
            pg8::Order S; S.init(M, D, F.G, F.bid, 1);
            pg8::EpiResid E{x, mod + 2 * D, nullptr};
            pg8::gemm_phase(F.lds, g, S, E, F.wave);
            if (rep + 1 < REPS(9)) xcd_barrier(bar); }
            SEAM(pb + 9);
        }
        if (EN(10) && IN(pb + 10)) { for (int rep = 0; rep < REPS(10); ++rep) { FRESH(); norm_phase(F, x, x + (size_t)NPR * D, nullptr, INP(F, I_LN2) + l * D, mod, 3, 4, Hb); if (rep + 1 < REPS(10)) xcd_barrier(bar); } SEAM(pb + 10); }
        if (EN(11) && IN(pb + 11)) { for (int rep = 0; rep < REPS(11); ++rep) { FRESH();
            pg8::Gemm g{Hb, (const bf16*)(ws + WS_WFF1) + (size_t)l * D * DFF, D, D, D, 0, 0, 0};
            pg8::Order S; S.init(M, DFF, F.G, F.bid, 1);
            pg8::EpiFF1 E{proj, INP(F, I_BFF1) + l * DFF};
            pg8::gemm_phase(F.lds, g, S, E, F.wave);
            if (rep + 1 < REPS(11)) xcd_barrier(bar); }
            SEAM(pb + 11);
        }
        if (EN(12) && IN(pb + 12)) { for (int rep = 0; rep < REPS(12); ++rep) { FRESH();
            pg8::Gemm g{proj, (const bf16*)(ws + WS_WFF2) + (size_t)l * D * DFF, DFF, DFF, DFF, 0, 0, 0};
            pg8::Order S; S.init(M, D, F.G, F.bid, 1);
            pg8::EpiResid E{x, mod + 5 * D, INP(F, I_BFF2) + l * D};
            pg8::gemm_phase(F.lds, g, S, E, F.wave);
            if (rep + 1 < REPS(12)) xcd_barrier(bar); }
            SEAM(pb + 12);
        }
    }
    asm volatile("" : "+s"(lo), "+s"(hi));
    if (EN(22) && IN(PH_FINAL)) { FRESH(); final_norm_phase(F, OUTP(F), INP(F, I_FING)); }
#undef IN
#undef SEAM
}

extern "C" void kernel_launch(void* const* d_in, const int* in_sizes, int n_in, void* d_out, int out_size, void* d_ws, size_t ws_size, hipStream_t stream) {
    static int grid = 0;
    if (grid == 0) {
        if (n_in != N_INPUTS || (size_t)out_size != OUT_TOTAL || ws_size < WS_END) { fprintf(stderr, "kernel_launch: unexpected shapes: n_in %d out %d ws %zu\n", n_in, out_size, ws_size); grid = -1; return; }
        int dev = 0, cus = 0, per_cu = 0;
        if (hipGetDevice(&dev) != hipSuccess || hipDeviceGetAttribute(&cus, hipDeviceAttributeMultiprocessorCount, dev) != hipSuccess) { grid = -1; return; }
        if (hipFuncSetAttribute((const void*)mega, hipFuncAttributeMaxDynamicSharedMemorySize, LDS_BYTES) != hipSuccess) { fprintf(stderr, "kernel_launch: hipFuncSetAttribute failed\n"); grid = -1; return; }
        if (hipOccupancyMaxActiveBlocksPerMultiprocessor(&per_cu, (const void*)mega, 512, LDS_BYTES) != hipSuccess || per_cu < 1) { fprintf(stderr, "kernel_launch: occupancy query says %d\n", per_cu); }
        (void)hipGetLastError();
        grid = cus;
    }
    if (grid < 0) return;
    (void)hipMemsetAsync((char*)d_ws + WS_CTL, 0, CTL_ZERO_BYTES, stream);
    Args a{};
    for (int i = 0; i < N_INPUTS; ++i) a.in[i] = (const float*)d_in[i];
    a.out = (float*)d_out; a.ws = (unsigned char*)d_ws;
#if MK_MULTI
    for (int ph = 0; ph < N_PHASES; ++ph) { a.ph_lo = ph; a.ph_hi = ph + 1; hipLaunchKernelGGL(mega, dim3(grid), dim3(512), LDS_BYTES, stream, a); }
#else
    a.ph_lo = 0; a.ph_hi = N_PHASES;
    hipLaunchKernelGGL(mega, dim3(grid), dim3(512), LDS_BYTES, stream, a);
#endif
    const hipError_t le = hipPeekAtLastError();
    if (le != hipSuccess) fprintf(stderr, "kernel_launch: launch failed: %s\n", hipGetErrorName(le));
}
```

```cpp
#include <hip/hip_runtime.h>
#include <cstdio>
#include <cstdint>

#ifndef MK_MULTI
#define MK_MULTI 0
#endif

#define GAS __attribute__((address_space(1)))
#define LAS __attribute__((address_space(3)))
typedef unsigned short bf16;
typedef short bf16x8 __attribute__((ext_vector_type(8)));
typedef short s16x4 __attribute__((ext_vector_type(4)));
typedef float f32x4 __attribute__((ext_vector_type(4)));
typedef float f32x2 __attribute__((ext_vector_type(2)));
typedef float f32x16 __attribute__((ext_vector_type(16)));
typedef unsigned u32x4 __attribute__((ext_vector_type(4)));
typedef unsigned u32x2 __attribute__((ext_vector_type(2)));
typedef __bf16 bf16x2_t __attribute__((ext_vector_type(2)));

constexpr int D = 2048, DEPTH = 4, NPR = 8192  , M = 16384, DFF = 8192;
constexpr int NPROJ = 15872;
constexpr int COL_K = 1024, COL_V = 2048, COL_R = 3072, COL_X0 = 6144, COL_X1 = 7168, COL_VV = 8192, COL_GL = 9216, COL_LW = 15360, COL_G1A = 15488;
constexpr int L_P = 256, L_S = 2048;

enum { I_XP = 0, I_XS, I_CK, I_CV, I_ST, I_C, I_CCTX, I_LN1, I_LN2, I_WMOD, I_BMOD, I_WIN, I_RPB, I_CW, I_CB, I_W0, I_W1, I_W2, I_A0, I_A1, I_A2, I_G1, I_G2,
       I_KK, I_KA, I_RK, I_GNG, I_GNB, I_HCW, I_HCB, I_F1, I_FB1, I_F2, I_FB2, I_FREQ, I_F3, I_HD, I_WPA, I_WPR, I_WPC, I_WOUT, I_FF1, I_BFF1, I_FF2, I_BFF2, I_FING, N_INPUTS };

constexpr size_t OUT_X = 0, OUT_CK = 33554432, OUT_CV = 67108864, OUT_ST = 100663296, OUT_TOTAL = 117440512;

constexpr size_t MiB = 1u << 20;
constexpr size_t WS_CTL = 0, CTL_ZERO_BYTES = 1 * MiB;
constexpr size_t WS_WIN = 2 * MiB;
constexpr size_t WS_W2T = 250 * MiB;
constexpr size_t WS_WP = 260 * MiB;
constexpr size_t WS_WOUT = 308 * MiB;
constexpr size_t WS_WFF1 = 340 * MiB;
constexpr size_t WS_WFF2 = 468 * MiB;
constexpr size_t WS_H = 596 * MiB;
constexpr size_t WS_A = 660 * MiB;
constexpr size_t WS_PROJ = 724 * MiB;
constexpr size_t WS_OALL = 1220 * MiB;
constexpr size_t WS_DEC = 1316 * MiB;
constexpr size_t WS_G = 1444 * MiB;
constexpr size_t WS_TIL = 1476 * MiB;
constexpr size_t WS_CK = 1764 * MiB;
constexpr size_t WS_CV = 1772 * MiB;
constexpr size_t WS_FS = 1780 * MiB;
constexpr size_t WS_FP = 1797 * MiB;
constexpr size_t WS_ZT = 1800 * MiB;
constexpr size_t WS_MOD = 1832 * MiB;
constexpr size_t WS_T2 = 1833 * MiB;
constexpr size_t WS_BONUS = 1837 * MiB;
constexpr size_t WS_TINV = 1838 * MiB;
constexpr size_t WS_Q = WS_TINV;
constexpr size_t WS_WTB = 1870 * MiB;
constexpr size_t WS_END = 1874 * MiB;
constexpr int TILP = 576;
constexpr int LPS = 2120, LPP = 328;

constexpr int CW_BAR = 4096;
constexpr int CW_FNORM = 32768;

constexpr int LDS_SCRATCH = 131072, LDSCTL_OFF = 131072, LDS_BYTES = 147456;

#define LDS_WAIT() asm volatile("s_waitcnt lgkmcnt(0)" ::: "memory")
#define VM_WAIT() asm volatile("s_waitcnt vmcnt(0)" ::: "memory")
__device__ __forceinline__ unsigned cvtpk(float lo, float hi) { f32x2 v = {lo, hi}; bf16x2_t b = __builtin_convertvector(v, bf16x2_t); return __builtin_bit_cast(unsigned, b); }
__device__ __forceinline__ bf16 f2bf(float f) { return (bf16)(cvtpk(f, 0.f) & 0xffffu); }
__device__ __forceinline__ float bf2f(bf16 b) { return __uint_as_float(((unsigned)b) << 16); }
__device__ __forceinline__ float bflo(unsigned w) { return __uint_as_float(w << 16); }
__device__ __forceinline__ float bfhi(unsigned w) { return __uint_as_float(w & 0xffff0000u); }
#define DPPF(v, ctrl) __int_as_float(__builtin_amdgcn_update_dpp(0, __float_as_int(v), (ctrl), 0xf, 0xf, false))
__device__ __forceinline__ float wave_sum(float v) {
    v += DPPF(v, 0xB1); v += DPPF(v, 0x4E); v += DPPF(v, 0x141); v += DPPF(v, 0x140);
    const float a = __int_as_float(__builtin_amdgcn_readlane(__float_as_int(v), 0)), b = __int_as_float(__builtin_amdgcn_readlane(__float_as_int(v), 16)),
                c = __int_as_float(__builtin_amdgcn_readlane(__float_as_int(v), 32)), d = __int_as_float(__builtin_amdgcn_readlane(__float_as_int(v), 48));
    return (a + b) + (c + d);
}
__device__ __forceinline__ float xor32(float v, int lane) { return __int_as_float(__builtin_amdgcn_ds_bpermute((lane ^ 32) << 2, __float_as_int(v))); }
__device__ __forceinline__ int lane_id() { return (int)__builtin_amdgcn_mbcnt_hi(~0u, __builtin_amdgcn_mbcnt_lo(~0u, 0u)); }
__device__ __forceinline__ float sigmoidf_(float x) { return 1.0f / (1.0f + __expf(-x)); }

#define XB_TMO      128
#define XB_XCNT(j)  (256  + 64 * (j))
#define XB_XSUB(j)  (1280 + 64 * (j))
#define XB_XGEN(j)  (2304 + 64 * (j))
#define XB_TOP      3328
#define XB_TOPGEN   3392
#define XCD_BAR_WORDS 3456
#define XB_SPIN_CAP (1u << 20)
__device__ __forceinline__ unsigned xb_ld(unsigned* p)              { return __hip_atomic_load(p, __ATOMIC_RELAXED, __HIP_MEMORY_SCOPE_AGENT); }
__device__ __forceinline__ unsigned xb_add(unsigned* p, unsigned v) { return __hip_atomic_fetch_add(p, v, __ATOMIC_RELAXED, __HIP_MEMORY_SCOPE_AGENT); }
__device__ __forceinline__ unsigned xb_xcc_id() { return (unsigned)__builtin_amdgcn_s_getreg((3 << 11) | 20) & 0xFu; }
#define XB_SPIN(cond, bar) do { unsigned _sp = 0; while (cond) { __builtin_amdgcn_s_sleep(1); \
    if ((++_sp & 255u) == 0u) { if (xb_ld(&(bar)[XB_TMO])) break; if (_sp > XB_SPIN_CAP) { atomicAdd(&(bar)[XB_TMO], 1u); break; } } } } while (0)
struct XcdBarrier { unsigned* bar; unsigned x; volatile LAS unsigned* st; int wave; };
__device__ __forceinline__ XcdBarrier xcd_barrier_post(unsigned* bar, volatile LAS unsigned* st, int wave) {
    XcdBarrier b; b.bar = bar; b.x = xb_xcc_id(); b.st = st; b.wave = wave;
    if (wave == 0 && lane_id() == 0) (void)xb_add(&bar[XB_XCNT(b.x)], 1u);
    return b;
}
__device__ __forceinline__ void xcd_barrier_complete(unsigned* bar, unsigned x, unsigned& nloc, unsigned& nx) {
    const unsigned G = gridDim.x * gridDim.y * gridDim.z;
    unsigned sum, cnt, mine, sp = 0u;
    for (;;) {
        sum = 0u; cnt = 0u; mine = 0u;
#pragma unroll
        for (unsigned j = 0; j < 16; ++j) { const unsigned c = xb_ld(&bar[XB_XCNT(j)]); sum += c; cnt += (c > 0u) ? 1u : 0u; mine = (j == x) ? c : mine; }
        if (sum == G) break;
        __builtin_amdgcn_s_sleep(1);
        if ((++sp & 255u) == 0u) { if (xb_ld(&bar[XB_TMO])) break; if (sp > XB_SPIN_CAP) { atomicAdd(&bar[XB_TMO], 1u); break; } }
    }
    nloc = mine > 0u ? mine : 1u; nx = cnt > 0u ? cnt : 1u;
}
__device__ __forceinline__ void xcd_barrier(const XcdBarrier& b) {
    asm volatile("s_waitcnt vmcnt(0)" ::: "memory");
    __syncthreads();
    if (b.wave == 0 && lane_id() == 0) {
        unsigned* bar = b.bar; asm volatile("" : "+s"(bar));
        __builtin_amdgcn_s_waitcnt(0);
        unsigned nloc = b.st[0], nx = b.st[1];
        if (nloc == 0u) { xcd_barrier_complete(bar, b.x, nloc, nx); b.st[0] = nloc; b.st[1] = nx; }
        const unsigned old = xb_add(&bar[XB_XSUB(b.x)], 1u);
        const unsigned gen = old / nloc;
        if (old + 1u == (gen + 1u) * nloc) {
            __builtin_amdgcn_fence(__ATOMIC_RELEASE, "agent");
            asm volatile("s_waitcnt vmcnt(0)" ::: "memory");
            const unsigned og = xb_add(&bar[XB_TOP], 1u);
            const unsigned tg = og / nx;
            if (og + 1u == (tg + 1u) * nx) xb_add(&bar[XB_TOPGEN], 1u);
            else XB_SPIN(xb_ld(&bar[XB_TOPGEN]) == tg, bar);
            __builtin_amdgcn_fence(__ATOMIC_ACQUIRE, "agent");
            xb_add(&bar[XB_XGEN(b.x)], 1u);
            asm volatile("s_waitcnt vmcnt(0)" ::: "memory");
        } else {
            XB_SPIN(xb_ld(&bar[XB_XGEN(b.x)]) == gen, bar);
            __builtin_amdgcn_fence(__ATOMIC_ACQUIRE, "agent");
            asm volatile("s_waitcnt vmcnt(0)" ::: "memory");
        }
    }
    __syncthreads();
}

struct Args { const float* in[N_INPUTS]; float* out; unsigned char* ws; int ph_lo, ph_hi; };
struct Frame {
    LAS unsigned char* lds;
    int tid, lane, wave, G, bid;
};
constexpr int LDS_ARGT = 131072 + 1024;
__device__ __forceinline__ const float* INP(const Frame& F, int k) {
    const LAS unsigned* t = (const LAS unsigned*)(F.lds + LDS_ARGT) + 2 * k;
    const unsigned lo = __builtin_amdgcn_readfirstlane(t[0]), hi = __builtin_amdgcn_readfirstlane(t[1]);
    return (const float*)(((unsigned long long)hi << 32) | lo);
}
__device__ __forceinline__ float* OUTP(const Frame& F) { return (float*)INP(F, 46); }
__device__ __forceinline__ unsigned char* WSP(const Frame& F) { return (unsigned char*)INP(F, 47); }

namespace pg8 {
constexpr int BM = 256, BK = 64, HALF = 128, HTB = HALF * BK * 2, STAGE_BYTES = 8 * HTB, NXCD = 8, WGM = 8;
__host__ __device__ __forceinline__ int lds_byte(int r, int c) { const int st = (r >> 4) * 2 + (c >> 5), rr = r & 15, cc = c & 31, ob = rr * 64 + cc * 2; return st * 1024 + (ob ^ (((ob >> 9) & 1) << 5)); }
__host__ __device__ __forceinline__ void stage_rc(int b, int& R, int& C) { const int st = b / 1024, sb = b % 1024, swz = sb ^ (((sb >> 9) & 1) << 5); R = (st >> 1) * 16 + swz / 64; C = (st & 1) * 32 + (swz % 64) / 2; }
__host__ __device__ __forceinline__ int perm32(int rho) { const int n = rho >> 4, i = rho & 15; return 8 * (i >> 2) + 4 * n + (i & 3); }

struct Unit { int pm, pn, br; };
struct Gemm { const bf16* A; const bf16* Bt; int lda, ldb, K; int a_br_stride  , a_br4_off  , b_br_tiles  ; };

struct Order {
    int nM, nN, nwg, G, c, nbr;
    __device__ void init(int Mrows, int N, int G_, int c_, int nbr_) { nM = Mrows / BM; nN = N / BM; nwg = nM * nN; G = G_; c = c_; nbr = nbr_; }
    __device__ bool next(int i, Unit& u) const {
        const int it = i / nbr; u.br = i - it * nbr;
        const long L = (long)it * G + c; if (L >= nwg) return false;
        int wgid = (int)L; { const int q = nwg / NXCD, r = nwg % NXCD, xcd = wgid % NXCD, off = wgid / NXCD; wgid = (xcd < r ? xcd * (q + 1) : r * (q + 1) + (xcd - r) * q) + off; }
        const int nig = WGM * nN, gid = wgid / nig, fm = gid * WGM, gsz = (nM - fm) < WGM ? (nM - fm) : WGM;
        u.pm = fm + ((wgid % nig) % gsz); u.pn = (wgid % nig) / gsz; return true;
    }
};
struct Order5 {
    Order o;
    __device__ void init(int Mrows, int G_, int c_) { o.init(Mrows, 20 * BM, G_, c_, 1); }
    __device__ bool next(int i, Unit& u) const { if (!o.next(i, u)) return false; u.br = u.pn >> 2; u.pn &= 3; return true; }
};

template <class Epi, class Sched>
__device__ __forceinline__ void gemm_phase(LAS unsigned char* lds, const Gemm g, const Sched& S, const Epi& E, int wave) {
    int tid = wave * 64 + lane_id(); asm volatile("" : "+v"(tid));
    const int wid = __builtin_amdgcn_readfirstlane(tid >> 6), lane = tid & 63, wr = wid >> 2, wc = wid & 3, fr = lane & 15, fq = lane >> 4;
    const int K = g.K, nt = K / BK;
    unsigned voffA[2], voffB[2];
#pragma unroll
    for (int i = 0; i < 2; ++i) { int R, C; stage_rc(tid * 16 + i * 8192, R, C); const int Rb = Epi::PERM ? ((R & ~31) + perm32(R & 31)) : R;
        voffA[i] = (unsigned)(R * g.lda + C) * 2u; voffB[i] = (unsigned)(Rb * g.ldb + C) * 2u; }
    const size_t kstep = (size_t)(BK * 2);
    const size_t hstepA = (size_t)HALF * g.lda * 2, hstepB = (size_t)HALF * g.ldb * 2;
    const unsigned ldsw = (unsigned)wid * 1024u;
    const int aoff = lds_byte(wr * 64 + fr, fq * 8), boff = lds_byte(wc * 32 + fr, fq * 8);
#define PG8_APTR(u) ((const char*)g.A + ((size_t)(u).pm * 256 * g.lda + (size_t)(u).br * g.a_br_stride + ((u).br == 4 ? g.a_br4_off : 0)) * 2)
#define PG8_BPTR(u) ((const char*)g.Bt + ((size_t)((u).br * g.b_br_tiles + (u).pn) * 256 * g.ldb) * 2)
#define PG8_SA(b, h) (((b) * 2 + (h)) * HTB)
#define PG8_SB(b, h) ((4 + (b) * 2 + (h)) * HTB)
#define PG8_STAGE(bufoff, gbase, voff) do { _Pragma("unroll") for (int _i = 0; _i < 2; ++_i) \
        __builtin_amdgcn_global_load_lds((const unsigned*)((const char*)(gbase) + (voff)[_i]), (LAS unsigned*)(lds + (bufoff) + ldsw + _i * 8192), 16, 0, 0); } while (0)
#define PG8_LDA(dst, b, h) do { _Pragma("unroll") for (int m = 0; m < 4; ++m) _Pragma("unroll") for (int k = 0; k < 2; ++k) dst[m][k] = *(const LAS bf16x8*)(lds + PG8_SA(b, h) + aoff + m * 2048 + k * 1024); } while (0)
#define PG8_LDB(dst, b, h) do { _Pragma("unroll") for (int n = 0; n < 2; ++n) _Pragma("unroll") for (int k = 0; k < 2; ++k) dst[n][k] = *(const LAS bf16x8*)(lds + PG8_SB(b, h) + boff + n * 2048 + k * 1024); } while (0)
#define PG8_MMA(ai, bj, At, Bt) do { __builtin_amdgcn_s_setprio(1); _Pragma("unroll") for (int m = 0; m < 4; ++m) _Pragma("unroll") for (int n = 0; n < 2; ++n) _Pragma("unroll") for (int k = 0; k < 2; ++k) \
        acc[ai][bj][m][n] = __builtin_amdgcn_mfma_f32_16x16x32_bf16(Bt[n][k], At[m][k], acc[ai][bj][m][n], 0, 0, 0); __builtin_amdgcn_s_setprio(0); } while (0)
#define PG8_WAIT_V(n) asm volatile("s_waitcnt vmcnt(" #n ")" ::: "memory")
#define PG8_WAIT_L(n) asm volatile("s_waitcnt lgkmcnt(" #n ")" ::: "memory")
#define PG8_BAR __builtin_amdgcn_s_barrier()
#define PG8_SCHED __builtin_amdgcn_sched_barrier(0)
    Unit cur, nxt; int ui = 0;
    if (!S.next(0, cur)) return;
    f32x4 acc[2][2][4][2];
#pragma unroll
    for (int a = 0; a < 2; ++a)
#pragma unroll
        for (int b = 0; b < 2; ++b)
#pragma unroll
            for (int m = 0; m < 4; ++m)
#pragma unroll
                for (int n = 0; n < 2; ++n) acc[a][b][m][n] = (f32x4){0.f, 0.f, 0.f, 0.f};
    bf16x8 At[4][2], B0[2][2], B1[2][2];
    const char* cA = PG8_APTR(cur); const char* cB = PG8_BPTR(cur);
    PG8_STAGE(PG8_SB(0, 0), cB, voffB); PG8_STAGE(PG8_SB(0, 1), cB + hstepB, voffB); PG8_STAGE(PG8_SA(0, 0), cA, voffA); PG8_STAGE(PG8_SA(0, 1), cA + hstepA, voffA);
    if (wr == 1) PG8_BAR;
    PG8_WAIT_V(2); PG8_BAR;
    PG8_STAGE(PG8_SB(1, 0), cB + kstep, voffB); PG8_STAGE(PG8_SA(1, 0), cA + kstep, voffA); PG8_STAGE(PG8_SB(1, 1), cB + hstepB + kstep, voffB);
    PG8_WAIT_V(6); PG8_BAR;
    for (;;) {
        const bool has_next = S.next(ui + 1, nxt);
        const char* nA = has_next ? PG8_APTR(nxt) : cA; const char* nB = has_next ? PG8_BPTR(nxt) : cB;
#pragma unroll 1
        for (int t = 0; t < nt; t += 2) {
            const bool last = (t == nt - 2);
            const char* a1 = cA + (size_t)(t + 1) * kstep;
            const char* a2 = last ? nA : cA + (size_t)(t + 2) * kstep; const char* b2 = last ? nB : cB + (size_t)(t + 2) * kstep;
            const char* a3 = a2 + kstep; const char* b3 = b2 + kstep;
            PG8_LDB(B0, 0, 0); PG8_LDB(B1, 0, 1); PG8_SCHED; PG8_LDA(At, 0, 0); PG8_STAGE(PG8_SA(1, 1), a1 + hstepA, voffA);
            PG8_WAIT_V(8); PG8_WAIT_L(0); PG8_BAR; PG8_MMA(0, 0, At, B0); PG8_MMA(0, 1, At, B1); PG8_BAR; PG8_SCHED;
            PG8_LDA(At, 0, 1); PG8_STAGE(PG8_SB(0, 0), b2, voffB); PG8_STAGE(PG8_SB(0, 1), b2 + hstepB, voffB); PG8_STAGE(PG8_SA(0, 0), a2, voffA);
            PG8_WAIT_V(8); PG8_WAIT_L(0); PG8_BAR; PG8_MMA(1, 0, At, B0); PG8_MMA(1, 1, At, B1); PG8_BAR; PG8_SCHED;
            PG8_LDB(B0, 1, 0); PG8_LDB(B1, 1, 1); PG8_SCHED; PG8_LDA(At, 1, 0); PG8_STAGE(PG8_SA(0, 1), a2 + hstepA, voffA);
            PG8_WAIT_V(8); PG8_WAIT_L(0); PG8_BAR; PG8_MMA(0, 0, At, B0); PG8_MMA(0, 1, At, B1); PG8_BAR; PG8_SCHED;
            PG8_LDA(At, 1, 1); PG8_STAGE(PG8_SB(1, 0), b3, voffB); PG8_STAGE(PG8_SB(1, 1), b3 + hstepB, voffB); PG8_STAGE(PG8_SA(1, 0), a3, voffA);
            PG8_WAIT_V(8); PG8_WAIT_L(0); PG8_BAR; PG8_MMA(1, 0, At, B0); PG8_MMA(1, 1, At, B1); PG8_BAR; PG8_SCHED;
        }
        if (wr == 0) PG8_BAR;
        E(acc, cur, wr, wc, fr, fq);
        if (!has_next) break;
#pragma unroll
        for (int a = 0; a < 2; ++a)
#pragma unroll
            for (int b = 0; b < 2; ++b)
#pragma unroll
                for (int m = 0; m < 4; ++m)
#pragma unroll
                    for (int n = 0; n < 2; ++n) acc[a][b][m][n] = (f32x4){0.f, 0.f, 0.f, 0.f};
        cur = nxt; cA = nA; cB = nB; ++ui;
        if (wr == 1) PG8_BAR;
    }
    PG8_WAIT_V(0);
    PG8_BAR;
#undef PG8_APTR
#undef PG8_BPTR
#undef PG8_SA
#undef PG8_SB
#undef PG8_STAGE
#undef PG8_LDA
#undef PG8_LDB
#undef PG8_MMA
#undef PG8_WAIT_V
#undef PG8_WAIT_L
#undef PG8_BAR
#undef PG8_SCHED
}

__device__ __forceinline__ float mrow_sel(int row) { return 0.f; }
__device__ __forceinline__ int modrow(int row) { return row < NPR ? 0 : 1 + ((row - NPR) >> 11); }

struct EpiProj {
    static constexpr bool PERM = true;
    bf16* proj; float* outk; float* outv; int layer;
    __device__ __forceinline__ void operator()(const f32x4 (&acc)[2][2][4][2], const Unit& u, int wr, int wc, int fr, int fq) const {
        { int t_ = lane_id(); asm volatile("" : "+v"(t_)); fr = t_ & 15; fq = (t_ >> 4) & 3; }
        const int row0 = u.pm * BM + wr * 64 + fr, colb = u.pn * BM + wc * 32 + 8 * fq;
        const int mode = (u.pn == 60) ? 1 : (u.pn == 61 ? 2 : ((u.pn >= 36) ? 3 : 0));
        const bool kv = (u.pm < 32) && (u.pn >= 4) && (u.pn < 12);
#pragma unroll
        for (int ai = 0; ai < 2; ++ai)
#pragma unroll
            for (int m = 0; m < 4; ++m) {
                const int row = row0 + ai * HALF + m * 16;
                bf16* rowp = proj + (size_t)row * NPROJ + colb;
#pragma unroll
                for (int bj = 0; bj < 2; ++bj) {
                    f32x4 v0 = acc[ai][bj][m][0], v1 = acc[ai][bj][m][1];
                    if (mode == 1) { if (colb + bj * HALF < COL_G1A) {
#pragma unroll
                        for (int j = 0; j < 4; ++j) { v0[j] = tanhf(v0[j]); v1[j] = tanhf(v1[j]); } } }
                    else if (mode == 3) {
#pragma unroll
                        for (int j = 0; j < 4; ++j) { v0[j] = sigmoidf_(v0[j]); v1[j] = sigmoidf_(v1[j]); } }
                    else if (mode == 2) { const bool act = (colb + bj * HALF) < 15744;
#pragma unroll
                        for (int j = 0; j < 4; ++j) { v0[j] = act ? sigmoidf_(v0[j]) : 0.f; v1[j] = act ? sigmoidf_(v1[j]) : 0.f; } }
                    u32x4 w; w.x = cvtpk(v0[0], v0[1]); w.y = cvtpk(v0[2], v0[3]); w.z = cvtpk(v1[0], v1[1]); w.w = cvtpk(v1[2], v1[3]);
                    *(u32x4*)(rowp + bj * HALF) = w;
                    if (kv) { const int col = colb + bj * HALF; float* ob = (u.pn < 8) ? outk : outv; const int ch = col - ((u.pn < 8) ? COL_K : COL_V);
                        float* dst = ob + ((size_t)(((row >> 8) * 4 + layer) * 256 + (row & 255))) * 1024 + ch;
                        *(f32x4*)dst = v0; *(f32x4*)(dst + 4) = v1; }
                }
            }
    }
};
struct EpiLora2 {
    static constexpr bool PERM = true;
    float* dec; bf16* abuf; bf16* gbuf; const float* w0; const float* a0;
    __device__ __forceinline__ void operator()(const f32x4 (&acc)[2][2][4][2], const Unit& u, int wr, int wc, int fr, int fq) const {
        { int t_ = lane_id(); asm volatile("" : "+v"(t_)); fr = t_ & 15; fq = (t_ >> 4) & 3; }
        const int row0 = u.pm * BM + wr * 64 + fr, colb = u.pn * BM + wc * 32 + 8 * fq;
        const int br = u.br, e = br & 1;
        const float* bsrc = (br < 2) ? w0 + e * 1024 : a0 + e * 1024;
#pragma unroll
        for (int bj = 0; bj < 2; ++bj)
#pragma unroll
            for (int n = 0; n < 2; ++n) {
                const int ch = colb + bj * HALF + 4 * n;
                f32x4 b0 = (f32x4){0.f, 0.f, 0.f, 0.f};
                if (br < 4) b0 = *(const f32x4*)(bsrc + ch);
#pragma unroll
                for (int ai = 0; ai < 2; ++ai)
#pragma unroll
                    for (int m = 0; m < 4; ++m) {
                        const int row = row0 + ai * HALF + m * 16;
                        f32x4 v0 = acc[ai][bj][m][n] + b0;
                        if (br < 2) {
#pragma unroll
                            for (int j = 0; j < 4; ++j) v0[j] = -0.6065306597126334f * sigmoidf_(v0[j]);
                            *(f32x4*)(dec + ((size_t)row * 2 + e) * 1024 + ch) = v0;
                        } else {
                            if (br < 4) {
#pragma unroll
                                for (int j = 0; j < 4; ++j) v0[j] = sigmoidf_(v0[j]); }
                            bf16* dst = (br < 4) ? abuf + ((size_t)row * 2 + e) * 1024 + ch : gbuf + (size_t)row * 1024 + ch;
                            *(u32x2*)dst = (u32x2){cvtpk(v0[0], v0[1]), cvtpk(v0[2], v0[3])};
                        }
                        __builtin_amdgcn_sched_barrier(0);
                    }
            }
    }
};
struct EpiMerge {
    static constexpr bool PERM = true;
    const bf16* proj; bf16* merged;
    __device__ __forceinline__ void operator()(const f32x4 (&acc)[2][2][4][2], const Unit& u, int wr, int wc, int fr, int fq) const {
        { int t_ = lane_id(); asm volatile("" : "+v"(t_)); fr = t_ & 15; fq = (t_ >> 4) & 3; }
        const int row0 = u.pm * BM + wr * 64 + fr, colb = u.pn * BM + wc * 32 + 8 * fq;
        const int br = u.br;
#pragma unroll
        for (int ai = 0; ai < 2; ++ai)
#pragma unroll
            for (int m = 0; m < 4; ++m) {
                const int row = row0 + ai * HALF + m * 16;
#pragma unroll
                for (int bj = 0; bj < 2; ++bj) {
                    const int col = colb + bj * HALF;
                    const u32x4 gw = *(const u32x4*)(proj + (size_t)row * NPROJ + COL_GL + br * 2048 + col);
                    bf16* dst = merged + (size_t)row * D + col;
                    f32x4 v0 = acc[ai][bj][m][0], v1 = acc[ai][bj][m][1];
                    v0[0] *= bflo(gw.x); v0[1] *= bfhi(gw.x); v0[2] *= bflo(gw.y); v0[3] *= bfhi(gw.y);
                    v1[0] *= bflo(gw.z); v1[1] *= bfhi(gw.z); v1[2] *= bflo(gw.w); v1[3] *= bfhi(gw.w);
                    if (br > 0) { const u32x4 pw = *(const u32x4*)dst;
                        v0[0] += bflo(pw.x); v0[1] += bfhi(pw.x); v0[2] += bflo(pw.y); v0[3] += bfhi(pw.y);
                        v1[0] += bflo(pw.z); v1[1] += bfhi(pw.z); v1[2] += bflo(pw.w); v1[3] += bfhi(pw.w); }
                    u32x4 w; w.x = cvtpk(v0[0], v0[1]); w.y = cvtpk(v0[2], v0[3]); w.z = cvtpk(v1[0], v1[1]); w.w = cvtpk(v1[2], v1[3]);
                    *(u32x4*)dst = w;
                }
            }
    }
};
struct EpiResid {
    static constexpr bool PERM = false;
    float* x; const float* gate;   const float* bias; float gscale;
    __device__ __forceinline__ void operator()(const f32x4 (&acc)[2][2][4][2], const Unit& u, int wr, int wc, int fr, int fq) const {
        { int t_ = lane_id(); asm volatile("" : "+v"(t_)); fr = t_ & 15; fq = (t_ >> 4) & 3; }
        const int row0 = u.pm * BM + wr * 64 + fr, col0 = u.pn * BM + wc * 32 + 4 * fq;
        const int mr = modrow(u.pm * BM);
        const float* gp = gate + (size_t)mr * 12288;
        f32x4 gv[2][2], bv[2][2];
#pragma unroll
        for (int bj = 0; bj < 2; ++bj)
#pragma unroll
            for (int n = 0; n < 2; ++n) { gv[bj][n] = *(const f32x4*)(gp + col0 + bj * HALF + n * 16) * gscale;
                bv[bj][n] = bias ? *(const f32x4*)(bias + col0 + bj * HALF + n * 16) : (f32x4){0.f, 0.f, 0.f, 0.f}; }
#pragma unroll
        for (int ai = 0; ai < 2; ++ai)
#pragma unroll
            for (int m = 0; m < 4; ++m) { float* rowp = x + (size_t)(row0 + ai * HALF + m * 16) * D + col0;
#pragma unroll
                for (int bj = 0; bj < 2; ++bj)
#pragma unroll
                    for (int n = 0; n < 2; ++n) { f32x4* p = (f32x4*)(rowp + bj * HALF + n * 16); const f32x4 xo = *p; *p = xo + gv[bj][n] * (acc[ai][bj][m][n] + bv[bj][n]); }
                asm volatile("" ::: "memory"); }
    }
};
struct EpiFF1 {
    static constexpr bool PERM = true;
    bf16* U; const float* bias;
    __device__ __forceinline__ void operator()(const f32x4 (&acc)[2][2][4][2], const Unit& u, int wr, int wc, int fr, int fq) const {
        { int t_ = lane_id(); asm volatile("" : "+v"(t_)); fr = t_ & 15; fq = (t_ >> 4) & 3; }
        const int row0 = u.pm * BM + wr * 64 + fr, colb = u.pn * BM + wc * 32 + 8 * fq;
        f32x4 bv[2][2];
#pragma unroll
        for (int bj = 0; bj < 2; ++bj)
#pragma unroll
            for (int n = 0; n < 2; ++n) bv[bj][n] = *(const f32x4*)(bias + colb + bj * HALF + 4 * n);
#pragma unroll
        for (int ai = 0; ai < 2; ++ai)
#pragma unroll
            for (int m = 0; m < 4; ++m) { bf16* rowp = U + (size_t)(row0 + ai * HALF + m * 16) * DFF + colb;
#pragma unroll
                for (int bj = 0; bj < 2; ++bj) { f32x4 v0 = acc[ai][bj][m][0] + bv[bj][0], v1 = acc[ai][bj][m][1] + bv[bj][1];
#pragma unroll
                    for (int j = 0; j < 4; ++j) { const float a = fmaxf(v0[j], 0.f), b = fmaxf(v1[j], 0.f); v0[j] = a * a; v1[j] = b * b; }
                    u32x4 w; w.x = cvtpk(v0[0], v0[1]); w.y = cvtpk(v0[2], v0[3]); w.z = cvtpk(v1[0], v1[1]); w.w = cvtpk(v1[2], v1[3]);
                    *(u32x4*)(rowp + bj * HALF) = w; } }
    }
};
}

__device__ __forceinline__ void transpose_item(const float* W, int K, int N, bf16* WT, int ldk, int row_off, LAS bf16* scr, int item, int lane) {
    const int nblk = N / 64, kb = item / nblk, nb = item % nblk, k0 = 64 * kb, n0 = 64 * nb;
    const float* src = W + (size_t)k0 * N + n0 + lane;
#pragma unroll 1
    for (int h = 0; h < 2; ++h) { float v[32];
#pragma unroll
        for (int i = 0; i < 32; ++i) v[i] = src[(size_t)(h * 32 + i) * N];
#pragma unroll
        for (int i = 0; i < 32; ++i) scr[(h * 32 + i) * 66 + lane] = f2bf(v[i]); }
    LDS_WAIT(); asm volatile("" ::: "memory");
    const int kc = lane & 7, ns = lane >> 3;
#pragma unroll
    for (int j = 0; j < 8; ++j) { const int n = 8 * j + ns; const LAS bf16* s = scr + (8 * kc) * 66 + n;
        u32x4 o; o.x = (unsigned)s[0] | ((unsigned)s[66] << 16); o.y = (unsigned)s[2 * 66] | ((unsigned)s[3 * 66] << 16); o.z = (unsigned)s[4 * 66] | ((unsigned)s[5 * 66] << 16); o.w = (unsigned)s[6 * 66] | ((unsigned)s[7 * 66] << 16);
        *(u32x4*)(WT + (size_t)(row_off + n0 + n) * ldk + k0 + 8 * kc) = o; }
    LDS_WAIT(); asm volatile("" ::: "memory");
}

__device__ __forceinline__ void convert_layer(const Frame& F, int l, LAS bf16* scr, int gw, int NGW) {
    unsigned char* ws = WSP(F);
        bf16* WinT = (bf16*)(ws + WS_WIN) + (size_t)l * NPROJ * D;
        {   const int n_items = (D / 64) * (15360 / 64); const float* W = INP(F, I_WIN) + (size_t)l * D * 15360;
            for (int it = gw; it < n_items; it += NGW) transpose_item(W, D, 15360, WinT, D, 0, scr, it, F.lane); }
        for (int e = 0; e < 2; ++e) {
            const int n_items = (D / 64);
            const float* W1 = INP(F, I_W1) + ((size_t)l * 2 + e) * D * 64; const float* A1 = INP(F, I_A1) + ((size_t)l * 2 + e) * D * 64;
            for (int it = gw; it < n_items; it += NGW) { transpose_item(W1, D, 64, WinT, D, COL_LW + e * 64, scr, it, F.lane); transpose_item(A1, D, 64, WinT, D, COL_LW + 128 + e * 64, scr, it, F.lane); }
        }
        {   const int n_items = (D / 64) * 2; const float* W = INP(F, I_G1) + (size_t)l * D * 128;
            for (int it = gw; it < n_items; it += NGW) transpose_item(W, D, 128, WinT, D, COL_LW + 256, scr, it, F.lane); }
        for (int i = gw * 64 + F.lane; i < 128 * D / 8; i += NGW * 64) ((u32x4*)(WinT + (size_t)15744 * D))[i] = (u32x4){0u, 0u, 0u, 0u};
        for (int br = 0; br < 3; ++br) { const float* W = INP(F, I_WPA + br) + (size_t)l * 1024 * D; bf16* WT = (bf16*)(ws + WS_WP) + ((size_t)l * 3 + br) * D * 1024;
            const int n_items = (1024 / 64) * (D / 64);
            for (int it = gw; it < n_items; it += NGW) transpose_item(W, 1024, D, WT, 1024, 0, scr, it, F.lane); }
        {   const float* W = INP(F, I_WOUT) + (size_t)l * D * D; bf16* WT = (bf16*)(ws + WS_WOUT) + (size_t)l * D * D; const int n_items = (D / 64) * (D / 64);
            for (int it = gw; it < n_items; it += NGW) transpose_item(W, D, D, WT, D, 0, scr, it, F.lane); }
        {   const float* W = INP(F, I_FF1) + (size_t)l * D * DFF; bf16* WT = (bf16*)(ws + WS_WFF1) + (size_t)l * D * DFF; const int n_items = (D / 64) * (DFF / 64);
            for (int it = gw; it < n_items; it += NGW) transpose_item(W, D, DFF, WT, D, 0, scr, it, F.lane); }
        {   const float* W = INP(F, I_FF2) + (size_t)l * D * DFF; bf16* WT = (bf16*)(ws + WS_WFF2) + (size_t)l * D * DFF; const int n_items = (DFF / 64) * (D / 64);
            for (int it = gw; it < n_items; it += NGW) transpose_item(W, DFF, D, WT, DFF, 0, scr, it, F.lane); }
        {   bf16* W2T = (bf16*)(ws + WS_W2T) + (size_t)l * 5120 * 256;
            const float* w2 = INP(F, I_W2) + (size_t)l * 2 * 64 * 1024; const float* a2 = INP(F, I_A2) + (size_t)l * 2 * 64 * 1024; const float* g2 = INP(F, I_G2) + (size_t)l * 128 * 1024;
            for (int it = gw; it < 16 * 6; it += NGW) { const int m = it / 16, sub = it % 16;
                const float* W = m == 0 ? w2 : (m == 1 ? w2 + 65536 : (m == 2 ? a2 : (m == 3 ? a2 + 65536 : (m == 4 ? g2 : g2 + 65536))));
                const int br = m < 4 ? m : 4, koff = m < 4 ? 64 * m : (m == 4 ? 128 : 192);
                transpose_item(W, 64, 1024, W2T + (size_t)br * 1024 * 256 + koff, 256, 0, scr, sub, F.lane); }
            for (int i = gw * 64 + F.lane; i < 5120 * 32; i += NGW * 64) { const int n = i >> 5, k8 = (i & 31) * 8, br = n >> 10;
                const bool nz = br == 4 ? (k8 >= 128) : (k8 >= 64 * br && k8 < 64 * br + 64);
                if (!nz) *(u32x4*)(W2T + (size_t)n * 256 + k8) = (u32x4){0u, 0u, 0u, 0u}; }
        }
    }

__device__ __forceinline__ void prologue0(const Frame& F, const Args& a) {
    unsigned char* ws = WSP(F);
    LAS bf16* scr = (LAS bf16*)(F.lds + F.wave * 16384);
    const int gw = F.bid * 8 + F.wave, NGW = F.G * 8;
    convert_layer(F, 0, scr, gw, NGW);
    {   const float* ck = INP(F, I_CK); const float* cv = INP(F, I_CV); bf16* ok = (bf16*)(ws + WS_CK); bf16* ov = (bf16*)(ws + WS_CV);
        const int n4 = 4 * 4 * 256 * 1024 / 4;
        for (int i = gw * 64 + F.lane; i < n4; i += NGW * 64) { const f32x4 x = ((const f32x4*)ck)[i], y = ((const f32x4*)cv)[i];
            ((u32x2*)ok)[i] = (u32x2){cvtpk(x[0], x[1]), cvtpk(x[2], x[3])}; ((u32x2*)ov)[i] = (u32x2){cvtpk(y[0], y[1]), cvtpk(y[2], y[3])}; }
    }
    {   LAS float* sv = (LAS float*)(F.lds + 65536);
        __syncthreads();
        for (int i = F.tid; i < 5 * D; i += 512) { const int r = i / D, d = i - r * D; const float x = (r == 0) ? INP(F, I_CCTX)[d] : INP(F, I_C)[(r - 1) * D + d]; sv[i] = x / (1.0f + __expf(-x)); }
        __syncthreads();
        float* PART = (float*)(ws + WS_Q);
        const int n_items = DEPTH * 48 * 8;
        for (int it = gw; it < n_items; it += NGW) {
            const int l = it / 384, rem = it % 384, jc = rem >> 3, ds = rem & 7, j4 = jc * 256 + 4 * F.lane;
            const float* W = INP(F, I_WMOD) + (size_t)l * D * 12288 + (size_t)(ds * 256) * 12288 + j4;
            f32x4 acc[5];
#pragma unroll
            for (int r = 0; r < 5; ++r) acc[r] = (f32x4){0.f, 0.f, 0.f, 0.f};
#pragma unroll 4
            for (int d = 0; d < 256; d += 4) {
                f32x4 w[4];
#pragma unroll
                for (int q = 0; q < 4; ++q) w[q] = *(const f32x4*)(W + (size_t)(d + q) * 12288);
#pragma unroll
                for (int r = 0; r < 5; ++r) { const f32x4 s = *(const LAS f32x4*)(sv + r * D + ds * 256 + d);
#pragma unroll
                    for (int q = 0; q < 4; ++q) acc[r] += w[q] * s[q]; }
            }
#pragma unroll
            for (int r = 0; r < 5; ++r) *(f32x4*)(PART + (((size_t)ds * 4 + l) * 5 + r) * 12288 + j4) = acc[r];
        }
        __syncthreads();
    }
    {   float* T2 = (float*)(ws + WS_T2);
        const int n_items = DEPTH * (L_S + L_P);
        for (int it = gw; it < n_items; it += NGW) {
            const int l = it / (L_S + L_P), rr = it % (L_S + L_P), sel = rr < L_S ? 0 : 1, t = sel ? rr - L_S : rr, L = sel ? L_P : L_S;
            float zf = 0.f;
            {   const float tt = (float)t / (float)(L - 1);
                const float w = (6.283185307179586f * (float)t) / (float)L;
                const int band = (F.lane - 1) & 15;
                const float f = 1e-4f + (float)band * ((15.0f - 1e-4f) / 15.0f);
                const float fw = f * w;
                const double rd = (double)fw - 6.283185307179586 * rint((double)fw * 0.15915494309189535);
                const float rf = (float)rd;
                zf = (F.lane == 0) ? tt : (F.lane <= 16 ? __cosf(rf) : -__sinf(rf));
            }
            const float* f1 = INP(F, I_F1) + (size_t)l * 33 * 64; const float* f2 = INP(F, I_F2) + (size_t)l * 64 * 64;
            const float fq = INP(F, I_FREQ)[l * 64 + F.lane];
            float s = INP(F, I_FB1)[l * 64 + F.lane];
            for (int i = 0; i < 33; ++i) s += __int_as_float(__builtin_amdgcn_readlane(__float_as_int(zf), i)) * f1[i * 64 + F.lane];
            float x = fq * s; { const double rd = (double)x - 6.283185307179586 * rint((double)x * 0.15915494309189535); x = (float)rd; }
            const float t1 = __sinf(x);
            float s2 = INP(F, I_FB2)[l * 64 + F.lane];
            for (int i = 0; i < 64; ++i) s2 += __int_as_float(__builtin_amdgcn_readlane(__float_as_int(t1), i)) * f2[i * 64 + F.lane];
            float y = fq * s2; { const double rd = (double)y - 6.283185307179586 * rint((double)y * 0.15915494309189535); y = (float)rd; }
            T2[(((size_t)l * 2 + sel) * L_S + t) * 64 + F.lane] = __sinf(y);
        }
    }
    {   bf16* FS = (bf16*)(ws + WS_FS); bf16* FP = (bf16*)(ws + WS_FP);
        for (int i = gw * 64 + F.lane; i < DEPTH * 1024 * 72; i += NGW * 64) { const int row = i / 72, p = i % 72; const int m = p < 32 ? p : p - 32 + 32;
            FS[(size_t)row * LPS + (p < 32 ? p : L_S + p)] = 0; FP[(size_t)row * LPP + (p < 32 ? p : L_P + p)] = 0; (void)m; }
    }
}

__device__ __forceinline__ void prologue1(const Frame& F, const Args& a) {
    unsigned char* ws = WSP(F);
    const int gw = F.bid * 8 + F.wave, NGW = F.G * 8;
    {   const float* PART = (const float*)(ws + WS_Q); float* MOD = (float*)(ws + WS_MOD);
        for (int i = (F.bid * 8 + F.wave) * 64 + F.lane; i < DEPTH * 5 * 12288 / 4; i += F.G * 8 * 64) {
            const int l = i / (5 * 3072), j4 = (i % 3072) * 4;
            f32x4 s = *(const f32x4*)(INP(F, I_BMOD) + l * 12288 + j4);
#pragma unroll
            for (int ds = 0; ds < 8; ++ds) s += ((const f32x4*)PART)[(size_t)ds * (DEPTH * 5 * 3072) + i];
            ((f32x4*)MOD)[i] = s; }
    }
    const float* T2 = (const float*)(ws + WS_T2);
    float* FNORM = (float*)(ws + WS_CTL) + CW_FNORM;
    const int items_s = DEPTH * 16 * (L_S / 64), items_p = DEPTH * 16 * (L_P / 64);
    for (int it = gw; it < items_s + items_p; it += NGW) {
        int sel, l, cg, tc;
        if (it < items_s) { sel = 0; l = it / (16 * 32); cg = (it / 32) % 16; tc = it % 32; } else { const int r = it - items_s; sel = 1; l = r / (16 * 4); cg = (r / 4) % 16; tc = r % 4; }
        const int L = sel ? L_P : L_S, c = cg * 64 + F.lane;
        const float* f3 = INP(F, I_F3) + (size_t)l * 64 * 1024 + c;
        float w3[64];
#pragma unroll
        for (int j = 0; j < 64; ++j) w3[j] = f3[(size_t)j * 1024];
        const float delta = fabsf(-3.0701134573253946f + (float)c * ((-15.350567286626973f + 3.0701134573253946f) / 1023.0f));
        bf16* dst = sel ? (bf16*)(ws + WS_FP) + ((size_t)l * 1024 + c) * LPP : (bf16*)(ws + WS_FS) + ((size_t)l * 1024 + c) * LPS;
        float asum = 0.f;
        for (int tt = 0; tt < 64; ++tt) {
            const int t = tc * 64 + tt;
            const float tv = T2[(((size_t)l * 2 + sel) * L_S + t) * 64 + F.lane];
            float s = 0.f;
#pragma unroll
            for (int j = 0; j < 64; ++j) s += __int_as_float(__builtin_amdgcn_readlane(__float_as_int(tv), j)) * w3[j];
            const float dist = fabsf((float)(t - L / 2)) / (float)L;
            const float fv = s * __expf(-dist * delta);
            asum += fabsf(fv);
            dst[32 + (L - 1 - t)] = f2bf(fv);
        }
        atomicAdd(FNORM + ((size_t)l * 2 + sel) * 1024 + c, asum);
    }
}

__device__ __forceinline__ void norm_phase(const Frame& F, const float* xp, const float* xs, float* xcopy, const float* g, const float* mod, int i_sh, int i_sc, bf16* hout) {
    const int gw = F.bid * 8 + F.wave, NGW = F.G * 8;
    for (int row = gw; row < M; row += NGW) {
        const float* xr = row < NPR ? xp + (size_t)row * D : xs + (size_t)(row - NPR) * D;
        const float* mr = mod + (size_t)pg8::modrow(row) * 12288;
        f32x4 v[8]; float ss = 0.f;
#pragma unroll
        for (int j = 0; j < 8; ++j) { v[j] = ((const f32x4*)xr)[F.lane + 64 * j]; ss += (v[j][0] * v[j][0] + v[j][1] * v[j][1]) + (v[j][2] * v[j][2] + v[j][3] * v[j][3]); }
        const float rstd = 1.0f / sqrtf(wave_sum(ss) * (1.0f / D) + 1e-6f);
        if (xcopy) {
#pragma unroll
            for (int j = 0; j < 8; ++j) ((f32x4*)(xcopy + (size_t)row * D))[F.lane + 64 * j] = v[j]; }
#pragma unroll
        for (int j = 0; j < 8; ++j) {
            const f32x4 gg = ((const f32x4*)g)[F.lane + 64 * j], sc = ((const f32x4*)(mr + i_sc * D))[F.lane + 64 * j], sh = ((const f32x4*)(mr + i_sh * D))[F.lane + 64 * j];
            const f32x4 o = v[j] * rstd * gg * (1.0f + sc) + sh;
            ((u32x2*)(hout + (size_t)row * D))[F.lane + 64 * j] = (u32x2){cvtpk(o[0], o[1]), cvtpk(o[2], o[3])};
        }
    }
}
__device__ __forceinline__ void final_norm_phase(const Frame& F, float* x, const float* g) {
    const int gw = F.bid * 8 + F.wave, NGW = F.G * 8;
    for (int row = gw; row < M; row += NGW) {
        float* xr = x + (size_t)row * D;
        f32x4 v[8]; float ss = 0.f;
#pragma unroll
        for (int j = 0; j < 8; ++j) { v[j] = ((const f32x4*)xr)[F.lane + 64 * j]; ss += (v[j][0] * v[j][0] + v[j][1] * v[j][1]) + (v[j][2] * v[j][2] + v[j][3] * v[j][3]); }
        const float rstd = 1.0f / sqrtf(wave_sum(ss) * (1.0f / D) + 1e-6f);
#pragma unroll
        for (int j = 0; j < 8; ++j) { const f32x4 gg = ((const f32x4*)g)[F.lane + 64 * j]; ((f32x4*)xr)[F.lane + 64 * j] = v[j] * rstd * gg; }
    }
}

__device__ __forceinline__ s16x4 vtr(const LAS unsigned char* p) { return __builtin_bit_cast(s16x4, __builtin_amdgcn_ds_read_tr16_b64_v4i16((LAS s16x4*)p)); }

struct AttnState { float m, l; f32x16 o[2]; };

template <int NT, bool HASB, class KT, class VL, class BIAS>
__device__ __forceinline__ void attendN(AttnState& st, const bf16x8 (&qf)[4], const KT& ktp, size_t kstride, const LAS unsigned char* lds, const VL& vlo, const BIAS& bias, int lane) {
    const int r = lane & 31, h = lane >> 5;
    f32x16 s[NT];
#pragma unroll
    for (int kt = 0; kt < NT; ++kt) {
        const bf16* kp = ktp(kt) + (size_t)r * kstride + 8 * h;
        bf16x8 kf[4];
#pragma unroll
        for (int ks = 0; ks < 4; ++ks) kf[ks] = *(const bf16x8*)(kp + 16 * ks);
        f32x16 acc;
#pragma unroll
        for (int i = 0; i < 16; ++i) acc[i] = 0.f;
#pragma unroll
        for (int ks = 0; ks < 4; ++ks) acc = __builtin_amdgcn_mfma_f32_32x32x16_bf16(kf[ks], qf[ks], acc, 0, 0, 0);
        s[kt] = acc;
    }
    float gm = -3.0e38f;
#pragma unroll
    for (int kt = 0; kt < NT; ++kt)
#pragma unroll
        for (int i = 0; i < 16; ++i) {
            float v = s[kt][i] * 0.125f;
            if (HASB) v = bias(kt, (i & 3) + 8 * (i >> 2) + 4 * h, v);
            s[kt][i] = v; gm = fmaxf(gm, v);
        }
    gm = fmaxf(gm, xor32(gm, lane));
    const float mnew = fmaxf(st.m, gm);
    const float alpha = __expf(st.m - mnew);
    float ps = 0.f;
#pragma unroll
    for (int kt = 0; kt < NT; ++kt)
#pragma unroll
        for (int i = 0; i < 16; ++i) { const float p = __expf(s[kt][i] - mnew); s[kt][i] = p; ps += p; }
    st.l = st.l * alpha + ps; st.m = mnew;
#pragma unroll
    for (int i = 0; i < 16; ++i) { st.o[0][i] *= alpha; st.o[1][i] *= alpha; }
    const int i16 = lane & 15, tq = i16 >> 2, tp = i16 & 3, blk = (lane >> 4) & 1;
#pragma unroll
    for (int kt = 0; kt < NT; ++kt) {
        const LAS unsigned char* vb = lds + vlo(kt);
#pragma unroll
        for (int ss = 0; ss < 2; ++ss) {
            u32x4 pw; pw.x = cvtpk(s[kt][8 * ss + 0], s[kt][8 * ss + 1]); pw.y = cvtpk(s[kt][8 * ss + 2], s[kt][8 * ss + 3]); pw.z = cvtpk(s[kt][8 * ss + 4], s[kt][8 * ss + 5]); pw.w = cvtpk(s[kt][8 * ss + 6], s[kt][8 * ss + 7]);
            const bf16x8 pf = __builtin_bit_cast(bf16x8, pw);
#pragma unroll
            for (int dt = 0; dt < 2; ++dt) {
                const LAS unsigned char* p0 = vb + (16 * ss + 4 * h + tq) * 128 + (dt * 32 + 16 * blk + 4 * tp) * 2;
                const s16x4 lo = vtr(p0), hi = vtr(p0 + 8 * 128);
                const bf16x8 vf = __builtin_shufflevector(lo, hi, 0, 1, 2, 3, 4, 5, 6, 7);
                st.o[dt] = __builtin_amdgcn_mfma_f32_32x32x16_bf16(vf, pf, st.o[dt], 0, 0, 0);
            }
        }
    }
}

__device__ __forceinline__ void attn_store(const AttnState& st, bf16* orow  , int lane) {
    const int h = lane >> 5;
    const float lt = st.l + xor32(st.l, lane);
    const float inv = 1.0f / lt;
#pragma unroll
    for (int dt = 0; dt < 2; ++dt)
#pragma unroll
        for (int g = 0; g < 4; ++g) {
            const u32x2 w = (u32x2){cvtpk(st.o[dt][4 * g] * inv, st.o[dt][4 * g + 1] * inv), cvtpk(st.o[dt][4 * g + 2] * inv, st.o[dt][4 * g + 3] * inv)};
            *(u32x2*)(orow + dt * 32 + 8 * g + 4 * h) = w;
        }
}

__device__ __forceinline__ void attention_phase(const Frame& F, const Args& a, int layer) {
    unsigned char* ws = WSP(F);
    const bf16* proj = (const bf16*)(ws + WS_PROJ);
    bf16* oall = (bf16*)(ws + WS_OALL);
    const int lane = F.lane, w = F.wave, r = lane & 31, h = lane >> 5;
    LAS unsigned char* lds = F.lds;
    LAS float* rpbl = (LAS float*)(lds + 122880);
    for (int u = F.bid; u < 1024; u += F.G) {
        __syncthreads();
        if (u < 512) {
            const int b = u >> 4, hd = u & 15;
            const int tok0 = b * 256;
            for (int i = F.tid; i < 256 * 8; i += 512) { const int key = i >> 3, pc = i & 7;
                *(LAS u32x4*)(lds + key * 128 + pc * 16) = *(const u32x4*)(proj + (size_t)(tok0 + key) * NPROJ + COL_V + hd * 64 + pc * 8); }
            __syncthreads();
            bf16x8 qf[4];
            { const bf16* qp = proj + (size_t)(tok0 + 32 * w + r) * NPROJ + hd * 64 + 8 * h;
#pragma unroll
              for (int ks = 0; ks < 4; ++ks) qf[ks] = *(const bf16x8*)(qp + 16 * ks); }
            AttnState st; st.m = -3.0e38f; st.l = 0.f;
#pragma unroll
            for (int i = 0; i < 16; ++i) { st.o[0][i] = 0.f; st.o[1][i] = 0.f; }
            const bf16* kbase = proj + (size_t)tok0 * NPROJ + COL_K + hd * 64;
#pragma unroll 1
            for (int kg = 0; kg < 2; ++kg)
                attendN<4, false>(st, qf, [&](int kt) { return kbase + (size_t)((kg * 4 + kt) * 32) * NPROJ; }, (size_t)NPROJ, lds, [&](int kt) { return (kg * 4 + kt) * 4096; }, [&](int, int, float v) { return v; }, lane);
            attn_store(st, oall + (size_t)(tok0 + 32 * w + r) * 3072 + hd * 64, lane);
        } else {
            const int uu = u - 512, b = uu >> 7, hd = (uu >> 3) & 15, rg = uu & 7;
            const int tokb = NPR + b * 2048;
            int rlo = 4 * rg - 4; rlo = rlo < 0 ? 0 : (rlo > 24 ? 24 : rlo);
            int rhi0 = 4 * rg + 3 - 4; rhi0 = rhi0 < 0 ? 0 : (rhi0 > 24 ? 24 : rhi0); const int nr = rhi0 + 8 - rlo;
            for (int i = F.tid; i < nr * 64 * 8; i += 512) { const int key = i >> 3, pc = i & 7;
                *(LAS u32x4*)(lds + key * 128 + pc * 16) = *(const u32x4*)(proj + (size_t)(tokb + rlo * 64 + key) * NPROJ + COL_V + hd * 64 + pc * 8); }
            const bf16* cv = (const bf16*)(ws + WS_CV) + ((size_t)(b * 4 + layer) * 256) * 1024 + hd * 64;
            const bf16* ck = (const bf16*)(ws + WS_CK) + ((size_t)(b * 4 + layer) * 256) * 1024 + hd * 64;
            for (int i = F.tid; i < 256 * 8; i += 512) { const int key = i >> 3, pc = i & 7;
                *(LAS u32x4*)(lds + 90112 + key * 128 + pc * 16) = *(const u32x4*)(cv + (size_t)key * 1024 + pc * 8); }
            for (int i = F.tid; i < 465; i += 512) rpbl[i] = INP(F, I_RPB)[((size_t)layer * 16 + hd) * 465 + i];
            __syncthreads();
            const int qrow = 4 * rg + (w >> 1), qc = (w & 1) * 32 + r;
            int r0 = qrow - 4; r0 = r0 < 0 ? 0 : (r0 > 24 ? 24 : r0);
            int c0 = qc - 8; c0 = c0 < 0 ? 0 : (c0 > 48 ? 48 : c0);
            const int qtok = tokb + qrow * 64 + (w & 1) * 32 + r;
            bf16x8 qf[4];
            { const bf16* qp = proj + (size_t)qtok * NPROJ + hd * 64 + 8 * h;
#pragma unroll
              for (int ks = 0; ks < 4; ++ks) qf[ks] = *(const bf16x8*)(qp + 16 * ks); }
            AttnState st; st.m = -3.0e38f; st.l = 0.f;
#pragma unroll
            for (int i = 0; i < 16; ++i) { st.o[0][i] = 0.f; st.o[1][i] = 0.f; }
            const bf16* kloc = proj + (size_t)tokb * NPROJ + COL_K + hd * 64;
#pragma unroll 1
            for (int grp = 0; grp < 4; ++grp) {
                const int krb = r0 + 2 * grp;
                attendN<4, true>(st, qf, [&](int kt) { return kloc + (size_t)((krb + (kt >> 1)) * 64 + (kt & 1) * 32) * NPROJ; }, (size_t)NPROJ, lds,
                    [&](int kt) { return ((krb + (kt >> 1) - rlo) * 64 + (kt & 1) * 32) * 128; },
                    [&](int kt, int kin, float v) { const int kr = krb + (kt >> 1), kc = (kt & 1) * 32 + kin; const bool ok = (kc >= c0) && (kc < c0 + 16);
                        const int dr = kr - qrow + 7, dc = kc - qc + 15; const int idx = ok ? dr * 31 + dc : 0; return ok ? v + rpbl[idx] : -1.0e30f; }, lane);
            }
#pragma unroll 1
            for (int kg = 0; kg < 2; ++kg)
                attendN<4, false>(st, qf, [&](int kt) { return ck + (size_t)((kg * 4 + kt) * 32) * 1024; }, (size_t)1024, lds, [&](int kt) { return 90112 + (kg * 4 + kt) * 4096; }, [&](int, int, float v) { return v; }, lane);
            attn_store(st, oall + (size_t)qtok * 3072 + hd * 64, lane);
        }
    }
    __syncthreads();
}

__device__ __forceinline__ float row_sum16(float v) { v += DPPF(v, 0xB1); v += DPPF(v, 0x4E); v += DPPF(v, 0x141); v += DPPF(v, 0x140); return v; }
__device__ __forceinline__ f32x4 unpack4(u32x2 w) { return (f32x4){bflo(w.x), bfhi(w.x), bflo(w.y), bfhi(w.y)}; }
__device__ __forceinline__ u32x2 pack4(f32x4 v) { return (u32x2){cvtpk(v[0], v[1]), cvtpk(v[2], v[3])}; }
__device__ __forceinline__ void rwkv_tinv_unit(const Frame& F, int unit) {
    unsigned char* ws = WSP(F);
    const bf16* til = (const bf16*)(ws + WS_TIL);
    bf16* tinv = (bf16*)(ws + WS_TINV);
    int lane = lane_id(); asm volatile("" : "+v"(lane));
    const int r = lane & 31, h = lane >> 5;
    LAS float* Lw = (LAS float*)(F.lds + F.wave * 16384);
    {
        const int run = unit >> 5, e = (unit >> 4) & 1, hd = unit & 15;
        const size_t tok = (size_t)(run * 32 + (e ? 31 - r : r));
        const bf16* rowp = til + (tok * 16 + hd) * TILP + e * 256 + 8 * h;
        f32x16 acc;
#pragma unroll
        for (int i = 0; i < 16; ++i) acc[i] = 0.f;
        bf16x8 bfr[4], afr[4];
#pragma unroll
        for (int ks = 0; ks < 4; ++ks) { afr[ks] = *(const bf16x8*)(rowp + 16 * ks); bfr[ks] = *(const bf16x8*)(rowp + 64 + 16 * ks); }
#pragma unroll
        for (int ks = 0; ks < 4; ++ks) acc = __builtin_amdgcn_mfma_f32_32x32x16_bf16(bfr[ks], afr[ks], acc, 0, 0, 0);
#pragma unroll
        for (int g = 0; g < 4; ++g) { const int j0 = 8 * g + 4 * h; f32x4 v;
#pragma unroll
            for (int q = 0; q < 4; ++q) v[q] = (j0 + q < r) ? acc[4 * g + q] : 0.f;
            *(LAS f32x4*)(Lw + r * 36 + j0) = v; }
        LDS_WAIT(); asm volatile("" ::: "memory");
        float X[32];
#pragma unroll
        for (int i = 0; i < 32; ++i) {
            float s = (i == r) ? 1.f : 0.f;
#pragma unroll
            for (int jq = 0; jq < (i + 3) / 4; ++jq) { const f32x4 lv = *(const LAS f32x4*)(Lw + i * 36 + 4 * jq);
#pragma unroll
                for (int q = 0; q < 4; ++q) if (4 * jq + q < i) s += lv[q] * X[4 * jq + q]; }
            X[i] = s;
        }
        if (h == 0) { bf16* o = tinv + (size_t)unit * 1024 + r;
#pragma unroll
            for (int i = 0; i < 32; ++i) o[i * 32] = f2bf(X[i]); }
        LDS_WAIT(); asm volatile("" ::: "memory");
    }
}

__device__ __forceinline__ f32x4 exp4(f32x4 x) { return (f32x4){__expf(x[0]), __expf(x[1]), __expf(x[2]), __expf(x[3])}; }
__device__ __forceinline__ f32x4 rcp4(f32x4 x) { return (f32x4){__builtin_amdgcn_rcpf(x[0]), __builtin_amdgcn_rcpf(x[1]), __builtin_amdgcn_rcpf(x[2]), __builtin_amdgcn_rcpf(x[3])}; }
__device__ __forceinline__ void rwkv_prep_phase(const Frame& F, const Args& a, int layer) {
    unsigned char* ws = WSP(F);
    const bf16* proj = (const bf16*)(ws + WS_PROJ);
    const bf16* abuf = (const bf16*)(ws + WS_A);
    const float* logw = (const float*)(ws + WS_DEC);
    bf16* til = (bf16*)(ws + WS_TIL);
    float* bonus = (float*)(ws + WS_BONUS);
    float* wtb = (float*)(ws + WS_WTB);
    const float* cw = INP(F, I_CW) + (size_t)layer * 3 * 3072; const float* cb = INP(F, I_CB) + (size_t)layer * 3072;
    for (int item = F.wave * F.G + F.bid; item < 2048; item += 8 * F.G) {
        int lane = lane_id(); asm volatile("" : "+v"(lane));
        const int run = item >> 2, tok0 = run * 32, cg = item & 3, c4 = cg * 256 + 4 * lane, head = cg * 4 + (lane >> 4), hl = 4 * (lane & 15);
        const int t0 = tok0 < NPR ? (tok0 & 255) : ((tok0 - NPR) & 2047), L = tok0 < NPR ? L_P : L_S;
        const f32x4 kkw = *(const f32x4*)(INP(F, I_KK) + layer * 1024 + c4), kaw = *(const f32x4*)(INP(F, I_KA) + layer * 1024 + c4), rkw = *(const f32x4*)(INP(F, I_RK) + layer * 1024 + c4);
        f32x4 tot1 = (f32x4){0.f, 0.f, 0.f, 0.f};
#pragma unroll 1
        for (int q = 0; q < 4; ++q) { f32x4 t[8];
#pragma unroll
          for (int i = 0; i < 8; ++i) t[i] = *(const f32x4*)(logw + ((size_t)(tok0 + 8 * q + i) * 2 + 1) * 1024 + c4);
#pragma unroll
          for (int i = 0; i < 8; ++i) tot1 += t[i]; }
        f32x4 pre0 = (f32x4){0.f, 0.f, 0.f, 0.f}, pre1 = pre0, e0prev = (f32x4){1.f, 1.f, 1.f, 1.f};
        const bf16* pbase = proj + (size_t)tok0 * NPROJ + COL_R + c4;
#pragma unroll 1
        for (int ch = 0; ch < 8; ++ch) {
            const float* cwp = cw; const float* cbp = cb; asm volatile("" : "+s"(cwp), "+s"(cbp));
            f32x4 w[3][3], bs[3];
#pragma unroll
            for (int s = 0; s < 3; ++s) { bs[s] = *(const f32x4*)(cbp + s * 1024 + c4);
#pragma unroll
                for (int tp = 0; tp < 3; ++tp) w[s][tp] = *(const f32x4*)(cwp + tp * 3072 + s * 1024 + c4); }
            u32x2 rows[6][3], av[4][2]; f32x4 lw[4][2];
#pragma unroll
            for (int i = 0; i < 6; ++i) { const int tt = ch * 4 + i - 1, t = t0 + tt; const bool ok = (t >= 0) && (t < L);
#pragma unroll
                for (int s = 0; s < 3; ++s) rows[i][s] = ok ? *(const u32x2*)(pbase + (long)tt * NPROJ + s * 1024) : (u32x2){0u, 0u}; }
#pragma unroll
            for (int i = 0; i < 4; ++i) { const size_t tok = (size_t)(tok0 + ch * 4 + i); av[i][0] = *(const u32x2*)(abuf + (tok * 2 + 0) * 1024 + c4); av[i][1] = *(const u32x2*)(abuf + (tok * 2 + 1) * 1024 + c4);
                lw[i][0] = *(const f32x4*)(logw + (tok * 2 + 0) * 1024 + c4); lw[i][1] = *(const f32x4*)(logw + (tok * 2 + 1) * 1024 + c4); }
#pragma unroll
            for (int i = 0; i < 4; ++i) {
                const size_t tok = (size_t)(tok0 + ch * 4 + i);
                f32x4 x[3];
#pragma unroll
                for (int s = 0; s < 3; ++s) x[s] = unpack4(rows[i][s]) * w[s][0] + unpack4(rows[i + 1][s]) * w[s][1] + unpack4(rows[i + 2][s]) * w[s][2] + bs[s];
                const f32x4 rr = x[0], k0 = x[1], vv = x[2];
                f32x4 kk = k0 * kkw;
                const float ssq = row_sum16((kk[0] * kk[0] + kk[1] * kk[1]) + (kk[2] * kk[2] + kk[3] * kk[3]));
                kk = kk * (1.0f / sqrtf(ssq + 1e-12f));
                const f32x4 a0 = unpack4(av[i][0]), a1 = unpack4(av[i][1]);
                const f32x4 kd0 = k0 * (1.0f + (a0 - 1.0f) * kaw), kd1 = k0 * (1.0f + (a1 - 1.0f) * kaw);
                const f32x4 rk = rr * k0 * rkw;
                const float bsum = row_sum16((rk[0] + rk[1]) + (rk[2] + rk[3]));
                pre0 += lw[i][0];
                const f32x4 e0 = exp4(pre0), ie0 = rcp4(e0);
                const f32x4 l1 = tot1 - pre1; pre1 += lw[i][1];
                const f32x4 e1 = exp4(l1), ie1 = rcp4(e1), e1prev = exp4(l1 - lw[i][1]);
                bf16* o = til + (tok * 16 + head) * TILP + hl;
                *(u32x2*)(o) = pack4(-kk * e0prev); *(u32x2*)(o + 64) = pack4(kk * a0 * ie0); *(u32x2*)(o + 128) = pack4(kd0 * ie0); *(u32x2*)(o + 192) = pack4(rr * e0);
                *(u32x2*)(o + 256) = pack4(-kk * e1prev); *(u32x2*)(o + 320) = pack4(kk * a1 * ie1); *(u32x2*)(o + 384) = pack4(kd1 * ie1); *(u32x2*)(o + 448) = pack4(rr * e1);
                *(u32x2*)(o + 512) = pack4(vv);
                e0prev = e0;
                if ((lane & 15) == 0) bonus[tok * 16 + head] = bsum;
            }
        }
        *(f32x4*)(wtb + (((size_t)run * 2 + 0) * 16 + head) * 64 + hl) = exp4(pre0);
        *(f32x4*)(wtb + (((size_t)run * 2 + 1) * 16 + head) * 64 + hl) = exp4(tot1);
        asm volatile("s_waitcnt vmcnt(0)" ::: "memory");
#pragma unroll 1
        for (int uu = 0; uu < 8; ++uu) rwkv_tinv_unit(F, (run << 5) | ((uu & 1) << 4) | (cg * 4 + (uu >> 1)));
    }
}

__device__ __forceinline__ bf16x8 packf(const f32x16& x, int s) {
    u32x4 p; p.x = cvtpk(x[8 * s + 0], x[8 * s + 1]); p.y = cvtpk(x[8 * s + 2], x[8 * s + 3]); p.z = cvtpk(x[8 * s + 4], x[8 * s + 5]); p.w = cvtpk(x[8 * s + 6], x[8 * s + 7]);
    return __builtin_bit_cast(bf16x8, p);
}
#define MFMA32(a, b, c) __builtin_amdgcn_mfma_f32_32x32x16_bf16((a), (b), (c), 0, 0, 0)

#define TR8(F0, F1, F2, F3, A, O0, O1, O2, O3) do { s16x4 l0_, h0_, l1_, h1_, l2_, h2_, l3_, h3_; \
    asm volatile("ds_read_b64_tr_b16 %0, %8 offset:%9\n\tds_read_b64_tr_b16 %1, %8 offset:%9+1024\n\tds_read_b64_tr_b16 %2, %8 offset:%10\n\tds_read_b64_tr_b16 %3, %8 offset:%10+1024\n\t" \
                 "ds_read_b64_tr_b16 %4, %8 offset:%11\n\tds_read_b64_tr_b16 %5, %8 offset:%11+1024\n\tds_read_b64_tr_b16 %6, %8 offset:%12\n\tds_read_b64_tr_b16 %7, %8 offset:%12+1024\n\ts_waitcnt lgkmcnt(0)" \
                 : "=&v"(l0_), "=&v"(h0_), "=&v"(l1_), "=&v"(h1_), "=&v"(l2_), "=&v"(h2_), "=&v"(l3_), "=&v"(h3_) : "v"(A), "n"(O0), "n"(O1), "n"(O2), "n"(O3)); \
    F0 = __builtin_shufflevector(l0_, h0_, 0, 1, 2, 3, 4, 5, 6, 7); F1 = __builtin_shufflevector(l1_, h1_, 0, 1, 2, 3, 4, 5, 6, 7); \
    F2 = __builtin_shufflevector(l2_, h2_, 0, 1, 2, 3, 4, 5, 6, 7); F3 = __builtin_shufflevector(l3_, h3_, 0, 1, 2, 3, 4, 5, 6, 7); } while (0)
#define TR4(F0, F1, A, O0, O1) do { s16x4 l0_, h0_, l1_, h1_; \
    asm volatile("ds_read_b64_tr_b16 %0, %4 offset:%5\n\tds_read_b64_tr_b16 %1, %4 offset:%5+1024\n\tds_read_b64_tr_b16 %2, %4 offset:%6\n\tds_read_b64_tr_b16 %3, %4 offset:%6+1024\n\ts_waitcnt lgkmcnt(0)" \
                 : "=&v"(l0_), "=&v"(h0_), "=&v"(l1_), "=&v"(h1_) : "v"(A), "n"(O0), "n"(O1)); \
    F0 = __builtin_shufflevector(l0_, h0_, 0, 1, 2, 3, 4, 5, 6, 7); F1 = __builtin_shufflevector(l1_, h1_, 0, 1, 2, 3, 4, 5, 6, 7); } while (0)
template <int V> struct IC { static constexpr int value = V; };
__device__ __forceinline__ void hyena_post_phase(const Frame& F, const Args& a, int layer, LAS bf16* tl, int gw, int NGW);
constexpr int CS_BUF = 23552, CS_AT = 0, CS_BT = 4096, CS_KT = 8192, CS_RT = 12288, CS_VV = 16384, CS_TI = 20480, CS_WT = 22528;
__device__ __forceinline__ void rwkv_cscan_phase(const Frame& F, const Args& a, int layer) {
    if (F.wave >= 2) {
        if (F.wave < 6) { LAS bf16* sl = (LAS bf16*)(F.lds + 4 * CS_BUF + (F.wave - 2) * 8704); const int gw = F.bid * 4 + (F.wave - 2), NGW = F.G * 4;
            hyena_post_phase(F, a, layer, sl, gw, NGW);
            if (layer + 1 < DEPTH) convert_layer(F, layer + 1, sl, gw, NGW); }
        return; }
    unsigned char* ws = WSP(F);
    const bf16* til = (const bf16*)(ws + WS_TIL);
    const bf16* tinv = (const bf16*)(ws + WS_TINV);
    const float* wtb = (const float*)(ws + WS_WTB);
    float* Y = (float*)(ws + WS_H);
    const int lane = F.lane, r = lane & 31, h = lane >> 5;
    const int i16 = lane & 15, tq = i16 >> 2, tp = i16 & 3, blk = (lane >> 4) & 1;
    LAS unsigned char* lbase = F.lds + F.wave * (2 * CS_BUF);
    const int slot = F.wave * F.G + F.bid, nslot = 2 * F.G;
    const int nsamp = 256;
    for (int item = slot; item < 2304; item += (slot < nsamp) ? 2304 : (nslot - nsamp)) {
        const bool sample = item < 256; const int hc = sample ? item : item - 256, chain = hc >> 1, vt = hc & 1;
        const int hd = chain & 15, e = (chain >> 4) & 1, b = chain >> 5;
        const int NC = sample ? (L_S / 32) : (L_P / 32), tokb = sample ? NPR + b * L_S : b * L_P;
        f32x16 ST[2];
        if (sample) { const float* s0 = INP(F, I_ST) + ((((size_t)b * 4 + layer) * 2 + e) * 16 + hd) * 4096;
#pragma unroll
            for (int kt = 0; kt < 2; ++kt)
#pragma unroll
                for (int g = 0; g < 4; ++g) { const f32x4 v = *(const f32x4*)(s0 + (32 * vt + r) * 64 + 32 * kt + 8 * g + 4 * h);
                    ST[kt][4 * g] = v[0]; ST[kt][4 * g + 1] = v[1]; ST[kt][4 * g + 2] = v[2]; ST[kt][4 * g + 3] = v[3]; }
        } else {
#pragma unroll
            for (int kt = 0; kt < 2; ++kt)
#pragma unroll
                for (int i = 0; i < 16; ++i) ST[kt][i] = 0.f;
        }
#define CS_DMA(C, BUFP) do { const int run_ = (tokb >> 5) + (e ? NC - 1 - (C) : (C)); int ln_ = lane_id(); asm volatile("" : "+v"(ln_));     \
            _Pragma("unroll") for (int i_ = 0; i_ < 4; ++i_) { const int q_ = ln_ + 64 * i_, p_ = q_ >> 3, cc_ = q_ & 7; \
                const bf16* g_ = til + ((size_t)(run_ * 32 + (e ? 31 - p_ : p_)) * 16 + hd) * TILP + e * 256 + 8 * cc_; \
                __builtin_amdgcn_global_load_lds((const unsigned*)(g_), (LAS unsigned*)((BUFP) + CS_AT + i_ * 1024), 16, 0, 0); \
                __builtin_amdgcn_global_load_lds((const unsigned*)(g_ + 64), (LAS unsigned*)((BUFP) + CS_BT + i_ * 1024), 16, 0, 0); \
                __builtin_amdgcn_global_load_lds((const unsigned*)(g_ + 128), (LAS unsigned*)((BUFP) + CS_KT + i_ * 1024), 16, 0, 0); \
                __builtin_amdgcn_global_load_lds((const unsigned*)(g_ + 192), (LAS unsigned*)((BUFP) + CS_RT + i_ * 1024), 16, 0, 0); \
                __builtin_amdgcn_global_load_lds((const unsigned*)(g_ - e * 256 + 512), (LAS unsigned*)((BUFP) + CS_VV + i_ * 1024), 16, 0, 0); } \
            const size_t unit_ = ((size_t)run_ * 2 + e) * 16 + hd; \
            _Pragma("unroll") for (int i_ = 0; i_ < 2; ++i_) __builtin_amdgcn_global_load_lds((const unsigned*)(tinv + unit_ * 1024 + (ln_ + 64 * i_) * 8), (LAS unsigned*)((BUFP) + CS_TI + i_ * 1024), 16, 0, 0); \
            __builtin_amdgcn_global_load_lds((const unsigned*)(wtb + unit_ * 64 + (ln_ & 15) * 4), (LAS unsigned*)((BUFP) + CS_WT), 16, 0, 0); } while (0)
        CS_DMA(0, lbase);
        auto chunk = [&](auto bi_, int c) __attribute__((always_inline)) {
            constexpr int BI = decltype(bi_)::value;
            const LAS unsigned char* B = lbase + BI * CS_BUF;
            if (c == 0) asm volatile("s_waitcnt vmcnt(0)" ::: "memory");
            else asm volatile("s_waitcnt vmcnt(16)" ::: "memory");
            if (c + 1 < NC) CS_DMA(c + 1, lbase + (1 - BI) * CS_BUF);
            bf16x8 nkaF[2], nbrF[2], nkrF[2];
#define CS_NMAT(OUTF, OFFA, OFFB, STRICT) do { f32x16 n_; _Pragma("unroll") for (int i = 0; i < 16; ++i) n_[i] = 0.f; \
                    _Pragma("unroll") for (int ks = 0; ks < 4; ++ks) { const int o = r * 128 + (16 * ks + 8 * h) * 2; \
                        n_ = MFMA32(*(const LAS bf16x8*)(B + (OFFA) + o), *(const LAS bf16x8*)(B + (OFFB) + o), n_); } \
                    _Pragma("unroll") for (int i = 0; i < 16; ++i) { const int row = (i & 3) + 8 * (i >> 2) + 4 * h; n_[i] = ((STRICT) ? (row < r) : (row <= r)) ? n_[i] : 0.f; } \
                    OUTF[0] = packf(n_, 0); OUTF[1] = packf(n_, 1); } while (0)
            CS_NMAT(nkaF, CS_KT, CS_AT, true);
            CS_NMAT(nbrF, CS_BT, CS_RT, false);
            CS_NMAT(nkrF, CS_KT, CS_RT, false);
#undef CS_NMAT
            const unsigned tra = (unsigned)(size_t)(B) + (4 * h + tq) * 128 + (16 * blk + 4 * tp) * 2 + vt * 64;
            const unsigned trk = (unsigned)(size_t)(B) + (4 * h + tq) * 128 + (16 * blk + 4 * tp) * 2;
            bf16x8 vvF[2], btF[2][2], ktF[2][2];
            TR4(vvF[0], vvF[1], tra, CS_VV, CS_VV + 2048);
            TR8(btF[0][0], btF[0][1], btF[1][0], btF[1][1], trk, CS_BT, CS_BT + 2048, CS_BT + 64, CS_BT + 64 + 2048);
            TR8(ktF[0][0], ktF[0][1], ktF[1][0], ktF[1][1], trk, CS_KT, CS_KT + 2048, CS_KT + 64, CS_KT + 64 + 2048);
#define CS_APERM(OFF, KT, S) ({ const LAS unsigned char* p_ = B + (OFF) + r * 128 + (32 * (KT) + 16 * (S) + 4 * h) * 2; \
                const u32x2 lo_ = *(const LAS u32x2*)p_, hi_ = *(const LAS u32x2*)(p_ + 16); __builtin_bit_cast(bf16x8, (u32x4){lo_.x, lo_.y, hi_.x, hi_.y}); })
            bf16x8 uF[2];
            {   f32x16 rhs;
#pragma unroll
                for (int i = 0; i < 16; ++i) rhs[i] = 0.f;
#pragma unroll
                for (int kt = 0; kt < 2; ++kt)
#pragma unroll
                    for (int s = 0; s < 2; ++s) rhs = MFMA32(CS_APERM(CS_AT, kt, s), packf(ST[kt], s), rhs);
#pragma unroll
                for (int s = 0; s < 2; ++s) rhs = MFMA32(nkaF[s], vvF[s], rhs);
                f32x16 u;
#pragma unroll
                for (int i = 0; i < 16; ++i) u[i] = 0.f;
#pragma unroll
                for (int s = 0; s < 2; ++s) { const LAS unsigned char* p_ = B + CS_TI + r * 64 + (16 * s + 4 * h) * 2;
                    const u32x2 lo_ = *(const LAS u32x2*)p_, hi_ = *(const LAS u32x2*)(p_ + 16);
                    u = MFMA32(__builtin_bit_cast(bf16x8, (u32x4){lo_.x, lo_.y, hi_.x, hi_.y}), packf(rhs, s), u); }
                uF[0] = packf(u, 0); uF[1] = packf(u, 1);
            }
            {   const int run = (tokb >> 5) + (e ? NC - 1 - c : c);
                f32x16 y;
#pragma unroll
                for (int i = 0; i < 16; ++i) y[i] = 0.f;
#pragma unroll
                for (int kt = 0; kt < 2; ++kt)
#pragma unroll
                    for (int s = 0; s < 2; ++s) y = MFMA32(CS_APERM(CS_RT, kt, s), packf(ST[kt], s), y);
#pragma unroll
                for (int s = 0; s < 2; ++s) { y = MFMA32(nbrF[s], uF[s], y); y = MFMA32(nkrF[s], vvF[s], y); }
#pragma unroll
                for (int i = 0; i < 16; ++i) { const int p = (i & 3) + 8 * (i >> 2) + 4 * h; const size_t tok = (size_t)(run * 32 + (e ? 31 - p : p));
                    Y[((size_t)e * M + tok) * 1024 + hd * 64 + 32 * vt + r] = y[i]; }
            }
#pragma unroll
            for (int kt = 0; kt < 2; ++kt) {
                f32x4 wt[4];
#pragma unroll
                for (int g = 0; g < 4; ++g) wt[g] = *(const LAS f32x4*)(B + CS_WT + (32 * kt + 8 * g + 4 * h) * 4);
#pragma unroll
                for (int s = 0; s < 2; ++s) { ST[kt] = MFMA32(btF[kt][s], uF[s], ST[kt]); ST[kt] = MFMA32(ktF[kt][s], vvF[s], ST[kt]); }
#pragma unroll
                for (int i = 0; i < 16; ++i) ST[kt][i] *= wt[i >> 2][i & 3];
            }
        };
#pragma unroll 1
        for (int c2 = 0; c2 < NC; c2 += 2) { chunk(IC<0>{}, c2); chunk(IC<1>{}, c2 + 1); }
#undef CS_APERM
#undef CS_DMA
        if (!sample) { float* so = OUTP(F) + OUT_ST + ((((size_t)b * 4 + layer) * 2 + e) * 16 + hd) * 4096;
#pragma unroll
            for (int kt = 0; kt < 2; ++kt)
#pragma unroll
                for (int g = 0; g < 4; ++g) *(f32x4*)(so + (32 * vt + r) * 64 + 32 * kt + 8 * g + 4 * h) = (f32x4){ST[kt][4 * g], ST[kt][4 * g + 1], ST[kt][4 * g + 2], ST[kt][4 * g + 3]};
        }
    }
    asm volatile("s_waitcnt vmcnt(0)" ::: "memory");
}

__device__ __forceinline__ void rwkv_post_phase(const Frame& F, const Args& a, int layer) {
    unsigned char* ws = WSP(F);
    const float* Y = (const float*)(ws + WS_H);
    const bf16* til = (const bf16*)(ws + WS_TIL); const bf16* gbuf = (const bf16*)(ws + WS_G); const float* bonus = (const float*)(ws + WS_BONUS);
    bf16* oall = (bf16*)(ws + WS_OALL);
    const int lane = F.lane;
    for (int item = F.wave * F.G + F.bid; item < 2048; item += 8 * F.G) {
        const int tok0 = (item >> 2) * 32, cg = item & 3, c4 = cg * 256 + 4 * lane, head = cg * 4 + (lane >> 4), hl = 4 * (lane & 15);
        const f32x4 gng = *(const f32x4*)(INP(F, I_GNG) + layer * 1024 + c4), gnb = *(const f32x4*)(INP(F, I_GNB) + layer * 1024 + c4);
#pragma unroll 1
        for (int ch = 0; ch < 4; ++ch) {
            f32x4 y0[8], y1[8]; u32x2 vw[8], gw[8]; float bn[8];
#pragma unroll
            for (int i = 0; i < 8; ++i) { const size_t tok = (size_t)(tok0 + ch * 8 + i);
                y0[i] = *(const f32x4*)(Y + tok * 1024 + c4); y1[i] = *(const f32x4*)(Y + ((size_t)M + tok) * 1024 + c4);
                vw[i] = *(const u32x2*)(til + (tok * 16 + head) * TILP + 512 + hl); gw[i] = *(const u32x2*)(gbuf + tok * 1024 + c4); bn[i] = bonus[tok * 16 + head]; }
#pragma unroll
            for (int i = 0; i < 8; ++i) { const size_t tok = (size_t)(tok0 + ch * 8 + i);
                const f32x4 y = y0[i] + y1[i];
                const float mu = row_sum16((y[0] + y[1]) + (y[2] + y[3])) * (1.0f / 64.0f);
                const f32x4 dd = y - mu;
                const float var = row_sum16((dd[0] * dd[0] + dd[1] * dd[1]) + (dd[2] * dd[2] + dd[3] * dd[3])) * (1.0f / 64.0f);
                const f32x4 yn = dd * (1.0f / sqrtf(var + 64e-5f)) * gng + gnb;
                const f32x4 o = (yn + bn[i] * unpack4(vw[i])) * unpack4(gw[i]);
                *(u32x2*)(oall + tok * 3072 + 1024 + c4) = pack4(o);
            }
        }
    }
}

__device__ __forceinline__ void hyena_prep_phase(const Frame& F, const Args& a, int layer) {
    unsigned char* ws = WSP(F);
    const bf16* proj = (const bf16*)(ws + WS_PROJ);
    bf16* zT = (bf16*)(ws + WS_ZT);
    const float* cw = INP(F, I_HCW) + (size_t)layer * 3 * 3072; const float* cb = INP(F, I_HCB) + (size_t)layer * 3072;
    const int gw = F.bid * 8 + F.wave, NGW = F.G * 8, lane = F.lane, tsub = lane >> 4, cq = lane & 15;
    LAS bf16* tl = (LAS bf16*)(F.lds + F.wave * 16384);
    for (int it = gw; it < 256 * 16; it += NGW) {
        const int tt0 = (it >> 4) * 64, c0 = (it & 15) * 64, c4 = c0 + 4 * cq;
        const int t0 = tt0 < NPR ? (tt0 & 255) : ((tt0 - NPR) & 2047), L = tt0 < NPR ? L_P : L_S;
        f32x4 w1[3], w2[3];
#pragma unroll
        for (int tp = 0; tp < 3; ++tp) { w1[tp] = *(const f32x4*)(cw + tp * 3072 + 1024 + c4); w2[tp] = *(const f32x4*)(cw + tp * 3072 + 2048 + c4); }
        const f32x4 b1 = *(const f32x4*)(cb + 1024 + c4), b2 = *(const f32x4*)(cb + 2048 + c4);
        const bf16* px = proj + (size_t)tt0 * NPROJ + COL_X1 + c4;
#pragma unroll 1
        for (int hf = 0; hf < 2; ++hf) {
            u32x2 xr[8][3], vr[8][3];
#pragma unroll
            for (int i = 0; i < 8; ++i) { const int tt = 4 * (hf * 8 + i) + tsub;
#pragma unroll
                for (int d = 0; d < 3; ++d) { const int t = t0 + tt + d - 1; const bool ok = (t >= 0) && (t < L); const bf16* p = px + (long)(tt + d - 1) * NPROJ;
                    xr[i][d] = ok ? *(const u32x2*)p : (u32x2){0u, 0u}; vr[i][d] = ok ? *(const u32x2*)(p + 1024) : (u32x2){0u, 0u}; } }
#pragma unroll
            for (int i = 0; i < 8; ++i) { const int tt = 4 * (hf * 8 + i) + tsub;
                const f32x4 x1c = unpack4(xr[i][0]) * w1[0] + unpack4(xr[i][1]) * w1[1] + unpack4(xr[i][2]) * w1[2] + b1;
                const f32x4 vvc = unpack4(vr[i][0]) * w2[0] + unpack4(vr[i][1]) * w2[1] + unpack4(vr[i][2]) * w2[2] + b2;
                *(LAS u32x2*)(tl + tt * 68 + 4 * cq) = pack4(x1c * vvc); }
        }
        LDS_WAIT(); asm volatile("" ::: "memory");
#pragma unroll 16
        for (int cc = 0; cc < 64; ++cc) zT[(size_t)(c0 + cc) * M + tt0 + lane] = tl[lane * 68 + cc];
        LDS_WAIT(); asm volatile("" ::: "memory");
    }
}

__device__ __forceinline__ void hyena_conv_phase(const Frame& F, const Args& a, int layer) {
    unsigned char* ws = WSP(F);
    bf16* zT = (bf16*)(ws + WS_ZT);
    const float* FNORM = (const float*)(ws + WS_CTL) + CW_FNORM;
    const int lane = F.lane, w = F.wave, r = lane & 31, h = lane >> 5;
    LAS unsigned char* lds = F.lds;
    for (int u = F.bid; u < 2048; u += F.G) {
        const bool sample = u < 1024; const int c = u & 1023;
        const int L = sample ? L_S : L_P, LP = sample ? LPS : LPP, FCS = LP * 2;
        const int ZROW = (L + 448) * 2, ZOFF = 2 * FCS;
        const int NB = sample ? 4 : 32, tokb = sample ? NPR : 0;
        const bf16* fsrc = sample ? (const bf16*)(ws + WS_FS) + ((size_t)layer * 1024 + c) * LPS : (const bf16*)(ws + WS_FP) + ((size_t)layer * 1024 + c) * LPP;
        __syncthreads();
        for (int i = F.tid; i < LP / 8; i += 512) *(LAS u32x4*)(lds + i * 16) = *(const u32x4*)(fsrc + i * 8);
        for (int i = F.tid; i < LP; i += 512) *(LAS bf16*)(lds + FCS + i * 2) = (i + 1 < LP) ? fsrc[i + 1] : (bf16)0;
        { const int cpr = L / 8;
          for (int i = F.tid; i < NB * cpr; i += 512) { const int b = i / cpr, q = i - b * cpr;
              *(LAS u32x4*)(lds + ZOFF + b * ZROW + 448 + q * 16) = *(const u32x4*)(zT + (size_t)c * M + tokb + b * L + q * 8); }
          if (sample) for (int i = F.tid; i < NB * 56; i += 512) { const int b = i / 56, q = i - b * 56;
              *(LAS u32x4*)(lds + ZOFF + b * ZROW + (q < 28 ? q * 16 : 448 + L * 2 + (q - 28) * 16)) = (u32x4){0u, 0u, 0u, 0u}; } }
        __syncthreads();
        const int nbl = sample ? 2 : 5;
        const int I0 = sample ? 8 * w : w;
        const int b = r & (NB - 1), I = I0 + (r >> nbl);
        int dlo = (sample ? I0 - 63 : I0 - 7), dhi = (sample ? I0 + 7 : I0);
        const int dmax = L / 64;
        dlo = dlo < -dmax ? -dmax : dlo; dhi = dhi > dmax ? dmax : dhi;
        f32x16 acc;
#pragma unroll
        for (int i = 0; i < 16; ++i) acc[i] = 0.f;
        const LAS unsigned char* zb = lds + ZOFF + b * ZROW + (224 + 8 * h) * 2;
#pragma unroll 2
        for (int d = dlo; d <= dhi; ++d) {
#pragma unroll
            for (int ks = 0; ks < 2; ++ks) {
                const int st = (L / 2 - 1) - 32 * d - r + 16 * ks + 8 * h + 32;
                const int par = st & 1;
                const LAS unsigned* ap = (const LAS unsigned*)(lds + par * FCS + (st - par) * 2);
                const u32x4 aw = (u32x4){ap[0], ap[1], ap[2], ap[3]};
                const bf16x8 af = __builtin_bit_cast(bf16x8, aw);
                const bf16x8 bfr = *(const LAS bf16x8*)(zb + (32 * (I - d) + 16 * ks) * 2);
                acc = __builtin_amdgcn_mfma_f32_32x32x16_bf16(af, bfr, acc, 0, 0, 0);
            }
        }
        const float inv = 1.0f / (FNORM[((size_t)layer * 2 + (sample ? 0 : 1)) * 1024 + c] + 1e-6f);
        const float dco = INP(F, I_HD)[layer * 1024 + c];
        __syncthreads();
#pragma unroll
        for (int g = 0; g < 4; ++g) {
            const int t = 32 * I + 8 * g + 4 * h;
            const LAS bf16* zp = (const LAS bf16*)(lds + ZOFF + b * ZROW + (224 + t) * 2);
            float o[4];
#pragma unroll
            for (int j = 0; j < 4; ++j) o[j] = acc[4 * g + j] * inv + bf2f(zp[j]) * dco;
            *(u32x2*)(zT + (size_t)c * M + tokb + b * L + t) = (u32x2){cvtpk(o[0], o[1]), cvtpk(o[2], o[3])};
        }
    }
    __syncthreads();
}

__device__ __forceinline__ void hyena_post_phase(const Frame& F, const Args& a, int layer, LAS bf16* tl, int gw, int NGW) {
    unsigned char* ws = WSP(F);
    const bf16* proj = (const bf16*)(ws + WS_PROJ);
    const bf16* yT = (const bf16*)(ws + WS_ZT);
    bf16* oall = (bf16*)(ws + WS_OALL);
    const float* cw = INP(F, I_HCW) + (size_t)layer * 3 * 3072; const float* cb = INP(F, I_HCB) + (size_t)layer * 3072;
    const int lane = F.lane, tsub = lane >> 4, cq = lane & 15;
    for (int it = gw; it < 256 * 16; it += NGW) {
        const int tt0 = (it >> 4) * 64, c0 = (it & 15) * 64, c4 = c0 + 4 * cq;
        const int t0 = tt0 < NPR ? (tt0 & 255) : ((tt0 - NPR) & 2047), L = tt0 < NPR ? L_P : L_S;
#pragma unroll 1
        for (int q = 0; q < 4; ++q) { bf16 tmp[16];
#pragma unroll
            for (int j = 0; j < 16; ++j) tmp[j] = yT[(size_t)(c0 + q * 16 + j) * M + tt0 + lane];
#pragma unroll
            for (int j = 0; j < 16; ++j) tl[(q * 16 + j) * 68 + lane] = tmp[j]; }
        LDS_WAIT(); asm volatile("" ::: "memory");
        f32x4 w0[3];
#pragma unroll
        for (int tp = 0; tp < 3; ++tp) w0[tp] = *(const f32x4*)(cw + tp * 3072 + c4);
        const f32x4 b0 = *(const f32x4*)(cb + c4);
        const bf16* px = proj + (size_t)tt0 * NPROJ + COL_X0 + c4;
#pragma unroll 1
        for (int hf = 0; hf < 2; ++hf) {
            u32x2 xr[8][3];
#pragma unroll
            for (int i = 0; i < 8; ++i) { const int tt = 4 * (hf * 8 + i) + tsub;
#pragma unroll
                for (int d = 0; d < 3; ++d) { const int t = t0 + tt + d - 1; const bool ok = (t >= 0) && (t < L); xr[i][d] = ok ? *(const u32x2*)(px + (long)(tt + d - 1) * NPROJ) : (u32x2){0u, 0u}; } }
#pragma unroll
            for (int i = 0; i < 8; ++i) { const int tt = 4 * (hf * 8 + i) + tsub;
                const f32x4 x0c = unpack4(xr[i][0]) * w0[0] + unpack4(xr[i][1]) * w0[1] + unpack4(xr[i][2]) * w0[2] + b0;
                const f32x4 yv = (f32x4){bf2f(tl[(4 * cq + 0) * 68 + tt]), bf2f(tl[(4 * cq + 1) * 68 + tt]), bf2f(tl[(4 * cq + 2) * 68 + tt]), bf2f(tl[(4 * cq + 3) * 68 + tt])};
                *(u32x2*)(oall + (size_t)(tt0 + tt) * 3072 + 2048 + c4) = pack4(x0c * yv); }
        }
        LDS_WAIT(); asm volatile("" ::: "memory");
    }
}

constexpr int NPL = 11, PH_LAYER0 = 2, PH_FINAL = PH_LAYER0 + DEPTH * NPL, N_PHASES = PH_FINAL + 1;

__global__ void __launch_bounds__(512, 2) mega(Args args) {
    extern __shared__ __attribute__((aligned(16))) unsigned char lds_raw[];
    Frame F;
    F.lds = (LAS unsigned char*)lds_raw;
    F.tid = threadIdx.x; F.lane = F.tid & 63; F.wave = __builtin_amdgcn_readfirstlane(F.tid >> 6);
    F.G = gridDim.x; F.bid = blockIdx.x;
    for (int u = F.tid; u < (LDS_BYTES - LDSCTL_OFF) / 4; u += 512) ((LAS unsigned*)(F.lds + LDSCTL_OFF))[u] = 0u;
    __syncthreads();
    if (F.tid < 48) { const unsigned long long p = F.tid < 46 ? (unsigned long long)args.in[F.tid] : (F.tid == 46 ? (unsigned long long)args.out : (unsigned long long)args.ws);
        ((LAS unsigned*)(F.lds + LDS_ARGT))[2 * F.tid] = (unsigned)p; ((LAS unsigned*)(F.lds + LDS_ARGT))[2 * F.tid + 1] = (unsigned)(p >> 32); }
    __syncthreads();
    unsigned char* ws = WSP(F);
    unsigned* ctl = (unsigned*)(ws + WS_CTL);
    int lo = args.ph_lo, hi = args.ph_hi;
    const bool single = (hi - lo) > 1;
    XcdBarrier bar; bar.bar = ctl + CW_BAR; bar.x = 0; bar.st = (volatile LAS unsigned*)(F.lds + LDSCTL_OFF + 64); bar.wave = F.wave;
    if (single) bar = xcd_barrier_post(ctl + CW_BAR, (volatile LAS unsigned*)(F.lds + LDSCTL_OFF + 64), F.wave);
#ifndef MK_EN
#define MK_EN 0xFFFFFF
#endif
#define IN(k) (lo <= (k) && (k) < hi)
#define EN(b) ((MK_EN >> (b)) & 1)
#ifndef MK_DUP
#define MK_DUP -1
#endif
#define REPS(k) ((MK_DUP == (k)) ? 2 : 1)
#define FRESH() do { F.lane = lane_id(); asm volatile("" : "+v"(F.lane), "+s"(F.bid), "+s"(F.wave), "+s"(F.G)); F.tid = F.wave * 64 + F.lane; } while (0)
#define SEAM(k) do { if (IN(k) && IN((k) + 1)) xcd_barrier(bar); } while (0)

    if (EN(20) && IN(0)) { FRESH(); prologue0(F, args); SEAM(0); }
    if (EN(21) && IN(1)) { FRESH(); prologue1(F, args); SEAM(1); }

    bf16* Hb = (bf16*)(ws + WS_H); bf16* proj = (bf16*)(ws + WS_PROJ); bf16* oall = (bf16*)(ws + WS_OALL);
    float* x = OUTP(F);
#pragma unroll 1
    for (int l = 0; l < DEPTH; ++l) {
        const int pb = PH_LAYER0 + l * NPL;
        asm volatile("" : "+s"(lo), "+s"(hi));
        const float* mod = (const float*)(ws + WS_MOD) + (size_t)l * 5 * 12288;
        if (EN(0) && IN(pb + 0)) { FRESH();
            norm_phase(F, l == 0 ? INP(F, I_XP) : x, l == 0 ? INP(F, I_XS) : x + (size_t)NPR * D, l == 0 ? x : nullptr, INP(F, I_LN1) + l * D, mod, 0, 1, Hb);
            SEAM(pb + 0);
        }
        if (EN(1) && IN(pb + 1)) { FRESH();
            pg8::Gemm g{Hb, (const bf16*)(ws + WS_WIN) + (size_t)l * NPROJ * D, D, D, D, 0, 0, 0};
            pg8::Order S; S.init(M, NPROJ, F.G, F.bid, 1);
            pg8::EpiProj E{proj, x + OUT_CK, x + OUT_CV, l};
            pg8::gemm_phase(F.lds, g, S, E, F.wave);
            SEAM(pb + 1);
        }
        if (EN(2) && IN(pb + 2)) { FRESH();
            {   pg8::Gemm g{proj + COL_LW, (const bf16*)(ws + WS_W2T) + (size_t)l * 5120 * 256, NPROJ, 256, 256, 0, 128, 4};
                pg8::Order5 S; S.init(M, F.G, F.bid);
                pg8::EpiLora2 E{(float*)(ws + WS_DEC), (bf16*)(ws + WS_A), (bf16*)(ws + WS_G), INP(F, I_W0) + l * 2048, INP(F, I_A0) + l * 2048};
                pg8::gemm_phase(F.lds, g, S, E, F.wave); }
            FRESH(); attention_phase(F, args, l);
            FRESH(); hyena_prep_phase(F, args, l);
            SEAM(pb + 2);
        }
        if (EN(3) && IN(pb + 3)) { FRESH(); rwkv_prep_phase(F, args, l); FRESH(); hyena_conv_phase(F, args, l); SEAM(pb + 3); }
        if (EN(4) && IN(pb + 4)) { FRESH(); rwkv_cscan_phase(F, args, l); SEAM(pb + 4); }
        if (EN(5) && IN(pb + 5)) { FRESH(); rwkv_post_phase(F, args, l); SEAM(pb + 5); }
        if (EN(6) && IN(pb + 6)) { FRESH();
            pg8::Gemm g{oall, (const bf16*)(ws + WS_WP) + (size_t)l * 3 * D * 1024, 3072, 1024, 1024, 1024, 0, 8};
            pg8::Order S; S.init(M, D, F.G, F.bid, 3);
            pg8::EpiMerge E{proj, Hb};
            pg8::gemm_phase(F.lds, g, S, E, F.wave);
            SEAM(pb + 6);
        }
        if (EN(7) && IN(pb + 7)) { FRESH();
            pg8::Gemm g{Hb, (const bf16*)(ws + WS_WOUT) + (size_t)l * D * D, D, D, D, 0, 0, 0};
            pg8::Order S; S.init(M, D, F.G, F.bid, 1);
            pg8::EpiResid E{x, mod + 2 * D, nullptr, 1.0f};
            pg8::gemm_phase(F.lds, g, S, E, F.wave);
            SEAM(pb + 7);
        }
        if (EN(8) && IN(pb + 8)) { FRESH(); norm_phase(F, x, x + (size_t)NPR * D, nullptr, INP(F, I_LN2) + l * D, mod, 3, 4, Hb); SEAM(pb + 8); }
        if (EN(9) && IN(pb + 9)) { FRESH();
            pg8::Gemm g{Hb, (const bf16*)(ws + WS_WFF1) + (size_t)l * D * DFF, D, D, D, 0, 0, 0};
            pg8::Order S; S.init(M, DFF, F.G, F.bid, 1);
            pg8::EpiFF1 E{proj, INP(F, I_BFF1) + l * DFF};
            pg8::gemm_phase(F.lds, g, S, E, F.wave);
            SEAM(pb + 9);
        }
        if (EN(10) && IN(pb + 10)) { FRESH();
            pg8::Gemm g{proj, (const bf16*)(ws + WS_WFF2) + (size_t)l * D * DFF, DFF, DFF, DFF, 0, 0, 0};
            pg8::Order S; S.init(M, D, F.G, F.bid, 1);
            pg8::EpiResid E{x, mod + 5 * D, INP(F, I_BFF2) + l * D, 1.0f};
            pg8::gemm_phase(F.lds, g, S, E, F.wave);
            SEAM(pb + 10);
        }
    }
    asm volatile("" : "+s"(lo), "+s"(hi));
    if (EN(22) && IN(PH_FINAL)) { FRESH(); final_norm_phase(F, OUTP(F), INP(F, I_FING)); }
#undef IN
#undef SEAM
}

extern "C" void kernel_launch(void* const* d_in, const int* in_sizes, int n_in, void* d_out, int out_size, void* d_ws, size_t ws_size, hipStream_t stream) {
    static int grid = 0;
    if (grid == 0) {
        if (n_in != N_INPUTS || (size_t)out_size != OUT_TOTAL || ws_size < WS_END) { fprintf(stderr, "kernel_launch: unexpected shapes: n_in %d out %d ws %zu\n", n_in, out_size, ws_size); grid = -1; return; }
        int dev = 0, cus = 0, per_cu = 0;
        if (hipGetDevice(&dev) != hipSuccess || hipDeviceGetAttribute(&cus, hipDeviceAttributeMultiprocessorCount, dev) != hipSuccess) { grid = -1; return; }
        if (hipFuncSetAttribute((const void*)mega, hipFuncAttributeMaxDynamicSharedMemorySize, LDS_BYTES) != hipSuccess) { fprintf(stderr, "kernel_launch: hipFuncSetAttribute failed\n"); grid = -1; return; }
        if (hipOccupancyMaxActiveBlocksPerMultiprocessor(&per_cu, (const void*)mega, 512, LDS_BYTES) != hipSuccess || per_cu < 1) { fprintf(stderr, "kernel_launch: occupancy query says %d\n", per_cu); }
        (void)hipGetLastError();
        grid = cus;
    }
    if (grid < 0) return;
    (void)hipMemsetAsync((char*)d_ws + WS_CTL, 0, CTL_ZERO_BYTES, stream);
    Args a{};
    for (int i = 0; i < N_INPUTS; ++i) a.in[i] = (const float*)d_in[i];
    a.out = (float*)d_out; a.ws = (unsigned char*)d_ws;
#if MK_MULTI
    for (int ph = 0; ph < N_PHASES; ++ph) { a.ph_lo = ph; a.ph_hi = ph + 1; hipLaunchKernelGGL(mega, dim3(grid), dim3(512), LDS_BYTES, stream, a); }
#else
    a.ph_lo = 0; a.ph_hi = N_PHASES;
    hipLaunchKernelGGL(mega, dim3(grid), dim3(512), LDS_BYTES, stream, a);
#endif
    const hipError_t le = hipPeekAtLastError();
    if (le != hipSuccess) fprintf(stderr, "kernel_launch: launch failed: %s\n", hipGetErrorName(le));
}
```

```cpp
#include <hip/hip_runtime.h>
#include <cstdio>
#include <cstdint>

#ifndef MK_MULTI
#define MK_MULTI 0
#endif

#define GAS __attribute__((address_space(1)))
#define LAS __attribute__((address_space(3)))
typedef unsigned short bf16;
typedef short bf16x8 __attribute__((ext_vector_type(8)));
typedef short s16x4 __attribute__((ext_vector_type(4)));
typedef float f32x4 __attribute__((ext_vector_type(4)));
typedef float f32x2 __attribute__((ext_vector_type(2)));
typedef float f32x16 __attribute__((ext_vector_type(16)));
typedef unsigned u32x4 __attribute__((ext_vector_type(4)));
typedef unsigned u32x2 __attribute__((ext_vector_type(2)));
typedef __bf16 bf16x2_t __attribute__((ext_vector_type(2)));

constexpr int D = 2048, DEPTH = 4, NPR = 8192  , M = 16384, DFF = 8192;
constexpr int NPROJ = 15872;
constexpr int COL_K = 1024, COL_V = 2048, COL_R = 3072, COL_X0 = 6144, COL_X1 = 7168, COL_VV = 8192, COL_GL = 9216, COL_LW = 15360, COL_G1A = 15488;
constexpr int L_P = 256, L_S = 2048;

enum { I_XP = 0, I_XS, I_CK, I_CV, I_ST, I_C, I_CCTX, I_LN1, I_LN2, I_WMOD, I_BMOD, I_WIN, I_RPB, I_CW, I_CB, I_W0, I_W1, I_W2, I_A0, I_A1, I_A2, I_G1, I_G2,
       I_KK, I_KA, I_RK, I_GNG, I_GNB, I_HCW, I_HCB, I_F1, I_FB1, I_F2, I_FB2, I_FREQ, I_F3, I_HD, I_WPA, I_WPR, I_WPC, I_WOUT, I_FF1, I_BFF1, I_FF2, I_BFF2, I_FING, N_INPUTS };

constexpr size_t OUT_X = 0, OUT_CK = 33554432, OUT_CV = 67108864, OUT_ST = 100663296, OUT_TOTAL = 117440512;

constexpr size_t MiB = 1u << 20;
constexpr size_t WS_CTL = 0, CTL_ZERO_BYTES = 1 * MiB;
constexpr size_t WS_WIN = 2 * MiB;
constexpr size_t WS_W2T = 250 * MiB;
constexpr size_t WS_WP = 260 * MiB;
constexpr size_t WS_WOUT = 308 * MiB;
constexpr size_t WS_WFF1 = 340 * MiB;
constexpr size_t WS_WFF2 = 468 * MiB;
constexpr size_t WS_H = 596 * MiB;
constexpr size_t WS_A = 660 * MiB;
constexpr size_t WS_PROJ = 724 * MiB;
constexpr size_t WS_OALL = 1220 * MiB;
constexpr size_t WS_DEC = 1316 * MiB;
constexpr size_t WS_G = 1444 * MiB;
constexpr size_t WS_TIL = 1476 * MiB;
constexpr size_t WS_CK = 1764 * MiB;
constexpr size_t WS_CV = 1772 * MiB;
constexpr size_t WS_FS = 1780 * MiB;
constexpr size_t WS_FP = 1797 * MiB;
constexpr size_t WS_ZT = 1800 * MiB;
constexpr size_t WS_MOD = 1832 * MiB;
constexpr size_t WS_T2 = 1833 * MiB;
constexpr size_t WS_BONUS = 1837 * MiB;
constexpr size_t WS_TINV = 1838 * MiB;
constexpr size_t WS_Q = WS_TINV;
constexpr size_t WS_WTB = 1870 * MiB;
constexpr size_t WS_END = 1874 * MiB;
constexpr int TILP = 576;
constexpr int LPS = 2120, LPP = 328;

constexpr int CW_BAR = 4096;
constexpr int CW_FNORM = 32768;

constexpr int LDS_SCRATCH = 131072, LDSCTL_OFF = 131072, LDS_BYTES = 147456;

#define LDS_WAIT() asm volatile("s_waitcnt lgkmcnt(0)" ::: "memory")
#define VM_WAIT() asm volatile("s_waitcnt vmcnt(0)" ::: "memory")
__device__ __forceinline__ unsigned cvtpk(float lo, float hi) { f32x2 v = {lo, hi}; bf16x2_t b = __builtin_convertvector(v, bf16x2_t); return __builtin_bit_cast(unsigned, b); }
__device__ __forceinline__ bf16 f2bf(float f) { return (bf16)(cvtpk(f, 0.f) & 0xffffu); }
__device__ __forceinline__ float bf2f(bf16 b) { return __uint_as_float(((unsigned)b) << 16); }
__device__ __forceinline__ float bflo(unsigned w) { return __uint_as_float(w << 16); }
__device__ __forceinline__ float bfhi(unsigned w) { return __uint_as_float(w & 0xffff0000u); }
#define DPPF(v, ctrl) __int_as_float(__builtin_amdgcn_update_dpp(0, __float_as_int(v), (ctrl), 0xf, 0xf, false))
__device__ __forceinline__ float wave_sum(float v) {
    v += DPPF(v, 0xB1); v += DPPF(v, 0x4E); v += DPPF(v, 0x141); v += DPPF(v, 0x140);
    const float a = __int_as_float(__builtin_amdgcn_readlane(__float_as_int(v), 0)), b = __int_as_float(__builtin_amdgcn_readlane(__float_as_int(v), 16)),
                c = __int_as_float(__builtin_amdgcn_readlane(__float_as_int(v), 32)), d = __int_as_float(__builtin_amdgcn_readlane(__float_as_int(v), 48));
    return (a + b) + (c + d);
}
__device__ __forceinline__ float xor32(float v, int lane) { return __int_as_float(__builtin_amdgcn_ds_bpermute((lane ^ 32) << 2, __float_as_int(v))); }
__device__ __forceinline__ int lane_id() { return (int)__builtin_amdgcn_mbcnt_hi(~0u, __builtin_amdgcn_mbcnt_lo(~0u, 0u)); }
__device__ __forceinline__ float sigmoidf_(float x) { return 1.0f / (1.0f + __expf(-x)); }

#define XB_TMO      128
#define XB_XCNT(j)  (256  + 64 * (j))
#define XB_XSUB(j)  (1280 + 64 * (j))
#define XB_XGEN(j)  (2304 + 64 * (j))
#define XB_TOP      3328
#define XB_TOPGEN   3392
#define XCD_BAR_WORDS 3456
#define XB_SPIN_CAP (1u << 20)
__device__ __forceinline__ unsigned xb_ld(unsigned* p)              { return __hip_atomic_load(p, __ATOMIC_RELAXED, __HIP_MEMORY_SCOPE_AGENT); }
__device__ __forceinline__ unsigned xb_add(unsigned* p, unsigned v) { return __hip_atomic_fetch_add(p, v, __ATOMIC_RELAXED, __HIP_MEMORY_SCOPE_AGENT); }
__device__ __forceinline__ unsigned xb_xcc_id() { return (unsigned)__builtin_amdgcn_s_getreg((3 << 11) | 20) & 0xFu; }
#define XB_SPIN(cond, bar) do { unsigned _sp = 0; while (cond) { __builtin_amdgcn_s_sleep(1); \
    if ((++_sp & 255u) == 0u) { if (xb_ld(&(bar)[XB_TMO])) break; if (_sp > XB_SPIN_CAP) { atomicAdd(&(bar)[XB_TMO], 1u); break; } } } } while (0)
struct XcdBarrier { unsigned* bar; unsigned x; volatile LAS unsigned* st; int wave; };
__device__ __forceinline__ XcdBarrier xcd_barrier_post(unsigned* bar, volatile LAS unsigned* st, int wave) {
    XcdBarrier b; b.bar = bar; b.x = xb_xcc_id(); b.st = st; b.wave = wave;
    if (wave == 0 && lane_id() == 0) (void)xb_add(&bar[XB_XCNT(b.x)], 1u);
    return b;
}
__device__ __forceinline__ void xcd_barrier_complete(unsigned* bar, unsigned x, unsigned& nloc, unsigned& nx) {
    const unsigned G = gridDim.x * gridDim.y * gridDim.z;
    unsigned sum, cnt, mine, sp = 0u;
    for (;;) {
        sum = 0u; cnt = 0u; mine = 0u;
#pragma unroll
        for (unsigned j = 0; j < 16; ++j) { const unsigned c = xb_ld(&bar[XB_XCNT(j)]); sum += c; cnt += (c > 0u) ? 1u : 0u; mine = (j == x) ? c : mine; }
        if (sum == G) break;
        __builtin_amdgcn_s_sleep(1);
        if ((++sp & 255u) == 0u) { if (xb_ld(&bar[XB_TMO])) break; if (sp > XB_SPIN_CAP) { atomicAdd(&bar[XB_TMO], 1u); break; } }
    }
    nloc = mine > 0u ? mine : 1u; nx = cnt > 0u ? cnt : 1u;
}
__device__ __forceinline__ void xcd_barrier(const XcdBarrier& b) {
    asm volatile("s_waitcnt vmcnt(0)" ::: "memory");
    __syncthreads();
    if (b.wave == 0 && lane_id() == 0) {
        unsigned* bar = b.bar; asm volatile("" : "+s"(bar));
        __builtin_amdgcn_s_waitcnt(0);
        unsigned nloc = b.st[0], nx = b.st[1];
        if (nloc == 0u) { xcd_barrier_complete(bar, b.x, nloc, nx); b.st[0] = nloc; b.st[1] = nx; }
        const unsigned old = xb_add(&bar[XB_XSUB(b.x)], 1u);
        const unsigned gen = old / nloc;
        if (old + 1u == (gen + 1u) * nloc) {
            __builtin_amdgcn_fence(__ATOMIC_RELEASE, "agent");
            asm volatile("s_waitcnt vmcnt(0)" ::: "memory");
            const unsigned og = xb_add(&bar[XB_TOP], 1u);
            const unsigned tg = og / nx;
            if (og + 1u == (tg + 1u) * nx) xb_add(&bar[XB_TOPGEN], 1u);
            else XB_SPIN(xb_ld(&bar[XB_TOPGEN]) == tg, bar);
            __builtin_amdgcn_fence(__ATOMIC_ACQUIRE, "agent");
            xb_add(&bar[XB_XGEN(b.x)], 1u);
            asm volatile("s_waitcnt vmcnt(0)" ::: "memory");
        } else {
            XB_SPIN(xb_ld(&bar[XB_XGEN(b.x)]) == gen, bar);
            __builtin_amdgcn_fence(__ATOMIC_ACQUIRE, "agent");
            asm volatile("s_waitcnt vmcnt(0)" ::: "memory");
        }
    }
    __syncthreads();
}

struct Args { const float* in[N_INPUTS]; float* out; unsigned char* ws; int ph_lo, ph_hi; };
struct Frame {
    LAS unsigned char* lds;
    int tid, lane, wave, G, bid;
};
constexpr int LDS_ARGT = 131072 + 1024;
__device__ __forceinline__ const float* INP(const Frame& F, int k) {
    const LAS unsigned* t = (const LAS unsigned*)(F.lds + LDS_ARGT) + 2 * k;
    const unsigned lo = __builtin_amdgcn_readfirstlane(t[0]), hi = __builtin_amdgcn_readfirstlane(t[1]);
    return (const float*)(((unsigned long long)hi << 32) | lo);
}
__device__ __forceinline__ float* OUTP(const Frame& F) { return (float*)INP(F, 46); }
__device__ __forceinline__ unsigned char* WSP(const Frame& F) { return (unsigned char*)INP(F, 47); }

namespace pg8 {
constexpr int BM = 256, BK = 64, HALF = 128, HTB = HALF * BK * 2, STAGE_BYTES = 8 * HTB, NXCD = 8, WGM = 8;
__host__ __device__ __forceinline__ int lds_byte(int r, int c) { const int st = (r >> 4) * 2 + (c >> 5), rr = r & 15, cc = c & 31, ob = rr * 64 + cc * 2; return st * 1024 + (ob ^ (((ob >> 9) & 1) << 5)); }
__host__ __device__ __forceinline__ void stage_rc(int b, int& R, int& C) { const int st = b / 1024, sb = b % 1024, swz = sb ^ (((sb >> 9) & 1) << 5); R = (st >> 1) * 16 + swz / 64; C = (st & 1) * 32 + (swz % 64) / 2; }
__host__ __device__ __forceinline__ int perm32(int rho) { const int n = rho >> 4, i = rho & 15; return 8 * (i >> 2) + 4 * n + (i & 3); }

struct Unit { int pm, pn, br; };
struct Gemm { const bf16* A; const bf16* Bt; int lda, ldb, K; int a_br_stride  , a_pair_off  , b_br_tiles  ; };

struct Order {
    int nM, nN, nwg, G, c, nbr;
    __device__ void init(int Mrows, int N, int G_, int c_, int nbr_) { nM = Mrows / BM; nN = N / BM; nwg = nM * nN; G = G_; c = c_; nbr = nbr_; }
    __device__ bool next(int i, Unit& u) const {
        const int it = i / nbr; u.br = i - it * nbr;
        const long L = (long)it * G + c; if (L >= nwg) return false;
        int wgid = (int)L; { const int q = nwg / NXCD, r = nwg % NXCD, xcd = wgid % NXCD, off = wgid / NXCD; wgid = (xcd < r ? xcd * (q + 1) : r * (q + 1) + (xcd - r) * q) + off; }
        const int nig = WGM * nN, gid = wgid / nig, fm = gid * WGM, gsz = (nM - fm) < WGM ? (nM - fm) : WGM;
        u.pm = fm + ((wgid % nig) % gsz); u.pn = (wgid % nig) / gsz; return true;
    }
};
struct Order5 {
    Order o;
    __device__ void init(int Mrows, int G_, int c_) { o.init(Mrows, 20 * BM, G_, c_, 1); }
    __device__ bool next(int i, Unit& u) const { if (!o.next(i, u)) return false; u.br = u.pn >> 2; u.pn &= 3; return true; }
};

template <class Epi, class Sched>
__device__ __forceinline__ void gemm_phase(LAS unsigned char* lds, const Gemm g, const Sched& S, const Epi& E, int wave) {
    int tid = wave * 64 + lane_id(); asm volatile("" : "+v"(tid));
    const int wid = __builtin_amdgcn_readfirstlane(tid >> 6), lane = tid & 63, wr = wid >> 2, wc = wid & 3, fr = lane & 15, fq = lane >> 4;
    const int K = g.K; int nt = K / BK; asm volatile("" : "+s"(nt));
    unsigned voffA[2], voffB[2];
#pragma unroll
    for (int i = 0; i < 2; ++i) { int R, C; stage_rc(tid * 16 + i * 8192, R, C); const int Rb = Epi::PERM ? ((R & ~31) + perm32(R & 31)) : R;
        voffA[i] = (unsigned)(R * g.lda + C) * 2u; voffB[i] = (unsigned)(Rb * g.ldb + C) * 2u; }
    const size_t kstep = (size_t)(BK * 2);
    const size_t hstepA = (size_t)HALF * g.lda * 2, hstepB = (size_t)HALF * g.ldb * 2;
    const unsigned ldsw = (unsigned)wid * 1024u;
    const int aoff = lds_byte(wr * 64 + fr, fq * 8), boff = lds_byte(wc * 32 + fr, fq * 8);
#define PG8_APTR(u) ((const char*)g.A + ((size_t)(u).pm * 256 * g.lda + (size_t)(u).br * g.a_br_stride + (size_t)((u).br >> 1) * g.a_pair_off) * 2)
#define PG8_BPTR(u) ((const char*)g.Bt + ((size_t)((u).br * g.b_br_tiles + (u).pn) * 256 * g.ldb) * 2)
#define PG8_SA(b, h) (((b) * 2 + (h)) * HTB)
#define PG8_SB(b, h) ((4 + (b) * 2 + (h)) * HTB)
#define PG8_STAGE(bufoff, gbase, voff) do { _Pragma("unroll") for (int _i = 0; _i < 2; ++_i) \
        __builtin_amdgcn_global_load_lds((const unsigned*)((const char*)(gbase) + (voff)[_i]), (LAS unsigned*)(lds + (bufoff) + ldsw + _i * 8192), 16, 0, 0); } while (0)
#define PG8_LDA(dst, b, h) do { _Pragma("unroll") for (int m = 0; m < 4; ++m) _Pragma("unroll") for (int k = 0; k < 2; ++k) dst[m][k] = *(const LAS bf16x8*)(lds + PG8_SA(b, h) + aoff + m * 2048 + k * 1024); } while (0)
#define PG8_LDB(dst, b, h) do { _Pragma("unroll") for (int n = 0; n < 2; ++n) _Pragma("unroll") for (int k = 0; k < 2; ++k) dst[n][k] = *(const LAS bf16x8*)(lds + PG8_SB(b, h) + boff + n * 2048 + k * 1024); } while (0)
#define PG8_MMA(ai, bj, At, Bt) do { __builtin_amdgcn_s_setprio(1); _Pragma("unroll") for (int m = 0; m < 4; ++m) _Pragma("unroll") for (int n = 0; n < 2; ++n) _Pragma("unroll") for (int k = 0; k < 2; ++k) \
        acc[ai][bj][m][n] = __builtin_amdgcn_mfma_f32_16x16x32_bf16(Bt[n][k], At[m][k], acc[ai][bj][m][n], 0, 0, 0); __builtin_amdgcn_s_setprio(0); } while (0)
#define PG8_WAIT_V(n) asm volatile("s_waitcnt vmcnt(" #n ")" ::: "memory")
#define PG8_WAIT_L(n) asm volatile("s_waitcnt lgkmcnt(" #n ")" ::: "memory")
#define PG8_BAR __builtin_amdgcn_s_barrier()
#define PG8_SCHED __builtin_amdgcn_sched_barrier(0)
    Unit cur, nxt; int ui = 0;
    if (!S.next(0, cur)) return;
    f32x4 acc[2][2][4][2];
#pragma unroll
    for (int a = 0; a < 2; ++a)
#pragma unroll
        for (int b = 0; b < 2; ++b)
#pragma unroll
            for (int m = 0; m < 4; ++m)
#pragma unroll
                for (int n = 0; n < 2; ++n) acc[a][b][m][n] = (f32x4){0.f, 0.f, 0.f, 0.f};
    bf16x8 At[4][2], B0[2][2], B1[2][2];
    const char* cA = PG8_APTR(cur); const char* cB = PG8_BPTR(cur);
    PG8_STAGE(PG8_SB(0, 0), cB, voffB); PG8_STAGE(PG8_SB(0, 1), cB + hstepB, voffB); PG8_STAGE(PG8_SA(0, 0), cA, voffA); PG8_STAGE(PG8_SA(0, 1), cA + hstepA, voffA);
    if (wr == 1) PG8_BAR;
    PG8_WAIT_V(2); PG8_BAR;
    PG8_STAGE(PG8_SB(1, 0), cB + kstep, voffB); PG8_STAGE(PG8_SA(1, 0), cA + kstep, voffA); PG8_STAGE(PG8_SB(1, 1), cB + hstepB + kstep, voffB);
    PG8_WAIT_V(6); PG8_BAR;
    for (;;) {
        const bool has_next = S.next(ui + 1, nxt);
        const char* nA = has_next ? PG8_APTR(nxt) : cA; const char* nB = has_next ? PG8_BPTR(nxt) : cB;
#pragma unroll 1
        for (int t = 0; t < nt; t += 2) {
            const bool last = (t == nt - 2);
            const char* a1 = cA + (size_t)(t + 1) * kstep;
            const char* a2 = last ? nA : cA + (size_t)(t + 2) * kstep; const char* b2 = last ? nB : cB + (size_t)(t + 2) * kstep;
            const char* a3 = a2 + kstep; const char* b3 = b2 + kstep;
            PG8_LDB(B0, 0, 0); PG8_LDB(B1, 0, 1); PG8_SCHED; PG8_LDA(At, 0, 0); PG8_STAGE(PG8_SA(1, 1), a1 + hstepA, voffA);
            PG8_WAIT_V(8); PG8_WAIT_L(0); PG8_BAR; PG8_MMA(0, 0, At, B0); PG8_MMA(0, 1, At, B1); PG8_BAR; PG8_SCHED;
            PG8_LDA(At, 0, 1); PG8_STAGE(PG8_SB(0, 0), b2, voffB); PG8_STAGE(PG8_SB(0, 1), b2 + hstepB, voffB); PG8_STAGE(PG8_SA(0, 0), a2, voffA);
            PG8_WAIT_V(8); PG8_WAIT_L(0); PG8_BAR; PG8_MMA(1, 0, At, B0); PG8_MMA(1, 1, At, B1); PG8_BAR; PG8_SCHED;
            PG8_LDB(B0, 1, 0); PG8_LDB(B1, 1, 1); PG8_SCHED; PG8_LDA(At, 1, 0); PG8_STAGE(PG8_SA(0, 1), a2 + hstepA, voffA);
            PG8_WAIT_V(8); PG8_WAIT_L(0); PG8_BAR; PG8_MMA(0, 0, At, B0); PG8_MMA(0, 1, At, B1); PG8_BAR; PG8_SCHED;
            PG8_LDA(At, 1, 1); PG8_STAGE(PG8_SB(1, 0), b3, voffB); PG8_STAGE(PG8_SB(1, 1), b3 + hstepB, voffB); PG8_STAGE(PG8_SA(1, 0), a3, voffA);
            PG8_WAIT_V(8); PG8_WAIT_L(0); PG8_BAR; PG8_MMA(1, 0, At, B0); PG8_MMA(1, 1, At, B1); PG8_BAR; PG8_SCHED;
        }
        if (wr == 0) PG8_BAR;
        E(acc, cur, wr, wc, fr, fq);
        if (!has_next) break;
#pragma unroll
        for (int a = 0; a < 2; ++a)
#pragma unroll
            for (int b = 0; b < 2; ++b)
#pragma unroll
                for (int m = 0; m < 4; ++m)
#pragma unroll
                    for (int n = 0; n < 2; ++n) acc[a][b][m][n] = (f32x4){0.f, 0.f, 0.f, 0.f};
        cur = nxt; cA = nA; cB = nB; ++ui;
        if (wr == 1) PG8_BAR;
    }
    PG8_WAIT_V(0);
    PG8_BAR;
#undef PG8_APTR
#undef PG8_BPTR
#undef PG8_SA
#undef PG8_SB
#undef PG8_STAGE
#undef PG8_LDA
#undef PG8_LDB
#undef PG8_MMA
#undef PG8_WAIT_V
#undef PG8_WAIT_L
#undef PG8_BAR
#undef PG8_SCHED
}

__device__ __forceinline__ float mrow_sel(int row) { return 0.f; }
__device__ __forceinline__ int modrow(int row) { return row < NPR ? 0 : 1 + ((row - NPR) >> 11); }

struct EpiProj {
    static constexpr bool PERM = true;
    bf16* proj; float* outk; float* outv; int layer;
    __device__ __forceinline__ void operator()(const f32x4 (&acc)[2][2][4][2], const Unit& u, int wr, int wc, int fr, int fq) const {
        { int t_ = lane_id(); asm volatile("" : "+v"(t_)); fr = t_ & 15; fq = (t_ >> 4) & 3; }
        const int row0 = u.pm * BM + wr * 64 + fr, colb = u.pn * BM + wc * 32 + 8 * fq;
        const int mode = (u.pn == 60) ? 1 : (u.pn == 61 ? 2 : ((u.pn >= 36) ? 3 : 0));
        const bool kv = (u.pm < 32) && (u.pn >= 4) && (u.pn < 12);
#pragma unroll
        for (int ai = 0; ai < 2; ++ai)
#pragma unroll
            for (int m = 0; m < 4; ++m) {
                const int row = row0 + ai * HALF + m * 16;
                bf16* rowp = proj + (size_t)row * NPROJ + colb;
#pragma unroll
                for (int bj = 0; bj < 2; ++bj) {
                    f32x4 v0 = acc[ai][bj][m][0], v1 = acc[ai][bj][m][1];
                    if (mode == 1) { if (colb + bj * HALF < COL_G1A) {
#pragma unroll
                        for (int j = 0; j < 4; ++j) { v0[j] = tanhf(v0[j]); v1[j] = tanhf(v1[j]); } } }
                    else if (mode == 3) {
#pragma unroll
                        for (int j = 0; j < 4; ++j) { v0[j] = sigmoidf_(v0[j]); v1[j] = sigmoidf_(v1[j]); } }
                    else if (mode == 2) { const bool act = (colb + bj * HALF) < 15744;
#pragma unroll
                        for (int j = 0; j < 4; ++j) { v0[j] = act ? sigmoidf_(v0[j]) : 0.f; v1[j] = act ? sigmoidf_(v1[j]) : 0.f; } }
                    u32x4 w; w.x = cvtpk(v0[0], v0[1]); w.y = cvtpk(v0[2], v0[3]); w.z = cvtpk(v1[0], v1[1]); w.w = cvtpk(v1[2], v1[3]);
                    *(u32x4*)(rowp + bj * HALF) = w;
                    if (kv) { const int col = colb + bj * HALF; float* ob = (u.pn < 8) ? outk : outv; const int ch = col - ((u.pn < 8) ? COL_K : COL_V);
                        float* dst = ob + ((size_t)(((row >> 8) * 4 + layer) * 256 + (row & 255))) * 1024 + ch;
                        *(f32x4*)dst = v0; *(f32x4*)(dst + 4) = v1; }
                }
            }
    }
};
struct EpiLora2 {
    static constexpr bool PERM = true;
    bf16* dec; bf16* abuf; bf16* gbuf; const float* w0; const float* a0;
    __device__ __forceinline__ void operator()(const f32x4 (&acc)[2][2][4][2], const Unit& u, int wr, int wc, int fr, int fq) const {
        { int t_ = lane_id(); asm volatile("" : "+v"(t_)); fr = t_ & 15; fq = (t_ >> 4) & 3; }
        const int row0 = u.pm * BM + wr * 64 + fr, colb = u.pn * BM + wc * 32 + 8 * fq;
        const int br = u.br, e = br & 1;
        const float* bsrc = (br < 2) ? w0 + e * 1024 : a0 + e * 1024;
#pragma unroll
        for (int bj = 0; bj < 2; ++bj)
#pragma unroll
            for (int n = 0; n < 2; ++n) {
                const int ch = colb + bj * HALF + 4 * n;
                f32x4 b0 = (f32x4){0.f, 0.f, 0.f, 0.f};
                if (br < 4) b0 = *(const f32x4*)(bsrc + ch);
#pragma unroll
                for (int ai = 0; ai < 2; ++ai)
#pragma unroll
                    for (int m = 0; m < 4; ++m) {
                        const int row = row0 + ai * HALF + m * 16;
                        f32x4 v0 = acc[ai][bj][m][n] + b0;
                        if (br < 2) {
#pragma unroll
                            for (int j = 0; j < 4; ++j) v0[j] = -0.6065306597126334f * sigmoidf_(v0[j]);
                            *(u32x2*)(dec + ((size_t)row * 2 + e) * 1024 + ch) = (u32x2){cvtpk(v0[0], v0[1]), cvtpk(v0[2], v0[3])};
                        } else {
                            if (br < 4) {
#pragma unroll
                                for (int j = 0; j < 4; ++j) v0[j] = sigmoidf_(v0[j]); }
                            bf16* dst = (br < 4) ? abuf + ((size_t)row * 2 + e) * 1024 + ch : gbuf + (size_t)row * 1024 + ch;
                            *(u32x2*)dst = (u32x2){cvtpk(v0[0], v0[1]), cvtpk(v0[2], v0[3])};
                        }
                        __builtin_amdgcn_sched_barrier(0);
                    }
            }
    }
};
struct EpiMerge {
    static constexpr bool PERM = true;
    const bf16* proj; bf16* merged;
    __device__ __forceinline__ void operator()(const f32x4 (&acc)[2][2][4][2], const Unit& u, int wr, int wc, int fr, int fq) const {
        { int t_ = lane_id(); asm volatile("" : "+v"(t_)); fr = t_ & 15; fq = (t_ >> 4) & 3; }
        const int row0 = u.pm * BM + wr * 64 + fr, colb = u.pn * BM + wc * 32 + 8 * fq;
        const int br = u.br;
#pragma unroll
        for (int ai = 0; ai < 2; ++ai)
#pragma unroll
            for (int m = 0; m < 4; ++m) {
                const int row = row0 + ai * HALF + m * 16;
#pragma unroll
                for (int bj = 0; bj < 2; ++bj) {
                    const int col = colb + bj * HALF;
                    const u32x4 gw = *(const u32x4*)(proj + (size_t)row * NPROJ + COL_GL + br * 2048 + col);
                    bf16* dst = merged + (size_t)row * D + col;
                    f32x4 v0 = acc[ai][bj][m][0], v1 = acc[ai][bj][m][1];
                    v0[0] *= bflo(gw.x); v0[1] *= bfhi(gw.x); v0[2] *= bflo(gw.y); v0[3] *= bfhi(gw.y);
                    v1[0] *= bflo(gw.z); v1[1] *= bfhi(gw.z); v1[2] *= bflo(gw.w); v1[3] *= bfhi(gw.w);
                    if (br > 0) { const u32x4 pw = *(const u32x4*)dst;
                        v0[0] += bflo(pw.x); v0[1] += bfhi(pw.x); v0[2] += bflo(pw.y); v0[3] += bfhi(pw.y);
                        v1[0] += bflo(pw.z); v1[1] += bfhi(pw.z); v1[2] += bflo(pw.w); v1[3] += bfhi(pw.w); }
                    u32x4 w; w.x = cvtpk(v0[0], v0[1]); w.y = cvtpk(v0[2], v0[3]); w.z = cvtpk(v1[0], v1[1]); w.w = cvtpk(v1[2], v1[3]);
                    *(u32x4*)dst = w;
                }
            }
    }
};
struct EpiResid {
    static constexpr bool PERM = false;
    float* x; const float* gate;   const float* bias; float gscale;
    __device__ __forceinline__ void operator()(const f32x4 (&acc)[2][2][4][2], const Unit& u, int wr, int wc, int fr, int fq) const {
        { int t_ = lane_id(); asm volatile("" : "+v"(t_)); fr = t_ & 15; fq = (t_ >> 4) & 3; }
        const int row0 = u.pm * BM + wr * 64 + fr, col0 = u.pn * BM + wc * 32 + 4 * fq;
        const int mr = modrow(u.pm * BM);
        const float* gp = gate + (size_t)mr * 12288;
        f32x4 gv[2][2], bv[2][2];
#pragma unroll
        for (int bj = 0; bj < 2; ++bj)
#pragma unroll
            for (int n = 0; n < 2; ++n) { gv[bj][n] = *(const f32x4*)(gp + col0 + bj * HALF + n * 16) * gscale;
                bv[bj][n] = bias ? *(const f32x4*)(bias + col0 + bj * HALF + n * 16) : (f32x4){0.f, 0.f, 0.f, 0.f}; }
#pragma unroll
        for (int ai = 0; ai < 2; ++ai)
#pragma unroll
            for (int m = 0; m < 4; ++m) { float* rowp = x + (size_t)(row0 + ai * HALF + m * 16) * D + col0;
#pragma unroll
                for (int bj = 0; bj < 2; ++bj)
#pragma unroll
                    for (int n = 0; n < 2; ++n) { f32x4* p = (f32x4*)(rowp + bj * HALF + n * 16); const f32x4 xo = *p; *p = xo + gv[bj][n] * (acc[ai][bj][m][n] + bv[bj][n]); }
                asm volatile("" ::: "memory"); }
    }
};
struct EpiFF1 {
    static constexpr bool PERM = true;
    bf16* U; const float* bias;
    __device__ __forceinline__ void operator()(const f32x4 (&acc)[2][2][4][2], const Unit& u, int wr, int wc, int fr, int fq) const {
        { int t_ = lane_id(); asm volatile("" : "+v"(t_)); fr = t_ & 15; fq = (t_ >> 4) & 3; }
        const int row0 = u.pm * BM + wr * 64 + fr, colb = u.pn * BM + wc * 32 + 8 * fq;
        f32x4 bv[2][2];
#pragma unroll
        for (int bj = 0; bj < 2; ++bj)
#pragma unroll
            for (int n = 0; n < 2; ++n) bv[bj][n] = *(const f32x4*)(bias + colb + bj * HALF + 4 * n);
#pragma unroll
        for (int ai = 0; ai < 2; ++ai)
#pragma unroll
            for (int m = 0; m < 4; ++m) { bf16* rowp = U + (size_t)(row0 + ai * HALF + m * 16) * DFF + colb;
#pragma unroll
                for (int bj = 0; bj < 2; ++bj) { f32x4 v0 = acc[ai][bj][m][0] + bv[bj][0], v1 = acc[ai][bj][m][1] + bv[bj][1];
#pragma unroll
                    for (int j = 0; j < 4; ++j) { const float a = fmaxf(v0[j], 0.f), b = fmaxf(v1[j], 0.f); v0[j] = a * a; v1[j] = b * b; }
                    u32x4 w; w.x = cvtpk(v0[0], v0[1]); w.y = cvtpk(v0[2], v0[3]); w.z = cvtpk(v1[0], v1[1]); w.w = cvtpk(v1[2], v1[3]);
                    *(u32x4*)(rowp + bj * HALF) = w; } }
    }
};
}

__device__ __forceinline__ void transpose_item(const float* W, int K, int N, bf16* WT, int ldk, int row_off, LAS bf16* scr, int item, int lane) {
    const int nblk = N / 64, kb = item / nblk, nb = item % nblk, k0 = 32 * kb, n = 64 * nb + lane;
    const float* src = W + (size_t)k0 * N + n;
    float v[32];
#pragma unroll
    for (int i = 0; i < 32; ++i) v[i] = src[(size_t)i * N];
    bf16* dst = WT + (size_t)(row_off + n) * ldk + k0;
#pragma unroll
    for (int q = 0; q < 4; ++q) *(u32x4*)(dst + 8 * q) = (u32x4){cvtpk(v[8 * q], v[8 * q + 1]), cvtpk(v[8 * q + 2], v[8 * q + 3]), cvtpk(v[8 * q + 4], v[8 * q + 5]), cvtpk(v[8 * q + 6], v[8 * q + 7])};
    (void)scr; (void)K;
}

__device__ __forceinline__ void convert_layer(const Frame& F, int l, LAS bf16* scr, int gw, int NGW) {
    unsigned char* ws = WSP(F);
        bf16* WinT = (bf16*)(ws + WS_WIN) + (size_t)l * NPROJ * D;
        {   const int n_items = (D / 32) * (15360 / 64); const float* W = INP(F, I_WIN) + (size_t)l * D * 15360;
            for (int it = gw; it < n_items; it += NGW) transpose_item(W, D, 15360, WinT, D, 0, scr, it, F.lane); }
        for (int e = 0; e < 2; ++e) {
            const int n_items = (D / 32);
            const float* W1 = INP(F, I_W1) + ((size_t)l * 2 + e) * D * 64; const float* A1 = INP(F, I_A1) + ((size_t)l * 2 + e) * D * 64;
            for (int it = gw; it < n_items; it += NGW) { transpose_item(W1, D, 64, WinT, D, COL_LW + e * 64, scr, it, F.lane); transpose_item(A1, D, 64, WinT, D, COL_LW + 128 + e * 64, scr, it, F.lane); }
        }
        {   const int n_items = (D / 32) * 2; const float* W = INP(F, I_G1) + (size_t)l * D * 128;
            for (int it = gw; it < n_items; it += NGW) transpose_item(W, D, 128, WinT, D, COL_LW + 256, scr, it, F.lane); }
        for (int i = gw * 64 + F.lane; i < 128 * D / 8; i += NGW * 64) ((u32x4*)(WinT + (size_t)15744 * D))[i] = (u32x4){0u, 0u, 0u, 0u};
        for (int br = 0; br < 3; ++br) { const float* W = INP(F, I_WPA + br) + (size_t)l * 1024 * D; bf16* WT = (bf16*)(ws + WS_WP) + ((size_t)l * 3 + br) * D * 1024;
            const int n_items = (1024 / 32) * (D / 64);
            for (int it = gw; it < n_items; it += NGW) transpose_item(W, 1024, D, WT, 1024, 0, scr, it, F.lane); }
        {   const float* W = INP(F, I_WOUT) + (size_t)l * D * D; bf16* WT = (bf16*)(ws + WS_WOUT) + (size_t)l * D * D; const int n_items = (D / 32) * (D / 64);
            for (int it = gw; it < n_items; it += NGW) transpose_item(W, D, D, WT, D, 0, scr, it, F.lane); }
        {   const float* W = INP(F, I_FF1) + (size_t)l * D * DFF; bf16* WT = (bf16*)(ws + WS_WFF1) + (size_t)l * D * DFF; const int n_items = (D / 32) * (DFF / 64);
            for (int it = gw; it < n_items; it += NGW) transpose_item(W, D, DFF, WT, D, 0, scr, it, F.lane); }
        {   const float* W = INP(F, I_FF2) + (size_t)l * D * DFF; bf16* WT = (bf16*)(ws + WS_WFF2) + (size_t)l * D * DFF; const int n_items = (DFF / 32) * (D / 64);
            for (int it = gw; it < n_items; it += NGW) transpose_item(W, DFF, D, WT, DFF, 0, scr, it, F.lane); }
        {   bf16* W2T = (bf16*)(ws + WS_W2T) + (size_t)l * 5120 * 128;
            const float* w2 = INP(F, I_W2) + (size_t)l * 2 * 64 * 1024; const float* a2 = INP(F, I_A2) + (size_t)l * 2 * 64 * 1024; const float* g2 = INP(F, I_G2) + (size_t)l * 128 * 1024;
            for (int it = gw; it < 32 * 6; it += NGW) { const int m = it / 32, sub = it % 32;
                const float* W = m == 0 ? w2 : (m == 1 ? w2 + 65536 : (m == 2 ? a2 : (m == 3 ? a2 + 65536 : (m == 4 ? g2 : g2 + 65536))));
                const int br = m < 4 ? m : 4, koff = m < 4 ? 64 * (m & 1) : (m == 4 ? 0 : 64);
                transpose_item(W, 64, 1024, W2T + (size_t)br * 1024 * 128 + koff, 128, 0, scr, sub, F.lane); }
            for (int i = gw * 64 + F.lane; i < 4096 * 8; i += NGW * 64) { const int n = i >> 3, k8 = (i & 7) * 8, br = n >> 10;
                *(u32x4*)(W2T + (size_t)n * 128 + ((br & 1) ? 0 : 64) + k8) = (u32x4){0u, 0u, 0u, 0u}; }
        }
    }

__device__ __forceinline__ void prologue0(const Frame& F, const Args& a) {
    unsigned char* ws = WSP(F);
    LAS bf16* scr = (LAS bf16*)(F.lds + F.wave * 16384);
    const int gw = F.bid * 8 + F.wave, NGW = F.G * 8;
    convert_layer(F, 0, scr, gw, NGW);
    {   const float* ck = INP(F, I_CK); const float* cv = INP(F, I_CV); bf16* ok = (bf16*)(ws + WS_CK); bf16* ov = (bf16*)(ws + WS_CV);
        const int n4 = 4 * 4 * 256 * 1024 / 4;
        for (int i = gw * 64 + F.lane; i < n4; i += NGW * 64) { const f32x4 x = ((const f32x4*)ck)[i], y = ((const f32x4*)cv)[i];
            ((u32x2*)ok)[i] = (u32x2){cvtpk(x[0], x[1]), cvtpk(x[2], x[3])}; ((u32x2*)ov)[i] = (u32x2){cvtpk(y[0], y[1]), cvtpk(y[2], y[3])}; }
    }
    {   LAS float* sv = (LAS float*)(F.lds + 65536);
        __syncthreads();
        for (int i = F.tid; i < 5 * D; i += 512) { const int r = i / D, d = i - r * D; const float x = (r == 0) ? INP(F, I_CCTX)[d] : INP(F, I_C)[(r - 1) * D + d]; sv[i] = x / (1.0f + __expf(-x)); }
        __syncthreads();
        float* PART = (float*)(ws + WS_Q);
        const int n_items = DEPTH * 48 * 8;
        for (int it = gw; it < n_items; it += NGW) {
            const int l = it / 384, rem = it % 384, jc = rem >> 3, ds = rem & 7, j4 = jc * 256 + 4 * F.lane;
            const float* W = INP(F, I_WMOD) + (size_t)l * D * 12288 + (size_t)(ds * 256) * 12288 + j4;
            f32x4 acc[5];
#pragma unroll
            for (int r = 0; r < 5; ++r) acc[r] = (f32x4){0.f, 0.f, 0.f, 0.f};
#pragma unroll 4
            for (int d = 0; d < 256; d += 4) {
                f32x4 w[4];
#pragma unroll
                for (int q = 0; q < 4; ++q) w[q] = *(const f32x4*)(W + (size_t)(d + q) * 12288);
#pragma unroll
                for (int r = 0; r < 5; ++r) { const f32x4 s = *(const LAS f32x4*)(sv + r * D + ds * 256 + d);
#pragma unroll
                    for (int q = 0; q < 4; ++q) acc[r] += w[q] * s[q]; }
            }
#pragma unroll
            for (int r = 0; r < 5; ++r) *(f32x4*)(PART + (((size_t)ds * 4 + l) * 5 + r) * 12288 + j4) = acc[r];
        }
        __syncthreads();
    }
    {   float* T2 = (float*)(ws + WS_T2);
        const int n_items = DEPTH * (L_S + L_P);
        for (int it = gw; it < n_items; it += NGW) {
            const int l = it / (L_S + L_P), rr = it % (L_S + L_P), sel = rr < L_S ? 0 : 1, t = sel ? rr - L_S : rr, L = sel ? L_P : L_S;
            float zf = 0.f;
            {   const float tt = (float)t / (float)(L - 1);
                const float w = (6.283185307179586f * (float)t) / (float)L;
                const int band = (F.lane - 1) & 15;
                const float f = 1e-4f + (float)band * ((15.0f - 1e-4f) / 15.0f);
                const float fw = f * w;
                const double rd = (double)fw - 6.283185307179586 * rint((double)fw * 0.15915494309189535);
                const float rf = (float)rd;
                zf = (F.lane == 0) ? tt : (F.lane <= 16 ? __cosf(rf) : -__sinf(rf));
            }
            const float* f1 = INP(F, I_F1) + (size_t)l * 33 * 64; const float* f2 = INP(F, I_F2) + (size_t)l * 64 * 64;
            const float fq = INP(F, I_FREQ)[l * 64 + F.lane];
            float s = INP(F, I_FB1)[l * 64 + F.lane];
            for (int i = 0; i < 33; ++i) s += __int_as_float(__builtin_amdgcn_readlane(__float_as_int(zf), i)) * f1[i * 64 + F.lane];
            float x = fq * s; { const double rd = (double)x - 6.283185307179586 * rint((double)x * 0.15915494309189535); x = (float)rd; }
            const float t1 = __sinf(x);
            float s2 = INP(F, I_FB2)[l * 64 + F.lane];
            for (int i = 0; i < 64; ++i) s2 += __int_as_float(__builtin_amdgcn_readlane(__float_as_int(t1), i)) * f2[i * 64 + F.lane];
            float y = fq * s2; { const double rd = (double)y - 6.283185307179586 * rint((double)y * 0.15915494309189535); y = (float)rd; }
            T2[(((size_t)l * 2 + sel) * L_S + t) * 64 + F.lane] = __sinf(y);
        }
    }
    {   bf16* FS = (bf16*)(ws + WS_FS); bf16* FP = (bf16*)(ws + WS_FP);
        for (int i = gw * 64 + F.lane; i < DEPTH * 1024 * 72; i += NGW * 64) { const int row = i / 72, p = i % 72; const int m = p < 32 ? p : p - 32 + 32;
            FS[(size_t)row * LPS + (p < 32 ? p : L_S + p)] = 0; FP[(size_t)row * LPP + (p < 32 ? p : L_P + p)] = 0; (void)m; }
    }
}

__device__ __forceinline__ void prologue1(const Frame& F, const Args& a) {
    unsigned char* ws = WSP(F);
    const int gw = F.bid * 8 + F.wave, NGW = F.G * 8;
    {   const float* PART = (const float*)(ws + WS_Q); float* MOD = (float*)(ws + WS_MOD);
        for (int i = (F.bid * 8 + F.wave) * 64 + F.lane; i < DEPTH * 5 * 12288 / 4; i += F.G * 8 * 64) {
            const int l = i / (5 * 3072), j4 = (i % 3072) * 4;
            f32x4 s = *(const f32x4*)(INP(F, I_BMOD) + l * 12288 + j4);
#pragma unroll
            for (int ds = 0; ds < 8; ++ds) s += ((const f32x4*)PART)[(size_t)ds * (DEPTH * 5 * 3072) + i];
            ((f32x4*)MOD)[i] = s; }
    }
    const float* T2 = (const float*)(ws + WS_T2);
    float* FNORM = (float*)(ws + WS_CTL) + CW_FNORM;
    const int items_s = DEPTH * 16 * (L_S / 64), items_p = DEPTH * 16 * (L_P / 64);
    for (int it = gw; it < items_s + items_p; it += NGW) {
        int sel, l, cg, tc;
        if (it < items_s) { sel = 0; l = it / (16 * 32); cg = (it / 32) % 16; tc = it % 32; } else { const int r = it - items_s; sel = 1; l = r / (16 * 4); cg = (r / 4) % 16; tc = r % 4; }
        const int L = sel ? L_P : L_S, c = cg * 64 + F.lane;
        const float* f3 = INP(F, I_F3) + (size_t)l * 64 * 1024 + c;
        float w3[64];
#pragma unroll
        for (int j = 0; j < 64; ++j) w3[j] = f3[(size_t)j * 1024];
        const float delta = fabsf(-3.0701134573253946f + (float)c * ((-15.350567286626973f + 3.0701134573253946f) / 1023.0f));
        bf16* dst = sel ? (bf16*)(ws + WS_FP) + ((size_t)l * 1024 + c) * LPP : (bf16*)(ws + WS_FS) + ((size_t)l * 1024 + c) * LPS;
        float asum = 0.f;
        for (int tt = 0; tt < 64; ++tt) {
            const int t = tc * 64 + tt;
            const float tv = T2[(((size_t)l * 2 + sel) * L_S + t) * 64 + F.lane];
            float s = 0.f;
#pragma unroll
            for (int j = 0; j < 64; ++j) s += __int_as_float(__builtin_amdgcn_readlane(__float_as_int(tv), j)) * w3[j];
            const float dist = fabsf((float)(t - L / 2)) / (float)L;
            const float fv = s * __expf(-dist * delta);
            asum += fabsf(fv);
            dst[32 + (L - 1 - t)] = f2bf(fv);
        }
        atomicAdd(FNORM + ((size_t)l * 2 + sel) * 1024 + c, asum);
    }
}

__device__ __forceinline__ void norm_phase(const Frame& F, const float* xp, const float* xs, float* xcopy, const float* g, const float* mod, int i_sh, int i_sc, bf16* hout) {
    const int gw = F.bid * 8 + F.wave, NGW = F.G * 8;
    for (int row = gw; row < M; row += NGW) {
        const float* xr = row < NPR ? xp + (size_t)row * D : xs + (size_t)(row - NPR) * D;
        const float* mr = mod + (size_t)pg8::modrow(row) * 12288;
        f32x4 v[8]; float ss = 0.f;
#pragma unroll
        for (int j = 0; j < 8; ++j) { v[j] = ((const f32x4*)xr)[F.lane + 64 * j]; ss += (v[j][0] * v[j][0] + v[j][1] * v[j][1]) + (v[j][2] * v[j][2] + v[j][3] * v[j][3]); }
        const float rstd = 1.0f / sqrtf(wave_sum(ss) * (1.0f / D) + 1e-6f);
        if (xcopy) {
#pragma unroll
            for (int j = 0; j < 8; ++j) ((f32x4*)(xcopy + (size_t)row * D))[F.lane + 64 * j] = v[j]; }
#pragma unroll
        for (int j = 0; j < 8; ++j) {
            const f32x4 gg = ((const f32x4*)g)[F.lane + 64 * j], sc = ((const f32x4*)(mr + i_sc * D))[F.lane + 64 * j], sh = ((const f32x4*)(mr + i_sh * D))[F.lane + 64 * j];
            const f32x4 o = v[j] * rstd * gg * (1.0f + sc) + sh;
            ((u32x2*)(hout + (size_t)row * D))[F.lane + 64 * j] = (u32x2){cvtpk(o[0], o[1]), cvtpk(o[2], o[3])};
        }
    }
}
__device__ __forceinline__ void final_norm_phase(const Frame& F, float* x, const float* g) {
    const int gw = F.bid * 8 + F.wave, NGW = F.G * 8;
    for (int row = gw; row < M; row += NGW) {
        float* xr = x + (size_t)row * D;
        f32x4 v[8]; float ss = 0.f;
#pragma unroll
        for (int j = 0; j < 8; ++j) { v[j] = ((const f32x4*)xr)[F.lane + 64 * j]; ss += (v[j][0] * v[j][0] + v[j][1] * v[j][1]) + (v[j][2] * v[j][2] + v[j][3] * v[j][3]); }
        const float rstd = 1.0f / sqrtf(wave_sum(ss) * (1.0f / D) + 1e-6f);
#pragma unroll
        for (int j = 0; j < 8; ++j) { const f32x4 gg = ((const f32x4*)g)[F.lane + 64 * j]; ((f32x4*)xr)[F.lane + 64 * j] = v[j] * rstd * gg; }
    }
}

__device__ __forceinline__ s16x4 vtr(const LAS unsigned char* p) { return __builtin_bit_cast(s16x4, __builtin_amdgcn_ds_read_tr16_b64_v4i16((LAS s16x4*)p)); }

struct AttnState { float m, l; f32x16 o[2]; };

template <int NT, bool HASB, class KT, class VL, class BIAS>
__device__ __forceinline__ void attendN(AttnState& st, const bf16x8 (&qf)[4], const KT& ktp, size_t kstride, const LAS unsigned char* lds, const VL& vlo, const BIAS& bias, int lane) {
    const int r = lane & 31, h = lane >> 5;
    f32x16 s[NT];
#pragma unroll
    for (int kt = 0; kt < NT; ++kt) {
        const bf16* kp = ktp(kt) + (size_t)r * kstride + 8 * h;
        bf16x8 kf[4];
#pragma unroll
        for (int ks = 0; ks < 4; ++ks) kf[ks] = *(const bf16x8*)(kp + 16 * ks);
        f32x16 acc;
#pragma unroll
        for (int i = 0; i < 16; ++i) acc[i] = 0.f;
#pragma unroll
        for (int ks = 0; ks < 4; ++ks) acc = __builtin_amdgcn_mfma_f32_32x32x16_bf16(kf[ks], qf[ks], acc, 0, 0, 0);
        s[kt] = acc;
    }
    float gm = -3.0e38f;
#pragma unroll
    for (int kt = 0; kt < NT; ++kt)
#pragma unroll
        for (int i = 0; i < 16; ++i) {
            float v = s[kt][i] * 0.125f;
            if (HASB) v = bias(kt, (i & 3) + 8 * (i >> 2) + 4 * h, v);
            s[kt][i] = v; gm = fmaxf(gm, v);
        }
    gm = fmaxf(gm, xor32(gm, lane));
    const float mnew = fmaxf(st.m, gm);
    const float alpha = __expf(st.m - mnew);
    float ps = 0.f;
#pragma unroll
    for (int kt = 0; kt < NT; ++kt)
#pragma unroll
        for (int i = 0; i < 16; ++i) { const float p = __expf(s[kt][i] - mnew); s[kt][i] = p; ps += p; }
    st.l = st.l * alpha + ps; st.m = mnew;
#pragma unroll
    for (int i = 0; i < 16; ++i) { st.o[0][i] *= alpha; st.o[1][i] *= alpha; }
    const int i16 = lane & 15, tq = i16 >> 2, tp = i16 & 3, blk = (lane >> 4) & 1;
#pragma unroll
    for (int kt = 0; kt < NT; ++kt) {
        const LAS unsigned char* vb = lds + vlo(kt);
#pragma unroll
        for (int ss = 0; ss < 2; ++ss) {
            u32x4 pw; pw.x = cvtpk(s[kt][8 * ss + 0], s[kt][8 * ss + 1]); pw.y = cvtpk(s[kt][8 * ss + 2], s[kt][8 * ss + 3]); pw.z = cvtpk(s[kt][8 * ss + 4], s[kt][8 * ss + 5]); pw.w = cvtpk(s[kt][8 * ss + 6], s[kt][8 * ss + 7]);
            const bf16x8 pf = __builtin_bit_cast(bf16x8, pw);
#pragma unroll
            for (int dt = 0; dt < 2; ++dt) {
                const LAS unsigned char* p0 = vb + (16 * ss + 4 * h + tq) * 128 + (dt * 32 + 16 * blk + 4 * tp) * 2;
                const s16x4 lo = vtr(p0), hi = vtr(p0 + 8 * 128);
                const bf16x8 vf = __builtin_shufflevector(lo, hi, 0, 1, 2, 3, 4, 5, 6, 7);
                st.o[dt] = __builtin_amdgcn_mfma_f32_32x32x16_bf16(vf, pf, st.o[dt], 0, 0, 0);
            }
        }
    }
}

__device__ __forceinline__ void attn_store(const AttnState& st, bf16* orow  , int lane) {
    const int h = lane >> 5;
    const float lt = st.l + xor32(st.l, lane);
    const float inv = 1.0f / lt;
#pragma unroll
    for (int dt = 0; dt < 2; ++dt)
#pragma unroll
        for (int g = 0; g < 4; ++g) {
            const u32x2 w = (u32x2){cvtpk(st.o[dt][4 * g] * inv, st.o[dt][4 * g + 1] * inv), cvtpk(st.o[dt][4 * g + 2] * inv, st.o[dt][4 * g + 3] * inv)};
            *(u32x2*)(orow + dt * 32 + 8 * g + 4 * h) = w;
        }
}

__device__ __forceinline__ void attention_phase(const Frame& F, const Args& a, int layer) {
    unsigned char* ws = WSP(F);
    const bf16* proj = (const bf16*)(ws + WS_PROJ);
    bf16* oall = (bf16*)(ws + WS_OALL);
    const int lane = F.lane, w = F.wave, r = lane & 31, h = lane >> 5;
    LAS unsigned char* lds = F.lds;
    LAS float* rpbl = (LAS float*)(lds + 122880);
    for (int u = F.bid; u < 1024; u += F.G) {
        __syncthreads();
        if (u < 512) {
            const int b = u >> 4, hd = u & 15;
            const int tok0 = b * 256;
            for (int i = F.tid; i < 256 * 8; i += 512) { const int key = i >> 3, pc = i & 7;
                *(LAS u32x4*)(lds + key * 128 + pc * 16) = *(const u32x4*)(proj + (size_t)(tok0 + key) * NPROJ + COL_V + hd * 64 + pc * 8); }
            __syncthreads();
            bf16x8 qf[4];
            { const bf16* qp = proj + (size_t)(tok0 + 32 * w + r) * NPROJ + hd * 64 + 8 * h;
#pragma unroll
              for (int ks = 0; ks < 4; ++ks) qf[ks] = *(const bf16x8*)(qp + 16 * ks); }
            AttnState st; st.m = -3.0e38f; st.l = 0.f;
#pragma unroll
            for (int i = 0; i < 16; ++i) { st.o[0][i] = 0.f; st.o[1][i] = 0.f; }
            const bf16* kbase = proj + (size_t)tok0 * NPROJ + COL_K + hd * 64;
#pragma unroll 1
            for (int kg = 0; kg < 2; ++kg)
                attendN<4, false>(st, qf, [&](int kt) { return kbase + (size_t)((kg * 4 + kt) * 32) * NPROJ; }, (size_t)NPROJ, lds, [&](int kt) { return (kg * 4 + kt) * 4096; }, [&](int, int, float v) { return v; }, lane);
            attn_store(st, oall + (size_t)(tok0 + 32 * w + r) * 3072 + hd * 64, lane);
        } else {
            const int uu = u - 512, b = uu >> 7, hd = (uu >> 3) & 15, rg = uu & 7;
            const int tokb = NPR + b * 2048;
            int rlo = 4 * rg - 4; rlo = rlo < 0 ? 0 : (rlo > 24 ? 24 : rlo);
            int rhi0 = 4 * rg + 3 - 4; rhi0 = rhi0 < 0 ? 0 : (rhi0 > 24 ? 24 : rhi0); const int nr = rhi0 + 8 - rlo;
            for (int i = F.tid; i < nr * 64 * 8; i += 512) { const int key = i >> 3, pc = i & 7;
                *(LAS u32x4*)(lds + key * 128 + pc * 16) = *(const u32x4*)(proj + (size_t)(tokb + rlo * 64 + key) * NPROJ + COL_V + hd * 64 + pc * 8); }
            const bf16* cv = (const bf16*)(ws + WS_CV) + ((size_t)(b * 4 + layer) * 256) * 1024 + hd * 64;
            const bf16* ck = (const bf16*)(ws + WS_CK) + ((size_t)(b * 4 + layer) * 256) * 1024 + hd * 64;
            for (int i = F.tid; i < 256 * 8; i += 512) { const int key = i >> 3, pc = i & 7;
                *(LAS u32x4*)(lds + 90112 + key * 128 + pc * 16) = *(const u32x4*)(cv + (size_t)key * 1024 + pc * 8); }
            for (int i = F.tid; i < 465; i += 512) rpbl[i] = INP(F, I_RPB)[((size_t)layer * 16 + hd) * 465 + i];
            __syncthreads();
            const int qrow = 4 * rg + (w >> 1), qc = (w & 1) * 32 + r;
            int r0 = qrow - 4; r0 = r0 < 0 ? 0 : (r0 > 24 ? 24 : r0);
            int c0 = qc - 8; c0 = c0 < 0 ? 0 : (c0 > 48 ? 48 : c0);
            const int qtok = tokb + qrow * 64 + (w & 1) * 32 + r;
            bf16x8 qf[4];
            { const bf16* qp = proj + (size_t)qtok * NPROJ + hd * 64 + 8 * h;
#pragma unroll
              for (int ks = 0; ks < 4; ++ks) qf[ks] = *(const bf16x8*)(qp + 16 * ks); }
            AttnState st; st.m = -3.0e38f; st.l = 0.f;
#pragma unroll
            for (int i = 0; i < 16; ++i) { st.o[0][i] = 0.f; st.o[1][i] = 0.f; }
            const bf16* kloc = proj + (size_t)tokb * NPROJ + COL_K + hd * 64;
#pragma unroll 1
            for (int grp = 0; grp < 4; ++grp) {
                const int krb = r0 + 2 * grp;
                attendN<4, true>(st, qf, [&](int kt) { return kloc + (size_t)((krb + (kt >> 1)) * 64 + (kt & 1) * 32) * NPROJ; }, (size_t)NPROJ, lds,
                    [&](int kt) { return ((krb + (kt >> 1) - rlo) * 64 + (kt & 1) * 32) * 128; },
                    [&](int kt, int kin, float v) { const int kr = krb + (kt >> 1), kc = (kt & 1) * 32 + kin; const bool ok = (kc >= c0) && (kc < c0 + 16);
                        const int dr = kr - qrow + 7, dc = kc - qc + 15; const int idx = ok ? dr * 31 + dc : 0; return ok ? v + rpbl[idx] : -1.0e30f; }, lane);
            }
#pragma unroll 1
            for (int kg = 0; kg < 2; ++kg)
                attendN<4, false>(st, qf, [&](int kt) { return ck + (size_t)((kg * 4 + kt) * 32) * 1024; }, (size_t)1024, lds, [&](int kt) { return 90112 + (kg * 4 + kt) * 4096; }, [&](int, int, float v) { return v; }, lane);
            attn_store(st, oall + (size_t)qtok * 3072 + hd * 64, lane);
        }
    }
    __syncthreads();
}

__device__ __forceinline__ float row_sum16(float v) { v += DPPF(v, 0xB1); v += DPPF(v, 0x4E); v += DPPF(v, 0x141); v += DPPF(v, 0x140); return v; }
__device__ __forceinline__ f32x4 unpack4(u32x2 w) { return (f32x4){bflo(w.x), bfhi(w.x), bflo(w.y), bfhi(w.y)}; }
__device__ __forceinline__ u32x2 pack4(f32x4 v) { return (u32x2){cvtpk(v[0], v[1]), cvtpk(v[2], v[3])}; }
__device__ __forceinline__ void rwkv_tinv_unit(const Frame& F, int unit) {
    unsigned char* ws = WSP(F);
    const bf16* til = (const bf16*)(ws + WS_TIL);
    bf16* tinv = (bf16*)(ws + WS_TINV);
    int lane = lane_id(); asm volatile("" : "+v"(lane));
    const int r = lane & 31, h = lane >> 5;
    LAS float* Lw = (LAS float*)(F.lds + F.wave * 16384);
    {
        const int run = unit >> 5, e = (unit >> 4) & 1, hd = unit & 15;
        const size_t tok = (size_t)(run * 32 + (e ? 31 - r : r));
        const bf16* rowp = til + (tok * 16 + hd) * TILP + e * 256 + 8 * h;
        f32x16 acc;
#pragma unroll
        for (int i = 0; i < 16; ++i) acc[i] = 0.f;
        bf16x8 bfr[4], afr[4];
#pragma unroll
        for (int ks = 0; ks < 4; ++ks) { afr[ks] = *(const bf16x8*)(rowp + 16 * ks); bfr[ks] = *(const bf16x8*)(rowp + 64 + 16 * ks); }
#pragma unroll
        for (int ks = 0; ks < 4; ++ks) acc = __builtin_amdgcn_mfma_f32_32x32x16_bf16(bfr[ks], afr[ks], acc, 0, 0, 0);
#pragma unroll
        for (int g = 0; g < 4; ++g) { const int j0 = 8 * g + 4 * h; f32x4 v;
#pragma unroll
            for (int q = 0; q < 4; ++q) v[q] = (j0 + q < r) ? acc[4 * g + q] : 0.f;
            *(LAS f32x4*)(Lw + r * 36 + j0) = v; }
        LDS_WAIT(); asm volatile("" ::: "memory");
        float X[32];
#pragma unroll
        for (int i = 0; i < 32; ++i) {
            float s = (i == r) ? 1.f : 0.f;
#pragma unroll
            for (int jq = 0; jq < (i + 3) / 4; ++jq) { const f32x4 lv = *(const LAS f32x4*)(Lw + i * 36 + 4 * jq);
#pragma unroll
                for (int q = 0; q < 4; ++q) if (4 * jq + q < i) s += lv[q] * X[4 * jq + q]; }
            X[i] = s;
        }
        if (h == 0) { bf16* o = tinv + (size_t)unit * 1024 + r;
#pragma unroll
            for (int i = 0; i < 32; ++i) o[i * 32] = f2bf(X[i]); }
        LDS_WAIT(); asm volatile("" ::: "memory");
    }
}

__device__ __forceinline__ f32x4 exp4(f32x4 x) { return (f32x4){__expf(x[0]), __expf(x[1]), __expf(x[2]), __expf(x[3])}; }
__device__ __forceinline__ f32x4 rcp4(f32x4 x) { return (f32x4){__builtin_amdgcn_rcpf(x[0]), __builtin_amdgcn_rcpf(x[1]), __builtin_amdgcn_rcpf(x[2]), __builtin_amdgcn_rcpf(x[3])}; }
__device__ __forceinline__ void rwkv_prep_phase(const Frame& F, const Args& a, int layer) {
    unsigned char* ws = WSP(F);
    const bf16* proj = (const bf16*)(ws + WS_PROJ);
    const bf16* abuf = (const bf16*)(ws + WS_A);
    const bf16* logw = (const bf16*)(ws + WS_DEC);
    bf16* til = (bf16*)(ws + WS_TIL);
    float* bonus = (float*)(ws + WS_BONUS);
    float* wtb = (float*)(ws + WS_WTB);
    const float* cw = INP(F, I_CW) + (size_t)layer * 3 * 3072; const float* cb = INP(F, I_CB) + (size_t)layer * 3072;
    for (int item = F.wave * F.G + F.bid; item < 2048; item += 8 * F.G) {
        int lane = lane_id(); asm volatile("" : "+v"(lane));
        const int run = item >> 2, tok0 = run * 32, cg = item & 3, c4 = cg * 256 + 4 * lane, head = cg * 4 + (lane >> 4), hl = 4 * (lane & 15);
        const int t0 = tok0 < NPR ? (tok0 & 255) : ((tok0 - NPR) & 2047), L = tok0 < NPR ? L_P : L_S;
        const f32x4 kkw = *(const f32x4*)(INP(F, I_KK) + layer * 1024 + c4), kaw = *(const f32x4*)(INP(F, I_KA) + layer * 1024 + c4), rkw = *(const f32x4*)(INP(F, I_RK) + layer * 1024 + c4);
        f32x4 tot1 = (f32x4){0.f, 0.f, 0.f, 0.f};
#pragma unroll 1
        for (int q = 0; q < 4; ++q) { f32x4 t[8];
#pragma unroll
          for (int i = 0; i < 8; ++i) t[i] = unpack4(*(const u32x2*)(logw + ((size_t)(tok0 + 8 * q + i) * 2 + 1) * 1024 + c4));
#pragma unroll
          for (int i = 0; i < 8; ++i) tot1 += t[i]; }
        f32x4 pre0 = (f32x4){0.f, 0.f, 0.f, 0.f}, pre1 = pre0, e0prev = (f32x4){1.f, 1.f, 1.f, 1.f};
        const bf16* pbase = proj + (size_t)tok0 * NPROJ + COL_R + c4;
#pragma unroll 1
        for (int ch = 0; ch < 8; ++ch) {
            const float* cwp = cw; const float* cbp = cb; asm volatile("" : "+s"(cwp), "+s"(cbp));
            f32x4 w[3][3], bs[3];
#pragma unroll
            for (int s = 0; s < 3; ++s) { bs[s] = *(const f32x4*)(cbp + s * 1024 + c4);
#pragma unroll
                for (int tp = 0; tp < 3; ++tp) w[s][tp] = *(const f32x4*)(cwp + tp * 3072 + s * 1024 + c4); }
            u32x2 rows[6][3], av[4][2]; f32x4 lw[4][2];
#pragma unroll
            for (int i = 0; i < 6; ++i) { const int tt = ch * 4 + i - 1, t = t0 + tt; const bool ok = (t >= 0) && (t < L);
#pragma unroll
                for (int s = 0; s < 3; ++s) rows[i][s] = ok ? *(const u32x2*)(pbase + (long)tt * NPROJ + s * 1024) : (u32x2){0u, 0u}; }
#pragma unroll
            for (int i = 0; i < 4; ++i) { const size_t tok = (size_t)(tok0 + ch * 4 + i); av[i][0] = *(const u32x2*)(abuf + (tok * 2 + 0) * 1024 + c4); av[i][1] = *(const u32x2*)(abuf + (tok * 2 + 1) * 1024 + c4);
                lw[i][0] = unpack4(*(const u32x2*)(logw + (tok * 2 + 0) * 1024 + c4)); lw[i][1] = unpack4(*(const u32x2*)(logw + (tok * 2 + 1) * 1024 + c4)); }
#pragma unroll
            for (int i = 0; i < 4; ++i) {
                const size_t tok = (size_t)(tok0 + ch * 4 + i);
                f32x4 x[3];
#pragma unroll
                for (int s = 0; s < 3; ++s) x[s] = unpack4(rows[i][s]) * w[s][0] + unpack4(rows[i + 1][s]) * w[s][1] + unpack4(rows[i + 2][s]) * w[s][2] + bs[s];
                const f32x4 rr = x[0], k0 = x[1], vv = x[2];
                f32x4 kk = k0 * kkw;
                const float ssq = row_sum16((kk[0] * kk[0] + kk[1] * kk[1]) + (kk[2] * kk[2] + kk[3] * kk[3]));
                kk = kk * (1.0f / sqrtf(ssq + 1e-12f));
                const f32x4 a0 = unpack4(av[i][0]), a1 = unpack4(av[i][1]);
                const f32x4 kd0 = k0 * (1.0f + (a0 - 1.0f) * kaw), kd1 = k0 * (1.0f + (a1 - 1.0f) * kaw);
                const f32x4 rk = rr * k0 * rkw;
                const float bsum = row_sum16((rk[0] + rk[1]) + (rk[2] + rk[3]));
                pre0 += lw[i][0];
                const f32x4 e0 = exp4(pre0), ie0 = rcp4(e0);
                const f32x4 l1 = tot1 - pre1; pre1 += lw[i][1];
                const f32x4 e1 = exp4(l1), ie1 = rcp4(e1), e1prev = exp4(l1 - lw[i][1]);
                bf16* o = til + (tok * 16 + head) * TILP + hl;
                *(u32x2*)(o) = pack4(-kk * e0prev); *(u32x2*)(o + 64) = pack4(kk * a0 * ie0); *(u32x2*)(o + 128) = pack4(kd0 * ie0); *(u32x2*)(o + 192) = pack4(rr * e0);
                *(u32x2*)(o + 256) = pack4(-kk * e1prev); *(u32x2*)(o + 320) = pack4(kk * a1 * ie1); *(u32x2*)(o + 384) = pack4(kd1 * ie1); *(u32x2*)(o + 448) = pack4(rr * e1);
                *(u32x2*)(o + 512) = pack4(vv);
                e0prev = e0;
                if ((lane & 15) == 0) bonus[tok * 16 + head] = bsum;
            }
        }
        *(f32x4*)(wtb + (((size_t)run * 2 + 0) * 16 + head) * 64 + hl) = exp4(pre0);
        *(f32x4*)(wtb + (((size_t)run * 2 + 1) * 16 + head) * 64 + hl) = exp4(tot1);
        asm volatile("s_waitcnt vmcnt(0)" ::: "memory");
#pragma unroll 1
        for (int uu = 0; uu < 8; ++uu) rwkv_tinv_unit(F, (run << 5) | ((uu & 1) << 4) | (cg * 4 + (uu >> 1)));
    }
}

__device__ __forceinline__ bf16x8 packf(const f32x16& x, int s) {
    u32x4 p; p.x = cvtpk(x[8 * s + 0], x[8 * s + 1]); p.y = cvtpk(x[8 * s + 2], x[8 * s + 3]); p.z = cvtpk(x[8 * s + 4], x[8 * s + 5]); p.w = cvtpk(x[8 * s + 6], x[8 * s + 7]);
    return __builtin_bit_cast(bf16x8, p);
}
#define MFMA32(a, b, c) __builtin_amdgcn_mfma_f32_32x32x16_bf16((a), (b), (c), 0, 0, 0)

#define TR8(F0, F1, F2, F3, A, O0, O1, O2, O3) do { s16x4 l0_, h0_, l1_, h1_, l2_, h2_, l3_, h3_; \
    asm volatile("ds_read_b64_tr_b16 %0, %8 offset:%9\n\tds_read_b64_tr_b16 %1, %8 offset:%9+1024\n\tds_read_b64_tr_b16 %2, %8 offset:%10\n\tds_read_b64_tr_b16 %3, %8 offset:%10+1024\n\t" \
                 "ds_read_b64_tr_b16 %4, %8 offset:%11\n\tds_read_b64_tr_b16 %5, %8 offset:%11+1024\n\tds_read_b64_tr_b16 %6, %8 offset:%12\n\tds_read_b64_tr_b16 %7, %8 offset:%12+1024\n\ts_waitcnt lgkmcnt(0)" \
                 : "=&v"(l0_), "=&v"(h0_), "=&v"(l1_), "=&v"(h1_), "=&v"(l2_), "=&v"(h2_), "=&v"(l3_), "=&v"(h3_) : "v"(A), "n"(O0), "n"(O1), "n"(O2), "n"(O3)); \
    F0 = __builtin_shufflevector(l0_, h0_, 0, 1, 2, 3, 4, 5, 6, 7); F1 = __builtin_shufflevector(l1_, h1_, 0, 1, 2, 3, 4, 5, 6, 7); \
    F2 = __builtin_shufflevector(l2_, h2_, 0, 1, 2, 3, 4, 5, 6, 7); F3 = __builtin_shufflevector(l3_, h3_, 0, 1, 2, 3, 4, 5, 6, 7); } while (0)
#define TR4(F0, F1, A, O0, O1) do { s16x4 l0_, h0_, l1_, h1_; \
    asm volatile("ds_read_b64_tr_b16 %0, %4 offset:%5\n\tds_read_b64_tr_b16 %1, %4 offset:%5+1024\n\tds_read_b64_tr_b16 %2, %4 offset:%6\n\tds_read_b64_tr_b16 %3, %4 offset:%6+1024\n\ts_waitcnt lgkmcnt(0)" \
                 : "=&v"(l0_), "=&v"(h0_), "=&v"(l1_), "=&v"(h1_) : "v"(A), "n"(O0), "n"(O1)); \
    F0 = __builtin_shufflevector(l0_, h0_, 0, 1, 2, 3, 4, 5, 6, 7); F1 = __builtin_shufflevector(l1_, h1_, 0, 1, 2, 3, 4, 5, 6, 7); } while (0)
template <int V> struct IC { static constexpr int value = V; };
__device__ __forceinline__ void hyena_post_phase(const Frame& F, const Args& a, int layer, LAS bf16* tl, int gw, int NGW);
constexpr int CS_BUF = 23552, CS_AT = 0, CS_BT = 4096, CS_KT = 8192, CS_RT = 12288, CS_VV = 16384, CS_TI = 20480, CS_WT = 22528;
__device__ __forceinline__ void rwkv_cscan_phase(const Frame& F, const Args& a, int layer) {
    if (F.wave >= 2) {
        if (F.wave < 6) { LAS bf16* sl = (LAS bf16*)(F.lds + 4 * CS_BUF + (F.wave - 2) * 8704);
            hyena_post_phase(F, a, layer, sl, F.bid * 4 + (F.wave - 2), F.G * 4); }
        if (layer + 1 < DEPTH) convert_layer(F, layer + 1, nullptr, F.bid * 6 + (F.wave - 2), F.G * 6);
        return; }
    unsigned char* ws = WSP(F);
    const bf16* til = (const bf16*)(ws + WS_TIL);
    const bf16* tinv = (const bf16*)(ws + WS_TINV);
    const float* wtb = (const float*)(ws + WS_WTB);
    float* Y = (float*)(ws + WS_H);
    const int lane = F.lane, r = lane & 31, h = lane >> 5;
    const int i16 = lane & 15, tq = i16 >> 2, tp = i16 & 3, blk = (lane >> 4) & 1;
    LAS unsigned char* lbase = F.lds + F.wave * (2 * CS_BUF);
    const int slot = F.wave * F.G + F.bid, nslot = 2 * F.G;
    const int nsamp = 256;
    for (int item = slot; item < 2304; item += (slot < nsamp) ? 2304 : (nslot - nsamp)) {
        const bool sample = item < 256; const int hc = sample ? item : item - 256, chain = hc >> 1, vt = hc & 1;
        const int hd = chain & 15, e = (chain >> 4) & 1, b = chain >> 5;
        const int NC = sample ? (L_S / 32) : (L_P / 32), tokb = sample ? NPR + b * L_S : b * L_P;
        f32x16 ST[2];
        if (sample) { const float* s0 = INP(F, I_ST) + ((((size_t)b * 4 + layer) * 2 + e) * 16 + hd) * 4096;
#pragma unroll
            for (int kt = 0; kt < 2; ++kt)
#pragma unroll
                for (int g = 0; g < 4; ++g) { const f32x4 v = *(const f32x4*)(s0 + (32 * vt + r) * 64 + 32 * kt + 8 * g + 4 * h);
                    ST[kt][4 * g] = v[0]; ST[kt][4 * g + 1] = v[1]; ST[kt][4 * g + 2] = v[2]; ST[kt][4 * g + 3] = v[3]; }
        } else {
#pragma unroll
            for (int kt = 0; kt < 2; ++kt)
#pragma unroll
                for (int i = 0; i < 16; ++i) ST[kt][i] = 0.f;
        }
#define CS_DMA(C, BUFP) do { const int run_ = (tokb >> 5) + (e ? NC - 1 - (C) : (C)); int ln_ = lane_id(); asm volatile("" : "+v"(ln_));     \
            _Pragma("unroll") for (int i_ = 0; i_ < 4; ++i_) { const int q_ = ln_ + 64 * i_, p_ = q_ >> 3, cc_ = q_ & 7; \
                const bf16* g_ = til + ((size_t)(run_ * 32 + (e ? 31 - p_ : p_)) * 16 + hd) * TILP + e * 256 + 8 * cc_; \
                __builtin_amdgcn_global_load_lds((const unsigned*)(g_), (LAS unsigned*)((BUFP) + CS_AT + i_ * 1024), 16, 0, 0); \
                __builtin_amdgcn_global_load_lds((const unsigned*)(g_ + 64), (LAS unsigned*)((BUFP) + CS_BT + i_ * 1024), 16, 0, 0); \
                __builtin_amdgcn_global_load_lds((const unsigned*)(g_ + 128), (LAS unsigned*)((BUFP) + CS_KT + i_ * 1024), 16, 0, 0); \
                __builtin_amdgcn_global_load_lds((const unsigned*)(g_ + 192), (LAS unsigned*)((BUFP) + CS_RT + i_ * 1024), 16, 0, 0); \
                __builtin_amdgcn_global_load_lds((const unsigned*)(g_ - e * 256 + 512), (LAS unsigned*)((BUFP) + CS_VV + i_ * 1024), 16, 0, 0); } \
            const size_t unit_ = ((size_t)run_ * 2 + e) * 16 + hd; \
            _Pragma("unroll") for (int i_ = 0; i_ < 2; ++i_) __builtin_amdgcn_global_load_lds((const unsigned*)(tinv + unit_ * 1024 + (ln_ + 64 * i_) * 8), (LAS unsigned*)((BUFP) + CS_TI + i_ * 1024), 16, 0, 0); \
            __builtin_amdgcn_global_load_lds((const unsigned*)(wtb + unit_ * 64 + (ln_ & 15) * 4), (LAS unsigned*)((BUFP) + CS_WT), 16, 0, 0); } while (0)
        CS_DMA(0, lbase);
        auto chunk = [&](auto bi_, int c) __attribute__((always_inline)) {
            constexpr int BI = decltype(bi_)::value;
            const LAS unsigned char* B = lbase + BI * CS_BUF;
            if (c == 0) asm volatile("s_waitcnt vmcnt(0)" ::: "memory");
            else asm volatile("s_waitcnt vmcnt(16)" ::: "memory");
            if (c + 1 < NC) CS_DMA(c + 1, lbase + (1 - BI) * CS_BUF);
            bf16x8 nkaF[2], nbrF[2], nkrF[2];
#define CS_NMAT(OUTF, OFFA, OFFB, STRICT) do { f32x16 n_; _Pragma("unroll") for (int i = 0; i < 16; ++i) n_[i] = 0.f; \
                    _Pragma("unroll") for (int ks = 0; ks < 4; ++ks) { const int o = r * 128 + (16 * ks + 8 * h) * 2; \
                        n_ = MFMA32(*(const LAS bf16x8*)(B + (OFFA) + o), *(const LAS bf16x8*)(B + (OFFB) + o), n_); } \
                    _Pragma("unroll") for (int i = 0; i < 16; ++i) { const int row = (i & 3) + 8 * (i >> 2) + 4 * h; n_[i] = ((STRICT) ? (row < r) : (row <= r)) ? n_[i] : 0.f; } \
                    OUTF[0] = packf(n_, 0); OUTF[1] = packf(n_, 1); } while (0)
            CS_NMAT(nkaF, CS_KT, CS_AT, true);
            CS_NMAT(nbrF, CS_BT, CS_RT, false);
            CS_NMAT(nkrF, CS_KT, CS_RT, false);
#undef CS_NMAT
            const unsigned tra = (unsigned)(size_t)(B) + (4 * h + tq) * 128 + (16 * blk + 4 * tp) * 2 + vt * 64;
            const unsigned trk = (unsigned)(size_t)(B) + (4 * h + tq) * 128 + (16 * blk + 4 * tp) * 2;
            bf16x8 vvF[2], btF[2][2], ktF[2][2];
            TR4(vvF[0], vvF[1], tra, CS_VV, CS_VV + 2048);
            TR8(btF[0][0], btF[0][1], btF[1][0], btF[1][1], trk, CS_BT, CS_BT + 2048, CS_BT + 64, CS_BT + 64 + 2048);
            TR8(ktF[0][0], ktF[0][1], ktF[1][0], ktF[1][1], trk, CS_KT, CS_KT + 2048, CS_KT + 64, CS_KT + 64 + 2048);
#define CS_APERM(OFF, KT, S) ({ const LAS unsigned char* p_ = B + (OFF) + r * 128 + (32 * (KT) + 16 * (S) + 4 * h) * 2; \
                const u32x2 lo_ = *(const LAS u32x2*)p_, hi_ = *(const LAS u32x2*)(p_ + 16); __builtin_bit_cast(bf16x8, (u32x4){lo_.x, lo_.y, hi_.x, hi_.y}); })
            bf16x8 uF[2];
            {   f32x16 rhs;
#pragma unroll
                for (int i = 0; i < 16; ++i) rhs[i] = 0.f;
#pragma unroll
                for (int kt = 0; kt < 2; ++kt)
#pragma unroll
                    for (int s = 0; s < 2; ++s) rhs = MFMA32(CS_APERM(CS_AT, kt, s), packf(ST[kt], s), rhs);
#pragma unroll
                for (int s = 0; s < 2; ++s) rhs = MFMA32(nkaF[s], vvF[s], rhs);
                f32x16 u;
#pragma unroll
                for (int i = 0; i < 16; ++i) u[i] = 0.f;
#pragma unroll
                for (int s = 0; s < 2; ++s) { const LAS unsigned char* p_ = B + CS_TI + r * 64 + (16 * s + 4 * h) * 2;
                    const u32x2 lo_ = *(const LAS u32x2*)p_, hi_ = *(const LAS u32x2*)(p_ + 16);
                    u = MFMA32(__builtin_bit_cast(bf16x8, (u32x4){lo_.x, lo_.y, hi_.x, hi_.y}), packf(rhs, s), u); }
                uF[0] = packf(u, 0); uF[1] = packf(u, 1);
            }
            {   const int run = (tokb >> 5) + (e ? NC - 1 - c : c);
                f32x16 y;
#pragma unroll
                for (int i = 0; i < 16; ++i) y[i] = 0.f;
#pragma unroll
                for (int kt = 0; kt < 2; ++kt)
#pragma unroll
                    for (int s = 0; s < 2; ++s) y = MFMA32(CS_APERM(CS_RT, kt, s), packf(ST[kt], s), y);
#pragma unroll
                for (int s = 0; s < 2; ++s) { y = MFMA32(nbrF[s], uF[s], y); y = MFMA32(nkrF[s], vvF[s], y); }
#pragma unroll
                for (int i = 0; i < 16; ++i) { const int p = (i & 3) + 8 * (i >> 2) + 4 * h; const size_t tok = (size_t)(run * 32 + (e ? 31 - p : p));
                    Y[((size_t)e * M + tok) * 1024 + hd * 64 + 32 * vt + r] = y[i]; }
            }
#pragma unroll
            for (int kt = 0; kt < 2; ++kt) {
                f32x4 wt[4];
#pragma unroll
                for (int g = 0; g < 4; ++g) wt[g] = *(const LAS f32x4*)(B + CS_WT + (32 * kt + 8 * g + 4 * h) * 4);
#pragma unroll
                for (int s = 0; s < 2; ++s) { ST[kt] = MFMA32(btF[kt][s], uF[s], ST[kt]); ST[kt] = MFMA32(ktF[kt][s], vvF[s], ST[kt]); }
#pragma unroll
                for (int i = 0; i < 16; ++i) ST[kt][i] *= wt[i >> 2][i & 3];
            }
        };
#pragma unroll 1
        for (int c2 = 0; c2 < NC; c2 += 2) { chunk(IC<0>{}, c2); chunk(IC<1>{}, c2 + 1); }
#undef CS_APERM
#undef CS_DMA
        if (!sample) { float* so = OUTP(F) + OUT_ST + ((((size_t)b * 4 + layer) * 2 + e) * 16 + hd) * 4096;
#pragma unroll
            for (int kt = 0; kt < 2; ++kt)
#pragma unroll
                for (int g = 0; g < 4; ++g) *(f32x4*)(so + (32 * vt + r) * 64 + 32 * kt + 8 * g + 4 * h) = (f32x4){ST[kt][4 * g], ST[kt][4 * g + 1], ST[kt][4 * g + 2], ST[kt][4 * g + 3]};
        }
    }
    asm volatile("s_waitcnt vmcnt(0)" ::: "memory");
}

__device__ __forceinline__ void rwkv_post_phase(const Frame& F, const Args& a, int layer) {
    unsigned char* ws = WSP(F);
    const float* Y = (const float*)(ws + WS_H);
    const bf16* til = (const bf16*)(ws + WS_TIL); const bf16* gbuf = (const bf16*)(ws + WS_G); const float* bonus = (const float*)(ws + WS_BONUS);
    bf16* oall = (bf16*)(ws + WS_OALL);
    const int lane = F.lane;
    for (int item = F.wave * F.G + F.bid; item < 2048; item += 8 * F.G) {
        const int tok0 = (item >> 2) * 32, cg = item & 3, c4 = cg * 256 + 4 * lane, head = cg * 4 + (lane >> 4), hl = 4 * (lane & 15);
        const f32x4 gng = *(const f32x4*)(INP(F, I_GNG) + layer * 1024 + c4), gnb = *(const f32x4*)(INP(F, I_GNB) + layer * 1024 + c4);
#pragma unroll 1
        for (int ch = 0; ch < 4; ++ch) {
            f32x4 y0[8], y1[8]; u32x2 vw[8], gw[8]; float bn[8];
#pragma unroll
            for (int i = 0; i < 8; ++i) { const size_t tok = (size_t)(tok0 + ch * 8 + i);
                y0[i] = *(const f32x4*)(Y + tok * 1024 + c4); y1[i] = *(const f32x4*)(Y + ((size_t)M + tok) * 1024 + c4);
                vw[i] = *(const u32x2*)(til + (tok * 16 + head) * TILP + 512 + hl); gw[i] = *(const u32x2*)(gbuf + tok * 1024 + c4); bn[i] = bonus[tok * 16 + head]; }
#pragma unroll
            for (int i = 0; i < 8; ++i) { const size_t tok = (size_t)(tok0 + ch * 8 + i);
                const f32x4 y = y0[i] + y1[i];
                const float mu = row_sum16((y[0] + y[1]) + (y[2] + y[3])) * (1.0f / 64.0f);
                const f32x4 dd = y - mu;
                const float var = row_sum16((dd[0] * dd[0] + dd[1] * dd[1]) + (dd[2] * dd[2] + dd[3] * dd[3])) * (1.0f / 64.0f);
                const f32x4 yn = dd * (1.0f / sqrtf(var + 64e-5f)) * gng + gnb;
                const f32x4 o = (yn + bn[i] * unpack4(vw[i])) * unpack4(gw[i]);
                *(u32x2*)(oall + tok * 3072 + 1024 + c4) = pack4(o);
            }
        }
    }
}

__device__ __forceinline__ void hyena_prep_phase(const Frame& F, const Args& a, int layer) {
    unsigned char* ws = WSP(F);
    const bf16* proj = (const bf16*)(ws + WS_PROJ);
    bf16* zT = (bf16*)(ws + WS_ZT);
    const float* cw = INP(F, I_HCW) + (size_t)layer * 3 * 3072; const float* cb = INP(F, I_HCB) + (size_t)layer * 3072;
    const int gw = F.bid * 8 + F.wave, NGW = F.G * 8, lane = F.lane, tsub = lane >> 4, cq = lane & 15;
    LAS bf16* tl = (LAS bf16*)(F.lds + F.wave * 16384);
    for (int it = gw; it < 256 * 16; it += NGW) {
        const int tt0 = (it >> 4) * 64, c0 = (it & 15) * 64, c4 = c0 + 4 * cq;
        const int t0 = tt0 < NPR ? (tt0 & 255) : ((tt0 - NPR) & 2047), L = tt0 < NPR ? L_P : L_S;
        f32x4 w1[3], w2[3];
#pragma unroll
        for (int tp = 0; tp < 3; ++tp) { w1[tp] = *(const f32x4*)(cw + tp * 3072 + 1024 + c4); w2[tp] = *(const f32x4*)(cw + tp * 3072 + 2048 + c4); }
        const f32x4 b1 = *(const f32x4*)(cb + 1024 + c4), b2 = *(const f32x4*)(cb + 2048 + c4);
        const bf16* px = proj + (size_t)tt0 * NPROJ + COL_X1 + c4;
#pragma unroll 1
        for (int hf = 0; hf < 2; ++hf) {
            u32x2 xr[8][3], vr[8][3];
#pragma unroll
            for (int i = 0; i < 8; ++i) { const int tt = 4 * (hf * 8 + i) + tsub;
#pragma unroll
                for (int d = 0; d < 3; ++d) { const int t = t0 + tt + d - 1; const bool ok = (t >= 0) && (t < L); const bf16* p = px + (long)(tt + d - 1) * NPROJ;
                    xr[i][d] = ok ? *(const u32x2*)p : (u32x2){0u, 0u}; vr[i][d] = ok ? *(const u32x2*)(p + 1024) : (u32x2){0u, 0u}; } }
#pragma unroll
            for (int i = 0; i < 8; ++i) { const int tt = 4 * (hf * 8 + i) + tsub;
                const f32x4 x1c = unpack4(xr[i][0]) * w1[0] + unpack4(xr[i][1]) * w1[1] + unpack4(xr[i][2]) * w1[2] + b1;
                const f32x4 vvc = unpack4(vr[i][0]) * w2[0] + unpack4(vr[i][1]) * w2[1] + unpack4(vr[i][2]) * w2[2] + b2;
                *(LAS u32x2*)(tl + tt * 68 + 4 * cq) = pack4(x1c * vvc); }
        }
        LDS_WAIT(); asm volatile("" ::: "memory");
#pragma unroll 16
        for (int cc = 0; cc < 64; ++cc) zT[(size_t)(c0 + cc) * M + tt0 + lane] = tl[lane * 68 + cc];
        LDS_WAIT(); asm volatile("" ::: "memory");
    }
}

__device__ __forceinline__ void hyena_conv_phase(const Frame& F, const Args& a, int layer) {
    unsigned char* ws = WSP(F);
    bf16* zT = (bf16*)(ws + WS_ZT);
    const float* FNORM = (const float*)(ws + WS_CTL) + CW_FNORM;
    const int lane = F.lane, w = F.wave, r = lane & 31, h = lane >> 5;
    LAS unsigned char* lds = F.lds;
    for (int u = F.bid; u < 2048; u += F.G) {
        const bool sample = u < 1024; const int c = u & 1023;
        const int L = sample ? L_S : L_P, LP = sample ? LPS : LPP, FCS = LP * 2;
        const int ZROW = (L + 448) * 2, ZOFF = 2 * FCS;
        const int NB = sample ? 4 : 32, tokb = sample ? NPR : 0;
        const bf16* fsrc = sample ? (const bf16*)(ws + WS_FS) + ((size_t)layer * 1024 + c) * LPS : (const bf16*)(ws + WS_FP) + ((size_t)layer * 1024 + c) * LPP;
        __syncthreads();
        for (int i = F.tid; i < LP / 8; i += 512) *(LAS u32x4*)(lds + i * 16) = *(const u32x4*)(fsrc + i * 8);
        for (int i = F.tid; i < LP; i += 512) *(LAS bf16*)(lds + FCS + i * 2) = (i + 1 < LP) ? fsrc[i + 1] : (bf16)0;
        { const int cpr = L / 8;
          for (int i = F.tid; i < NB * cpr; i += 512) { const int b = i / cpr, q = i - b * cpr;
              *(LAS u32x4*)(lds + ZOFF + b * ZROW + 448 + q * 16) = *(const u32x4*)(zT + (size_t)c * M + tokb + b * L + q * 8); }
          if (sample) for (int i = F.tid; i < NB * 56; i += 512) { const int b = i / 56, q = i - b * 56;
              *(LAS u32x4*)(lds + ZOFF + b * ZROW + (q < 28 ? q * 16 : 448 + L * 2 + (q - 28) * 16)) = (u32x4){0u, 0u, 0u, 0u}; } }
        __syncthreads();
        const int nbl = sample ? 2 : 5;
        const int I0 = sample ? 8 * w : w;
        const int b = r & (NB - 1), I = I0 + (r >> nbl);
        int dlo = (sample ? I0 - 63 : I0 - 7), dhi = (sample ? I0 + 7 : I0);
        const int dmax = L / 64;
        dlo = dlo < -dmax ? -dmax : dlo; dhi = dhi > dmax ? dmax : dhi;
        f32x16 acc;
#pragma unroll
        for (int i = 0; i < 16; ++i) acc[i] = 0.f;
        const LAS unsigned char* zb = lds + ZOFF + b * ZROW + (224 + 8 * h) * 2;
#pragma unroll 2
        for (int d = dlo; d <= dhi; ++d) {
#pragma unroll
            for (int ks = 0; ks < 2; ++ks) {
                const int st = (L / 2 - 1) - 32 * d - r + 16 * ks + 8 * h + 32;
                const int par = st & 1;
                const LAS unsigned* ap = (const LAS unsigned*)(lds + par * FCS + (st - par) * 2);
                const u32x4 aw = (u32x4){ap[0], ap[1], ap[2], ap[3]};
                const bf16x8 af = __builtin_bit_cast(bf16x8, aw);
                const bf16x8 bfr = *(const LAS bf16x8*)(zb + (32 * (I - d) + 16 * ks) * 2);
                acc = __builtin_amdgcn_mfma_f32_32x32x16_bf16(af, bfr, acc, 0, 0, 0);
            }
        }
        const float inv = 1.0f / (FNORM[((size_t)layer * 2 + (sample ? 0 : 1)) * 1024 + c] + 1e-6f);
        const float dco = INP(F, I_HD)[layer * 1024 + c];
        __syncthreads();
#pragma unroll
        for (int g = 0; g < 4; ++g) {
            const int t = 32 * I + 8 * g + 4 * h;
            const LAS bf16* zp = (const LAS bf16*)(lds + ZOFF + b * ZROW + (224 + t) * 2);
            float o[4];
#pragma unroll
            for (int j = 0; j < 4; ++j) o[j] = acc[4 * g + j] * inv + bf2f(zp[j]) * dco;
            *(u32x2*)(zT + (size_t)c * M + tokb + b * L + t) = (u32x2){cvtpk(o[0], o[1]), cvtpk(o[2], o[3])};
        }
    }
    __syncthreads();
}

__device__ __forceinline__ void hyena_post_phase(const Frame& F, const Args& a, int layer, LAS bf16* tl, int gw, int NGW) {
    unsigned char* ws = WSP(F);
    const bf16* proj = (const bf16*)(ws + WS_PROJ);
    const bf16* yT = (const bf16*)(ws + WS_ZT);
    bf16* oall = (bf16*)(ws + WS_OALL);
    const float* cw = INP(F, I_HCW) + (size_t)layer * 3 * 3072; const float* cb = INP(F, I_HCB) + (size_t)layer * 3072;
    const int lane = F.lane, tsub = lane >> 4, cq = lane & 15;
    for (int it = gw; it < 256 * 16; it += NGW) {
        const int tt0 = (it >> 4) * 64, c0 = (it & 15) * 64, c4 = c0 + 4 * cq;
        const int t0 = tt0 < NPR ? (tt0 & 255) : ((tt0 - NPR) & 2047), L = tt0 < NPR ? L_P : L_S;
#pragma unroll 1
        for (int q = 0; q < 4; ++q) { bf16 tmp[16];
#pragma unroll
            for (int j = 0; j < 16; ++j) tmp[j] = yT[(size_t)(c0 + q * 16 + j) * M + tt0 + lane];
#pragma unroll
            for (int j = 0; j < 16; ++j) tl[(q * 16 + j) * 68 + lane] = tmp[j]; }
        LDS_WAIT(); asm volatile("" ::: "memory");
        f32x4 w0[3];
#pragma unroll
        for (int tp = 0; tp < 3; ++tp) w0[tp] = *(const f32x4*)(cw + tp * 3072 + c4);
        const f32x4 b0 = *(const f32x4*)(cb + c4);
        const bf16* px = proj + (size_t)tt0 * NPROJ + COL_X0 + c4;
#pragma unroll 1
        for (int hf = 0; hf < 2; ++hf) {
            u32x2 xr[8][3];
#pragma unroll
            for (int i = 0; i < 8; ++i) { const int tt = 4 * (hf * 8 + i) + tsub;
#pragma unroll
                for (int d = 0; d < 3; ++d) { const int t = t0 + tt + d - 1; const bool ok = (t >= 0) && (t < L); xr[i][d] = ok ? *(const u32x2*)(px + (long)(tt + d - 1) * NPROJ) : (u32x2){0u, 0u}; } }
#pragma unroll
            for (int i = 0; i < 8; ++i) { const int tt = 4 * (hf * 8 + i) + tsub;
                const f32x4 x0c = unpack4(xr[i][0]) * w0[0] + unpack4(xr[i][1]) * w0[1] + unpack4(xr[i][2]) * w0[2] + b0;
                const f32x4 yv = (f32x4){bf2f(tl[(4 * cq + 0) * 68 + tt]), bf2f(tl[(4 * cq + 1) * 68 + tt]), bf2f(tl[(4 * cq + 2) * 68 + tt]), bf2f(tl[(4 * cq + 3) * 68 + tt])};
                *(u32x2*)(oall + (size_t)(tt0 + tt) * 3072 + 2048 + c4) = pack4(x0c * yv); }
        }
        LDS_WAIT(); asm volatile("" ::: "memory");
    }
}

constexpr int NPL = 11, PH_LAYER0 = 2, PH_FINAL = PH_LAYER0 + DEPTH * NPL, N_PHASES = PH_FINAL + 1;

__global__ void __launch_bounds__(512, 2) mega(Args args) {
    extern __shared__ __attribute__((aligned(16))) unsigned char lds_raw[];
    Frame F;
    F.lds = (LAS unsigned char*)lds_raw;
    F.tid = threadIdx.x; F.lane = F.tid & 63; F.wave = __builtin_amdgcn_readfirstlane(F.tid >> 6);
    F.G = gridDim.x; F.bid = blockIdx.x;
    for (int u = F.tid; u < (LDS_BYTES - LDSCTL_OFF) / 4; u += 512) ((LAS unsigned*)(F.lds + LDSCTL_OFF))[u] = 0u;
    __syncthreads();
    if (F.tid < 48) { const unsigned long long p = F.tid < 46 ? (unsigned long long)args.in[F.tid] : (F.tid == 46 ? (unsigned long long)args.out : (unsigned long long)args.ws);
        ((LAS unsigned*)(F.lds + LDS_ARGT))[2 * F.tid] = (unsigned)p; ((LAS unsigned*)(F.lds + LDS_ARGT))[2 * F.tid + 1] = (unsigned)(p >> 32); }
    __syncthreads();
    unsigned char* ws = WSP(F);
    unsigned* ctl = (unsigned*)(ws + WS_CTL);
    int lo = args.ph_lo, hi = args.ph_hi;
    const bool single = (hi - lo) > 1;
    XcdBarrier bar; bar.bar = ctl + CW_BAR; bar.x = 0; bar.st = (volatile LAS unsigned*)(F.lds + LDSCTL_OFF + 64); bar.wave = F.wave;
    if (single) bar = xcd_barrier_post(ctl + CW_BAR, (volatile LAS unsigned*)(F.lds + LDSCTL_OFF + 64), F.wave);
#ifndef MK_EN
#define MK_EN 0xFFFFFF
#endif
#define IN(k) (lo <= (k) && (k) < hi)
#define EN(b) ((MK_EN >> (b)) & 1)
#ifndef MK_DUP
#define MK_DUP -1
#endif
#define REPS(k) ((MK_DUP == (k)) ? 2 : 1)
#define FRESH() do { F.lane = lane_id(); asm volatile("" : "+v"(F.lane), "+s"(F.bid), "+s"(F.wave), "+s"(F.G)); F.tid = F.wave * 64 + F.lane; } while (0)
#define SEAM(k) do { if (IN(k) && IN((k) + 1)) xcd_barrier(bar); } while (0)

    if (EN(20) && IN(0)) { FRESH(); prologue0(F, args); SEAM(0); }
    if (EN(21) && IN(1)) { FRESH(); prologue1(F, args); SEAM(1); }

    bf16* Hb = (bf16*)(ws + WS_H); bf16* proj = (bf16*)(ws + WS_PROJ); bf16* oall = (bf16*)(ws + WS_OALL);
    float* x = OUTP(F);
#pragma unroll 1
    for (int l = 0; l < DEPTH; ++l) {
        const int pb = PH_LAYER0 + l * NPL;
        asm volatile("" : "+s"(lo), "+s"(hi));
        const float* mod = (const float*)(ws + WS_MOD) + (size_t)l * 5 * 12288;
        if (EN(0) && IN(pb + 0)) { FRESH();
            norm_phase(F, l == 0 ? INP(F, I_XP) : x, l == 0 ? INP(F, I_XS) : x + (size_t)NPR * D, l == 0 ? x : nullptr, INP(F, I_LN1) + l * D, mod, 0, 1, Hb);
            SEAM(pb + 0);
        }
        if (EN(1) && IN(pb + 1)) { FRESH();
            pg8::Gemm g{Hb, (const bf16*)(ws + WS_WIN) + (size_t)l * NPROJ * D, D, D, D, 0, 0, 0};
            pg8::Order S; S.init(M, NPROJ, F.G, F.bid, 1);
            pg8::EpiProj E{proj, x + OUT_CK, x + OUT_CV, l};
            pg8::gemm_phase(F.lds, g, S, E, F.wave);
            SEAM(pb + 1);
        }
        if (EN(2) && IN(pb + 2)) { FRESH();
            {   pg8::Gemm g{proj + COL_LW, (const bf16*)(ws + WS_W2T) + (size_t)l * 5120 * 128, NPROJ, 128, 128, 0, 128, 4};
                pg8::Order5 S; S.init(M, F.G, F.bid);
                pg8::EpiLora2 E{(bf16*)(ws + WS_DEC), (bf16*)(ws + WS_A), (bf16*)(ws + WS_G), INP(F, I_W0) + l * 2048, INP(F, I_A0) + l * 2048};
                pg8::gemm_phase(F.lds, g, S, E, F.wave); }
            FRESH(); attention_phase(F, args, l);
            FRESH(); hyena_prep_phase(F, args, l);
            SEAM(pb + 2);
        }
        if (EN(3) && IN(pb + 3)) { FRESH(); rwkv_prep_phase(F, args, l); FRESH(); hyena_conv_phase(F, args, l); SEAM(pb + 3); }
        if (EN(4) && IN(pb + 4)) { FRESH(); rwkv_cscan_phase(F, args, l); SEAM(pb + 4); }
        if (EN(5) && IN(pb + 5)) { FRESH(); rwkv_post_phase(F, args, l); SEAM(pb + 5); }
        if (EN(6) && IN(pb + 6)) { FRESH();
            pg8::Gemm g{oall, (const bf16*)(ws + WS_WP) + (size_t)l * 3 * D * 1024, 3072, 1024, 1024, 1024, 0, 8};
            pg8::Order S; S.init(M, D, F.G, F.bid, 3);
            pg8::EpiMerge E{proj, Hb};
            pg8::gemm_phase(F.lds, g, S, E, F.wave);
            SEAM(pb + 6);
        }
        if (EN(7) && IN(pb + 7)) { FRESH();
            pg8::Gemm g{Hb, (const bf16*)(ws + WS_WOUT) + (size_t)l * D * D, D, D, D, 0, 0, 0};
            pg8::Order S; S.init(M, D, F.G, F.bid, 1);
            pg8::EpiResid E{x, mod + 2 * D, nullptr, 1.0f};
            pg8::gemm_phase(F.lds, g, S, E, F.wave);
            SEAM(pb + 7);
        }
        if (EN(8) && IN(pb + 8)) { FRESH(); norm_phase(F, x, x + (size_t)NPR * D, nullptr, INP(F, I_LN2) + l * D, mod, 3, 4, Hb); SEAM(pb + 8); }
        if (EN(9) && IN(pb + 9)) { FRESH();
            pg8::Gemm g{Hb, (const bf16*)(ws + WS_WFF1) + (size_t)l * D * DFF, D, D, D, 0, 0, 0};
            pg8::Order S; S.init(M, DFF, F.G, F.bid, 1);
            pg8::EpiFF1 E{proj, INP(F, I_BFF1) + l * DFF};
            pg8::gemm_phase(F.lds, g, S, E, F.wave);
            SEAM(pb + 9);
        }
        if (EN(10) && IN(pb + 10)) { FRESH();
            pg8::Gemm g{proj, (const bf16*)(ws + WS_WFF2) + (size_t)l * D * DFF, DFF, DFF, DFF, 0, 0, 0};
            pg8::Order S; S.init(M, D, F.G, F.bid, 1);
            pg8::EpiResid E{x, mod + 5 * D, INP(F, I_BFF2) + l * D, 1.0f};
            pg8::gemm_phase(F.lds, g, S, E, F.wave);
            SEAM(pb + 10);
        }
    }
    asm volatile("" : "+s"(lo), "+s"(hi));
    if (EN(22) && IN(PH_FINAL)) { FRESH(); final_norm_phase(F, OUTP(F), INP(F, I_FING)); }
#undef IN
#undef SEAM
}

extern "C" void kernel_launch(void* const* d_in, const int* in_sizes, int n_in, void* d_out, int out_size, void* d_ws, size_t ws_size, hipStream_t stream) {
    static int grid = 0;
    if (grid == 0) {
        if (n_in != N_INPUTS || (size_t)out_size != OUT_TOTAL || ws_size < WS_END) { fprintf(stderr, "kernel_launch: unexpected shapes: n_in %d out %d ws %zu\n", n_in, out_size, ws_size); grid = -1; return; }
        int dev = 0, cus = 0, per_cu = 0;
        if (hipGetDevice(&dev) != hipSuccess || hipDeviceGetAttribute(&cus, hipDeviceAttributeMultiprocessorCount, dev) != hipSuccess) { grid = -1; return; }
        if (hipFuncSetAttribute((const void*)mega, hipFuncAttributeMaxDynamicSharedMemorySize, LDS_BYTES) != hipSuccess) { fprintf(stderr, "kernel_launch: hipFuncSetAttribute failed\n"); grid = -1; return; }
        if (hipOccupancyMaxActiveBlocksPerMultiprocessor(&per_cu, (const void*)mega, 512, LDS_BYTES) != hipSuccess || per_cu < 1) { fprintf(stderr, "kernel_launch: occupancy query says %d\n", per_cu); }
        (void)hipGetLastError();
        grid = cus;
    }
    if (grid < 0) return;
    (void)hipMemsetAsync((char*)d_ws + WS_CTL, 0, CTL_ZERO_BYTES, stream);
    Args a{};
    for (int i = 0; i < N_INPUTS; ++i) a.in[i] = (const float*)d_in[i];
    a.out = (float*)d_out; a.ws = (unsigned char*)d_ws;
#if MK_MULTI
    for (int ph = 0; ph < N_PHASES; ++ph) { a.ph_lo = ph; a.ph_hi = ph + 1; hipLaunchKernelGGL(mega, dim3(grid), dim3(512), LDS_BYTES, stream, a); }
#else
    a.ph_lo = 0; a.ph_hi = N_PHASES;
    hipLaunchKernelGGL(mega, dim3(grid), dim3(512), LDS_BYTES, stream, a);
#endif
    const hipError_t le = hipPeekAtLastError();
    if (le != hipSuccess) fprintf(stderr, "kernel_launch: launch failed: %s\n", hipGetErrorName(le));
}
```

```cpp
#include <hip/hip_runtime.h>
#include <cstdio>
#include <cstdint>

#ifndef MK_MULTI
#define MK_MULTI 0
#endif

#define GAS __attribute__((address_space(1)))
#define LAS __attribute__((address_space(3)))
typedef unsigned short bf16;
typedef short bf16x8 __attribute__((ext_vector_type(8)));
typedef short s16x4 __attribute__((ext_vector_type(4)));
typedef float f32x4 __attribute__((ext_vector_type(4)));
typedef float f32x2 __attribute__((ext_vector_type(2)));
typedef float f32x16 __attribute__((ext_vector_type(16)));
typedef unsigned u32x4 __attribute__((ext_vector_type(4)));
typedef unsigned u32x2 __attribute__((ext_vector_type(2)));
typedef __bf16 bf16x2_t __attribute__((ext_vector_type(2)));

constexpr int D = 2048, DEPTH = 4, NPR = 8192  , M = 16384, DFF = 8192;
constexpr int NPROJ = 15872;
constexpr int COL_K = 1024, COL_V = 2048, COL_R = 3072, COL_X0 = 6144, COL_X1 = 7168, COL_VV = 8192, COL_GL = 9216, COL_LW = 15360, COL_G1A = 15488;
constexpr int L_P = 256, L_S = 2048;

enum { I_XP = 0, I_XS, I_CK, I_CV, I_ST, I_C, I_CCTX, I_LN1, I_LN2, I_WMOD, I_BMOD, I_WIN, I_RPB, I_CW, I_CB, I_W0, I_W1, I_W2, I_A0, I_A1, I_A2, I_G1, I_G2,
       I_KK, I_KA, I_RK, I_GNG, I_GNB, I_HCW, I_HCB, I_F1, I_FB1, I_F2, I_FB2, I_FREQ, I_F3, I_HD, I_WPA, I_WPR, I_WPC, I_WOUT, I_FF1, I_BFF1, I_FF2, I_BFF2, I_FING, N_INPUTS };

constexpr size_t OUT_X = 0, OUT_CK = 33554432, OUT_CV = 67108864, OUT_ST = 100663296, OUT_TOTAL = 117440512;

constexpr size_t MiB = 1u << 20;
constexpr size_t WS_CTL = 0, CTL_ZERO_BYTES = 1 * MiB;
constexpr size_t WS_WIN = 2 * MiB;
constexpr size_t WS_W2T = 250 * MiB;
constexpr size_t WS_WP = 260 * MiB;
constexpr size_t WS_WOUT = 308 * MiB;
constexpr size_t WS_WFF1 = 340 * MiB;
constexpr size_t WS_WFF2 = 468 * MiB;
constexpr size_t WS_H = 596 * MiB;
constexpr size_t WS_A = 660 * MiB;
constexpr size_t WS_PROJ = 724 * MiB;
constexpr size_t WS_OALL = 1220 * MiB;
constexpr size_t WS_DEC = 1316 * MiB;
constexpr size_t WS_G = 1444 * MiB;
constexpr size_t WS_TIL = 1476 * MiB;
constexpr size_t WS_CK = 1764 * MiB;
constexpr size_t WS_CV = 1772 * MiB;
constexpr size_t WS_FS = 1780 * MiB;
constexpr size_t WS_FP = 1797 * MiB;
constexpr size_t WS_ZT = 1800 * MiB;
constexpr size_t WS_MOD = 1832 * MiB;
constexpr size_t WS_T2 = 1833 * MiB;
constexpr size_t WS_BONUS = 1837 * MiB;
constexpr size_t WS_TINV = 1838 * MiB;
constexpr size_t WS_Q = WS_TINV;
constexpr size_t WS_WTB = 1870 * MiB;
constexpr size_t WS_END = 1874 * MiB;
constexpr int TILP = 576;
constexpr int LPS = 2120, LPP = 328;

constexpr int CW_BAR = 4096;
constexpr int CW_FNORM = 32768;

constexpr int LDS_SCRATCH = 131072, LDSCTL_OFF = 131072, LDS_BYTES = 147456;

#define LDS_WAIT() asm volatile("s_waitcnt lgkmcnt(0)" ::: "memory")
#define VM_WAIT() asm volatile("s_waitcnt vmcnt(0)" ::: "memory")
__device__ __forceinline__ unsigned cvtpk(float lo, float hi) { f32x2 v = {lo, hi}; bf16x2_t b = __builtin_convertvector(v, bf16x2_t); return __builtin_bit_cast(unsigned, b); }
__device__ __forceinline__ bf16 f2bf(float f) { return (bf16)(cvtpk(f, 0.f) & 0xffffu); }
__device__ __forceinline__ float bf2f(bf16 b) { return __uint_as_float(((unsigned)b) << 16); }
__device__ __forceinline__ float bflo(unsigned w) { return __uint_as_float(w << 16); }
__device__ __forceinline__ float bfhi(unsigned w) { return __uint_as_float(w & 0xffff0000u); }
#define DPPF(v, ctrl) __int_as_float(__builtin_amdgcn_update_dpp(0, __float_as_int(v), (ctrl), 0xf, 0xf, false))
__device__ __forceinline__ float wave_sum(float v) {
    v += DPPF(v, 0xB1); v += DPPF(v, 0x4E); v += DPPF(v, 0x141); v += DPPF(v, 0x140);
    const float a = __int_as_float(__builtin_amdgcn_readlane(__float_as_int(v), 0)), b = __int_as_float(__builtin_amdgcn_readlane(__float_as_int(v), 16)),
                c = __int_as_float(__builtin_amdgcn_readlane(__float_as_int(v), 32)), d = __int_as_float(__builtin_amdgcn_readlane(__float_as_int(v), 48));
    return (a + b) + (c + d);
}
__device__ __forceinline__ float xor32(float v, int lane) { return __int_as_float(__builtin_amdgcn_ds_bpermute((lane ^ 32) << 2, __float_as_int(v))); }
__device__ __forceinline__ int lane_id() { return (int)__builtin_amdgcn_mbcnt_hi(~0u, __builtin_amdgcn_mbcnt_lo(~0u, 0u)); }
__device__ __forceinline__ float sigmoidf_(float x) { return 1.0f / (1.0f + __expf(-x)); }

#define XB_TMO      128
#define XB_XCNT(j)  (256  + 64 * (j))
#define XB_XSUB(j)  (1280 + 64 * (j))
#define XB_XGEN(j)  (2304 + 64 * (j))
#define XB_TOP      3328
#define XB_TOPGEN   3392
#define XCD_BAR_WORDS 3456
#define XB_SPIN_CAP (1u << 20)
__device__ __forceinline__ unsigned xb_ld(unsigned* p)              { return __hip_atomic_load(p, __ATOMIC_RELAXED, __HIP_MEMORY_SCOPE_AGENT); }
__device__ __forceinline__ unsigned xb_add(unsigned* p, unsigned v) { return __hip_atomic_fetch_add(p, v, __ATOMIC_RELAXED, __HIP_MEMORY_SCOPE_AGENT); }
__device__ __forceinline__ unsigned xb_xcc_id() { return (unsigned)__builtin_amdgcn_s_getreg((3 << 11) | 20) & 0xFu; }
#define XB_SPIN(cond, bar) do { unsigned _sp = 0; while (cond) { __builtin_amdgcn_s_sleep(1); \
    if ((++_sp & 255u) == 0u) { if (xb_ld(&(bar)[XB_TMO])) break; if (_sp > XB_SPIN_CAP) { atomicAdd(&(bar)[XB_TMO], 1u); break; } } } } while (0)
struct XcdBarrier { unsigned* bar; unsigned x; volatile LAS unsigned* st; int wave; };
__device__ __forceinline__ XcdBarrier xcd_barrier_post(unsigned* bar, volatile LAS unsigned* st, int wave) {
    XcdBarrier b; b.bar = bar; b.x = xb_xcc_id(); b.st = st; b.wave = wave;
    if (wave == 0 && lane_id() == 0) (void)xb_add(&bar[XB_XCNT(b.x)], 1u);
    return b;
}
__device__ __forceinline__ void xcd_barrier_complete(unsigned* bar, unsigned x, unsigned& nloc, unsigned& nx) {
    const unsigned G = gridDim.x * gridDim.y * gridDim.z;
    unsigned sum, cnt, mine, sp = 0u;
    for (;;) {
        sum = 0u; cnt = 0u; mine = 0u;
#pragma unroll
        for (unsigned j = 0; j < 16; ++j) { const unsigned c = xb_ld(&bar[XB_XCNT(j)]); sum += c; cnt += (c > 0u) ? 1u : 0u; mine = (j == x) ? c : mine; }
        if (sum == G) break;
        __builtin_amdgcn_s_sleep(1);
        if ((++sp & 255u) == 0u) { if (xb_ld(&bar[XB_TMO])) break; if (sp > XB_SPIN_CAP) { atomicAdd(&bar[XB_TMO], 1u); break; } }
    }
    nloc = mine > 0u ? mine : 1u; nx = cnt > 0u ? cnt : 1u;
}
__device__ __forceinline__ void xcd_barrier(const XcdBarrier& b) {
    asm volatile("s_waitcnt vmcnt(0)" ::: "memory");
    __syncthreads();
    if (b.wave == 0 && lane_id() == 0) {
        unsigned* bar = b.bar; asm volatile("" : "+s"(bar));
        __builtin_amdgcn_s_waitcnt(0);
        unsigned nloc = b.st[0], nx = b.st[1];
        if (nloc == 0u) { xcd_barrier_complete(bar, b.x, nloc, nx); b.st[0] = nloc; b.st[1] = nx; }
        const unsigned old = xb_add(&bar[XB_XSUB(b.x)], 1u);
        const unsigned gen = old / nloc;
        if (old + 1u == (gen + 1u) * nloc) {
            __builtin_amdgcn_fence(__ATOMIC_RELEASE, "agent");
            asm volatile("s_waitcnt vmcnt(0)" ::: "memory");
            const unsigned og = xb_add(&bar[XB_TOP], 1u);
            const unsigned tg = og / nx;
            if (og + 1u == (tg + 1u) * nx) xb_add(&bar[XB_TOPGEN], 1u);
            else XB_SPIN(xb_ld(&bar[XB_TOPGEN]) == tg, bar);
            __builtin_amdgcn_fence(__ATOMIC_ACQUIRE, "agent");
            xb_add(&bar[XB_XGEN(b.x)], 1u);
            asm volatile("s_waitcnt vmcnt(0)" ::: "memory");
        } else {
            XB_SPIN(xb_ld(&bar[XB_XGEN(b.x)]) == gen, bar);
            __builtin_amdgcn_fence(__ATOMIC_ACQUIRE, "agent");
            asm volatile("s_waitcnt vmcnt(0)" ::: "memory");
        }
    }
    __syncthreads();
}

struct Args { const float* in[N_INPUTS]; float* out; unsigned char* ws; int ph_lo, ph_hi; };
struct Frame {
    LAS unsigned char* lds;
    int tid, lane, wave, G, bid;
};
constexpr int LDS_ARGT = 131072 + 1024;
__device__ __forceinline__ const float* INP(const Frame& F, int k) {
    const LAS unsigned* t = (const LAS unsigned*)(F.lds + LDS_ARGT) + 2 * k;
    const unsigned lo = __builtin_amdgcn_readfirstlane(t[0]), hi = __builtin_amdgcn_readfirstlane(t[1]);
    return (const float*)(((unsigned long long)hi << 32) | lo);
}
__device__ __forceinline__ float* OUTP(const Frame& F) { return (float*)INP(F, 46); }
__device__ __forceinline__ unsigned char* WSP(const Frame& F) { return (unsigned char*)INP(F, 47); }

namespace pg8 {
constexpr int BM = 256, BK = 64, HALF = 128, HTB = HALF * BK * 2, STAGE_BYTES = 8 * HTB, NXCD = 8, WGM = 8;
__host__ __device__ __forceinline__ int lds_byte(int r, int c) { const int st = (r >> 4) * 2 + (c >> 5), rr = r & 15, cc = c & 31, ob = rr * 64 + cc * 2; return st * 1024 + (ob ^ (((ob >> 9) & 1) << 5)); }
__host__ __device__ __forceinline__ void stage_rc(int b, int& R, int& C) { const int st = b / 1024, sb = b % 1024, swz = sb ^ (((sb >> 9) & 1) << 5); R = (st >> 1) * 16 + swz / 64; C = (st & 1) * 32 + (swz % 64) / 2; }
__host__ __device__ __forceinline__ int perm32(int rho) { const int n = rho >> 4, i = rho & 15; return 8 * (i >> 2) + 4 * n + (i & 3); }

struct Unit { int pm, pn, br; };
struct Gemm { const bf16* A; const bf16* Bt; int lda, ldb, K; int a_br_stride  , a_pair_off  , b_br_tiles  ; };

struct Order {
    int nM, nN, nwg, G, c, nbr;
    __device__ void init(int Mrows, int N, int G_, int c_, int nbr_) { nM = Mrows / BM; nN = N / BM; nwg = nM * nN; G = G_; c = c_; nbr = nbr_; }
    __device__ bool next(int i, Unit& u) const {
        const int it = i / nbr; u.br = i - it * nbr;
        const long L = (long)it * G + c; if (L >= nwg) return false;
        int wgid = (int)L; { const int q = nwg / NXCD, r = nwg % NXCD, xcd = wgid % NXCD, off = wgid / NXCD; wgid = (xcd < r ? xcd * (q + 1) : r * (q + 1) + (xcd - r) * q) + off; }
        const int nig = WGM * nN, gid = wgid / nig, fm = gid * WGM, gsz = (nM - fm) < WGM ? (nM - fm) : WGM;
        u.pm = fm + ((wgid % nig) % gsz); u.pn = (wgid % nig) / gsz; return true;
    }
};
struct Order5 {
    Order o;
    __device__ void init(int Mrows, int G_, int c_) { o.init(Mrows, 20 * BM, G_, c_, 1); }
    __device__ bool next(int i, Unit& u) const { if (!o.next(i, u)) return false; u.br = u.pn >> 2; u.pn &= 3; return true; }
};

template <class Epi, class Sched>
__device__ __forceinline__ void gemm_phase(LAS unsigned char* lds, const Gemm g, const Sched& S, const Epi& E, int wave) {
    int tid = wave * 64 + lane_id(); asm volatile("" : "+v"(tid));
    const int wid = __builtin_amdgcn_readfirstlane(tid >> 6), lane = tid & 63, wr = wid >> 2, wc = wid & 3, fr = lane & 15, fq = lane >> 4;
    const int K = g.K; int nt = K / BK; asm volatile("" : "+s"(nt));
    unsigned voffA[2], voffB[2];
#pragma unroll
    for (int i = 0; i < 2; ++i) { int R, C; stage_rc(tid * 16 + i * 8192, R, C); const int Rb = Epi::PERM ? ((R & ~31) + perm32(R & 31)) : R;
        voffA[i] = (unsigned)(R * g.lda + C) * 2u; voffB[i] = (unsigned)(Rb * g.ldb + C) * 2u; }
    const size_t kstep = (size_t)(BK * 2);
    const size_t hstepA = (size_t)HALF * g.lda * 2, hstepB = (size_t)HALF * g.ldb * 2;
    const unsigned ldsw = (unsigned)wid * 1024u;
    const int aoff = lds_byte(wr * 64 + fr, fq * 8), boff = lds_byte(wc * 32 + fr, fq * 8);
#define PG8_APTR(u) ((const char*)g.A + ((size_t)(u).pm * 256 * g.lda + (size_t)(u).br * g.a_br_stride + (size_t)((u).br >> 1) * g.a_pair_off) * 2)
#define PG8_BPTR(u) ((const char*)g.Bt + ((size_t)((u).br * g.b_br_tiles + (u).pn) * 256 * g.ldb) * 2)
#define PG8_SA(b, h) (((b) * 2 + (h)) * HTB)
#define PG8_SB(b, h) ((4 + (b) * 2 + (h)) * HTB)
#define PG8_STAGE(bufoff, gbase, voff) do { _Pragma("unroll") for (int _i = 0; _i < 2; ++_i) \
        __builtin_amdgcn_global_load_lds((const unsigned*)((const char*)(gbase) + (voff)[_i]), (LAS unsigned*)(lds + (bufoff) + ldsw + _i * 8192), 16, 0, 0); } while (0)
#define PG8_LDA(dst, b, h) do { _Pragma("unroll") for (int m = 0; m < 4; ++m) _Pragma("unroll") for (int k = 0; k < 2; ++k) dst[m][k] = *(const LAS bf16x8*)(lds + PG8_SA(b, h) + aoff + m * 2048 + k * 1024); } while (0)
#define PG8_LDB(dst, b, h) do { _Pragma("unroll") for (int n = 0; n < 2; ++n) _Pragma("unroll") for (int k = 0; k < 2; ++k) dst[n][k] = *(const LAS bf16x8*)(lds + PG8_SB(b, h) + boff + n * 2048 + k * 1024); } while (0)
#define PG8_MMA(ai, bj, At, Bt) do { __builtin_amdgcn_s_setprio(1); _Pragma("unroll") for (int m = 0; m < 4; ++m) _Pragma("unroll") for (int n = 0; n < 2; ++n) _Pragma("unroll") for (int k = 0; k < 2; ++k) \
        acc[ai][bj][m][n] = __builtin_amdgcn_mfma_f32_16x16x32_bf16(Bt[n][k], At[m][k], acc[ai][bj][m][n], 0, 0, 0); __builtin_amdgcn_s_setprio(0); } while (0)
#define PG8_WAIT_V(n) asm volatile("s_waitcnt vmcnt(" #n ")" ::: "memory")
#define PG8_WAIT_L(n) asm volatile("s_waitcnt lgkmcnt(" #n ")" ::: "memory")
#define PG8_BAR __builtin_amdgcn_s_barrier()
#define PG8_SCHED __builtin_amdgcn_sched_barrier(0)
    Unit cur, nxt; int ui = 0;
    if (!S.next(0, cur)) return;
    f32x4 acc[2][2][4][2];
#pragma unroll
    for (int a = 0; a < 2; ++a)
#pragma unroll
        for (int b = 0; b < 2; ++b)
#pragma unroll
            for (int m = 0; m < 4; ++m)
#pragma unroll
                for (int n = 0; n < 2; ++n) acc[a][b][m][n] = (f32x4){0.f, 0.f, 0.f, 0.f};
    bf16x8 At[4][2], B0[2][2], B1[2][2];
    const char* cA = PG8_APTR(cur); const char* cB = PG8_BPTR(cur);
    PG8_STAGE(PG8_SB(0, 0), cB, voffB); PG8_STAGE(PG8_SB(0, 1), cB + hstepB, voffB); PG8_STAGE(PG8_SA(0, 0), cA, voffA); PG8_STAGE(PG8_SA(0, 1), cA + hstepA, voffA);
    if (wr == 1) PG8_BAR;
    PG8_WAIT_V(2); PG8_BAR;
    PG8_STAGE(PG8_SB(1, 0), cB + kstep, voffB); PG8_STAGE(PG8_SA(1, 0), cA + kstep, voffA); PG8_STAGE(PG8_SB(1, 1), cB + hstepB + kstep, voffB);
    PG8_WAIT_V(6); PG8_BAR;
    for (;;) {
        const bool has_next = S.next(ui + 1, nxt);
        const char* nA = has_next ? PG8_APTR(nxt) : cA; const char* nB = has_next ? PG8_BPTR(nxt) : cB;
#pragma unroll 1
        for (int t = 0; t < nt; t += 2) {
            const bool last = (t == nt - 2);
            const char* a1 = cA + (size_t)(t + 1) * kstep;
            const char* a2 = last ? nA : cA + (size_t)(t + 2) * kstep; const char* b2 = last ? nB : cB + (size_t)(t + 2) * kstep;
            const char* a3 = a2 + kstep; const char* b3 = b2 + kstep;
            PG8_LDB(B0, 0, 0); PG8_LDB(B1, 0, 1); PG8_SCHED; PG8_LDA(At, 0, 0); PG8_STAGE(PG8_SA(1, 1), a1 + hstepA, voffA);
            PG8_WAIT_V(8); PG8_WAIT_L(0); PG8_BAR; PG8_MMA(0, 0, At, B0); PG8_MMA(0, 1, At, B1); PG8_BAR; PG8_SCHED;
            PG8_LDA(At, 0, 1); PG8_STAGE(PG8_SB(0, 0), b2, voffB); PG8_STAGE(PG8_SB(0, 1), b2 + hstepB, voffB); PG8_STAGE(PG8_SA(0, 0), a2, voffA);
            PG8_WAIT_V(8); PG8_WAIT_L(0); PG8_BAR; PG8_MMA(1, 0, At, B0); PG8_MMA(1, 1, At, B1); PG8_BAR; PG8_SCHED;
            PG8_LDB(B0, 1, 0); PG8_LDB(B1, 1, 1); PG8_SCHED; PG8_LDA(At, 1, 0); PG8_STAGE(PG8_SA(0, 1), a2 + hstepA, voffA);
            PG8_WAIT_V(8); PG8_WAIT_L(0); PG8_BAR; PG8_MMA(0, 0, At, B0); PG8_MMA(0, 1, At, B1); PG8_BAR; PG8_SCHED;
            PG8_LDA(At, 1, 1); PG8_STAGE(PG8_SB(1, 0), b3, voffB); PG8_STAGE(PG8_SB(1, 1), b3 + hstepB, voffB); PG8_STAGE(PG8_SA(1, 0), a3, voffA);
            PG8_WAIT_V(8); PG8_WAIT_L(0); PG8_BAR; PG8_MMA(1, 0, At, B0); PG8_MMA(1, 1, At, B1); PG8_BAR; PG8_SCHED;
        }
        if (wr == 0) PG8_BAR;
        E(acc, cur, wr, wc, fr, fq);
        if (!has_next) break;
#pragma unroll
        for (int a = 0; a < 2; ++a)
#pragma unroll
            for (int b = 0; b < 2; ++b)
#pragma unroll
                for (int m = 0; m < 4; ++m)
#pragma unroll
                    for (int n = 0; n < 2; ++n) acc[a][b][m][n] = (f32x4){0.f, 0.f, 0.f, 0.f};
        cur = nxt; cA = nA; cB = nB; ++ui;
        if (wr == 1) PG8_BAR;
    }
    PG8_WAIT_V(0);
    PG8_BAR;
#undef PG8_APTR
#undef PG8_BPTR
#undef PG8_SA
#undef PG8_SB
#undef PG8_STAGE
#undef PG8_LDA
#undef PG8_LDB
#undef PG8_MMA
#undef PG8_WAIT_V
#undef PG8_WAIT_L
#undef PG8_BAR
#undef PG8_SCHED
}

__device__ __forceinline__ float mrow_sel(int row) { return 0.f; }
__device__ __forceinline__ int modrow(int row) { return row < NPR ? 0 : 1 + ((row - NPR) >> 11); }

struct EpiProj {
    static constexpr bool PERM = true;
    bf16* proj; float* outk; float* outv; int layer;
    __device__ __forceinline__ void operator()(const f32x4 (&acc)[2][2][4][2], const Unit& u, int wr, int wc, int fr, int fq) const {
        { int t_ = lane_id(); asm volatile("" : "+v"(t_)); fr = t_ & 15; fq = (t_ >> 4) & 3; }
        const int row0 = u.pm * BM + wr * 64 + fr, colb = u.pn * BM + wc * 32 + 8 * fq;
        const int mode = (u.pn == 60) ? 1 : (u.pn == 61 ? 2 : ((u.pn >= 36) ? 3 : 0));
        const bool kv = (u.pm < 32) && (u.pn >= 4) && (u.pn < 12);
#pragma unroll
        for (int ai = 0; ai < 2; ++ai)
#pragma unroll
            for (int m = 0; m < 4; ++m) {
                const int row = row0 + ai * HALF + m * 16;
                bf16* rowp = proj + (size_t)row * NPROJ + colb;
#pragma unroll
                for (int bj = 0; bj < 2; ++bj) {
                    f32x4 v0 = acc[ai][bj][m][0], v1 = acc[ai][bj][m][1];
                    if (mode == 1) { if (colb + bj * HALF < COL_G1A) {
#pragma unroll
                        for (int j = 0; j < 4; ++j) { v0[j] = tanhf(v0[j]); v1[j] = tanhf(v1[j]); } } }
                    else if (mode == 3) {
#pragma unroll
                        for (int j = 0; j < 4; ++j) { v0[j] = sigmoidf_(v0[j]); v1[j] = sigmoidf_(v1[j]); } }
                    else if (mode == 2) { const bool act = (colb + bj * HALF) < 15744;
#pragma unroll
                        for (int j = 0; j < 4; ++j) { v0[j] = act ? sigmoidf_(v0[j]) : 0.f; v1[j] = act ? sigmoidf_(v1[j]) : 0.f; } }
                    u32x4 w; w.x = cvtpk(v0[0], v0[1]); w.y = cvtpk(v0[2], v0[3]); w.z = cvtpk(v1[0], v1[1]); w.w = cvtpk(v1[2], v1[3]);
                    *(u32x4*)(rowp + bj * HALF) = w;
                    if (kv) { const int col = colb + bj * HALF; float* ob = (u.pn < 8) ? outk : outv; const int ch = col - ((u.pn < 8) ? COL_K : COL_V);
                        float* dst = ob + ((size_t)(((row >> 8) * 4 + layer) * 256 + (row & 255))) * 1024 + ch;
                        *(f32x4*)dst = v0; *(f32x4*)(dst + 4) = v1; }
                }
            }
    }
};
struct EpiLora2 {
    static constexpr bool PERM = true;
    bf16* dec; bf16* abuf; bf16* gbuf; const float* w0; const float* a0;
    __device__ __forceinline__ void operator()(const f32x4 (&acc)[2][2][4][2], const Unit& u, int wr, int wc, int fr, int fq) const {
        { int t_ = lane_id(); asm volatile("" : "+v"(t_)); fr = t_ & 15; fq = (t_ >> 4) & 3; }
        const int row0 = u.pm * BM + wr * 64 + fr, colb = u.pn * BM + wc * 32 + 8 * fq;
        const int br = u.br, e = br & 1;
        const float* bsrc = (br < 2) ? w0 + e * 1024 : a0 + e * 1024;
#pragma unroll
        for (int bj = 0; bj < 2; ++bj)
#pragma unroll
            for (int n = 0; n < 2; ++n) {
                const int ch = colb + bj * HALF + 4 * n;
                f32x4 b0 = (f32x4){0.f, 0.f, 0.f, 0.f};
                if (br < 4) b0 = *(const f32x4*)(bsrc + ch);
#pragma unroll
                for (int ai = 0; ai < 2; ++ai)
#pragma unroll
                    for (int m = 0; m < 4; ++m) {
                        const int row = row0 + ai * HALF + m * 16;
                        f32x4 v0 = acc[ai][bj][m][n] + b0;
                        if (br < 2) {
#pragma unroll
                            for (int j = 0; j < 4; ++j) v0[j] = -0.6065306597126334f * sigmoidf_(v0[j]);
                            *(u32x2*)(dec + ((size_t)row * 2 + e) * 1024 + ch) = (u32x2){cvtpk(v0[0], v0[1]), cvtpk(v0[2], v0[3])};
                        } else {
                            if (br < 4) {
#pragma unroll
                                for (int j = 0; j < 4; ++j) v0[j] = sigmoidf_(v0[j]); }
                            bf16* dst = (br < 4) ? abuf + ((size_t)row * 2 + e) * 1024 + ch : gbuf + (size_t)row * 1024 + ch;
                            *(u32x2*)dst = (u32x2){cvtpk(v0[0], v0[1]), cvtpk(v0[2], v0[3])};
                        }
                        __builtin_amdgcn_sched_barrier(0);
                    }
            }
    }
};
struct EpiMerge {
    static constexpr bool PERM = true;
    const bf16* proj; bf16* merged;
    __device__ __forceinline__ void operator()(const f32x4 (&acc)[2][2][4][2], const Unit& u, int wr, int wc, int fr, int fq) const {
        { int t_ = lane_id(); asm volatile("" : "+v"(t_)); fr = t_ & 15; fq = (t_ >> 4) & 3; }
        const int row0 = u.pm * BM + wr * 64 + fr, colb = u.pn * BM + wc * 32 + 8 * fq;
        const int br = u.br;
#pragma unroll
        for (int ai = 0; ai < 2; ++ai)
#pragma unroll
            for (int m = 0; m < 4; ++m) {
                const int row = row0 + ai * HALF + m * 16;
#pragma unroll
                for (int bj = 0; bj < 2; ++bj) {
                    const int col = colb + bj * HALF;
                    const u32x4 gw = *(const u32x4*)(proj + (size_t)row * NPROJ + COL_GL + br * 2048 + col);
                    bf16* dst = merged + (size_t)row * D + col;
                    f32x4 v0 = acc[ai][bj][m][0], v1 = acc[ai][bj][m][1];
                    v0[0] *= bflo(gw.x); v0[1] *= bfhi(gw.x); v0[2] *= bflo(gw.y); v0[3] *= bfhi(gw.y);
                    v1[0] *= bflo(gw.z); v1[1] *= bfhi(gw.z); v1[2] *= bflo(gw.w); v1[3] *= bfhi(gw.w);
                    if (br > 0) { const u32x4 pw = *(const u32x4*)dst;
                        v0[0] += bflo(pw.x); v0[1] += bfhi(pw.x); v0[2] += bflo(pw.y); v0[3] += bfhi(pw.y);
                        v1[0] += bflo(pw.z); v1[1] += bfhi(pw.z); v1[2] += bflo(pw.w); v1[3] += bfhi(pw.w); }
                    u32x4 w; w.x = cvtpk(v0[0], v0[1]); w.y = cvtpk(v0[2], v0[3]); w.z = cvtpk(v1[0], v1[1]); w.w = cvtpk(v1[2], v1[3]);
                    *(u32x4*)dst = w;
                }
            }
    }
};
struct EpiResid {
    static constexpr bool PERM = false;
    float* x; const float* gate;   const float* bias; float gscale;
    __device__ __forceinline__ void operator()(const f32x4 (&acc)[2][2][4][2], const Unit& u, int wr, int wc, int fr, int fq) const {
        { int t_ = lane_id(); asm volatile("" : "+v"(t_)); fr = t_ & 15; fq = (t_ >> 4) & 3; }
        const int row0 = u.pm * BM + wr * 64 + fr, col0 = u.pn * BM + wc * 32 + 4 * fq;
        const int mr = modrow(u.pm * BM);
        const float* gp = gate + (size_t)mr * 12288;
        f32x4 gv[2][2], bv[2][2];
#pragma unroll
        for (int bj = 0; bj < 2; ++bj)
#pragma unroll
            for (int n = 0; n < 2; ++n) { gv[bj][n] = *(const f32x4*)(gp + col0 + bj * HALF + n * 16) * gscale;
                bv[bj][n] = bias ? *(const f32x4*)(bias + col0 + bj * HALF + n * 16) : (f32x4){0.f, 0.f, 0.f, 0.f}; }
#pragma unroll
        for (int ai = 0; ai < 2; ++ai)
#pragma unroll
            for (int m = 0; m < 4; ++m) { float* rowp = x + (size_t)(row0 + ai * HALF + m * 16) * D + col0;
#pragma unroll
                for (int bj = 0; bj < 2; ++bj)
#pragma unroll
                    for (int n = 0; n < 2; ++n) { f32x4* p = (f32x4*)(rowp + bj * HALF + n * 16); const f32x4 xo = *p; *p = xo + gv[bj][n] * (acc[ai][bj][m][n] + bv[bj][n]); }
                asm volatile("" ::: "memory"); }
    }
};
struct EpiFF1 {
    static constexpr bool PERM = true;
    bf16* U; const float* bias;
    __device__ __forceinline__ void operator()(const f32x4 (&acc)[2][2][4][2], const Unit& u, int wr, int wc, int fr, int fq) const {
        { int t_ = lane_id(); asm volatile("" : "+v"(t_)); fr = t_ & 15; fq = (t_ >> 4) & 3; }
        const int row0 = u.pm * BM + wr * 64 + fr, colb = u.pn * BM + wc * 32 + 8 * fq;
        f32x4 bv[2][2];
#pragma unroll
        for (int bj = 0; bj < 2; ++bj)
#pragma unroll
            for (int n = 0; n < 2; ++n) bv[bj][n] = *(const f32x4*)(bias + colb + bj * HALF + 4 * n);
#pragma unroll
        for (int ai = 0; ai < 2; ++ai)
#pragma unroll
            for (int m = 0; m < 4; ++m) { bf16* rowp = U + (size_t)(row0 + ai * HALF + m * 16) * DFF + colb;
#pragma unroll
                for (int bj = 0; bj < 2; ++bj) { f32x4 v0 = acc[ai][bj][m][0] + bv[bj][0], v1 = acc[ai][bj][m][1] + bv[bj][1];
#pragma unroll
                    for (int j = 0; j < 4; ++j) { const float a = fmaxf(v0[j], 0.f), b = fmaxf(v1[j], 0.f); v0[j] = a * a; v1[j] = b * b; }
                    u32x4 w; w.x = cvtpk(v0[0], v0[1]); w.y = cvtpk(v0[2], v0[3]); w.z = cvtpk(v1[0], v1[1]); w.w = cvtpk(v1[2], v1[3]);
                    *(u32x4*)(rowp + bj * HALF) = w; } }
    }
};
}

__device__ __forceinline__ void transpose_item(const float* W, int K, int N, bf16* WT, int ldk, int row_off, LAS bf16* scr, int item, int lane) {
    const int nblk = N / 64, kb = item / nblk, nb = item % nblk, k0 = 32 * kb, n = 64 * nb + lane;
    const float* src = W + (size_t)k0 * N + n;
    float v[32];
#pragma unroll
    for (int i = 0; i < 32; ++i) v[i] = src[(size_t)i * N];
    bf16* dst = WT + (size_t)(row_off + n) * ldk + k0;
#pragma unroll
    for (int q = 0; q < 4; ++q) *(u32x4*)(dst + 8 * q) = (u32x4){cvtpk(v[8 * q], v[8 * q + 1]), cvtpk(v[8 * q + 2], v[8 * q + 3]), cvtpk(v[8 * q + 4], v[8 * q + 5]), cvtpk(v[8 * q + 6], v[8 * q + 7])};
    (void)scr; (void)K;
}

__device__ __forceinline__ void convert_layer(const Frame& F, int l, LAS bf16* scr, int gw, int NGW) {
    unsigned char* ws = WSP(F);
        bf16* WinT = (bf16*)(ws + WS_WIN) + (size_t)l * NPROJ * D;
        {   const int n_items = (D / 32) * (15360 / 64); const float* W = INP(F, I_WIN) + (size_t)l * D * 15360;
            for (int it = gw; it < n_items; it += NGW) transpose_item(W, D, 15360, WinT, D, 0, scr, it, F.lane); }
        for (int e = 0; e < 2; ++e) {
            const int n_items = (D / 32);
            const float* W1 = INP(F, I_W1) + ((size_t)l * 2 + e) * D * 64; const float* A1 = INP(F, I_A1) + ((size_t)l * 2 + e) * D * 64;
            for (int it = gw; it < n_items; it += NGW) { transpose_item(W1, D, 64, WinT, D, COL_LW + e * 64, scr, it, F.lane); transpose_item(A1, D, 64, WinT, D, COL_LW + 128 + e * 64, scr, it, F.lane); }
        }
        {   const int n_items = (D / 32) * 2; const float* W = INP(F, I_G1) + (size_t)l * D * 128;
            for (int it = gw; it < n_items; it += NGW) transpose_item(W, D, 128, WinT, D, COL_LW + 256, scr, it, F.lane); }
        for (int i = gw * 64 + F.lane; i < 128 * D / 8; i += NGW * 64) ((u32x4*)(WinT + (size_t)15744 * D))[i] = (u32x4){0u, 0u, 0u, 0u};
        for (int br = 0; br < 3; ++br) { const float* W = INP(F, I_WPA + br) + (size_t)l * 1024 * D; bf16* WT = (bf16*)(ws + WS_WP) + ((size_t)l * 3 + br) * D * 1024;
            const int n_items = (1024 / 32) * (D / 64);
            for (int it = gw; it < n_items; it += NGW) transpose_item(W, 1024, D, WT, 1024, 0, scr, it, F.lane); }
        {   const float* W = INP(F, I_WOUT) + (size_t)l * D * D; bf16* WT = (bf16*)(ws + WS_WOUT) + (size_t)l * D * D; const int n_items = (D / 32) * (D / 64);
            for (int it = gw; it < n_items; it += NGW) transpose_item(W, D, D, WT, D, 0, scr, it, F.lane); }
        {   const float* W = INP(F, I_FF1) + (size_t)l * D * DFF; bf16* WT = (bf16*)(ws + WS_WFF1) + (size_t)l * D * DFF; const int n_items = (D / 32) * (DFF / 64);
            for (int it = gw; it < n_items; it += NGW) transpose_item(W, D, DFF, WT, D, 0, scr, it, F.lane); }
        {   const float* W = INP(F, I_FF2) + (size_t)l * D * DFF; bf16* WT = (bf16*)(ws + WS_WFF2) + (size_t)l * D * DFF; const int n_items = (DFF / 32) * (D / 64);
            for (int it = gw; it < n_items; it += NGW) transpose_item(W, DFF, D, WT, DFF, 0, scr, it, F.lane); }
        {   bf16* W2T = (bf16*)(ws + WS_W2T) + (size_t)l * 5120 * 128;
            const float* w2 = INP(F, I_W2) + (size_t)l * 2 * 64 * 1024; const float* a2 = INP(F, I_A2) + (size_t)l * 2 * 64 * 1024; const float* g2 = INP(F, I_G2) + (size_t)l * 128 * 1024;
            for (int it = gw; it < 32 * 6; it += NGW) { const int m = it / 32, sub = it % 32;
                const float* W = m == 0 ? w2 : (m == 1 ? w2 + 65536 : (m == 2 ? a2 : (m == 3 ? a2 + 65536 : (m == 4 ? g2 : g2 + 65536))));
                const int br = m < 4 ? m : 4, koff = m < 4 ? 64 * (m & 1) : (m == 4 ? 0 : 64);
                transpose_item(W, 64, 1024, W2T + (size_t)br * 1024 * 128 + koff, 128, 0, scr, sub, F.lane); }
            for (int i = gw * 64 + F.lane; i < 4096 * 8; i += NGW * 64) { const int n = i >> 3, k8 = (i & 7) * 8, br = n >> 10;
                *(u32x4*)(W2T + (size_t)n * 128 + ((br & 1) ? 0 : 64) + k8) = (u32x4){0u, 0u, 0u, 0u}; }
        }
    }

__device__ __forceinline__ void prologue0(const Frame& F, const Args& a) {
    unsigned char* ws = WSP(F);
    LAS bf16* scr = (LAS bf16*)(F.lds + F.wave * 16384);
    const int gw = F.bid * 8 + F.wave, NGW = F.G * 8;
    convert_layer(F, 0, scr, gw, NGW);
    {   const float* ck = INP(F, I_CK); const float* cv = INP(F, I_CV); bf16* ok = (bf16*)(ws + WS_CK); bf16* ov = (bf16*)(ws + WS_CV);
        const int n4 = 4 * 4 * 256 * 1024 / 4;
        for (int i = gw * 64 + F.lane; i < n4; i += NGW * 64) { const f32x4 x = ((const f32x4*)ck)[i], y = ((const f32x4*)cv)[i];
            ((u32x2*)ok)[i] = (u32x2){cvtpk(x[0], x[1]), cvtpk(x[2], x[3])}; ((u32x2*)ov)[i] = (u32x2){cvtpk(y[0], y[1]), cvtpk(y[2], y[3])}; }
    }
    {   LAS float* sv = (LAS float*)(F.lds + 65536);
        __syncthreads();
        for (int i = F.tid; i < 5 * D; i += 512) { const int r = i / D, d = i - r * D; const float x = (r == 0) ? INP(F, I_CCTX)[d] : INP(F, I_C)[(r - 1) * D + d]; sv[i] = x / (1.0f + __expf(-x)); }
        __syncthreads();
        float* PART = (float*)(ws + WS_Q);
        const int n_items = DEPTH * 48 * 8;
        for (int it = gw; it < n_items; it += NGW) {
            const int l = it / 384, rem = it % 384, jc = rem >> 3, ds = rem & 7, j4 = jc * 256 + 4 * F.lane;
            const float* W = INP(F, I_WMOD) + (size_t)l * D * 12288 + (size_t)(ds * 256) * 12288 + j4;
            f32x4 acc[5];
#pragma unroll
            for (int r = 0; r < 5; ++r) acc[r] = (f32x4){0.f, 0.f, 0.f, 0.f};
#pragma unroll 4
            for (int d = 0; d < 256; d += 4) {
                f32x4 w[4];
#pragma unroll
                for (int q = 0; q < 4; ++q) w[q] = *(const f32x4*)(W + (size_t)(d + q) * 12288);
#pragma unroll
                for (int r = 0; r < 5; ++r) { const f32x4 s = *(const LAS f32x4*)(sv + r * D + ds * 256 + d);
#pragma unroll
                    for (int q = 0; q < 4; ++q) acc[r] += w[q] * s[q]; }
            }
#pragma unroll
            for (int r = 0; r < 5; ++r) *(f32x4*)(PART + (((size_t)ds * 4 + l) * 5 + r) * 12288 + j4) = acc[r];
        }
        __syncthreads();
    }
    {   float* T2 = (float*)(ws + WS_T2);
        const int n_items = DEPTH * (L_S + L_P);
        for (int it = gw; it < n_items; it += NGW) {
            const int l = it / (L_S + L_P), rr = it % (L_S + L_P), sel = rr < L_S ? 0 : 1, t = sel ? rr - L_S : rr, L = sel ? L_P : L_S;
            float zf = 0.f;
            {   const float tt = (float)t / (float)(L - 1);
                const float w = (6.283185307179586f * (float)t) / (float)L;
                const int band = (F.lane - 1) & 15;
                const float f = 1e-4f + (float)band * ((15.0f - 1e-4f) / 15.0f);
                const float fw = f * w;
                const double rd = (double)fw - 6.283185307179586 * rint((double)fw * 0.15915494309189535);
                const float rf = (float)rd;
                zf = (F.lane == 0) ? tt : (F.lane <= 16 ? __cosf(rf) : -__sinf(rf));
            }
            const float* f1 = INP(F, I_F1) + (size_t)l * 33 * 64; const float* f2 = INP(F, I_F2) + (size_t)l * 64 * 64;
            const float fq = INP(F, I_FREQ)[l * 64 + F.lane];
            float s = INP(F, I_FB1)[l * 64 + F.lane];
            for (int i = 0; i < 33; ++i) s += __int_as_float(__builtin_amdgcn_readlane(__float_as_int(zf), i)) * f1[i * 64 + F.lane];
            float x = fq * s; { const double rd = (double)x - 6.283185307179586 * rint((double)x * 0.15915494309189535); x = (float)rd; }
            const float t1 = __sinf(x);
            float s2 = INP(F, I_FB2)[l * 64 + F.lane];
            for (int i = 0; i < 64; ++i) s2 += __int_as_float(__builtin_amdgcn_readlane(__float_as_int(t1), i)) * f2[i * 64 + F.lane];
            float y = fq * s2; { const double rd = (double)y - 6.283185307179586 * rint((double)y * 0.15915494309189535); y = (float)rd; }
            T2[(((size_t)l * 2 + sel) * L_S + t) * 64 + F.lane] = __sinf(y);
        }
    }
    {   bf16* FS = (bf16*)(ws + WS_FS); bf16* FP = (bf16*)(ws + WS_FP);
        for (int i = gw * 64 + F.lane; i < DEPTH * 1024 * 72; i += NGW * 64) { const int row = i / 72, p = i % 72; const int m = p < 32 ? p : p - 32 + 32;
            FS[(size_t)row * LPS + (p < 32 ? p : L_S + p)] = 0; FP[(size_t)row * LPP + (p < 32 ? p : L_P + p)] = 0; (void)m; }
    }
}

__device__ __forceinline__ void prologue1(const Frame& F, const Args& a) {
    unsigned char* ws = WSP(F);
    const int gw = F.bid * 8 + F.wave, NGW = F.G * 8;
    {   const float* PART = (const float*)(ws + WS_Q); float* MOD = (float*)(ws + WS_MOD);
        for (int i = (F.bid * 8 + F.wave) * 64 + F.lane; i < DEPTH * 5 * 12288 / 4; i += F.G * 8 * 64) {
            const int l = i / (5 * 3072), j4 = (i % 3072) * 4;
            f32x4 s = *(const f32x4*)(INP(F, I_BMOD) + l * 12288 + j4);
#pragma unroll
            for (int ds = 0; ds < 8; ++ds) s += ((const f32x4*)PART)[(size_t)ds * (DEPTH * 5 * 3072) + i];
            ((f32x4*)MOD)[i] = s; }
    }
    const float* T2 = (const float*)(ws + WS_T2);
    float* FNORM = (float*)(ws + WS_CTL) + CW_FNORM;
    const int items_s = DEPTH * 16 * (L_S / 64), items_p = DEPTH * 16 * (L_P / 64);
    for (int it = gw; it < items_s + items_p; it += NGW) {
        int sel, l, cg, tc;
        if (it < items_s) { sel = 0; l = it / (16 * 32); cg = (it / 32) % 16; tc = it % 32; } else { const int r = it - items_s; sel = 1; l = r / (16 * 4); cg = (r / 4) % 16; tc = r % 4; }
        const int L = sel ? L_P : L_S, c = cg * 64 + F.lane;
        const float* f3 = INP(F, I_F3) + (size_t)l * 64 * 1024 + c;
        float w3[64];
#pragma unroll
        for (int j = 0; j < 64; ++j) w3[j] = f3[(size_t)j * 1024];
        const float delta = fabsf(-3.0701134573253946f + (float)c * ((-15.350567286626973f + 3.0701134573253946f) / 1023.0f));
        bf16* dst = sel ? (bf16*)(ws + WS_FP) + ((size_t)l * 1024 + c) * LPP : (bf16*)(ws + WS_FS) + ((size_t)l * 1024 + c) * LPS;
        float asum = 0.f;
        for (int tt = 0; tt < 64; ++tt) {
            const int t = tc * 64 + tt;
            const float tv = T2[(((size_t)l * 2 + sel) * L_S + t) * 64 + F.lane];
            float s = 0.f;
#pragma unroll
            for (int j = 0; j < 64; ++j) s += __int_as_float(__builtin_amdgcn_readlane(__float_as_int(tv), j)) * w3[j];
            const float dist = fabsf((float)(t - L / 2)) / (float)L;
            const float fv = s * __expf(-dist * delta);
            asum += fabsf(fv);
            dst[32 + (L - 1 - t)] = f2bf(fv);
        }
        atomicAdd(FNORM + ((size_t)l * 2 + sel) * 1024 + c, asum);
    }
}

__device__ __forceinline__ void norm_phase(const Frame& F, const float* xp, const float* xs, float* xcopy, const float* g, const float* mod, int i_sh, int i_sc, bf16* hout) {
    const int gw = F.bid * 8 + F.wave, NGW = F.G * 8;
    for (int row = gw; row < M; row += NGW) {
        const float* xr = row < NPR ? xp + (size_t)row * D : xs + (size_t)(row - NPR) * D;
        const float* mr = mod + (size_t)pg8::modrow(row) * 12288;
        f32x4 v[8]; float ss = 0.f;
#pragma unroll
        for (int j = 0; j < 8; ++j) { v[j] = ((const f32x4*)xr)[F.lane + 64 * j]; ss += (v[j][0] * v[j][0] + v[j][1] * v[j][1]) + (v[j][2] * v[j][2] + v[j][3] * v[j][3]); }
        const float rstd = 1.0f / sqrtf(wave_sum(ss) * (1.0f / D) + 1e-6f);
        if (xcopy) {
#pragma unroll
            for (int j = 0; j < 8; ++j) ((f32x4*)(xcopy + (size_t)row * D))[F.lane + 64 * j] = v[j]; }
#pragma unroll
        for (int j = 0; j < 8; ++j) {
            const f32x4 gg = ((const f32x4*)g)[F.lane + 64 * j], sc = ((const f32x4*)(mr + i_sc * D))[F.lane + 64 * j], sh = ((const f32x4*)(mr + i_sh * D))[F.lane + 64 * j];
            const f32x4 o = v[j] * rstd * gg * (1.0f + sc) + sh;
            ((u32x2*)(hout + (size_t)row * D))[F.lane + 64 * j] = (u32x2){cvtpk(o[0], o[1]), cvtpk(o[2], o[3])};
        }
    }
}
__device__ __forceinline__ void final_norm_phase(const Frame& F, float* x, const float* g) {
    const int gw = F.bid * 8 + F.wave, NGW = F.G * 8;
    for (int row = gw; row < M; row += NGW) {
        float* xr = x + (size_t)row * D;
        f32x4 v[8]; float ss = 0.f;
#pragma unroll
        for (int j = 0; j < 8; ++j) { v[j] = ((const f32x4*)xr)[F.lane + 64 * j]; ss += (v[j][0] * v[j][0] + v[j][1] * v[j][1]) + (v[j][2] * v[j][2] + v[j][3] * v[j][3]); }
        const float rstd = 1.0f / sqrtf(wave_sum(ss) * (1.0f / D) + 1e-6f);
#pragma unroll
        for (int j = 0; j < 8; ++j) { const f32x4 gg = ((const f32x4*)g)[F.lane + 64 * j]; ((f32x4*)xr)[F.lane + 64 * j] = v[j] * rstd * gg; }
    }
}

__device__ __forceinline__ s16x4 vtr(const LAS unsigned char* p) { return __builtin_bit_cast(s16x4, __builtin_amdgcn_ds_read_tr16_b64_v4i16((LAS s16x4*)p)); }

struct AttnState { float m, l; f32x16 o[2]; };

__device__ __forceinline__ void attn_loadk(bf16x8 (&kf)[2][4], const bf16* kbase, size_t kstride, int lane) {
    const bf16* kp = kbase + (size_t)(lane & 31) * kstride + 8 * (lane >> 5);
#pragma unroll
    for (int kt = 0; kt < 2; ++kt)
#pragma unroll
        for (int ks = 0; ks < 4; ++ks) kf[kt][ks] = *(const bf16x8*)(kp + (size_t)(32 * kt) * kstride + 16 * ks);
}
template <bool HASB, class BIAS>
__device__ __forceinline__ void attend64(AttnState& st, const bf16x8 (&qf)[4], bf16x8 (&kf)[2][4], const bf16* knext, size_t knstride, const LAS unsigned char* vb, const BIAS& bias, int lane) {
    constexpr int NT = 2;
    const int h = lane >> 5;
    f32x16 s[NT];
#pragma unroll
    for (int kt = 0; kt < NT; ++kt) {
        f32x16 acc;
#pragma unroll
        for (int i = 0; i < 16; ++i) acc[i] = 0.f;
#pragma unroll
        for (int ks = 0; ks < 4; ++ks) acc = __builtin_amdgcn_mfma_f32_32x32x16_bf16(kf[kt][ks], qf[ks], acc, 0, 0, 0);
        s[kt] = acc;
    }
    if (knext) attn_loadk(kf, knext, knstride, lane);
    float gm = -3.0e38f;
#pragma unroll
    for (int kt = 0; kt < NT; ++kt)
#pragma unroll
        for (int i = 0; i < 16; ++i) {
            float v = s[kt][i] * 0.125f;
            if (HASB) v = bias(kt, (i & 3) + 8 * (i >> 2) + 4 * h, v);
            s[kt][i] = v; gm = fmaxf(gm, v);
        }
    gm = fmaxf(gm, xor32(gm, lane));
    const float mnew = fmaxf(st.m, gm);
    const float alpha = __expf(st.m - mnew);
    float ps = 0.f;
#pragma unroll
    for (int kt = 0; kt < NT; ++kt)
#pragma unroll
        for (int i = 0; i < 16; ++i) { const float p = __expf(s[kt][i] - mnew); s[kt][i] = p; ps += p; }
    st.l = st.l * alpha + ps; st.m = mnew;
#pragma unroll
    for (int i = 0; i < 16; ++i) { st.o[0][i] *= alpha; st.o[1][i] *= alpha; }
    const int i16 = lane & 15, tq = i16 >> 2, tp = i16 & 3, blk = (lane >> 4) & 1;
#pragma unroll
    for (int kt = 0; kt < NT; ++kt) {
#pragma unroll
        for (int ss = 0; ss < 2; ++ss) {
            u32x4 pw; pw.x = cvtpk(s[kt][8 * ss + 0], s[kt][8 * ss + 1]); pw.y = cvtpk(s[kt][8 * ss + 2], s[kt][8 * ss + 3]); pw.z = cvtpk(s[kt][8 * ss + 4], s[kt][8 * ss + 5]); pw.w = cvtpk(s[kt][8 * ss + 6], s[kt][8 * ss + 7]);
            const bf16x8 pf = __builtin_bit_cast(bf16x8, pw);
#pragma unroll
            for (int dt = 0; dt < 2; ++dt) {
                const LAS unsigned char* p0 = vb + kt * 4096 + (16 * ss + 4 * h + tq) * 128 + (dt * 32 + 16 * blk + 4 * tp) * 2;
                const s16x4 lo = vtr(p0), hi = vtr(p0 + 8 * 128);
                const bf16x8 vf = __builtin_shufflevector(lo, hi, 0, 1, 2, 3, 4, 5, 6, 7);
                st.o[dt] = __builtin_amdgcn_mfma_f32_32x32x16_bf16(vf, pf, st.o[dt], 0, 0, 0);
            }
        }
    }
}

__device__ __forceinline__ void attn_store(const AttnState& st, bf16* orow  , int lane) {
    const int h = lane >> 5;
    const float lt = st.l + xor32(st.l, lane);
    const float inv = 1.0f / lt;
#pragma unroll
    for (int dt = 0; dt < 2; ++dt)
#pragma unroll
        for (int g = 0; g < 4; ++g) {
            const u32x2 w = (u32x2){cvtpk(st.o[dt][4 * g] * inv, st.o[dt][4 * g + 1] * inv), cvtpk(st.o[dt][4 * g + 2] * inv, st.o[dt][4 * g + 3] * inv)};
            *(u32x2*)(orow + dt * 32 + 8 * g + 4 * h) = w;
        }
}

__device__ __forceinline__ void attention_phase(const Frame& F, const Args& a, int layer) {
    unsigned char* ws = WSP(F);
    const bf16* proj = (const bf16*)(ws + WS_PROJ);
    bf16* oall = (bf16*)(ws + WS_OALL);
    const int lane = F.lane, w = F.wave, r = lane & 31, h = lane >> 5;
    LAS unsigned char* lds = F.lds;
    LAS float* rpbl = (LAS float*)(lds + 122880);
    for (int u = F.bid; u < 1024; u += F.G) {
        __syncthreads();
        if (u < 512) {
            const int b = u >> 4, hd = u & 15;
            const int tok0 = b * 256;
            for (int i = F.tid; i < 256 * 8; i += 512) { const int key = i >> 3, pc = i & 7;
                *(LAS u32x4*)(lds + key * 128 + pc * 16) = *(const u32x4*)(proj + (size_t)(tok0 + key) * NPROJ + COL_V + hd * 64 + pc * 8); }
            __syncthreads();
            bf16x8 qf[4];
            { const bf16* qp = proj + (size_t)(tok0 + 32 * w + r) * NPROJ + hd * 64 + 8 * h;
#pragma unroll
              for (int ks = 0; ks < 4; ++ks) qf[ks] = *(const bf16x8*)(qp + 16 * ks); }
            AttnState st; st.m = -3.0e38f; st.l = 0.f;
#pragma unroll
            for (int i = 0; i < 16; ++i) { st.o[0][i] = 0.f; st.o[1][i] = 0.f; }
            const bf16* kbase = proj + (size_t)tok0 * NPROJ + COL_K + hd * 64;
            bf16x8 kf[2][4];
            attn_loadk(kf, kbase, (size_t)NPROJ, lane);
#pragma unroll 1
            for (int kg = 0; kg < 4; ++kg)
                attend64<false>(st, qf, kf, kg < 3 ? kbase + (size_t)(64 * (kg + 1)) * NPROJ : nullptr, (size_t)NPROJ, lds + kg * 8192, [&](int, int, float v) { return v; }, lane);
            attn_store(st, oall + (size_t)(tok0 + 32 * w + r) * 3072 + hd * 64, lane);
        } else {
            const int uu = u - 512, b = uu >> 7, hd = (uu >> 3) & 15, rg = uu & 7;
            const int tokb = NPR + b * 2048;
            int rlo = 4 * rg - 4; rlo = rlo < 0 ? 0 : (rlo > 24 ? 24 : rlo);
            int rhi0 = 4 * rg + 3 - 4; rhi0 = rhi0 < 0 ? 0 : (rhi0 > 24 ? 24 : rhi0); const int nr = rhi0 + 8 - rlo;
            for (int i = F.tid; i < nr * 64 * 8; i += 512) { const int key = i >> 3, pc = i & 7;
                *(LAS u32x4*)(lds + key * 128 + pc * 16) = *(const u32x4*)(proj + (size_t)(tokb + rlo * 64 + key) * NPROJ + COL_V + hd * 64 + pc * 8); }
            const bf16* cv = (const bf16*)(ws + WS_CV) + ((size_t)(b * 4 + layer) * 256) * 1024 + hd * 64;
            const bf16* ck = (const bf16*)(ws + WS_CK) + ((size_t)(b * 4 + layer) * 256) * 1024 + hd * 64;
            for (int i = F.tid; i < 256 * 8; i += 512) { const int key = i >> 3, pc = i & 7;
                *(LAS u32x4*)(lds + 90112 + key * 128 + pc * 16) = *(const u32x4*)(cv + (size_t)key * 1024 + pc * 8); }
            for (int i = F.tid; i < 465; i += 512) rpbl[i] = INP(F, I_RPB)[((size_t)layer * 16 + hd) * 465 + i];
            __syncthreads();
            const int qrow = 4 * rg + (w >> 1), qc = (w & 1) * 32 + r;
            int r0 = qrow - 4; r0 = r0 < 0 ? 0 : (r0 > 24 ? 24 : r0);
            int c0 = qc - 8; c0 = c0 < 0 ? 0 : (c0 > 48 ? 48 : c0);
            const int qtok = tokb + qrow * 64 + (w & 1) * 32 + r;
            bf16x8 qf[4];
            { const bf16* qp = proj + (size_t)qtok * NPROJ + hd * 64 + 8 * h;
#pragma unroll
              for (int ks = 0; ks < 4; ++ks) qf[ks] = *(const bf16x8*)(qp + 16 * ks); }
            AttnState st; st.m = -3.0e38f; st.l = 0.f;
#pragma unroll
            for (int i = 0; i < 16; ++i) { st.o[0][i] = 0.f; st.o[1][i] = 0.f; }
            const bf16* kloc = proj + (size_t)tokb * NPROJ + COL_K + hd * 64;
            bf16x8 kf[2][4];
            attn_loadk(kf, kloc + (size_t)(r0 * 64) * NPROJ, (size_t)NPROJ, lane);
#pragma unroll 1
            for (int grp = 0; grp < 12; ++grp) {
                const bf16* knext = grp < 7 ? kloc + (size_t)((r0 + grp + 1) * 64) * NPROJ : (grp < 11 ? ck + (size_t)((grp - 7) * 64) * 1024 : nullptr);
                const size_t knstride = grp < 7 ? (size_t)NPROJ : (size_t)1024;
                if (grp < 8) { const int kr = r0 + grp;
                    attend64<true>(st, qf, kf, knext, knstride, lds + ((kr - rlo) * 64) * 128,
                        [&](int kt, int kin, float v) { const int kc = kt * 32 + kin; const bool ok = (kc >= c0) && (kc < c0 + 16);
                            const int dr = kr - qrow + 7, dc = kc - qc + 15; const int idx = ok ? dr * 31 + dc : 0; return ok ? v + rpbl[idx] : -1.0e30f; }, lane);
                } else attend64<false>(st, qf, kf, knext, knstride, lds + 90112 + (grp - 8) * 8192, [&](int, int, float v) { return v; }, lane);
            }
            attn_store(st, oall + (size_t)qtok * 3072 + hd * 64, lane);
        }
    }
    __syncthreads();
}

__device__ __forceinline__ float row_sum16(float v) { v += DPPF(v, 0xB1); v += DPPF(v, 0x4E); v += DPPF(v, 0x141); v += DPPF(v, 0x140); return v; }
__device__ __forceinline__ f32x4 unpack4(u32x2 w) { return (f32x4){bflo(w.x), bfhi(w.x), bflo(w.y), bfhi(w.y)}; }
__device__ __forceinline__ u32x2 pack4(f32x4 v) { return (u32x2){cvtpk(v[0], v[1]), cvtpk(v[2], v[3])}; }
__device__ __forceinline__ void rwkv_tinv_unit(const Frame& F, int unit) {
    unsigned char* ws = WSP(F);
    const bf16* til = (const bf16*)(ws + WS_TIL);
    bf16* tinv = (bf16*)(ws + WS_TINV);
    int lane = lane_id(); asm volatile("" : "+v"(lane));
    const int r = lane & 31, h = lane >> 5;
    LAS float* Lw = (LAS float*)(F.lds + F.wave * 16384);
    {
        const int run = unit >> 5, e = (unit >> 4) & 1, hd = unit & 15;
        const size_t tok = (size_t)(run * 32 + (e ? 31 - r : r));
        const bf16* rowp = til + (tok * 16 + hd) * TILP + e * 256 + 8 * h;
        f32x16 acc;
#pragma unroll
        for (int i = 0; i < 16; ++i) acc[i] = 0.f;
        bf16x8 bfr[4], afr[4];
#pragma unroll
        for (int ks = 0; ks < 4; ++ks) { afr[ks] = *(const bf16x8*)(rowp + 16 * ks); bfr[ks] = *(const bf16x8*)(rowp + 64 + 16 * ks); }
#pragma unroll
        for (int ks = 0; ks < 4; ++ks) acc = __builtin_amdgcn_mfma_f32_32x32x16_bf16(bfr[ks], afr[ks], acc, 0, 0, 0);
#pragma unroll
        for (int g = 0; g < 4; ++g) { const int j0 = 8 * g + 4 * h; f32x4 v;
#pragma unroll
            for (int q = 0; q < 4; ++q) v[q] = (j0 + q < r) ? acc[4 * g + q] : 0.f;
            *(LAS f32x4*)(Lw + r * 36 + j0) = v; }
        LDS_WAIT(); asm volatile("" ::: "memory");
        float X[32];
#pragma unroll
        for (int i = 0; i < 32; ++i) {
            float s = (i == r) ? 1.f : 0.f;
#pragma unroll
            for (int jq = 0; jq < (i + 3) / 4; ++jq) { const f32x4 lv = *(const LAS f32x4*)(Lw + i * 36 + 4 * jq);
#pragma unroll
                for (int q = 0; q < 4; ++q) if (4 * jq + q < i) s += lv[q] * X[4 * jq + q]; }
            X[i] = s;
        }
        if (h == 0) { bf16* o = tinv + (size_t)unit * 1024 + r;
#pragma unroll
            for (int i = 0; i < 32; ++i) o[i * 32] = f2bf(X[i]); }
        LDS_WAIT(); asm volatile("" ::: "memory");
    }
}

__device__ __forceinline__ f32x4 exp4(f32x4 x) { return (f32x4){__expf(x[0]), __expf(x[1]), __expf(x[2]), __expf(x[3])}; }
__device__ __forceinline__ f32x4 rcp4(f32x4 x) { return (f32x4){__builtin_amdgcn_rcpf(x[0]), __builtin_amdgcn_rcpf(x[1]), __builtin_amdgcn_rcpf(x[2]), __builtin_amdgcn_rcpf(x[3])}; }
__device__ __forceinline__ void rwkv_prep_phase(const Frame& F, const Args& a, int layer) {
    unsigned char* ws = WSP(F);
    const bf16* proj = (const bf16*)(ws + WS_PROJ);
    const bf16* abuf = (const bf16*)(ws + WS_A);
    const bf16* logw = (const bf16*)(ws + WS_DEC);
    bf16* til = (bf16*)(ws + WS_TIL);
    float* bonus = (float*)(ws + WS_BONUS);
    float* wtb = (float*)(ws + WS_WTB);
    const float* cw = INP(F, I_CW) + (size_t)layer * 3 * 3072; const float* cb = INP(F, I_CB) + (size_t)layer * 3072;
    for (int item = F.wave * F.G + F.bid; item < 2048; item += 8 * F.G) {
        int lane = lane_id(); asm volatile("" : "+v"(lane));
        const int run = item >> 2, tok0 = run * 32, cg = item & 3, c4 = cg * 256 + 4 * lane, head = cg * 4 + (lane >> 4), hl = 4 * (lane & 15);
        const int t0 = tok0 < NPR ? (tok0 & 255) : ((tok0 - NPR) & 2047), L = tok0 < NPR ? L_P : L_S;
        const f32x4 kkw = *(const f32x4*)(INP(F, I_KK) + layer * 1024 + c4), kaw = *(const f32x4*)(INP(F, I_KA) + layer * 1024 + c4), rkw = *(const f32x4*)(INP(F, I_RK) + layer * 1024 + c4);
        f32x4 tot1 = (f32x4){0.f, 0.f, 0.f, 0.f};
#pragma unroll 1
        for (int q = 0; q < 4; ++q) { f32x4 t[8];
#pragma unroll
          for (int i = 0; i < 8; ++i) t[i] = unpack4(*(const u32x2*)(logw + ((size_t)(tok0 + 8 * q + i) * 2 + 1) * 1024 + c4));
#pragma unroll
          for (int i = 0; i < 8; ++i) tot1 += t[i]; }
        f32x4 pre0 = (f32x4){0.f, 0.f, 0.f, 0.f}, pre1 = pre0, e0prev = (f32x4){1.f, 1.f, 1.f, 1.f};
        const bf16* pbase = proj + (size_t)tok0 * NPROJ + COL_R + c4;
#pragma unroll 1
        for (int ch = 0; ch < 8; ++ch) {
            const float* cwp = cw; const float* cbp = cb; asm volatile("" : "+s"(cwp), "+s"(cbp));
            f32x4 w[3][3], bs[3];
#pragma unroll
            for (int s = 0; s < 3; ++s) { bs[s] = *(const f32x4*)(cbp + s * 1024 + c4);
#pragma unroll
                for (int tp = 0; tp < 3; ++tp) w[s][tp] = *(const f32x4*)(cwp + tp * 3072 + s * 1024 + c4); }
            u32x2 rows[6][3], av[4][2]; f32x4 lw[4][2];
#pragma unroll
            for (int i = 0; i < 6; ++i) { const int tt = ch * 4 + i - 1, t = t0 + tt; const bool ok = (t >= 0) && (t < L);
#pragma unroll
                for (int s = 0; s < 3; ++s) rows[i][s] = ok ? *(const u32x2*)(pbase + (long)tt * NPROJ + s * 1024) : (u32x2){0u, 0u}; }
#pragma unroll
            for (int i = 0; i < 4; ++i) { const size_t tok = (size_t)(tok0 + ch * 4 + i); av[i][0] = *(const u32x2*)(abuf + (tok * 2 + 0) * 1024 + c4); av[i][1] = *(const u32x2*)(abuf + (tok * 2 + 1) * 1024 + c4);
                lw[i][0] = unpack4(*(const u32x2*)(logw + (tok * 2 + 0) * 1024 + c4)); lw[i][1] = unpack4(*(const u32x2*)(logw + (tok * 2 + 1) * 1024 + c4)); }
#pragma unroll
            for (int i = 0; i < 4; ++i) {
                const size_t tok = (size_t)(tok0 + ch * 4 + i);
                f32x4 x[3];
#pragma unroll
                for (int s = 0; s < 3; ++s) x[s] = unpack4(rows[i][s]) * w[s][0] + unpack4(rows[i + 1][s]) * w[s][1] + unpack4(rows[i + 2][s]) * w[s][2] + bs[s];
                const f32x4 rr = x[0], k0 = x[1], vv = x[2];
                f32x4 kk = k0 * kkw;
                const float ssq = row_sum16((kk[0] * kk[0] + kk[1] * kk[1]) + (kk[2] * kk[2] + kk[3] * kk[3]));
                kk = kk * (1.0f / sqrtf(ssq + 1e-12f));
                const f32x4 a0 = unpack4(av[i][0]), a1 = unpack4(av[i][1]);
                const f32x4 kd0 = k0 * (1.0f + (a0 - 1.0f) * kaw), kd1 = k0 * (1.0f + (a1 - 1.0f) * kaw);
                const f32x4 rk = rr * k0 * rkw;
                const float bsum = row_sum16((rk[0] + rk[1]) + (rk[2] + rk[3]));
                pre0 += lw[i][0];
                const f32x4 e0 = exp4(pre0), ie0 = rcp4(e0);
                const f32x4 l1 = tot1 - pre1; pre1 += lw[i][1];
                const f32x4 e1 = exp4(l1), ie1 = rcp4(e1), e1prev = exp4(l1 - lw[i][1]);
                bf16* o = til + (tok * 16 + head) * TILP + hl;
                *(u32x2*)(o) = pack4(-kk * e0prev); *(u32x2*)(o + 64) = pack4(kk * a0 * ie0); *(u32x2*)(o + 128) = pack4(kd0 * ie0); *(u32x2*)(o + 192) = pack4(rr * e0);
                *(u32x2*)(o + 256) = pack4(-kk * e1prev); *(u32x2*)(o + 320) = pack4(kk * a1 * ie1); *(u32x2*)(o + 384) = pack4(kd1 * ie1); *(u32x2*)(o + 448) = pack4(rr * e1);
                *(u32x2*)(o + 512) = pack4(vv);
                e0prev = e0;
                if ((lane & 15) == 0) bonus[tok * 16 + head] = bsum;
            }
        }
        *(f32x4*)(wtb + (((size_t)run * 2 + 0) * 16 + head) * 64 + hl) = exp4(pre0);
        *(f32x4*)(wtb + (((size_t)run * 2 + 1) * 16 + head) * 64 + hl) = exp4(tot1);
        asm volatile("s_waitcnt vmcnt(0)" ::: "memory");
#pragma unroll 1
        for (int uu = 0; uu < 8; ++uu) rwkv_tinv_unit(F, (run << 5) | ((uu & 1) << 4) | (cg * 4 + (uu >> 1)));
    }
}

__device__ __forceinline__ bf16x8 packf(const f32x16& x, int s) {
    u32x4 p; p.x = cvtpk(x[8 * s + 0], x[8 * s + 1]); p.y = cvtpk(x[8 * s + 2], x[8 * s + 3]); p.z = cvtpk(x[8 * s + 4], x[8 * s + 5]); p.w = cvtpk(x[8 * s + 6], x[8 * s + 7]);
    return __builtin_bit_cast(bf16x8, p);
}
#define MFMA32(a, b, c) __builtin_amdgcn_mfma_f32_32x32x16_bf16((a), (b), (c), 0, 0, 0)

#define TR8(F0, F1, F2, F3, A, O0, O1, O2, O3) do { s16x4 l0_, h0_, l1_, h1_, l2_, h2_, l3_, h3_; \
    asm volatile("ds_read_b64_tr_b16 %0, %8 offset:%9\n\tds_read_b64_tr_b16 %1, %8 offset:%9+1024\n\tds_read_b64_tr_b16 %2, %8 offset:%10\n\tds_read_b64_tr_b16 %3, %8 offset:%10+1024\n\t" \
                 "ds_read_b64_tr_b16 %4, %8 offset:%11\n\tds_read_b64_tr_b16 %5, %8 offset:%11+1024\n\tds_read_b64_tr_b16 %6, %8 offset:%12\n\tds_read_b64_tr_b16 %7, %8 offset:%12+1024\n\ts_waitcnt lgkmcnt(0)" \
                 : "=&v"(l0_), "=&v"(h0_), "=&v"(l1_), "=&v"(h1_), "=&v"(l2_), "=&v"(h2_), "=&v"(l3_), "=&v"(h3_) : "v"(A), "n"(O0), "n"(O1), "n"(O2), "n"(O3)); \
    F0 = __builtin_shufflevector(l0_, h0_, 0, 1, 2, 3, 4, 5, 6, 7); F1 = __builtin_shufflevector(l1_, h1_, 0, 1, 2, 3, 4, 5, 6, 7); \
    F2 = __builtin_shufflevector(l2_, h2_, 0, 1, 2, 3, 4, 5, 6, 7); F3 = __builtin_shufflevector(l3_, h3_, 0, 1, 2, 3, 4, 5, 6, 7); } while (0)
#define TR4(F0, F1, A, O0, O1) do { s16x4 l0_, h0_, l1_, h1_; \
    asm volatile("ds_read_b64_tr_b16 %0, %4 offset:%5\n\tds_read_b64_tr_b16 %1, %4 offset:%5+1024\n\tds_read_b64_tr_b16 %2, %4 offset:%6\n\tds_read_b64_tr_b16 %3, %4 offset:%6+1024\n\ts_waitcnt lgkmcnt(0)" \
                 : "=&v"(l0_), "=&v"(h0_), "=&v"(l1_), "=&v"(h1_) : "v"(A), "n"(O0), "n"(O1)); \
    F0 = __builtin_shufflevector(l0_, h0_, 0, 1, 2, 3, 4, 5, 6, 7); F1 = __builtin_shufflevector(l1_, h1_, 0, 1, 2, 3, 4, 5, 6, 7); } while (0)
template <int V> struct IC { static constexpr int value = V; };
__device__ __forceinline__ void hyena_post_phase(const Frame& F, const Args& a, int layer, LAS bf16* tl, int gw, int NGW);
constexpr int CS_BUF = 23552, CS_AT = 0, CS_BT = 4096, CS_KT = 8192, CS_RT = 12288, CS_VV = 16384, CS_TI = 20480, CS_WT = 22528;
__device__ __forceinline__ void rwkv_cscan_phase(const Frame& F, const Args& a, int layer) {
    if (F.wave >= 2) {
        if (F.wave < 6) { LAS bf16* sl = (LAS bf16*)(F.lds + 4 * CS_BUF + (F.wave - 2) * 8704);
            hyena_post_phase(F, a, layer, sl, F.bid * 4 + (F.wave - 2), F.G * 4); }
        if (layer + 1 < DEPTH) convert_layer(F, layer + 1, nullptr, F.bid * 6 + (F.wave - 2), F.G * 6);
        return; }
    unsigned char* ws = WSP(F);
    const bf16* til = (const bf16*)(ws + WS_TIL);
    const bf16* tinv = (const bf16*)(ws + WS_TINV);
    const float* wtb = (const float*)(ws + WS_WTB);
    float* Y = (float*)(ws + WS_H);
    const int lane = F.lane, r = lane & 31, h = lane >> 5;
    const int i16 = lane & 15, tq = i16 >> 2, tp = i16 & 3, blk = (lane >> 4) & 1;
    LAS unsigned char* lbase = F.lds + F.wave * (2 * CS_BUF);
    const int slot = F.wave * F.G + F.bid, nslot = 2 * F.G;
    const int nsamp = 256;
    for (int item = slot; item < 2304; item += (slot < nsamp) ? 2304 : (nslot - nsamp)) {
        const bool sample = item < 256; const int hc = sample ? item : item - 256, chain = hc >> 1, vt = hc & 1;
        const int hd = chain & 15, e = (chain >> 4) & 1, b = chain >> 5;
        const int NC = sample ? (L_S / 32) : (L_P / 32), tokb = sample ? NPR + b * L_S : b * L_P;
        f32x16 ST[2];
        if (sample) { const float* s0 = INP(F, I_ST) + ((((size_t)b * 4 + layer) * 2 + e) * 16 + hd) * 4096;
#pragma unroll
            for (int kt = 0; kt < 2; ++kt)
#pragma unroll
                for (int g = 0; g < 4; ++g) { const f32x4 v = *(const f32x4*)(s0 + (32 * vt + r) * 64 + 32 * kt + 8 * g + 4 * h);
                    ST[kt][4 * g] = v[0]; ST[kt][4 * g + 1] = v[1]; ST[kt][4 * g + 2] = v[2]; ST[kt][4 * g + 3] = v[3]; }
        } else {
#pragma unroll
            for (int kt = 0; kt < 2; ++kt)
#pragma unroll
                for (int i = 0; i < 16; ++i) ST[kt][i] = 0.f;
        }
#define CS_DMA(C, BUFP) do { const int run_ = (tokb >> 5) + (e ? NC - 1 - (C) : (C)); int ln_ = lane_id(); asm volatile("" : "+v"(ln_));     \
            _Pragma("unroll") for (int i_ = 0; i_ < 4; ++i_) { const int q_ = ln_ + 64 * i_, p_ = q_ >> 3, cc_ = q_ & 7; \
                const bf16* g_ = til + ((size_t)(run_ * 32 + (e ? 31 - p_ : p_)) * 16 + hd) * TILP + e * 256 + 8 * cc_; \
                __builtin_amdgcn_global_load_lds((const unsigned*)(g_), (LAS unsigned*)((BUFP) + CS_AT + i_ * 1024), 16, 0, 0); \
                __builtin_amdgcn_global_load_lds((const unsigned*)(g_ + 64), (LAS unsigned*)((BUFP) + CS_BT + i_ * 1024), 16, 0, 0); \
                __builtin_amdgcn_global_load_lds((const unsigned*)(g_ + 128), (LAS unsigned*)((BUFP) + CS_KT + i_ * 1024), 16, 0, 0); \
                __builtin_amdgcn_global_load_lds((const unsigned*)(g_ + 192), (LAS unsigned*)((BUFP) + CS_RT + i_ * 1024), 16, 0, 0); \
                __builtin_amdgcn_global_load_lds((const unsigned*)(g_ - e * 256 + 512), (LAS unsigned*)((BUFP) + CS_VV + i_ * 1024), 16, 0, 0); } \
            const size_t unit_ = ((size_t)run_ * 2 + e) * 16 + hd; \
            _Pragma("unroll") for (int i_ = 0; i_ < 2; ++i_) __builtin_amdgcn_global_load_lds((const unsigned*)(tinv + unit_ * 1024 + (ln_ + 64 * i_) * 8), (LAS unsigned*)((BUFP) + CS_TI + i_ * 1024), 16, 0, 0); \
            __builtin_amdgcn_global_load_lds((const unsigned*)(wtb + unit_ * 64 + (ln_ & 15) * 4), (LAS unsigned*)((BUFP) + CS_WT), 16, 0, 0); } while (0)
        CS_DMA(0, lbase);
        auto chunk = [&](auto bi_, int c) __attribute__((always_inline)) {
            constexpr int BI = decltype(bi_)::value;
            const LAS unsigned char* B = lbase + BI * CS_BUF;
            if (c == 0) asm volatile("s_waitcnt vmcnt(0)" ::: "memory");
            else asm volatile("s_waitcnt vmcnt(16)" ::: "memory");
            if (c + 1 < NC) CS_DMA(c + 1, lbase + (1 - BI) * CS_BUF);
            bf16x8 nkaF[2], nbrF[2], nkrF[2];
#define CS_NMAT(OUTF, OFFA, OFFB, STRICT) do { f32x16 n_; _Pragma("unroll") for (int i = 0; i < 16; ++i) n_[i] = 0.f; \
                    _Pragma("unroll") for (int ks = 0; ks < 4; ++ks) { const int o = r * 128 + (16 * ks + 8 * h) * 2; \
                        n_ = MFMA32(*(const LAS bf16x8*)(B + (OFFA) + o), *(const LAS bf16x8*)(B + (OFFB) + o), n_); } \
                    _Pragma("unroll") for (int i = 0; i < 16; ++i) { const int row = (i & 3) + 8 * (i >> 2) + 4 * h; n_[i] = ((STRICT) ? (row < r) : (row <= r)) ? n_[i] : 0.f; } \
                    OUTF[0] = packf(n_, 0); OUTF[1] = packf(n_, 1); } while (0)
            CS_NMAT(nkaF, CS_KT, CS_AT, true);
            CS_NMAT(nbrF, CS_BT, CS_RT, false);
            CS_NMAT(nkrF, CS_KT, CS_RT, false);
#undef CS_NMAT
            const unsigned tra = (unsigned)(size_t)(B) + (4 * h + tq) * 128 + (16 * blk + 4 * tp) * 2 + vt * 64;
            const unsigned trk = (unsigned)(size_t)(B) + (4 * h + tq) * 128 + (16 * blk + 4 * tp) * 2;
            bf16x8 vvF[2], btF[2][2], ktF[2][2];
            TR4(vvF[0], vvF[1], tra, CS_VV, CS_VV + 2048);
            TR8(btF[0][0], btF[0][1], btF[1][0], btF[1][1], trk, CS_BT, CS_BT + 2048, CS_BT + 64, CS_BT + 64 + 2048);
            TR8(ktF[0][0], ktF[0][1], ktF[1][0], ktF[1][1], trk, CS_KT, CS_KT + 2048, CS_KT + 64, CS_KT + 64 + 2048);
#define CS_APERM(OFF, KT, S) ({ const LAS unsigned char* p_ = B + (OFF) + r * 128 + (32 * (KT) + 16 * (S) + 4 * h) * 2; \
                const u32x2 lo_ = *(const LAS u32x2*)p_, hi_ = *(const LAS u32x2*)(p_ + 16); __builtin_bit_cast(bf16x8, (u32x4){lo_.x, lo_.y, hi_.x, hi_.y}); })
            bf16x8 uF[2];
            {   f32x16 rhs;
#pragma unroll
                for (int i = 0; i < 16; ++i) rhs[i] = 0.f;
#pragma unroll
                for (int kt = 0; kt < 2; ++kt)
#pragma unroll
                    for (int s = 0; s < 2; ++s) rhs = MFMA32(CS_APERM(CS_AT, kt, s), packf(ST[kt], s), rhs);
#pragma unroll
                for (int s = 0; s < 2; ++s) rhs = MFMA32(nkaF[s], vvF[s], rhs);
                f32x16 u;
#pragma unroll
                for (int i = 0; i < 16; ++i) u[i] = 0.f;
#pragma unroll
                for (int s = 0; s < 2; ++s) { const LAS unsigned char* p_ = B + CS_TI + r * 64 + (16 * s + 4 * h) * 2;
                    const u32x2 lo_ = *(const LAS u32x2*)p_, hi_ = *(const LAS u32x2*)(p_ + 16);
                    u = MFMA32(__builtin_bit_cast(bf16x8, (u32x4){lo_.x, lo_.y, hi_.x, hi_.y}), packf(rhs, s), u); }
                uF[0] = packf(u, 0); uF[1] = packf(u, 1);
            }
            {   const int run = (tokb >> 5) + (e ? NC - 1 - c : c);
                f32x16 y;
#pragma unroll
                for (int i = 0; i < 16; ++i) y[i] = 0.f;
#pragma unroll
                for (int kt = 0; kt < 2; ++kt)
#pragma unroll
                    for (int s = 0; s < 2; ++s) y = MFMA32(CS_APERM(CS_RT, kt, s), packf(ST[kt], s), y);
#pragma unroll
                for (int s = 0; s < 2; ++s) { y = MFMA32(nbrF[s], uF[s], y); y = MFMA32(nkrF[s], vvF[s], y); }
#pragma unroll
                for (int i = 0; i < 16; ++i) { const int p = (i & 3) + 8 * (i >> 2) + 4 * h; const size_t tok = (size_t)(run * 32 + (e ? 31 - p : p));
                    Y[((size_t)e * M + tok) * 1024 + hd * 64 + 32 * vt + r] = y[i]; }
            }
#pragma unroll
            for (int kt = 0; kt < 2; ++kt) {
                f32x4 wt[4];
#pragma unroll
                for (int g = 0; g < 4; ++g) wt[g] = *(const LAS f32x4*)(B + CS_WT + (32 * kt + 8 * g + 4 * h) * 4);
#pragma unroll
                for (int s = 0; s < 2; ++s) { ST[kt] = MFMA32(btF[kt][s], uF[s], ST[kt]); ST[kt] = MFMA32(ktF[kt][s], vvF[s], ST[kt]); }
#pragma unroll
                for (int i = 0; i < 16; ++i) ST[kt][i] *= wt[i >> 2][i & 3];
            }
        };
#pragma unroll 1
        for (int c2 = 0; c2 < NC; c2 += 2) { chunk(IC<0>{}, c2); chunk(IC<1>{}, c2 + 1); }
#undef CS_APERM
#undef CS_DMA
        if (!sample) { float* so = OUTP(F) + OUT_ST + ((((size_t)b * 4 + layer) * 2 + e) * 16 + hd) * 4096;
#pragma unroll
            for (int kt = 0; kt < 2; ++kt)
#pragma unroll
                for (int g = 0; g < 4; ++g) *(f32x4*)(so + (32 * vt + r) * 64 + 32 * kt + 8 * g + 4 * h) = (f32x4){ST[kt][4 * g], ST[kt][4 * g + 1], ST[kt][4 * g + 2], ST[kt][4 * g + 3]};
        }
    }
    asm volatile("s_waitcnt vmcnt(0)" ::: "memory");
}

__device__ __forceinline__ void rwkv_post_phase(const Frame& F, const Args& a, int layer) {
    unsigned char* ws = WSP(F);
    const float* Y = (const float*)(ws + WS_H);
    const bf16* til = (const bf16*)(ws + WS_TIL); const bf16* gbuf = (const bf16*)(ws + WS_G); const float* bonus = (const float*)(ws + WS_BONUS);
    bf16* oall = (bf16*)(ws + WS_OALL);
    const int lane = F.lane;
    for (int item = F.wave * F.G + F.bid; item < 2048; item += 8 * F.G) {
        const int tok0 = (item >> 2) * 32, cg = item & 3, c4 = cg * 256 + 4 * lane, head = cg * 4 + (lane >> 4), hl = 4 * (lane & 15);
        const f32x4 gng = *(const f32x4*)(INP(F, I_GNG) + layer * 1024 + c4), gnb = *(const f32x4*)(INP(F, I_GNB) + layer * 1024 + c4);
#pragma unroll 1
        for (int ch = 0; ch < 4; ++ch) {
            f32x4 y0[8], y1[8]; u32x2 vw[8], gw[8]; float bn[8];
#pragma unroll
            for (int i = 0; i < 8; ++i) { const size_t tok = (size_t)(tok0 + ch * 8 + i);
                y0[i] = *(const f32x4*)(Y + tok * 1024 + c4); y1[i] = *(const f32x4*)(Y + ((size_t)M + tok) * 1024 + c4);
                vw[i] = *(const u32x2*)(til + (tok * 16 + head) * TILP + 512 + hl); gw[i] = *(const u32x2*)(gbuf + tok * 1024 + c4); bn[i] = bonus[tok * 16 + head]; }
#pragma unroll
            for (int i = 0; i < 8; ++i) { const size_t tok = (size_t)(tok0 + ch * 8 + i);
                const f32x4 y = y0[i] + y1[i];
                const float mu = row_sum16((y[0] + y[1]) + (y[2] + y[3])) * (1.0f / 64.0f);
                const f32x4 dd = y - mu;
                const float var = row_sum16((dd[0] * dd[0] + dd[1] * dd[1]) + (dd[2] * dd[2] + dd[3] * dd[3])) * (1.0f / 64.0f);
                const f32x4 yn = dd * (1.0f / sqrtf(var + 64e-5f)) * gng + gnb;
                const f32x4 o = (yn + bn[i] * unpack4(vw[i])) * unpack4(gw[i]);
                *(u32x2*)(oall + tok * 3072 + 1024 + c4) = pack4(o);
            }
        }
    }
}

__device__ __forceinline__ void hyena_prep_phase(const Frame& F, const Args& a, int layer) {
    unsigned char* ws = WSP(F);
    const bf16* proj = (const bf16*)(ws + WS_PROJ);
    bf16* zT = (bf16*)(ws + WS_ZT);
    const float* cw = INP(F, I_HCW) + (size_t)layer * 3 * 3072; const float* cb = INP(F, I_HCB) + (size_t)layer * 3072;
    const int gw = F.bid * 8 + F.wave, NGW = F.G * 8, lane = F.lane, tsub = lane >> 4, cq = lane & 15;
    LAS bf16* tl = (LAS bf16*)(F.lds + F.wave * 16384);
    for (int it = gw; it < 256 * 16; it += NGW) {
        const int tt0 = (it >> 4) * 64, c0 = (it & 15) * 64, c4 = c0 + 4 * cq;
        const int t0 = tt0 < NPR ? (tt0 & 255) : ((tt0 - NPR) & 2047), L = tt0 < NPR ? L_P : L_S;
        f32x4 w1[3], w2[3];
#pragma unroll
        for (int tp = 0; tp < 3; ++tp) { w1[tp] = *(const f32x4*)(cw + tp * 3072 + 1024 + c4); w2[tp] = *(const f32x4*)(cw + tp * 3072 + 2048 + c4); }
        const f32x4 b1 = *(const f32x4*)(cb + 1024 + c4), b2 = *(const f32x4*)(cb + 2048 + c4);
        const bf16* px = proj + (size_t)tt0 * NPROJ + COL_X1 + c4;
#pragma unroll 1
        for (int hf = 0; hf < 2; ++hf) {
            u32x2 xr[8][3], vr[8][3];
#pragma unroll
            for (int i = 0; i < 8; ++i) { const int tt = 4 * (hf * 8 + i) + tsub;
#pragma unroll
                for (int d = 0; d < 3; ++d) { const int t = t0 + tt + d - 1; const bool ok = (t >= 0) && (t < L); const bf16* p = px + (long)(tt + d - 1) * NPROJ;
                    xr[i][d] = ok ? *(const u32x2*)p : (u32x2){0u, 0u}; vr[i][d] = ok ? *(const u32x2*)(p + 1024) : (u32x2){0u, 0u}; } }
#pragma unroll
            for (int i = 0; i < 8; ++i) { const int tt = 4 * (hf * 8 + i) + tsub;
                const f32x4 x1c = unpack4(xr[i][0]) * w1[0] + unpack4(xr[i][1]) * w1[1] + unpack4(xr[i][2]) * w1[2] + b1;
                const f32x4 vvc = unpack4(vr[i][0]) * w2[0] + unpack4(vr[i][1]) * w2[1] + unpack4(vr[i][2]) * w2[2] + b2;
                *(LAS u32x2*)(tl + tt * 68 + 4 * cq) = pack4(x1c * vvc); }
        }
        LDS_WAIT(); asm volatile("" ::: "memory");
#pragma unroll
        for (int j = 0; j < 8; ++j) { const int id = lane + 64 * j, ch = id >> 3, tg = id & 7; const LAS bf16* s = tl + (8 * tg) * 68 + ch;
            u32x4 o; o.x = (unsigned)s[0] | ((unsigned)s[68] << 16); o.y = (unsigned)s[2 * 68] | ((unsigned)s[3 * 68] << 16); o.z = (unsigned)s[4 * 68] | ((unsigned)s[5 * 68] << 16); o.w = (unsigned)s[6 * 68] | ((unsigned)s[7 * 68] << 16);
            *(u32x4*)(zT + (size_t)(c0 + ch) * M + tt0 + 8 * tg) = o; }
        LDS_WAIT(); asm volatile("" ::: "memory");
    }
}

__device__ __forceinline__ void hyena_conv_phase(const Frame& F, const Args& a, int layer) {
    unsigned char* ws = WSP(F);
    bf16* zT = (bf16*)(ws + WS_ZT);
    const float* FNORM = (const float*)(ws + WS_CTL) + CW_FNORM;
    const int lane = F.lane, w = F.wave, r = lane & 31, h = lane >> 5;
    LAS unsigned char* lds = F.lds;
    for (int u = F.bid; u < 2048; u += F.G) {
        const bool sample = u < 1024; const int c = u & 1023;
        const int L = sample ? L_S : L_P, LP = sample ? LPS : LPP, FCS = LP * 2;
        const int ZROW = (L + 448) * 2, ZOFF = 2 * FCS;
        const int NB = sample ? 4 : 32, tokb = sample ? NPR : 0;
        const bf16* fsrc = sample ? (const bf16*)(ws + WS_FS) + ((size_t)layer * 1024 + c) * LPS : (const bf16*)(ws + WS_FP) + ((size_t)layer * 1024 + c) * LPP;
        __syncthreads();
        for (int i = F.tid; i < LP / 8; i += 512) *(LAS u32x4*)(lds + i * 16) = *(const u32x4*)(fsrc + i * 8);
        for (int i = F.tid; i < LP; i += 512) *(LAS bf16*)(lds + FCS + i * 2) = (i + 1 < LP) ? fsrc[i + 1] : (bf16)0;
        { const int cpr = L / 8;
          for (int i = F.tid; i < NB * cpr; i += 512) { const int b = i / cpr, q = i - b * cpr;
              *(LAS u32x4*)(lds + ZOFF + b * ZROW + 448 + q * 16) = *(const u32x4*)(zT + (size_t)c * M + tokb + b * L + q * 8); }
          if (sample) for (int i = F.tid; i < NB * 56; i += 512) { const int b = i / 56, q = i - b * 56;
              *(LAS u32x4*)(lds + ZOFF + b * ZROW + (q < 28 ? q * 16 : 448 + L * 2 + (q - 28) * 16)) = (u32x4){0u, 0u, 0u, 0u}; } }
        __syncthreads();
        const int nbl = sample ? 2 : 5;
        const int I0 = sample ? 8 * w : w;
        const int b = r & (NB - 1), I = I0 + (r >> nbl);
        int dlo = (sample ? I0 - 63 : I0 - 7), dhi = (sample ? I0 + 7 : I0);
        const int dmax = L / 64;
        dlo = dlo < -dmax ? -dmax : dlo; dhi = dhi > dmax ? dmax : dhi;
        f32x16 acc;
#pragma unroll
        for (int i = 0; i < 16; ++i) acc[i] = 0.f;
        const LAS unsigned char* zb = lds + ZOFF + b * ZROW + (224 + 8 * h) * 2;
#pragma unroll 2
        for (int d = dlo; d <= dhi; ++d) {
#pragma unroll
            for (int ks = 0; ks < 2; ++ks) {
                const int st = (L / 2 - 1) - 32 * d - r + 16 * ks + 8 * h + 32;
                const int par = st & 1;
                const LAS unsigned* ap = (const LAS unsigned*)(lds + par * FCS + (st - par) * 2);
                const u32x4 aw = (u32x4){ap[0], ap[1], ap[2], ap[3]};
                const bf16x8 af = __builtin_bit_cast(bf16x8, aw);
                const bf16x8 bfr = *(const LAS bf16x8*)(zb + (32 * (I - d) + 16 * ks) * 2);
                acc = __builtin_amdgcn_mfma_f32_32x32x16_bf16(af, bfr, acc, 0, 0, 0);
            }
        }
        const float inv = 1.0f / (FNORM[((size_t)layer * 2 + (sample ? 0 : 1)) * 1024 + c] + 1e-6f);
        const float dco = INP(F, I_HD)[layer * 1024 + c];
        __syncthreads();
#pragma unroll
        for (int g = 0; g < 4; ++g) {
            const int t = 32 * I + 8 * g + 4 * h;
            const LAS bf16* zp = (const LAS bf16*)(lds + ZOFF + b * ZROW + (224 + t) * 2);
            float o[4];
#pragma unroll
            for (int j = 0; j < 4; ++j) o[j] = acc[4 * g + j] * inv + bf2f(zp[j]) * dco;
            *(u32x2*)(zT + (size_t)c * M + tokb + b * L + t) = (u32x2){cvtpk(o[0], o[1]), cvtpk(o[2], o[3])};
        }
    }
    __syncthreads();
}

__device__ __forceinline__ void hyena_post_phase(const Frame& F, const Args& a, int layer, LAS bf16* tl, int gw, int NGW) {
    unsigned char* ws = WSP(F);
    const bf16* proj = (const bf16*)(ws + WS_PROJ);
    const bf16* yT = (const bf16*)(ws + WS_ZT);
    bf16* oall = (bf16*)(ws + WS_OALL);
    const float* cw = INP(F, I_HCW) + (size_t)layer * 3 * 3072; const float* cb = INP(F, I_HCB) + (size_t)layer * 3072;
    const int lane = F.lane, tsub = lane >> 4, cq = lane & 15;
    for (int it = gw; it < 256 * 16; it += NGW) {
        const int tt0 = (it >> 4) * 64, c0 = (it & 15) * 64, c4 = c0 + 4 * cq;
        const int t0 = tt0 < NPR ? (tt0 & 255) : ((tt0 - NPR) & 2047), L = tt0 < NPR ? L_P : L_S;
        {   u32x4 tmp[8];
#pragma unroll
            for (int j = 0; j < 8; ++j) { const int id = lane + 64 * j, ch = id >> 3, tg = id & 7; tmp[j] = *(const u32x4*)(yT + (size_t)(c0 + ch) * M + tt0 + 8 * tg); }
#pragma unroll
            for (int j = 0; j < 8; ++j) { const int id = lane + 64 * j, ch = id >> 3, tg = id & 7; LAS unsigned* d = (LAS unsigned*)(tl + ch * 68 + 8 * tg);
                d[0] = tmp[j].x; d[1] = tmp[j].y; d[2] = tmp[j].z; d[3] = tmp[j].w; } }
        LDS_WAIT(); asm volatile("" ::: "memory");
        f32x4 w0[3];
#pragma unroll
        for (int tp = 0; tp < 3; ++tp) w0[tp] = *(const f32x4*)(cw + tp * 3072 + c4);
        const f32x4 b0 = *(const f32x4*)(cb + c4);
        const bf16* px = proj + (size_t)tt0 * NPROJ + COL_X0 + c4;
#pragma unroll 1
        for (int hf = 0; hf < 2; ++hf) {
            u32x2 xr[8][3];
#pragma unroll
            for (int i = 0; i < 8; ++i) { const int tt = 4 * (hf * 8 + i) + tsub;
#pragma unroll
                for (int d = 0; d < 3; ++d) { const int t = t0 + tt + d - 1; const bool ok = (t >= 0) && (t < L); xr[i][d] = ok ? *(const u32x2*)(px + (long)(tt + d - 1) * NPROJ) : (u32x2){0u, 0u}; } }
#pragma unroll
            for (int i = 0; i < 8; ++i) { const int tt = 4 * (hf * 8 + i) + tsub;
                const f32x4 x0c = unpack4(xr[i][0]) * w0[0] + unpack4(xr[i][1]) * w0[1] + unpack4(xr[i][2]) * w0[2] + b0;
                const f32x4 yv = (f32x4){bf2f(tl[(4 * cq + 0) * 68 + tt]), bf2f(tl[(4 * cq + 1) * 68 + tt]), bf2f(tl[(4 * cq + 2) * 68 + tt]), bf2f(tl[(4 * cq + 3) * 68 + tt])};
                *(u32x2*)(oall + (size_t)(tt0 + tt) * 3072 + 2048 + c4) = pack4(x0c * yv); }
        }
        LDS_WAIT(); asm volatile("" ::: "memory");
    }
}

constexpr int NPL = 11, PH_LAYER0 = 2, PH_FINAL = PH_LAYER0 + DEPTH * NPL, N_PHASES = PH_FINAL + 1;

__global__ void __launch_bounds__(512, 2) mega(Args args) {
    extern __shared__ __attribute__((aligned(16))) unsigned char lds_raw[];
    Frame F;
    F.lds = (LAS unsigned char*)lds_raw;
    F.tid = threadIdx.x; F.lane = F.tid & 63; F.wave = __builtin_amdgcn_readfirstlane(F.tid >> 6);
    F.G = gridDim.x; F.bid = blockIdx.x;
    for (int u = F.tid; u < (LDS_BYTES - LDSCTL_OFF) / 4; u += 512) ((LAS unsigned*)(F.lds + LDSCTL_OFF))[u] = 0u;
    __syncthreads();
    if (F.tid < 48) { const unsigned long long p = F.tid < 46 ? (unsigned long long)args.in[F.tid] : (F.tid == 46 ? (unsigned long long)args.out : (unsigned long long)args.ws);
        ((LAS unsigned*)(F.lds + LDS_ARGT))[2 * F.tid] = (unsigned)p; ((LAS unsigned*)(F.lds + LDS_ARGT))[2 * F.tid + 1] = (unsigned)(p >> 32); }
    __syncthreads();
    unsigned char* ws = WSP(F);
    unsigned* ctl = (unsigned*)(ws + WS_CTL);
    int lo = args.ph_lo, hi = args.ph_hi;
    const bool single = (hi - lo) > 1;
    XcdBarrier bar; bar.bar = ctl + CW_BAR; bar.x = 0; bar.st = (volatile LAS unsigned*)(F.lds + LDSCTL_OFF + 64); bar.wave = F.wave;
    if (single) bar = xcd_barrier_post(ctl + CW_BAR, (volatile LAS unsigned*)(F.lds + LDSCTL_OFF + 64), F.wave);
#ifndef MK_EN
#define MK_EN 0xFFFFFF
#endif
#define IN(k) (lo <= (k) && (k) < hi)
#define EN(b) ((MK_EN >> (b)) & 1)
#ifndef MK_DUP
#define MK_DUP -1
#endif
#define REPS(k) ((MK_DUP == (k)) ? 2 : 1)
#define FRESH() do { F.lane = lane_id(); asm volatile("" : "+v"(F.lane), "+s"(F.bid), "+s"(F.wave), "+s"(F.G)); F.tid = F.wave * 64 + F.lane; } while (0)
#define SEAM(k) do { if (IN(k) && IN((k) + 1)) xcd_barrier(bar); } while (0)

    if (EN(20) && IN(0)) { FRESH(); prologue0(F, args); SEAM(0); }
    if (EN(21) && IN(1)) { FRESH(); prologue1(F, args); SEAM(1); }

    bf16* Hb = (bf16*)(ws + WS_H); bf16* proj = (bf16*)(ws + WS_PROJ); bf16* oall = (bf16*)(ws + WS_OALL);
    float* x = OUTP(F);
#pragma unroll 1
    for (int l = 0; l < DEPTH; ++l) {
        const int pb = PH_LAYER0 + l * NPL;
        asm volatile("" : "+s"(lo), "+s"(hi));
        const float* mod = (const float*)(ws + WS_MOD) + (size_t)l * 5 * 12288;
        if (EN(0) && IN(pb + 0)) { FRESH();
            norm_phase(F, l == 0 ? INP(F, I_XP) : x, l == 0 ? INP(F, I_XS) : x + (size_t)NPR * D, l == 0 ? x : nullptr, INP(F, I_LN1) + l * D, mod, 0, 1, Hb);
            SEAM(pb + 0);
        }
        if (EN(1) && IN(pb + 1)) { FRESH();
            pg8::Gemm g{Hb, (const bf16*)(ws + WS_WIN) + (size_t)l * NPROJ * D, D, D, D, 0, 0, 0};
            pg8::Order S; S.init(M, NPROJ, F.G, F.bid, 1);
            pg8::EpiProj E{proj, x + OUT_CK, x + OUT_CV, l};
            pg8::gemm_phase(F.lds, g, S, E, F.wave);
            SEAM(pb + 1);
        }
        if (EN(2) && IN(pb + 2)) { FRESH();
            {   pg8::Gemm g{proj + COL_LW, (const bf16*)(ws + WS_W2T) + (size_t)l * 5120 * 128, NPROJ, 128, 128, 0, 128, 4};
                pg8::Order5 S; S.init(M, F.G, F.bid);
                pg8::EpiLora2 E{(bf16*)(ws + WS_DEC), (bf16*)(ws + WS_A), (bf16*)(ws + WS_G), INP(F, I_W0) + l * 2048, INP(F, I_A0) + l * 2048};
                pg8::gemm_phase(F.lds, g, S, E, F.wave); }
            FRESH(); attention_phase(F, args, l);
            FRESH(); hyena_prep_phase(F, args, l);
            SEAM(pb + 2);
        }
        if (EN(3) && IN(pb + 3)) { FRESH(); rwkv_prep_phase(F, args, l); FRESH(); hyena_conv_phase(F, args, l); SEAM(pb + 3); }
        if (EN(4) && IN(pb + 4)) { FRESH(); rwkv_cscan_phase(F, args, l); SEAM(pb + 4); }
        if (EN(5) && IN(pb + 5)) { FRESH(); rwkv_post_phase(F, args, l); SEAM(pb + 5); }
        if (EN(6) && IN(pb + 6)) { FRESH();
            pg8::Gemm g{oall, (const bf16*)(ws + WS_WP) + (size_t)l * 3 * D * 1024, 3072, 1024, 1024, 1024, 0, 8};
            pg8::Order S; S.init(M, D, F.G, F.bid, 3);
            pg8::EpiMerge E{proj, Hb};
            pg8::gemm_phase(F.lds, g, S, E, F.wave);
            SEAM(pb + 6);
        }
        if (EN(7) && IN(pb + 7)) { FRESH();
            pg8::Gemm g{Hb, (const bf16*)(ws + WS_WOUT) + (size_t)l * D * D, D, D, D, 0, 0, 0};
            pg8::Order S; S.init(M, D, F.G, F.bid, 1);
            pg8::EpiResid E{x, mod + 2 * D, nullptr, 1.0f};
            pg8::gemm_phase(F.lds, g, S, E, F.wave);
            SEAM(pb + 7);
        }
        if (EN(8) && IN(pb + 8)) { FRESH(); norm_phase(F, x, x + (size_t)NPR * D, nullptr, INP(F, I_LN2) + l * D, mod, 3, 4, Hb); SEAM(pb + 8); }
        if (EN(9) && IN(pb + 9)) { FRESH();
            pg8::Gemm g{Hb, (const bf16*)(ws + WS_WFF1) + (size_t)l * D * DFF, D, D, D, 0, 0, 0};
            pg8::Order S; S.init(M, DFF, F.G, F.bid, 1);
            pg8::EpiFF1 E{proj, INP(F, I_BFF1) + l * DFF};
            pg8::gemm_phase(F.lds, g, S, E, F.wave);
            SEAM(pb + 9);
        }
        if (EN(10) && IN(pb + 10)) { FRESH();
            pg8::Gemm g{proj, (const bf16*)(ws + WS_WFF2) + (size_t)l * D * DFF, DFF, DFF, DFF, 0, 0, 0};
            pg8::Order S; S.init(M, D, F.G, F.bid, 1);
            pg8::EpiResid E{x, mod + 5 * D, INP(F, I_BFF2) + l * D, 1.0f};
            pg8::gemm_phase(F.lds, g, S, E, F.wave);
            SEAM(pb + 10);
        }
    }
    asm volatile("" : "+s"(lo), "+s"(hi));
    if (EN(22) && IN(PH_FINAL)) { FRESH(); final_norm_phase(F, OUTP(F), INP(F, I_FING)); }
#undef IN
#undef SEAM
}

extern "C" void kernel_launch(void* const* d_in, const int* in_sizes, int n_in, void* d_out, int out_size, void* d_ws, size_t ws_size, hipStream_t stream) {
    static int grid = 0;
    if (grid == 0) {
        if (n_in != N_INPUTS || (size_t)out_size != OUT_TOTAL || ws_size < WS_END) { fprintf(stderr, "kernel_launch: unexpected shapes: n_in %d out %d ws %zu\n", n_in, out_size, ws_size); grid = -1; return; }
        int dev = 0, cus = 0, per_cu = 0;
        if (hipGetDevice(&dev) != hipSuccess || hipDeviceGetAttribute(&cus, hipDeviceAttributeMultiprocessorCount, dev) != hipSuccess) { grid = -1; return; }
        if (hipFuncSetAttribute((const void*)mega, hipFuncAttributeMaxDynamicSharedMemorySize, LDS_BYTES) != hipSuccess) { fprintf(stderr, "kernel_launch: hipFuncSetAttribute failed\n"); grid = -1; return; }
        if (hipOccupancyMaxActiveBlocksPerMultiprocessor(&per_cu, (const void*)mega, 512, LDS_BYTES) != hipSuccess || per_cu < 1) { fprintf(stderr, "kernel_launch: occupancy query says %d\n", per_cu); }
        (void)hipGetLastError();
        grid = cus;
    }
    if (grid < 0) return;
    (void)hipMemsetAsync((char*)d_ws + WS_CTL, 0, CTL_ZERO_BYTES, stream);
    Args a{};
    for (int i = 0; i < N_INPUTS; ++i) a.in[i] = (const float*)d_in[i];
    a.out = (float*)d_out; a.ws = (unsigned char*)d_ws;
#if MK_MULTI
    for (int ph = 0; ph < N_PHASES; ++ph) { a.ph_lo = ph; a.ph_hi = ph + 1; hipLaunchKernelGGL(mega, dim3(grid), dim3(512), LDS_BYTES, stream, a); }
#else
    a.ph_lo = 0; a.ph_hi = N_PHASES;
    hipLaunchKernelGGL(mega, dim3(grid), dim3(512), LDS_BYTES, stream, a);
#endif
    const hipError_t le = hipPeekAtLastError();
    if (le != hipSuccess) fprintf(stderr, "kernel_launch: launch failed: %s\n", hipGetErrorName(le));
}
```

```cpp
#include <hip/hip_runtime.h>
#include <cstdio>
#include <cstdint>

#ifndef MK_MULTI
#define MK_MULTI 0
#endif

#define GAS __attribute__((address_space(1)))
#define LAS __attribute__((address_space(3)))
typedef unsigned short bf16;
typedef short bf16x8 __attribute__((ext_vector_type(8)));
typedef short s16x4 __attribute__((ext_vector_type(4)));
typedef float f32x4 __attribute__((ext_vector_type(4)));
typedef float f32x2 __attribute__((ext_vector_type(2)));
typedef float f32x16 __attribute__((ext_vector_type(16)));
typedef unsigned u32x4 __attribute__((ext_vector_type(4)));
typedef unsigned u32x2 __attribute__((ext_vector_type(2)));
typedef __bf16 bf16x2_t __attribute__((ext_vector_type(2)));

constexpr int D = 2048, DEPTH = 4, NPR = 8192  , M = 16384, DFF = 8192;
constexpr int NPROJ = 15872;
constexpr int COL_K = 1024, COL_V = 2048, COL_R = 3072, COL_X0 = 6144, COL_X1 = 7168, COL_VV = 8192, COL_GL = 9216, COL_LW = 15360, COL_G1A = 15488;
constexpr int L_P = 256, L_S = 2048;

enum { I_XP = 0, I_XS, I_CK, I_CV, I_ST, I_C, I_CCTX, I_LN1, I_LN2, I_WMOD, I_BMOD, I_WIN, I_RPB, I_CW, I_CB, I_W0, I_W1, I_W2, I_A0, I_A1, I_A2, I_G1, I_G2,
       I_KK, I_KA, I_RK, I_GNG, I_GNB, I_HCW, I_HCB, I_F1, I_FB1, I_F2, I_FB2, I_FREQ, I_F3, I_HD, I_WPA, I_WPR, I_WPC, I_WOUT, I_FF1, I_BFF1, I_FF2, I_BFF2, I_FING, N_INPUTS };

constexpr size_t OUT_X = 0, OUT_CK = 33554432, OUT_CV = 67108864, OUT_ST = 100663296, OUT_TOTAL = 117440512;

constexpr size_t MiB = 1u << 20;
constexpr size_t WS_CTL = 0, CTL_ZERO_BYTES = 1 * MiB;
constexpr size_t WS_WIN = 2 * MiB;
constexpr size_t WS_W2T = 250 * MiB;
constexpr size_t WS_WP = 260 * MiB;
constexpr size_t WS_WOUT = 308 * MiB;
constexpr size_t WS_WFF1 = 340 * MiB;
constexpr size_t WS_WFF2 = 468 * MiB;
constexpr size_t WS_H = 596 * MiB;
constexpr size_t WS_A = 660 * MiB;
constexpr size_t WS_PROJ = 724 * MiB;
constexpr size_t WS_OALL = 1220 * MiB;
constexpr size_t WS_DEC = 1316 * MiB;
constexpr size_t WS_G = 1444 * MiB;
constexpr size_t WS_TIL = 1476 * MiB;
constexpr size_t WS_CK = 1764 * MiB;
constexpr size_t WS_CV = 1772 * MiB;
constexpr size_t WS_FS = 1780 * MiB;
constexpr size_t WS_FP = 1797 * MiB;
constexpr size_t WS_ZT = 1800 * MiB;
constexpr size_t WS_MOD = 1832 * MiB;
constexpr size_t WS_T2 = 1833 * MiB;
constexpr size_t WS_BONUS = 1837 * MiB;
constexpr size_t WS_TINV = 1838 * MiB;
constexpr size_t WS_Q = WS_TINV;
constexpr size_t WS_WTB = 1870 * MiB;
constexpr size_t WS_END = 1874 * MiB;
constexpr int TILP = 576;
constexpr int LPS = 2120, LPP = 328;

constexpr int CW_BAR = 4096;
constexpr int CW_FNORM = 32768;

constexpr int LDS_SCRATCH = 131072, LDSCTL_OFF = 131072, LDS_BYTES = 147456;

#define LDS_WAIT() asm volatile("s_waitcnt lgkmcnt(0)" ::: "memory")
#define VM_WAIT() asm volatile("s_waitcnt vmcnt(0)" ::: "memory")
__device__ __forceinline__ unsigned cvtpk(float lo, float hi) { f32x2 v = {lo, hi}; bf16x2_t b = __builtin_convertvector(v, bf16x2_t); return __builtin_bit_cast(unsigned, b); }
__device__ __forceinline__ bf16 f2bf(float f) { return (bf16)(cvtpk(f, 0.f) & 0xffffu); }
__device__ __forceinline__ float bf2f(bf16 b) { return __uint_as_float(((unsigned)b) << 16); }
__device__ __forceinline__ float bflo(unsigned w) { return __uint_as_float(w << 16); }
__device__ __forceinline__ float bfhi(unsigned w) { return __uint_as_float(w & 0xffff0000u); }
#define DPPF(v, ctrl) __int_as_float(__builtin_amdgcn_update_dpp(0, __float_as_int(v), (ctrl), 0xf, 0xf, false))
__device__ __forceinline__ float wave_sum(float v) {
    v += DPPF(v, 0xB1); v += DPPF(v, 0x4E); v += DPPF(v, 0x141); v += DPPF(v, 0x140);
    const float a = __int_as_float(__builtin_amdgcn_readlane(__float_as_int(v), 0)), b = __int_as_float(__builtin_amdgcn_readlane(__float_as_int(v), 16)),
                c = __int_as_float(__builtin_amdgcn_readlane(__float_as_int(v), 32)), d = __int_as_float(__builtin_amdgcn_readlane(__float_as_int(v), 48));
    return (a + b) + (c + d);
}
__device__ __forceinline__ float xor32(float v, int lane) { return __int_as_float(__builtin_amdgcn_ds_bpermute((lane ^ 32) << 2, __float_as_int(v))); }
__device__ __forceinline__ int lane_id() { return (int)__builtin_amdgcn_mbcnt_hi(~0u, __builtin_amdgcn_mbcnt_lo(~0u, 0u)); }
__device__ __forceinline__ float sigmoidf_(float x) { return 1.0f / (1.0f + __expf(-x)); }

#define XB_TMO      128
#define XB_XCNT(j)  (256  + 64 * (j))
#define XB_XSUB(j)  (1280 + 64 * (j))
#define XB_XGEN(j)  (2304 + 64 * (j))
#define XB_TOP      3328
#define XB_TOPGEN   3392
#define XCD_BAR_WORDS 3456
#define XB_SPIN_CAP (1u << 20)
__device__ __forceinline__ unsigned xb_ld(unsigned* p)              { return __hip_atomic_load(p, __ATOMIC_RELAXED, __HIP_MEMORY_SCOPE_AGENT); }
__device__ __forceinline__ unsigned xb_add(unsigned* p, unsigned v) { return __hip_atomic_fetch_add(p, v, __ATOMIC_RELAXED, __HIP_MEMORY_SCOPE_AGENT); }
__device__ __forceinline__ unsigned xb_xcc_id() { return (unsigned)__builtin_amdgcn_s_getreg((3 << 11) | 20) & 0xFu; }
#define XB_SPIN(cond, bar) do { unsigned _sp = 0; while (cond) { __builtin_amdgcn_s_sleep(1); \
    if ((++_sp & 255u) == 0u) { if (xb_ld(&(bar)[XB_TMO])) break; if (_sp > XB_SPIN_CAP) { atomicAdd(&(bar)[XB_TMO], 1u); break; } } } } while (0)
struct XcdBarrier { unsigned* bar; unsigned x; volatile LAS unsigned* st; int wave; };
__device__ __forceinline__ XcdBarrier xcd_barrier_post(unsigned* bar, volatile LAS unsigned* st, int wave) {
    XcdBarrier b; b.bar = bar; b.x = xb_xcc_id(); b.st = st; b.wave = wave;
    if (wave == 0 && lane_id() == 0) (void)xb_add(&bar[XB_XCNT(b.x)], 1u);
    return b;
}
__device__ __forceinline__ void xcd_barrier_complete(unsigned* bar, unsigned x, unsigned& nloc, unsigned& nx) {
    const unsigned G = gridDim.x * gridDim.y * gridDim.z;
    unsigned sum, cnt, mine, sp = 0u;
    for (;;) {
        sum = 0u; cnt = 0u; mine = 0u;
#pragma unroll
        for (unsigned j = 0; j < 16; ++j) { const unsigned c = xb_ld(&bar[XB_XCNT(j)]); sum += c; cnt += (c > 0u) ? 1u : 0u; mine = (j == x) ? c : mine; }
        if (sum == G) break;
        __builtin_amdgcn_s_sleep(1);
        if ((++sp & 255u) == 0u) { if (xb_ld(&bar[XB_TMO])) break; if (sp > XB_SPIN_CAP) { atomicAdd(&bar[XB_TMO], 1u); break; } }
    }
    nloc = mine > 0u ? mine : 1u; nx = cnt > 0u ? cnt : 1u;
}
__device__ __forceinline__ void xcd_barrier(const XcdBarrier& b) {
    asm volatile("s_waitcnt vmcnt(0)" ::: "memory");
    __syncthreads();
    if (b.wave == 0 && lane_id() == 0) {
        unsigned* bar = b.bar; asm volatile("" : "+s"(bar));
        __builtin_amdgcn_s_waitcnt(0);
        unsigned nloc = b.st[0], nx = b.st[1];
        if (nloc == 0u) { xcd_barrier_complete(bar, b.x, nloc, nx); b.st[0] = nloc; b.st[1] = nx; }
        const unsigned old = xb_add(&bar[XB_XSUB(b.x)], 1u);
        const unsigned gen = old / nloc;
        if (old + 1u == (gen + 1u) * nloc) {
            __builtin_amdgcn_fence(__ATOMIC_RELEASE, "agent");
            asm volatile("s_waitcnt vmcnt(0)" ::: "memory");
            const unsigned og = xb_add(&bar[XB_TOP], 1u);
            const unsigned tg = og / nx;
            if (og + 1u == (tg + 1u) * nx) xb_add(&bar[XB_TOPGEN], 1u);
            else XB_SPIN(xb_ld(&bar[XB_TOPGEN]) == tg, bar);
            __builtin_amdgcn_fence(__ATOMIC_ACQUIRE, "agent");
            xb_add(&bar[XB_XGEN(b.x)], 1u);
            asm volatile("s_waitcnt vmcnt(0)" ::: "memory");
        } else {
            XB_SPIN(xb_ld(&bar[XB_XGEN(b.x)]) == gen, bar);
            __builtin_amdgcn_fence(__ATOMIC_ACQUIRE, "agent");
            asm volatile("s_waitcnt vmcnt(0)" ::: "memory");
        }
    }
    __syncthreads();
}

struct Args { const float* in[N_INPUTS]; float* out; unsigned char* ws; int ph_lo, ph_hi; };
struct Frame {
    LAS unsigned char* lds;
    int tid, lane, wave, G, bid;
};
constexpr int LDS_ARGT = 131072 + 1024;
__device__ __forceinline__ const float* INP(const Frame& F, int k) {
    const LAS unsigned* t = (const LAS unsigned*)(F.lds + LDS_ARGT) + 2 * k;
    const unsigned lo = __builtin_amdgcn_readfirstlane(t[0]), hi = __builtin_amdgcn_readfirstlane(t[1]);
    return (const float*)(((unsigned long long)hi << 32) | lo);
}
__device__ __forceinline__ float* OUTP(const Frame& F) { return (float*)INP(F, 46); }
__device__ __forceinline__ unsigned char* WSP(const Frame& F) { return (unsigned char*)INP(F, 47); }

namespace pg8 {
constexpr int BM = 256, BK = 64, HALF = 128, HTB = HALF * BK * 2, STAGE_BYTES = 8 * HTB, NXCD = 8, WGM = 4;
__host__ __device__ __forceinline__ int lds_byte(int r, int c) { const int st = (r >> 4) * 2 + (c >> 5), rr = r & 15, cc = c & 31, ob = rr * 64 + cc * 2; return st * 1024 + (ob ^ (((ob >> 9) & 1) << 5)); }
__host__ __device__ __forceinline__ void stage_rc(int b, int& R, int& C) { const int st = b / 1024, sb = b % 1024, swz = sb ^ (((sb >> 9) & 1) << 5); R = (st >> 1) * 16 + swz / 64; C = (st & 1) * 32 + (swz % 64) / 2; }
__host__ __device__ __forceinline__ int perm32(int rho) { const int n = rho >> 4, i = rho & 15; return 8 * (i >> 2) + 4 * n + (i & 3); }

struct Unit { int pm, pn, br; };
struct Gemm { const bf16* A; const bf16* Bt; int lda, ldb, K; int a_br_stride  , a_pair_off  , b_br_tiles  ; };

struct Order {
    int nM, nN, nwg, G, c, nbr;
    __device__ void init(int Mrows, int N, int G_, int c_, int nbr_) { nM = Mrows / BM; nN = N / BM; nwg = nM * nN; G = G_; c = c_; nbr = nbr_; }
    __device__ bool next(int i, Unit& u) const {
        const int it = i / nbr; u.br = i - it * nbr;
        const long L = (long)it * G + c; if (L >= nwg) return false;
        int wgid = (int)L; { const int q = nwg / NXCD, r = nwg % NXCD, xcd = wgid % NXCD, off = wgid / NXCD; wgid = (xcd < r ? xcd * (q + 1) : r * (q + 1) + (xcd - r) * q) + off; }
        const int nig = WGM * nN, gid = wgid / nig, fm = gid * WGM, gsz = (nM - fm) < WGM ? (nM - fm) : WGM;
        u.pm = fm + ((wgid % nig) % gsz); u.pn = (wgid % nig) / gsz; return true;
    }
};
struct Order5 {
    Order o;
    __device__ void init(int Mrows, int G_, int c_) { o.init(Mrows, 20 * BM, G_, c_, 1); }
    __device__ bool next(int i, Unit& u) const { if (!o.next(i, u)) return false; u.br = u.pn >> 2; u.pn &= 3; return true; }
};

template <class Epi, class Sched>
__device__ __forceinline__ void gemm_phase(LAS unsigned char* lds, const Gemm g, const Sched& S, const Epi& E, int wave) {
    int tid = wave * 64 + lane_id(); asm volatile("" : "+v"(tid));
    const int wid = __builtin_amdgcn_readfirstlane(tid >> 6), lane = tid & 63, wr = wid >> 2, wc = wid & 3, fr = lane & 15, fq = lane >> 4;
    const int K = g.K; int nt = K / BK; asm volatile("" : "+s"(nt));
    unsigned voffA[2], voffB[2];
#pragma unroll
    for (int i = 0; i < 2; ++i) { int R, C; stage_rc(tid * 16 + i * 8192, R, C); const int Rb = Epi::PERM ? ((R & ~31) + perm32(R & 31)) : R;
        voffA[i] = (unsigned)(R * g.lda + C) * 2u; voffB[i] = (unsigned)(Rb * g.ldb + C) * 2u; }
    const size_t kstep = (size_t)(BK * 2);
    const size_t hstepA = (size_t)HALF * g.lda * 2, hstepB = (size_t)HALF * g.ldb * 2;
    const unsigned ldsw = (unsigned)wid * 1024u;
    const int aoff = lds_byte(wr * 64 + fr, fq * 8), boff = lds_byte(wc * 32 + fr, fq * 8);
#define PG8_APTR(u) ((const char*)g.A + ((size_t)(u).pm * 256 * g.lda + (size_t)(u).br * g.a_br_stride + (size_t)((u).br >> 1) * g.a_pair_off) * 2)
#define PG8_BPTR(u) ((const char*)g.Bt + ((size_t)((u).br * g.b_br_tiles + (u).pn) * 256 * g.ldb) * 2)
#define PG8_SA(b, h) (((b) * 2 + (h)) * HTB)
#define PG8_SB(b, h) ((4 + (b) * 2 + (h)) * HTB)
#define PG8_STAGE(bufoff, gbase, voff) do { _Pragma("unroll") for (int _i = 0; _i < 2; ++_i) \
        __builtin_amdgcn_global_load_lds((const unsigned*)((const char*)(gbase) + (voff)[_i]), (LAS unsigned*)(lds + (bufoff) + ldsw + _i * 8192), 16, 0, 0); } while (0)
#define PG8_LDA(dst, b, h) do { _Pragma("unroll") for (int m = 0; m < 4; ++m) _Pragma("unroll") for (int k = 0; k < 2; ++k) dst[m][k] = *(const LAS bf16x8*)(lds + PG8_SA(b, h) + aoff + m * 2048 + k * 1024); } while (0)
#define PG8_LDB(dst, b, h) do { _Pragma("unroll") for (int n = 0; n < 2; ++n) _Pragma("unroll") for (int k = 0; k < 2; ++k) dst[n][k] = *(const LAS bf16x8*)(lds + PG8_SB(b, h) + boff + n * 2048 + k * 1024); } while (0)
#define PG8_MMA(ai, bj, At, Bt) do { __builtin_amdgcn_s_setprio(1); _Pragma("unroll") for (int m = 0; m < 4; ++m) _Pragma("unroll") for (int n = 0; n < 2; ++n) _Pragma("unroll") for (int k = 0; k < 2; ++k) \
        acc[ai][bj][m][n] = __builtin_amdgcn_mfma_f32_16x16x32_bf16(Bt[n][k], At[m][k], acc[ai][bj][m][n], 0, 0, 0); __builtin_amdgcn_s_setprio(0); } while (0)
#define PG8_WAIT_V(n) asm volatile("s_waitcnt vmcnt(" #n ")" ::: "memory")
#define PG8_WAIT_L(n) asm volatile("s_waitcnt lgkmcnt(" #n ")" ::: "memory")
#define PG8_BAR __builtin_amdgcn_s_barrier()
#define PG8_SCHED __builtin_amdgcn_sched_barrier(0)
    Unit cur, nxt; int ui = 0;
    if (!S.next(0, cur)) return;
    f32x4 acc[2][2][4][2];
#pragma unroll
    for (int a = 0; a < 2; ++a)
#pragma unroll
        for (int b = 0; b < 2; ++b)
#pragma unroll
            for (int m = 0; m < 4; ++m)
#pragma unroll
                for (int n = 0; n < 2; ++n) acc[a][b][m][n] = (f32x4){0.f, 0.f, 0.f, 0.f};
    bf16x8 At[4][2], B0[2][2], B1[2][2];
    const char* cA = PG8_APTR(cur); const char* cB = PG8_BPTR(cur);
    PG8_STAGE(PG8_SB(0, 0), cB, voffB); PG8_STAGE(PG8_SB(0, 1), cB + hstepB, voffB); PG8_STAGE(PG8_SA(0, 0), cA, voffA); PG8_STAGE(PG8_SA(0, 1), cA + hstepA, voffA);
    if (wr == 1) PG8_BAR;
    PG8_WAIT_V(2); PG8_BAR;
    PG8_STAGE(PG8_SB(1, 0), cB + kstep, voffB); PG8_STAGE(PG8_SA(1, 0), cA + kstep, voffA); PG8_STAGE(PG8_SB(1, 1), cB + hstepB + kstep, voffB);
    PG8_WAIT_V(6); PG8_BAR;
    for (;;) {
        const bool has_next = S.next(ui + 1, nxt);
        const char* nA = has_next ? PG8_APTR(nxt) : cA; const char* nB = has_next ? PG8_BPTR(nxt) : cB;
#pragma unroll 1
        for (int t = 0; t < nt; t += 2) {
            const bool last = (t == nt - 2);
            const char* a1 = cA + (size_t)(t + 1) * kstep;
            const char* a2 = last ? nA : cA + (size_t)(t + 2) * kstep; const char* b2 = last ? nB : cB + (size_t)(t + 2) * kstep;
            const char* a3 = a2 + kstep; const char* b3 = b2 + kstep;
            PG8_LDB(B0, 0, 0); PG8_LDB(B1, 0, 1); PG8_SCHED; PG8_LDA(At, 0, 0); PG8_STAGE(PG8_SA(1, 1), a1 + hstepA, voffA);
            PG8_WAIT_V(8); PG8_WAIT_L(0); PG8_BAR; PG8_MMA(0, 0, At, B0); PG8_MMA(0, 1, At, B1); PG8_BAR; PG8_SCHED;
            PG8_LDA(At, 0, 1); PG8_STAGE(PG8_SB(0, 0), b2, voffB); PG8_STAGE(PG8_SB(0, 1), b2 + hstepB, voffB); PG8_STAGE(PG8_SA(0, 0), a2, voffA);
            PG8_WAIT_V(8); PG8_WAIT_L(0); PG8_BAR; PG8_MMA(1, 0, At, B0); PG8_MMA(1, 1, At, B1); PG8_BAR; PG8_SCHED;
            PG8_LDB(B0, 1, 0); PG8_LDB(B1, 1, 1); PG8_SCHED; PG8_LDA(At, 1, 0); PG8_STAGE(PG8_SA(0, 1), a2 + hstepA, voffA);
            PG8_WAIT_V(8); PG8_WAIT_L(0); PG8_BAR; PG8_MMA(0, 0, At, B0); PG8_MMA(0, 1, At, B1); PG8_BAR; PG8_SCHED;
            PG8_LDA(At, 1, 1); PG8_STAGE(PG8_SB(1, 0), b3, voffB); PG8_STAGE(PG8_SB(1, 1), b3 + hstepB, voffB); PG8_STAGE(PG8_SA(1, 0), a3, voffA);
            PG8_WAIT_V(8); PG8_WAIT_L(0); PG8_BAR; PG8_MMA(1, 0, At, B0); PG8_MMA(1, 1, At, B1); PG8_BAR; PG8_SCHED;
        }
        if (wr == 0) PG8_BAR;
        E(acc, cur, wr, wc, fr, fq);
        if (!has_next) break;
#pragma unroll
        for (int a = 0; a < 2; ++a)
#pragma unroll
            for (int b = 0; b < 2; ++b)
#pragma unroll
                for (int m = 0; m < 4; ++m)
#pragma unroll
                    for (int n = 0; n < 2; ++n) acc[a][b][m][n] = (f32x4){0.f, 0.f, 0.f, 0.f};
        cur = nxt; cA = nA; cB = nB; ++ui;
        if (wr == 1) PG8_BAR;
    }
    PG8_WAIT_V(0);
    PG8_BAR;
#undef PG8_APTR
#undef PG8_BPTR
#undef PG8_SA
#undef PG8_SB
#undef PG8_STAGE
#undef PG8_LDA
#undef PG8_LDB
#undef PG8_MMA
#undef PG8_WAIT_V
#undef PG8_WAIT_L
#undef PG8_BAR
#undef PG8_SCHED
}

__device__ __forceinline__ float mrow_sel(int row) { return 0.f; }
__device__ __forceinline__ int modrow(int row) { return row < NPR ? 0 : 1 + ((row - NPR) >> 11); }

struct EpiProj {
    static constexpr bool PERM = true;
    bf16* proj; float* outk; float* outv; int layer;
    __device__ __forceinline__ void operator()(const f32x4 (&acc)[2][2][4][2], const Unit& u, int wr, int wc, int fr, int fq) const {
        { int t_ = lane_id(); asm volatile("" : "+v"(t_)); fr = t_ & 15; fq = (t_ >> 4) & 3; }
        const int row0 = u.pm * BM + wr * 64 + fr, colb = u.pn * BM + wc * 32 + 8 * fq;
        const int mode = (u.pn == 60) ? 1 : (u.pn == 61 ? 2 : ((u.pn >= 36) ? 3 : 0));
        const bool kv = (u.pm < 32) && (u.pn >= 4) && (u.pn < 12);
#pragma unroll
        for (int ai = 0; ai < 2; ++ai)
#pragma unroll
            for (int m = 0; m < 4; ++m) {
                const int row = row0 + ai * HALF + m * 16;
                bf16* rowp = proj + (size_t)row * NPROJ + colb;
#pragma unroll
                for (int bj = 0; bj < 2; ++bj) {
                    f32x4 v0 = acc[ai][bj][m][0], v1 = acc[ai][bj][m][1];
                    if (mode == 1) { if (colb + bj * HALF < COL_G1A) {
#pragma unroll
                        for (int j = 0; j < 4; ++j) { v0[j] = tanhf(v0[j]); v1[j] = tanhf(v1[j]); } } }
                    else if (mode == 3) {
#pragma unroll
                        for (int j = 0; j < 4; ++j) { v0[j] = sigmoidf_(v0[j]); v1[j] = sigmoidf_(v1[j]); } }
                    else if (mode == 2) { const bool act = (colb + bj * HALF) < 15744;
#pragma unroll
                        for (int j = 0; j < 4; ++j) { v0[j] = act ? sigmoidf_(v0[j]) : 0.f; v1[j] = act ? sigmoidf_(v1[j]) : 0.f; } }
                    u32x4 w; w.x = cvtpk(v0[0], v0[1]); w.y = cvtpk(v0[2], v0[3]); w.z = cvtpk(v1[0], v1[1]); w.w = cvtpk(v1[2], v1[3]);
                    *(u32x4*)(rowp + bj * HALF) = w;
                    if (kv) { const int col = colb + bj * HALF; float* ob = (u.pn < 8) ? outk : outv; const int ch = col - ((u.pn < 8) ? COL_K : COL_V);
                        float* dst = ob + ((size_t)(((row >> 8) * 4 + layer) * 256 + (row & 255))) * 1024 + ch;
                        *(f32x4*)dst = v0; *(f32x4*)(dst + 4) = v1; }
                }
            }
    }
};
struct EpiLora2 {
    static constexpr bool PERM = true;
    bf16* dec; bf16* abuf; bf16* gbuf; const float* w0; const float* a0;
    __device__ __forceinline__ void operator()(const f32x4 (&acc)[2][2][4][2], const Unit& u, int wr, int wc, int fr, int fq) const {
        { int t_ = lane_id(); asm volatile("" : "+v"(t_)); fr = t_ & 15; fq = (t_ >> 4) & 3; }
        const int row0 = u.pm * BM + wr * 64 + fr, colb = u.pn * BM + wc * 32 + 8 * fq;
        const int br = u.br, e = br & 1;
        const float* bsrc = (br < 2) ? w0 + e * 1024 : a0 + e * 1024;
#pragma unroll
        for (int bj = 0; bj < 2; ++bj)
#pragma unroll
            for (int n = 0; n < 2; ++n) {
                const int ch = colb + bj * HALF + 4 * n;
                f32x4 b0 = (f32x4){0.f, 0.f, 0.f, 0.f};
                if (br < 4) b0 = *(const f32x4*)(bsrc + ch);
#pragma unroll
                for (int ai = 0; ai < 2; ++ai)
#pragma unroll
                    for (int m = 0; m < 4; ++m) {
                        const int row = row0 + ai * HALF + m * 16;
                        f32x4 v0 = acc[ai][bj][m][n] + b0;
                        if (br < 2) {
#pragma unroll
                            for (int j = 0; j < 4; ++j) v0[j] = -0.6065306597126334f * sigmoidf_(v0[j]);
                            *(u32x2*)(dec + ((size_t)row * 2 + e) * 1024 + ch) = (u32x2){cvtpk(v0[0], v0[1]), cvtpk(v0[2], v0[3])};
                        } else {
                            if (br < 4) {
#pragma unroll
                                for (int j = 0; j < 4; ++j) v0[j] = sigmoidf_(v0[j]); }
                            bf16* dst = (br < 4) ? abuf + ((size_t)row * 2 + e) * 1024 + ch : gbuf + (size_t)row * 1024 + ch;
                            *(u32x2*)dst = (u32x2){cvtpk(v0[0], v0[1]), cvtpk(v0[2], v0[3])};
                        }
                        __builtin_amdgcn_sched_barrier(0);
                    }
            }
    }
};
struct EpiMerge {
    static constexpr bool PERM = true;
    const bf16* proj; bf16* merged;
    __device__ __forceinline__ void operator()(const f32x4 (&acc)[2][2][4][2], const Unit& u, int wr, int wc, int fr, int fq) const {
        { int t_ = lane_id(); asm volatile("" : "+v"(t_)); fr = t_ & 15; fq = (t_ >> 4) & 3; }
        const int row0 = u.pm * BM + wr * 64 + fr, colb = u.pn * BM + wc * 32 + 8 * fq;
        const int br = u.br;
#pragma unroll
        for (int ai = 0; ai < 2; ++ai)
#pragma unroll
            for (int m = 0; m < 4; ++m) {
                const int row = row0 + ai * HALF + m * 16;
#pragma unroll
                for (int bj = 0; bj < 2; ++bj) {
                    const int col = colb + bj * HALF;
                    const u32x4 gw = *(const u32x4*)(proj + (size_t)row * NPROJ + COL_GL + br * 2048 + col);
                    bf16* dst = merged + (size_t)row * D + col;
                    f32x4 v0 = acc[ai][bj][m][0], v1 = acc[ai][bj][m][1];
                    v0[0] *= bflo(gw.x); v0[1] *= bfhi(gw.x); v0[2] *= bflo(gw.y); v0[3] *= bfhi(gw.y);
                    v1[0] *= bflo(gw.z); v1[1] *= bfhi(gw.z); v1[2] *= bflo(gw.w); v1[3] *= bfhi(gw.w);
                    if (br > 0) { const u32x4 pw = *(const u32x4*)dst;
                        v0[0] += bflo(pw.x); v0[1] += bfhi(pw.x); v0[2] += bflo(pw.y); v0[3] += bfhi(pw.y);
                        v1[0] += bflo(pw.z); v1[1] += bfhi(pw.z); v1[2] += bflo(pw.w); v1[3] += bfhi(pw.w); }
                    u32x4 w; w.x = cvtpk(v0[0], v0[1]); w.y = cvtpk(v0[2], v0[3]); w.z = cvtpk(v1[0], v1[1]); w.w = cvtpk(v1[2], v1[3]);
                    *(u32x4*)dst = w;
                }
            }
    }
};
struct EpiResid {
    static constexpr bool PERM = false;
    float* x; const float* gate;   const float* bias; float gscale;
    __device__ __forceinline__ void operator()(const f32x4 (&acc)[2][2][4][2], const Unit& u, int wr, int wc, int fr, int fq) const {
        { int t_ = lane_id(); asm volatile("" : "+v"(t_)); fr = t_ & 15; fq = (t_ >> 4) & 3; }
        const int row0 = u.pm * BM + wr * 64 + fr, col0 = u.pn * BM + wc * 32 + 4 * fq;
        const int mr = modrow(u.pm * BM);
        const float* gp = gate + (size_t)mr * 12288;
        f32x4 gv[2][2], bv[2][2];
#pragma unroll
        for (int bj = 0; bj < 2; ++bj)
#pragma unroll
            for (int n = 0; n < 2; ++n) { gv[bj][n] = *(const f32x4*)(gp + col0 + bj * HALF + n * 16) * gscale;
                bv[bj][n] = bias ? *(const f32x4*)(bias + col0 + bj * HALF + n * 16) : (f32x4){0.f, 0.f, 0.f, 0.f}; }
#pragma unroll
        for (int ai = 0; ai < 2; ++ai)
#pragma unroll
            for (int m = 0; m < 4; ++m) { float* rowp = x + (size_t)(row0 + ai * HALF + m * 16) * D + col0;
#pragma unroll
                for (int bj = 0; bj < 2; ++bj)
#pragma unroll
                    for (int n = 0; n < 2; ++n) { f32x4* p = (f32x4*)(rowp + bj * HALF + n * 16); const f32x4 xo = *p; *p = xo + gv[bj][n] * (acc[ai][bj][m][n] + bv[bj][n]); }
                asm volatile("" ::: "memory"); }
    }
};
struct EpiFF1 {
    static constexpr bool PERM = true;
    bf16* U; const float* bias;
    __device__ __forceinline__ void operator()(const f32x4 (&acc)[2][2][4][2], const Unit& u, int wr, int wc, int fr, int fq) const {
        { int t_ = lane_id(); asm volatile("" : "+v"(t_)); fr = t_ & 15; fq = (t_ >> 4) & 3; }
        const int row0 = u.pm * BM + wr * 64 + fr, colb = u.pn * BM + wc * 32 + 8 * fq;
        f32x4 bv[2][2];
#pragma unroll
        for (int bj = 0; bj < 2; ++bj)
#pragma unroll
            for (int n = 0; n < 2; ++n) bv[bj][n] = *(const f32x4*)(bias + colb + bj * HALF + 4 * n);
#pragma unroll
        for (int ai = 0; ai < 2; ++ai)
#pragma unroll
            for (int m = 0; m < 4; ++m) { bf16* rowp = U + (size_t)(row0 + ai * HALF + m * 16) * DFF + colb;
#pragma unroll
                for (int bj = 0; bj < 2; ++bj) { f32x4 v0 = acc[ai][bj][m][0] + bv[bj][0], v1 = acc[ai][bj][m][1] + bv[bj][1];
#pragma unroll
                    for (int j = 0; j < 4; ++j) { const float a = fmaxf(v0[j], 0.f), b = fmaxf(v1[j], 0.f); v0[j] = a * a; v1[j] = b * b; }
                    u32x4 w; w.x = cvtpk(v0[0], v0[1]); w.y = cvtpk(v0[2], v0[3]); w.z = cvtpk(v1[0], v1[1]); w.w = cvtpk(v1[2], v1[3]);
                    *(u32x4*)(rowp + bj * HALF) = w; } }
    }
};
}

__device__ __forceinline__ void transpose_item(const float* W, int K, int N, bf16* WT, int ldk, int row_off, LAS bf16* scr, int item, int lane) {
    const int nblk = N / 64, kb = item / nblk, nb = item % nblk, k0 = 32 * kb, n = 64 * nb + lane;
    const float* src = W + (size_t)k0 * N + n;
    float v[32];
#pragma unroll
    for (int i = 0; i < 32; ++i) v[i] = src[(size_t)i * N];
    bf16* dst = WT + (size_t)(row_off + n) * ldk + k0;
#pragma unroll
    for (int q = 0; q < 4; ++q) *(u32x4*)(dst + 8 * q) = (u32x4){cvtpk(v[8 * q], v[8 * q + 1]), cvtpk(v[8 * q + 2], v[8 * q + 3]), cvtpk(v[8 * q + 4], v[8 * q + 5]), cvtpk(v[8 * q + 6], v[8 * q + 7])};
    (void)scr; (void)K;
}

__device__ __forceinline__ void convert_layer(const Frame& F, int l, LAS bf16* scr, int gw, int NGW) {
    unsigned char* ws = WSP(F);
        bf16* WinT = (bf16*)(ws + WS_WIN) + (size_t)l * NPROJ * D;
        {   const int n_items = (D / 32) * (15360 / 64); const float* W = INP(F, I_WIN) + (size_t)l * D * 15360;
            for (int it = gw; it < n_items; it += NGW) transpose_item(W, D, 15360, WinT, D, 0, scr, it, F.lane); }
        for (int e = 0; e < 2; ++e) {
            const int n_items = (D / 32);
            const float* W1 = INP(F, I_W1) + ((size_t)l * 2 + e) * D * 64; const float* A1 = INP(F, I_A1) + ((size_t)l * 2 + e) * D * 64;
            for (int it = gw; it < n_items; it += NGW) { transpose_item(W1, D, 64, WinT, D, COL_LW + e * 64, scr, it, F.lane); transpose_item(A1, D, 64, WinT, D, COL_LW + 128 + e * 64, scr, it, F.lane); }
        }
        {   const int n_items = (D / 32) * 2; const float* W = INP(F, I_G1) + (size_t)l * D * 128;
            for (int it = gw; it < n_items; it += NGW) transpose_item(W, D, 128, WinT, D, COL_LW + 256, scr, it, F.lane); }
        for (int i = gw * 64 + F.lane; i < 128 * D / 8; i += NGW * 64) ((u32x4*)(WinT + (size_t)15744 * D))[i] = (u32x4){0u, 0u, 0u, 0u};
        for (int br = 0; br < 3; ++br) { const float* W = INP(F, I_WPA + br) + (size_t)l * 1024 * D; bf16* WT = (bf16*)(ws + WS_WP) + ((size_t)l * 3 + br) * D * 1024;
            const int n_items = (1024 / 32) * (D / 64);
            for (int it = gw; it < n_items; it += NGW) transpose_item(W, 1024, D, WT, 1024, 0, scr, it, F.lane); }
        {   const float* W = INP(F, I_WOUT) + (size_t)l * D * D; bf16* WT = (bf16*)(ws + WS_WOUT) + (size_t)l * D * D; const int n_items = (D / 32) * (D / 64);
            for (int it = gw; it < n_items; it += NGW) transpose_item(W, D, D, WT, D, 0, scr, it, F.lane); }
        {   const float* W = INP(F, I_FF1) + (size_t)l * D * DFF; bf16* WT = (bf16*)(ws + WS_WFF1) + (size_t)l * D * DFF; const int n_items = (D / 32) * (DFF / 64);
            for (int it = gw; it < n_items; it += NGW) transpose_item(W, D, DFF, WT, D, 0, scr, it, F.lane); }
        {   const float* W = INP(F, I_FF2) + (size_t)l * D * DFF; bf16* WT = (bf16*)(ws + WS_WFF2) + (size_t)l * D * DFF; const int n_items = (DFF / 32) * (D / 64);
            for (int it = gw; it < n_items; it += NGW) transpose_item(W, DFF, D, WT, DFF, 0, scr, it, F.lane); }
        {   bf16* W2T = (bf16*)(ws + WS_W2T) + (size_t)l * 5120 * 128;
            const float* w2 = INP(F, I_W2) + (size_t)l * 2 * 64 * 1024; const float* a2 = INP(F, I_A2) + (size_t)l * 2 * 64 * 1024; const float* g2 = INP(F, I_G2) + (size_t)l * 128 * 1024;
            for (int it = gw; it < 32 * 6; it += NGW) { const int m = it / 32, sub = it % 32;
                const float* W = m == 0 ? w2 : (m == 1 ? w2 + 65536 : (m == 2 ? a2 : (m == 3 ? a2 + 65536 : (m == 4 ? g2 : g2 + 65536))));
                const int br = m < 4 ? m : 4, koff = m < 4 ? 64 * (m & 1) : (m == 4 ? 0 : 64);
                transpose_item(W, 64, 1024, W2T + (size_t)br * 1024 * 128 + koff, 128, 0, scr, sub, F.lane); }
            for (int i = gw * 64 + F.lane; i < 4096 * 8; i += NGW * 64) { const int n = i >> 3, k8 = (i & 7) * 8, br = n >> 10;
                *(u32x4*)(W2T + (size_t)n * 128 + ((br & 1) ? 0 : 64) + k8) = (u32x4){0u, 0u, 0u, 0u}; }
        }
    }

__device__ __forceinline__ void prologue0(const Frame& F, const Args& a) {
    unsigned char* ws = WSP(F);
    LAS bf16* scr = (LAS bf16*)(F.lds + F.wave * 16384);
    const int gw = F.bid * 8 + F.wave, NGW = F.G * 8;
    convert_layer(F, 0, scr, gw, NGW);
    {   const float* ck = INP(F, I_CK); const float* cv = INP(F, I_CV); bf16* ok = (bf16*)(ws + WS_CK); bf16* ov = (bf16*)(ws + WS_CV);
        const int n4 = 4 * 4 * 256 * 1024 / 4;
        for (int i = gw * 64 + F.lane; i < n4; i += NGW * 64) { const f32x4 x = ((const f32x4*)ck)[i], y = ((const f32x4*)cv)[i];
            ((u32x2*)ok)[i] = (u32x2){cvtpk(x[0], x[1]), cvtpk(x[2], x[3])}; ((u32x2*)ov)[i] = (u32x2){cvtpk(y[0], y[1]), cvtpk(y[2], y[3])}; }
    }
    {   LAS float* sv = (LAS float*)(F.lds + 65536);
        __syncthreads();
        for (int i = F.tid; i < 5 * D; i += 512) { const int r = i / D, d = i - r * D; const float x = (r == 0) ? INP(F, I_CCTX)[d] : INP(F, I_C)[(r - 1) * D + d]; sv[i] = x / (1.0f + __expf(-x)); }
        __syncthreads();
        float* PART = (float*)(ws + WS_Q);
        const int n_items = DEPTH * 48 * 8;
        for (int it = gw; it < n_items; it += NGW) {
            const int l = it / 384, rem = it % 384, jc = rem >> 3, ds = rem & 7, j4 = jc * 256 + 4 * F.lane;
            const float* W = INP(F, I_WMOD) + (size_t)l * D * 12288 + (size_t)(ds * 256) * 12288 + j4;
            f32x4 acc[5];
#pragma unroll
            for (int r = 0; r < 5; ++r) acc[r] = (f32x4){0.f, 0.f, 0.f, 0.f};
#pragma unroll 4
            for (int d = 0; d < 256; d += 4) {
                f32x4 w[4];
#pragma unroll
                for (int q = 0; q < 4; ++q) w[q] = *(const f32x4*)(W + (size_t)(d + q) * 12288);
#pragma unroll
                for (int r = 0; r < 5; ++r) { const f32x4 s = *(const LAS f32x4*)(sv + r * D + ds * 256 + d);
#pragma unroll
                    for (int q = 0; q < 4; ++q) acc[r] += w[q] * s[q]; }
            }
#pragma unroll
            for (int r = 0; r < 5; ++r) *(f32x4*)(PART + (((size_t)ds * 4 + l) * 5 + r) * 12288 + j4) = acc[r];
        }
        __syncthreads();
    }
    {   float* T2 = (float*)(ws + WS_T2);
        const int n_items = DEPTH * (L_S + L_P);
        for (int it = gw; it < n_items; it += NGW) {
            const int l = it / (L_S + L_P), rr = it % (L_S + L_P), sel = rr < L_S ? 0 : 1, t = sel ? rr - L_S : rr, L = sel ? L_P : L_S;
            float zf = 0.f;
            {   const float tt = (float)t / (float)(L - 1);
                const float w = (6.283185307179586f * (float)t) / (float)L;
                const int band = (F.lane - 1) & 15;
                const float f = 1e-4f + (float)band * ((15.0f - 1e-4f) / 15.0f);
                const float fw = f * w;
                const double rd = (double)fw - 6.283185307179586 * rint((double)fw * 0.15915494309189535);
                const float rf = (float)rd;
                zf = (F.lane == 0) ? tt : (F.lane <= 16 ? __cosf(rf) : -__sinf(rf));
            }
            const float* f1 = INP(F, I_F1) + (size_t)l * 33 * 64; const float* f2 = INP(F, I_F2) + (size_t)l * 64 * 64;
            const float fq = INP(F, I_FREQ)[l * 64 + F.lane];
            float s = INP(F, I_FB1)[l * 64 + F.lane];
            for (int i = 0; i < 33; ++i) s += __int_as_float(__builtin_amdgcn_readlane(__float_as_int(zf), i)) * f1[i * 64 + F.lane];
            float x = fq * s; { const double rd = (double)x - 6.283185307179586 * rint((double)x * 0.15915494309189535); x = (float)rd; }
            const float t1 = __sinf(x);
            float s2 = INP(F, I_FB2)[l * 64 + F.lane];
            for (int i = 0; i < 64; ++i) s2 += __int_as_float(__builtin_amdgcn_readlane(__float_as_int(t1), i)) * f2[i * 64 + F.lane];
            float y = fq * s2; { const double rd = (double)y - 6.283185307179586 * rint((double)y * 0.15915494309189535); y = (float)rd; }
            T2[(((size_t)l * 2 + sel) * L_S + t) * 64 + F.lane] = __sinf(y);
        }
    }
    {   bf16* FS = (bf16*)(ws + WS_FS); bf16* FP = (bf16*)(ws + WS_FP);
        for (int i = gw * 64 + F.lane; i < DEPTH * 1024 * 72; i += NGW * 64) { const int row = i / 72, p = i % 72; const int m = p < 32 ? p : p - 32 + 32;
            FS[(size_t)row * LPS + (p < 32 ? p : L_S + p)] = 0; FP[(size_t)row * LPP + (p < 32 ? p : L_P + p)] = 0; (void)m; }
    }
}

__device__ __forceinline__ void prologue1(const Frame& F, const Args& a) {
    unsigned char* ws = WSP(F);
    const int gw = F.bid * 8 + F.wave, NGW = F.G * 8;
    {   const float* PART = (const float*)(ws + WS_Q); float* MOD = (float*)(ws + WS_MOD);
        for (int i = (F.bid * 8 + F.wave) * 64 + F.lane; i < DEPTH * 5 * 12288 / 4; i += F.G * 8 * 64) {
            const int l = i / (5 * 3072), j4 = (i % 3072) * 4;
            f32x4 s = *(const f32x4*)(INP(F, I_BMOD) + l * 12288 + j4);
#pragma unroll
            for (int ds = 0; ds < 8; ++ds) s += ((const f32x4*)PART)[(size_t)ds * (DEPTH * 5 * 3072) + i];
            ((f32x4*)MOD)[i] = s; }
    }
    const float* T2 = (const float*)(ws + WS_T2);
    float* FNORM = (float*)(ws + WS_CTL) + CW_FNORM;
    const int items_s = DEPTH * 16 * (L_S / 64), items_p = DEPTH * 16 * (L_P / 64);
    for (int it = gw; it < items_s + items_p; it += NGW) {
        int sel, l, cg, tc;
        if (it < items_s) { sel = 0; l = it / (16 * 32); cg = (it / 32) % 16; tc = it % 32; } else { const int r = it - items_s; sel = 1; l = r / (16 * 4); cg = (r / 4) % 16; tc = r % 4; }
        const int L = sel ? L_P : L_S, c = cg * 64 + F.lane;
        const float* f3 = INP(F, I_F3) + (size_t)l * 64 * 1024 + c;
        float w3[64];
#pragma unroll
        for (int j = 0; j < 64; ++j) w3[j] = f3[(size_t)j * 1024];
        const float delta = fabsf(-3.0701134573253946f + (float)c * ((-15.350567286626973f + 3.0701134573253946f) / 1023.0f));
        bf16* dst = sel ? (bf16*)(ws + WS_FP) + ((size_t)l * 1024 + c) * LPP : (bf16*)(ws + WS_FS) + ((size_t)l * 1024 + c) * LPS;
        float asum = 0.f;
        for (int tt = 0; tt < 64; ++tt) {
            const int t = tc * 64 + tt;
            const float tv = T2[(((size_t)l * 2 + sel) * L_S + t) * 64 + F.lane];
            float s = 0.f;
#pragma unroll
            for (int j = 0; j < 64; ++j) s += __int_as_float(__builtin_amdgcn_readlane(__float_as_int(tv), j)) * w3[j];
            const float dist = fabsf((float)(t - L / 2)) / (float)L;
            const float fv = s * __expf(-dist * delta);
            asum += fabsf(fv);
            dst[32 + (L - 1 - t)] = f2bf(fv);
        }
        atomicAdd(FNORM + ((size_t)l * 2 + sel) * 1024 + c, asum);
    }
}

__device__ __forceinline__ void norm_phase(const Frame& F, const float* xp, const float* xs, float* xcopy, const float* g, const float* mod, int i_sh, int i_sc, bf16* hout) {
    const int gw = F.bid * 8 + F.wave, NGW = F.G * 8;
    for (int row = gw; row < M; row += NGW) {
        const float* xr = row < NPR ? xp + (size_t)row * D : xs + (size_t)(row - NPR) * D;
        const float* mr = mod + (size_t)pg8::modrow(row) * 12288;
        f32x4 v[8]; float ss = 0.f;
#pragma unroll
        for (int j = 0; j < 8; ++j) { v[j] = ((const f32x4*)xr)[F.lane + 64 * j]; ss += (v[j][0] * v[j][0] + v[j][1] * v[j][1]) + (v[j][2] * v[j][2] + v[j][3] * v[j][3]); }
        const float rstd = 1.0f / sqrtf(wave_sum(ss) * (1.0f / D) + 1e-6f);
        if (xcopy) {
#pragma unroll
            for (int j = 0; j < 8; ++j) ((f32x4*)(xcopy + (size_t)row * D))[F.lane + 64 * j] = v[j]; }
#pragma unroll
        for (int j = 0; j < 8; ++j) {
            const f32x4 gg = ((const f32x4*)g)[F.lane + 64 * j], sc = ((const f32x4*)(mr + i_sc * D))[F.lane + 64 * j], sh = ((const f32x4*)(mr + i_sh * D))[F.lane + 64 * j];
            const f32x4 o = v[j] * rstd * gg * (1.0f + sc) + sh;
            ((u32x2*)(hout + (size_t)row * D))[F.lane + 64 * j] = (u32x2){cvtpk(o[0], o[1]), cvtpk(o[2], o[3])};
        }
    }
}
__device__ __forceinline__ void final_norm_phase(const Frame& F, float* x, const float* g) {
    const int gw = F.bid * 8 + F.wave, NGW = F.G * 8;
    for (int row = gw; row < M; row += NGW) {
        float* xr = x + (size_t)row * D;
        f32x4 v[8]; float ss = 0.f;
#pragma unroll
        for (int j = 0; j < 8; ++j) { v[j] = ((const f32x4*)xr)[F.lane + 64 * j]; ss += (v[j][0] * v[j][0] + v[j][1] * v[j][1]) + (v[j][2] * v[j][2] + v[j][3] * v[j][3]); }
        const float rstd = 1.0f / sqrtf(wave_sum(ss) * (1.0f / D) + 1e-6f);
#pragma unroll
        for (int j = 0; j < 8; ++j) { const f32x4 gg = ((const f32x4*)g)[F.lane + 64 * j]; ((f32x4*)xr)[F.lane + 64 * j] = v[j] * rstd * gg; }
    }
}

__device__ __forceinline__ s16x4 vtr(const LAS unsigned char* p) { return __builtin_bit_cast(s16x4, __builtin_amdgcn_ds_read_tr16_b64_v4i16((LAS s16x4*)p)); }

struct AttnState { float m, l; f32x16 o[2]; };

__device__ __forceinline__ void attn_loadk(bf16x8 (&kf)[2][4], const bf16* kbase, size_t kstride, int lane) {
    const bf16* kp = kbase + (size_t)(lane & 31) * kstride + 8 * (lane >> 5);
#pragma unroll
    for (int kt = 0; kt < 2; ++kt)
#pragma unroll
        for (int ks = 0; ks < 4; ++ks) kf[kt][ks] = *(const bf16x8*)(kp + (size_t)(32 * kt) * kstride + 16 * ks);
}
template <bool HASB, class BIAS>
__device__ __forceinline__ void attend64(AttnState& st, const bf16x8 (&qf)[4], bf16x8 (&kf)[2][4], const bf16* knext, size_t knstride, const LAS unsigned char* vb, const BIAS& bias, int lane) {
    constexpr int NT = 2;
    const int h = lane >> 5;
    f32x16 s[NT];
#pragma unroll
    for (int kt = 0; kt < NT; ++kt) {
        f32x16 acc;
#pragma unroll
        for (int i = 0; i < 16; ++i) acc[i] = 0.f;
#pragma unroll
        for (int ks = 0; ks < 4; ++ks) acc = __builtin_amdgcn_mfma_f32_32x32x16_bf16(kf[kt][ks], qf[ks], acc, 0, 0, 0);
        s[kt] = acc;
    }
    if (knext) attn_loadk(kf, knext, knstride, lane);
    float gm = -3.0e38f;
#pragma unroll
    for (int kt = 0; kt < NT; ++kt)
#pragma unroll
        for (int i = 0; i < 16; ++i) {
            float v = s[kt][i] * 0.125f;
            if (HASB) v = bias(kt, (i & 3) + 8 * (i >> 2) + 4 * h, v);
            s[kt][i] = v; gm = fmaxf(gm, v);
        }
    gm = fmaxf(gm, xor32(gm, lane));
    const float mnew = fmaxf(st.m, gm);
    const float alpha = __expf(st.m - mnew);
    float ps = 0.f;
#pragma unroll
    for (int kt = 0; kt < NT; ++kt)
#pragma unroll
        for (int i = 0; i < 16; ++i) { const float p = __expf(s[kt][i] - mnew); s[kt][i] = p; ps += p; }
    st.l = st.l * alpha + ps; st.m = mnew;
#pragma unroll
    for (int i = 0; i < 16; ++i) { st.o[0][i] *= alpha; st.o[1][i] *= alpha; }
    const int i16 = lane & 15, tq = i16 >> 2, tp = i16 & 3, blk = (lane >> 4) & 1;
#pragma unroll
    for (int kt = 0; kt < NT; ++kt) {
#pragma unroll
        for (int ss = 0; ss < 2; ++ss) {
            u32x4 pw; pw.x = cvtpk(s[kt][8 * ss + 0], s[kt][8 * ss + 1]); pw.y = cvtpk(s[kt][8 * ss + 2], s[kt][8 * ss + 3]); pw.z = cvtpk(s[kt][8 * ss + 4], s[kt][8 * ss + 5]); pw.w = cvtpk(s[kt][8 * ss + 6], s[kt][8 * ss + 7]);
            const bf16x8 pf = __builtin_bit_cast(bf16x8, pw);
#pragma unroll
            for (int dt = 0; dt < 2; ++dt) {
                const LAS unsigned char* p0 = vb + kt * 4096 + (16 * ss + 4 * h + tq) * 128 + (dt * 32 + 16 * blk + 4 * tp) * 2;
                const s16x4 lo = vtr(p0), hi = vtr(p0 + 8 * 128);
                const bf16x8 vf = __builtin_shufflevector(lo, hi, 0, 1, 2, 3, 4, 5, 6, 7);
                st.o[dt] = __builtin_amdgcn_mfma_f32_32x32x16_bf16(vf, pf, st.o[dt], 0, 0, 0);
            }
        }
    }
}

__device__ __forceinline__ void attn_store(const AttnState& st, bf16* orow  , int lane) {
    const int h = lane >> 5;
    const float lt = st.l + xor32(st.l, lane);
    const float inv = 1.0f / lt;
#pragma unroll
    for (int dt = 0; dt < 2; ++dt)
#pragma unroll
        for (int g = 0; g < 4; ++g) {
            const u32x2 w = (u32x2){cvtpk(st.o[dt][4 * g] * inv, st.o[dt][4 * g + 1] * inv), cvtpk(st.o[dt][4 * g + 2] * inv, st.o[dt][4 * g + 3] * inv)};
            *(u32x2*)(orow + dt * 32 + 8 * g + 4 * h) = w;
        }
}

__device__ __forceinline__ void attention_phase(const Frame& F, const Args& a, int layer) {
    unsigned char* ws = WSP(F);
    const bf16* proj = (const bf16*)(ws + WS_PROJ);
    bf16* oall = (bf16*)(ws + WS_OALL);
    const int lane = F.lane, w = F.wave, r = lane & 31, h = lane >> 5;
    LAS unsigned char* lds = F.lds;
    LAS float* rpbl = (LAS float*)(lds + 122880);
    for (int u = F.bid; u < 1024; u += F.G) {
        __syncthreads();
        if (u < 512) {
            const int b = u >> 4, hd = u & 15;
            const int tok0 = b * 256;
            for (int i = F.tid; i < 256 * 8; i += 512) { const int key = i >> 3, pc = i & 7;
                *(LAS u32x4*)(lds + key * 128 + pc * 16) = *(const u32x4*)(proj + (size_t)(tok0 + key) * NPROJ + COL_V + hd * 64 + pc * 8); }
            __syncthreads();
            bf16x8 qf[4];
            { const bf16* qp = proj + (size_t)(tok0 + 32 * w + r) * NPROJ + hd * 64 + 8 * h;
#pragma unroll
              for (int ks = 0; ks < 4; ++ks) qf[ks] = *(const bf16x8*)(qp + 16 * ks); }
            AttnState st; st.m = -3.0e38f; st.l = 0.f;
#pragma unroll
            for (int i = 0; i < 16; ++i) { st.o[0][i] = 0.f; st.o[1][i] = 0.f; }
            const bf16* kbase = proj + (size_t)tok0 * NPROJ + COL_K + hd * 64;
            bf16x8 kf[2][4];
            attn_loadk(kf, kbase, (size_t)NPROJ, lane);
#pragma unroll 1
            for (int kg = 0; kg < 4; ++kg)
                attend64<false>(st, qf, kf, kg < 3 ? kbase + (size_t)(64 * (kg + 1)) * NPROJ : nullptr, (size_t)NPROJ, lds + kg * 8192, [&](int, int, float v) { return v; }, lane);
            attn_store(st, oall + (size_t)(tok0 + 32 * w + r) * 3072 + hd * 64, lane);
        } else {
            const int uu = u - 512, b = uu >> 7, hd = (uu >> 3) & 15, rg = uu & 7;
            const int tokb = NPR + b * 2048;
            int rlo = 4 * rg - 4; rlo = rlo < 0 ? 0 : (rlo > 24 ? 24 : rlo);
            int rhi0 = 4 * rg + 3 - 4; rhi0 = rhi0 < 0 ? 0 : (rhi0 > 24 ? 24 : rhi0); const int nr = rhi0 + 8 - rlo;
            for (int i = F.tid; i < nr * 64 * 8; i += 512) { const int key = i >> 3, pc = i & 7;
                *(LAS u32x4*)(lds + key * 128 + pc * 16) = *(const u32x4*)(proj + (size_t)(tokb + rlo * 64 + key) * NPROJ + COL_V + hd * 64 + pc * 8); }
            const bf16* cv = (const bf16*)(ws + WS_CV) + ((size_t)(b * 4 + layer) * 256) * 1024 + hd * 64;
            const bf16* ck = (const bf16*)(ws + WS_CK) + ((size_t)(b * 4 + layer) * 256) * 1024 + hd * 64;
            for (int i = F.tid; i < 256 * 8; i += 512) { const int key = i >> 3, pc = i & 7;
                *(LAS u32x4*)(lds + 90112 + key * 128 + pc * 16) = *(const u32x4*)(cv + (size_t)key * 1024 + pc * 8); }
            for (int i = F.tid; i < 465; i += 512) rpbl[i] = INP(F, I_RPB)[((size_t)layer * 16 + hd) * 465 + i];
            __syncthreads();
            const int qrow = 4 * rg + (w >> 1), qc = (w & 1) * 32 + r;
            int r0 = qrow - 4; r0 = r0 < 0 ? 0 : (r0 > 24 ? 24 : r0);
            int c0 = qc - 8; c0 = c0 < 0 ? 0 : (c0 > 48 ? 48 : c0);
            const int qtok = tokb + qrow * 64 + (w & 1) * 32 + r;
            bf16x8 qf[4];
            { const bf16* qp = proj + (size_t)qtok * NPROJ + hd * 64 + 8 * h;
#pragma unroll
              for (int ks = 0; ks < 4; ++ks) qf[ks] = *(const bf16x8*)(qp + 16 * ks); }
            AttnState st; st.m = -3.0e38f; st.l = 0.f;
#pragma unroll
            for (int i = 0; i < 16; ++i) { st.o[0][i] = 0.f; st.o[1][i] = 0.f; }
            const bf16* kloc = proj + (size_t)tokb * NPROJ + COL_K + hd * 64;
            bf16x8 kf[2][4];
            attn_loadk(kf, kloc + (size_t)(r0 * 64) * NPROJ, (size_t)NPROJ, lane);
#pragma unroll 1
            for (int grp = 0; grp < 12; ++grp) {
                const bf16* knext = grp < 7 ? kloc + (size_t)((r0 + grp + 1) * 64) * NPROJ : (grp < 11 ? ck + (size_t)((grp - 7) * 64) * 1024 : nullptr);
                const size_t knstride = grp < 7 ? (size_t)NPROJ : (size_t)1024;
                if (grp < 8) { const int kr = r0 + grp;
                    attend64<true>(st, qf, kf, knext, knstride, lds + ((kr - rlo) * 64) * 128,
                        [&](int kt, int kin, float v) { const int kc = kt * 32 + kin; const bool ok = (kc >= c0) && (kc < c0 + 16);
                            const int dr = kr - qrow + 7, dc = kc - qc + 15; const int idx = ok ? dr * 31 + dc : 0; return ok ? v + rpbl[idx] : -1.0e30f; }, lane);
                } else attend64<false>(st, qf, kf, knext, knstride, lds + 90112 + (grp - 8) * 8192, [&](int, int, float v) { return v; }, lane);
            }
            attn_store(st, oall + (size_t)qtok * 3072 + hd * 64, lane);
        }
    }
    __syncthreads();
}

__device__ __forceinline__ float row_sum16(float v) { v += DPPF(v, 0xB1); v += DPPF(v, 0x4E); v += DPPF(v, 0x141); v += DPPF(v, 0x140); return v; }
__device__ __forceinline__ f32x4 unpack4(u32x2 w) { return (f32x4){bflo(w.x), bfhi(w.x), bflo(w.y), bfhi(w.y)}; }
__device__ __forceinline__ u32x2 pack4(f32x4 v) { return (u32x2){cvtpk(v[0], v[1]), cvtpk(v[2], v[3])}; }
__device__ __forceinline__ void rwkv_tinv_unit(const Frame& F, int unit) {
    unsigned char* ws = WSP(F);
    const bf16* til = (const bf16*)(ws + WS_TIL);
    bf16* tinv = (bf16*)(ws + WS_TINV);
    int lane = lane_id(); asm volatile("" : "+v"(lane));
    const int r = lane & 31, h = lane >> 5;
    LAS float* Lw = (LAS float*)(F.lds + F.wave * 16384);
    {
        const int run = unit >> 5, e = (unit >> 4) & 1, hd = unit & 15;
        const size_t tok = (size_t)(run * 32 + (e ? 31 - r : r));
        const bf16* rowp = til + (tok * 16 + hd) * TILP + e * 256 + 8 * h;
        f32x16 acc;
#pragma unroll
        for (int i = 0; i < 16; ++i) acc[i] = 0.f;
        bf16x8 bfr[4], afr[4];
#pragma unroll
        for (int ks = 0; ks < 4; ++ks) { afr[ks] = *(const bf16x8*)(rowp + 16 * ks); bfr[ks] = *(const bf16x8*)(rowp + 64 + 16 * ks); }
#pragma unroll
        for (int ks = 0; ks < 4; ++ks) acc = __builtin_amdgcn_mfma_f32_32x32x16_bf16(bfr[ks], afr[ks], acc, 0, 0, 0);
#pragma unroll
        for (int g = 0; g < 4; ++g) { const int j0 = 8 * g + 4 * h; f32x4 v;
#pragma unroll
            for (int q = 0; q < 4; ++q) v[q] = (j0 + q < r) ? acc[4 * g + q] : 0.f;
            *(LAS f32x4*)(Lw + r * 36 + j0) = v; }
        LDS_WAIT(); asm volatile("" ::: "memory");
        float X[32];
#pragma unroll
        for (int i = 0; i < 32; ++i) {
            float s = (i == r) ? 1.f : 0.f;
#pragma unroll
            for (int jq = 0; jq < (i + 3) / 4; ++jq) { const f32x4 lv = *(const LAS f32x4*)(Lw + i * 36 + 4 * jq);
#pragma unroll
                for (int q = 0; q < 4; ++q) if (4 * jq + q < i) s += lv[q] * X[4 * jq + q]; }
            X[i] = s;
        }
        if (h == 0) { bf16* o = tinv + (size_t)unit * 1024 + r;
#pragma unroll
            for (int i = 0; i < 32; ++i) o[i * 32] = f2bf(X[i]); }
        LDS_WAIT(); asm volatile("" ::: "memory");
    }
}

__device__ __forceinline__ f32x4 exp4(f32x4 x) { return (f32x4){__expf(x[0]), __expf(x[1]), __expf(x[2]), __expf(x[3])}; }
__device__ __forceinline__ f32x4 rcp4(f32x4 x) { return (f32x4){__builtin_amdgcn_rcpf(x[0]), __builtin_amdgcn_rcpf(x[1]), __builtin_amdgcn_rcpf(x[2]), __builtin_amdgcn_rcpf(x[3])}; }
__device__ __forceinline__ void rwkv_prep_phase(const Frame& F, const Args& a, int layer) {
    unsigned char* ws = WSP(F);
    const bf16* proj = (const bf16*)(ws + WS_PROJ);
    const bf16* abuf = (const bf16*)(ws + WS_A);
    const bf16* logw = (const bf16*)(ws + WS_DEC);
    bf16* til = (bf16*)(ws + WS_TIL);
    float* bonus = (float*)(ws + WS_BONUS);
    float* wtb = (float*)(ws + WS_WTB);
    const float* cw = INP(F, I_CW) + (size_t)layer * 3 * 3072; const float* cb = INP(F, I_CB) + (size_t)layer * 3072;
    for (int item = F.wave * F.G + F.bid; item < 2048; item += 8 * F.G) {
        int lane = lane_id(); asm volatile("" : "+v"(lane));
        const int run = item >> 2, tok0 = run * 32, cg = item & 3, c4 = cg * 256 + 4 * lane, head = cg * 4 + (lane >> 4), hl = 4 * (lane & 15);
        const int t0 = tok0 < NPR ? (tok0 & 255) : ((tok0 - NPR) & 2047), L = tok0 < NPR ? L_P : L_S;
        const f32x4 kkw = *(const f32x4*)(INP(F, I_KK) + layer * 1024 + c4), kaw = *(const f32x4*)(INP(F, I_KA) + layer * 1024 + c4), rkw = *(const f32x4*)(INP(F, I_RK) + layer * 1024 + c4);
        f32x4 tot1 = (f32x4){0.f, 0.f, 0.f, 0.f};
#pragma unroll 1
        for (int q = 0; q < 4; ++q) { f32x4 t[8];
#pragma unroll
          for (int i = 0; i < 8; ++i) t[i] = unpack4(*(const u32x2*)(logw + ((size_t)(tok0 + 8 * q + i) * 2 + 1) * 1024 + c4));
#pragma unroll
          for (int i = 0; i < 8; ++i) tot1 += t[i]; }
        f32x4 pre0 = (f32x4){0.f, 0.f, 0.f, 0.f}, pre1 = pre0, e0prev = (f32x4){1.f, 1.f, 1.f, 1.f};
        const bf16* pbase = proj + (size_t)tok0 * NPROJ + COL_R + c4;
#pragma unroll 1
        for (int ch = 0; ch < 8; ++ch) {
            const float* cwp = cw; const float* cbp = cb; asm volatile("" : "+s"(cwp), "+s"(cbp));
            f32x4 w[3][3], bs[3];
#pragma unroll
            for (int s = 0; s < 3; ++s) { bs[s] = *(const f32x4*)(cbp + s * 1024 + c4);
#pragma unroll
                for (int tp = 0; tp < 3; ++tp) w[s][tp] = *(const f32x4*)(cwp + tp * 3072 + s * 1024 + c4); }
            u32x2 rows[6][3], av[4][2]; f32x4 lw[4][2];
#pragma unroll
            for (int i = 0; i < 6; ++i) { const int tt = ch * 4 + i - 1, t = t0 + tt; const bool ok = (t >= 0) && (t < L);
#pragma unroll
                for (int s = 0; s < 3; ++s) rows[i][s] = ok ? *(const u32x2*)(pbase + (long)tt * NPROJ + s * 1024) : (u32x2){0u, 0u}; }
#pragma unroll
            for (int i = 0; i < 4; ++i) { const size_t tok = (size_t)(tok0 + ch * 4 + i); av[i][0] = *(const u32x2*)(abuf + (tok * 2 + 0) * 1024 + c4); av[i][1] = *(const u32x2*)(abuf + (tok * 2 + 1) * 1024 + c4);
                lw[i][0] = unpack4(*(const u32x2*)(logw + (tok * 2 + 0) * 1024 + c4)); lw[i][1] = unpack4(*(const u32x2*)(logw + (tok * 2 + 1) * 1024 + c4)); }
#pragma unroll
            for (int i = 0; i < 4; ++i) {
                const size_t tok = (size_t)(tok0 + ch * 4 + i);
                f32x4 x[3];
#pragma unroll
                for (int s = 0; s < 3; ++s) x[s] = unpack4(rows[i][s]) * w[s][0] + unpack4(rows[i + 1][s]) * w[s][1] + unpack4(rows[i + 2][s]) * w[s][2] + bs[s];
                const f32x4 rr = x[0], k0 = x[1], vv = x[2];
                f32x4 kk = k0 * kkw;
                const float ssq = row_sum16((kk[0] * kk[0] + kk[1] * kk[1]) + (kk[2] * kk[2] + kk[3] * kk[3]));
                kk = kk * (1.0f / sqrtf(ssq + 1e-12f));
                const f32x4 a0 = unpack4(av[i][0]), a1 = unpack4(av[i][1]);
                const f32x4 kd0 = k0 * (1.0f + (a0 - 1.0f) * kaw), kd1 = k0 * (1.0f + (a1 - 1.0f) * kaw);
                const f32x4 rk = rr * k0 * rkw;
                const float bsum = row_sum16((rk[0] + rk[1]) + (rk[2] + rk[3]));
                pre0 += lw[i][0];
                const f32x4 e0 = exp4(pre0), ie0 = rcp4(e0);
                const f32x4 l1 = tot1 - pre1; pre1 += lw[i][1];
                const f32x4 e1 = exp4(l1), ie1 = rcp4(e1), e1prev = exp4(l1 - lw[i][1]);
                bf16* o = til + (tok * 16 + head) * TILP + hl;
                *(u32x2*)(o) = pack4(-kk * e0prev); *(u32x2*)(o + 64) = pack4(kk * a0 * ie0); *(u32x2*)(o + 128) = pack4(kd0 * ie0); *(u32x2*)(o + 192) = pack4(rr * e0);
                *(u32x2*)(o + 256) = pack4(-kk * e1prev); *(u32x2*)(o + 320) = pack4(kk * a1 * ie1); *(u32x2*)(o + 384) = pack4(kd1 * ie1); *(u32x2*)(o + 448) = pack4(rr * e1);
                *(u32x2*)(o + 512) = pack4(vv);
                e0prev = e0;
                if ((lane & 15) == 0) bonus[tok * 16 + head] = bsum;
            }
        }
        *(f32x4*)(wtb + (((size_t)run * 2 + 0) * 16 + head) * 64 + hl) = exp4(pre0);
        *(f32x4*)(wtb + (((size_t)run * 2 + 1) * 16 + head) * 64 + hl) = exp4(tot1);
        asm volatile("s_waitcnt vmcnt(0)" ::: "memory");
#pragma unroll 1
        for (int uu = 0; uu < 8; ++uu) rwkv_tinv_unit(F, (run << 5) | ((uu & 1) << 4) | (cg * 4 + (uu >> 1)));
    }
}

__device__ __forceinline__ bf16x8 packf(const f32x16& x, int s) {
    u32x4 p; p.x = cvtpk(x[8 * s + 0], x[8 * s + 1]); p.y = cvtpk(x[8 * s + 2], x[8 * s + 3]); p.z = cvtpk(x[8 * s + 4], x[8 * s + 5]); p.w = cvtpk(x[8 * s + 6], x[8 * s + 7]);
    return __builtin_bit_cast(bf16x8, p);
}
#define MFMA32(a, b, c) __builtin_amdgcn_mfma_f32_32x32x16_bf16((a), (b), (c), 0, 0, 0)

#define TR8(F0, F1, F2, F3, A, O0, O1, O2, O3) do { s16x4 l0_, h0_, l1_, h1_, l2_, h2_, l3_, h3_; \
    asm volatile("ds_read_b64_tr_b16 %0, %8 offset:%9\n\tds_read_b64_tr_b16 %1, %8 offset:%9+1024\n\tds_read_b64_tr_b16 %2, %8 offset:%10\n\tds_read_b64_tr_b16 %3, %8 offset:%10+1024\n\t" \
                 "ds_read_b64_tr_b16 %4, %8 offset:%11\n\tds_read_b64_tr_b16 %5, %8 offset:%11+1024\n\tds_read_b64_tr_b16 %6, %8 offset:%12\n\tds_read_b64_tr_b16 %7, %8 offset:%12+1024\n\ts_waitcnt lgkmcnt(0)" \
                 : "=&v"(l0_), "=&v"(h0_), "=&v"(l1_), "=&v"(h1_), "=&v"(l2_), "=&v"(h2_), "=&v"(l3_), "=&v"(h3_) : "v"(A), "n"(O0), "n"(O1), "n"(O2), "n"(O3)); \
    F0 = __builtin_shufflevector(l0_, h0_, 0, 1, 2, 3, 4, 5, 6, 7); F1 = __builtin_shufflevector(l1_, h1_, 0, 1, 2, 3, 4, 5, 6, 7); \
    F2 = __builtin_shufflevector(l2_, h2_, 0, 1, 2, 3, 4, 5, 6, 7); F3 = __builtin_shufflevector(l3_, h3_, 0, 1, 2, 3, 4, 5, 6, 7); } while (0)
#define TR4(F0, F1, A, O0, O1) do { s16x4 l0_, h0_, l1_, h1_; \
    asm volatile("ds_read_b64_tr_b16 %0, %4 offset:%5\n\tds_read_b64_tr_b16 %1, %4 offset:%5+1024\n\tds_read_b64_tr_b16 %2, %4 offset:%6\n\tds_read_b64_tr_b16 %3, %4 offset:%6+1024\n\ts_waitcnt lgkmcnt(0)" \
                 : "=&v"(l0_), "=&v"(h0_), "=&v"(l1_), "=&v"(h1_) : "v"(A), "n"(O0), "n"(O1)); \
    F0 = __builtin_shufflevector(l0_, h0_, 0, 1, 2, 3, 4, 5, 6, 7); F1 = __builtin_shufflevector(l1_, h1_, 0, 1, 2, 3, 4, 5, 6, 7); } while (0)
template <int V> struct IC { static constexpr int value = V; };
__device__ __forceinline__ void hyena_post_phase(const Frame& F, const Args& a, int layer, LAS bf16* tl, int gw, int NGW);
constexpr int CS_BUF = 23552, CS_AT = 0, CS_BT = 4096, CS_KT = 8192, CS_RT = 12288, CS_VV = 16384, CS_TI = 20480, CS_WT = 22528;
__device__ __forceinline__ void rwkv_cscan_phase(const Frame& F, const Args& a, int layer) {
    if (F.wave >= 2) {
        if (F.wave < 6) { LAS bf16* sl = (LAS bf16*)(F.lds + 4 * CS_BUF + (F.wave - 2) * 8704);
            hyena_post_phase(F, a, layer, sl, F.bid * 4 + (F.wave - 2), F.G * 4); }
        if (layer + 1 < DEPTH) convert_layer(F, layer + 1, nullptr, F.bid * 6 + (F.wave - 2), F.G * 6);
        return; }
    unsigned char* ws = WSP(F);
    const bf16* til = (const bf16*)(ws + WS_TIL);
    const bf16* tinv = (const bf16*)(ws + WS_TINV);
    const float* wtb = (const float*)(ws + WS_WTB);
    float* Y = (float*)(ws + WS_H);
    const int lane = F.lane, r = lane & 31, h = lane >> 5;
    const int i16 = lane & 15, tq = i16 >> 2, tp = i16 & 3, blk = (lane >> 4) & 1;
    LAS unsigned char* lbase = F.lds + F.wave * (2 * CS_BUF);
    const int slot = F.wave * F.G + F.bid, nslot = 2 * F.G;
    const int nsamp = 256;
    for (int item = slot; item < 2304; item += (slot < nsamp) ? 2304 : (nslot - nsamp)) {
        const bool sample = item < 256; const int hc = sample ? item : item - 256, chain = hc >> 1, vt = hc & 1;
        const int hd = chain & 15, e = (chain >> 4) & 1, b = chain >> 5;
        const int NC = sample ? (L_S / 32) : (L_P / 32), tokb = sample ? NPR + b * L_S : b * L_P;
        f32x16 ST[2];
        if (sample) { const float* s0 = INP(F, I_ST) + ((((size_t)b * 4 + layer) * 2 + e) * 16 + hd) * 4096;
#pragma unroll
            for (int kt = 0; kt < 2; ++kt)
#pragma unroll
                for (int g = 0; g < 4; ++g) { const f32x4 v = *(const f32x4*)(s0 + (32 * vt + r) * 64 + 32 * kt + 8 * g + 4 * h);
                    ST[kt][4 * g] = v[0]; ST[kt][4 * g + 1] = v[1]; ST[kt][4 * g + 2] = v[2]; ST[kt][4 * g + 3] = v[3]; }
        } else {
#pragma unroll
            for (int kt = 0; kt < 2; ++kt)
#pragma unroll
                for (int i = 0; i < 16; ++i) ST[kt][i] = 0.f;
        }
#define CS_DMA(C, BUFP) do { const int run_ = (tokb >> 5) + (e ? NC - 1 - (C) : (C)); int ln_ = lane_id(); asm volatile("" : "+v"(ln_));     \
            _Pragma("unroll") for (int i_ = 0; i_ < 4; ++i_) { const int q_ = ln_ + 64 * i_, p_ = q_ >> 3, cc_ = q_ & 7; \
                const bf16* g_ = til + ((size_t)(run_ * 32 + (e ? 31 - p_ : p_)) * 16 + hd) * TILP + e * 256 + 8 * cc_; \
                __builtin_amdgcn_global_load_lds((const unsigned*)(g_), (LAS unsigned*)((BUFP) + CS_AT + i_ * 1024), 16, 0, 0); \
                __builtin_amdgcn_global_load_lds((const unsigned*)(g_ + 64), (LAS unsigned*)((BUFP) + CS_BT + i_ * 1024), 16, 0, 0); \
                __builtin_amdgcn_global_load_lds((const unsigned*)(g_ + 128), (LAS unsigned*)((BUFP) + CS_KT + i_ * 1024), 16, 0, 0); \
                __builtin_amdgcn_global_load_lds((const unsigned*)(g_ + 192), (LAS unsigned*)((BUFP) + CS_RT + i_ * 1024), 16, 0, 0); \
                __builtin_amdgcn_global_load_lds((const unsigned*)(g_ - e * 256 + 512), (LAS unsigned*)((BUFP) + CS_VV + i_ * 1024), 16, 0, 0); } \
            const size_t unit_ = ((size_t)run_ * 2 + e) * 16 + hd; \
            _Pragma("unroll") for (int i_ = 0; i_ < 2; ++i_) __builtin_amdgcn_global_load_lds((const unsigned*)(tinv + unit_ * 1024 + (ln_ + 64 * i_) * 8), (LAS unsigned*)((BUFP) + CS_TI + i_ * 1024), 16, 0, 0); \
            __builtin_amdgcn_global_load_lds((const unsigned*)(wtb + unit_ * 64 + (ln_ & 15) * 4), (LAS unsigned*)((BUFP) + CS_WT), 16, 0, 0); } while (0)
        CS_DMA(0, lbase);
        auto chunk = [&](auto bi_, int c) __attribute__((always_inline)) {
            constexpr int BI = decltype(bi_)::value;
            const LAS unsigned char* B = lbase + BI * CS_BUF;
            if (c == 0) asm volatile("s_waitcnt vmcnt(0)" ::: "memory");
            else asm volatile("s_waitcnt vmcnt(16)" ::: "memory");
            if (c + 1 < NC) CS_DMA(c + 1, lbase + (1 - BI) * CS_BUF);
            bf16x8 nkaF[2], nbrF[2], nkrF[2];
#define CS_NMAT(OUTF, OFFA, OFFB, STRICT) do { f32x16 n_; _Pragma("unroll") for (int i = 0; i < 16; ++i) n_[i] = 0.f; \
                    _Pragma("unroll") for (int ks = 0; ks < 4; ++ks) { const int o = r * 128 + (16 * ks + 8 * h) * 2; \
                        n_ = MFMA32(*(const LAS bf16x8*)(B + (OFFA) + o), *(const LAS bf16x8*)(B + (OFFB) + o), n_); } \
                    _Pragma("unroll") for (int i = 0; i < 16; ++i) { const int row = (i & 3) + 8 * (i >> 2) + 4 * h; n_[i] = ((STRICT) ? (row < r) : (row <= r)) ? n_[i] : 0.f; } \
                    OUTF[0] = packf(n_, 0); OUTF[1] = packf(n_, 1); } while (0)
            CS_NMAT(nkaF, CS_KT, CS_AT, true);
            CS_NMAT(nbrF, CS_BT, CS_RT, false);
            CS_NMAT(nkrF, CS_KT, CS_RT, false);
#undef CS_NMAT
            const unsigned tra = (unsigned)(size_t)(B) + (4 * h + tq) * 128 + (16 * blk + 4 * tp) * 2 + vt * 64;
            const unsigned trk = (unsigned)(size_t)(B) + (4 * h + tq) * 128 + (16 * blk + 4 * tp) * 2;
            bf16x8 vvF[2], btF[2][2], ktF[2][2];
            TR4(vvF[0], vvF[1], tra, CS_VV, CS_VV + 2048);
            TR8(btF[0][0], btF[0][1], btF[1][0], btF[1][1], trk, CS_BT, CS_BT + 2048, CS_BT + 64, CS_BT + 64 + 2048);
            TR8(ktF[0][0], ktF[0][1], ktF[1][0], ktF[1][1], trk, CS_KT, CS_KT + 2048, CS_KT + 64, CS_KT + 64 + 2048);
#define CS_APERM(OFF, KT, S) ({ const LAS unsigned char* p_ = B + (OFF) + r * 128 + (32 * (KT) + 16 * (S) + 4 * h) * 2; \
                const u32x2 lo_ = *(const LAS u32x2*)p_, hi_ = *(const LAS u32x2*)(p_ + 16); __builtin_bit_cast(bf16x8, (u32x4){lo_.x, lo_.y, hi_.x, hi_.y}); })
            bf16x8 uF[2];
            {   f32x16 rhs;
#pragma unroll
                for (int i = 0; i < 16; ++i) rhs[i] = 0.f;
#pragma unroll
                for (int kt = 0; kt < 2; ++kt)
#pragma unroll
                    for (int s = 0; s < 2; ++s) rhs = MFMA32(CS_APERM(CS_AT, kt, s), packf(ST[kt], s), rhs);
#pragma unroll
                for (int s = 0; s < 2; ++s) rhs = MFMA32(nkaF[s], vvF[s], rhs);
                f32x16 u;
#pragma unroll
                for (int i = 0; i < 16; ++i) u[i] = 0.f;
#pragma unroll
                for (int s = 0; s < 2; ++s) { const LAS unsigned char* p_ = B + CS_TI + r * 64 + (16 * s + 4 * h) * 2;
                    const u32x2 lo_ = *(const LAS u32x2*)p_, hi_ = *(const LAS u32x2*)(p_ + 16);
                    u = MFMA32(__builtin_bit_cast(bf16x8, (u32x4){lo_.x, lo_.y, hi_.x, hi_.y}), packf(rhs, s), u); }
                uF[0] = packf(u, 0); uF[1] = packf(u, 1);
            }
            {   const int run = (tokb >> 5) + (e ? NC - 1 - c : c);
                f32x16 y;
#pragma unroll
                for (int i = 0; i < 16; ++i) y[i] = 0.f;
#pragma unroll
                for (int kt = 0; kt < 2; ++kt)
#pragma unroll
                    for (int s = 0; s < 2; ++s) y = MFMA32(CS_APERM(CS_RT, kt, s), packf(ST[kt], s), y);
#pragma unroll
                for (int s = 0; s < 2; ++s) { y = MFMA32(nbrF[s], uF[s], y); y = MFMA32(nkrF[s], vvF[s], y); }
#pragma unroll
                for (int i = 0; i < 16; ++i) { const int p = (i & 3) + 8 * (i >> 2) + 4 * h; const size_t tok = (size_t)(run * 32 + (e ? 31 - p : p));
                    Y[((size_t)e * M + tok) * 1024 + hd * 64 + 32 * vt + r] = y[i]; }
            }
#pragma unroll
            for (int kt = 0; kt < 2; ++kt) {
                f32x4 wt[4];
#pragma unroll
                for (int g = 0; g < 4; ++g) wt[g] = *(const LAS f32x4*)(B + CS_WT + (32 * kt + 8 * g + 4 * h) * 4);
#pragma unroll
                for (int s = 0; s < 2; ++s) { ST[kt] = MFMA32(btF[kt][s], uF[s], ST[kt]); ST[kt] = MFMA32(ktF[kt][s], vvF[s], ST[kt]); }
#pragma unroll
                for (int i = 0; i < 16; ++i) ST[kt][i] *= wt[i >> 2][i & 3];
            }
        };
#pragma unroll 1
        for (int c2 = 0; c2 < NC; c2 += 2) { chunk(IC<0>{}, c2); chunk(IC<1>{}, c2 + 1); }
#undef CS_APERM
#undef CS_DMA
        if (!sample) { float* so = OUTP(F) + OUT_ST + ((((size_t)b * 4 + layer) * 2 + e) * 16 + hd) * 4096;
#pragma unroll
            for (int kt = 0; kt < 2; ++kt)
#pragma unroll
                for (int g = 0; g < 4; ++g) *(f32x4*)(so + (32 * vt + r) * 64 + 32 * kt + 8 * g + 4 * h) = (f32x4){ST[kt][4 * g], ST[kt][4 * g + 1], ST[kt][4 * g + 2], ST[kt][4 * g + 3]};
        }
    }
    asm volatile("s_waitcnt vmcnt(0)" ::: "memory");
}

__device__ __forceinline__ void rwkv_post_phase(const Frame& F, const Args& a, int layer) {
    unsigned char* ws = WSP(F);
    const float* Y = (const float*)(ws + WS_H);
    const bf16* til = (const bf16*)(ws + WS_TIL); const bf16* gbuf = (const bf16*)(ws + WS_G); const float* bonus = (const float*)(ws + WS_BONUS);
    bf16* oall = (bf16*)(ws + WS_OALL);
    const int lane = F.lane;
    for (int item = F.wave * F.G + F.bid; item < 2048; item += 8 * F.G) {
        const int tok0 = (item >> 2) * 32, cg = item & 3, c4 = cg * 256 + 4 * lane, head = cg * 4 + (lane >> 4), hl = 4 * (lane & 15);
        const f32x4 gng = *(const f32x4*)(INP(F, I_GNG) + layer * 1024 + c4), gnb = *(const f32x4*)(INP(F, I_GNB) + layer * 1024 + c4);
#pragma unroll 1
        for (int ch = 0; ch < 4; ++ch) {
            f32x4 y0[8], y1[8]; u32x2 vw[8], gw[8]; float bn[8];
#pragma unroll
            for (int i = 0; i < 8; ++i) { const size_t tok = (size_t)(tok0 + ch * 8 + i);
                y0[i] = *(const f32x4*)(Y + tok * 1024 + c4); y1[i] = *(const f32x4*)(Y + ((size_t)M + tok) * 1024 + c4);
                vw[i] = *(const u32x2*)(til + (tok * 16 + head) * TILP + 512 + hl); gw[i] = *(const u32x2*)(gbuf + tok * 1024 + c4); bn[i] = bonus[tok * 16 + head]; }
#pragma unroll
            for (int i = 0; i < 8; ++i) { const size_t tok = (size_t)(tok0 + ch * 8 + i);
                const f32x4 y = y0[i] + y1[i];
                const float mu = row_sum16((y[0] + y[1]) + (y[2] + y[3])) * (1.0f / 64.0f);
                const f32x4 dd = y - mu;
                const float var = row_sum16((dd[0] * dd[0] + dd[1] * dd[1]) + (dd[2] * dd[2] + dd[3] * dd[3])) * (1.0f / 64.0f);
                const f32x4 yn = dd * (1.0f / sqrtf(var + 64e-5f)) * gng + gnb;
                const f32x4 o = (yn + bn[i] * unpack4(vw[i])) * unpack4(gw[i]);
                *(u32x2*)(oall + tok * 3072 + 1024 + c4) = pack4(o);
            }
        }
    }
}

__device__ __forceinline__ void hyena_prep_phase(const Frame& F, const Args& a, int layer) {
    unsigned char* ws = WSP(F);
    const bf16* proj = (const bf16*)(ws + WS_PROJ);
    bf16* zT = (bf16*)(ws + WS_ZT);
    const float* cw = INP(F, I_HCW) + (size_t)layer * 3 * 3072; const float* cb = INP(F, I_HCB) + (size_t)layer * 3072;
    const int gw = F.bid * 8 + F.wave, NGW = F.G * 8, lane = F.lane, tsub = lane >> 4, cq = lane & 15;
    LAS bf16* tl = (LAS bf16*)(F.lds + F.wave * 16384);
    for (int it = gw; it < 256 * 16; it += NGW) {
        const int tt0 = (it >> 4) * 64, c0 = (it & 15) * 64, c4 = c0 + 4 * cq;
        const int t0 = tt0 < NPR ? (tt0 & 255) : ((tt0 - NPR) & 2047), L = tt0 < NPR ? L_P : L_S;
        f32x4 w1[3], w2[3];
#pragma unroll
        for (int tp = 0; tp < 3; ++tp) { w1[tp] = *(const f32x4*)(cw + tp * 3072 + 1024 + c4); w2[tp] = *(const f32x4*)(cw + tp * 3072 + 2048 + c4); }
        const f32x4 b1 = *(const f32x4*)(cb + 1024 + c4), b2 = *(const f32x4*)(cb + 2048 + c4);
        const bf16* px = proj + (size_t)tt0 * NPROJ + COL_X1 + c4;
#pragma unroll 1
        for (int hf = 0; hf < 2; ++hf) {
            u32x2 xr[8][3], vr[8][3];
#pragma unroll
            for (int i = 0; i < 8; ++i) { const int tt = 4 * (hf * 8 + i) + tsub;
#pragma unroll
                for (int d = 0; d < 3; ++d) { const int t = t0 + tt + d - 1; const bool ok = (t >= 0) && (t < L); const bf16* p = px + (long)(tt + d - 1) * NPROJ;
                    xr[i][d] = ok ? *(const u32x2*)p : (u32x2){0u, 0u}; vr[i][d] = ok ? *(const u32x2*)(p + 1024) : (u32x2){0u, 0u}; } }
#pragma unroll
            for (int i = 0; i < 8; ++i) { const int tt = 4 * (hf * 8 + i) + tsub;
                const f32x4 x1c = unpack4(xr[i][0]) * w1[0] + unpack4(xr[i][1]) * w1[1] + unpack4(xr[i][2]) * w1[2] + b1;
                const f32x4 vvc = unpack4(vr[i][0]) * w2[0] + unpack4(vr[i][1]) * w2[1] + unpack4(vr[i][2]) * w2[2] + b2;
                *(LAS u32x2*)(tl + tt * 68 + 4 * cq) = pack4(x1c * vvc); }
        }
        LDS_WAIT(); asm volatile("" ::: "memory");
#pragma unroll
        for (int j = 0; j < 8; ++j) { const int id = lane + 64 * j, ch = id >> 3, tg = id & 7; const LAS bf16* s = tl + (8 * tg) * 68 + ch;
            u32x4 o; o.x = (unsigned)s[0] | ((unsigned)s[68] << 16); o.y = (unsigned)s[2 * 68] | ((unsigned)s[3 * 68] << 16); o.z = (unsigned)s[4 * 68] | ((unsigned)s[5 * 68] << 16); o.w = (unsigned)s[6 * 68] | ((unsigned)s[7 * 68] << 16);
            *(u32x4*)(zT + (size_t)(c0 + ch) * M + tt0 + 8 * tg) = o; }
        LDS_WAIT(); asm volatile("" ::: "memory");
    }
}

__device__ __forceinline__ void hyena_conv_phase(const Frame& F, const Args& a, int layer) {
    unsigned char* ws = WSP(F);
    bf16* zT = (bf16*)(ws + WS_ZT);
    const float* FNORM = (const float*)(ws + WS_CTL) + CW_FNORM;
    const int lane = F.lane, w = F.wave, r = lane & 31, h = lane >> 5;
    LAS unsigned char* lds = F.lds;
    for (int u = F.bid; u < 2048; u += F.G) {
        const bool sample = u < 1024; const int c = u & 1023;
        const int L = sample ? L_S : L_P, LP = sample ? LPS : LPP, FCS = LP * 2;
        const int ZROW = (L + 448) * 2, ZOFF = 2 * FCS;
        const int NB = sample ? 4 : 32, tokb = sample ? NPR : 0;
        const bf16* fsrc = sample ? (const bf16*)(ws + WS_FS) + ((size_t)layer * 1024 + c) * LPS : (const bf16*)(ws + WS_FP) + ((size_t)layer * 1024 + c) * LPP;
        __syncthreads();
        for (int i = F.tid; i < LP / 8; i += 512) *(LAS u32x4*)(lds + i * 16) = *(const u32x4*)(fsrc + i * 8);
        for (int i = F.tid; i < LP; i += 512) *(LAS bf16*)(lds + FCS + i * 2) = (i + 1 < LP) ? fsrc[i + 1] : (bf16)0;
        { const int cpr = L / 8;
          for (int i = F.tid; i < NB * cpr; i += 512) { const int b = i / cpr, q = i - b * cpr;
              *(LAS u32x4*)(lds + ZOFF + b * ZROW + 448 + q * 16) = *(const u32x4*)(zT + (size_t)c * M + tokb + b * L + q * 8); }
          if (sample) for (int i = F.tid; i < NB * 56; i += 512) { const int b = i / 56, q = i - b * 56;
              *(LAS u32x4*)(lds + ZOFF + b * ZROW + (q < 28 ? q * 16 : 448 + L * 2 + (q - 28) * 16)) = (u32x4){0u, 0u, 0u, 0u}; } }
        __syncthreads();
        const int nbl = sample ? 2 : 5;
        const int I0 = sample ? 8 * w : w;
        const int b = r & (NB - 1), I = I0 + (r >> nbl);
        int dlo = (sample ? I0 - 63 : I0 - 7), dhi = (sample ? I0 + 7 : I0);
        const int dmax = L / 64;
        dlo = dlo < -dmax ? -dmax : dlo; dhi = dhi > dmax ? dmax : dhi;
        f32x16 acc;
#pragma unroll
        for (int i = 0; i < 16; ++i) acc[i] = 0.f;
        const LAS unsigned char* zb = lds + ZOFF + b * ZROW + (224 + 8 * h) * 2;
#pragma unroll 2
        for (int d = dlo; d <= dhi; ++d) {
#pragma unroll
            for (int ks = 0; ks < 2; ++ks) {
                const int st = (L / 2 - 1) - 32 * d - r + 16 * ks + 8 * h + 32;
                const int par = st & 1;
                const LAS unsigned* ap = (const LAS unsigned*)(lds + par * FCS + (st - par) * 2);
                const u32x4 aw = (u32x4){ap[0], ap[1], ap[2], ap[3]};
                const bf16x8 af = __builtin_bit_cast(bf16x8, aw);
                const bf16x8 bfr = *(const LAS bf16x8*)(zb + (32 * (I - d) + 16 * ks) * 2);
                acc = __builtin_amdgcn_mfma_f32_32x32x16_bf16(af, bfr, acc, 0, 0, 0);
            }
        }
        const float inv = 1.0f / (FNORM[((size_t)layer * 2 + (sample ? 0 : 1)) * 1024 + c] + 1e-6f);
        const float dco = INP(F, I_HD)[layer * 1024 + c];
        __syncthreads();
#pragma unroll
        for (int g = 0; g < 4; ++g) {
            const int t = 32 * I + 8 * g + 4 * h;
            const LAS bf16* zp = (const LAS bf16*)(lds + ZOFF + b * ZROW + (224 + t) * 2);
            float o[4];
#pragma unroll
            for (int j = 0; j < 4; ++j) o[j] = acc[4 * g + j] * inv + bf2f(zp[j]) * dco;
            *(u32x2*)(zT + (size_t)c * M + tokb + b * L + t) = (u32x2){cvtpk(o[0], o[1]), cvtpk(o[2], o[3])};
        }
    }
    __syncthreads();
}

__device__ __forceinline__ void hyena_post_phase(const Frame& F, const Args& a, int layer, LAS bf16* tl, int gw, int NGW) {
    unsigned char* ws = WSP(F);
    const bf16* proj = (const bf16*)(ws + WS_PROJ);
    const bf16* yT = (const bf16*)(ws + WS_ZT);
    bf16* oall = (bf16*)(ws + WS_OALL);
    const float* cw = INP(F, I_HCW) + (size_t)layer * 3 * 3072; const float* cb = INP(F, I_HCB) + (size_t)layer * 3072;
    const int lane = F.lane, tsub = lane >> 4, cq = lane & 15;
    for (int it = gw; it < 256 * 16; it += NGW) {
        const int tt0 = (it >> 4) * 64, c0 = (it & 15) * 64, c4 = c0 + 4 * cq;
        const int t0 = tt0 < NPR ? (tt0 & 255) : ((tt0 - NPR) & 2047), L = tt0 < NPR ? L_P : L_S;
        {   u32x4 tmp[8];
#pragma unroll
            for (int j = 0; j < 8; ++j) { const int id = lane + 64 * j, ch = id >> 3, tg = id & 7; tmp[j] = *(const u32x4*)(yT + (size_t)(c0 + ch) * M + tt0 + 8 * tg); }
#pragma unroll
            for (int j = 0; j < 8; ++j) { const int id = lane + 64 * j, ch = id >> 3, tg = id & 7; LAS unsigned* d = (LAS unsigned*)(tl + ch * 68 + 8 * tg);
                d[0] = tmp[j].x; d[1] = tmp[j].y; d[2] = tmp[j].z; d[3] = tmp[j].w; } }
        LDS_WAIT(); asm volatile("" ::: "memory");
        f32x4 w0[3];
#pragma unroll
        for (int tp = 0; tp < 3; ++tp) w0[tp] = *(const f32x4*)(cw + tp * 3072 + c4);
        const f32x4 b0 = *(const f32x4*)(cb + c4);
        const bf16* px = proj + (size_t)tt0 * NPROJ + COL_X0 + c4;
#pragma unroll 1
        for (int hf = 0; hf < 2; ++hf) {
            u32x2 xr[8][3];
#pragma unroll
            for (int i = 0; i < 8; ++i) { const int tt = 4 * (hf * 8 + i) + tsub;
#pragma unroll
                for (int d = 0; d < 3; ++d) { const int t = t0 + tt + d - 1; const bool ok = (t >= 0) && (t < L); xr[i][d] = ok ? *(const u32x2*)(px + (long)(tt + d - 1) * NPROJ) : (u32x2){0u, 0u}; } }
#pragma unroll
            for (int i = 0; i < 8; ++i) { const int tt = 4 * (hf * 8 + i) + tsub;
                const f32x4 x0c = unpack4(xr[i][0]) * w0[0] + unpack4(xr[i][1]) * w0[1] + unpack4(xr[i][2]) * w0[2] + b0;
                const f32x4 yv = (f32x4){bf2f(tl[(4 * cq + 0) * 68 + tt]), bf2f(tl[(4 * cq + 1) * 68 + tt]), bf2f(tl[(4 * cq + 2) * 68 + tt]), bf2f(tl[(4 * cq + 3) * 68 + tt])};
                *(u32x2*)(oall + (size_t)(tt0 + tt) * 3072 + 2048 + c4) = pack4(x0c * yv); }
        }
        LDS_WAIT(); asm volatile("" ::: "memory");
    }
}

constexpr int NPL = 11, PH_LAYER0 = 2, PH_FINAL = PH_LAYER0 + DEPTH * NPL, N_PHASES = PH_FINAL + 1;

__global__ void __launch_bounds__(512, 2) mega(Args args) {
    extern __shared__ __attribute__((aligned(16))) unsigned char lds_raw[];
    Frame F;
    F.lds = (LAS unsigned char*)lds_raw;
    F.tid = threadIdx.x; F.lane = F.tid & 63; F.wave = __builtin_amdgcn_readfirstlane(F.tid >> 6);
    F.G = gridDim.x; F.bid = blockIdx.x;
    for (int u = F.tid; u < (LDS_BYTES - LDSCTL_OFF) / 4; u += 512) ((LAS unsigned*)(F.lds + LDSCTL_OFF))[u] = 0u;
    __syncthreads();
    if (F.tid < 48) { const unsigned long long p = F.tid < 46 ? (unsigned long long)args.in[F.tid] : (F.tid == 46 ? (unsigned long long)args.out : (unsigned long long)args.ws);
        ((LAS unsigned*)(F.lds + LDS_ARGT))[2 * F.tid] = (unsigned)p; ((LAS unsigned*)(F.lds + LDS_ARGT))[2 * F.tid + 1] = (unsigned)(p >> 32); }
    __syncthreads();
    unsigned char* ws = WSP(F);
    unsigned* ctl = (unsigned*)(ws + WS_CTL);
    int lo = args.ph_lo, hi = args.ph_hi;
    const bool single = (hi - lo) > 1;
    XcdBarrier bar; bar.bar = ctl + CW_BAR; bar.x = 0; bar.st = (volatile LAS unsigned*)(F.lds + LDSCTL_OFF + 64); bar.wave = F.wave;
    if (single) bar = xcd_barrier_post(ctl + CW_BAR, (volatile LAS unsigned*)(F.lds + LDSCTL_OFF + 64), F.wave);
#ifndef MK_EN
#define MK_EN 0xFFFFFF
#endif
#define IN(k) (lo <= (k) && (k) < hi)
#define EN(b) ((MK_EN >> (b)) & 1)
#ifndef MK_DUP
#define MK_DUP -1
#endif
#define REPS(k) ((MK_DUP == (k)) ? 2 : 1)
#define FRESH() do { F.lane = lane_id(); asm volatile("" : "+v"(F.lane), "+s"(F.bid), "+s"(F.wave), "+s"(F.G)); F.tid = F.wave * 64 + F.lane; } while (0)
#define SEAM(k) do { if (IN(k) && IN((k) + 1)) xcd_barrier(bar); } while (0)

    if (EN(20) && IN(0)) { FRESH(); prologue0(F, args); SEAM(0); }
    if (EN(21) && IN(1)) { FRESH(); prologue1(F, args); SEAM(1); }

    bf16* Hb = (bf16*)(ws + WS_H); bf16* proj = (bf16*)(ws + WS_PROJ); bf16* oall = (bf16*)(ws + WS_OALL);
    float* x = OUTP(F);
#pragma unroll 1
    for (int l = 0; l < DEPTH; ++l) {
        const int pb = PH_LAYER0 + l * NPL;
        asm volatile("" : "+s"(lo), "+s"(hi));
        const float* mod = (const float*)(ws + WS_MOD) + (size_t)l * 5 * 12288;
        if (EN(0) && IN(pb + 0)) { FRESH();
            norm_phase(F, l == 0 ? INP(F, I_XP) : x, l == 0 ? INP(F, I_XS) : x + (size_t)NPR * D, l == 0 ? x : nullptr, INP(F, I_LN1) + l * D, mod, 0, 1, Hb);
            SEAM(pb + 0);
        }
        if (EN(1) && IN(pb + 1)) { FRESH();
            pg8::Gemm g{Hb, (const bf16*)(ws + WS_WIN) + (size_t)l * NPROJ * D, D, D, D, 0, 0, 0};
            pg8::Order S; S.init(M, NPROJ, F.G, F.bid, 1);
            pg8::EpiProj E{proj, x + OUT_CK, x + OUT_CV, l};
            pg8::gemm_phase(F.lds, g, S, E, F.wave);
            SEAM(pb + 1);
        }
        if (EN(2) && IN(pb + 2)) { FRESH();
            {   pg8::Gemm g{proj + COL_LW, (const bf16*)(ws + WS_W2T) + (size_t)l * 5120 * 128, NPROJ, 128, 128, 0, 128, 4};
                pg8::Order5 S; S.init(M, F.G, F.bid);
                pg8::EpiLora2 E{(bf16*)(ws + WS_DEC), (bf16*)(ws + WS_A), (bf16*)(ws + WS_G), INP(F, I_W0) + l * 2048, INP(F, I_A0) + l * 2048};
                pg8::gemm_phase(F.lds, g, S, E, F.wave); }
            FRESH(); attention_phase(F, args, l);
            FRESH(); hyena_prep_phase(F, args, l);
            SEAM(pb + 2);
        }
        if (EN(3) && IN(pb + 3)) { FRESH(); rwkv_prep_phase(F, args, l); FRESH(); hyena_conv_phase(F, args, l); SEAM(pb + 3); }
        if (EN(4) && IN(pb + 4)) { FRESH(); rwkv_cscan_phase(F, args, l); SEAM(pb + 4); }
        if (EN(5) && IN(pb + 5)) { FRESH(); rwkv_post_phase(F, args, l); SEAM(pb + 5); }
        if (EN(6) && IN(pb + 6)) { FRESH();
            pg8::Gemm g{oall, (const bf16*)(ws + WS_WP) + (size_t)l * 3 * D * 1024, 3072, 1024, 1024, 1024, 0, 8};
            pg8::Order S; S.init(M, D, F.G, F.bid, 3);
            pg8::EpiMerge E{proj, Hb};
            pg8::gemm_phase(F.lds, g, S, E, F.wave);
            SEAM(pb + 6);
        }
        if (EN(7) && IN(pb + 7)) { FRESH();
            pg8::Gemm g{Hb, (const bf16*)(ws + WS_WOUT) + (size_t)l * D * D, D, D, D, 0, 0, 0};
            pg8::Order S; S.init(M, D, F.G, F.bid, 1);
            pg8::EpiResid E{x, mod + 2 * D, nullptr, 1.0f};
            pg8::gemm_phase(F.lds, g, S, E, F.wave);
            SEAM(pb + 7);
        }
        if (EN(8) && IN(pb + 8)) { FRESH(); norm_phase(F, x, x + (size_t)NPR * D, nullptr, INP(F, I_LN2) + l * D, mod, 3, 4, Hb); SEAM(pb + 8); }
        if (EN(9) && IN(pb + 9)) { FRESH();
            pg8::Gemm g{Hb, (const bf16*)(ws + WS_WFF1) + (size_t)l * D * DFF, D, D, D, 0, 0, 0};
            pg8::Order S; S.init(M, DFF, F.G, F.bid, 1);
            pg8::EpiFF1 E{proj, INP(F, I_BFF1) + l * DFF};
            pg8::gemm_phase(F.lds, g, S, E, F.wave);
            SEAM(pb + 9);
        }
        if (EN(10) && IN(pb + 10)) { FRESH();
            pg8::Gemm g{proj, (const bf16*)(ws + WS_WFF2) + (size_t)l * D * DFF, DFF, DFF, DFF, 0, 0, 0};
            pg8::Order S; S.init(M, D, F.G, F.bid, 1);
            pg8::EpiResid E{x, mod + 5 * D, INP(F, I_BFF2) + l * D, 1.0f};
            pg8::gemm_phase(F.lds, g, S, E, F.wave);
            SEAM(pb + 10);
        }
    }
    asm volatile("" : "+s"(lo), "+s"(hi));
    if (EN(22) && IN(PH_FINAL)) { FRESH(); final_norm_phase(F, OUTP(F), INP(F, I_FING)); }
#undef IN
#undef SEAM
}

extern "C" void kernel_launch(void* const* d_in, const int* in_sizes, int n_in, void* d_out, int out_size, void* d_ws, size_t ws_size, hipStream_t stream) {
    static int grid = 0;
    if (grid == 0) {
        if (n_in != N_INPUTS || (size_t)out_size != OUT_TOTAL || ws_size < WS_END) { fprintf(stderr, "kernel_launch: unexpected shapes: n_in %d out %d ws %zu\n", n_in, out_size, ws_size); grid = -1; return; }
        int dev = 0, cus = 0, per_cu = 0;
        if (hipGetDevice(&dev) != hipSuccess || hipDeviceGetAttribute(&cus, hipDeviceAttributeMultiprocessorCount, dev) != hipSuccess) { grid = -1; return; }
        if (hipFuncSetAttribute((const void*)mega, hipFuncAttributeMaxDynamicSharedMemorySize, LDS_BYTES) != hipSuccess) { fprintf(stderr, "kernel_launch: hipFuncSetAttribute failed\n"); grid = -1; return; }
        if (hipOccupancyMaxActiveBlocksPerMultiprocessor(&per_cu, (const void*)mega, 512, LDS_BYTES) != hipSuccess || per_cu < 1) { fprintf(stderr, "kernel_launch: occupancy query says %d\n", per_cu); }
        (void)hipGetLastError();
        grid = cus;
    }
    if (grid < 0) return;
    (void)hipMemsetAsync((char*)d_ws + WS_CTL, 0, CTL_ZERO_BYTES, stream);
    Args a{};
    for (int i = 0; i < N_INPUTS; ++i) a.in[i] = (const float*)d_in[i];
    a.out = (float*)d_out; a.ws = (unsigned char*)d_ws;
#if MK_MULTI
    for (int ph = 0; ph < N_PHASES; ++ph) { a.ph_lo = ph; a.ph_hi = ph + 1; hipLaunchKernelGGL(mega, dim3(grid), dim3(512), LDS_BYTES, stream, a); }
#else
    a.ph_lo = 0; a.ph_hi = N_PHASES;
    hipLaunchKernelGGL(mega, dim3(grid), dim3(512), LDS_BYTES, stream, a);
#endif
    const hipError_t le = hipPeekAtLastError();
    if (le != hipSuccess) fprintf(stderr, "kernel_launch: launch failed: %s\n", hipGetErrorName(le));
}
```

```cpp
#include <hip/hip_runtime.h>
#include <cstdio>
#include <cstdint>

#ifndef MK_MULTI
#define MK_MULTI 0
#endif

#define GAS __attribute__((address_space(1)))
#define LAS __attribute__((address_space(3)))
typedef unsigned short bf16;
typedef short bf16x8 __attribute__((ext_vector_type(8)));
typedef short s16x4 __attribute__((ext_vector_type(4)));
typedef float f32x4 __attribute__((ext_vector_type(4)));
typedef float f32x2 __attribute__((ext_vector_type(2)));
typedef float f32x16 __attribute__((ext_vector_type(16)));
typedef unsigned u32x4 __attribute__((ext_vector_type(4)));
typedef unsigned u32x2 __attribute__((ext_vector_type(2)));
typedef __bf16 bf16x2_t __attribute__((ext_vector_type(2)));

constexpr int D = 2048, DEPTH = 4, NPR = 8192  , M = 16384, DFF = 8192;
constexpr int NPROJ = 15872;
constexpr int COL_K = 1024, COL_V = 2048, COL_R = 3072, COL_X0 = 6144, COL_X1 = 7168, COL_VV = 8192, COL_GL = 9216, COL_LW = 15360, COL_G1A = 15488;
constexpr int L_P = 256, L_S = 2048;

enum { I_XP = 0, I_XS, I_CK, I_CV, I_ST, I_C, I_CCTX, I_LN1, I_LN2, I_WMOD, I_BMOD, I_WIN, I_RPB, I_CW, I_CB, I_W0, I_W1, I_W2, I_A0, I_A1, I_A2, I_G1, I_G2,
       I_KK, I_KA, I_RK, I_GNG, I_GNB, I_HCW, I_HCB, I_F1, I_FB1, I_F2, I_FB2, I_FREQ, I_F3, I_HD, I_WPA, I_WPR, I_WPC, I_WOUT, I_FF1, I_BFF1, I_FF2, I_BFF2, I_FING, N_INPUTS };

constexpr size_t OUT_X = 0, OUT_CK = 33554432, OUT_CV = 67108864, OUT_ST = 100663296, OUT_TOTAL = 117440512;

constexpr size_t MiB = 1u << 20;
constexpr size_t WS_CTL = 0, CTL_ZERO_BYTES = 1 * MiB;
constexpr size_t WS_WIN = 2 * MiB;
constexpr size_t WS_W2T = 250 * MiB;
constexpr size_t WS_WP = 260 * MiB;
constexpr size_t WS_WOUT = 308 * MiB;
constexpr size_t WS_WFF1 = 340 * MiB;
constexpr size_t WS_WFF2 = 468 * MiB;
constexpr size_t WS_H = 596 * MiB;
constexpr size_t WS_A = 660 * MiB;
constexpr size_t WS_PROJ = 724 * MiB;
constexpr size_t WS_OALL = 1220 * MiB;
constexpr size_t WS_DEC = 1316 * MiB;
constexpr size_t WS_G = 1444 * MiB;
constexpr size_t WS_TIL = 1476 * MiB;
constexpr size_t WS_CK = 1764 * MiB;
constexpr size_t WS_CV = 1772 * MiB;
constexpr size_t WS_FS = 1780 * MiB;
constexpr size_t WS_FP = 1797 * MiB;
constexpr size_t WS_ZT = 1800 * MiB;
constexpr size_t WS_MOD = 1832 * MiB;
constexpr size_t WS_T2 = 1833 * MiB;
constexpr size_t WS_BONUS = 1837 * MiB;
constexpr size_t WS_TINV = 1838 * MiB;
constexpr size_t WS_Q = WS_TINV;
constexpr size_t WS_WTB = 1870 * MiB;
constexpr size_t WS_END = 1874 * MiB;
constexpr int TILP = 576;
constexpr int LPS = 2120, LPP = 328;

constexpr int CW_BAR = 4096;
constexpr int CW_FNORM = 32768;

constexpr int LDS_SCRATCH = 131072, LDSCTL_OFF = 131072, LDS_BYTES = 147456;

#define LDS_WAIT() asm volatile("s_waitcnt lgkmcnt(0)" ::: "memory")
#define VM_WAIT() asm volatile("s_waitcnt vmcnt(0)" ::: "memory")
__device__ __forceinline__ unsigned cvtpk(float lo, float hi) { f32x2 v = {lo, hi}; bf16x2_t b = __builtin_convertvector(v, bf16x2_t); return __builtin_bit_cast(unsigned, b); }
__device__ __forceinline__ bf16 f2bf(float f) { return (bf16)(cvtpk(f, 0.f) & 0xffffu); }
__device__ __forceinline__ float bf2f(bf16 b) { return __uint_as_float(((unsigned)b) << 16); }
__device__ __forceinline__ float bflo(unsigned w) { return __uint_as_float(w << 16); }
__device__ __forceinline__ float bfhi(unsigned w) { return __uint_as_float(w & 0xffff0000u); }
#define DPPF(v, ctrl) __int_as_float(__builtin_amdgcn_update_dpp(0, __float_as_int(v), (ctrl), 0xf, 0xf, false))
__device__ __forceinline__ float wave_sum(float v) {
    v += DPPF(v, 0xB1); v += DPPF(v, 0x4E); v += DPPF(v, 0x141); v += DPPF(v, 0x140);
    const float a = __int_as_float(__builtin_amdgcn_readlane(__float_as_int(v), 0)), b = __int_as_float(__builtin_amdgcn_readlane(__float_as_int(v), 16)),
                c = __int_as_float(__builtin_amdgcn_readlane(__float_as_int(v), 32)), d = __int_as_float(__builtin_amdgcn_readlane(__float_as_int(v), 48));
    return (a + b) + (c + d);
}
__device__ __forceinline__ float xor32(float v, int lane) { return __int_as_float(__builtin_amdgcn_ds_bpermute((lane ^ 32) << 2, __float_as_int(v))); }
__device__ __forceinline__ int lane_id() { return (int)__builtin_amdgcn_mbcnt_hi(~0u, __builtin_amdgcn_mbcnt_lo(~0u, 0u)); }
__device__ __forceinline__ float sigmoidf_(float x) { return 1.0f / (1.0f + __expf(-x)); }

#define XB_TMO      128
#define XB_XCNT(j)  (256  + 64 * (j))
#define XB_XSUB(j)  (1280 + 64 * (j))
#define XB_XGEN(j)  (2304 + 64 * (j))
#define XB_TOP      3328
#define XB_TOPGEN   3392
#define XCD_BAR_WORDS 3456
#define XB_SPIN_CAP (1u << 20)
__device__ __forceinline__ unsigned xb_ld(unsigned* p)              { return __hip_atomic_load(p, __ATOMIC_RELAXED, __HIP_MEMORY_SCOPE_AGENT); }
__device__ __forceinline__ unsigned xb_add(unsigned* p, unsigned v) { return __hip_atomic_fetch_add(p, v, __ATOMIC_RELAXED, __HIP_MEMORY_SCOPE_AGENT); }
__device__ __forceinline__ unsigned xb_xcc_id() { return (unsigned)__builtin_amdgcn_s_getreg((3 << 11) | 20) & 0xFu; }
#define XB_SPIN(cond, bar) do { unsigned _sp = 0; while (cond) { __builtin_amdgcn_s_sleep(1); \
    if ((++_sp & 255u) == 0u) { if (xb_ld(&(bar)[XB_TMO])) break; if (_sp > XB_SPIN_CAP) { atomicAdd(&(bar)[XB_TMO], 1u); break; } } } } while (0)
struct XcdBarrier { unsigned* bar; unsigned x; volatile LAS unsigned* st; int wave; };
__device__ __forceinline__ XcdBarrier xcd_barrier_post(unsigned* bar, volatile LAS unsigned* st, int wave) {
    XcdBarrier b; b.bar = bar; b.x = xb_xcc_id(); b.st = st; b.wave = wave;
    if (wave == 0 && lane_id() == 0) (void)xb_add(&bar[XB_XCNT(b.x)], 1u);
    return b;
}
__device__ __forceinline__ void xcd_barrier_complete(unsigned* bar, unsigned x, unsigned& nloc, unsigned& nx) {
    const unsigned G = gridDim.x * gridDim.y * gridDim.z;
    unsigned sum, cnt, mine, sp = 0u;
    for (;;) {
        sum = 0u; cnt = 0u; mine = 0u;
#pragma unroll
        for (unsigned j = 0; j < 16; ++j) { const unsigned c = xb_ld(&bar[XB_XCNT(j)]); sum += c; cnt += (c > 0u) ? 1u : 0u; mine = (j == x) ? c : mine; }
        if (sum == G) break;
        __builtin_amdgcn_s_sleep(1);
        if ((++sp & 255u) == 0u) { if (xb_ld(&bar[XB_TMO])) break; if (sp > XB_SPIN_CAP) { atomicAdd(&bar[XB_TMO], 1u); break; } }
    }
    nloc = mine > 0u ? mine : 1u; nx = cnt > 0u ? cnt : 1u;
}
__device__ __forceinline__ void xcd_barrier(const XcdBarrier& b) {
    asm volatile("s_waitcnt vmcnt(0)" ::: "memory");
    __syncthreads();
    if (b.wave == 0 && lane_id() == 0) {
        unsigned* bar = b.bar; asm volatile("" : "+s"(bar));
        __builtin_amdgcn_s_waitcnt(0);
        unsigned nloc = b.st[0], nx = b.st[1];
        if (nloc == 0u) { xcd_barrier_complete(bar, b.x, nloc, nx); b.st[0] = nloc; b.st[1] = nx; }
        const unsigned old = xb_add(&bar[XB_XSUB(b.x)], 1u);
        const unsigned gen = old / nloc;
        if (old + 1u == (gen + 1u) * nloc) {
            __builtin_amdgcn_fence(__ATOMIC_RELEASE, "agent");
            asm volatile("s_waitcnt vmcnt(0)" ::: "memory");
            const unsigned og = xb_add(&bar[XB_TOP], 1u);
            const unsigned tg = og / nx;
            if (og + 1u == (tg + 1u) * nx) xb_add(&bar[XB_TOPGEN], 1u);
            else XB_SPIN(xb_ld(&bar[XB_TOPGEN]) == tg, bar);
            __builtin_amdgcn_fence(__ATOMIC_ACQUIRE, "agent");
            xb_add(&bar[XB_XGEN(b.x)], 1u);
            asm volatile("s_waitcnt vmcnt(0)" ::: "memory");
        } else {
            XB_SPIN(xb_ld(&bar[XB_XGEN(b.x)]) == gen, bar);
            __builtin_amdgcn_fence(__ATOMIC_ACQUIRE, "agent");
            asm volatile("s_waitcnt vmcnt(0)" ::: "memory");
        }
    }
    __syncthreads();
}

struct Args { const float* in[N_INPUTS]; float* out; unsigned char* ws; int ph_lo, ph_hi; };
struct Frame {
    LAS unsigned char* lds;
    int tid, lane, wave, G, bid;
};
constexpr int LDS_ARGT = 131072 + 1024;
__device__ __forceinline__ const float* INP(const Frame& F, int k) {
    const LAS unsigned* t = (const LAS unsigned*)(F.lds + LDS_ARGT) + 2 * k;
    const unsigned lo = __builtin_amdgcn_readfirstlane(t[0]), hi = __builtin_amdgcn_readfirstlane(t[1]);
    return (const float*)(((unsigned long long)hi << 32) | lo);
}
__device__ __forceinline__ float* OUTP(const Frame& F) { return (float*)INP(F, 46); }
__device__ __forceinline__ unsigned char* WSP(const Frame& F) { return (unsigned char*)INP(F, 47); }

namespace pg8 {
constexpr int BM = 256, BK = 64, HALF = 128, HTB = HALF * BK * 2, STAGE_BYTES = 8 * HTB, NXCD = 8, WGM = 4;
__host__ __device__ __forceinline__ int lds_byte(int r, int c) { const int st = (r >> 4) * 2 + (c >> 5), rr = r & 15, cc = c & 31, ob = rr * 64 + cc * 2; return st * 1024 + (ob ^ (((ob >> 9) & 1) << 5)); }
__host__ __device__ __forceinline__ void stage_rc(int b, int& R, int& C) { const int st = b / 1024, sb = b % 1024, swz = sb ^ (((sb >> 9) & 1) << 5); R = (st >> 1) * 16 + swz / 64; C = (st & 1) * 32 + (swz % 64) / 2; }
__host__ __device__ __forceinline__ int perm32(int rho) { const int n = rho >> 4, i = rho & 15; return 8 * (i >> 2) + 4 * n + (i & 3); }

struct Unit { int pm, pn, br; };
struct Gemm { const bf16* A; const bf16* Bt; int lda, ldb, K; int a_br_stride  , a_pair_off  , b_br_tiles  ; };

struct Order {
    int nM, nN, nwg, G, c, nbr;
    __device__ void init(int Mrows, int N, int G_, int c_, int nbr_) { nM = Mrows / BM; nN = N / BM; nwg = nM * nN; G = G_; c = c_; nbr = nbr_; }
    __device__ bool next(int i, Unit& u) const {
        const int it = i / nbr; u.br = i - it * nbr;
        const long L = (long)it * G + c; if (L >= nwg) return false;
        int wgid = (int)L; { const int q = nwg / NXCD, r = nwg % NXCD, xcd = wgid % NXCD, off = wgid / NXCD; wgid = (xcd < r ? xcd * (q + 1) : r * (q + 1) + (xcd - r) * q) + off; }
        const int nig = WGM * nN, gid = wgid / nig, fm = gid * WGM, gsz = (nM - fm) < WGM ? (nM - fm) : WGM;
        u.pm = fm + ((wgid % nig) % gsz); u.pn = (wgid % nig) / gsz; return true;
    }
};
struct Order5 {
    Order o;
    __device__ void init(int Mrows, int G_, int c_) { o.init(Mrows, 20 * BM, G_, c_, 1); }
    __device__ bool next(int i, Unit& u) const { if (!o.next(i, u)) return false; u.br = u.pn >> 2; u.pn &= 3; return true; }
};

template <class Epi, class Sched>
__device__ __forceinline__ void gemm_phase(LAS unsigned char* lds, const Gemm g, const Sched& S, const Epi& E, int wave) {
    int tid = wave * 64 + lane_id(); asm volatile("" : "+v"(tid));
    const int wid = __builtin_amdgcn_readfirstlane(tid >> 6), lane = tid & 63, wr = wid >> 2, wc = wid & 3, fr = lane & 15, fq = lane >> 4;
    const int K = g.K; int nt = K / BK; asm volatile("" : "+s"(nt));
    unsigned voffA[2], voffB[2];
#pragma unroll
    for (int i = 0; i < 2; ++i) { int R, C; stage_rc(tid * 16 + i * 8192, R, C); const int Rb = Epi::PERM ? ((R & ~31) + perm32(R & 31)) : R;
        voffA[i] = (unsigned)(R * g.lda + C) * 2u; voffB[i] = (unsigned)(Rb * g.ldb + C) * 2u; }
    const size_t kstep = (size_t)(BK * 2);
    const size_t hstepA = (size_t)HALF * g.lda * 2, hstepB = (size_t)HALF * g.ldb * 2;
    const unsigned ldsw = (unsigned)wid * 1024u;
    const int aoff = lds_byte(wr * 64 + fr, fq * 8), boff = lds_byte(wc * 32 + fr, fq * 8);
#define PG8_APTR(u) ((const char*)g.A + ((size_t)(u).pm * 256 * g.lda + (size_t)(u).br * g.a_br_stride + (size_t)((u).br >> 1) * g.a_pair_off) * 2)
#define PG8_BPTR(u) ((const char*)g.Bt + ((size_t)((u).br * g.b_br_tiles + (u).pn) * 256 * g.ldb) * 2)
#define PG8_SA(b, h) (((b) * 2 + (h)) * HTB)
#define PG8_SB(b, h) ((4 + (b) * 2 + (h)) * HTB)
#define PG8_STAGE(bufoff, gbase, voff) do { _Pragma("unroll") for (int _i = 0; _i < 2; ++_i) \
        __builtin_amdgcn_global_load_lds((const unsigned*)((const char*)(gbase) + (voff)[_i]), (LAS unsigned*)(lds + (bufoff) + ldsw + _i * 8192), 16, 0, 0); } while (0)
#define PG8_LDA(dst, b, h) do { _Pragma("unroll") for (int m = 0; m < 4; ++m) _Pragma("unroll") for (int k = 0; k < 2; ++k) dst[m][k] = *(const LAS bf16x8*)(lds + PG8_SA(b, h) + aoff + m * 2048 + k * 1024); } while (0)
#define PG8_LDB(dst, b, h) do { _Pragma("unroll") for (int n = 0; n < 2; ++n) _Pragma("unroll") for (int k = 0; k < 2; ++k) dst[n][k] = *(const LAS bf16x8*)(lds + PG8_SB(b, h) + boff + n * 2048 + k * 1024); } while (0)
#define PG8_MMA(ai, bj, At, Bt) do { __builtin_amdgcn_s_setprio(1); _Pragma("unroll") for (int m = 0; m < 4; ++m) _Pragma("unroll") for (int n = 0; n < 2; ++n) _Pragma("unroll") for (int k = 0; k < 2; ++k) \
        acc[ai][bj][m][n] = __builtin_amdgcn_mfma_f32_16x16x32_bf16(Bt[n][k], At[m][k], acc[ai][bj][m][n], 0, 0, 0); __builtin_amdgcn_s_setprio(0); } while (0)
#define PG8_WAIT_V(n) asm volatile("s_waitcnt vmcnt(" #n ")" ::: "memory")
#define PG8_WAIT_L(n) asm volatile("s_waitcnt lgkmcnt(" #n ")" ::: "memory")
#define PG8_BAR __builtin_amdgcn_s_barrier()
#define PG8_SCHED __builtin_amdgcn_sched_barrier(0)
    Unit cur, nxt; int ui = 0;
    if (!S.next(0, cur)) return;
    f32x4 acc[2][2][4][2];
#pragma unroll
    for (int a = 0; a < 2; ++a)
#pragma unroll
        for (int b = 0; b < 2; ++b)
#pragma unroll
            for (int m = 0; m < 4; ++m)
#pragma unroll
                for (int n = 0; n < 2; ++n) acc[a][b][m][n] = (f32x4){0.f, 0.f, 0.f, 0.f};
    bf16x8 At[4][2], B0[2][2], B1[2][2];
    const char* cA = PG8_APTR(cur); const char* cB = PG8_BPTR(cur);
    PG8_STAGE(PG8_SB(0, 0), cB, voffB); PG8_STAGE(PG8_SB(0, 1), cB + hstepB, voffB); PG8_STAGE(PG8_SA(0, 0), cA, voffA); PG8_STAGE(PG8_SA(0, 1), cA + hstepA, voffA);
    if (wr == 1) PG8_BAR;
    PG8_WAIT_V(2); PG8_BAR;
    PG8_STAGE(PG8_SB(1, 0), cB + kstep, voffB); PG8_STAGE(PG8_SA(1, 0), cA + kstep, voffA); PG8_STAGE(PG8_SB(1, 1), cB + hstepB + kstep, voffB);
    PG8_WAIT_V(6); PG8_BAR;
    for (;;) {
        const bool has_next = S.next(ui + 1, nxt);
        const char* nA = has_next ? PG8_APTR(nxt) : cA; const char* nB = has_next ? PG8_BPTR(nxt) : cB;
#pragma unroll 1
        for (int t = 0; t < nt; t += 2) {
            const bool last = (t == nt - 2);
            const char* a1 = cA + (size_t)(t + 1) * kstep;
            const char* a2 = last ? nA : cA + (size_t)(t + 2) * kstep; const char* b2 = last ? nB : cB + (size_t)(t + 2) * kstep;
            const char* a3 = a2 + kstep; const char* b3 = b2 + kstep;
            PG8_LDB(B0, 0, 0); PG8_LDB(B1, 0, 1); PG8_SCHED; PG8_LDA(At, 0, 0); PG8_STAGE(PG8_SA(1, 1), a1 + hstepA, voffA);
            PG8_WAIT_V(8); PG8_WAIT_L(0); PG8_BAR; PG8_MMA(0, 0, At, B0); PG8_MMA(0, 1, At, B1); PG8_BAR; PG8_SCHED;
            PG8_LDA(At, 0, 1); PG8_STAGE(PG8_SB(0, 0), b2, voffB); PG8_STAGE(PG8_SB(0, 1), b2 + hstepB, voffB); PG8_STAGE(PG8_SA(0, 0), a2, voffA);
            PG8_WAIT_V(8); PG8_WAIT_L(0); PG8_BAR; PG8_MMA(1, 0, At, B0); PG8_MMA(1, 1, At, B1); PG8_BAR; PG8_SCHED;
            PG8_LDB(B0, 1, 0); PG8_LDB(B1, 1, 1); PG8_SCHED; PG8_LDA(At, 1, 0); PG8_STAGE(PG8_SA(0, 1), a2 + hstepA, voffA);
            PG8_WAIT_V(8); PG8_WAIT_L(0); PG8_BAR; PG8_MMA(0, 0, At, B0); PG8_MMA(0, 1, At, B1); PG8_BAR; PG8_SCHED;
            PG8_LDA(At, 1, 1); PG8_STAGE(PG8_SB(1, 0), b3, voffB); PG8_STAGE(PG8_SB(1, 1), b3 + hstepB, voffB); PG8_STAGE(PG8_SA(1, 0), a3, voffA);
            PG8_WAIT_V(8); PG8_WAIT_L(0); PG8_BAR; PG8_MMA(1, 0, At, B0); PG8_MMA(1, 1, At, B1); PG8_BAR; PG8_SCHED;
        }
        if (wr == 0) PG8_BAR;
        E(acc, cur, wr, wc, fr, fq);
        if (!has_next) break;
#pragma unroll
        for (int a = 0; a < 2; ++a)
#pragma unroll
            for (int b = 0; b < 2; ++b)
#pragma unroll
                for (int m = 0; m < 4; ++m)
#pragma unroll
                    for (int n = 0; n < 2; ++n) acc[a][b][m][n] = (f32x4){0.f, 0.f, 0.f, 0.f};
        cur = nxt; cA = nA; cB = nB; ++ui;
        if (wr == 1) PG8_BAR;
    }
    PG8_WAIT_V(0);
    PG8_BAR;
#undef PG8_APTR
#undef PG8_BPTR
#undef PG8_SA
#undef PG8_SB
#undef PG8_STAGE
#undef PG8_LDA
#undef PG8_LDB
#undef PG8_MMA
#undef PG8_WAIT_V
#undef PG8_WAIT_L
#undef PG8_BAR
#undef PG8_SCHED
}

__device__ __forceinline__ float mrow_sel(int row) { return 0.f; }
__device__ __forceinline__ int modrow(int row) { return row < NPR ? 0 : 1 + ((row - NPR) >> 11); }

struct EpiProj {
    static constexpr bool PERM = true;
    bf16* proj; float* outk; float* outv; int layer;
    __device__ __forceinline__ void operator()(const f32x4 (&acc)[2][2][4][2], const Unit& u, int wr, int wc, int fr, int fq) const {
        { int t_ = lane_id(); asm volatile("" : "+v"(t_)); fr = t_ & 15; fq = (t_ >> 4) & 3; }
        const int row0 = u.pm * BM + wr * 64 + fr, colb = u.pn * BM + wc * 32 + 8 * fq;
        const int mode = (u.pn == 60) ? 1 : (u.pn == 61 ? 2 : ((u.pn >= 36) ? 3 : 0));
        const bool kv = (u.pm < 32) && (u.pn >= 4) && (u.pn < 12);
#pragma unroll
        for (int ai = 0; ai < 2; ++ai)
#pragma unroll
            for (int m = 0; m < 4; ++m) {
                const int row = row0 + ai * HALF + m * 16;
                bf16* rowp = proj + (size_t)row * NPROJ + colb;
#pragma unroll
                for (int bj = 0; bj < 2; ++bj) {
                    f32x4 v0 = acc[ai][bj][m][0], v1 = acc[ai][bj][m][1];
                    if (mode == 1) { if (colb + bj * HALF < COL_G1A) {
#pragma unroll
                        for (int j = 0; j < 4; ++j) { v0[j] = tanhf(v0[j]); v1[j] = tanhf(v1[j]); } } }
                    else if (mode == 3) {
#pragma unroll
                        for (int j = 0; j < 4; ++j) { v0[j] = sigmoidf_(v0[j]); v1[j] = sigmoidf_(v1[j]); } }
                    else if (mode == 2) { const bool act = (colb + bj * HALF) < 15744;
#pragma unroll
                        for (int j = 0; j < 4; ++j) { v0[j] = act ? sigmoidf_(v0[j]) : 0.f; v1[j] = act ? sigmoidf_(v1[j]) : 0.f; } }
                    u32x4 w; w.x = cvtpk(v0[0], v0[1]); w.y = cvtpk(v0[2], v0[3]); w.z = cvtpk(v1[0], v1[1]); w.w = cvtpk(v1[2], v1[3]);
                    *(u32x4*)(rowp + bj * HALF) = w;
                    if (kv) { const int col = colb + bj * HALF; float* ob = (u.pn < 8) ? outk : outv; const int ch = col - ((u.pn < 8) ? COL_K : COL_V);
                        float* dst = ob + ((size_t)(((row >> 8) * 4 + layer) * 256 + (row & 255))) * 1024 + ch;
                        *(f32x4*)dst = v0; *(f32x4*)(dst + 4) = v1; }
                }
            }
    }
};
struct EpiLora2 {
    static constexpr bool PERM = true;
    bf16* dec; bf16* abuf; bf16* gbuf; const float* w0; const float* a0;
    __device__ __forceinline__ void operator()(const f32x4 (&acc)[2][2][4][2], const Unit& u, int wr, int wc, int fr, int fq) const {
        { int t_ = lane_id(); asm volatile("" : "+v"(t_)); fr = t_ & 15; fq = (t_ >> 4) & 3; }
        const int row0 = u.pm * BM + wr * 64 + fr, colb = u.pn * BM + wc * 32 + 8 * fq;
        const int br = u.br, e = br & 1;
        const float* bsrc = (br < 2) ? w0 + e * 1024 : a0 + e * 1024;
#pragma unroll
        for (int bj = 0; bj < 2; ++bj)
#pragma unroll
            for (int n = 0; n < 2; ++n) {
                const int ch = colb + bj * HALF + 4 * n;
                f32x4 b0 = (f32x4){0.f, 0.f, 0.f, 0.f};
                if (br < 4) b0 = *(const f32x4*)(bsrc + ch);
#pragma unroll
                for (int ai = 0; ai < 2; ++ai)
#pragma unroll
                    for (int m = 0; m < 4; ++m) {
                        const int row = row0 + ai * HALF + m * 16;
                        f32x4 v0 = acc[ai][bj][m][n] + b0;
                        if (br < 2) {
#pragma unroll
                            for (int j = 0; j < 4; ++j) v0[j] = -0.6065306597126334f * sigmoidf_(v0[j]);
                            *(u32x2*)(dec + ((size_t)row * 2 + e) * 1024 + ch) = (u32x2){cvtpk(v0[0], v0[1]), cvtpk(v0[2], v0[3])};
                        } else {
                            if (br < 4) {
#pragma unroll
                                for (int j = 0; j < 4; ++j) v0[j] = sigmoidf_(v0[j]); }
                            bf16* dst = (br < 4) ? abuf + ((size_t)row * 2 + e) * 1024 + ch : gbuf + (size_t)row * 1024 + ch;
                            *(u32x2*)dst = (u32x2){cvtpk(v0[0], v0[1]), cvtpk(v0[2], v0[3])};
                        }
                        __builtin_amdgcn_sched_barrier(0);
                    }
            }
    }
};
struct EpiMerge {
    static constexpr bool PERM = true;
    const bf16* proj; bf16* merged;
    __device__ __forceinline__ void operator()(const f32x4 (&acc)[2][2][4][2], const Unit& u, int wr, int wc, int fr, int fq) const {
        { int t_ = lane_id(); asm volatile("" : "+v"(t_)); fr = t_ & 15; fq = (t_ >> 4) & 3; }
        const int row0 = u.pm * BM + wr * 64 + fr, colb = u.pn * BM + wc * 32 + 8 * fq;
        const int br = u.br;
#pragma unroll
        for (int ai = 0; ai < 2; ++ai)
#pragma unroll
            for (int m = 0; m < 4; ++m) {
                const int row = row0 + ai * HALF + m * 16;
#pragma unroll
                for (int bj = 0; bj < 2; ++bj) {
                    const int col = colb + bj * HALF;
                    const u32x4 gw = *(const u32x4*)(proj + (size_t)row * NPROJ + COL_GL + br * 2048 + col);
                    bf16* dst = merged + (size_t)row * D + col;
                    f32x4 v0 = acc[ai][bj][m][0], v1 = acc[ai][bj][m][1];
                    v0[0] *= bflo(gw.x); v0[1] *= bfhi(gw.x); v0[2] *= bflo(gw.y); v0[3] *= bfhi(gw.y);
                    v1[0] *= bflo(gw.z); v1[1] *= bfhi(gw.z); v1[2] *= bflo(gw.w); v1[3] *= bfhi(gw.w);
                    if (br > 0) { const u32x4 pw = *(const u32x4*)dst;
                        v0[0] += bflo(pw.x); v0[1] += bfhi(pw.x); v0[2] += bflo(pw.y); v0[3] += bfhi(pw.y);
                        v1[0] += bflo(pw.z); v1[1] += bfhi(pw.z); v1[2] += bflo(pw.w); v1[3] += bfhi(pw.w); }
                    u32x4 w; w.x = cvtpk(v0[0], v0[1]); w.y = cvtpk(v0[2], v0[3]); w.z = cvtpk(v1[0], v1[1]); w.w = cvtpk(v1[2], v1[3]);
                    *(u32x4*)dst = w;
                }
            }
    }
};
struct EpiResid {
    static constexpr bool PERM = false;
    float* x; const float* gate;   const float* bias; float gscale;
    __device__ __forceinline__ void operator()(const f32x4 (&acc)[2][2][4][2], const Unit& u, int wr, int wc, int fr, int fq) const {
        { int t_ = lane_id(); asm volatile("" : "+v"(t_)); fr = t_ & 15; fq = (t_ >> 4) & 3; }
        const int row0 = u.pm * BM + wr * 64 + fr, col0 = u.pn * BM + wc * 32 + 4 * fq;
        const int mr = modrow(u.pm * BM);
        const float* gp = gate + (size_t)mr * 12288;
        f32x4 gv[2][2], bv[2][2];
#pragma unroll
        for (int bj = 0; bj < 2; ++bj)
#pragma unroll
            for (int n = 0; n < 2; ++n) { gv[bj][n] = *(const f32x4*)(gp + col0 + bj * HALF + n * 16) * gscale;
                bv[bj][n] = bias ? *(const f32x4*)(bias + col0 + bj * HALF + n * 16) : (f32x4){0.f, 0.f, 0.f, 0.f}; }
#pragma unroll
        for (int ai = 0; ai < 2; ++ai)
#pragma unroll
            for (int m = 0; m < 4; ++m) { float* rowp = x + (size_t)(row0 + ai * HALF + m * 16) * D + col0;
#pragma unroll
                for (int bj = 0; bj < 2; ++bj)
#pragma unroll
                    for (int n = 0; n < 2; ++n) { f32x4* p = (f32x4*)(rowp + bj * HALF + n * 16); const f32x4 xo = *p; *p = xo + gv[bj][n] * (acc[ai][bj][m][n] + bv[bj][n]); }
                asm volatile("" ::: "memory"); }
    }
};
struct EpiFF1 {
    static constexpr bool PERM = true;
    bf16* U; const float* bias;
    __device__ __forceinline__ void operator()(const f32x4 (&acc)[2][2][4][2], const Unit& u, int wr, int wc, int fr, int fq) const {
        { int t_ = lane_id(); asm volatile("" : "+v"(t_)); fr = t_ & 15; fq = (t_ >> 4) & 3; }
        const int row0 = u.pm * BM + wr * 64 + fr, colb = u.pn * BM + wc * 32 + 8 * fq;
        f32x4 bv[2][2];
#pragma unroll
        for (int bj = 0; bj < 2; ++bj)
#pragma unroll
            for (int n = 0; n < 2; ++n) bv[bj][n] = *(const f32x4*)(bias + colb + bj * HALF + 4 * n);
#pragma unroll
        for (int ai = 0; ai < 2; ++ai)
#pragma unroll
            for (int m = 0; m < 4; ++m) { bf16* rowp = U + (size_t)(row0 + ai * HALF + m * 16) * DFF + colb;
#pragma unroll
                for (int bj = 0; bj < 2; ++bj) { f32x4 v0 = acc[ai][bj][m][0] + bv[bj][0], v1 = acc[ai][bj][m][1] + bv[bj][1];
#pragma unroll
                    for (int j = 0; j < 4; ++j) { const float a = fmaxf(v0[j], 0.f), b = fmaxf(v1[j], 0.f); v0[j] = a * a; v1[j] = b * b; }
                    u32x4 w; w.x = cvtpk(v0[0], v0[1]); w.y = cvtpk(v0[2], v0[3]); w.z = cvtpk(v1[0], v1[1]); w.w = cvtpk(v1[2], v1[3]);
                    *(u32x4*)(rowp + bj * HALF) = w; } }
    }
};
}

__device__ __forceinline__ void transpose_item(const float* W, int K, int N, bf16* WT, int ldk, int row_off, LAS bf16* scr, int item, int lane) {
    const int nblk = N / 64, kb = item / nblk, nb = item % nblk, k0 = 32 * kb, n = 64 * nb + lane;
    const float* src = W + (size_t)k0 * N + n;
    float v[32];
#pragma unroll
    for (int i = 0; i < 32; ++i) v[i] = src[(size_t)i * N];
    bf16* dst = WT + (size_t)(row_off + n) * ldk + k0;
#pragma unroll
    for (int q = 0; q < 4; ++q) *(u32x4*)(dst + 8 * q) = (u32x4){cvtpk(v[8 * q], v[8 * q + 1]), cvtpk(v[8 * q + 2], v[8 * q + 3]), cvtpk(v[8 * q + 4], v[8 * q + 5]), cvtpk(v[8 * q + 6], v[8 * q + 7])};
    (void)scr; (void)K;
}

__device__ __forceinline__ void convert_layer(const Frame& F, int l, LAS bf16* scr, int gw, int NGW) {
    unsigned char* ws = WSP(F);
        bf16* WinT = (bf16*)(ws + WS_WIN) + (size_t)l * NPROJ * D;
        {   const int n_items = (D / 32) * (15360 / 64); const float* W = INP(F, I_WIN) + (size_t)l * D * 15360;
            for (int it = gw; it < n_items; it += NGW) transpose_item(W, D, 15360, WinT, D, 0, scr, it, F.lane); }
        for (int e = 0; e < 2; ++e) {
            const int n_items = (D / 32);
            const float* W1 = INP(F, I_W1) + ((size_t)l * 2 + e) * D * 64; const float* A1 = INP(F, I_A1) + ((size_t)l * 2 + e) * D * 64;
            for (int it = gw; it < n_items; it += NGW) { transpose_item(W1, D, 64, WinT, D, COL_LW + e * 64, scr, it, F.lane); transpose_item(A1, D, 64, WinT, D, COL_LW + 128 + e * 64, scr, it, F.lane); }
        }
        {   const int n_items = (D / 32) * 2; const float* W = INP(F, I_G1) + (size_t)l * D * 128;
            for (int it = gw; it < n_items; it += NGW) transpose_item(W, D, 128, WinT, D, COL_LW + 256, scr, it, F.lane); }
        for (int i = gw * 64 + F.lane; i < 128 * D / 8; i += NGW * 64) ((u32x4*)(WinT + (size_t)15744 * D))[i] = (u32x4){0u, 0u, 0u, 0u};
        for (int br = 0; br < 3; ++br) { const float* W = INP(F, I_WPA + br) + (size_t)l * 1024 * D; bf16* WT = (bf16*)(ws + WS_WP) + ((size_t)l * 3 + br) * D * 1024;
            const int n_items = (1024 / 32) * (D / 64);
            for (int it = gw; it < n_items; it += NGW) transpose_item(W, 1024, D, WT, 1024, 0, scr, it, F.lane); }
        {   const float* W = INP(F, I_WOUT) + (size_t)l * D * D; bf16* WT = (bf16*)(ws + WS_WOUT) + (size_t)l * D * D; const int n_items = (D / 32) * (D / 64);
            for (int it = gw; it < n_items; it += NGW) transpose_item(W, D, D, WT, D, 0, scr, it, F.lane); }
        {   const float* W = INP(F, I_FF1) + (size_t)l * D * DFF; bf16* WT = (bf16*)(ws + WS_WFF1) + (size_t)l * D * DFF; const int n_items = (D / 32) * (DFF / 64);
            for (int it = gw; it < n_items; it += NGW) transpose_item(W, D, DFF, WT, D, 0, scr, it, F.lane); }
        {   const float* W = INP(F, I_FF2) + (size_t)l * D * DFF; bf16* WT = (bf16*)(ws + WS_WFF2) + (size_t)l * D * DFF; const int n_items = (DFF / 32) * (D / 64);
            for (int it = gw; it < n_items; it += NGW) transpose_item(W, DFF, D, WT, DFF, 0, scr, it, F.lane); }
        {   bf16* W2T = (bf16*)(ws + WS_W2T) + (size_t)l * 5120 * 128;
            const float* w2 = INP(F, I_W2) + (size_t)l * 2 * 64 * 1024; const float* a2 = INP(F, I_A2) + (size_t)l * 2 * 64 * 1024; const float* g2 = INP(F, I_G2) + (size_t)l * 128 * 1024;
            for (int it = gw; it < 32 * 6; it += NGW) { const int m = it / 32, sub = it % 32;
                const float* W = m == 0 ? w2 : (m == 1 ? w2 + 65536 : (m == 2 ? a2 : (m == 3 ? a2 + 65536 : (m == 4 ? g2 : g2 + 65536))));
                const int br = m < 4 ? m : 4, koff = m < 4 ? 64 * (m & 1) : (m == 4 ? 0 : 64);
                transpose_item(W, 64, 1024, W2T + (size_t)br * 1024 * 128 + koff, 128, 0, scr, sub, F.lane); }
            for (int i = gw * 64 + F.lane; i < 4096 * 8; i += NGW * 64) { const int n = i >> 3, k8 = (i & 7) * 8, br = n >> 10;
                *(u32x4*)(W2T + (size_t)n * 128 + ((br & 1) ? 0 : 64) + k8) = (u32x4){0u, 0u, 0u, 0u}; }
        }
    }

__device__ __forceinline__ void prologue0(const Frame& F, const Args& a) {
    unsigned char* ws = WSP(F);
    LAS bf16* scr = (LAS bf16*)(F.lds + F.wave * 16384);
    const int gw = F.bid * 8 + F.wave, NGW = F.G * 8;
    convert_layer(F, 0, scr, gw, NGW);
    {   const float* ck = INP(F, I_CK); const float* cv = INP(F, I_CV); bf16* ok = (bf16*)(ws + WS_CK); bf16* ov = (bf16*)(ws + WS_CV);
        const int n4 = 4 * 4 * 256 * 1024 / 4;
        for (int i = gw * 64 + F.lane; i < n4; i += NGW * 64) { const f32x4 x = ((const f32x4*)ck)[i], y = ((const f32x4*)cv)[i];
            ((u32x2*)ok)[i] = (u32x2){cvtpk(x[0], x[1]), cvtpk(x[2], x[3])}; ((u32x2*)ov)[i] = (u32x2){cvtpk(y[0], y[1]), cvtpk(y[2], y[3])}; }
    }
    {   LAS float* sv = (LAS float*)(F.lds + 65536);
        __syncthreads();
        for (int i = F.tid; i < 5 * D; i += 512) { const int r = i / D, d = i - r * D; const float x = (r == 0) ? INP(F, I_CCTX)[d] : INP(F, I_C)[(r - 1) * D + d]; sv[i] = x / (1.0f + __expf(-x)); }
        __syncthreads();
        float* PART = (float*)(ws + WS_Q);
        const int n_items = DEPTH * 48 * 8;
        for (int it = gw; it < n_items; it += NGW) {
            const int l = it / 384, rem = it % 384, jc = rem >> 3, ds = rem & 7, j4 = jc * 256 + 4 * F.lane;
            const float* W = INP(F, I_WMOD) + (size_t)l * D * 12288 + (size_t)(ds * 256) * 12288 + j4;
            f32x4 acc[5];
#pragma unroll
            for (int r = 0; r < 5; ++r) acc[r] = (f32x4){0.f, 0.f, 0.f, 0.f};
#pragma unroll 4
            for (int d = 0; d < 256; d += 4) {
                f32x4 w[4];
#pragma unroll
                for (int q = 0; q < 4; ++q) w[q] = *(const f32x4*)(W + (size_t)(d + q) * 12288);
#pragma unroll
                for (int r = 0; r < 5; ++r) { const f32x4 s = *(const LAS f32x4*)(sv + r * D + ds * 256 + d);
#pragma unroll
                    for (int q = 0; q < 4; ++q) acc[r] += w[q] * s[q]; }
            }
#pragma unroll
            for (int r = 0; r < 5; ++r) *(f32x4*)(PART + (((size_t)ds * 4 + l) * 5 + r) * 12288 + j4) = acc[r];
        }
        __syncthreads();
    }
    {   float* T2 = (float*)(ws + WS_T2);
        const int n_items = DEPTH * (L_S + L_P);
        for (int it = gw; it < n_items; it += NGW) {
            const int l = it / (L_S + L_P), rr = it % (L_S + L_P), sel = rr < L_S ? 0 : 1, t = sel ? rr - L_S : rr, L = sel ? L_P : L_S;
            float zf = 0.f;
            {   const float tt = (float)t / (float)(L - 1);
                const float w = (6.283185307179586f * (float)t) / (float)L;
                const int band = (F.lane - 1) & 15;
                const float f = 1e-4f + (float)band * ((15.0f - 1e-4f) / 15.0f);
                const float fw = f * w;
                const double rd = (double)fw - 6.283185307179586 * rint((double)fw * 0.15915494309189535);
                const float rf = (float)rd;
                zf = (F.lane == 0) ? tt : (F.lane <= 16 ? __cosf(rf) : -__sinf(rf));
            }
            const float* f1 = INP(F, I_F1) + (size_t)l * 33 * 64; const float* f2 = INP(F, I_F2) + (size_t)l * 64 * 64;
            const float fq = INP(F, I_FREQ)[l * 64 + F.lane];
            float s = INP(F, I_FB1)[l * 64 + F.lane];
            for (int i = 0; i < 33; ++i) s += __int_as_float(__builtin_amdgcn_readlane(__float_as_int(zf), i)) * f1[i * 64 + F.lane];
            float x = fq * s; { const double rd = (double)x - 6.283185307179586 * rint((double)x * 0.15915494309189535); x = (float)rd; }
            const float t1 = __sinf(x);
            float s2 = INP(F, I_FB2)[l * 64 + F.lane];
            for (int i = 0; i < 64; ++i) s2 += __int_as_float(__builtin_amdgcn_readlane(__float_as_int(t1), i)) * f2[i * 64 + F.lane];
            float y = fq * s2; { const double rd = (double)y - 6.283185307179586 * rint((double)y * 0.15915494309189535); y = (float)rd; }
            T2[(((size_t)l * 2 + sel) * L_S + t) * 64 + F.lane] = __sinf(y);
        }
    }
    {   bf16* FS = (bf16*)(ws + WS_FS); bf16* FP = (bf16*)(ws + WS_FP);
        for (int i = gw * 64 + F.lane; i < DEPTH * 1024 * 72; i += NGW * 64) { const int row = i / 72, p = i % 72; const int m = p < 32 ? p : p - 32 + 32;
            FS[(size_t)row * LPS + (p < 32 ? p : L_S + p)] = 0; FP[(size_t)row * LPP + (p < 32 ? p : L_P + p)] = 0; (void)m; }
    }
}

__device__ __forceinline__ void prologue1(const Frame& F, const Args& a) {
    unsigned char* ws = WSP(F);
    const int gw = F.bid * 8 + F.wave, NGW = F.G * 8;
    {   const float* PART = (const float*)(ws + WS_Q); float* MOD = (float*)(ws + WS_MOD);
        for (int i = (F.bid * 8 + F.wave) * 64 + F.lane; i < DEPTH * 5 * 12288 / 4; i += F.G * 8 * 64) {
            const int l = i / (5 * 3072), j4 = (i % 3072) * 4;
            f32x4 s = *(const f32x4*)(INP(F, I_BMOD) + l * 12288 + j4);
#pragma unroll
            for (int ds = 0; ds < 8; ++ds) s += ((const f32x4*)PART)[(size_t)ds * (DEPTH * 5 * 3072) + i];
            ((f32x4*)MOD)[i] = s; }
    }
    const float* T2 = (const float*)(ws + WS_T2);
    float* FNORM = (float*)(ws + WS_CTL) + CW_FNORM;
    const int items_s = DEPTH * 16 * (L_S / 64), items_p = DEPTH * 16 * (L_P / 64);
    for (int it = gw; it < items_s + items_p; it += NGW) {
        int sel, l, cg, tc;
        if (it < items_s) { sel = 0; l = it / (16 * 32); cg = (it / 32) % 16; tc = it % 32; } else { const int r = it - items_s; sel = 1; l = r / (16 * 4); cg = (r / 4) % 16; tc = r % 4; }
        const int L = sel ? L_P : L_S, c = cg * 64 + F.lane;
        const float* f3 = INP(F, I_F3) + (size_t)l * 64 * 1024 + c;
        float w3[64];
#pragma unroll
        for (int j = 0; j < 64; ++j) w3[j] = f3[(size_t)j * 1024];
        const float delta = fabsf(-3.0701134573253946f + (float)c * ((-15.350567286626973f + 3.0701134573253946f) / 1023.0f));
        bf16* dst = sel ? (bf16*)(ws + WS_FP) + ((size_t)l * 1024 + c) * LPP : (bf16*)(ws + WS_FS) + ((size_t)l * 1024 + c) * LPS;
        float asum = 0.f;
        for (int tt = 0; tt < 64; ++tt) {
            const int t = tc * 64 + tt;
            const float tv = T2[(((size_t)l * 2 + sel) * L_S + t) * 64 + F.lane];
            float s = 0.f;
#pragma unroll
            for (int j = 0; j < 64; ++j) s += __int_as_float(__builtin_amdgcn_readlane(__float_as_int(tv), j)) * w3[j];
            const float dist = fabsf((float)(t - L / 2)) / (float)L;
            const float fv = s * __expf(-dist * delta);
            asum += fabsf(fv);
            dst[32 + (L - 1 - t)] = f2bf(fv);
        }
        atomicAdd(FNORM + ((size_t)l * 2 + sel) * 1024 + c, asum);
    }
}

__device__ __forceinline__ void norm_phase(const Frame& F, const float* xp, const float* xs, float* xcopy, const float* g, const float* mod, int i_sh, int i_sc, bf16* hout) {
    const int gw = F.bid * 8 + F.wave, NGW = F.G * 8;
    for (int row = gw; row < M; row += NGW) {
        const float* xr = row < NPR ? xp + (size_t)row * D : xs + (size_t)(row - NPR) * D;
        const float* mr = mod + (size_t)pg8::modrow(row) * 12288;
        f32x4 v[8]; float ss = 0.f;
#pragma unroll
        for (int j = 0; j < 8; ++j) { v[j] = ((const f32x4*)xr)[F.lane + 64 * j]; ss += (v[j][0] * v[j][0] + v[j][1] * v[j][1]) + (v[j][2] * v[j][2] + v[j][3] * v[j][3]); }
        const float rstd = 1.0f / sqrtf(wave_sum(ss) * (1.0f / D) + 1e-6f);
        if (xcopy) {
#pragma unroll
            for (int j = 0; j < 8; ++j) ((f32x4*)(xcopy + (size_t)row * D))[F.lane + 64 * j] = v[j]; }
#pragma unroll
        for (int j = 0; j < 8; ++j) {
            const f32x4 gg = ((const f32x4*)g)[F.lane + 64 * j], sc = ((const f32x4*)(mr + i_sc * D))[F.lane + 64 * j], sh = ((const f32x4*)(mr + i_sh * D))[F.lane + 64 * j];
            const f32x4 o = v[j] * rstd * gg * (1.0f + sc) + sh;
            ((u32x2*)(hout + (size_t)row * D))[F.lane + 64 * j] = (u32x2){cvtpk(o[0], o[1]), cvtpk(o[2], o[3])};
        }
    }
}
__device__ __forceinline__ void final_norm_phase(const Frame& F, float* x, const float* g) {
    const int gw = F.bid * 8 + F.wave, NGW = F.G * 8;
    for (int row = gw; row < M; row += NGW) {
        float* xr = x + (size_t)row * D;
        f32x4 v[8]; float ss = 0.f;
#pragma unroll
        for (int j = 0; j < 8; ++j) { v[j] = ((const f32x4*)xr)[F.lane + 64 * j]; ss += (v[j][0] * v[j][0] + v[j][1] * v[j][1]) + (v[j][2] * v[j][2] + v[j][3] * v[j][3]); }
        const float rstd = 1.0f / sqrtf(wave_sum(ss) * (1.0f / D) + 1e-6f);
#pragma unroll
        for (int j = 0; j < 8; ++j) { const f32x4 gg = ((const f32x4*)g)[F.lane + 64 * j]; ((f32x4*)xr)[F.lane + 64 * j] = v[j] * rstd * gg; }
    }
}

__device__ __forceinline__ s16x4 vtr(const LAS unsigned char* p) { return __builtin_bit_cast(s16x4, __builtin_amdgcn_ds_read_tr16_b64_v4i16((LAS s16x4*)p)); }

struct AttnState { float m, l; f32x16 o[2]; };

__device__ __forceinline__ void attn_loadk(bf16x8 (&kf)[2][4], const bf16* kbase, size_t kstride, int lane) {
    const bf16* kp = kbase + (size_t)(lane & 31) * kstride + 8 * (lane >> 5);
#pragma unroll
    for (int kt = 0; kt < 2; ++kt)
#pragma unroll
        for (int ks = 0; ks < 4; ++ks) kf[kt][ks] = *(const bf16x8*)(kp + (size_t)(32 * kt) * kstride + 16 * ks);
}
template <bool HASB, class BIAS>
__device__ __forceinline__ void attend64(AttnState& st, const bf16x8 (&qf)[4], bf16x8 (&kf)[2][4], const bf16* knext, size_t knstride, const LAS unsigned char* vb, const BIAS& bias, int lane) {
    constexpr int NT = 2;
    const int h = lane >> 5;
    f32x16 s[NT];
#pragma unroll
    for (int kt = 0; kt < NT; ++kt) {
        f32x16 acc;
#pragma unroll
        for (int i = 0; i < 16; ++i) acc[i] = 0.f;
#pragma unroll
        for (int ks = 0; ks < 4; ++ks) acc = __builtin_amdgcn_mfma_f32_32x32x16_bf16(kf[kt][ks], qf[ks], acc, 0, 0, 0);
        s[kt] = acc;
    }
    if (knext) attn_loadk(kf, knext, knstride, lane);
    float gm = -3.0e38f;
#pragma unroll
    for (int kt = 0; kt < NT; ++kt)
#pragma unroll
        for (int i = 0; i < 16; ++i) {
            float v = s[kt][i] * 0.125f;
            if (HASB) v = bias(kt, (i & 3) + 8 * (i >> 2) + 4 * h, v);
            s[kt][i] = v; gm = fmaxf(gm, v);
        }
    gm = fmaxf(gm, xor32(gm, lane));
    const float mnew = fmaxf(st.m, gm);
    const float alpha = __expf(st.m - mnew);
    float ps = 0.f;
#pragma unroll
    for (int kt = 0; kt < NT; ++kt)
#pragma unroll
        for (int i = 0; i < 16; ++i) { const float p = __expf(s[kt][i] - mnew); s[kt][i] = p; ps += p; }
    st.l = st.l * alpha + ps; st.m = mnew;
#pragma unroll
    for (int i = 0; i < 16; ++i) { st.o[0][i] *= alpha; st.o[1][i] *= alpha; }
    const int i16 = lane & 15, tq = i16 >> 2, tp = i16 & 3, blk = (lane >> 4) & 1;
#pragma unroll
    for (int kt = 0; kt < NT; ++kt) {
#pragma unroll
        for (int ss = 0; ss < 2; ++ss) {
            u32x4 pw; pw.x = cvtpk(s[kt][8 * ss + 0], s[kt][8 * ss + 1]); pw.y = cvtpk(s[kt][8 * ss + 2], s[kt][8 * ss + 3]); pw.z = cvtpk(s[kt][8 * ss + 4], s[kt][8 * ss + 5]); pw.w = cvtpk(s[kt][8 * ss + 6], s[kt][8 * ss + 7]);
            const bf16x8 pf = __builtin_bit_cast(bf16x8, pw);
#pragma unroll
            for (int dt = 0; dt < 2; ++dt) {
                const LAS unsigned char* p0 = vb + kt * 4096 + (16 * ss + 4 * h + tq) * 128 + (dt * 32 + 16 * blk + 4 * tp) * 2;
                const s16x4 lo = vtr(p0), hi = vtr(p0 + 8 * 128);
                const bf16x8 vf = __builtin_shufflevector(lo, hi, 0, 1, 2, 3, 4, 5, 6, 7);
                st.o[dt] = __builtin_amdgcn_mfma_f32_32x32x16_bf16(vf, pf, st.o[dt], 0, 0, 0);
            }
        }
    }
}

__device__ __forceinline__ void attn_store(const AttnState& st, bf16* orow  , int lane) {
    const int h = lane >> 5;
    const float lt = st.l + xor32(st.l, lane);
    const float inv = 1.0f / lt;
#pragma unroll
    for (int dt = 0; dt < 2; ++dt)
#pragma unroll
        for (int g = 0; g < 4; ++g) {
            const u32x2 w = (u32x2){cvtpk(st.o[dt][4 * g] * inv, st.o[dt][4 * g + 1] * inv), cvtpk(st.o[dt][4 * g + 2] * inv, st.o[dt][4 * g + 3] * inv)};
            *(u32x2*)(orow + dt * 32 + 8 * g + 4 * h) = w;
        }
}

__device__ __forceinline__ void attention_phase(const Frame& F, const Args& a, int layer) {
    unsigned char* ws = WSP(F);
    const bf16* proj = (const bf16*)(ws + WS_PROJ);
    bf16* oall = (bf16*)(ws + WS_OALL);
    const int lane = F.lane, w = F.wave, r = lane & 31, h = lane >> 5;
    LAS unsigned char* lds = F.lds;
    LAS float* rpbl = (LAS float*)(lds + 122880);
    for (int u = F.bid; u < 1024; u += F.G) {
        __syncthreads();
        if (u < 512) {
            const int b = u >> 4, hd = u & 15;
            const int tok0 = b * 256;
            for (int i = F.tid; i < 256 * 8; i += 512) { const int key = i >> 3, pc = i & 7;
                *(LAS u32x4*)(lds + key * 128 + pc * 16) = *(const u32x4*)(proj + (size_t)(tok0 + key) * NPROJ + COL_V + hd * 64 + pc * 8); }
            __syncthreads();
            bf16x8 qf[4];
            { const bf16* qp = proj + (size_t)(tok0 + 32 * w + r) * NPROJ + hd * 64 + 8 * h;
#pragma unroll
              for (int ks = 0; ks < 4; ++ks) qf[ks] = *(const bf16x8*)(qp + 16 * ks); }
            AttnState st; st.m = -3.0e38f; st.l = 0.f;
#pragma unroll
            for (int i = 0; i < 16; ++i) { st.o[0][i] = 0.f; st.o[1][i] = 0.f; }
            const bf16* kbase = proj + (size_t)tok0 * NPROJ + COL_K + hd * 64;
            bf16x8 kf[2][4];
            attn_loadk(kf, kbase, (size_t)NPROJ, lane);
#pragma unroll 1
            for (int kg = 0; kg < 4; ++kg)
                attend64<false>(st, qf, kf, kg < 3 ? kbase + (size_t)(64 * (kg + 1)) * NPROJ : nullptr, (size_t)NPROJ, lds + kg * 8192, [&](int, int, float v) { return v; }, lane);
            attn_store(st, oall + (size_t)(tok0 + 32 * w + r) * 3072 + hd * 64, lane);
        } else {
            const int uu = u - 512, b = uu >> 7, hd = (uu >> 3) & 15, rg = uu & 7;
            const int tokb = NPR + b * 2048;
            int rlo = 4 * rg - 4; rlo = rlo < 0 ? 0 : (rlo > 24 ? 24 : rlo);
            int rhi0 = 4 * rg + 3 - 4; rhi0 = rhi0 < 0 ? 0 : (rhi0 > 24 ? 24 : rhi0); const int nr = rhi0 + 8 - rlo;
            for (int i = F.tid; i < nr * 64 * 8; i += 512) { const int key = i >> 3, pc = i & 7;
                *(LAS u32x4*)(lds + key * 128 + pc * 16) = *(const u32x4*)(proj + (size_t)(tokb + rlo * 64 + key) * NPROJ + COL_V + hd * 64 + pc * 8); }
            const bf16* cv = (const bf16*)(ws + WS_CV) + ((size_t)(b * 4 + layer) * 256) * 1024 + hd * 64;
            const bf16* ck = (const bf16*)(ws + WS_CK) + ((size_t)(b * 4 + layer) * 256) * 1024 + hd * 64;
            for (int i = F.tid; i < 256 * 8; i += 512) { const int key = i >> 3, pc = i & 7;
                *(LAS u32x4*)(lds + 90112 + key * 128 + pc * 16) = *(const u32x4*)(cv + (size_t)key * 1024 + pc * 8); }
            for (int i = F.tid; i < 465; i += 512) rpbl[i] = INP(F, I_RPB)[((size_t)layer * 16 + hd) * 465 + i];
            __syncthreads();
            const int qrow = 4 * rg + (w >> 1), qc = (w & 1) * 32 + r;
            int r0 = qrow - 4; r0 = r0 < 0 ? 0 : (r0 > 24 ? 24 : r0);
            int c0 = qc - 8; c0 = c0 < 0 ? 0 : (c0 > 48 ? 48 : c0);
            const int qtok = tokb + qrow * 64 + (w & 1) * 32 + r;
            bf16x8 qf[4];
            { const bf16* qp = proj + (size_t)qtok * NPROJ + hd * 64 + 8 * h;
#pragma unroll
              for (int ks = 0; ks < 4; ++ks) qf[ks] = *(const bf16x8*)(qp + 16 * ks); }
            AttnState st; st.m = -3.0e38f; st.l = 0.f;
#pragma unroll
            for (int i = 0; i < 16; ++i) { st.o[0][i] = 0.f; st.o[1][i] = 0.f; }
            const bf16* kloc = proj + (size_t)tokb * NPROJ + COL_K + hd * 64;
            bf16x8 kf[2][4];
            attn_loadk(kf, kloc + (size_t)(r0 * 64) * NPROJ, (size_t)NPROJ, lane);
#pragma unroll 1
            for (int grp = 0; grp < 12; ++grp) {
                const bf16* knext = grp < 7 ? kloc + (size_t)((r0 + grp + 1) * 64) * NPROJ : (grp < 11 ? ck + (size_t)((grp - 7) * 64) * 1024 : nullptr);
                const size_t knstride = grp < 7 ? (size_t)NPROJ : (size_t)1024;
                if (grp < 8) { const int kr = r0 + grp;
                    attend64<true>(st, qf, kf, knext, knstride, lds + ((kr - rlo) * 64) * 128,
                        [&](int kt, int kin, float v) { const int kc = kt * 32 + kin; const bool ok = (kc >= c0) && (kc < c0 + 16);
                            const int dr = kr - qrow + 7, dc = kc - qc + 15; const int idx = ok ? dr * 31 + dc : 0; return ok ? v + rpbl[idx] : -1.0e30f; }, lane);
                } else attend64<false>(st, qf, kf, knext, knstride, lds + 90112 + (grp - 8) * 8192, [&](int, int, float v) { return v; }, lane);
            }
            attn_store(st, oall + (size_t)qtok * 3072 + hd * 64, lane);
        }
    }
    __syncthreads();
}

__device__ __forceinline__ float row_sum16(float v) { v += DPPF(v, 0xB1); v += DPPF(v, 0x4E); v += DPPF(v, 0x141); v += DPPF(v, 0x140); return v; }
__device__ __forceinline__ f32x4 unpack4(u32x2 w) { return (f32x4){bflo(w.x), bfhi(w.x), bflo(w.y), bfhi(w.y)}; }
__device__ __forceinline__ u32x2 pack4(f32x4 v) { return (u32x2){cvtpk(v[0], v[1]), cvtpk(v[2], v[3])}; }
__device__ __forceinline__ void rwkv_tinv_unit(const Frame& F, int unit) {
    unsigned char* ws = WSP(F);
    const bf16* til = (const bf16*)(ws + WS_TIL);
    bf16* tinv = (bf16*)(ws + WS_TINV);
    int lane = lane_id(); asm volatile("" : "+v"(lane));
    const int r = lane & 31, h = lane >> 5;
    LAS float* Lw = (LAS float*)(F.lds + F.wave * 16384);
    {
        const int run = unit >> 5, e = (unit >> 4) & 1, hd = unit & 15;
        const size_t tok = (size_t)(run * 32 + (e ? 31 - r : r));
        const bf16* rowp = til + (tok * 16 + hd) * TILP + e * 256 + 8 * h;
        f32x16 acc;
#pragma unroll
        for (int i = 0; i < 16; ++i) acc[i] = 0.f;
        bf16x8 bfr[4], afr[4];
#pragma unroll
        for (int ks = 0; ks < 4; ++ks) { afr[ks] = *(const bf16x8*)(rowp + 16 * ks); bfr[ks] = *(const bf16x8*)(rowp + 64 + 16 * ks); }
#pragma unroll
        for (int ks = 0; ks < 4; ++ks) acc = __builtin_amdgcn_mfma_f32_32x32x16_bf16(bfr[ks], afr[ks], acc, 0, 0, 0);
#pragma unroll
        for (int g = 0; g < 4; ++g) { const int j0 = 8 * g + 4 * h; f32x4 v;
#pragma unroll
            for (int q = 0; q < 4; ++q) v[q] = (j0 + q < r) ? acc[4 * g + q] : 0.f;
            *(LAS f32x4*)(Lw + r * 36 + j0) = v; }
        LDS_WAIT(); asm volatile("" ::: "memory");
        float X[32];
#pragma unroll
        for (int i = 0; i < 32; ++i) {
            float s = (i == r) ? 1.f : 0.f;
#pragma unroll
            for (int jq = 0; jq < (i + 3) / 4; ++jq) { const f32x4 lv = *(const LAS f32x4*)(Lw + i * 36 + 4 * jq);
#pragma unroll
                for (int q = 0; q < 4; ++q) if (4 * jq + q < i) s += lv[q] * X[4 * jq + q]; }
            X[i] = s;
        }
        if (h == 0) { bf16* o = tinv + (size_t)unit * 1024 + r;
#pragma unroll
            for (int i = 0; i < 32; ++i) o[i * 32] = f2bf(X[i]); }
        LDS_WAIT(); asm volatile("" ::: "memory");
    }
}

__device__ __forceinline__ f32x4 exp4(f32x4 x) { return (f32x4){__expf(x[0]), __expf(x[1]), __expf(x[2]), __expf(x[3])}; }
__device__ __forceinline__ f32x4 rcp4(f32x4 x) { return (f32x4){__builtin_amdgcn_rcpf(x[0]), __builtin_amdgcn_rcpf(x[1]), __builtin_amdgcn_rcpf(x[2]), __builtin_amdgcn_rcpf(x[3])}; }
__device__ __forceinline__ void rwkv_prep_phase(const Frame& F, const Args& a, int layer) {
    unsigned char* ws = WSP(F);
    const bf16* proj = (const bf16*)(ws + WS_PROJ);
    const bf16* abuf = (const bf16*)(ws + WS_A);
    const bf16* logw = (const bf16*)(ws + WS_DEC);
    bf16* til = (bf16*)(ws + WS_TIL);
    float* bonus = (float*)(ws + WS_BONUS);
    float* wtb = (float*)(ws + WS_WTB);
    const float* cw = INP(F, I_CW) + (size_t)layer * 3 * 3072; const float* cb = INP(F, I_CB) + (size_t)layer * 3072;
    for (int item = F.wave * F.G + F.bid; item < 2048; item += 8 * F.G) {
        int lane = lane_id(); asm volatile("" : "+v"(lane));
        const int run = item >> 2, tok0 = run * 32, cg = item & 3, c4 = cg * 256 + 4 * lane, head = cg * 4 + (lane >> 4), hl = 4 * (lane & 15);
        const int t0 = tok0 < NPR ? (tok0 & 255) : ((tok0 - NPR) & 2047), L = tok0 < NPR ? L_P : L_S;
        const f32x4 kkw = *(const f32x4*)(INP(F, I_KK) + layer * 1024 + c4), kaw = *(const f32x4*)(INP(F, I_KA) + layer * 1024 + c4), rkw = *(const f32x4*)(INP(F, I_RK) + layer * 1024 + c4);
        f32x4 tot1 = (f32x4){0.f, 0.f, 0.f, 0.f};
#pragma unroll 1
        for (int q = 0; q < 4; ++q) { f32x4 t[8];
#pragma unroll
          for (int i = 0; i < 8; ++i) t[i] = unpack4(*(const u32x2*)(logw + ((size_t)(tok0 + 8 * q + i) * 2 + 1) * 1024 + c4));
#pragma unroll
          for (int i = 0; i < 8; ++i) tot1 += t[i]; }
        f32x4 pre0 = (f32x4){0.f, 0.f, 0.f, 0.f}, pre1 = pre0, e0prev = (f32x4){1.f, 1.f, 1.f, 1.f};
        const bf16* pbase = proj + (size_t)tok0 * NPROJ + COL_R + c4;
#pragma unroll 1
        for (int ch = 0; ch < 8; ++ch) {
            const float* cwp = cw; const float* cbp = cb; asm volatile("" : "+s"(cwp), "+s"(cbp));
            f32x4 w[3][3], bs[3];
#pragma unroll
            for (int s = 0; s < 3; ++s) { bs[s] = *(const f32x4*)(cbp + s * 1024 + c4);
#pragma unroll
                for (int tp = 0; tp < 3; ++tp) w[s][tp] = *(const f32x4*)(cwp + tp * 3072 + s * 1024 + c4); }
            u32x2 rows[6][3], av[4][2]; f32x4 lw[4][2];
#pragma unroll
            for (int i = 0; i < 6; ++i) { const int tt = ch * 4 + i - 1, t = t0 + tt; const bool ok = (t >= 0) && (t < L);
#pragma unroll
                for (int s = 0; s < 3; ++s) rows[i][s] = ok ? *(const u32x2*)(pbase + (long)tt * NPROJ + s * 1024) : (u32x2){0u, 0u}; }
#pragma unroll
            for (int i = 0; i < 4; ++i) { const size_t tok = (size_t)(tok0 + ch * 4 + i); av[i][0] = *(const u32x2*)(abuf + (tok * 2 + 0) * 1024 + c4); av[i][1] = *(const u32x2*)(abuf + (tok * 2 + 1) * 1024 + c4);
                lw[i][0] = unpack4(*(const u32x2*)(logw + (tok * 2 + 0) * 1024 + c4)); lw[i][1] = unpack4(*(const u32x2*)(logw + (tok * 2 + 1) * 1024 + c4)); }
#pragma unroll
            for (int i = 0; i < 4; ++i) {
                const size_t tok = (size_t)(tok0 + ch * 4 + i);
                f32x4 x[3];
#pragma unroll
                for (int s = 0; s < 3; ++s) x[s] = unpack4(rows[i][s]) * w[s][0] + unpack4(rows[i + 1][s]) * w[s][1] + unpack4(rows[i + 2][s]) * w[s][2] + bs[s];
                const f32x4 rr = x[0], k0 = x[1], vv = x[2];
                f32x4 kk = k0 * kkw;
                const float ssq = row_sum16((kk[0] * kk[0] + kk[1] * kk[1]) + (kk[2] * kk[2] + kk[3] * kk[3]));
                kk = kk * (1.0f / sqrtf(ssq + 1e-12f));
                const f32x4 a0 = unpack4(av[i][0]), a1 = unpack4(av[i][1]);
                const f32x4 kd0 = k0 * (1.0f + (a0 - 1.0f) * kaw), kd1 = k0 * (1.0f + (a1 - 1.0f) * kaw);
                const f32x4 rk = rr * k0 * rkw;
                const float bsum = row_sum16((rk[0] + rk[1]) + (rk[2] + rk[3]));
                pre0 += lw[i][0];
                const f32x4 e0 = exp4(pre0), ie0 = rcp4(e0);
                const f32x4 l1 = tot1 - pre1; pre1 += lw[i][1];
                const f32x4 e1 = exp4(l1), ie1 = rcp4(e1), e1prev = exp4(l1 - lw[i][1]);
                bf16* o = til + (tok * 16 + head) * TILP + hl;
                *(u32x2*)(o) = pack4(-kk * e0prev); *(u32x2*)(o + 64) = pack4(kk * a0 * ie0); *(u32x2*)(o + 128) = pack4(kd0 * ie0); *(u32x2*)(o + 192) = pack4(rr * e0);
                *(u32x2*)(o + 256) = pack4(-kk * e1prev); *(u32x2*)(o + 320) = pack4(kk * a1 * ie1); *(u32x2*)(o + 384) = pack4(kd1 * ie1); *(u32x2*)(o + 448) = pack4(rr * e1);
                *(u32x2*)(o + 512) = pack4(vv);
                e0prev = e0;
                if ((lane & 15) == 0) bonus[tok * 16 + head] = bsum;
            }
        }
        *(f32x4*)(wtb + (((size_t)run * 2 + 0) * 16 + head) * 64 + hl) = exp4(pre0);
        *(f32x4*)(wtb + (((size_t)run * 2 + 1) * 16 + head) * 64 + hl) = exp4(tot1);
        asm volatile("s_waitcnt vmcnt(0)" ::: "memory");
#pragma unroll 1
        for (int uu = 0; uu < 8; ++uu) rwkv_tinv_unit(F, (run << 5) | ((uu & 1) << 4) | (cg * 4 + (uu >> 1)));
    }
}

__device__ __forceinline__ bf16x8 packf(const f32x16& x, int s) {
    u32x4 p; p.x = cvtpk(x[8 * s + 0], x[8 * s + 1]); p.y = cvtpk(x[8 * s + 2], x[8 * s + 3]); p.z = cvtpk(x[8 * s + 4], x[8 * s + 5]); p.w = cvtpk(x[8 * s + 6], x[8 * s + 7]);
    return __builtin_bit_cast(bf16x8, p);
}
#define MFMA32(a, b, c) __builtin_amdgcn_mfma_f32_32x32x16_bf16((a), (b), (c), 0, 0, 0)

#define TR8(F0, F1, F2, F3, A, O0, O1, O2, O3) do { s16x4 l0_, h0_, l1_, h1_, l2_, h2_, l3_, h3_; \
    asm volatile("ds_read_b64_tr_b16 %0, %8 offset:%9\n\tds_read_b64_tr_b16 %1, %8 offset:%9+1024\n\tds_read_b64_tr_b16 %2, %8 offset:%10\n\tds_read_b64_tr_b16 %3, %8 offset:%10+1024\n\t" \
                 "ds_read_b64_tr_b16 %4, %8 offset:%11\n\tds_read_b64_tr_b16 %5, %8 offset:%11+1024\n\tds_read_b64_tr_b16 %6, %8 offset:%12\n\tds_read_b64_tr_b16 %7, %8 offset:%12+1024\n\ts_waitcnt lgkmcnt(0)" \
                 : "=&v"(l0_), "=&v"(h0_), "=&v"(l1_), "=&v"(h1_), "=&v"(l2_), "=&v"(h2_), "=&v"(l3_), "=&v"(h3_) : "v"(A), "n"(O0), "n"(O1), "n"(O2), "n"(O3)); \
    F0 = __builtin_shufflevector(l0_, h0_, 0, 1, 2, 3, 4, 5, 6, 7); F1 = __builtin_shufflevector(l1_, h1_, 0, 1, 2, 3, 4, 5, 6, 7); \
    F2 = __builtin_shufflevector(l2_, h2_, 0, 1, 2, 3, 4, 5, 6, 7); F3 = __builtin_shufflevector(l3_, h3_, 0, 1, 2, 3, 4, 5, 6, 7); } while (0)
#define TR4(F0, F1, A, O0, O1) do { s16x4 l0_, h0_, l1_, h1_; \
    asm volatile("ds_read_b64_tr_b16 %0, %4 offset:%5\n\tds_read_b64_tr_b16 %1, %4 offset:%5+1024\n\tds_read_b64_tr_b16 %2, %4 offset:%6\n\tds_read_b64_tr_b16 %3, %4 offset:%6+1024\n\ts_waitcnt lgkmcnt(0)" \
                 : "=&v"(l0_), "=&v"(h0_), "=&v"(l1_), "=&v"(h1_) : "v"(A), "n"(O0), "n"(O1)); \
    F0 = __builtin_shufflevector(l0_, h0_, 0, 1, 2, 3, 4, 5, 6, 7); F1 = __builtin_shufflevector(l1_, h1_, 0, 1, 2, 3, 4, 5, 6, 7); } while (0)
template <int V> struct IC { static constexpr int value = V; };
__device__ __forceinline__ void hyena_post_phase(const Frame& F, const Args& a, int layer, LAS bf16* tl, int gw, int NGW);
constexpr int CS_BUF = 23552, CS_AT = 0, CS_BT = 4096, CS_KT = 8192, CS_RT = 12288, CS_VV = 16384, CS_TI = 20480, CS_WT = 22528;
__device__ __forceinline__ void rwkv_cscan_phase(const Frame& F, const Args& a, int layer) {
    if (F.wave >= 2) {
        if (F.wave < 6) { LAS bf16* sl = (LAS bf16*)(F.lds + 4 * CS_BUF + (F.wave - 2) * 8704);
            hyena_post_phase(F, a, layer, sl, F.bid * 4 + (F.wave - 2), F.G * 4); }
        if (layer + 1 < DEPTH) convert_layer(F, layer + 1, nullptr, F.bid * 6 + (F.wave - 2), F.G * 6);
        return; }
    unsigned char* ws = WSP(F);
    const bf16* til = (const bf16*)(ws + WS_TIL);
    const bf16* tinv = (const bf16*)(ws + WS_TINV);
    const float* wtb = (const float*)(ws + WS_WTB);
    float* Y = (float*)(ws + WS_H);
    const int lane = F.lane, r = lane & 31, h = lane >> 5;
    const int i16 = lane & 15, tq = i16 >> 2, tp = i16 & 3, blk = (lane >> 4) & 1;
    LAS unsigned char* lbase = F.lds + F.wave * (2 * CS_BUF);
    const int slot = F.wave * F.G + F.bid, nslot = 2 * F.G;
    const int nsamp = 256;
    for (int item = slot; item < 2304; item += (slot < nsamp) ? 2304 : (nslot - nsamp)) {
        const bool sample = item < 256; const int hc = sample ? item : item - 256, chain = hc >> 1, vt = hc & 1;
        const int hd = chain & 15, e = (chain >> 4) & 1, b = chain >> 5;
        const int NC = sample ? (L_S / 32) : (L_P / 32), tokb = sample ? NPR + b * L_S : b * L_P;
        f32x16 ST[2];
        if (sample) { const float* s0 = INP(F, I_ST) + ((((size_t)b * 4 + layer) * 2 + e) * 16 + hd) * 4096;
#pragma unroll
            for (int kt = 0; kt < 2; ++kt)
#pragma unroll
                for (int g = 0; g < 4; ++g) { const f32x4 v = *(const f32x4*)(s0 + (32 * vt + r) * 64 + 32 * kt + 8 * g + 4 * h);
                    ST[kt][4 * g] = v[0]; ST[kt][4 * g + 1] = v[1]; ST[kt][4 * g + 2] = v[2]; ST[kt][4 * g + 3] = v[3]; }
        } else {
#pragma unroll
            for (int kt = 0; kt < 2; ++kt)
#pragma unroll
                for (int i = 0; i < 16; ++i) ST[kt][i] = 0.f;
        }
#define CS_DMA(C, BUFP) do { const int run_ = (tokb >> 5) + (e ? NC - 1 - (C) : (C)); int ln_ = lane_id(); asm volatile("" : "+v"(ln_));     \
            _Pragma("unroll") for (int i_ = 0; i_ < 4; ++i_) { const int q_ = ln_ + 64 * i_, p_ = q_ >> 3, cc_ = q_ & 7; \
                const bf16* g_ = til + ((size_t)(run_ * 32 + (e ? 31 - p_ : p_)) * 16 + hd) * TILP + e * 256 + 8 * cc_; \
                __builtin_amdgcn_global_load_lds((const unsigned*)(g_), (LAS unsigned*)((BUFP) + CS_AT + i_ * 1024), 16, 0, 0); \
                __builtin_amdgcn_global_load_lds((const unsigned*)(g_ + 64), (LAS unsigned*)((BUFP) + CS_BT + i_ * 1024), 16, 0, 0); \
                __builtin_amdgcn_global_load_lds((const unsigned*)(g_ + 128), (LAS unsigned*)((BUFP) + CS_KT + i_ * 1024), 16, 0, 0); \
                __builtin_amdgcn_global_load_lds((const unsigned*)(g_ + 192), (LAS unsigned*)((BUFP) + CS_RT + i_ * 1024), 16, 0, 0); \
                __builtin_amdgcn_global_load_lds((const unsigned*)(g_ - e * 256 + 512), (LAS unsigned*)((BUFP) + CS_VV + i_ * 1024), 16, 0, 0); } \
            const size_t unit_ = ((size_t)run_ * 2 + e) * 16 + hd; \
            _Pragma("unroll") for (int i_ = 0; i_ < 2; ++i_) __builtin_amdgcn_global_load_lds((const unsigned*)(tinv + unit_ * 1024 + (ln_ + 64 * i_) * 8), (LAS unsigned*)((BUFP) + CS_TI + i_ * 1024), 16, 0, 0); \
            __builtin_amdgcn_global_load_lds((const unsigned*)(wtb + unit_ * 64 + (ln_ & 15) * 4), (LAS unsigned*)((BUFP) + CS_WT), 16, 0, 0); } while (0)
        CS_DMA(0, lbase);
        auto chunk = [&](auto bi_, int c) __attribute__((always_inline)) {
            constexpr int BI = decltype(bi_)::value;
            const LAS unsigned char* B = lbase + BI * CS_BUF;
            if (c == 0) asm volatile("s_waitcnt vmcnt(0)" ::: "memory");
            else asm volatile("s_waitcnt vmcnt(16)" ::: "memory");
            if (c + 1 < NC) CS_DMA(c + 1, lbase + (1 - BI) * CS_BUF);
            bf16x8 nkaF[2], nbrF[2], nkrF[2];
#define CS_NMAT(OUTF, OFFA, OFFB, STRICT) do { f32x16 n_; _Pragma("unroll") for (int i = 0; i < 16; ++i) n_[i] = 0.f; \
                    _Pragma("unroll") for (int ks = 0; ks < 4; ++ks) { const int o = r * 128 + (16 * ks + 8 * h) * 2; \
                        n_ = MFMA32(*(const LAS bf16x8*)(B + (OFFA) + o), *(const LAS bf16x8*)(B + (OFFB) + o), n_); } \
                    _Pragma("unroll") for (int i = 0; i < 16; ++i) { const int row = (i & 3) + 8 * (i >> 2) + 4 * h; n_[i] = ((STRICT) ? (row < r) : (row <= r)) ? n_[i] : 0.f; } \
                    OUTF[0] = packf(n_, 0); OUTF[1] = packf(n_, 1); } while (0)
            CS_NMAT(nkaF, CS_KT, CS_AT, true);
            CS_NMAT(nbrF, CS_BT, CS_RT, false);
            CS_NMAT(nkrF, CS_KT, CS_RT, false);
#undef CS_NMAT
            const unsigned tra = (unsigned)(size_t)(B) + (4 * h + tq) * 128 + (16 * blk + 4 * tp) * 2 + vt * 64;
            const unsigned trk = (unsigned)(size_t)(B) + (4 * h + tq) * 128 + (16 * blk + 4 * tp) * 2;
            bf16x8 vvF[2], btF[2][2], ktF[2][2];
            {   s16x4 t_[20];
                asm volatile("ds_read_b64_tr_b16 %0, %20 offset:%22\n\tds_read_b64_tr_b16 %1, %20 offset:%22+1024\n\tds_read_b64_tr_b16 %2, %20 offset:%22+2048\n\tds_read_b64_tr_b16 %3, %20 offset:%22+3072\n\t"
                             "ds_read_b64_tr_b16 %4, %21 offset:%23\n\tds_read_b64_tr_b16 %5, %21 offset:%23+1024\n\tds_read_b64_tr_b16 %6, %21 offset:%23+2048\n\tds_read_b64_tr_b16 %7, %21 offset:%23+3072\n\t"
                             "ds_read_b64_tr_b16 %8, %21 offset:%23+64\n\tds_read_b64_tr_b16 %9, %21 offset:%23+64+1024\n\tds_read_b64_tr_b16 %10, %21 offset:%23+64+2048\n\tds_read_b64_tr_b16 %11, %21 offset:%23+64+3072\n\t"
                             "ds_read_b64_tr_b16 %12, %21 offset:%24\n\tds_read_b64_tr_b16 %13, %21 offset:%24+1024\n\tds_read_b64_tr_b16 %14, %21 offset:%24+2048\n\tds_read_b64_tr_b16 %15, %21 offset:%24+3072\n\t"
                             "ds_read_b64_tr_b16 %16, %21 offset:%24+64\n\tds_read_b64_tr_b16 %17, %21 offset:%24+64+1024\n\tds_read_b64_tr_b16 %18, %21 offset:%24+64+2048\n\tds_read_b64_tr_b16 %19, %21 offset:%24+64+3072\n\ts_waitcnt lgkmcnt(0)"
                             : "=&v"(t_[0]), "=&v"(t_[1]), "=&v"(t_[2]), "=&v"(t_[3]), "=&v"(t_[4]), "=&v"(t_[5]), "=&v"(t_[6]), "=&v"(t_[7]), "=&v"(t_[8]), "=&v"(t_[9]),
                               "=&v"(t_[10]), "=&v"(t_[11]), "=&v"(t_[12]), "=&v"(t_[13]), "=&v"(t_[14]), "=&v"(t_[15]), "=&v"(t_[16]), "=&v"(t_[17]), "=&v"(t_[18]), "=&v"(t_[19])
                             : "v"(tra), "v"(trk), "n"(CS_VV), "n"(CS_BT), "n"(CS_KT));
#define CS_FR(I) (bf16x8)__builtin_shufflevector(t_[I], t_[I + 1], 0, 1, 2, 3, 4, 5, 6, 7)
                vvF[0] = CS_FR(0); vvF[1] = CS_FR(2); btF[0][0] = CS_FR(4); btF[0][1] = CS_FR(6); btF[1][0] = CS_FR(8); btF[1][1] = CS_FR(10);
                ktF[0][0] = CS_FR(12); ktF[0][1] = CS_FR(14); ktF[1][0] = CS_FR(16); ktF[1][1] = CS_FR(18);
#undef CS_FR
            }
#define CS_APERM(OFF, KT, S) ({ const LAS unsigned char* p_ = B + (OFF) + r * 128 + (32 * (KT) + 16 * (S) + 4 * h) * 2; \
                const u32x2 lo_ = *(const LAS u32x2*)p_, hi_ = *(const LAS u32x2*)(p_ + 16); __builtin_bit_cast(bf16x8, (u32x4){lo_.x, lo_.y, hi_.x, hi_.y}); })
            bf16x8 uF[2];
            f32x16 rhsB, yC, stK[2];
#pragma unroll
            for (int i = 0; i < 16; ++i) { rhsB[i] = 0.f; yC[i] = 0.f; stK[0][i] = 0.f; stK[1][i] = 0.f; }
#pragma unroll
            for (int s = 0; s < 2; ++s) { rhsB = MFMA32(nkaF[s], vvF[s], rhsB); yC = MFMA32(nkrF[s], vvF[s], yC); stK[0] = MFMA32(ktF[0][s], vvF[s], stK[0]); stK[1] = MFMA32(ktF[1][s], vvF[s], stK[1]); }
            {   f32x16 rhs = rhsB;
#pragma unroll
                for (int kt = 0; kt < 2; ++kt)
#pragma unroll
                    for (int s = 0; s < 2; ++s) rhs = MFMA32(CS_APERM(CS_AT, kt, s), packf(ST[kt], s), rhs);
                f32x16 u;
#pragma unroll
                for (int i = 0; i < 16; ++i) u[i] = 0.f;
#pragma unroll
                for (int s = 0; s < 2; ++s) { const LAS unsigned char* p_ = B + CS_TI + r * 64 + (16 * s + 4 * h) * 2;
                    const u32x2 lo_ = *(const LAS u32x2*)p_, hi_ = *(const LAS u32x2*)(p_ + 16);
                    u = MFMA32(__builtin_bit_cast(bf16x8, (u32x4){lo_.x, lo_.y, hi_.x, hi_.y}), packf(rhs, s), u); }
                uF[0] = packf(u, 0); uF[1] = packf(u, 1);
            }
            {   const int run = (tokb >> 5) + (e ? NC - 1 - c : c);
                f32x16 y = yC;
#pragma unroll
                for (int kt = 0; kt < 2; ++kt)
#pragma unroll
                    for (int s = 0; s < 2; ++s) y = MFMA32(CS_APERM(CS_RT, kt, s), packf(ST[kt], s), y);
#pragma unroll
                for (int s = 0; s < 2; ++s) y = MFMA32(nbrF[s], uF[s], y);
#pragma unroll
                for (int i = 0; i < 16; ++i) { const int p = (i & 3) + 8 * (i >> 2) + 4 * h; const size_t tok = (size_t)(run * 32 + (e ? 31 - p : p));
                    Y[((size_t)e * M + tok) * 1024 + hd * 64 + 32 * vt + r] = y[i]; }
            }
#pragma unroll
            for (int kt = 0; kt < 2; ++kt) {
                f32x4 wt[4];
#pragma unroll
                for (int g = 0; g < 4; ++g) wt[g] = *(const LAS f32x4*)(B + CS_WT + (32 * kt + 8 * g + 4 * h) * 4);
#pragma unroll
                for (int s = 0; s < 2; ++s) ST[kt] = MFMA32(btF[kt][s], uF[s], ST[kt]);
#pragma unroll
                for (int i = 0; i < 16; ++i) ST[kt][i] = (ST[kt][i] + stK[kt][i]) * wt[i >> 2][i & 3];
            }
        };
#pragma unroll 1
        for (int c2 = 0; c2 < NC; c2 += 2) { chunk(IC<0>{}, c2); chunk(IC<1>{}, c2 + 1); }
#undef CS_APERM
#undef CS_DMA
        if (!sample) { float* so = OUTP(F) + OUT_ST + ((((size_t)b * 4 + layer) * 2 + e) * 16 + hd) * 4096;
#pragma unroll
            for (int kt = 0; kt < 2; ++kt)
#pragma unroll
                for (int g = 0; g < 4; ++g) *(f32x4*)(so + (32 * vt + r) * 64 + 32 * kt + 8 * g + 4 * h) = (f32x4){ST[kt][4 * g], ST[kt][4 * g + 1], ST[kt][4 * g + 2], ST[kt][4 * g + 3]};
        }
    }
    asm volatile("s_waitcnt vmcnt(0)" ::: "memory");
}

__device__ __forceinline__ void rwkv_post_phase(const Frame& F, const Args& a, int layer) {
    unsigned char* ws = WSP(F);
    const float* Y = (const float*)(ws + WS_H);
    const bf16* til = (const bf16*)(ws + WS_TIL); const bf16* gbuf = (const bf16*)(ws + WS_G); const float* bonus = (const float*)(ws + WS_BONUS);
    bf16* oall = (bf16*)(ws + WS_OALL);
    const int lane = F.lane;
    for (int item = F.wave * F.G + F.bid; item < 2048; item += 8 * F.G) {
        const int tok0 = (item >> 2) * 32, cg = item & 3, c4 = cg * 256 + 4 * lane, head = cg * 4 + (lane >> 4), hl = 4 * (lane & 15);
        const f32x4 gng = *(const f32x4*)(INP(F, I_GNG) + layer * 1024 + c4), gnb = *(const f32x4*)(INP(F, I_GNB) + layer * 1024 + c4);
#pragma unroll 1
        for (int ch = 0; ch < 4; ++ch) {
            f32x4 y0[8], y1[8]; u32x2 vw[8], gw[8]; float bn[8];
#pragma unroll
            for (int i = 0; i < 8; ++i) { const size_t tok = (size_t)(tok0 + ch * 8 + i);
                y0[i] = *(const f32x4*)(Y + tok * 1024 + c4); y1[i] = *(const f32x4*)(Y + ((size_t)M + tok) * 1024 + c4);
                vw[i] = *(const u32x2*)(til + (tok * 16 + head) * TILP + 512 + hl); gw[i] = *(const u32x2*)(gbuf + tok * 1024 + c4); bn[i] = bonus[tok * 16 + head]; }
#pragma unroll
            for (int i = 0; i < 8; ++i) { const size_t tok = (size_t)(tok0 + ch * 8 + i);
                const f32x4 y = y0[i] + y1[i];
                const float mu = row_sum16((y[0] + y[1]) + (y[2] + y[3])) * (1.0f / 64.0f);
                const f32x4 dd = y - mu;
                const float var = row_sum16((dd[0] * dd[0] + dd[1] * dd[1]) + (dd[2] * dd[2] + dd[3] * dd[3])) * (1.0f / 64.0f);
                const f32x4 yn = dd * (1.0f / sqrtf(var + 64e-5f)) * gng + gnb;
                const f32x4 o = (yn + bn[i] * unpack4(vw[i])) * unpack4(gw[i]);
                *(u32x2*)(oall + tok * 3072 + 1024 + c4) = pack4(o);
            }
        }
    }
}

__device__ __forceinline__ void hyena_prep_phase(const Frame& F, const Args& a, int layer) {
    unsigned char* ws = WSP(F);
    const bf16* proj = (const bf16*)(ws + WS_PROJ);
    bf16* zT = (bf16*)(ws + WS_ZT);
    const float* cw = INP(F, I_HCW) + (size_t)layer * 3 * 3072; const float* cb = INP(F, I_HCB) + (size_t)layer * 3072;
    const int gw = F.bid * 8 + F.wave, NGW = F.G * 8, lane = F.lane, tsub = lane >> 4, cq = lane & 15;
    LAS bf16* tl = (LAS bf16*)(F.lds + F.wave * 16384);
    for (int it = gw; it < 256 * 16; it += NGW) {
        const int tt0 = (it >> 4) * 64, c0 = (it & 15) * 64, c4 = c0 + 4 * cq;
        const int t0 = tt0 < NPR ? (tt0 & 255) : ((tt0 - NPR) & 2047), L = tt0 < NPR ? L_P : L_S;
        f32x4 w1[3], w2[3];
#pragma unroll
        for (int tp = 0; tp < 3; ++tp) { w1[tp] = *(const f32x4*)(cw + tp * 3072 + 1024 + c4); w2[tp] = *(const f32x4*)(cw + tp * 3072 + 2048 + c4); }
        const f32x4 b1 = *(const f32x4*)(cb + 1024 + c4), b2 = *(const f32x4*)(cb + 2048 + c4);
        const bf16* px = proj + (size_t)tt0 * NPROJ + COL_X1 + c4;
#pragma unroll 1
        for (int hf = 0; hf < 2; ++hf) {
            u32x2 xr[8][3], vr[8][3];
#pragma unroll
            for (int i = 0; i < 8; ++i) { const int tt = 4 * (hf * 8 + i) + tsub;
#pragma unroll
                for (int d = 0; d < 3; ++d) { const int t = t0 + tt + d - 1; const bool ok = (t >= 0) && (t < L); const bf16* p = px + (long)(tt + d - 1) * NPROJ;
                    xr[i][d] = ok ? *(const u32x2*)p : (u32x2){0u, 0u}; vr[i][d] = ok ? *(const u32x2*)(p + 1024) : (u32x2){0u, 0u}; } }
#pragma unroll
            for (int i = 0; i < 8; ++i) { const int tt = 4 * (hf * 8 + i) + tsub;
                const f32x4 x1c = unpack4(xr[i][0]) * w1[0] + unpack4(xr[i][1]) * w1[1] + unpack4(xr[i][2]) * w1[2] + b1;
                const f32x4 vvc = unpack4(vr[i][0]) * w2[0] + unpack4(vr[i][1]) * w2[1] + unpack4(vr[i][2]) * w2[2] + b2;
                *(LAS u32x2*)(tl + tt * 68 + 4 * cq) = pack4(x1c * vvc); }
        }
        LDS_WAIT(); asm volatile("" ::: "memory");
#pragma unroll
        for (int j = 0; j < 8; ++j) { const int id = lane + 64 * j, ch = id >> 3, tg = id & 7; const LAS bf16* s = tl + (8 * tg) * 68 + ch;
            u32x4 o; o.x = (unsigned)s[0] | ((unsigned)s[68] << 16); o.y = (unsigned)s[2 * 68] | ((unsigned)s[3 * 68] << 16); o.z = (unsigned)s[4 * 68] | ((unsigned)s[5 * 68] << 16); o.w = (unsigned)s[6 * 68] | ((unsigned)s[7 * 68] << 16);
            *(u32x4*)(zT + (size_t)(c0 + ch) * M + tt0 + 8 * tg) = o; }
        LDS_WAIT(); asm volatile("" ::: "memory");
    }
}

__device__ __forceinline__ void hyena_conv_phase(const Frame& F, const Args& a, int layer) {
    unsigned char* ws = WSP(F);
    bf16* zT = (bf16*)(ws + WS_ZT);
    const float* FNORM = (const float*)(ws + WS_CTL) + CW_FNORM;
    const int lane = F.lane, w = F.wave, r = lane & 31, h = lane >> 5;
    LAS unsigned char* lds = F.lds;
    for (int u = F.bid; u < 2048; u += F.G) {
        const bool sample = u < 1024; const int c = u & 1023;
        const int L = sample ? L_S : L_P, LP = sample ? LPS : LPP, FCS = LP * 2;
        const int ZROW = (L + 448) * 2, ZOFF = 2 * FCS;
        const int NB = sample ? 4 : 32, tokb = sample ? NPR : 0;
        const bf16* fsrc = sample ? (const bf16*)(ws + WS_FS) + ((size_t)layer * 1024 + c) * LPS : (const bf16*)(ws + WS_FP) + ((size_t)layer * 1024 + c) * LPP;
        __syncthreads();
        for (int i = F.tid; i < LP / 8; i += 512) *(LAS u32x4*)(lds + i * 16) = *(const u32x4*)(fsrc + i * 8);
        for (int i = F.tid; i < LP; i += 512) *(LAS bf16*)(lds + FCS + i * 2) = (i + 1 < LP) ? fsrc[i + 1] : (bf16)0;
        { const int cpr = L / 8;
          for (int i = F.tid; i < NB * cpr; i += 512) { const int b = i / cpr, q = i - b * cpr;
              *(LAS u32x4*)(lds + ZOFF + b * ZROW + 448 + q * 16) = *(const u32x4*)(zT + (size_t)c * M + tokb + b * L + q * 8); }
          if (sample) for (int i = F.tid; i < NB * 56; i += 512) { const int b = i / 56, q = i - b * 56;
              *(LAS u32x4*)(lds + ZOFF + b * ZROW + (q < 28 ? q * 16 : 448 + L * 2 + (q - 28) * 16)) = (u32x4){0u, 0u, 0u, 0u}; } }
        __syncthreads();
        const int nbl = sample ? 2 : 5;
        const int I0 = sample ? 8 * w : w;
        const int b = r & (NB - 1), I = I0 + (r >> nbl);
        int dlo = (sample ? I0 - 63 : I0 - 7), dhi = (sample ? I0 + 7 : I0);
        const int dmax = L / 64;
        dlo = dlo < -dmax ? -dmax : dlo; dhi = dhi > dmax ? dmax : dhi;
        f32x16 acc;
#pragma unroll
        for (int i = 0; i < 16; ++i) acc[i] = 0.f;
        const LAS unsigned char* zb = lds + ZOFF + b * ZROW + (224 + 8 * h) * 2;
#pragma unroll 2
        for (int d = dlo; d <= dhi; ++d) {
#pragma unroll
            for (int ks = 0; ks < 2; ++ks) {
                const int st = (L / 2 - 1) - 32 * d - r + 16 * ks + 8 * h + 32;
                const int par = st & 1;
                const LAS unsigned* ap = (const LAS unsigned*)(lds + par * FCS + (st - par) * 2);
                const u32x4 aw = (u32x4){ap[0], ap[1], ap[2], ap[3]};
                const bf16x8 af = __builtin_bit_cast(bf16x8, aw);
                const bf16x8 bfr = *(const LAS bf16x8*)(zb + (32 * (I - d) + 16 * ks) * 2);
                acc = __builtin_amdgcn_mfma_f32_32x32x16_bf16(af, bfr, acc, 0, 0, 0);
            }
        }
        const float inv = 1.0f / (FNORM[((size_t)layer * 2 + (sample ? 0 : 1)) * 1024 + c] + 1e-6f);
        const float dco = INP(F, I_HD)[layer * 1024 + c];
        __syncthreads();
#pragma unroll
        for (int g = 0; g < 4; ++g) {
            const int t = 32 * I + 8 * g + 4 * h;
            const LAS bf16* zp = (const LAS bf16*)(lds + ZOFF + b * ZROW + (224 + t) * 2);
            float o[4];
#pragma unroll
            for (int j = 0; j < 4; ++j) o[j] = acc[4 * g + j] * inv + bf2f(zp[j]) * dco;
            *(u32x2*)(zT + (size_t)c * M + tokb + b * L + t) = (u32x2){cvtpk(o[0], o[1]), cvtpk(o[2], o[3])};
        }
    }
    __syncthreads();
}

__device__ __forceinline__ void hyena_post_phase(const Frame& F, const Args& a, int layer, LAS bf16* tl, int gw, int NGW) {
    unsigned char* ws = WSP(F);
    const bf16* proj = (const bf16*)(ws + WS_PROJ);
    const bf16* yT = (const bf16*)(ws + WS_ZT);
    bf16* oall = (bf16*)(ws + WS_OALL);
    const float* cw = INP(F, I_HCW) + (size_t)layer * 3 * 3072; const float* cb = INP(F, I_HCB) + (size_t)layer * 3072;
    const int lane = F.lane, tsub = lane >> 4, cq = lane & 15;
    for (int it = gw; it < 256 * 16; it += NGW) {
        const int tt0 = (it >> 4) * 64, c0 = (it & 15) * 64, c4 = c0 + 4 * cq;
        const int t0 = tt0 < NPR ? (tt0 & 255) : ((tt0 - NPR) & 2047), L = tt0 < NPR ? L_P : L_S;
        {   u32x4 tmp[8];
#pragma unroll
            for (int j = 0; j < 8; ++j) { const int id = lane + 64 * j, ch = id >> 3, tg = id & 7; tmp[j] = *(const u32x4*)(yT + (size_t)(c0 + ch) * M + tt0 + 8 * tg); }
#pragma unroll
            for (int j = 0; j < 8; ++j) { const int id = lane + 64 * j, ch = id >> 3, tg = id & 7; LAS unsigned* d = (LAS unsigned*)(tl + ch * 68 + 8 * tg);
                d[0] = tmp[j].x; d[1] = tmp[j].y; d[2] = tmp[j].z; d[3] = tmp[j].w; } }
        LDS_WAIT(); asm volatile("" ::: "memory");
        f32x4 w0[3];
#pragma unroll
        for (int tp = 0; tp < 3; ++tp) w0[tp] = *(const f32x4*)(cw + tp * 3072 + c4);
        const f32x4 b0 = *(const f32x4*)(cb + c4);
        const bf16* px = proj + (size_t)tt0 * NPROJ + COL_X0 + c4;
#pragma unroll 1
        for (int hf = 0; hf < 2; ++hf) {
            u32x2 xr[8][3];
#pragma unroll
            for (int i = 0; i < 8; ++i) { const int tt = 4 * (hf * 8 + i) + tsub;
#pragma unroll
                for (int d = 0; d < 3; ++d) { const int t = t0 + tt + d - 1; const bool ok = (t >= 0) && (t < L); xr[i][d] = ok ? *(const u32x2*)(px + (long)(tt + d - 1) * NPROJ) : (u32x2){0u, 0u}; } }
#pragma unroll
            for (int i = 0; i < 8; ++i) { const int tt = 4 * (hf * 8 + i) + tsub;
                const f32x4 x0c = unpack4(xr[i][0]) * w0[0] + unpack4(xr[i][1]) * w0[1] + unpack4(xr[i][2]) * w0[2] + b0;
                const f32x4 yv = (f32x4){bf2f(tl[(4 * cq + 0) * 68 + tt]), bf2f(tl[(4 * cq + 1) * 68 + tt]), bf2f(tl[(4 * cq + 2) * 68 + tt]), bf2f(tl[(4 * cq + 3) * 68 + tt])};
                *(u32x2*)(oall + (size_t)(tt0 + tt) * 3072 + 2048 + c4) = pack4(x0c * yv); }
        }
        LDS_WAIT(); asm volatile("" ::: "memory");
    }
}

constexpr int NPL = 11, PH_LAYER0 = 2, PH_FINAL = PH_LAYER0 + DEPTH * NPL, N_PHASES = PH_FINAL + 1;

__global__ void __launch_bounds__(512, 2) mega(Args args) {
    extern __shared__ __attribute__((aligned(16))) unsigned char lds_raw[];
    Frame F;
    F.lds = (LAS unsigned char*)lds_raw;
    F.tid = threadIdx.x; F.lane = F.tid & 63; F.wave = __builtin_amdgcn_readfirstlane(F.tid >> 6);
    F.G = gridDim.x; F.bid = blockIdx.x;
    for (int u = F.tid; u < (LDS_BYTES - LDSCTL_OFF) / 4; u += 512) ((LAS unsigned*)(F.lds + LDSCTL_OFF))[u] = 0u;
    __syncthreads();
    if (F.tid < 48) { const unsigned long long p = F.tid < 46 ? (unsigned long long)args.in[F.tid] : (F.tid == 46 ? (unsigned long long)args.out : (unsigned long long)args.ws);
        ((LAS unsigned*)(F.lds + LDS_ARGT))[2 * F.tid] = (unsigned)p; ((LAS unsigned*)(F.lds + LDS_ARGT))[2 * F.tid + 1] = (unsigned)(p >> 32); }
    __syncthreads();
    unsigned char* ws = WSP(F);
    unsigned* ctl = (unsigned*)(ws + WS_CTL);
    int lo = args.ph_lo, hi = args.ph_hi;
    const bool single = (hi - lo) > 1;
    XcdBarrier bar; bar.bar = ctl + CW_BAR; bar.x = 0; bar.st = (volatile LAS unsigned*)(F.lds + LDSCTL_OFF + 64); bar.wave = F.wave;
    if (single) bar = xcd_barrier_post(ctl + CW_BAR, (volatile LAS unsigned*)(F.lds + LDSCTL_OFF + 64), F.wave);
#ifndef MK_EN
#define MK_EN 0xFFFFFF
#endif
#define IN(k) (lo <= (k) && (k) < hi)
#define EN(b) ((MK_EN >> (b)) & 1)
#ifndef MK_DUP
#define MK_DUP -1
#endif
#define REPS(k) ((MK_DUP == (k)) ? 2 : 1)
#define FRESH() do { F.lane = lane_id(); asm volatile("" : "+v"(F.lane), "+s"(F.bid), "+s"(F.wave), "+s"(F.G)); F.tid = F.wave * 64 + F.lane; } while (0)
#define SEAM(k) do { if (IN(k) && IN((k) + 1)) xcd_barrier(bar); } while (0)

    if (EN(20) && IN(0)) { FRESH(); prologue0(F, args); SEAM(0); }
    if (EN(21) && IN(1)) { FRESH(); prologue1(F, args); SEAM(1); }

    bf16* Hb = (bf16*)(ws + WS_H); bf16* proj = (bf16*)(ws + WS_PROJ); bf16* oall = (bf16*)(ws + WS_OALL);
    float* x = OUTP(F);
#pragma unroll 1
    for (int l = 0; l < DEPTH; ++l) {
        const int pb = PH_LAYER0 + l * NPL;
        asm volatile("" : "+s"(lo), "+s"(hi));
        const float* mod = (const float*)(ws + WS_MOD) + (size_t)l * 5 * 12288;
        if (EN(0) && IN(pb + 0)) { FRESH();
            norm_phase(F, l == 0 ? INP(F, I_XP) : x, l == 0 ? INP(F, I_XS) : x + (size_t)NPR * D, l == 0 ? x : nullptr, INP(F, I_LN1) + l * D, mod, 0, 1, Hb);
            SEAM(pb + 0);
        }
        if (EN(1) && IN(pb + 1)) { FRESH();
            pg8::Gemm g{Hb, (const bf16*)(ws + WS_WIN) + (size_t)l * NPROJ * D, D, D, D, 0, 0, 0};
            pg8::Order S; S.init(M, NPROJ, F.G, F.bid, 1);
            pg8::EpiProj E{proj, x + OUT_CK, x + OUT_CV, l};
            pg8::gemm_phase(F.lds, g, S, E, F.wave);
            SEAM(pb + 1);
        }
        if (EN(2) && IN(pb + 2)) { FRESH();
            {   pg8::Gemm g{proj + COL_LW, (const bf16*)(ws + WS_W2T) + (size_t)l * 5120 * 128, NPROJ, 128, 128, 0, 128, 4};
                pg8::Order5 S; S.init(M, F.G, F.bid);
                pg8::EpiLora2 E{(bf16*)(ws + WS_DEC), (bf16*)(ws + WS_A), (bf16*)(ws + WS_G), INP(F, I_W0) + l * 2048, INP(F, I_A0) + l * 2048};
                pg8::gemm_phase(F.lds, g, S, E, F.wave); }
            FRESH(); attention_phase(F, args, l);
            FRESH(); hyena_prep_phase(F, args, l);
            SEAM(pb + 2);
        }
        if (EN(3) && IN(pb + 3)) { FRESH(); rwkv_prep_phase(F, args, l); FRESH(); hyena_conv_phase(F, args, l); SEAM(pb + 3); }
        if (EN(4) && IN(pb + 4)) { FRESH(); rwkv_cscan_phase(F, args, l); SEAM(pb + 4); }
        if (EN(5) && IN(pb + 5)) { FRESH(); rwkv_post_phase(F, args, l); SEAM(pb + 5); }
        if (EN(6) && IN(pb + 6)) { FRESH();
            pg8::Gemm g{oall, (const bf16*)(ws + WS_WP) + (size_t)l * 3 * D * 1024, 3072, 1024, 1024, 1024, 0, 8};
            pg8::Order S; S.init(M, D, F.G, F.bid, 3);
            pg8::EpiMerge E{proj, Hb};
            pg8::gemm_phase(F.lds, g, S, E, F.wave);
            SEAM(pb + 6);
        }
        if (EN(7) && IN(pb + 7)) { FRESH();
            pg8::Gemm g{Hb, (const bf16*)(ws + WS_WOUT) + (size_t)l * D * D, D, D, D, 0, 0, 0};
            pg8::Order S; S.init(M, D, F.G, F.bid, 1);
            pg8::EpiResid E{x, mod + 2 * D, nullptr, 1.0f};
            pg8::gemm_phase(F.lds, g, S, E, F.wave);
            SEAM(pb + 7);
        }
        if (EN(8) && IN(pb + 8)) { FRESH(); norm_phase(F, x, x + (size_t)NPR * D, nullptr, INP(F, I_LN2) + l * D, mod, 3, 4, Hb); SEAM(pb + 8); }
        if (EN(9) && IN(pb + 9)) { FRESH();
            pg8::Gemm g{Hb, (const bf16*)(ws + WS_WFF1) + (size_t)l * D * DFF, D, D, D, 0, 0, 0};
            pg8::Order S; S.init(M, DFF, F.G, F.bid, 1);
            pg8::EpiFF1 E{proj, INP(F, I_BFF1) + l * DFF};
            pg8::gemm_phase(F.lds, g, S, E, F.wave);
            SEAM(pb + 9);
        }
        if (EN(10) && IN(pb + 10)) { FRESH();
            pg8::Gemm g{proj, (const bf16*)(ws + WS_WFF2) + (size_t)l * D * DFF, DFF, DFF, DFF, 0, 0, 0};
            pg8::Order S; S.init(M, D, F.G, F.bid, 1);
            pg8::EpiResid E{x, mod + 5 * D, INP(F, I_BFF2) + l * D, 1.0f};
            pg8::gemm_phase(F.lds, g, S, E, F.wave);
            SEAM(pb + 10);
        }
    }
    asm volatile("" : "+s"(lo), "+s"(hi));
    if (EN(22) && IN(PH_FINAL)) { FRESH(); final_norm_phase(F, OUTP(F), INP(F, I_FING)); }
#undef IN
#undef SEAM
}

extern "C" void kernel_launch(void* const* d_in, const int* in_sizes, int n_in, void* d_out, int out_size, void* d_ws, size_t ws_size, hipStream_t stream) {
    static int grid = 0;
    if (grid == 0) {
        if (n_in != N_INPUTS || (size_t)out_size != OUT_TOTAL || ws_size < WS_END) { fprintf(stderr, "kernel_launch: unexpected shapes: n_in %d out %d ws %zu\n", n_in, out_size, ws_size); grid = -1; return; }
        int dev = 0, cus = 0, per_cu = 0;
        if (hipGetDevice(&dev) != hipSuccess || hipDeviceGetAttribute(&cus, hipDeviceAttributeMultiprocessorCount, dev) != hipSuccess) { grid = -1; return; }
        if (hipFuncSetAttribute((const void*)mega, hipFuncAttributeMaxDynamicSharedMemorySize, LDS_BYTES) != hipSuccess) { fprintf(stderr, "kernel_launch: hipFuncSetAttribute failed\n"); grid = -1; return; }
        if (hipOccupancyMaxActiveBlocksPerMultiprocessor(&per_cu, (const void*)mega, 512, LDS_BYTES) != hipSuccess || per_cu < 1) { fprintf(stderr, "kernel_launch: occupancy query says %d\n", per_cu); }
        (void)hipGetLastError();
        grid = cus;
    }
    if (grid < 0) return;
    (void)hipMemsetAsync((char*)d_ws + WS_CTL, 0, CTL_ZERO_BYTES, stream);
    Args a{};
    for (int i = 0; i < N_INPUTS; ++i) a.in[i] = (const float*)d_in[i];
    a.out = (float*)d_out; a.ws = (unsigned char*)d_ws;
#if MK_MULTI
    for (int ph = 0; ph < N_PHASES; ++ph) { a.ph_lo = ph; a.ph_hi = ph + 1; hipLaunchKernelGGL(mega, dim3(grid), dim3(512), LDS_BYTES, stream, a); }
#else
    a.ph_lo = 0; a.ph_hi = N_PHASES;
    hipLaunchKernelGGL(mega, dim3(grid), dim3(512), LDS_BYTES, stream, a);
#endif
    const hipError_t le = hipPeekAtLastError();
    if (le != hipSuccess) fprintf(stderr, "kernel_launch: launch failed: %s\n", hipGetErrorName(le));
}
```

```cpp
#include <hip/hip_runtime.h>
#include <cstdio>
#include <cstdint>

#ifndef MK_MULTI
#define MK_MULTI 0
#endif

#define GAS __attribute__((address_space(1)))
#define LAS __attribute__((address_space(3)))
typedef unsigned short bf16;
typedef short bf16x8 __attribute__((ext_vector_type(8)));
typedef short s16x4 __attribute__((ext_vector_type(4)));
typedef float f32x4 __attribute__((ext_vector_type(4)));
typedef float f32x2 __attribute__((ext_vector_type(2)));
typedef float f32x16 __attribute__((ext_vector_type(16)));
typedef unsigned u32x4 __attribute__((ext_vector_type(4)));
typedef unsigned u32x2 __attribute__((ext_vector_type(2)));
typedef __bf16 bf16x2_t __attribute__((ext_vector_type(2)));

constexpr int D = 2048, DEPTH = 4, NPR = 8192  , M = 16384, DFF = 8192;
constexpr int NPROJ = 15872;
constexpr int COL_K = 1024, COL_V = 2048, COL_R = 3072, COL_X0 = 6144, COL_X1 = 7168, COL_VV = 8192, COL_GL = 9216, COL_LW = 15360, COL_G1A = 15488;
constexpr int L_P = 256, L_S = 2048;

enum { I_XP = 0, I_XS, I_CK, I_CV, I_ST, I_C, I_CCTX, I_LN1, I_LN2, I_WMOD, I_BMOD, I_WIN, I_RPB, I_CW, I_CB, I_W0, I_W1, I_W2, I_A0, I_A1, I_A2, I_G1, I_G2,
       I_KK, I_KA, I_RK, I_GNG, I_GNB, I_HCW, I_HCB, I_F1, I_FB1, I_F2, I_FB2, I_FREQ, I_F3, I_HD, I_WPA, I_WPR, I_WPC, I_WOUT, I_FF1, I_BFF1, I_FF2, I_BFF2, I_FING, N_INPUTS };

constexpr size_t OUT_X = 0, OUT_CK = 33554432, OUT_CV = 67108864, OUT_ST = 100663296, OUT_TOTAL = 117440512;

constexpr size_t MiB = 1u << 20;
constexpr size_t WS_CTL = 0, CTL_ZERO_BYTES = 1 * MiB;
constexpr size_t WS_FNP = 1 * MiB;
constexpr size_t WS_WIN = 2 * MiB;
constexpr size_t WS_W2T = 250 * MiB;
constexpr size_t WS_WP = 260 * MiB;
constexpr size_t WS_WOUT = 308 * MiB;
constexpr size_t WS_WFF1 = 340 * MiB;
constexpr size_t WS_WFF2 = 468 * MiB;
constexpr size_t WS_H = 596 * MiB;
constexpr size_t WS_A = 660 * MiB;
constexpr size_t WS_PROJ = 724 * MiB;
constexpr size_t WS_OALL = 1220 * MiB;
constexpr size_t WS_DEC = 1316 * MiB;
constexpr size_t WS_X = 1380 * MiB;
constexpr size_t WS_G = 1444 * MiB;
constexpr size_t WS_TIL = 1476 * MiB;
constexpr size_t WS_CK = 1764 * MiB;
constexpr size_t WS_CV = 1772 * MiB;
constexpr size_t WS_FS = 1780 * MiB;
constexpr size_t WS_FP = 1797 * MiB;
constexpr size_t WS_ZT = 1800 * MiB;
constexpr size_t WS_MOD = 1832 * MiB;
constexpr size_t WS_T2 = 1833 * MiB;
constexpr size_t WS_BONUS = 1837 * MiB;
constexpr size_t WS_TINV = 1838 * MiB;
constexpr size_t WS_Q = WS_TINV;
constexpr size_t WS_WTB = 1870 * MiB;
constexpr size_t WS_END = 1874 * MiB;
constexpr int TILP = 576;
constexpr int LPS = 2120, LPP = 328;

constexpr int CW_BAR = 4096;
constexpr int CW_FNORM = 32768;

constexpr int LDS_SCRATCH = 131072, LDSCTL_OFF = 131072, LDS_BYTES = 147456;

#define LDS_WAIT() asm volatile("s_waitcnt lgkmcnt(0)" ::: "memory")
#define VM_WAIT() asm volatile("s_waitcnt vmcnt(0)" ::: "memory")
__device__ __forceinline__ unsigned cvtpk(float lo, float hi) { f32x2 v = {lo, hi}; bf16x2_t b = __builtin_convertvector(v, bf16x2_t); return __builtin_bit_cast(unsigned, b); }
__device__ __forceinline__ bf16 f2bf(float f) { return (bf16)(cvtpk(f, 0.f) & 0xffffu); }
__device__ __forceinline__ float bf2f(bf16 b) { return __uint_as_float(((unsigned)b) << 16); }
__device__ __forceinline__ float bflo(unsigned w) { return __uint_as_float(w << 16); }
__device__ __forceinline__ float bfhi(unsigned w) { return __uint_as_float(w & 0xffff0000u); }
#define DPPF(v, ctrl) __int_as_float(__builtin_amdgcn_update_dpp(0, __float_as_int(v), (ctrl), 0xf, 0xf, false))
__device__ __forceinline__ float wave_sum(float v) {
    v += DPPF(v, 0xB1); v += DPPF(v, 0x4E); v += DPPF(v, 0x141); v += DPPF(v, 0x140);
    const float a = __int_as_float(__builtin_amdgcn_readlane(__float_as_int(v), 0)), b = __int_as_float(__builtin_amdgcn_readlane(__float_as_int(v), 16)),
                c = __int_as_float(__builtin_amdgcn_readlane(__float_as_int(v), 32)), d = __int_as_float(__builtin_amdgcn_readlane(__float_as_int(v), 48));
    return (a + b) + (c + d);
}
__device__ __forceinline__ float xor32(float v, int lane) { return __int_as_float(__builtin_amdgcn_ds_bpermute((lane ^ 32) << 2, __float_as_int(v))); }
__device__ __forceinline__ int lane_id() { return (int)__builtin_amdgcn_mbcnt_hi(~0u, __builtin_amdgcn_mbcnt_lo(~0u, 0u)); }
__device__ __forceinline__ float sigmoidf_(float x) { return __builtin_amdgcn_rcpf(1.0f + __expf(-x)); }
__device__ __forceinline__ float tanhf_(float x) { return 1.0f - 2.0f * __builtin_amdgcn_rcpf(1.0f + __expf(2.0f * x)); }

#define XB_TMO      128
#define XB_XCNT(j)  (256  + 64 * (j))
#define XB_XSUB(j)  (1280 + 64 * (j))
#define XB_XGEN(j)  (2304 + 64 * (j))
#define XB_TOP      3328
#define XB_TOPGEN   3392
#define XCD_BAR_WORDS 3456
#define XB_SPIN_CAP (1u << 20)
__device__ __forceinline__ unsigned xb_ld(unsigned* p)              { return __hip_atomic_load(p, __ATOMIC_RELAXED, __HIP_MEMORY_SCOPE_AGENT); }
__device__ __forceinline__ unsigned xb_add(unsigned* p, unsigned v) { return __hip_atomic_fetch_add(p, v, __ATOMIC_RELAXED, __HIP_MEMORY_SCOPE_AGENT); }
__device__ __forceinline__ unsigned xb_xcc_id() { return (unsigned)__builtin_amdgcn_s_getreg((3 << 11) | 20) & 0xFu; }
#define XB_SPIN(cond, bar) do { unsigned _sp = 0; while (cond) { __builtin_amdgcn_s_sleep(1); \
    if ((++_sp & 255u) == 0u) { if (xb_ld(&(bar)[XB_TMO])) break; if (_sp > XB_SPIN_CAP) { atomicAdd(&(bar)[XB_TMO], 1u); break; } } } } while (0)
struct XcdBarrier { unsigned* bar; unsigned x; volatile LAS unsigned* st; int wave; };
__device__ __forceinline__ XcdBarrier xcd_barrier_post(unsigned* bar, volatile LAS unsigned* st, int wave) {
    XcdBarrier b; b.bar = bar; b.x = xb_xcc_id(); b.st = st; b.wave = wave;
    if (wave == 0 && lane_id() == 0) (void)xb_add(&bar[XB_XCNT(b.x)], 1u);
    return b;
}
__device__ __forceinline__ void xcd_barrier_complete(unsigned* bar, unsigned x, unsigned& nloc, unsigned& nx) {
    const unsigned G = gridDim.x * gridDim.y * gridDim.z;
    unsigned sum, cnt, mine, sp = 0u;
    for (;;) {
        sum = 0u; cnt = 0u; mine = 0u;
#pragma unroll
        for (unsigned j = 0; j < 16; ++j) { const unsigned c = xb_ld(&bar[XB_XCNT(j)]); sum += c; cnt += (c > 0u) ? 1u : 0u; mine = (j == x) ? c : mine; }
        if (sum == G) break;
        __builtin_amdgcn_s_sleep(1);
        if ((++sp & 255u) == 0u) { if (xb_ld(&bar[XB_TMO])) break; if (sp > XB_SPIN_CAP) { atomicAdd(&bar[XB_TMO], 1u); break; } }
    }
    nloc = mine > 0u ? mine : 1u; nx = cnt > 0u ? cnt : 1u;
}
__device__ __forceinline__ void xcd_barrier(const XcdBarrier& b) {
    asm volatile("s_waitcnt vmcnt(0)" ::: "memory");
    __syncthreads();
    if (b.wave == 0 && lane_id() == 0) {
        unsigned* bar = b.bar; asm volatile("" : "+s"(bar));
        __builtin_amdgcn_s_waitcnt(0);
        unsigned nloc = b.st[0], nx = b.st[1];
        if (nloc == 0u) { xcd_barrier_complete(bar, b.x, nloc, nx); b.st[0] = nloc; b.st[1] = nx; }
        const unsigned old = xb_add(&bar[XB_XSUB(b.x)], 1u);
        const unsigned gen = old / nloc;
        if (old + 1u == (gen + 1u) * nloc) {
            __builtin_amdgcn_fence(__ATOMIC_RELEASE, "agent");
            asm volatile("s_waitcnt vmcnt(0)" ::: "memory");
            const unsigned og = xb_add(&bar[XB_TOP], 1u);
            const unsigned tg = og / nx;
            if (og + 1u == (tg + 1u) * nx) xb_add(&bar[XB_TOPGEN], 1u);
            else XB_SPIN(xb_ld(&bar[XB_TOPGEN]) == tg, bar);
            __builtin_amdgcn_fence(__ATOMIC_ACQUIRE, "agent");
            xb_add(&bar[XB_XGEN(b.x)], 1u);
            asm volatile("s_waitcnt vmcnt(0)" ::: "memory");
        } else {
            XB_SPIN(xb_ld(&bar[XB_XGEN(b.x)]) == gen, bar);
            __builtin_amdgcn_fence(__ATOMIC_ACQUIRE, "agent");
            asm volatile("s_waitcnt vmcnt(0)" ::: "memory");
        }
    }
    __syncthreads();
}

struct Args { const float* in[N_INPUTS]; float* out; unsigned char* ws; int ph_lo, ph_hi; };
struct Frame {
    LAS unsigned char* lds;
    int tid, lane, wave, G, bid;
};
constexpr int LDS_ARGT = 131072 + 1024;
__device__ __forceinline__ const float* INP(const Frame& F, int k) {
    const LAS unsigned* t = (const LAS unsigned*)(F.lds + LDS_ARGT) + 2 * k;
    const unsigned lo = __builtin_amdgcn_readfirstlane(t[0]), hi = __builtin_amdgcn_readfirstlane(t[1]);
    return (const float*)(const GAS float*)(((unsigned long long)hi << 32) | lo);
}
__device__ __forceinline__ float* OUTP(const Frame& F) { return (float*)INP(F, 46); }
__device__ __forceinline__ unsigned char* WSP(const Frame& F) { return (unsigned char*)INP(F, 47); }

namespace pg8 {
constexpr int BM = 256, BK = 64, HALF = 128, HTB = HALF * BK * 2, STAGE_BYTES = 8 * HTB, NXCD = 8, WGM = 4;
__host__ __device__ __forceinline__ int lds_byte(int r, int c) { const int st = (r >> 4) * 2 + (c >> 5), rr = r & 15, cc = c & 31, ob = rr * 64 + cc * 2; return st * 1024 + (ob ^ (((ob >> 9) & 1) << 5)); }
__host__ __device__ __forceinline__ void stage_rc(int b, int& R, int& C) { const int st = b / 1024, sb = b % 1024, swz = sb ^ (((sb >> 9) & 1) << 5); R = (st >> 1) * 16 + swz / 64; C = (st & 1) * 32 + (swz % 64) / 2; }
__host__ __device__ __forceinline__ int perm32(int rho) { const int n = rho >> 4, i = rho & 15; return 8 * (i >> 2) + 4 * n + (i & 3); }

struct Unit { int pm, pn, br; };
struct Gemm { const bf16* A; const bf16* Bt; int lda, ldb, K; int a_br_stride  , a_pair_off  , b_br_tiles  ; };

struct Order {
    int nM, nN, nwg, G, c, nbr;
    __device__ void init(int Mrows, int N, int G_, int c_, int nbr_) { nM = Mrows / BM; nN = N / BM; nwg = nM * nN; G = G_; c = c_; nbr = nbr_; }
    __device__ int nbr_() const { return nbr; }
    __device__ bool next(int i, Unit& u) const {
        const int it = i / nbr; u.br = i - it * nbr;
        const long L = (long)it * G + c; if (L >= nwg) return false;
        int wgid = (int)L; { const int q = nwg / NXCD, r = nwg % NXCD, xcd = wgid % NXCD, off = wgid / NXCD; wgid = (xcd < r ? xcd * (q + 1) : r * (q + 1) + (xcd - r) * q) + off; }
        const int nig = WGM * nN, gid = wgid / nig, fm = gid * WGM, gsz = (nM - fm) < WGM ? (nM - fm) : WGM;
        u.pm = fm + ((wgid % nig) % gsz); u.pn = (wgid % nig) / gsz; return true;
    }
};
struct Order5 {
    Order o;
    __device__ void init(int Mrows, int G_, int c_) { o.init(Mrows, 20 * BM, G_, c_, 1); }
    __device__ int nbr_() const { return 1; }
    __device__ bool next(int i, Unit& u) const { if (!o.next(i, u)) return false; u.br = u.pn >> 2; u.pn &= 3; return true; }
};

template <class Epi, class Sched>
__device__ __forceinline__ void gemm_phase(LAS unsigned char* lds, const Gemm g, const Sched& S, const Epi& E, int wave) {
    int tid = wave * 64 + lane_id(); asm volatile("" : "+v"(tid));
    const int wid = __builtin_amdgcn_readfirstlane(tid >> 6), lane = tid & 63, wr = wid >> 2, wc = wid & 3, fr = lane & 15, fq = lane >> 4;
    const int K = g.K; int nt = K / BK; asm volatile("" : "+s"(nt));
    unsigned voffA[2], voffB[2];
#pragma unroll
    for (int i = 0; i < 2; ++i) { int R, C; stage_rc(tid * 16 + i * 8192, R, C); const int Rb = Epi::PERM ? ((R & ~31) + perm32(R & 31)) : R;
        voffA[i] = (unsigned)(R * g.lda + C) * 2u; voffB[i] = (unsigned)(Rb * g.ldb + C) * 2u; }
    const size_t kstep = (size_t)(BK * 2);
    const size_t hstepA = (size_t)HALF * g.lda * 2, hstepB = (size_t)HALF * g.ldb * 2;
    const unsigned ldsw = (unsigned)wid * 1024u;
    const int aoff = lds_byte(wr * 64 + fr, fq * 8), boff = lds_byte(wc * 32 + fr, fq * 8);
#define PG8_APTR(u) ((const char*)g.A + ((size_t)(u).pm * 256 * g.lda + (size_t)(u).br * g.a_br_stride + (size_t)((u).br >> 1) * g.a_pair_off) * 2)
#define PG8_BPTR(u) ((const char*)g.Bt + ((size_t)((u).br * g.b_br_tiles + (u).pn) * 256 * g.ldb) * 2)
#define PG8_SA(b, h) (((b) * 2 + (h)) * HTB)
#define PG8_SB(b, h) ((4 + (b) * 2 + (h)) * HTB)
#define PG8_STAGE(bufoff, gbase, voff) do { _Pragma("unroll") for (int _i = 0; _i < 2; ++_i) \
        __builtin_amdgcn_global_load_lds((const unsigned*)((const char*)(gbase) + (voff)[_i]), (LAS unsigned*)(lds + (bufoff) + ldsw + _i * 8192), 16, 0, 0); } while (0)
#define PG8_LDA(dst, b, h) do { _Pragma("unroll") for (int m = 0; m < 4; ++m) _Pragma("unroll") for (int k = 0; k < 2; ++k) dst[m][k] = *(const LAS bf16x8*)(lds + PG8_SA(b, h) + aoff + m * 2048 + k * 1024); } while (0)
#define PG8_LDB(dst, b, h) do { _Pragma("unroll") for (int n = 0; n < 2; ++n) _Pragma("unroll") for (int k = 0; k < 2; ++k) dst[n][k] = *(const LAS bf16x8*)(lds + PG8_SB(b, h) + boff + n * 2048 + k * 1024); } while (0)
#define PG8_MMA(ai, bj, At, Bt) do { __builtin_amdgcn_s_setprio(1); _Pragma("unroll") for (int m = 0; m < 4; ++m) _Pragma("unroll") for (int n = 0; n < 2; ++n) _Pragma("unroll") for (int k = 0; k < 2; ++k) \
        acc[ai][bj][m][n] = __builtin_amdgcn_mfma_f32_16x16x32_bf16(Bt[n][k], At[m][k], acc[ai][bj][m][n], 0, 0, 0); __builtin_amdgcn_s_setprio(0); } while (0)
#define PG8_WAIT_V(n) asm volatile("s_waitcnt vmcnt(" #n ")" ::: "memory")
#define PG8_WAIT_L(n) asm volatile("s_waitcnt lgkmcnt(" #n ")" ::: "memory")
#define PG8_BAR __builtin_amdgcn_s_barrier()
#define PG8_SCHED __builtin_amdgcn_sched_barrier(0)
    Unit cur, nxt; int ui = 0;
    if (!S.next(0, cur)) return;
    f32x4 acc[2][2][4][2];
#pragma unroll
    for (int a = 0; a < 2; ++a)
#pragma unroll
        for (int b = 0; b < 2; ++b)
#pragma unroll
            for (int m = 0; m < 4; ++m)
#pragma unroll
                for (int n = 0; n < 2; ++n) acc[a][b][m][n] = (f32x4){0.f, 0.f, 0.f, 0.f};
    bf16x8 At[4][2], B0[2][2], B1[2][2];
    const char* cA = PG8_APTR(cur); const char* cB = PG8_BPTR(cur);
    PG8_STAGE(PG8_SB(0, 0), cB, voffB); PG8_STAGE(PG8_SB(0, 1), cB + hstepB, voffB); PG8_STAGE(PG8_SA(0, 0), cA, voffA); PG8_STAGE(PG8_SA(0, 1), cA + hstepA, voffA);
    if (wr == 1) PG8_BAR;
    PG8_WAIT_V(2); PG8_BAR;
    PG8_STAGE(PG8_SB(1, 0), cB + kstep, voffB); PG8_STAGE(PG8_SA(1, 0), cA + kstep, voffA); PG8_STAGE(PG8_SB(1, 1), cB + hstepB + kstep, voffB);
    PG8_WAIT_V(6); PG8_BAR;
    for (;;) {
        const bool has_next = S.next(ui + 1, nxt);
        const char* nA = has_next ? PG8_APTR(nxt) : cA; const char* nB = has_next ? PG8_BPTR(nxt) : cB;
#pragma unroll 1
        for (int t = 0; t < nt; t += 2) {
            const bool last = (t == nt - 2);
            const char* a1 = cA + (size_t)(t + 1) * kstep;
            const char* a2 = last ? nA : cA + (size_t)(t + 2) * kstep; const char* b2 = last ? nB : cB + (size_t)(t + 2) * kstep;
            const char* a3 = a2 + kstep; const char* b3 = b2 + kstep;
            PG8_LDB(B0, 0, 0); PG8_LDB(B1, 0, 1); PG8_SCHED; PG8_LDA(At, 0, 0); PG8_STAGE(PG8_SA(1, 1), a1 + hstepA, voffA);
            PG8_WAIT_V(8); PG8_WAIT_L(0); PG8_BAR; PG8_MMA(0, 0, At, B0); PG8_MMA(0, 1, At, B1); PG8_BAR; PG8_SCHED;
            PG8_LDA(At, 0, 1); PG8_STAGE(PG8_SB(0, 0), b2, voffB); PG8_STAGE(PG8_SB(0, 1), b2 + hstepB, voffB); PG8_STAGE(PG8_SA(0, 0), a2, voffA);
            PG8_WAIT_V(8); PG8_WAIT_L(0); PG8_BAR; PG8_MMA(1, 0, At, B0); PG8_MMA(1, 1, At, B1); PG8_BAR; PG8_SCHED;
            PG8_LDB(B0, 1, 0); PG8_LDB(B1, 1, 1); PG8_SCHED; PG8_LDA(At, 1, 0); PG8_STAGE(PG8_SA(0, 1), a2 + hstepA, voffA);
            PG8_WAIT_V(8); PG8_WAIT_L(0); PG8_BAR; PG8_MMA(0, 0, At, B0); PG8_MMA(0, 1, At, B1); PG8_BAR; PG8_SCHED;
            PG8_LDA(At, 1, 1); PG8_STAGE(PG8_SB(1, 0), b3, voffB); PG8_STAGE(PG8_SB(1, 1), b3 + hstepB, voffB); PG8_STAGE(PG8_SA(1, 0), a3, voffA);
            PG8_WAIT_V(8); PG8_WAIT_L(0); PG8_BAR; PG8_MMA(1, 0, At, B0); PG8_MMA(1, 1, At, B1); PG8_BAR; PG8_SCHED;
        }
        if (wr == 0) PG8_BAR;
        E(acc, cur, wr, wc, fr, fq);
        if (!has_next) break;
        if (!Epi::CHAIN || cur.br == S.nbr_() - 1) {
#pragma unroll
        for (int a = 0; a < 2; ++a)
#pragma unroll
            for (int b = 0; b < 2; ++b)
#pragma unroll
                for (int m = 0; m < 4; ++m)
#pragma unroll
                    for (int n = 0; n < 2; ++n) acc[a][b][m][n] = (f32x4){0.f, 0.f, 0.f, 0.f};
        }
        cur = nxt; cA = nA; cB = nB; ++ui;
        if (wr == 1) PG8_BAR;
    }
    PG8_WAIT_V(0);
    PG8_BAR;
#undef PG8_APTR
#undef PG8_BPTR
#undef PG8_SA
#undef PG8_SB
#undef PG8_STAGE
#undef PG8_LDA
#undef PG8_LDB
#undef PG8_MMA
#undef PG8_WAIT_V
#undef PG8_WAIT_L
#undef PG8_BAR
#undef PG8_SCHED
}

__device__ __forceinline__ float gclamp(float g) { return fmaxf(g, 1e-20f); }
__device__ __forceinline__ int modrow(int row) { return row < NPR ? 0 : 1 + ((row - NPR) >> 11); }

struct EpiProj {
    static constexpr bool PERM = true; static constexpr bool CHAIN = false;
    bf16* proj; float* outk; float* outv; int layer;
    __device__ __forceinline__ void operator()(const f32x4 (&acc)[2][2][4][2], const Unit& u, int wr, int wc, int fr, int fq) const {
        { int t_ = lane_id(); asm volatile("" : "+v"(t_)); fr = t_ & 15; fq = (t_ >> 4) & 3; }
        const int row0 = u.pm * BM + wr * 64 + fr, colb = u.pn * BM + wc * 32 + 8 * fq;
        const int mode = (u.pn == 60) ? 1 : (u.pn == 61 ? 2 : ((u.pn >= 36) ? 3 : 0));
        const bool kv = (u.pm < 32) && (u.pn >= 4) && (u.pn < 12);
#pragma unroll
        for (int ai = 0; ai < 2; ++ai)
#pragma unroll
            for (int m = 0; m < 4; ++m) {
                const int row = row0 + ai * HALF + m * 16;
                bf16* rowp = proj + (size_t)row * NPROJ + colb;
#pragma unroll
                for (int bj = 0; bj < 2; ++bj) {
                    f32x4 v0 = acc[ai][bj][m][0], v1 = acc[ai][bj][m][1];
                    if (mode == 1) { if (colb + bj * HALF < COL_G1A) {
#pragma unroll
                        for (int j = 0; j < 4; ++j) { v0[j] = tanhf_(v0[j]); v1[j] = tanhf_(v1[j]); } } }
                    else if (mode == 3) {
#pragma unroll
                        for (int j = 0; j < 4; ++j) { v0[j] = sigmoidf_(v0[j]); v1[j] = sigmoidf_(v1[j]); } }
                    else if (mode == 2) { const bool act = (colb + bj * HALF) < 15744;
#pragma unroll
                        for (int j = 0; j < 4; ++j) { v0[j] = act ? sigmoidf_(v0[j]) : 0.f; v1[j] = act ? sigmoidf_(v1[j]) : 0.f; } }
                    u32x4 w; w.x = cvtpk(v0[0], v0[1]); w.y = cvtpk(v0[2], v0[3]); w.z = cvtpk(v1[0], v1[1]); w.w = cvtpk(v1[2], v1[3]);
                    *(u32x4*)(rowp + bj * HALF) = w;
                    if (kv) { const int col = colb + bj * HALF; float* ob = (u.pn < 8) ? outk : outv; const int ch = col - ((u.pn < 8) ? COL_K : COL_V);
                        float* dst = ob + ((size_t)(((row >> 8) * 4 + layer) * 256 + (row & 255))) * 1024 + ch;
                        *(f32x4*)dst = v0; *(f32x4*)(dst + 4) = v1; }
                }
            }
    }
};
struct EpiLora2 {
    static constexpr bool PERM = true; static constexpr bool CHAIN = false;
    bf16* dec; bf16* abuf; bf16* gbuf; const float* w0; const float* a0;
    __device__ __forceinline__ void operator()(const f32x4 (&acc)[2][2][4][2], const Unit& u, int wr, int wc, int fr, int fq) const {
        { int t_ = lane_id(); asm volatile("" : "+v"(t_)); fr = t_ & 15; fq = (t_ >> 4) & 3; }
        const int row0 = u.pm * BM + wr * 64 + fr, colb = u.pn * BM + wc * 32 + 8 * fq;
        const int br = u.br, e = br & 1;
        const float* bsrc = (br < 2) ? w0 + e * 1024 : a0 + e * 1024;
        bf16* obase = (br < 2) ? dec + (size_t)e * 1024 : (br < 4 ? abuf + (size_t)e * 1024 : gbuf);
        const size_t opitch = (br < 4) ? 2048 : 1024;
#pragma unroll
        for (int bj = 0; bj < 2; ++bj) {
            const int ch = colb + bj * HALF;
            f32x4 b0 = (f32x4){0.f, 0.f, 0.f, 0.f}, b1 = b0;
            if (br < 4) { b0 = *(const f32x4*)(bsrc + ch); b1 = *(const f32x4*)(bsrc + ch + 4); }
#pragma unroll
            for (int ai = 0; ai < 2; ++ai)
#pragma unroll
                for (int m = 0; m < 4; ++m) {
                    const int row = row0 + ai * HALF + m * 16;
                    f32x4 v0 = acc[ai][bj][m][0] + b0, v1 = acc[ai][bj][m][1] + b1;
                    if (br < 4) {
#pragma unroll
                        for (int j = 0; j < 4; ++j) { v0[j] = sigmoidf_(v0[j]); v1[j] = sigmoidf_(v1[j]); }
                        if (br < 2) { v0 = v0 * -0.6065306597126334f; v1 = v1 * -0.6065306597126334f; }
                    }
                    u32x4 w; w.x = cvtpk(v0[0], v0[1]); w.y = cvtpk(v0[2], v0[3]); w.z = cvtpk(v1[0], v1[1]); w.w = cvtpk(v1[2], v1[3]);
                    *(u32x4*)(obase + (size_t)row * opitch + ch) = w;
                    __builtin_amdgcn_sched_barrier(0);
                }
        }
    }
};
struct EpiMerge {
    static constexpr bool PERM = true; static constexpr bool CHAIN = true;
    const bf16* proj; bf16* merged;
    __device__ __forceinline__ void operator()(f32x4 (&acc)[2][2][4][2], const Unit& u, int wr, int wc, int fr, int fq) const {
        { int t_ = lane_id(); asm volatile("" : "+v"(t_)); fr = t_ & 15; fq = (t_ >> 4) & 3; }
        const int row0 = u.pm * BM + wr * 64 + fr, colb = u.pn * BM + wc * 32 + 8 * fq;
        const int br = u.br;
        const bf16* gbase = proj + (size_t)row0 * NPROJ + COL_GL + br * 2048 + colb;
        if (br < 2) {
#pragma unroll
            for (int ai = 0; ai < 2; ++ai) {
                u32x4 ga[4][2], gb[4][2];
#pragma unroll
                for (int m = 0; m < 4; ++m)
#pragma unroll
                    for (int bj = 0; bj < 2; ++bj) { const bf16* gp = gbase + (size_t)(ai * HALF + m * 16) * NPROJ + bj * HALF;
                        ga[m][bj] = *(const u32x4*)gp; gb[m][bj] = *(const u32x4*)(gp + 2048); }
#pragma unroll
                for (int m = 0; m < 4; ++m)
#pragma unroll
                    for (int bj = 0; bj < 2; ++bj) {
                        const u32x4 a = ga[m][bj], b = gb[m][bj];
                        f32x4& v0 = acc[ai][bj][m][0]; f32x4& v1 = acc[ai][bj][m][1];
                        v0[0] *= gclamp(bflo(a.x)) * __builtin_amdgcn_rcpf(gclamp(bflo(b.x))); v0[1] *= gclamp(bfhi(a.x)) * __builtin_amdgcn_rcpf(gclamp(bfhi(b.x)));
                        v0[2] *= gclamp(bflo(a.y)) * __builtin_amdgcn_rcpf(gclamp(bflo(b.y))); v0[3] *= gclamp(bfhi(a.y)) * __builtin_amdgcn_rcpf(gclamp(bfhi(b.y)));
                        v1[0] *= gclamp(bflo(a.z)) * __builtin_amdgcn_rcpf(gclamp(bflo(b.z))); v1[1] *= gclamp(bfhi(a.z)) * __builtin_amdgcn_rcpf(gclamp(bfhi(b.z)));
                        v1[2] *= gclamp(bflo(a.w)) * __builtin_amdgcn_rcpf(gclamp(bflo(b.w))); v1[3] *= gclamp(bfhi(a.w)) * __builtin_amdgcn_rcpf(gclamp(bfhi(b.w)));
                    }
                asm volatile("" ::: "memory"); }
        } else {
#pragma unroll
            for (int ai = 0; ai < 2; ++ai)
#pragma unroll
                for (int m = 0; m < 4; ++m) {
                    const int row = row0 + ai * HALF + m * 16;
#pragma unroll
                    for (int bj = 0; bj < 2; ++bj) {
                        const int col = colb + bj * HALF;
                        const u32x4 gw = *(const u32x4*)(gbase + (size_t)(ai * HALF + m * 16) * NPROJ + bj * HALF);
                        f32x4 v0 = acc[ai][bj][m][0], v1 = acc[ai][bj][m][1];
                        v0[0] *= gclamp(bflo(gw.x)); v0[1] *= gclamp(bfhi(gw.x)); v0[2] *= gclamp(bflo(gw.y)); v0[3] *= gclamp(bfhi(gw.y));
                        v1[0] *= gclamp(bflo(gw.z)); v1[1] *= gclamp(bfhi(gw.z)); v1[2] *= gclamp(bflo(gw.w)); v1[3] *= gclamp(bfhi(gw.w));
                        u32x4 w; w.x = cvtpk(v0[0], v0[1]); w.y = cvtpk(v0[2], v0[3]); w.z = cvtpk(v1[0], v1[1]); w.w = cvtpk(v1[2], v1[3]);
                        *(u32x4*)(merged + (size_t)row * D + col) = w;
                    }
                }
        }
    }
};
struct EpiResid {
    static constexpr bool PERM = true; static constexpr bool CHAIN = false;
    bf16* x; const float* gate;   const float* bias;
    __device__ __forceinline__ void operator()(const f32x4 (&acc)[2][2][4][2], const Unit& u, int wr, int wc, int fr, int fq) const {
        { int t_ = lane_id(); asm volatile("" : "+v"(t_)); fr = t_ & 15; fq = (t_ >> 4) & 3; }
        const int row0 = u.pm * BM + wr * 64 + fr, colb = u.pn * BM + wc * 32 + 8 * fq;
        const int mr = modrow(u.pm * BM);
        const float* gp = gate + (size_t)mr * 12288;
        f32x4 gv[2][2], bv[2][2];
#pragma unroll
        for (int bj = 0; bj < 2; ++bj)
#pragma unroll
            for (int n = 0; n < 2; ++n) { gv[bj][n] = *(const f32x4*)(gp + colb + bj * HALF + 4 * n);
                bv[bj][n] = bias ? *(const f32x4*)(bias + colb + bj * HALF + 4 * n) : (f32x4){0.f, 0.f, 0.f, 0.f}; }
        bf16* base = x + (size_t)row0 * D + colb;
#pragma unroll
        for (int ai = 0; ai < 2; ++ai) {
            u32x4 xo[4][2];
#pragma unroll
            for (int m = 0; m < 4; ++m)
#pragma unroll
                for (int bj = 0; bj < 2; ++bj) xo[m][bj] = *(const u32x4*)(base + (size_t)(ai * HALF + m * 16) * D + bj * HALF);
#pragma unroll
            for (int m = 0; m < 4; ++m)
#pragma unroll
                for (int bj = 0; bj < 2; ++bj) { const u32x4 p = xo[m][bj];
                    const f32x4 o0 = (f32x4){bflo(p.x), bfhi(p.x), bflo(p.y), bfhi(p.y)} + gv[bj][0] * (acc[ai][bj][m][0] + bv[bj][0]);
                    const f32x4 o1 = (f32x4){bflo(p.z), bfhi(p.z), bflo(p.w), bfhi(p.w)} + gv[bj][1] * (acc[ai][bj][m][1] + bv[bj][1]);
                    *(u32x4*)(base + (size_t)(ai * HALF + m * 16) * D + bj * HALF) = (u32x4){cvtpk(o0[0], o0[1]), cvtpk(o0[2], o0[3]), cvtpk(o1[0], o1[1]), cvtpk(o1[2], o1[3])}; }
            asm volatile("" ::: "memory"); }
    }
};
struct EpiFF1 {
    static constexpr bool PERM = true; static constexpr bool CHAIN = false;
    bf16* U; const float* bias;
    __device__ __forceinline__ void operator()(const f32x4 (&acc)[2][2][4][2], const Unit& u, int wr, int wc, int fr, int fq) const {
        { int t_ = lane_id(); asm volatile("" : "+v"(t_)); fr = t_ & 15; fq = (t_ >> 4) & 3; }
        const int row0 = u.pm * BM + wr * 64 + fr, colb = u.pn * BM + wc * 32 + 8 * fq;
        f32x4 bv[2][2];
#pragma unroll
        for (int bj = 0; bj < 2; ++bj)
#pragma unroll
            for (int n = 0; n < 2; ++n) bv[bj][n] = *(const f32x4*)(bias + colb + bj * HALF + 4 * n);
#pragma unroll
        for (int ai = 0; ai < 2; ++ai)
#pragma unroll
            for (int m = 0; m < 4; ++m) { bf16* rowp = U + (size_t)(row0 + ai * HALF + m * 16) * DFF + colb;
#pragma unroll
                for (int bj = 0; bj < 2; ++bj) { f32x4 v0 = acc[ai][bj][m][0] + bv[bj][0], v1 = acc[ai][bj][m][1] + bv[bj][1];
#pragma unroll
                    for (int j = 0; j < 4; ++j) { const float a = fmaxf(v0[j], 0.f), b = fmaxf(v1[j], 0.f); v0[j] = a * a; v1[j] = b * b; }
                    u32x4 w; w.x = cvtpk(v0[0], v0[1]); w.y = cvtpk(v0[2], v0[3]); w.z = cvtpk(v1[0], v1[1]); w.w = cvtpk(v1[2], v1[3]);
                    *(u32x4*)(rowp + bj * HALF) = w; } }
    }
};
}

__device__ __forceinline__ void transpose_item(const float* W, int K, int N, bf16* WT, int ldk, int row_off, LAS bf16* scr, int item, int lane) {
    const int nblk = N / 64, kb = item / nblk, nb = item % nblk, k0 = 32 * kb, n = 64 * nb + lane;
    const float* src = W + (size_t)k0 * N + n;
    float v[32];
#pragma unroll
    for (int i = 0; i < 32; ++i) v[i] = __builtin_nontemporal_load(src + (size_t)i * N);
    bf16* dst = WT + (size_t)(row_off + n) * ldk + k0;
#pragma unroll
    for (int q = 0; q < 4; ++q) *(u32x4*)(dst + 8 * q) = (u32x4){cvtpk(v[8 * q], v[8 * q + 1]), cvtpk(v[8 * q + 2], v[8 * q + 3]), cvtpk(v[8 * q + 4], v[8 * q + 5]), cvtpk(v[8 * q + 6], v[8 * q + 7])};
    (void)scr; (void)K;
}

__device__ __forceinline__ void convert_layer(const Frame& F, int l, LAS bf16* scr, int gw, int NGW, int part) {
    unsigned char* ws = WSP(F);
    if (part & 1) {
        bf16* WinT = (bf16*)(ws + WS_WIN) + (size_t)l * NPROJ * D;
        {   const int n_items = (D / 32) * (15360 / 64); const float* W = INP(F, I_WIN) + (size_t)l * D * 15360;
            for (int it = gw; it < n_items; it += NGW) transpose_item(W, D, 15360, WinT, D, 0, scr, it, F.lane); }
        for (int e = 0; e < 2; ++e) {
            const int n_items = (D / 32);
            const float* W1 = INP(F, I_W1) + ((size_t)l * 2 + e) * D * 64; const float* A1 = INP(F, I_A1) + ((size_t)l * 2 + e) * D * 64;
            for (int it = gw; it < n_items; it += NGW) { transpose_item(W1, D, 64, WinT, D, COL_LW + e * 64, scr, it, F.lane); transpose_item(A1, D, 64, WinT, D, COL_LW + 128 + e * 64, scr, it, F.lane); }
        }
        {   const int n_items = (D / 32) * 2; const float* W = INP(F, I_G1) + (size_t)l * D * 128;
            for (int it = gw; it < n_items; it += NGW) transpose_item(W, D, 128, WinT, D, COL_LW + 256, scr, it, F.lane); }
        for (int i = gw * 64 + F.lane; i < 128 * D / 8; i += NGW * 64) ((u32x4*)(WinT + (size_t)15744 * D))[i] = (u32x4){0u, 0u, 0u, 0u};
        {   bf16* W2T = (bf16*)(ws + WS_W2T) + (size_t)l * 5120 * 128;
            const float* w2 = INP(F, I_W2) + (size_t)l * 2 * 64 * 1024; const float* a2 = INP(F, I_A2) + (size_t)l * 2 * 64 * 1024; const float* g2 = INP(F, I_G2) + (size_t)l * 128 * 1024;
            for (int it = gw; it < 32 * 6; it += NGW) { const int m = it / 32, sub = it % 32;
                const float* W = m == 0 ? w2 : (m == 1 ? w2 + 65536 : (m == 2 ? a2 : (m == 3 ? a2 + 65536 : (m == 4 ? g2 : g2 + 65536))));
                const int br = m < 4 ? m : 4, koff = m < 4 ? 64 * (m & 1) : (m == 4 ? 0 : 64);
                transpose_item(W, 64, 1024, W2T + (size_t)br * 1024 * 128 + koff, 128, 0, scr, sub, F.lane); }
            for (int i = gw * 64 + F.lane; i < 4096 * 8; i += NGW * 64) { const int n = i >> 3, k8 = (i & 7) * 8, br = n >> 10;
                *(u32x4*)(W2T + (size_t)n * 128 + ((br & 1) ? 0 : 64) + k8) = (u32x4){0u, 0u, 0u, 0u}; }
        }
    }
    if (part & 2) {
        for (int br = 0; br < 3; ++br) { const float* W = INP(F, I_WPA + br) + (size_t)l * 1024 * D; bf16* WT = (bf16*)(ws + WS_WP) + ((size_t)l * 3 + br) * D * 1024;
            const int n_items = (1024 / 32) * (D / 64);
            for (int it = gw; it < n_items; it += NGW) transpose_item(W, 1024, D, WT, 1024, 0, scr, it, F.lane); }
        {   const float* W = INP(F, I_WOUT) + (size_t)l * D * D; bf16* WT = (bf16*)(ws + WS_WOUT) + (size_t)l * D * D; const int n_items = (D / 32) * (D / 64);
            for (int it = gw; it < n_items; it += NGW) transpose_item(W, D, D, WT, D, 0, scr, it, F.lane); }
        {   const float* W = INP(F, I_FF1) + (size_t)l * D * DFF; bf16* WT = (bf16*)(ws + WS_WFF1) + (size_t)l * D * DFF; const int n_items = (D / 32) * (DFF / 64);
            for (int it = gw; it < n_items; it += NGW) transpose_item(W, D, DFF, WT, D, 0, scr, it, F.lane); }
        {   const float* W = INP(F, I_FF2) + (size_t)l * D * DFF; bf16* WT = (bf16*)(ws + WS_WFF2) + (size_t)l * D * DFF; const int n_items = (DFF / 32) * (D / 64);
            for (int it = gw; it < n_items; it += NGW) transpose_item(W, DFF, D, WT, DFF, 0, scr, it, F.lane); }
    }
}

constexpr int MOD_NDS = 16;
__device__ __forceinline__ void mod_partials(const Frame& F, int l0, int l1, int gw, int NGW) {
    unsigned char* ws = WSP(F);
    LAS float* sv = (LAS float*)(F.lds + 65536);
    __syncthreads();
    for (int i = F.tid; i < 5 * D; i += 512) { const int r = i / D, d = i - r * D; const float x = (r == 0) ? INP(F, I_CCTX)[d] : INP(F, I_C)[(r - 1) * D + d]; sv[i] = x / (1.0f + __expf(-x)); }
    __syncthreads();
    float* PART = (float*)(ws + WS_Q);
    const int n_items = (l1 - l0) * 48 * MOD_NDS;
    for (int it = gw; it < n_items; it += NGW) {
        const int l = l0 + it / (48 * MOD_NDS), rem = it % (48 * MOD_NDS), jc = rem / MOD_NDS, ds = rem % MOD_NDS, j4 = jc * 256 + 4 * F.lane;
        const float* W = INP(F, I_WMOD) + (size_t)l * D * 12288 + (size_t)(ds * (D / MOD_NDS)) * 12288 + j4;
        f32x4 acc[5];
#pragma unroll
        for (int r = 0; r < 5; ++r) acc[r] = (f32x4){0.f, 0.f, 0.f, 0.f};
#pragma unroll 4
        for (int d = 0; d < D / MOD_NDS; d += 4) {
            f32x4 w[4];
#pragma unroll
            for (int q = 0; q < 4; ++q) w[q] = __builtin_nontemporal_load((const f32x4*)(W + (size_t)(d + q) * 12288));
#pragma unroll
            for (int r = 0; r < 5; ++r) { const f32x4 s = *(const LAS f32x4*)(sv + r * D + ds * (D / MOD_NDS) + d);
#pragma unroll
                for (int q = 0; q < 4; ++q) acc[r] += w[q] * s[q]; }
        }
#pragma unroll
        for (int r = 0; r < 5; ++r) *(f32x4*)(PART + (((size_t)ds * 4 + l) * 5 + r) * 12288 + j4) = acc[r];
    }
    __syncthreads();
}
__device__ __forceinline__ void mod_reduce(const Frame& F, int l0, int l1) {
    unsigned char* ws = WSP(F);
    const float* PART = (const float*)(ws + WS_Q); float* MOD = (float*)(ws + WS_MOD);
    for (int i = l0 * 5 * 3072 + (F.bid * 8 + F.wave) * 64 + F.lane; i < l1 * 5 * 3072; i += F.G * 8 * 64) {
        const int l = i / (5 * 3072), j4 = (i % 3072) * 4;
        f32x4 s = *(const f32x4*)(INP(F, I_BMOD) + l * 12288 + j4);
#pragma unroll
        for (int ds = 0; ds < MOD_NDS; ++ds) s += ((const f32x4*)PART)[(size_t)ds * (DEPTH * 5 * 3072) + i];
        ((f32x4*)MOD)[i] = s; }
}
__device__ __forceinline__ void prologue0(const Frame& F, const Args& a) {
    unsigned char* ws = WSP(F);
    LAS bf16* scr = (LAS bf16*)(F.lds + F.wave * 16384);
    const int gw = F.bid * 8 + F.wave, NGW = F.G * 8;
    convert_layer(F, 0, scr, gw, NGW, 1);
    {   const float* ck = INP(F, I_CK); const float* cv = INP(F, I_CV); bf16* ok = (bf16*)(ws + WS_CK); bf16* ov = (bf16*)(ws + WS_CV);
        const int n4 = 4 * 4 * 256 * 1024 / 4;
        for (int i = gw * 64 + F.lane; i < n4; i += NGW * 64) { const f32x4 x = ((const f32x4*)ck)[i], y = ((const f32x4*)cv)[i];
            ((u32x2*)ok)[i] = (u32x2){cvtpk(x[0], x[1]), cvtpk(x[2], x[3])}; ((u32x2*)ov)[i] = (u32x2){cvtpk(y[0], y[1]), cvtpk(y[2], y[3])}; }
    }
    mod_partials(F, 0, 1, gw, NGW);
    {   float* T2 = (float*)(ws + WS_T2);
        const int n_items = DEPTH * (L_S + L_P);
        for (int it = gw; it < n_items; it += NGW) {
            const int l = it / (L_S + L_P), rr = it % (L_S + L_P), sel = rr < L_S ? 0 : 1, t = sel ? rr - L_S : rr, L = sel ? L_P : L_S;
            float zf = 0.f;
            {   const float tt = (float)t / (float)(L - 1);
                const float w = (6.283185307179586f * (float)t) / (float)L;
                const int band = (F.lane - 1) & 15;
                const float f = 1e-4f + (float)band * ((15.0f - 1e-4f) / 15.0f);
                const float fw = f * w;
                const double rd = (double)fw - 6.283185307179586 * rint((double)fw * 0.15915494309189535);
                const float rf = (float)rd;
                zf = (F.lane == 0) ? tt : (F.lane <= 16 ? __cosf(rf) : -__sinf(rf));
            }
            const float* f1 = INP(F, I_F1) + (size_t)l * 33 * 64; const float* f2 = INP(F, I_F2) + (size_t)l * 64 * 64;
            const float fq = INP(F, I_FREQ)[l * 64 + F.lane];
            float s = INP(F, I_FB1)[l * 64 + F.lane];
            for (int i = 0; i < 33; ++i) s += __int_as_float(__builtin_amdgcn_readlane(__float_as_int(zf), i)) * f1[i * 64 + F.lane];
            float x = fq * s; { const double rd = (double)x - 6.283185307179586 * rint((double)x * 0.15915494309189535); x = (float)rd; }
            const float t1 = __sinf(x);
            float s2 = INP(F, I_FB2)[l * 64 + F.lane];
            for (int i = 0; i < 64; ++i) s2 += __int_as_float(__builtin_amdgcn_readlane(__float_as_int(t1), i)) * f2[i * 64 + F.lane];
            float y = fq * s2; { const double rd = (double)y - 6.283185307179586 * rint((double)y * 0.15915494309189535); y = (float)rd; }
            T2[(((size_t)l * 2 + sel) * L_S + t) * 64 + F.lane] = __sinf(y);
        }
    }
    {   bf16* FS = (bf16*)(ws + WS_FS); bf16* FP = (bf16*)(ws + WS_FP);
        for (int i = gw * 64 + F.lane; i < DEPTH * 1024 * 72; i += NGW * 64) { const int row = i / 72, p = i % 72; const int m = p < 32 ? p : p - 32 + 32;
            FS[(size_t)row * LPS + (p < 32 ? p : L_S + p)] = 0; FP[(size_t)row * LPP + (p < 32 ? p : L_P + p)] = 0; (void)m; }
    }
}

__device__ __forceinline__ void prologue1(const Frame& F, const Args& a) {
    unsigned char* ws = WSP(F);
    const int gw = F.bid * 8 + F.wave, NGW = F.G * 8;
    mod_reduce(F, 0, 1);
    const float* T2 = (const float*)(ws + WS_T2);
    float* FNP = (float*)(ws + WS_FNP);
    for (int it = gw; it < DEPTH * 16 * 32; it += NGW) {
        const int l = it / (16 * 32), cg = (it / 32) % 16, pc = it % 32, c = cg * 64 + F.lane;
        const float* f3 = INP(F, I_F3) + (size_t)l * 64 * 1024 + c;
        float w3[64];
#pragma unroll
        for (int j = 0; j < 64; ++j) w3[j] = f3[(size_t)j * 1024];
        const float delta = fabsf(-3.0701134573253946f + (float)c * ((-15.350567286626973f + 3.0701134573253946f) / 1023.0f));
        bf16* dst_s = (bf16*)(ws + WS_FS) + ((size_t)l * 1024 + c) * LPS; bf16* dst_p = (bf16*)(ws + WS_FP) + ((size_t)l * 1024 + c) * LPP;
        float asum_s = 0.f, asum_p = 0.f;
        for (int gg = pc * 72; gg < pc * 72 + 72; ++gg) {
            const int sel = gg >= L_S ? 1 : 0, t = sel ? gg - L_S : gg, L = sel ? L_P : L_S;
            const float tv = T2[(((size_t)l * 2 + sel) * L_S + t) * 64 + F.lane];
            float s = 0.f;
#pragma unroll
            for (int j = 0; j < 64; ++j) s += __int_as_float(__builtin_amdgcn_readlane(__float_as_int(tv), j)) * w3[j];
            const float dist = fabsf((float)(t - L / 2)) / (float)L;
            const float fv = s * __expf(-dist * delta);
            if (sel) { asum_p += fabsf(fv); dst_p[32 + (L - 1 - t)] = f2bf(fv); } else { asum_s += fabsf(fv); dst_s[32 + (L - 1 - t)] = f2bf(fv); }
        }
        FNP[(((size_t)l * 2 + 0) * 1024 + c) * 32 + pc] = asum_s; FNP[(((size_t)l * 2 + 1) * 1024 + c) * 32 + pc] = asum_p;
    }
}

template <bool XF32>
__device__ __forceinline__ void norm_phase(const Frame& F, const void* xp, const void* xs, bf16* xcopy, const float* g, const float* mod, int i_sh, int i_sc, bf16* hout) {
    const int gw = F.bid * 8 + F.wave, NGW = F.G * 8, lane = F.lane;
    for (int rg = gw; rg < M / 8; rg += NGW) {
        const int row0 = rg * 8;
        const float* mr = mod + (size_t)pg8::modrow(row0) * 12288;
        f32x4 gs[4][2], sh[4][2];
#pragma unroll
        for (int j = 0; j < 4; ++j)
#pragma unroll
            for (int q = 0; q < 2; ++q) { const int c = 512 * j + 8 * lane + 4 * q;
                gs[j][q] = *(const f32x4*)(g + c) * (1.0f + *(const f32x4*)(mr + i_sc * D + c)); sh[j][q] = *(const f32x4*)(mr + i_sh * D + c); }
#pragma unroll 2
        for (int rr = 0; rr < 8; ++rr) {
            const int row = row0 + rr;
            f32x4 v[4][2]; float ss = 0.f;
            if (XF32) {
                const float* xr = row < NPR ? (const float*)xp + (size_t)row * D : (const float*)xs + (size_t)(row - NPR) * D;
#pragma unroll
                for (int j = 0; j < 4; ++j)
#pragma unroll
                    for (int q = 0; q < 2; ++q) v[j][q] = *(const f32x4*)(xr + 512 * j + 8 * lane + 4 * q);
            } else {
                const bf16* xr = (const bf16*)xp + (size_t)row * D;
                u32x4 w[4];
#pragma unroll
                for (int j = 0; j < 4; ++j) w[j] = *(const u32x4*)(xr + 512 * j + 8 * lane);
#pragma unroll
                for (int j = 0; j < 4; ++j) { v[j][0] = (f32x4){bflo(w[j].x), bfhi(w[j].x), bflo(w[j].y), bfhi(w[j].y)}; v[j][1] = (f32x4){bflo(w[j].z), bfhi(w[j].z), bflo(w[j].w), bfhi(w[j].w)}; }
            }
#pragma unroll
            for (int j = 0; j < 4; ++j)
#pragma unroll
                for (int q = 0; q < 2; ++q) ss += (v[j][q][0] * v[j][q][0] + v[j][q][1] * v[j][q][1]) + (v[j][q][2] * v[j][q][2] + v[j][q][3] * v[j][q][3]);
            const float rstd = __builtin_amdgcn_rsqf(wave_sum(ss) * (1.0f / D) + 1e-6f);
            if (XF32) {
#pragma unroll
                for (int j = 0; j < 4; ++j)
                    *(u32x4*)(xcopy + (size_t)row * D + 512 * j + 8 * lane) = (u32x4){cvtpk(v[j][0][0], v[j][0][1]), cvtpk(v[j][0][2], v[j][0][3]), cvtpk(v[j][1][0], v[j][1][1]), cvtpk(v[j][1][2], v[j][1][3])}; }
#pragma unroll
            for (int j = 0; j < 4; ++j) {
                const f32x4 o0 = v[j][0] * rstd * gs[j][0] + sh[j][0], o1 = v[j][1] * rstd * gs[j][1] + sh[j][1];
                *(u32x4*)(hout + (size_t)row * D + 512 * j + 8 * lane) = (u32x4){cvtpk(o0[0], o0[1]), cvtpk(o0[2], o0[3]), cvtpk(o1[0], o1[1]), cvtpk(o1[2], o1[3])};
            }
        }
    }
}
__device__ __forceinline__ void final_norm_phase(const Frame& F, const bf16* xb, float* y, const float* g) {
    const int gw = F.bid * 8 + F.wave, NGW = F.G * 8, lane = F.lane;
    for (int rg = gw; rg < M / 8; rg += NGW) {
        f32x4 gg[4][2];
#pragma unroll
        for (int j = 0; j < 4; ++j)
#pragma unroll
            for (int q = 0; q < 2; ++q) gg[j][q] = *(const f32x4*)(g + 512 * j + 8 * lane + 4 * q);
#pragma unroll 2
        for (int rr = 0; rr < 8; ++rr) {
            const bf16* xr = xb + (size_t)(rg * 8 + rr) * D;
            float* yr = y + (size_t)(rg * 8 + rr) * D;
            u32x4 w[4]; f32x4 v[4][2]; float ss = 0.f;
#pragma unroll
            for (int j = 0; j < 4; ++j) w[j] = *(const u32x4*)(xr + 512 * j + 8 * lane);
#pragma unroll
            for (int j = 0; j < 4; ++j) { v[j][0] = (f32x4){bflo(w[j].x), bfhi(w[j].x), bflo(w[j].y), bfhi(w[j].y)}; v[j][1] = (f32x4){bflo(w[j].z), bfhi(w[j].z), bflo(w[j].w), bfhi(w[j].w)};
#pragma unroll
                for (int q = 0; q < 2; ++q) ss += (v[j][q][0] * v[j][q][0] + v[j][q][1] * v[j][q][1]) + (v[j][q][2] * v[j][q][2] + v[j][q][3] * v[j][q][3]); }
            const float rstd = __builtin_amdgcn_rsqf(wave_sum(ss) * (1.0f / D) + 1e-6f);
#pragma unroll
            for (int j = 0; j < 4; ++j)
#pragma unroll
                for (int q = 0; q < 2; ++q) *(f32x4*)(yr + 512 * j + 8 * lane + 4 * q) = v[j][q] * rstd * gg[j][q];
        }
    }
}

__device__ __forceinline__ s16x4 vtr(const LAS unsigned char* p) { return __builtin_bit_cast(s16x4, __builtin_amdgcn_ds_read_tr16_b64_v4i16((LAS s16x4*)p)); }

struct AttnState { float m, l; f32x16 o[2]; };

__device__ __forceinline__ void attn_loadk(bf16x8 (&kf)[2][4], const bf16* kbase, size_t kstride, int lane) {
    const bf16* kp = kbase + (size_t)(lane & 31) * kstride + 8 * (lane >> 5);
#pragma unroll
    for (int kt = 0; kt < 2; ++kt)
#pragma unroll
        for (int ks = 0; ks < 4; ++ks) kf[kt][ks] = *(const bf16x8*)(kp + (size_t)(32 * kt) * kstride + 16 * ks);
}
template <bool HASB, class BIAS>
__device__ __forceinline__ void attend64(AttnState& st, const bf16x8 (&qf)[4], bf16x8 (&kf)[2][4], const bf16* knext, size_t knstride, const LAS unsigned char* vb, const BIAS& bias, int lane) {
    constexpr int NT = 2;
    const int h = lane >> 5;
    f32x16 s[NT];
#pragma unroll
    for (int kt = 0; kt < NT; ++kt) {
        f32x16 acc;
#pragma unroll
        for (int i = 0; i < 16; ++i) acc[i] = 0.f;
#pragma unroll
        for (int ks = 0; ks < 4; ++ks) acc = __builtin_amdgcn_mfma_f32_32x32x16_bf16(kf[kt][ks], qf[ks], acc, 0, 0, 0);
        s[kt] = acc;
    }
    if (knext) attn_loadk(kf, knext, knstride, lane);
    float gm = -3.0e38f;
#pragma unroll
    for (int kt = 0; kt < NT; ++kt)
#pragma unroll
        for (int i = 0; i < 16; ++i) {
            float v = s[kt][i] * (0.125f * 1.4426950408889634f);
            if (HASB) v = bias(kt, (i & 3) + 8 * (i >> 2), v);
            s[kt][i] = v; gm = fmaxf(gm, v);
        }
    gm = fmaxf(gm, xor32(gm, lane));
    const float mnew = fmaxf(st.m, gm);
    const float alpha = __builtin_amdgcn_exp2f(st.m - mnew);
    float ps = 0.f;
#pragma unroll
    for (int kt = 0; kt < NT; ++kt)
#pragma unroll
        for (int i = 0; i < 16; ++i) { const float p = __builtin_amdgcn_exp2f(s[kt][i] - mnew); s[kt][i] = p; ps += p; }
    st.l = st.l * alpha + ps; st.m = mnew;
#pragma unroll
    for (int i = 0; i < 16; ++i) { st.o[0][i] *= alpha; st.o[1][i] *= alpha; }
    const int i16 = lane & 15, tq = i16 >> 2, tp = i16 & 3, blk = (lane >> 4) & 1;
#pragma unroll
    for (int kt = 0; kt < NT; ++kt) {
#pragma unroll
        for (int ss = 0; ss < 2; ++ss) {
            u32x4 pw; pw.x = cvtpk(s[kt][8 * ss + 0], s[kt][8 * ss + 1]); pw.y = cvtpk(s[kt][8 * ss + 2], s[kt][8 * ss + 3]); pw.z = cvtpk(s[kt][8 * ss + 4], s[kt][8 * ss + 5]); pw.w = cvtpk(s[kt][8 * ss + 6], s[kt][8 * ss + 7]);
            const bf16x8 pf = __builtin_bit_cast(bf16x8, pw);
#pragma unroll
            for (int dt = 0; dt < 2; ++dt) {
                const LAS unsigned char* p0 = vb + kt * 4096 + (16 * ss + 4 * h + tq) * 128 + (dt * 32 + 16 * blk + 4 * tp) * 2;
                const s16x4 lo = vtr(p0), hi = vtr(p0 + 8 * 128);
                const bf16x8 vf = __builtin_shufflevector(lo, hi, 0, 1, 2, 3, 4, 5, 6, 7);
                st.o[dt] = __builtin_amdgcn_mfma_f32_32x32x16_bf16(vf, pf, st.o[dt], 0, 0, 0);
            }
        }
    }
}

__device__ __forceinline__ void attn_store(const AttnState& st, bf16* orow  , int lane) {
    const int h = lane >> 5;
    const float lt = st.l + xor32(st.l, lane);
    const float inv = 1.0f / lt;
#pragma unroll
    for (int dt = 0; dt < 2; ++dt)
#pragma unroll
        for (int g = 0; g < 4; ++g) {
            const u32x2 w = (u32x2){cvtpk(st.o[dt][4 * g] * inv, st.o[dt][4 * g + 1] * inv), cvtpk(st.o[dt][4 * g + 2] * inv, st.o[dt][4 * g + 3] * inv)};
            *(u32x2*)(orow + dt * 32 + 8 * g + 4 * h) = w;
        }
}

__device__ __forceinline__ void attention_phase(const Frame& F, const Args& a, int layer) {
    unsigned char* ws = WSP(F);
    const bf16* proj = (const bf16*)(ws + WS_PROJ);
    bf16* oall = (bf16*)(ws + WS_OALL);
    const int lane = F.lane, w = F.wave, r = lane & 31, h = lane >> 5;
    LAS unsigned char* lds = F.lds;
    LAS float* rpbl = (LAS float*)(lds + 122880);
    for (int u = F.bid; u < 1024; u += F.G) {
        __syncthreads();
        if (u < 512) {
            const int b = u >> 4, hd = u & 15;
            const int tok0 = b * 256;
            bf16x8 qf[4];
            { const bf16* qp = proj + (size_t)(tok0 + 32 * w + r) * NPROJ + hd * 64 + 8 * h;
#pragma unroll
              for (int ks = 0; ks < 4; ++ks) qf[ks] = *(const bf16x8*)(qp + 16 * ks); }
            const bf16* kbase = proj + (size_t)tok0 * NPROJ + COL_K + hd * 64;
            bf16x8 kf[2][4];
            attn_loadk(kf, kbase, (size_t)NPROJ, lane);
            for (int i = F.tid; i < 256 * 8; i += 512) { const int key = i >> 3, pc = i & 7;
                *(LAS u32x4*)(lds + key * 128 + pc * 16) = *(const u32x4*)(proj + (size_t)(tok0 + key) * NPROJ + COL_V + hd * 64 + pc * 8); }
            __syncthreads();
            AttnState st; st.m = -3.0e38f; st.l = 0.f;
#pragma unroll
            for (int i = 0; i < 16; ++i) { st.o[0][i] = 0.f; st.o[1][i] = 0.f; }
#pragma unroll 1
            for (int kg = 0; kg < 4; ++kg)
                attend64<false>(st, qf, kf, kg < 3 ? kbase + (size_t)(64 * (kg + 1)) * NPROJ : nullptr, (size_t)NPROJ, lds + kg * 8192, [&](int, int, float v) { return v; }, lane);
            attn_store(st, oall + (size_t)(tok0 + 32 * w + r) * 3072 + hd * 64, lane);
        } else {
            const int uu = u - 512, b = uu >> 7, hd = (uu >> 3) & 15, rg = uu & 7;
            const int tokb = NPR + b * 2048;
            int rlo = 4 * rg - 4; rlo = rlo < 0 ? 0 : (rlo > 24 ? 24 : rlo);
            int rhi0 = 4 * rg + 3 - 4; rhi0 = rhi0 < 0 ? 0 : (rhi0 > 24 ? 24 : rhi0); const int nr = rhi0 + 8 - rlo;
            const int qrow = 4 * rg + (w >> 1), qc = (w & 1) * 32 + r;
            int r0 = qrow - 4; r0 = r0 < 0 ? 0 : (r0 > 24 ? 24 : r0);
            const int qtok = tokb + qrow * 64 + (w & 1) * 32 + r;
            bf16x8 qf[4];
            { const bf16* qp = proj + (size_t)qtok * NPROJ + hd * 64 + 8 * h;
#pragma unroll
              for (int ks = 0; ks < 4; ++ks) qf[ks] = *(const bf16x8*)(qp + 16 * ks); }
            const bf16* kloc = proj + (size_t)tokb * NPROJ + COL_K + hd * 64;
            bf16x8 kf[2][4];
            attn_loadk(kf, kloc + (size_t)(r0 * 64) * NPROJ, (size_t)NPROJ, lane);
            for (int i = F.tid; i < nr * 64 * 8; i += 512) { const int key = i >> 3, pc = i & 7;
                *(LAS u32x4*)(lds + key * 128 + pc * 16) = *(const u32x4*)(proj + (size_t)(tokb + rlo * 64 + key) * NPROJ + COL_V + hd * 64 + pc * 8); }
            const bf16* cv = (const bf16*)(ws + WS_CV) + ((size_t)(b * 4 + layer) * 256) * 1024 + hd * 64;
            const bf16* ck = (const bf16*)(ws + WS_CK) + ((size_t)(b * 4 + layer) * 256) * 1024 + hd * 64;
            for (int i = F.tid; i < 256 * 8; i += 512) { const int key = i >> 3, pc = i & 7;
                *(LAS u32x4*)(lds + 90112 + key * 128 + pc * 16) = *(const u32x4*)(cv + (size_t)key * 1024 + pc * 8); }
            for (int i = F.tid; i < 465; i += 512) rpbl[i] = INP(F, I_RPB)[((size_t)layer * 16 + hd) * 465 + i] * 1.4426950408889634f;
            __syncthreads();
            int c0 = qc - 8; c0 = c0 < 0 ? 0 : (c0 > 48 ? 48 : c0);
            AttnState st; st.m = -3.0e38f; st.l = 0.f;
#pragma unroll
            for (int i = 0; i < 16; ++i) { st.o[0][i] = 0.f; st.o[1][i] = 0.f; }
#pragma unroll 1
            for (int grp = 0; grp < 12; ++grp) {
                const bf16* knext = grp < 7 ? kloc + (size_t)((r0 + grp + 1) * 64) * NPROJ : (grp < 11 ? ck + (size_t)((grp - 7) * 64) * 1024 : nullptr);
                const size_t knstride = grp < 7 ? (size_t)NPROJ : (size_t)1024;
                if (grp < 8) { const int kr = r0 + grp;
                    const int cb = c0 - 4 * h; const LAS float* rb = rpbl + (kr - qrow + 7) * 31 + (4 * h - qc + 15);
                    attend64<true>(st, qf, kf, knext, knstride, lds + ((kr - rlo) * 64) * 128,
                        [&](int kt, int ci, float v) { const unsigned d = (unsigned)(kt * 32 + ci - cb); const float bv = rb[kt * 32 + ci]; return d < 16u ? v + bv : -1.0e30f; }, lane);
                } else attend64<false>(st, qf, kf, knext, knstride, lds + 90112 + (grp - 8) * 8192, [&](int, int, float v) { return v; }, lane);
            }
            attn_store(st, oall + (size_t)qtok * 3072 + hd * 64, lane);
        }
    }
    __syncthreads();
}

__device__ __forceinline__ float row_sum16(float v) { v += DPPF(v, 0xB1); v += DPPF(v, 0x4E); v += DPPF(v, 0x141); v += DPPF(v, 0x140); return v; }
__device__ __forceinline__ f32x4 unpack4(u32x2 w) { return (f32x4){bflo(w.x), bfhi(w.x), bflo(w.y), bfhi(w.y)}; }
__device__ __forceinline__ u32x2 pack4(f32x4 v) { return (u32x2){cvtpk(v[0], v[1]), cvtpk(v[2], v[3])}; }
__device__ __forceinline__ void rwkv_tinv_pair(const Frame& F, int run, int hd) {
    unsigned char* ws = WSP(F);
    const bf16* til = (const bf16*)(ws + WS_TIL);
    bf16* tinv = (bf16*)(ws + WS_TINV);
    int lane = lane_id(); asm volatile("" : "+v"(lane));
    const int r = lane & 31, h = lane >> 5;
    LAS float* Lw = (LAS float*)(F.lds + F.wave * 16384);
#pragma unroll 1
    for (int e = 0; e < 2; ++e) {
        const size_t tok = (size_t)(run * 32 + (e ? 31 - r : r));
        const bf16* rowp = til + (tok * 16 + hd) * TILP + e * 256 + 8 * h;
        f32x16 acc;
#pragma unroll
        for (int i = 0; i < 16; ++i) acc[i] = 0.f;
        bf16x8 bfr[4], afr[4];
#pragma unroll
        for (int ks = 0; ks < 4; ++ks) { afr[ks] = *(const bf16x8*)(rowp + 16 * ks); bfr[ks] = *(const bf16x8*)(rowp + 64 + 16 * ks); }
#pragma unroll
        for (int ks = 0; ks < 4; ++ks) acc = __builtin_amdgcn_mfma_f32_32x32x16_bf16(bfr[ks], afr[ks], acc, 0, 0, 0);
#pragma unroll
        for (int g = 0; g < 4; ++g) { const int j0 = 8 * g + 4 * h; f32x4 v;
#pragma unroll
            for (int q = 0; q < 4; ++q) v[q] = (j0 + q < r) ? acc[4 * g + q] : 0.f;
            *(LAS f32x4*)(Lw + e * 1152 + r * 36 + j0) = v; }
    }
    LDS_WAIT(); asm volatile("" ::: "memory");
    {   const LAS float* Lh = Lw + h * 1152;
        float X[32];
#pragma unroll
        for (int i = 0; i < 32; ++i) {
            float s = (i == r) ? 1.f : 0.f;
#pragma unroll
            for (int jq = 0; jq < (i + 3) / 4; ++jq) { const f32x4 lv = *(const LAS f32x4*)(Lh + i * 36 + 4 * jq);
#pragma unroll
                for (int q = 0; q < 4; ++q) if (4 * jq + q < i) s += lv[q] * X[4 * jq + q]; }
            X[i] = s;
        }
        bf16* o = tinv + (size_t)((run << 5) | (h << 4) | hd) * 1024 + r;
#pragma unroll
        for (int i = 0; i < 32; ++i) o[i * 32] = f2bf(X[i]);
    }
    LDS_WAIT(); asm volatile("" ::: "memory");
}

__device__ __forceinline__ f32x4 exp4(f32x4 x) { return (f32x4){__expf(x[0]), __expf(x[1]), __expf(x[2]), __expf(x[3])}; }
__device__ __forceinline__ f32x4 rcp4(f32x4 x) { return (f32x4){__builtin_amdgcn_rcpf(x[0]), __builtin_amdgcn_rcpf(x[1]), __builtin_amdgcn_rcpf(x[2]), __builtin_amdgcn_rcpf(x[3])}; }
__device__ __forceinline__ void rwkv_prep_phase(const Frame& F, const Args& a, int layer) {
    unsigned char* ws = WSP(F);
    const bf16* proj = (const bf16*)(ws + WS_PROJ);
    const bf16* abuf = (const bf16*)(ws + WS_A);
    const bf16* logw = (const bf16*)(ws + WS_DEC);
    bf16* til = (bf16*)(ws + WS_TIL);
    float* bonus = (float*)(ws + WS_BONUS);
    float* wtb = (float*)(ws + WS_WTB);
    const float* cw = INP(F, I_CW) + (size_t)layer * 3 * 3072; const float* cb = INP(F, I_CB) + (size_t)layer * 3072;
    for (int item = F.wave * F.G + F.bid; item < 2048; item += 8 * F.G) {
        int lane = lane_id(); asm volatile("" : "+v"(lane));
        const int run = item >> 2, tok0 = run * 32, cg = item & 3, c4 = cg * 256 + 4 * lane, head = cg * 4 + (lane >> 4), hl = 4 * (lane & 15);
        const int t0 = tok0 < NPR ? (tok0 & 255) : ((tok0 - NPR) & 2047), L = tok0 < NPR ? L_P : L_S;
        const f32x4 kkw = *(const f32x4*)(INP(F, I_KK) + layer * 1024 + c4), kaw = *(const f32x4*)(INP(F, I_KA) + layer * 1024 + c4), rkw = *(const f32x4*)(INP(F, I_RK) + layer * 1024 + c4);
        f32x4 tot1 = (f32x4){0.f, 0.f, 0.f, 0.f};
        {   u32x2 t[32];
#pragma unroll
            for (int i = 0; i < 32; ++i) t[i] = *(const u32x2*)(logw + ((size_t)(tok0 + i) * 2 + 1) * 1024 + c4);
#pragma unroll
            for (int i = 0; i < 32; ++i) tot1 += unpack4(t[i]); }
        f32x4 pre0 = (f32x4){0.f, 0.f, 0.f, 0.f}, pre1 = pre0, e0prev = (f32x4){1.f, 1.f, 1.f, 1.f};
        const bf16* pbase = proj + (size_t)tok0 * NPROJ + COL_R + c4;
#pragma unroll 1
        for (int ch = 0; ch < 8; ++ch) {
            const float* cwp = cw; const float* cbp = cb; asm volatile("" : "+s"(cwp), "+s"(cbp));
            f32x4 w[3][3], bs[3];
#pragma unroll
            for (int s = 0; s < 3; ++s) { bs[s] = *(const f32x4*)(cbp + s * 1024 + c4);
#pragma unroll
                for (int tp = 0; tp < 3; ++tp) w[s][tp] = *(const f32x4*)(cwp + tp * 3072 + s * 1024 + c4); }
            u32x2 rows[6][3], av[4][2]; f32x4 lw[4][2];
#pragma unroll
            for (int i = 0; i < 6; ++i) { const int tt = ch * 4 + i - 1, t = t0 + tt; const bool ok = (t >= 0) && (t < L);
#pragma unroll
                for (int s = 0; s < 3; ++s) rows[i][s] = ok ? *(const u32x2*)(pbase + (long)tt * NPROJ + s * 1024) : (u32x2){0u, 0u}; }
#pragma unroll
            for (int i = 0; i < 4; ++i) { const size_t tok = (size_t)(tok0 + ch * 4 + i); av[i][0] = *(const u32x2*)(abuf + (tok * 2 + 0) * 1024 + c4); av[i][1] = *(const u32x2*)(abuf + (tok * 2 + 1) * 1024 + c4);
                lw[i][0] = unpack4(*(const u32x2*)(logw + (tok * 2 + 0) * 1024 + c4)); lw[i][1] = unpack4(*(const u32x2*)(logw + (tok * 2 + 1) * 1024 + c4)); }
#pragma unroll
            for (int i = 0; i < 4; ++i) {
                const size_t tok = (size_t)(tok0 + ch * 4 + i);
                f32x4 x[3];
#pragma unroll
                for (int s = 0; s < 3; ++s) x[s] = unpack4(rows[i][s]) * w[s][0] + unpack4(rows[i + 1][s]) * w[s][1] + unpack4(rows[i + 2][s]) * w[s][2] + bs[s];
                const f32x4 rr = x[0], k0 = x[1], vv = x[2];
                f32x4 kk = k0 * kkw;
                const float ssq = row_sum16((kk[0] * kk[0] + kk[1] * kk[1]) + (kk[2] * kk[2] + kk[3] * kk[3]));
                kk = kk * __builtin_amdgcn_rsqf(ssq + 1e-12f);
                const f32x4 a0 = unpack4(av[i][0]), a1 = unpack4(av[i][1]);
                const f32x4 kd0 = k0 * (1.0f + (a0 - 1.0f) * kaw), kd1 = k0 * (1.0f + (a1 - 1.0f) * kaw);
                const f32x4 rk = rr * k0 * rkw;
                const float bsum = row_sum16((rk[0] + rk[1]) + (rk[2] + rk[3]));
                pre0 += lw[i][0];
                const f32x4 e0 = exp4(pre0), ie0 = rcp4(e0);
                const f32x4 l1 = tot1 - pre1; pre1 += lw[i][1];
                const f32x4 e1 = exp4(l1), ie1 = rcp4(e1), e1prev = exp4(l1 - lw[i][1]);
                bf16* o = til + (tok * 16 + head) * TILP + hl;
                *(u32x2*)(o) = pack4(-kk * e0prev); *(u32x2*)(o + 64) = pack4(kk * a0 * ie0); *(u32x2*)(o + 128) = pack4(kd0 * ie0); *(u32x2*)(o + 192) = pack4(rr * e0);
                *(u32x2*)(o + 256) = pack4(-kk * e1prev); *(u32x2*)(o + 320) = pack4(kk * a1 * ie1); *(u32x2*)(o + 384) = pack4(kd1 * ie1); *(u32x2*)(o + 448) = pack4(rr * e1);
                *(u32x2*)(o + 512) = pack4(vv);
                e0prev = e0;
                if ((lane & 15) == 0) bonus[tok * 16 + head] = bsum;
            }
        }
        *(f32x4*)(wtb + (((size_t)run * 2 + 0) * 16 + head) * 64 + hl) = exp4(pre0);
        *(f32x4*)(wtb + (((size_t)run * 2 + 1) * 16 + head) * 64 + hl) = exp4(tot1);
        asm volatile("s_waitcnt vmcnt(0)" ::: "memory");
#pragma unroll 1
        for (int uu = 0; uu < 4; ++uu) rwkv_tinv_pair(F, run, cg * 4 + uu);
    }
}

__device__ __forceinline__ bf16x8 packf(const f32x16& x, int s) {
    u32x4 p; p.x = cvtpk(x[8 * s + 0], x[8 * s + 1]); p.y = cvtpk(x[8 * s + 2], x[8 * s + 3]); p.z = cvtpk(x[8 * s + 4], x[8 * s + 5]); p.w = cvtpk(x[8 * s + 6], x[8 * s + 7]);
    return __builtin_bit_cast(bf16x8, p);
}
#define MFMA32(a, b, c) __builtin_amdgcn_mfma_f32_32x32x16_bf16((a), (b), (c), 0, 0, 0)

__device__ __forceinline__ void glds16(const void* gsrc, unsigned lds_dst) { unsigned keep;
    asm volatile("s_mov_b32 %0, m0\n\ts_mov_b32 m0, %2\n\ts_nop 0\n\tglobal_load_lds_dwordx4 %1, off\n\ts_mov_b32 m0, %0" : "=&s"(keep) : "v"(gsrc), "s"(lds_dst) : "memory"); }
template <int V> struct IC { static constexpr int value = V; };
__device__ __forceinline__ void hyena_post_phase(const Frame& F, const Args& a, int layer, LAS bf16* tl, int gw, int NGW);
constexpr int CS_BUF = 23552, CS_AT = 0, CS_BT = 4096, CS_KT = 8192, CS_RT = 12288, CS_VV = 16384, CS_TI = 20480, CS_WT = 22528;
__device__ __forceinline__ void rwkv_cscan_phase(const Frame& F, const Args& a, int layer) {
    if (F.wave >= 2) {
        if (F.wave == 4 || F.wave == 5) return;
        const int sw = F.wave < 4 ? F.wave - 2 : F.wave - 4;
        {   LAS bf16* sl = (LAS bf16*)(F.lds + 4 * CS_BUF + sw * 8704);
            hyena_post_phase(F, a, layer, sl, F.bid * 4 + sw, F.G * 4); }
        convert_layer(F, layer, nullptr, F.bid * 4 + sw, F.G * 4, 2);
        if (layer + 1 < DEPTH) convert_layer(F, layer + 1, nullptr, F.bid * 4 + sw, F.G * 4, 1);
        return; }
    __builtin_amdgcn_s_setprio(3);
    unsigned char* ws = WSP(F);
    const bf16* til = (const bf16*)(ws + WS_TIL);
    const bf16* tinv = (const bf16*)(ws + WS_TINV);
    const float* wtb = (const float*)(ws + WS_WTB);
    float* Y = (float*)(ws + WS_H);
    const int lane = F.lane, r = lane & 31, h = lane >> 5;
    const int i16 = lane & 15, tq = i16 >> 2, tp = i16 & 3, blk = (lane >> 4) & 1;
    LAS unsigned char* lbase = F.lds + F.wave * (2 * CS_BUF);
    const int slot = F.wave * F.G + F.bid, nslot = 2 * F.G;
    const int nsamp = 256;
    for (int item = slot; item < 2304; item += (slot < nsamp) ? 2304 : (nslot - nsamp)) {
        const bool sample = item < 256; const int hc = sample ? item : item - 256, chain = hc >> 1, vt = hc & 1;
        const int hd = chain & 15, e = (chain >> 4) & 1, b = chain >> 5;
        const int NC = sample ? (L_S / 32) : (L_P / 32), tokb = sample ? NPR + b * L_S : b * L_P;
        f32x16 ST[2];
        if (sample) { const float* s0 = INP(F, I_ST) + ((((size_t)b * 4 + layer) * 2 + e) * 16 + hd) * 4096;
#pragma unroll
            for (int kt = 0; kt < 2; ++kt)
#pragma unroll
                for (int g = 0; g < 4; ++g) { const f32x4 v = *(const f32x4*)(s0 + (32 * vt + r) * 64 + 32 * kt + 8 * g + 4 * h);
                    ST[kt][4 * g] = v[0]; ST[kt][4 * g + 1] = v[1]; ST[kt][4 * g + 2] = v[2]; ST[kt][4 * g + 3] = v[3]; }
        } else {
#pragma unroll
            for (int kt = 0; kt < 2; ++kt)
#pragma unroll
                for (int i = 0; i < 16; ++i) ST[kt][i] = 0.f;
        }
#define CS_DMA(C, BUFP) do { const int run_ = (tokb >> 5) + (e ? NC - 1 - (C) : (C)); int ln_ = lane_id(); asm volatile("" : "+v"(ln_));     \
            const unsigned lb_ = (unsigned)(size_t)(BUFP); \
            _Pragma("unroll") for (int i_ = 0; i_ < 4; ++i_) { const int q_ = ln_ + 64 * i_, p_ = q_ >> 3, cc_ = q_ & 7; \
                const bf16* g_ = til + ((size_t)(run_ * 32 + (e ? 31 - p_ : p_)) * 16 + hd) * TILP + e * 256 + 8 * cc_; \
                glds16(g_, lb_ + CS_AT + i_ * 1024); glds16(g_ + 64, lb_ + CS_BT + i_ * 1024); glds16(g_ + 128, lb_ + CS_KT + i_ * 1024); glds16(g_ + 192, lb_ + CS_RT + i_ * 1024); \
                glds16(g_ - e * 256 + 512, lb_ + CS_VV + i_ * 1024); } \
            const size_t unit_ = ((size_t)run_ * 2 + e) * 16 + hd; \
            _Pragma("unroll") for (int i_ = 0; i_ < 2; ++i_) glds16(tinv + unit_ * 1024 + (ln_ + 64 * i_) * 8, lb_ + CS_TI + i_ * 1024); \
            glds16(wtb + unit_ * 64 + (ln_ & 15) * 4, lb_ + CS_WT); } while (0)
        CS_DMA(0, lbase);
        auto chunk = [&](auto bi_, int c) __attribute__((always_inline)) {
            constexpr int BI = decltype(bi_)::value;
            const LAS unsigned char* B = lbase + BI * CS_BUF;
            if (c == 0) asm volatile("s_waitcnt vmcnt(0)" ::: "memory");
            else asm volatile("s_waitcnt vmcnt(16)" ::: "memory");
            if (c + 1 < NC) CS_DMA(c + 1, lbase + (1 - BI) * CS_BUF);
            bf16x8 nkaF[2], nbrF[2], nkrF[2];
#define CS_NMAT(OUTF, OFFA, OFFB, STRICT) do { f32x16 n_; _Pragma("unroll") for (int i = 0; i < 16; ++i) n_[i] = 0.f; \
                    _Pragma("unroll") for (int ks = 0; ks < 4; ++ks) { const int o = r * 128 + (16 * ks + 8 * h) * 2; \
                        n_ = MFMA32(*(const LAS bf16x8*)(B + (OFFA) + o), *(const LAS bf16x8*)(B + (OFFB) + o), n_); } \
                    _Pragma("unroll") for (int i = 0; i < 16; ++i) { const int row = (i & 3) + 8 * (i >> 2) + 4 * h; n_[i] = ((STRICT) ? (row < r) : (row <= r)) ? n_[i] : 0.f; } \
                    OUTF[0] = packf(n_, 0); OUTF[1] = packf(n_, 1); } while (0)
            CS_NMAT(nkaF, CS_KT, CS_AT, true);
            CS_NMAT(nbrF, CS_BT, CS_RT, false);
            CS_NMAT(nkrF, CS_KT, CS_RT, false);
#undef CS_NMAT
            const unsigned tra = (unsigned)(size_t)(B) + (4 * h + tq) * 128 + (16 * blk + 4 * tp) * 2 + vt * 64;
            const unsigned trk = (unsigned)(size_t)(B) + (4 * h + tq) * 128 + (16 * blk + 4 * tp) * 2;
            bf16x8 vvF[2], btF[2][2], ktF[2][2];
            {   s16x4 t_[20];
                asm volatile("ds_read_b64_tr_b16 %0, %20 offset:%22\n\tds_read_b64_tr_b16 %1, %20 offset:%22+1024\n\tds_read_b64_tr_b16 %2, %20 offset:%22+2048\n\tds_read_b64_tr_b16 %3, %20 offset:%22+3072\n\t"
                             "ds_read_b64_tr_b16 %4, %21 offset:%23\n\tds_read_b64_tr_b16 %5, %21 offset:%23+1024\n\tds_read_b64_tr_b16 %6, %21 offset:%23+2048\n\tds_read_b64_tr_b16 %7, %21 offset:%23+3072\n\t"
                             "ds_read_b64_tr_b16 %8, %21 offset:%23+64\n\tds_read_b64_tr_b16 %9, %21 offset:%23+64+1024\n\tds_read_b64_tr_b16 %10, %21 offset:%23+64+2048\n\tds_read_b64_tr_b16 %11, %21 offset:%23+64+3072\n\t"
                             "ds_read_b64_tr_b16 %12, %21 offset:%24\n\tds_read_b64_tr_b16 %13, %21 offset:%24+1024\n\tds_read_b64_tr_b16 %14, %21 offset:%24+2048\n\tds_read_b64_tr_b16 %15, %21 offset:%24+3072\n\t"
                             "ds_read_b64_tr_b16 %16, %21 offset:%24+64\n\tds_read_b64_tr_b16 %17, %21 offset:%24+64+1024\n\tds_read_b64_tr_b16 %18, %21 offset:%24+64+2048\n\tds_read_b64_tr_b16 %19, %21 offset:%24+64+3072\n\ts_waitcnt lgkmcnt(0)"
                             : "=&v"(t_[0]), "=&v"(t_[1]), "=&v"(t_[2]), "=&v"(t_[3]), "=&v"(t_[4]), "=&v"(t_[5]), "=&v"(t_[6]), "=&v"(t_[7]), "=&v"(t_[8]), "=&v"(t_[9]),
                               "=&v"(t_[10]), "=&v"(t_[11]), "=&v"(t_[12]), "=&v"(t_[13]), "=&v"(t_[14]), "=&v"(t_[15]), "=&v"(t_[16]), "=&v"(t_[17]), "=&v"(t_[18]), "=&v"(t_[19])
                             : "v"(tra), "v"(trk), "n"(CS_VV), "n"(CS_BT), "n"(CS_KT));
#define CS_FR(I) (bf16x8)__builtin_shufflevector(t_[I], t_[I + 1], 0, 1, 2, 3, 4, 5, 6, 7)
                vvF[0] = CS_FR(0); vvF[1] = CS_FR(2); btF[0][0] = CS_FR(4); btF[0][1] = CS_FR(6); btF[1][0] = CS_FR(8); btF[1][1] = CS_FR(10);
                ktF[0][0] = CS_FR(12); ktF[0][1] = CS_FR(14); ktF[1][0] = CS_FR(16); ktF[1][1] = CS_FR(18);
#undef CS_FR
            }
#define CS_APERM(OFF, KT, S) ({ const LAS unsigned char* p_ = B + (OFF) + r * 128 + (32 * (KT) + 16 * (S) + 4 * h) * 2; \
                const u32x2 lo_ = *(const LAS u32x2*)p_, hi_ = *(const LAS u32x2*)(p_ + 16); __builtin_bit_cast(bf16x8, (u32x4){lo_.x, lo_.y, hi_.x, hi_.y}); })
            bf16x8 uF[2];
            f32x16 rhsB, yC, stK[2];
#pragma unroll
            for (int i = 0; i < 16; ++i) { rhsB[i] = 0.f; yC[i] = 0.f; stK[0][i] = 0.f; stK[1][i] = 0.f; }
#pragma unroll
            for (int s = 0; s < 2; ++s) { rhsB = MFMA32(nkaF[s], vvF[s], rhsB); yC = MFMA32(nkrF[s], vvF[s], yC); stK[0] = MFMA32(ktF[0][s], vvF[s], stK[0]); stK[1] = MFMA32(ktF[1][s], vvF[s], stK[1]); }
            {   f32x16 rhs = rhsB;
#pragma unroll
                for (int kt = 0; kt < 2; ++kt)
#pragma unroll
                    for (int s = 0; s < 2; ++s) rhs = MFMA32(CS_APERM(CS_AT, kt, s), packf(ST[kt], s), rhs);
                f32x16 u;
#pragma unroll
                for (int i = 0; i < 16; ++i) u[i] = 0.f;
#pragma unroll
                for (int s = 0; s < 2; ++s) { const LAS unsigned char* p_ = B + CS_TI + r * 64 + (16 * s + 4 * h) * 2;
                    const u32x2 lo_ = *(const LAS u32x2*)p_, hi_ = *(const LAS u32x2*)(p_ + 16);
                    u = MFMA32(__builtin_bit_cast(bf16x8, (u32x4){lo_.x, lo_.y, hi_.x, hi_.y}), packf(rhs, s), u); }
                uF[0] = packf(u, 0); uF[1] = packf(u, 1);
            }
            {   const int run = (tokb >> 5) + (e ? NC - 1 - c : c);
                f32x16 y = yC;
#pragma unroll
                for (int kt = 0; kt < 2; ++kt)
#pragma unroll
                    for (int s = 0; s < 2; ++s) y = MFMA32(CS_APERM(CS_RT, kt, s), packf(ST[kt], s), y);
#pragma unroll
                for (int s = 0; s < 2; ++s) y = MFMA32(nbrF[s], uF[s], y);
#pragma unroll
                for (int i = 0; i < 16; ++i) { const int p = (i & 3) + 8 * (i >> 2) + 4 * h; const size_t tok = (size_t)(run * 32 + (e ? 31 - p : p));
                    Y[((size_t)e * M + tok) * 1024 + hd * 64 + 32 * vt + r] = y[i]; }
            }
#pragma unroll
            for (int kt = 0; kt < 2; ++kt) {
                f32x4 wt[4];
#pragma unroll
                for (int g = 0; g < 4; ++g) wt[g] = *(const LAS f32x4*)(B + CS_WT + (32 * kt + 8 * g + 4 * h) * 4);
#pragma unroll
                for (int s = 0; s < 2; ++s) ST[kt] = MFMA32(btF[kt][s], uF[s], ST[kt]);
#pragma unroll
                for (int i = 0; i < 16; ++i) ST[kt][i] = (ST[kt][i] + stK[kt][i]) * wt[i >> 2][i & 3];
            }
        };
#pragma unroll 1
        for (int c2 = 0; c2 < NC; c2 += 2) { chunk(IC<0>{}, c2); chunk(IC<1>{}, c2 + 1); }
#undef CS_APERM
#undef CS_DMA
        if (!sample) { float* so = OUTP(F) + OUT_ST + ((((size_t)b * 4 + layer) * 2 + e) * 16 + hd) * 4096;
#pragma unroll
            for (int kt = 0; kt < 2; ++kt)
#pragma unroll
                for (int g = 0; g < 4; ++g) *(f32x4*)(so + (32 * vt + r) * 64 + 32 * kt + 8 * g + 4 * h) = (f32x4){ST[kt][4 * g], ST[kt][4 * g + 1], ST[kt][4 * g + 2], ST[kt][4 * g + 3]};
        }
    }
    asm volatile("s_waitcnt vmcnt(0)" ::: "memory");
    __builtin_amdgcn_s_setprio(0);
}

__device__ __forceinline__ void rwkv_post_phase(const Frame& F, const Args& a, int layer) {
    unsigned char* ws = WSP(F);
    const float* Y = (const float*)(ws + WS_H);
    const bf16* til = (const bf16*)(ws + WS_TIL); const bf16* gbuf = (const bf16*)(ws + WS_G); const float* bonus = (const float*)(ws + WS_BONUS);
    bf16* oall = (bf16*)(ws + WS_OALL);
    const int lane = F.lane;
    for (int item = F.wave * F.G + F.bid; item < 2048; item += 8 * F.G) {
        const int tok0 = (item >> 2) * 32, cg = item & 3, c4 = cg * 256 + 4 * lane, head = cg * 4 + (lane >> 4), hl = 4 * (lane & 15);
        const f32x4 gng = *(const f32x4*)(INP(F, I_GNG) + layer * 1024 + c4), gnb = *(const f32x4*)(INP(F, I_GNB) + layer * 1024 + c4);
#pragma unroll 1
        for (int ch = 0; ch < 4; ++ch) {
            f32x4 y0[8], y1[8]; u32x2 vw[8], gw[8]; float bn[8];
#pragma unroll
            for (int i = 0; i < 8; ++i) { const size_t tok = (size_t)(tok0 + ch * 8 + i);
                y0[i] = __builtin_nontemporal_load((const f32x4*)(Y + tok * 1024 + c4)); y1[i] = __builtin_nontemporal_load((const f32x4*)(Y + ((size_t)M + tok) * 1024 + c4));
                vw[i] = *(const u32x2*)(til + (tok * 16 + head) * TILP + 512 + hl); gw[i] = *(const u32x2*)(gbuf + tok * 1024 + c4); bn[i] = bonus[tok * 16 + head]; }
#pragma unroll
            for (int i = 0; i < 8; ++i) { const size_t tok = (size_t)(tok0 + ch * 8 + i);
                const f32x4 y = y0[i] + y1[i];
                const float mu = row_sum16((y[0] + y[1]) + (y[2] + y[3])) * (1.0f / 64.0f);
                const f32x4 dd = y - mu;
                const float var = row_sum16((dd[0] * dd[0] + dd[1] * dd[1]) + (dd[2] * dd[2] + dd[3] * dd[3])) * (1.0f / 64.0f);
                const f32x4 yn = dd * __builtin_amdgcn_rsqf(var + 64e-5f) * gng + gnb;
                const f32x4 o = (yn + bn[i] * unpack4(vw[i])) * unpack4(gw[i]);
                *(u32x2*)(oall + tok * 3072 + 1024 + c4) = pack4(o);
            }
        }
    }
}

__device__ __forceinline__ void hyena_prep_phase(const Frame& F, const Args& a, int layer) {
    unsigned char* ws = WSP(F);
    const bf16* proj = (const bf16*)(ws + WS_PROJ);
    bf16* zT = (bf16*)(ws + WS_ZT);
    const float* cw = INP(F, I_HCW) + (size_t)layer * 3 * 3072; const float* cb = INP(F, I_HCB) + (size_t)layer * 3072;
    const int gw = F.bid * 8 + F.wave, NGW = F.G * 8, lane = F.lane, tsub = lane >> 4, cq = lane & 15;
    LAS bf16* tl = (LAS bf16*)(F.lds + F.wave * 16384);
    for (int it = gw; it < 256 * 16; it += NGW) {
        const int tt0 = (it >> 4) * 64, c0 = (it & 15) * 64, c4 = c0 + 4 * cq;
        const int t0 = tt0 < NPR ? (tt0 & 255) : ((tt0 - NPR) & 2047), L = tt0 < NPR ? L_P : L_S;
        f32x4 w1[3], w2[3];
#pragma unroll
        for (int tp = 0; tp < 3; ++tp) { w1[tp] = *(const f32x4*)(cw + tp * 3072 + 1024 + c4); w2[tp] = *(const f32x4*)(cw + tp * 3072 + 2048 + c4); }
        const f32x4 b1 = *(const f32x4*)(cb + 1024 + c4), b2 = *(const f32x4*)(cb + 2048 + c4);
        const bf16* px = proj + (size_t)tt0 * NPROJ + COL_X1 + c4;
#pragma unroll 1
        for (int hf = 0; hf < 2; ++hf) {
            u32x2 xr[8][3], vr[8][3];
#pragma unroll
            for (int i = 0; i < 8; ++i) { const int tt = 4 * (hf * 8 + i) + tsub;
#pragma unroll
                for (int d = 0; d < 3; ++d) { const int t = t0 + tt + d - 1; const bool ok = (t >= 0) && (t < L); const bf16* p = px + (long)(tt + d - 1) * NPROJ;
                    xr[i][d] = ok ? *(const u32x2*)p : (u32x2){0u, 0u}; vr[i][d] = ok ? *(const u32x2*)(p + 1024) : (u32x2){0u, 0u}; } }
#pragma unroll
            for (int i = 0; i < 8; ++i) { const int tt = 4 * (hf * 8 + i) + tsub;
                const f32x4 x1c = unpack4(xr[i][0]) * w1[0] + unpack4(xr[i][1]) * w1[1] + unpack4(xr[i][2]) * w1[2] + b1;
                const f32x4 vvc = unpack4(vr[i][0]) * w2[0] + unpack4(vr[i][1]) * w2[1] + unpack4(vr[i][2]) * w2[2] + b2;
                *(LAS u32x2*)(tl + tt * 68 + 4 * cq) = pack4(x1c * vvc); }
        }
        LDS_WAIT(); asm volatile("" ::: "memory");
#pragma unroll
        for (int j = 0; j < 8; ++j) { const int id = lane + 64 * j, ch = id >> 3, tg = id & 7; const LAS bf16* s = tl + (8 * tg) * 68 + ch;
            u32x4 o; o.x = (unsigned)s[0] | ((unsigned)s[68] << 16); o.y = (unsigned)s[2 * 68] | ((unsigned)s[3 * 68] << 16); o.z = (unsigned)s[4 * 68] | ((unsigned)s[5 * 68] << 16); o.w = (unsigned)s[6 * 68] | ((unsigned)s[7 * 68] << 16);
            *(u32x4*)(zT + (size_t)(c0 + ch) * M + tt0 + 8 * tg) = o; }
        LDS_WAIT(); asm volatile("" ::: "memory");
    }
}

__device__ __forceinline__ void hyena_conv_phase(const Frame& F, const Args& a, int layer) {
    unsigned char* ws = WSP(F);
    bf16* zT = (bf16*)(ws + WS_ZT);
    const float* FNP = (const float*)(ws + WS_FNP);
    const int lane = F.lane, w = F.wave, r = lane & 31, h = lane >> 5;
    LAS unsigned char* lds = F.lds;
    for (int u = F.bid; u < 2048; u += F.G) {
        const bool sample = u < 1024; const int c = u & 1023;
        const int L = sample ? L_S : L_P, LP = sample ? LPS : LPP, FCS = LP * 2;
        const int ZROW = (L + 448) * 2, ZOFF = 2 * FCS;
        const int NB = sample ? 4 : 32, tokb = sample ? NPR : 0;
        const bf16* fsrc = sample ? (const bf16*)(ws + WS_FS) + ((size_t)layer * 1024 + c) * LPS : (const bf16*)(ws + WS_FP) + ((size_t)layer * 1024 + c) * LPP;
        __syncthreads();
        for (int i = F.tid; i < LP / 8; i += 512) *(LAS u32x4*)(lds + i * 16) = *(const u32x4*)(fsrc + i * 8);
        for (int i = F.tid; i < LP; i += 512) *(LAS bf16*)(lds + FCS + i * 2) = (i + 1 < LP) ? fsrc[i + 1] : (bf16)0;
        { const int cpr = L / 8;
          for (int i = F.tid; i < NB * cpr; i += 512) { const int b = i / cpr, q = i - b * cpr;
              *(LAS u32x4*)(lds + ZOFF + b * ZROW + 448 + q * 16) = *(const u32x4*)(zT + (size_t)c * M + tokb + b * L + q * 8); }
          if (sample) for (int i = F.tid; i < NB * 56; i += 512) { const int b = i / 56, q = i - b * 56;
              *(LAS u32x4*)(lds + ZOFF + b * ZROW + (q < 28 ? q * 16 : 448 + L * 2 + (q - 28) * 16)) = (u32x4){0u, 0u, 0u, 0u}; } }
        __syncthreads();
        const int nbl = sample ? 2 : 5;
        const int I0 = sample ? 8 * w : w;
        const int b = r & (NB - 1), I = I0 + (r >> nbl);
        int dlo = (sample ? I0 - 63 : I0 - 7), dhi = (sample ? I0 + 7 : I0);
        const int dmax = L / 64;
        dlo = dlo < -dmax ? -dmax : dlo; dhi = dhi > dmax ? dmax : dhi;
        f32x16 acc;
#pragma unroll
        for (int i = 0; i < 16; ++i) acc[i] = 0.f;
        const LAS unsigned char* zb = lds + ZOFF + b * ZROW + (224 + 8 * h) * 2;
#pragma unroll 2
        for (int d = dlo; d <= dhi; ++d) {
#pragma unroll
            for (int ks = 0; ks < 2; ++ks) {
                const int st = (L / 2 - 1) - 32 * d - r + 16 * ks + 8 * h + 32;
                const int par = st & 1;
                const LAS unsigned* ap = (const LAS unsigned*)(lds + par * FCS + (st - par) * 2);
                const u32x4 aw = (u32x4){ap[0], ap[1], ap[2], ap[3]};
                const bf16x8 af = __builtin_bit_cast(bf16x8, aw);
                const bf16x8 bfr = *(const LAS bf16x8*)(zb + (32 * (I - d) + 16 * ks) * 2);
                acc = __builtin_amdgcn_mfma_f32_32x32x16_bf16(af, bfr, acc, 0, 0, 0);
            }
        }
        float fsum = 0.f; { const float* fnp = FNP + (((size_t)layer * 2 + (sample ? 0 : 1)) * 1024 + c) * 32; const int np = 32;
#pragma unroll 4
            for (int i = 0; i < np; ++i) fsum += fnp[i]; }
        const float inv = 1.0f / (fsum + 1e-6f);
        const float dco = INP(F, I_HD)[layer * 1024 + c];
        __syncthreads();
#pragma unroll
        for (int g = 0; g < 4; ++g) {
            const int t = 32 * I + 8 * g + 4 * h;
            const LAS bf16* zp = (const LAS bf16*)(lds + ZOFF + b * ZROW + (224 + t) * 2);
            float o[4];
#pragma unroll
            for (int j = 0; j < 4; ++j) o[j] = acc[4 * g + j] * inv + bf2f(zp[j]) * dco;
            *(u32x2*)(zT + (size_t)c * M + tokb + b * L + t) = (u32x2){cvtpk(o[0], o[1]), cvtpk(o[2], o[3])};
        }
    }
    __syncthreads();
}

__device__ __forceinline__ void hyena_post_phase(const Frame& F, const Args& a, int layer, LAS bf16* tl, int gw, int NGW) {
    unsigned char* ws = WSP(F);
    const bf16* proj = (const bf16*)(ws + WS_PROJ);
    const bf16* yT = (const bf16*)(ws + WS_ZT);
    bf16* oall = (bf16*)(ws + WS_OALL);
    const float* cw = INP(F, I_HCW) + (size_t)layer * 3 * 3072; const float* cb = INP(F, I_HCB) + (size_t)layer * 3072;
    const int lane = F.lane, tsub = lane >> 4, cq = lane & 15;
    for (int it = gw; it < 256 * 16; it += NGW) {
        const int tt0 = (it >> 4) * 64, c0 = (it & 15) * 64, c4 = c0 + 4 * cq;
        const int t0 = tt0 < NPR ? (tt0 & 255) : ((tt0 - NPR) & 2047), L = tt0 < NPR ? L_P : L_S;
        {   u32x4 tmp[8];
#pragma unroll
            for (int j = 0; j < 8; ++j) { const int id = lane + 64 * j, ch = id >> 3, tg = id & 7; tmp[j] = *(const u32x4*)(yT + (size_t)(c0 + ch) * M + tt0 + 8 * tg); }
#pragma unroll
            for (int j = 0; j < 8; ++j) { const int id = lane + 64 * j, ch = id >> 3, tg = id & 7; LAS unsigned* d = (LAS unsigned*)(tl + ch * 68 + 8 * tg);
                d[0] = tmp[j].x; d[1] = tmp[j].y; d[2] = tmp[j].z; d[3] = tmp[j].w; } }
        LDS_WAIT(); asm volatile("" ::: "memory");
        f32x4 w0[3];
#pragma unroll
        for (int tp = 0; tp < 3; ++tp) w0[tp] = *(const f32x4*)(cw + tp * 3072 + c4);
        const f32x4 b0 = *(const f32x4*)(cb + c4);
        const bf16* px = proj + (size_t)tt0 * NPROJ + COL_X0 + c4;
#pragma unroll 1
        for (int hf = 0; hf < 2; ++hf) {
            u32x2 xr[8][3];
#pragma unroll
            for (int i = 0; i < 8; ++i) { const int tt = 4 * (hf * 8 + i) + tsub;
#pragma unroll
                for (int d = 0; d < 3; ++d) { const int t = t0 + tt + d - 1; const bool ok = (t >= 0) && (t < L); xr[i][d] = ok ? *(const u32x2*)(px + (long)(tt + d - 1) * NPROJ) : (u32x2){0u, 0u}; } }
#pragma unroll
            for (int i = 0; i < 8; ++i) { const int tt = 4 * (hf * 8 + i) + tsub;
                const f32x4 x0c = unpack4(xr[i][0]) * w0[0] + unpack4(xr[i][1]) * w0[1] + unpack4(xr[i][2]) * w0[2] + b0;
                const f32x4 yv = (f32x4){bf2f(tl[(4 * cq + 0) * 68 + tt]), bf2f(tl[(4 * cq + 1) * 68 + tt]), bf2f(tl[(4 * cq + 2) * 68 + tt]), bf2f(tl[(4 * cq + 3) * 68 + tt])};
                *(u32x2*)(oall + (size_t)(tt0 + tt) * 3072 + 2048 + c4) = pack4(x0c * yv); }
        }
        LDS_WAIT(); asm volatile("" ::: "memory");
    }
}

constexpr int NPL = 11, PH_LAYER0 = 2, PH_FINAL = PH_LAYER0 + DEPTH * NPL, N_PHASES = PH_FINAL + 1;

__global__ void __launch_bounds__(512, 2) mega(Args args) {
    extern __shared__ __attribute__((aligned(16))) unsigned char lds_raw[];
    Frame F;
    F.lds = (LAS unsigned char*)lds_raw;
    F.tid = threadIdx.x; F.lane = F.tid & 63; F.wave = __builtin_amdgcn_readfirstlane(F.tid >> 6);
    F.G = gridDim.x; F.bid = blockIdx.x;
    for (int u = F.tid; u < (LDS_BYTES - LDSCTL_OFF) / 4; u += 512) ((LAS unsigned*)(F.lds + LDSCTL_OFF))[u] = 0u;
    __syncthreads();
    if (F.tid < 48) { const unsigned long long p = F.tid < 46 ? (unsigned long long)args.in[F.tid] : (F.tid == 46 ? (unsigned long long)args.out : (unsigned long long)args.ws);
        ((LAS unsigned*)(F.lds + LDS_ARGT))[2 * F.tid] = (unsigned)p; ((LAS unsigned*)(F.lds + LDS_ARGT))[2 * F.tid + 1] = (unsigned)(p >> 32); }
    __syncthreads();
    unsigned char* ws = WSP(F);
    unsigned* ctl = (unsigned*)(ws + WS_CTL);
    int lo = args.ph_lo, hi = args.ph_hi;
    const bool single = (hi - lo) > 1;
    XcdBarrier bar; bar.bar = ctl + CW_BAR; bar.x = 0; bar.st = (volatile LAS unsigned*)(F.lds + LDSCTL_OFF + 64); bar.wave = F.wave;
    if (single) bar = xcd_barrier_post(ctl + CW_BAR, (volatile LAS unsigned*)(F.lds + LDSCTL_OFF + 64), F.wave);
#ifndef MK_EN
#define MK_EN 0xFFFFFF
#endif
#define IN(k) (lo <= (k) && (k) < hi)
#define EN(b) ((MK_EN >> (b)) & 1)
#define FRESH() do { F.lane = lane_id(); asm volatile("" : "+v"(F.lane), "+s"(F.bid), "+s"(F.wave), "+s"(F.G)); F.tid = F.wave * 64 + F.lane; } while (0)
#define SEAM(k) do { if (IN(k) && IN((k) + 1)) xcd_barrier(bar); } while (0)

    if (EN(20) && IN(0)) { FRESH(); prologue0(F, args); SEAM(0); }
    if (EN(21) && IN(1)) { FRESH(); prologue1(F, args); SEAM(1); }

    bf16* Hb = (bf16*)(ws + WS_H); bf16* proj = (bf16*)(ws + WS_PROJ); bf16* oall = (bf16*)(ws + WS_OALL);
    float* x = OUTP(F); bf16* xb = (bf16*)(ws + WS_X);
#pragma unroll 1
    for (int l = 0; l < DEPTH; ++l) {
        const int pb = PH_LAYER0 + l * NPL;
        asm volatile("" : "+s"(lo), "+s"(hi));
        const float* mod = (const float*)(ws + WS_MOD) + (size_t)l * 5 * 12288;
        if (EN(0) && IN(pb + 0)) { FRESH();
            if (l == 0) norm_phase<true>(F, INP(F, I_XP), INP(F, I_XS), xb, INP(F, I_LN1), mod, 0, 1, Hb);
            else norm_phase<false>(F, xb, nullptr, nullptr, INP(F, I_LN1) + l * D, mod, 0, 1, Hb);
            SEAM(pb + 0);
        }
        if (EN(1) && IN(pb + 1)) { FRESH();
            pg8::Gemm g{Hb, (const bf16*)(ws + WS_WIN) + (size_t)l * NPROJ * D, D, D, D, 0, 0, 0};
            pg8::Order S; S.init(M, NPROJ, F.G, F.bid, 1);
            pg8::EpiProj E{proj, x + OUT_CK, x + OUT_CV, l};
            pg8::gemm_phase(F.lds, g, S, E, F.wave);
            {   constexpr int nwg = (M / 256) * (NPROJ / 256); const int rem = nwg % F.G;
                if (l + 1 < DEPTH) { if (rem != 0) { if (F.bid >= rem) { FRESH(); mod_partials(F, l + 1, l + 2, (F.bid - rem) * 8 + F.wave, (F.G - rem) * 8); } }
                                     else { FRESH(); mod_partials(F, l + 1, l + 2, F.bid * 8 + F.wave, F.G * 8); } } }
            SEAM(pb + 1);
        }
        if (EN(2) && IN(pb + 2)) { FRESH();
            if (l + 1 < DEPTH) { mod_reduce(F, l + 1, l + 2); FRESH(); }
            {   pg8::Gemm g{proj + COL_LW, (const bf16*)(ws + WS_W2T) + (size_t)l * 5120 * 128, NPROJ, 128, 128, 0, 128, 4};
                pg8::Order5 S; S.init(M, F.G, F.bid);
                pg8::EpiLora2 E{(bf16*)(ws + WS_DEC), (bf16*)(ws + WS_A), (bf16*)(ws + WS_G), INP(F, I_W0) + l * 2048, INP(F, I_A0) + l * 2048};
                pg8::gemm_phase(F.lds, g, S, E, F.wave); }
            FRESH(); attention_phase(F, args, l);
            FRESH(); hyena_prep_phase(F, args, l);
            SEAM(pb + 2);
        }
        if (EN(3) && IN(pb + 3)) { FRESH(); rwkv_prep_phase(F, args, l); FRESH(); hyena_conv_phase(F, args, l); SEAM(pb + 3); }
        if (EN(4) && IN(pb + 4)) { FRESH(); rwkv_cscan_phase(F, args, l); SEAM(pb + 4); }
        if (EN(5) && IN(pb + 5)) { FRESH(); rwkv_post_phase(F, args, l); SEAM(pb + 5); }
        if (EN(6) && IN(pb + 6)) { FRESH();
            pg8::Gemm g{oall, (const bf16*)(ws + WS_WP) + (size_t)l * 3 * D * 1024, 3072, 1024, 1024, 1024, 0, 8};
            pg8::Order S; S.init(M, D, F.G, F.bid, 3);
            pg8::EpiMerge E{proj, Hb};
            pg8::gemm_phase(F.lds, g, S, E, F.wave);
            SEAM(pb + 6);
        }
        if (EN(7) && IN(pb + 7)) { FRESH();
            pg8::Gemm g{Hb, (const bf16*)(ws + WS_WOUT) + (size_t)l * D * D, D, D, D, 0, 0, 0};
            pg8::Order S; S.init(M, D, F.G, F.bid, 1);
            pg8::EpiResid E{xb, mod + 2 * D, nullptr};
            pg8::gemm_phase(F.lds, g, S, E, F.wave);
            SEAM(pb + 7);
        }
        if (EN(8) && IN(pb + 8)) { FRESH(); norm_phase<false>(F, xb, nullptr, nullptr, INP(F, I_LN2) + l * D, mod, 3, 4, Hb); SEAM(pb + 8); }
        if (EN(9) && IN(pb + 9)) { FRESH();
            pg8::Gemm g{Hb, (const bf16*)(ws + WS_WFF1) + (size_t)l * D * DFF, D, D, D, 0, 0, 0};
            pg8::Order S; S.init(M, DFF, F.G, F.bid, 1);
            pg8::EpiFF1 E{proj, INP(F, I_BFF1) + l * DFF};
            pg8::gemm_phase(F.lds, g, S, E, F.wave);
            SEAM(pb + 9);
        }
        if (EN(10) && IN(pb + 10)) { FRESH();
            pg8::Gemm g{proj, (const bf16*)(ws + WS_WFF2) + (size_t)l * D * DFF, DFF, DFF, DFF, 0, 0, 0};
            pg8::Order S; S.init(M, D, F.G, F.bid, 1);
            pg8::EpiResid E{xb, mod + 5 * D, INP(F, I_BFF2) + l * D};
            pg8::gemm_phase(F.lds, g, S, E, F.wave);
            SEAM(pb + 10);
        }
    }
    asm volatile("" : "+s"(lo), "+s"(hi));
    if (EN(22) && IN(PH_FINAL)) { FRESH(); final_norm_phase(F, (const bf16*)(WSP(F) + WS_X), OUTP(F), INP(F, I_FING)); }
#undef IN
#undef SEAM
}

extern "C" void kernel_launch(void* const* d_in, const int* in_sizes, int n_in, void* d_out, int out_size, void* d_ws, size_t ws_size, hipStream_t stream) {
    static int grid = 0;
    if (grid == 0) {
        if (n_in != N_INPUTS || (size_t)out_size != OUT_TOTAL || ws_size < WS_END) { fprintf(stderr, "kernel_launch: unexpected shapes: n_in %d out %d ws %zu\n", n_in, out_size, ws_size); grid = -1; return; }
        int dev = 0, cus = 0, per_cu = 0;
        if (hipGetDevice(&dev) != hipSuccess || hipDeviceGetAttribute(&cus, hipDeviceAttributeMultiprocessorCount, dev) != hipSuccess) { grid = -1; return; }
        if (hipFuncSetAttribute((const void*)mega, hipFuncAttributeMaxDynamicSharedMemorySize, LDS_BYTES) != hipSuccess) { fprintf(stderr, "kernel_launch: hipFuncSetAttribute failed\n"); grid = -1; return; }
        if (hipOccupancyMaxActiveBlocksPerMultiprocessor(&per_cu, (const void*)mega, 512, LDS_BYTES) != hipSuccess || per_cu < 1) { fprintf(stderr, "kernel_launch: occupancy query says %d\n", per_cu); }
        (void)hipGetLastError();
        grid = cus;
    }
    if (grid < 0) return;
    (void)hipMemsetAsync((char*)d_ws + WS_CTL, 0, CTL_ZERO_BYTES, stream);
    Args a{};
    for (int i = 0; i < N_INPUTS; ++i) a.in[i] = (const float*)d_in[i];
    a.out = (float*)d_out; a.ws = (unsigned char*)d_ws;
#if MK_MULTI
    for (int ph = 0; ph < N_PHASES; ++ph) { a.ph_lo = ph; a.ph_hi = ph + 1; hipLaunchKernelGGL(mega, dim3(grid), dim3(512), LDS_BYTES, stream, a); }
#else
    a.ph_lo = 0; a.ph_hi = N_PHASES;
    hipLaunchKernelGGL(mega, dim3(grid), dim3(512), LDS_BYTES, stream, a);
#endif
    const hipError_t le = hipPeekAtLastError();
    if (le != hipSuccess) fprintf(stderr, "kernel_launch: launch failed: %s\n", hipGetErrorName(le));
}
```

```cpp
#include <hip/hip_runtime.h>
#include <cstdio>
#include <cstdint>

#ifndef MK_MULTI
#define MK_MULTI 0
#endif

#define GAS __attribute__((address_space(1)))
#define LAS __attribute__((address_space(3)))
typedef unsigned short bf16;
typedef short bf16x8 __attribute__((ext_vector_type(8)));
typedef short s16x4 __attribute__((ext_vector_type(4)));
typedef float f32x4 __attribute__((ext_vector_type(4)));
typedef float f32x2 __attribute__((ext_vector_type(2)));
typedef float f32x16 __attribute__((ext_vector_type(16)));
typedef unsigned u32x4 __attribute__((ext_vector_type(4)));
typedef unsigned u32x2 __attribute__((ext_vector_type(2)));
typedef __bf16 bf16x2_t __attribute__((ext_vector_type(2)));

constexpr int D = 2048, DEPTH = 4, NPR = 8192  , M = 16384, DFF = 8192;
constexpr int NPROJ = 15872;
constexpr int COL_K = 1024, COL_V = 2048, COL_R = 3072, COL_X0 = 6144, COL_X1 = 7168, COL_VV = 8192, COL_GL = 9216, COL_LW = 15360, COL_G1A = 15488;
constexpr int L_P = 256, L_S = 2048;

enum { I_XP = 0, I_XS, I_CK, I_CV, I_ST, I_C, I_CCTX, I_LN1, I_LN2, I_WMOD, I_BMOD, I_WIN, I_RPB, I_CW, I_CB, I_W0, I_W1, I_W2, I_A0, I_A1, I_A2, I_G1, I_G2,
       I_KK, I_KA, I_RK, I_GNG, I_GNB, I_HCW, I_HCB, I_F1, I_FB1, I_F2, I_FB2, I_FREQ, I_F3, I_HD, I_WPA, I_WPR, I_WPC, I_WOUT, I_FF1, I_BFF1, I_FF2, I_BFF2, I_FING, N_INPUTS };

constexpr size_t OUT_X = 0, OUT_CK = 33554432, OUT_CV = 67108864, OUT_ST = 100663296, OUT_TOTAL = 117440512;

constexpr size_t MiB = 1u << 20;
constexpr size_t WS_CTL = 0, CTL_ZERO_BYTES = 1 * MiB;
constexpr size_t WS_FNP = 1 * MiB;
constexpr size_t WS_WIN = 2 * MiB;
constexpr size_t WS_W2T = 250 * MiB;
constexpr size_t WS_WP = 260 * MiB;
constexpr size_t WS_WOUT = 308 * MiB;
constexpr size_t WS_WFF1 = 340 * MiB;
constexpr size_t WS_WFF2 = 468 * MiB;
constexpr size_t WS_H = 596 * MiB;
constexpr size_t WS_A = 660 * MiB;
constexpr size_t WS_PROJ = 724 * MiB;
constexpr size_t WS_OALL = 1220 * MiB;
constexpr size_t WS_DEC = 1316 * MiB;
constexpr size_t WS_X = 1380 * MiB;
constexpr size_t WS_G = 1444 * MiB;
constexpr size_t WS_TIL = 1476 * MiB;
constexpr size_t WS_CK = 1764 * MiB;
constexpr size_t WS_CV = 1772 * MiB;
constexpr size_t WS_FS = 1780 * MiB;
constexpr size_t WS_FP = 1797 * MiB;
constexpr size_t WS_ZT = 1800 * MiB;
constexpr size_t WS_MOD = 1832 * MiB;
constexpr size_t WS_T2 = 1833 * MiB;
constexpr size_t WS_BONUS = 1837 * MiB;
constexpr size_t WS_TINV = 1838 * MiB;
constexpr size_t WS_Q = WS_TINV;
constexpr size_t WS_WTB = 1870 * MiB;
constexpr size_t WS_END = 1874 * MiB;
constexpr int TILP = 576;
constexpr int LPS = 2120, LPP = 328;

constexpr int CW_BAR = 4096;
constexpr int CW_FNORM = 32768;

constexpr int LDS_SCRATCH = 131072, LDSCTL_OFF = 131072, LDS_BYTES = 147456;

#define LDS_WAIT() asm volatile("s_waitcnt lgkmcnt(0)" ::: "memory")
#define VM_WAIT() asm volatile("s_waitcnt vmcnt(0)" ::: "memory")
__device__ __forceinline__ unsigned cvtpk(float lo, float hi) { f32x2 v = {lo, hi}; bf16x2_t b = __builtin_convertvector(v, bf16x2_t); return __builtin_bit_cast(unsigned, b); }
__device__ __forceinline__ bf16 f2bf(float f) { return (bf16)(cvtpk(f, 0.f) & 0xffffu); }
__device__ __forceinline__ float bf2f(bf16 b) { return __uint_as_float(((unsigned)b) << 16); }
__device__ __forceinline__ float bflo(unsigned w) { return __uint_as_float(w << 16); }
__device__ __forceinline__ float bfhi(unsigned w) { return __uint_as_float(w & 0xffff0000u); }
#define DPPF(v, ctrl) __int_as_float(__builtin_amdgcn_update_dpp(0, __float_as_int(v), (ctrl), 0xf, 0xf, false))
__device__ __forceinline__ float wave_sum(float v) {
    v += DPPF(v, 0xB1); v += DPPF(v, 0x4E); v += DPPF(v, 0x141); v += DPPF(v, 0x140);
    const float a = __int_as_float(__builtin_amdgcn_readlane(__float_as_int(v), 0)), b = __int_as_float(__builtin_amdgcn_readlane(__float_as_int(v), 16)),
                c = __int_as_float(__builtin_amdgcn_readlane(__float_as_int(v), 32)), d = __int_as_float(__builtin_amdgcn_readlane(__float_as_int(v), 48));
    return (a + b) + (c + d);
}
__device__ __forceinline__ float xor32(float v, int lane) { return __int_as_float(__builtin_amdgcn_ds_bpermute((lane ^ 32) << 2, __float_as_int(v))); }
__device__ __forceinline__ int lane_id() { return (int)__builtin_amdgcn_mbcnt_hi(~0u, __builtin_amdgcn_mbcnt_lo(~0u, 0u)); }
__device__ __forceinline__ float sigmoidf_(float x) { return __builtin_amdgcn_rcpf(1.0f + __expf(-x)); }
__device__ __forceinline__ float tanhf_(float x) { return 1.0f - 2.0f * __builtin_amdgcn_rcpf(1.0f + __expf(2.0f * x)); }

#define XB_TMO      128
#define XB_XCNT(j)  (256  + 64 * (j))
#define XB_XSUB(j)  (1280 + 64 * (j))
#define XB_XGEN(j)  (2304 + 64 * (j))
#define XB_TOP      3328
#define XB_TOPGEN   3392
#define XCD_BAR_WORDS 3456
#define XB_SPIN_CAP (1u << 20)
__device__ __forceinline__ unsigned xb_ld(unsigned* p)              { return __hip_atomic_load(p, __ATOMIC_RELAXED, __HIP_MEMORY_SCOPE_AGENT); }
__device__ __forceinline__ unsigned xb_add(unsigned* p, unsigned v) { return __hip_atomic_fetch_add(p, v, __ATOMIC_RELAXED, __HIP_MEMORY_SCOPE_AGENT); }
__device__ __forceinline__ unsigned xb_xcc_id() { return (unsigned)__builtin_amdgcn_s_getreg((3 << 11) | 20) & 0xFu; }
#define XB_SPIN(cond, bar) do { unsigned _sp = 0; while (cond) { __builtin_amdgcn_s_sleep(1); \
    if ((++_sp & 255u) == 0u) { if (xb_ld(&(bar)[XB_TMO])) break; if (_sp > XB_SPIN_CAP) { atomicAdd(&(bar)[XB_TMO], 1u); break; } } } } while (0)
struct XcdBarrier { unsigned* bar; unsigned x; volatile LAS unsigned* st; int wave; };
__device__ __forceinline__ XcdBarrier xcd_barrier_post(unsigned* bar, volatile LAS unsigned* st, int wave) {
    XcdBarrier b; b.bar = bar; b.x = xb_xcc_id(); b.st = st; b.wave = wave;
    if (wave == 0 && lane_id() == 0) (void)xb_add(&bar[XB_XCNT(b.x)], 1u);
    return b;
}
__device__ __forceinline__ void xcd_barrier_complete(unsigned* bar, unsigned x, unsigned& nloc, unsigned& nx) {
    const unsigned G = gridDim.x * gridDim.y * gridDim.z;
    unsigned sum, cnt, mine, sp = 0u;
    for (;;) {
        sum = 0u; cnt = 0u; mine = 0u;
#pragma unroll
        for (unsigned j = 0; j < 16; ++j) { const unsigned c = xb_ld(&bar[XB_XCNT(j)]); sum += c; cnt += (c > 0u) ? 1u : 0u; mine = (j == x) ? c : mine; }
        if (sum == G) break;
        __builtin_amdgcn_s_sleep(1);
        if ((++sp & 255u) == 0u) { if (xb_ld(&bar[XB_TMO])) break; if (sp > XB_SPIN_CAP) { atomicAdd(&bar[XB_TMO], 1u); break; } }
    }
    nloc = mine > 0u ? mine : 1u; nx = cnt > 0u ? cnt : 1u;
}
__device__ __forceinline__ void xcd_barrier(const XcdBarrier& b) {
    asm volatile("s_waitcnt vmcnt(0)" ::: "memory");
    __syncthreads();
    if (b.wave == 0 && lane_id() == 0) {
        unsigned* bar = b.bar; asm volatile("" : "+s"(bar));
        __builtin_amdgcn_s_waitcnt(0);
        unsigned nloc = b.st[0], nx = b.st[1];
        if (nloc == 0u) { xcd_barrier_complete(bar, b.x, nloc, nx); b.st[0] = nloc; b.st[1] = nx; }
        const unsigned old = xb_add(&bar[XB_XSUB(b.x)], 1u);
        const unsigned gen = old / nloc;
        if (old + 1u == (gen + 1u) * nloc) {
            __builtin_amdgcn_fence(__ATOMIC_RELEASE, "agent");
            asm volatile("s_waitcnt vmcnt(0)" ::: "memory");
            const unsigned og = xb_add(&bar[XB_TOP], 1u);
            const unsigned tg = og / nx;
            if (og + 1u == (tg + 1u) * nx) xb_add(&bar[XB_TOPGEN], 1u);
            else XB_SPIN(xb_ld(&bar[XB_TOPGEN]) == tg, bar);
            __builtin_amdgcn_fence(__ATOMIC_ACQUIRE, "agent");
            xb_add(&bar[XB_XGEN(b.x)], 1u);
            asm volatile("s_waitcnt vmcnt(0)" ::: "memory");
        } else {
            XB_SPIN(xb_ld(&bar[XB_XGEN(b.x)]) == gen, bar);
            __builtin_amdgcn_fence(__ATOMIC_ACQUIRE, "agent");
            asm volatile("s_waitcnt vmcnt(0)" ::: "memory");
        }
    }
    __syncthreads();
}

struct Args { const float* in[N_INPUTS]; float* out; unsigned char* ws; int ph_lo, ph_hi; };
struct Frame {
    LAS unsigned char* lds;
    int tid, lane, wave, G, bid;
};
constexpr int LDS_ARGT = 131072 + 1024;
__device__ __forceinline__ const float* INP(const Frame& F, int k) {
    const LAS unsigned* t = (const LAS unsigned*)(F.lds + LDS_ARGT) + 2 * k;
    const unsigned lo = __builtin_amdgcn_readfirstlane(t[0]), hi = __builtin_amdgcn_readfirstlane(t[1]);
    return (const float*)(const GAS float*)(((unsigned long long)hi << 32) | lo);
}
__device__ __forceinline__ float* OUTP(const Frame& F) { return (float*)INP(F, 46); }
__device__ __forceinline__ unsigned char* WSP(const Frame& F) { return (unsigned char*)INP(F, 47); }

namespace pg8 {
constexpr int BM = 256, BK = 64, HALF = 128, HTB = HALF * BK * 2, STAGE_BYTES = 8 * HTB, NXCD = 8, WGM = 4;
__host__ __device__ __forceinline__ int lds_byte(int r, int c) { const int st = (r >> 4) * 2 + (c >> 5), rr = r & 15, cc = c & 31, ob = rr * 64 + cc * 2; return st * 1024 + (ob ^ (((ob >> 9) & 1) << 5)); }
__host__ __device__ __forceinline__ void stage_rc(int b, int& R, int& C) { const int st = b / 1024, sb = b % 1024, swz = sb ^ (((sb >> 9) & 1) << 5); R = (st >> 1) * 16 + swz / 64; C = (st & 1) * 32 + (swz % 64) / 2; }
__host__ __device__ __forceinline__ int perm32(int rho) { const int n = rho >> 4, i = rho & 15; return 8 * (i >> 2) + 4 * n + (i & 3); }

struct Unit { int pm, pn, br; };
struct Gemm { const bf16* A; const bf16* Bt; int lda, ldb, K; int a_br_stride  , a_pair_off  , b_br_tiles  ; };

struct Order {
    int nM, nN, nwg, G, c, nbr;
    __device__ void init(int Mrows, int N, int G_, int c_, int nbr_) { nM = Mrows / BM; nN = N / BM; nwg = nM * nN; G = G_; c = c_; nbr = nbr_; }
    __device__ int nbr_() const { return nbr; }
    __device__ bool next(int i, Unit& u) const {
        const int it = i / nbr; u.br = i - it * nbr;
        const long L = (long)it * G + c; if (L >= nwg) return false;
        int wgid = (int)L; { const int q = nwg / NXCD, r = nwg % NXCD, xcd = wgid % NXCD, off = wgid / NXCD; wgid = (xcd < r ? xcd * (q + 1) : r * (q + 1) + (xcd - r) * q) + off; }
        const int nig = WGM * nN, gid = wgid / nig, fm = gid * WGM, gsz = (nM - fm) < WGM ? (nM - fm) : WGM;
        u.pm = fm + ((wgid % nig) % gsz); u.pn = (wgid % nig) / gsz; return true;
    }
};
struct Order5 {
    Order o;
    __device__ void init(int Mrows, int G_, int c_) { o.init(Mrows, 20 * BM, G_, c_, 1); }
    __device__ int nbr_() const { return 1; }
    __device__ bool next(int i, Unit& u) const { if (!o.next(i, u)) return false; u.br = u.pn >> 2; u.pn &= 3; return true; }
};

template <class Epi, class Sched>
__device__ __forceinline__ void gemm_phase(LAS unsigned char* lds, const Gemm g, const Sched& S, const Epi& E, int wave) {
    int tid = wave * 64 + lane_id(); asm volatile("" : "+v"(tid));
    const int wid = __builtin_amdgcn_readfirstlane(tid >> 6), lane = tid & 63, wr = wid >> 2, wc = wid & 3, fr = lane & 15, fq = lane >> 4;
    const int K = g.K; int nt = K / BK; asm volatile("" : "+s"(nt));
    unsigned voffA[2], voffB[2];
#pragma unroll
    for (int i = 0; i < 2; ++i) { int R, C; stage_rc(tid * 16 + i * 8192, R, C); const int Rb = Epi::PERM ? ((R & ~31) + perm32(R & 31)) : R;
        voffA[i] = (unsigned)(R * g.lda + C) * 2u; voffB[i] = (unsigned)(Rb * g.ldb + C) * 2u; }
    const size_t kstep = (size_t)(BK * 2);
    const size_t hstepA = (size_t)HALF * g.lda * 2, hstepB = (size_t)HALF * g.ldb * 2;
    const unsigned ldsw = (unsigned)wid * 1024u;
    const int aoff = lds_byte(wr * 64 + fr, fq * 8), boff = lds_byte(wc * 32 + fr, fq * 8);
#define PG8_APTR(u) ((const char*)g.A + ((size_t)(u).pm * 256 * g.lda + (size_t)(u).br * g.a_br_stride + (size_t)((u).br >> 1) * g.a_pair_off) * 2)
#define PG8_BPTR(u) ((const char*)g.Bt + ((size_t)((u).br * g.b_br_tiles + (u).pn) * 256 * g.ldb) * 2)
#define PG8_SA(b, h) (((b) * 2 + (h)) * HTB)
#define PG8_SB(b, h) ((4 + (b) * 2 + (h)) * HTB)
#define PG8_STAGE(bufoff, gbase, voff) do { _Pragma("unroll") for (int _i = 0; _i < 2; ++_i) \
        __builtin_amdgcn_global_load_lds((const unsigned*)((const char*)(gbase) + (voff)[_i]), (LAS unsigned*)(lds + (bufoff) + ldsw + _i * 8192), 16, 0, 0); } while (0)
#define PG8_LDA(dst, b, h) do { _Pragma("unroll") for (int m = 0; m < 4; ++m) _Pragma("unroll") for (int k = 0; k < 2; ++k) dst[m][k] = *(const LAS bf16x8*)(lds + PG8_SA(b, h) + aoff + m * 2048 + k * 1024); } while (0)
#define PG8_LDB(dst, b, h) do { _Pragma("unroll") for (int n = 0; n < 2; ++n) _Pragma("unroll") for (int k = 0; k < 2; ++k) dst[n][k] = *(const LAS bf16x8*)(lds + PG8_SB(b, h) + boff + n * 2048 + k * 1024); } while (0)
#define PG8_MMA(ai, bj, At, Bt) do { __builtin_amdgcn_s_setprio(1); _Pragma("unroll") for (int m = 0; m < 4; ++m) _Pragma("unroll") for (int n = 0; n < 2; ++n) _Pragma("unroll") for (int k = 0; k < 2; ++k) \
        acc[ai][bj][m][n] = __builtin_amdgcn_mfma_f32_16x16x32_bf16(Bt[n][k], At[m][k], acc[ai][bj][m][n], 0, 0, 0); __builtin_amdgcn_s_setprio(0); } while (0)
#define PG8_WAIT_V(n) asm volatile("s_waitcnt vmcnt(" #n ")" ::: "memory")
#define PG8_WAIT_L(n) asm volatile("s_waitcnt lgkmcnt(" #n ")" ::: "memory")
#define PG8_BAR __builtin_amdgcn_s_barrier()
#define PG8_SCHED __builtin_amdgcn_sched_barrier(0)
    Unit cur, nxt; int ui = 0;
    if (!S.next(0, cur)) return;
    f32x4 acc[2][2][4][2];
#pragma unroll
    for (int a = 0; a < 2; ++a)
#pragma unroll
        for (int b = 0; b < 2; ++b)
#pragma unroll
            for (int m = 0; m < 4; ++m)
#pragma unroll
                for (int n = 0; n < 2; ++n) acc[a][b][m][n] = (f32x4){0.f, 0.f, 0.f, 0.f};
    bf16x8 At[4][2], B0[2][2], B1[2][2];
    const char* cA = PG8_APTR(cur); const char* cB = PG8_BPTR(cur);
    PG8_STAGE(PG8_SB(0, 0), cB, voffB); PG8_STAGE(PG8_SB(0, 1), cB + hstepB, voffB); PG8_STAGE(PG8_SA(0, 0), cA, voffA); PG8_STAGE(PG8_SA(0, 1), cA + hstepA, voffA);
    if (wr == 1) PG8_BAR;
    PG8_WAIT_V(2); PG8_BAR;
    PG8_STAGE(PG8_SB(1, 0), cB + kstep, voffB); PG8_STAGE(PG8_SA(1, 0), cA + kstep, voffA); PG8_STAGE(PG8_SB(1, 1), cB + hstepB + kstep, voffB);
    PG8_WAIT_V(6); PG8_BAR;
    for (;;) {
        const bool has_next = S.next(ui + 1, nxt);
        const char* nA = has_next ? PG8_APTR(nxt) : cA; const char* nB = has_next ? PG8_BPTR(nxt) : cB;
#pragma unroll 1
        for (int t = 0; t < nt; t += 2) {
            const bool last = (t == nt - 2);
            const char* a1 = cA + (size_t)(t + 1) * kstep;
            const char* a2 = last ? nA : cA + (size_t)(t + 2) * kstep; const char* b2 = last ? nB : cB + (size_t)(t + 2) * kstep;
            const char* a3 = a2 + kstep; const char* b3 = b2 + kstep;
            PG8_LDB(B0, 0, 0); PG8_LDB(B1, 0, 1); PG8_SCHED; PG8_LDA(At, 0, 0); PG8_STAGE(PG8_SA(1, 1), a1 + hstepA, voffA);
            PG8_WAIT_V(8); PG8_WAIT_L(0); PG8_BAR; PG8_MMA(0, 0, At, B0); PG8_MMA(0, 1, At, B1); PG8_BAR; PG8_SCHED;
            PG8_LDA(At, 0, 1); PG8_STAGE(PG8_SB(0, 0), b2, voffB); PG8_STAGE(PG8_SB(0, 1), b2 + hstepB, voffB); PG8_STAGE(PG8_SA(0, 0), a2, voffA);
            PG8_WAIT_V(8); PG8_WAIT_L(0); PG8_BAR; PG8_MMA(1, 0, At, B0); PG8_MMA(1, 1, At, B1); PG8_BAR; PG8_SCHED;
            PG8_LDB(B0, 1, 0); PG8_LDB(B1, 1, 1); PG8_SCHED; PG8_LDA(At, 1, 0); PG8_STAGE(PG8_SA(0, 1), a2 + hstepA, voffA);
            PG8_WAIT_V(8); PG8_WAIT_L(0); PG8_BAR; PG8_MMA(0, 0, At, B0); PG8_MMA(0, 1, At, B1); PG8_BAR; PG8_SCHED;
            PG8_LDA(At, 1, 1); PG8_STAGE(PG8_SB(1, 0), b3, voffB); PG8_STAGE(PG8_SB(1, 1), b3 + hstepB, voffB); PG8_STAGE(PG8_SA(1, 0), a3, voffA);
            PG8_WAIT_V(8); PG8_WAIT_L(0); PG8_BAR; PG8_MMA(1, 0, At, B0); PG8_MMA(1, 1, At, B1); PG8_BAR; PG8_SCHED;
        }
        if (wr == 0) PG8_BAR;
        E(acc, cur, wr, wc, fr, fq);
        if (!has_next) break;
        if (!Epi::CHAIN || cur.br == S.nbr_() - 1) {
#pragma unroll
        for (int a = 0; a < 2; ++a)
#pragma unroll
            for (int b = 0; b < 2; ++b)
#pragma unroll
                for (int m = 0; m < 4; ++m)
#pragma unroll
                    for (int n = 0; n < 2; ++n) acc[a][b][m][n] = (f32x4){0.f, 0.f, 0.f, 0.f};
        }
        cur = nxt; cA = nA; cB = nB; ++ui;
        if (wr == 1) PG8_BAR;
    }
    PG8_WAIT_V(0);
    PG8_BAR;
#undef PG8_APTR
#undef PG8_BPTR
#undef PG8_SA
#undef PG8_SB
#undef PG8_STAGE
#undef PG8_LDA
#undef PG8_LDB
#undef PG8_MMA
#undef PG8_WAIT_V
#undef PG8_WAIT_L
#undef PG8_BAR
#undef PG8_SCHED
}

__device__ __forceinline__ float gclamp(float g) { return fmaxf(g, 1e-20f); }
__device__ __forceinline__ int modrow(int row) { return row < NPR ? 0 : 1 + ((row - NPR) >> 11); }

struct EpiProj {
    static constexpr bool PERM = true; static constexpr bool CHAIN = false;
    bf16* proj; float* outk; float* outv; int layer;
    __device__ __forceinline__ void operator()(const f32x4 (&acc)[2][2][4][2], const Unit& u, int wr, int wc, int fr, int fq) const {
        { int t_ = lane_id(); asm volatile("" : "+v"(t_)); fr = t_ & 15; fq = (t_ >> 4) & 3; }
        const int row0 = u.pm * BM + wr * 64 + fr, colb = u.pn * BM + wc * 32 + 8 * fq;
        const int mode = (u.pn == 60) ? 1 : (u.pn == 61 ? 2 : ((u.pn >= 36) ? 3 : 0));
        const bool kv = (u.pm < 32) && (u.pn >= 4) && (u.pn < 12);
#pragma unroll
        for (int ai = 0; ai < 2; ++ai)
#pragma unroll
            for (int m = 0; m < 4; ++m) {
                const int row = row0 + ai * HALF + m * 16;
                bf16* rowp = proj + (size_t)row * NPROJ + colb;
#pragma unroll
                for (int bj = 0; bj < 2; ++bj) {
                    f32x4 v0 = acc[ai][bj][m][0], v1 = acc[ai][bj][m][1];
                    if (mode == 1) { if (colb + bj * HALF < COL_G1A) {
#pragma unroll
                        for (int j = 0; j < 4; ++j) { v0[j] = tanhf_(v0[j]); v1[j] = tanhf_(v1[j]); } } }
                    else if (mode == 3) {
#pragma unroll
                        for (int j = 0; j < 4; ++j) { v0[j] = sigmoidf_(v0[j]); v1[j] = sigmoidf_(v1[j]); } }
                    else if (mode == 2) { const bool act = (colb + bj * HALF) < 15744;
#pragma unroll
                        for (int j = 0; j < 4; ++j) { v0[j] = act ? sigmoidf_(v0[j]) : 0.f; v1[j] = act ? sigmoidf_(v1[j]) : 0.f; } }
                    u32x4 w; w.x = cvtpk(v0[0], v0[1]); w.y = cvtpk(v0[2], v0[3]); w.z = cvtpk(v1[0], v1[1]); w.w = cvtpk(v1[2], v1[3]);
                    *(u32x4*)(rowp + bj * HALF) = w;
                    if (kv) { const int col = colb + bj * HALF; float* ob = (u.pn < 8) ? outk : outv; const int ch = col - ((u.pn < 8) ? COL_K : COL_V);
                        float* dst = ob + ((size_t)(((row >> 8) * 4 + layer) * 256 + (row & 255))) * 1024 + ch;
                        *(f32x4*)dst = v0; *(f32x4*)(dst + 4) = v1; }
                }
            }
    }
};
struct EpiLora2 {
    static constexpr bool PERM = true; static constexpr bool CHAIN = false;
    bf16* dec; bf16* abuf; bf16* gbuf; const float* w0; const float* a0;
    __device__ __forceinline__ void operator()(const f32x4 (&acc)[2][2][4][2], const Unit& u, int wr, int wc, int fr, int fq) const {
        { int t_ = lane_id(); asm volatile("" : "+v"(t_)); fr = t_ & 15; fq = (t_ >> 4) & 3; }
        const int row0 = u.pm * BM + wr * 64 + fr, colb = u.pn * BM + wc * 32 + 8 * fq;
        const int br = u.br, e = br & 1;
        const float* bsrc = (br < 2) ? w0 + e * 1024 : a0 + e * 1024;
        bf16* obase = (br < 2) ? dec + (size_t)e * 1024 : (br < 4 ? abuf + (size_t)e * 1024 : gbuf);
        const size_t opitch = (br < 4) ? 2048 : 1024;
#pragma unroll
        for (int bj = 0; bj < 2; ++bj) {
            const int ch = colb + bj * HALF;
            f32x4 b0 = (f32x4){0.f, 0.f, 0.f, 0.f}, b1 = b0;
            if (br < 4) { b0 = *(const f32x4*)(bsrc + ch); b1 = *(const f32x4*)(bsrc + ch + 4); }
#pragma unroll
            for (int ai = 0; ai < 2; ++ai)
#pragma unroll
                for (int m = 0; m < 4; ++m) {
                    const int row = row0 + ai * HALF + m * 16;
                    f32x4 v0 = acc[ai][bj][m][0] + b0, v1 = acc[ai][bj][m][1] + b1;
                    if (br < 4) {
#pragma unroll
                        for (int j = 0; j < 4; ++j) { v0[j] = sigmoidf_(v0[j]); v1[j] = sigmoidf_(v1[j]); }
                        if (br < 2) { v0 = v0 * -0.6065306597126334f; v1 = v1 * -0.6065306597126334f; }
                    }
                    u32x4 w; w.x = cvtpk(v0[0], v0[1]); w.y = cvtpk(v0[2], v0[3]); w.z = cvtpk(v1[0], v1[1]); w.w = cvtpk(v1[2], v1[3]);
                    *(u32x4*)(obase + (size_t)row * opitch + ch) = w;
                    __builtin_amdgcn_sched_barrier(0);
                }
        }
    }
};
struct EpiMerge {
    static constexpr bool PERM = true; static constexpr bool CHAIN = true;
    const bf16* proj; bf16* merged;
    __device__ __forceinline__ void operator()(f32x4 (&acc)[2][2][4][2], const Unit& u, int wr, int wc, int fr, int fq) const {
        { int t_ = lane_id(); asm volatile("" : "+v"(t_)); fr = t_ & 15; fq = (t_ >> 4) & 3; }
        const int row0 = u.pm * BM + wr * 64 + fr, colb = u.pn * BM + wc * 32 + 8 * fq;
        const int br = u.br;
        const bf16* gbase = proj + (size_t)row0 * NPROJ + COL_GL + br * 2048 + colb;
        if (br < 2) {
#pragma unroll
            for (int ai = 0; ai < 2; ++ai) {
                u32x4 ga[4][2], gb[4][2];
#pragma unroll
                for (int m = 0; m < 4; ++m)
#pragma unroll
                    for (int bj = 0; bj < 2; ++bj) { const bf16* gp = gbase + (size_t)(ai * HALF + m * 16) * NPROJ + bj * HALF;
                        ga[m][bj] = *(const u32x4*)gp; gb[m][bj] = *(const u32x4*)(gp + 2048); }
#pragma unroll
                for (int m = 0; m < 4; ++m)
#pragma unroll
                    for (int bj = 0; bj < 2; ++bj) {
                        const u32x4 a = ga[m][bj], b = gb[m][bj];
                        f32x4& v0 = acc[ai][bj][m][0]; f32x4& v1 = acc[ai][bj][m][1];
                        v0[0] *= gclamp(bflo(a.x)) * __builtin_amdgcn_rcpf(gclamp(bflo(b.x))); v0[1] *= gclamp(bfhi(a.x)) * __builtin_amdgcn_rcpf(gclamp(bfhi(b.x)));
                        v0[2] *= gclamp(bflo(a.y)) * __builtin_amdgcn_rcpf(gclamp(bflo(b.y))); v0[3] *= gclamp(bfhi(a.y)) * __builtin_amdgcn_rcpf(gclamp(bfhi(b.y)));
                        v1[0] *= gclamp(bflo(a.z)) * __builtin_amdgcn_rcpf(gclamp(bflo(b.z))); v1[1] *= gclamp(bfhi(a.z)) * __builtin_amdgcn_rcpf(gclamp(bfhi(b.z)));
                        v1[2] *= gclamp(bflo(a.w)) * __builtin_amdgcn_rcpf(gclamp(bflo(b.w))); v1[3] *= gclamp(bfhi(a.w)) * __builtin_amdgcn_rcpf(gclamp(bfhi(b.w)));
                    }
                asm volatile("" ::: "memory"); }
        } else {
#pragma unroll
            for (int ai = 0; ai < 2; ++ai)
#pragma unroll
                for (int m = 0; m < 4; ++m) {
                    const int row = row0 + ai * HALF + m * 16;
#pragma unroll
                    for (int bj = 0; bj < 2; ++bj) {
                        const int col = colb + bj * HALF;
                        const u32x4 gw = *(const u32x4*)(gbase + (size_t)(ai * HALF + m * 16) * NPROJ + bj * HALF);
                        f32x4 v0 = acc[ai][bj][m][0], v1 = acc[ai][bj][m][1];
                        v0[0] *= gclamp(bflo(gw.x)); v0[1] *= gclamp(bfhi(gw.x)); v0[2] *= gclamp(bflo(gw.y)); v0[3] *= gclamp(bfhi(gw.y));
                        v1[0] *= gclamp(bflo(gw.z)); v1[1] *= gclamp(bfhi(gw.z)); v1[2] *= gclamp(bflo(gw.w)); v1[3] *= gclamp(bfhi(gw.w));
                        u32x4 w; w.x = cvtpk(v0[0], v0[1]); w.y = cvtpk(v0[2], v0[3]); w.z = cvtpk(v1[0], v1[1]); w.w = cvtpk(v1[2], v1[3]);
                        *(u32x4*)(merged + (size_t)row * D + col) = w;
                    }
                }
        }
    }
};
struct EpiResid {
    static constexpr bool PERM = true; static constexpr bool CHAIN = false;
    bf16* x; const float* gate;   const float* bias;
    __device__ __forceinline__ void operator()(const f32x4 (&acc)[2][2][4][2], const Unit& u, int wr, int wc, int fr, int fq) const {
        { int t_ = lane_id(); asm volatile("" : "+v"(t_)); fr = t_ & 15; fq = (t_ >> 4) & 3; }
        const int row0 = u.pm * BM + wr * 64 + fr, colb = u.pn * BM + wc * 32 + 8 * fq;
        const int mr = modrow(u.pm * BM);
        const float* gp = gate + (size_t)mr * 12288;
        f32x4 gv[2][2], bv[2][2];
#pragma unroll
        for (int bj = 0; bj < 2; ++bj)
#pragma unroll
            for (int n = 0; n < 2; ++n) { gv[bj][n] = *(const f32x4*)(gp + colb + bj * HALF + 4 * n);
                bv[bj][n] = bias ? *(const f32x4*)(bias + colb + bj * HALF + 4 * n) : (f32x4){0.f, 0.f, 0.f, 0.f}; }
        bf16* base = x + (size_t)row0 * D + colb;
#pragma unroll
        for (int ai = 0; ai < 2; ++ai) {
            u32x4 xo[4][2];
#pragma unroll
            for (int m = 0; m < 4; ++m)
#pragma unroll
                for (int bj = 0; bj < 2; ++bj) xo[m][bj] = *(const u32x4*)(base + (size_t)(ai * HALF + m * 16) * D + bj * HALF);
#pragma unroll
            for (int m = 0; m < 4; ++m)
#pragma unroll
                for (int bj = 0; bj < 2; ++bj) { const u32x4 p = xo[m][bj];
                    const f32x4 o0 = (f32x4){bflo(p.x), bfhi(p.x), bflo(p.y), bfhi(p.y)} + gv[bj][0] * (acc[ai][bj][m][0] + bv[bj][0]);
                    const f32x4 o1 = (f32x4){bflo(p.z), bfhi(p.z), bflo(p.w), bfhi(p.w)} + gv[bj][1] * (acc[ai][bj][m][1] + bv[bj][1]);
                    *(u32x4*)(base + (size_t)(ai * HALF + m * 16) * D + bj * HALF) = (u32x4){cvtpk(o0[0], o0[1]), cvtpk(o0[2], o0[3]), cvtpk(o1[0], o1[1]), cvtpk(o1[2], o1[3])}; }
            asm volatile("" ::: "memory"); }
    }
};
struct EpiFF1 {
    static constexpr bool PERM = true; static constexpr bool CHAIN = false;
    bf16* U; const float* bias;
    __device__ __forceinline__ void operator()(const f32x4 (&acc)[2][2][4][2], const Unit& u, int wr, int wc, int fr, int fq) const {
        { int t_ = lane_id(); asm volatile("" : "+v"(t_)); fr = t_ & 15; fq = (t_ >> 4) & 3; }
        const int row0 = u.pm * BM + wr * 64 + fr, colb = u.pn * BM + wc * 32 + 8 * fq;
        f32x4 bv[2][2];
#pragma unroll
        for (int bj = 0; bj < 2; ++bj)
#pragma unroll
            for (int n = 0; n < 2; ++n) bv[bj][n] = *(const f32x4*)(bias + colb + bj * HALF + 4 * n);
#pragma unroll
        for (int ai = 0; ai < 2; ++ai)
#pragma unroll
            for (int m = 0; m < 4; ++m) { bf16* rowp = U + (size_t)(row0 + ai * HALF + m * 16) * DFF + colb;
#pragma unroll
                for (int bj = 0; bj < 2; ++bj) { f32x4 v0 = acc[ai][bj][m][0] + bv[bj][0], v1 = acc[ai][bj][m][1] + bv[bj][1];
#pragma unroll
                    for (int j = 0; j < 4; ++j) { const float a = fmaxf(v0[j], 0.f), b = fmaxf(v1[j], 0.f); v0[j] = a * a; v1[j] = b * b; }
                    u32x4 w; w.x = cvtpk(v0[0], v0[1]); w.y = cvtpk(v0[2], v0[3]); w.z = cvtpk(v1[0], v1[1]); w.w = cvtpk(v1[2], v1[3]);
                    *(u32x4*)(rowp + bj * HALF) = w; } }
    }
};
}

__device__ __forceinline__ void transpose_item(const float* W, int K, int N, bf16* WT, int ldk, int row_off, LAS bf16* scr, int item, int lane) {
    const int nblk = N / 64, kb = item / nblk, nb = item % nblk, k0 = 32 * kb, n = 64 * nb + lane;
    const float* src = W + (size_t)k0 * N + n;
    float v[32];
#pragma unroll
    for (int i = 0; i < 32; ++i) v[i] = __builtin_nontemporal_load(src + (size_t)i * N);
    bf16* dst = WT + (size_t)(row_off + n) * ldk + k0;
#pragma unroll
    for (int q = 0; q < 4; ++q) *(u32x4*)(dst + 8 * q) = (u32x4){cvtpk(v[8 * q], v[8 * q + 1]), cvtpk(v[8 * q + 2], v[8 * q + 3]), cvtpk(v[8 * q + 4], v[8 * q + 5]), cvtpk(v[8 * q + 6], v[8 * q + 7])};
    (void)scr; (void)K;
}

__device__ __forceinline__ void convert_layer(const Frame& F, int l, LAS bf16* scr, int gw, int NGW, int part) {
    unsigned char* ws = WSP(F);
    if (part & 1) {
        bf16* WinT = (bf16*)(ws + WS_WIN) + (size_t)l * NPROJ * D;
        {   const int n_items = (D / 32) * (15360 / 64); const float* W = INP(F, I_WIN) + (size_t)l * D * 15360;
            for (int it = gw; it < n_items; it += NGW) transpose_item(W, D, 15360, WinT, D, 0, scr, it, F.lane); }
        for (int e = 0; e < 2; ++e) {
            const int n_items = (D / 32);
            const float* W1 = INP(F, I_W1) + ((size_t)l * 2 + e) * D * 64; const float* A1 = INP(F, I_A1) + ((size_t)l * 2 + e) * D * 64;
            for (int it = gw; it < n_items; it += NGW) { transpose_item(W1, D, 64, WinT, D, COL_LW + e * 64, scr, it, F.lane); transpose_item(A1, D, 64, WinT, D, COL_LW + 128 + e * 64, scr, it, F.lane); }
        }
        {   const int n_items = (D / 32) * 2; const float* W = INP(F, I_G1) + (size_t)l * D * 128;
            for (int it = gw; it < n_items; it += NGW) transpose_item(W, D, 128, WinT, D, COL_LW + 256, scr, it, F.lane); }
        for (int i = gw * 64 + F.lane; i < 128 * D / 8; i += NGW * 64) ((u32x4*)(WinT + (size_t)15744 * D))[i] = (u32x4){0u, 0u, 0u, 0u};
        {   bf16* W2T = (bf16*)(ws + WS_W2T) + (size_t)l * 5120 * 128;
            const float* w2 = INP(F, I_W2) + (size_t)l * 2 * 64 * 1024; const float* a2 = INP(F, I_A2) + (size_t)l * 2 * 64 * 1024; const float* g2 = INP(F, I_G2) + (size_t)l * 128 * 1024;
            for (int it = gw; it < 32 * 6; it += NGW) { const int m = it / 32, sub = it % 32;
                const float* W = m == 0 ? w2 : (m == 1 ? w2 + 65536 : (m == 2 ? a2 : (m == 3 ? a2 + 65536 : (m == 4 ? g2 : g2 + 65536))));
                const int br = m < 4 ? m : 4, koff = m < 4 ? 64 * (m & 1) : (m == 4 ? 0 : 64);
                transpose_item(W, 64, 1024, W2T + (size_t)br * 1024 * 128 + koff, 128, 0, scr, sub, F.lane); }
            for (int i = gw * 64 + F.lane; i < 4096 * 8; i += NGW * 64) { const int n = i >> 3, k8 = (i & 7) * 8, br = n >> 10;
                *(u32x4*)(W2T + (size_t)n * 128 + ((br & 1) ? 0 : 64) + k8) = (u32x4){0u, 0u, 0u, 0u}; }
        }
    }
    if (part & 2) {
        for (int br = 0; br < 3; ++br) { const float* W = INP(F, I_WPA + br) + (size_t)l * 1024 * D; bf16* WT = (bf16*)(ws + WS_WP) + ((size_t)l * 3 + br) * D * 1024;
            const int n_items = (1024 / 32) * (D / 64);
            for (int it = gw; it < n_items; it += NGW) transpose_item(W, 1024, D, WT, 1024, 0, scr, it, F.lane); }
        {   const float* W = INP(F, I_WOUT) + (size_t)l * D * D; bf16* WT = (bf16*)(ws + WS_WOUT) + (size_t)l * D * D; const int n_items = (D / 32) * (D / 64);
            for (int it = gw; it < n_items; it += NGW) transpose_item(W, D, D, WT, D, 0, scr, it, F.lane); }
        {   const float* W = INP(F, I_FF1) + (size_t)l * D * DFF; bf16* WT = (bf16*)(ws + WS_WFF1) + (size_t)l * D * DFF; const int n_items = (D / 32) * (DFF / 64);
            for (int it = gw; it < n_items; it += NGW) transpose_item(W, D, DFF, WT, D, 0, scr, it, F.lane); }
        {   const float* W = INP(F, I_FF2) + (size_t)l * D * DFF; bf16* WT = (bf16*)(ws + WS_WFF2) + (size_t)l * D * DFF; const int n_items = (DFF / 32) * (D / 64);
            for (int it = gw; it < n_items; it += NGW) transpose_item(W, DFF, D, WT, DFF, 0, scr, it, F.lane); }
    }
}

constexpr int MOD_NDS = 32;
__device__ __forceinline__ void mod_partials(const Frame& F, int l0, int l1, int gw, int NGW) {
    unsigned char* ws = WSP(F);
    LAS float* sv = (LAS float*)(F.lds + 65536);
    __syncthreads();
    for (int i = F.tid; i < 5 * D; i += 512) { const int r = i / D, d = i - r * D; const float x = (r == 0) ? INP(F, I_CCTX)[d] : INP(F, I_C)[(r - 1) * D + d]; sv[i] = x / (1.0f + __expf(-x)); }
    __syncthreads();
    float* PART = (float*)(ws + WS_Q);
    const int n_items = (l1 - l0) * 48 * MOD_NDS;
    for (int it = gw; it < n_items; it += NGW) {
        const int l = l0 + it / (48 * MOD_NDS), rem = it % (48 * MOD_NDS), jc = rem / MOD_NDS, ds = rem % MOD_NDS, j4 = jc * 256 + 4 * F.lane;
        const float* W = INP(F, I_WMOD) + (size_t)l * D * 12288 + (size_t)(ds * (D / MOD_NDS)) * 12288 + j4;
        f32x4 acc[5];
#pragma unroll
        for (int r = 0; r < 5; ++r) acc[r] = (f32x4){0.f, 0.f, 0.f, 0.f};
#pragma unroll 4
        for (int d = 0; d < D / MOD_NDS; d += 4) {
            f32x4 w[4];
#pragma unroll
            for (int q = 0; q < 4; ++q) w[q] = __builtin_nontemporal_load((const f32x4*)(W + (size_t)(d + q) * 12288));
#pragma unroll
            for (int r = 0; r < 5; ++r) { const f32x4 s = *(const LAS f32x4*)(sv + r * D + ds * (D / MOD_NDS) + d);
#pragma unroll
                for (int q = 0; q < 4; ++q) acc[r] += w[q] * s[q]; }
        }
#pragma unroll
        for (int r = 0; r < 5; ++r) *(f32x4*)(PART + (((size_t)ds * 4 + l) * 5 + r) * 12288 + j4) = acc[r];
    }
    __syncthreads();
}
__device__ __forceinline__ void mod_reduce(const Frame& F, int l0, int l1) {
    unsigned char* ws = WSP(F);
    const float* PART = (const float*)(ws + WS_Q); float* MOD = (float*)(ws + WS_MOD);
    for (int i = l0 * 5 * 3072 + (F.bid * 8 + F.wave) * 64 + F.lane; i < l1 * 5 * 3072; i += F.G * 8 * 64) {
        const int l = i / (5 * 3072), j4 = (i % 3072) * 4;
        f32x4 s = *(const f32x4*)(INP(F, I_BMOD) + l * 12288 + j4);
#pragma unroll
        for (int ds = 0; ds < MOD_NDS; ++ds) s += ((const f32x4*)PART)[(size_t)ds * (DEPTH * 5 * 3072) + i];
        ((f32x4*)MOD)[i] = s; }
}
__device__ __forceinline__ void prologue0(const Frame& F, const Args& a) {
    unsigned char* ws = WSP(F);
    LAS bf16* scr = (LAS bf16*)(F.lds + F.wave * 16384);
    const int gw = F.bid * 8 + F.wave, NGW = F.G * 8;
    convert_layer(F, 0, scr, gw, NGW, 1);
    {   const float* ck = INP(F, I_CK); const float* cv = INP(F, I_CV); bf16* ok = (bf16*)(ws + WS_CK); bf16* ov = (bf16*)(ws + WS_CV);
        const int n4 = 4 * 4 * 256 * 1024 / 4;
        for (int i = gw * 64 + F.lane; i < n4; i += NGW * 64) { const f32x4 x = ((const f32x4*)ck)[i], y = ((const f32x4*)cv)[i];
            ((u32x2*)ok)[i] = (u32x2){cvtpk(x[0], x[1]), cvtpk(x[2], x[3])}; ((u32x2*)ov)[i] = (u32x2){cvtpk(y[0], y[1]), cvtpk(y[2], y[3])}; }
    }
    mod_partials(F, 0, 1, gw, NGW);
    {   float* T2 = (float*)(ws + WS_T2);
        const int n_items = DEPTH * (L_S + L_P);
        for (int it = gw; it < n_items; it += NGW) {
            const int l = it / (L_S + L_P), rr = it % (L_S + L_P), sel = rr < L_S ? 0 : 1, t = sel ? rr - L_S : rr, L = sel ? L_P : L_S;
            float zf = 0.f;
            {   const float tt = (float)t / (float)(L - 1);
                const float w = (6.283185307179586f * (float)t) / (float)L;
                const int band = (F.lane - 1) & 15;
                const float f = 1e-4f + (float)band * ((15.0f - 1e-4f) / 15.0f);
                const float fw = f * w;
                const double rd = (double)fw - 6.283185307179586 * rint((double)fw * 0.15915494309189535);
                const float rf = (float)rd;
                zf = (F.lane == 0) ? tt : (F.lane <= 16 ? __cosf(rf) : -__sinf(rf));
            }
            const float* f1 = INP(F, I_F1) + (size_t)l * 33 * 64; const float* f2 = INP(F, I_F2) + (size_t)l * 64 * 64;
            const float fq = INP(F, I_FREQ)[l * 64 + F.lane];
            float s = INP(F, I_FB1)[l * 64 + F.lane];
            for (int i = 0; i < 33; ++i) s += __int_as_float(__builtin_amdgcn_readlane(__float_as_int(zf), i)) * f1[i * 64 + F.lane];
            float x = fq * s; { const double rd = (double)x - 6.283185307179586 * rint((double)x * 0.15915494309189535); x = (float)rd; }
            const float t1 = __sinf(x);
            float s2 = INP(F, I_FB2)[l * 64 + F.lane];
            for (int i = 0; i < 64; ++i) s2 += __int_as_float(__builtin_amdgcn_readlane(__float_as_int(t1), i)) * f2[i * 64 + F.lane];
            float y = fq * s2; { const double rd = (double)y - 6.283185307179586 * rint((double)y * 0.15915494309189535); y = (float)rd; }
            T2[(((size_t)l * 2 + sel) * L_S + t) * 64 + F.lane] = __sinf(y);
        }
    }
    {   bf16* FS = (bf16*)(ws + WS_FS); bf16* FP = (bf16*)(ws + WS_FP);
        for (int i = gw * 64 + F.lane; i < DEPTH * 1024 * 72; i += NGW * 64) { const int row = i / 72, p = i % 72; const int m = p < 32 ? p : p - 32 + 32;
            FS[(size_t)row * LPS + (p < 32 ? p : L_S + p)] = 0; FP[(size_t)row * LPP + (p < 32 ? p : L_P + p)] = 0; (void)m; }
    }
}

__device__ __forceinline__ void prologue1(const Frame& F, const Args& a) {
    unsigned char* ws = WSP(F);
    const int gw = F.bid * 8 + F.wave, NGW = F.G * 8;
    mod_reduce(F, 0, 1);
    const float* T2 = (const float*)(ws + WS_T2);
    float* FNP = (float*)(ws + WS_FNP);
    for (int it = gw; it < DEPTH * 16 * 32; it += NGW) {
        const int l = it / (16 * 32), cg = (it / 32) % 16, pc = it % 32, c = cg * 64 + F.lane;
        const float* f3 = INP(F, I_F3) + (size_t)l * 64 * 1024 + c;
        float w3[64];
#pragma unroll
        for (int j = 0; j < 64; ++j) w3[j] = f3[(size_t)j * 1024];
        const float delta = fabsf(-3.0701134573253946f + (float)c * ((-15.350567286626973f + 3.0701134573253946f) / 1023.0f));
        bf16* dst_s = (bf16*)(ws + WS_FS) + ((size_t)l * 1024 + c) * LPS; bf16* dst_p = (bf16*)(ws + WS_FP) + ((size_t)l * 1024 + c) * LPP;
        float asum_s = 0.f, asum_p = 0.f;
        for (int gg = pc * 72; gg < pc * 72 + 72; ++gg) {
            const int sel = gg >= L_S ? 1 : 0, t = sel ? gg - L_S : gg, L = sel ? L_P : L_S;
            const float tv = T2[(((size_t)l * 2 + sel) * L_S + t) * 64 + F.lane];
            float s = 0.f;
#pragma unroll
            for (int j = 0; j < 64; ++j) s += __int_as_float(__builtin_amdgcn_readlane(__float_as_int(tv), j)) * w3[j];
            const float dist = fabsf((float)(t - L / 2)) / (float)L;
            const float fv = s * __expf(-dist * delta);
            if (sel) { asum_p += fabsf(fv); dst_p[32 + (L - 1 - t)] = f2bf(fv); } else { asum_s += fabsf(fv); dst_s[32 + (L - 1 - t)] = f2bf(fv); }
        }
        FNP[(((size_t)l * 2 + 0) * 1024 + c) * 32 + pc] = asum_s; FNP[(((size_t)l * 2 + 1) * 1024 + c) * 32 + pc] = asum_p;
    }
}

template <bool XF32>
__device__ __forceinline__ void norm_phase(const Frame& F, const void* xp, const void* xs, bf16* xcopy, const float* g, const float* mod, int i_sh, int i_sc, bf16* hout) {
    const int gw = F.bid * 8 + F.wave, NGW = F.G * 8, lane = F.lane;
    for (int rg = gw; rg < M / 8; rg += NGW) {
        const int row0 = rg * 8;
        const float* mr = mod + (size_t)pg8::modrow(row0) * 12288;
        f32x4 gs[4][2], sh[4][2];
#pragma unroll
        for (int j = 0; j < 4; ++j)
#pragma unroll
            for (int q = 0; q < 2; ++q) { const int c = 512 * j + 8 * lane + 4 * q;
                gs[j][q] = *(const f32x4*)(g + c) * (1.0f + *(const f32x4*)(mr + i_sc * D + c)); sh[j][q] = *(const f32x4*)(mr + i_sh * D + c); }
#pragma unroll 2
        for (int rr = 0; rr < 8; ++rr) {
            const int row = row0 + rr;
            f32x4 v[4][2]; float ss = 0.f;
            if (XF32) {
                const float* xr = row < NPR ? (const float*)xp + (size_t)row * D : (const float*)xs + (size_t)(row - NPR) * D;
#pragma unroll
                for (int j = 0; j < 4; ++j)
#pragma unroll
                    for (int q = 0; q < 2; ++q) v[j][q] = *(const f32x4*)(xr + 512 * j + 8 * lane + 4 * q);
            } else {
                const bf16* xr = (const bf16*)xp + (size_t)row * D;
                u32x4 w[4];
#pragma unroll
                for (int j = 0; j < 4; ++j) w[j] = *(const u32x4*)(xr + 512 * j + 8 * lane);
#pragma unroll
                for (int j = 0; j < 4; ++j) { v[j][0] = (f32x4){bflo(w[j].x), bfhi(w[j].x), bflo(w[j].y), bfhi(w[j].y)}; v[j][1] = (f32x4){bflo(w[j].z), bfhi(w[j].z), bflo(w[j].w), bfhi(w[j].w)}; }
            }
#pragma unroll
            for (int j = 0; j < 4; ++j)
#pragma unroll
                for (int q = 0; q < 2; ++q) ss += (v[j][q][0] * v[j][q][0] + v[j][q][1] * v[j][q][1]) + (v[j][q][2] * v[j][q][2] + v[j][q][3] * v[j][q][3]);
            const float rstd = __builtin_amdgcn_rsqf(wave_sum(ss) * (1.0f / D) + 1e-6f);
            if (XF32) {
#pragma unroll
                for (int j = 0; j < 4; ++j)
                    *(u32x4*)(xcopy + (size_t)row * D + 512 * j + 8 * lane) = (u32x4){cvtpk(v[j][0][0], v[j][0][1]), cvtpk(v[j][0][2], v[j][0][3]), cvtpk(v[j][1][0], v[j][1][1]), cvtpk(v[j][1][2], v[j][1][3])}; }
#pragma unroll
            for (int j = 0; j < 4; ++j) {
                const f32x4 o0 = v[j][0] * rstd * gs[j][0] + sh[j][0], o1 = v[j][1] * rstd * gs[j][1] + sh[j][1];
                *(u32x4*)(hout + (size_t)row * D + 512 * j + 8 * lane) = (u32x4){cvtpk(o0[0], o0[1]), cvtpk(o0[2], o0[3]), cvtpk(o1[0], o1[1]), cvtpk(o1[2], o1[3])};
            }
        }
    }
}
__device__ __forceinline__ void final_norm_phase(const Frame& F, const bf16* xb, float* y, const float* g) {
    const int gw = F.bid * 8 + F.wave, NGW = F.G * 8, lane = F.lane;
    for (int rg = gw; rg < M / 8; rg += NGW) {
        f32x4 gg[4][2];
#pragma unroll
        for (int j = 0; j < 4; ++j)
#pragma unroll
            for (int q = 0; q < 2; ++q) gg[j][q] = *(const f32x4*)(g + 512 * j + 8 * lane + 4 * q);
#pragma unroll 2
        for (int rr = 0; rr < 8; ++rr) {
            const bf16* xr = xb + (size_t)(rg * 8 + rr) * D;
            float* yr = y + (size_t)(rg * 8 + rr) * D;
            u32x4 w[4]; f32x4 v[4][2]; float ss = 0.f;
#pragma unroll
            for (int j = 0; j < 4; ++j) w[j] = *(const u32x4*)(xr + 512 * j + 8 * lane);
#pragma unroll
            for (int j = 0; j < 4; ++j) { v[j][0] = (f32x4){bflo(w[j].x), bfhi(w[j].x), bflo(w[j].y), bfhi(w[j].y)}; v[j][1] = (f32x4){bflo(w[j].z), bfhi(w[j].z), bflo(w[j].w), bfhi(w[j].w)};
#pragma unroll
                for (int q = 0; q < 2; ++q) ss += (v[j][q][0] * v[j][q][0] + v[j][q][1] * v[j][q][1]) + (v[j][q][2] * v[j][q][2] + v[j][q][3] * v[j][q][3]); }
            const float rstd = __builtin_amdgcn_rsqf(wave_sum(ss) * (1.0f / D) + 1e-6f);
#pragma unroll
            for (int j = 0; j < 4; ++j)
#pragma unroll
                for (int q = 0; q < 2; ++q) *(f32x4*)(yr + 512 * j + 8 * lane + 4 * q) = v[j][q] * rstd * gg[j][q];
        }
    }
}

__device__ __forceinline__ s16x4 vtr(const LAS unsigned char* p) { return __builtin_bit_cast(s16x4, __builtin_amdgcn_ds_read_tr16_b64_v4i16((LAS s16x4*)p)); }

struct AttnState { float m, l; f32x16 o[2]; };

__device__ __forceinline__ void attn_loadk(bf16x8 (&kf)[2][4], const bf16* kbase, size_t kstride, int lane) {
    const bf16* kp = kbase + (size_t)(lane & 31) * kstride + 8 * (lane >> 5);
#pragma unroll
    for (int kt = 0; kt < 2; ++kt)
#pragma unroll
        for (int ks = 0; ks < 4; ++ks) kf[kt][ks] = *(const bf16x8*)(kp + (size_t)(32 * kt) * kstride + 16 * ks);
}
template <bool HASB, class BIAS>
__device__ __forceinline__ void attend64(AttnState& st, const bf16x8 (&qf)[4], bf16x8 (&kf)[2][4], const bf16* knext, size_t knstride, const LAS unsigned char* vb, const BIAS& bias, int lane) {
    constexpr int NT = 2;
    const int h = lane >> 5;
    f32x16 s[NT];
#pragma unroll
    for (int kt = 0; kt < NT; ++kt) {
        f32x16 acc;
#pragma unroll
        for (int i = 0; i < 16; ++i) acc[i] = 0.f;
#pragma unroll
        for (int ks = 0; ks < 4; ++ks) acc = __builtin_amdgcn_mfma_f32_32x32x16_bf16(kf[kt][ks], qf[ks], acc, 0, 0, 0);
        s[kt] = acc;
    }
    if (knext) attn_loadk(kf, knext, knstride, lane);
    float gm = -3.0e38f;
#pragma unroll
    for (int kt = 0; kt < NT; ++kt)
#pragma unroll
        for (int i = 0; i < 16; ++i) {
            float v = s[kt][i] * (0.125f * 1.4426950408889634f);
            if (HASB) v = bias(kt, (i & 3) + 8 * (i >> 2), v);
            s[kt][i] = v; gm = fmaxf(gm, v);
        }
    gm = fmaxf(gm, xor32(gm, lane));
    const float mnew = fmaxf(st.m, gm);
    const float alpha = __builtin_amdgcn_exp2f(st.m - mnew);
    float ps = 0.f;
#pragma unroll
    for (int kt = 0; kt < NT; ++kt)
#pragma unroll
        for (int i = 0; i < 16; ++i) { const float p = __builtin_amdgcn_exp2f(s[kt][i] - mnew); s[kt][i] = p; ps += p; }
    st.l = st.l * alpha + ps; st.m = mnew;
#pragma unroll
    for (int i = 0; i < 16; ++i) { st.o[0][i] *= alpha; st.o[1][i] *= alpha; }
    const int i16 = lane & 15, tq = i16 >> 2, tp = i16 & 3, blk = (lane >> 4) & 1;
#pragma unroll
    for (int kt = 0; kt < NT; ++kt) {
#pragma unroll
        for (int ss = 0; ss < 2; ++ss) {
            u32x4 pw; pw.x = cvtpk(s[kt][8 * ss + 0], s[kt][8 * ss + 1]); pw.y = cvtpk(s[kt][8 * ss + 2], s[kt][8 * ss + 3]); pw.z = cvtpk(s[kt][8 * ss + 4], s[kt][8 * ss + 5]); pw.w = cvtpk(s[kt][8 * ss + 6], s[kt][8 * ss + 7]);
            const bf16x8 pf = __builtin_bit_cast(bf16x8, pw);
#pragma unroll
            for (int dt = 0; dt < 2; ++dt) {
                const LAS unsigned char* p0 = vb + kt * 4096 + (16 * ss + 4 * h + tq) * 128 + (dt * 32 + 16 * blk + 4 * tp) * 2;
                const s16x4 lo = vtr(p0), hi = vtr(p0 + 8 * 128);
                const bf16x8 vf = __builtin_shufflevector(lo, hi, 0, 1, 2, 3, 4, 5, 6, 7);
                st.o[dt] = __builtin_amdgcn_mfma_f32_32x32x16_bf16(vf, pf, st.o[dt], 0, 0, 0);
            }
        }
    }
}

__device__ __forceinline__ void attn_store(const AttnState& st, bf16* orow  , int lane) {
    const int h = lane >> 5;
    const float lt = st.l + xor32(st.l, lane);
    const float inv = 1.0f / lt;
#pragma unroll
    for (int dt = 0; dt < 2; ++dt)
#pragma unroll
        for (int g = 0; g < 4; ++g) {
            const u32x2 w = (u32x2){cvtpk(st.o[dt][4 * g] * inv, st.o[dt][4 * g + 1] * inv), cvtpk(st.o[dt][4 * g + 2] * inv, st.o[dt][4 * g + 3] * inv)};
            *(u32x2*)(orow + dt * 32 + 8 * g + 4 * h) = w;
        }
}

__device__ __forceinline__ void attention_phase(const Frame& F, const Args& a, int layer) {
    unsigned char* ws = WSP(F);
    const bf16* proj = (const bf16*)(ws + WS_PROJ);
    bf16* oall = (bf16*)(ws + WS_OALL);
    const int lane = F.lane, w = F.wave, r = lane & 31, h = lane >> 5;
    LAS unsigned char* lds = F.lds;
    LAS float* rpbl = (LAS float*)(lds + 122880);
    for (int u = F.bid; u < 1024; u += F.G) {
        __syncthreads();
        if (u < 512) {
            const int b = u >> 4, hd = u & 15;
            const int tok0 = b * 256;
            bf16x8 qf[4];
            { const bf16* qp = proj + (size_t)(tok0 + 32 * w + r) * NPROJ + hd * 64 + 8 * h;
#pragma unroll
              for (int ks = 0; ks < 4; ++ks) qf[ks] = *(const bf16x8*)(qp + 16 * ks); }
            const bf16* kbase = proj + (size_t)tok0 * NPROJ + COL_K + hd * 64;
            bf16x8 kf[2][4];
            attn_loadk(kf, kbase, (size_t)NPROJ, lane);
            for (int i = F.tid; i < 256 * 8; i += 512) { const int key = i >> 3, pc = i & 7;
                *(LAS u32x4*)(lds + key * 128 + pc * 16) = *(const u32x4*)(proj + (size_t)(tok0 + key) * NPROJ + COL_V + hd * 64 + pc * 8); }
            __syncthreads();
            AttnState st; st.m = -3.0e38f; st.l = 0.f;
#pragma unroll
            for (int i = 0; i < 16; ++i) { st.o[0][i] = 0.f; st.o[1][i] = 0.f; }
#pragma unroll 1
            for (int kg = 0; kg < 4; ++kg)
                attend64<false>(st, qf, kf, kg < 3 ? kbase + (size_t)(64 * (kg + 1)) * NPROJ : nullptr, (size_t)NPROJ, lds + kg * 8192, [&](int, int, float v) { return v; }, lane);
            attn_store(st, oall + (size_t)(tok0 + 32 * w + r) * 3072 + hd * 64, lane);
        } else {
            const int uu = u - 512, b = uu >> 7, hd = (uu >> 3) & 15, rg = uu & 7;
            const int tokb = NPR + b * 2048;
            int rlo = 4 * rg - 4; rlo = rlo < 0 ? 0 : (rlo > 24 ? 24 : rlo);
            int rhi0 = 4 * rg + 3 - 4; rhi0 = rhi0 < 0 ? 0 : (rhi0 > 24 ? 24 : rhi0); const int nr = rhi0 + 8 - rlo;
            const int qrow = 4 * rg + (w >> 1), qc = (w & 1) * 32 + r;
            int r0 = qrow - 4; r0 = r0 < 0 ? 0 : (r0 > 24 ? 24 : r0);
            const int qtok = tokb + qrow * 64 + (w & 1) * 32 + r;
            bf16x8 qf[4];
            { const bf16* qp = proj + (size_t)qtok * NPROJ + hd * 64 + 8 * h;
#pragma unroll
              for (int ks = 0; ks < 4; ++ks) qf[ks] = *(const bf16x8*)(qp + 16 * ks); }
            const bf16* kloc = proj + (size_t)tokb * NPROJ + COL_K + hd * 64;
            bf16x8 kf[2][4];
            attn_loadk(kf, kloc + (size_t)(r0 * 64) * NPROJ, (size_t)NPROJ, lane);
            for (int i = F.tid; i < nr * 64 * 8; i += 512) { const int key = i >> 3, pc = i & 7;
                *(LAS u32x4*)(lds + key * 128 + pc * 16) = *(const u32x4*)(proj + (size_t)(tokb + rlo * 64 + key) * NPROJ + COL_V + hd * 64 + pc * 8); }
            const bf16* cv = (const bf16*)(ws + WS_CV) + ((size_t)(b * 4 + layer) * 256) * 1024 + hd * 64;
            const bf16* ck = (const bf16*)(ws + WS_CK) + ((size_t)(b * 4 + layer) * 256) * 1024 + hd * 64;
            for (int i = F.tid; i < 256 * 8; i += 512) { const int key = i >> 3, pc = i & 7;
                *(LAS u32x4*)(lds + 90112 + key * 128 + pc * 16) = *(const u32x4*)(cv + (size_t)key * 1024 + pc * 8); }
            for (int i = F.tid; i < 465; i += 512) rpbl[i] = INP(F, I_RPB)[((size_t)layer * 16 + hd) * 465 + i] * 1.4426950408889634f;
            __syncthreads();
            int c0 = qc - 8; c0 = c0 < 0 ? 0 : (c0 > 48 ? 48 : c0);
            AttnState st; st.m = -3.0e38f; st.l = 0.f;
#pragma unroll
            for (int i = 0; i < 16; ++i) { st.o[0][i] = 0.f; st.o[1][i] = 0.f; }
#pragma unroll 1
            for (int grp = 0; grp < 12; ++grp) {
                const bf16* knext = grp < 7 ? kloc + (size_t)((r0 + grp + 1) * 64) * NPROJ : (grp < 11 ? ck + (size_t)((grp - 7) * 64) * 1024 : nullptr);
                const size_t knstride = grp < 7 ? (size_t)NPROJ : (size_t)1024;
                if (grp < 8) { const int kr = r0 + grp;
                    const int cb = c0 - 4 * h; const LAS float* rb = rpbl + (kr - qrow + 7) * 31 + (4 * h - qc + 15);
                    attend64<true>(st, qf, kf, knext, knstride, lds + ((kr - rlo) * 64) * 128,
                        [&](int kt, int ci, float v) { const unsigned d = (unsigned)(kt * 32 + ci - cb); const float bv = rb[kt * 32 + ci]; return d < 16u ? v + bv : -1.0e30f; }, lane);
                } else attend64<false>(st, qf, kf, knext, knstride, lds + 90112 + (grp - 8) * 8192, [&](int, int, float v) { return v; }, lane);
            }
            attn_store(st, oall + (size_t)qtok * 3072 + hd * 64, lane);
        }
    }
    __syncthreads();
}

__device__ __forceinline__ float row_sum16(float v) { v += DPPF(v, 0xB1); v += DPPF(v, 0x4E); v += DPPF(v, 0x141); v += DPPF(v, 0x140); return v; }
__device__ __forceinline__ f32x4 unpack4(u32x2 w) { return (f32x4){bflo(w.x), bfhi(w.x), bflo(w.y), bfhi(w.y)}; }
__device__ __forceinline__ u32x2 pack4(f32x4 v) { return (u32x2){cvtpk(v[0], v[1]), cvtpk(v[2], v[3])}; }
__device__ __forceinline__ void rwkv_tinv_pair(const Frame& F, int run, int hd) {
    unsigned char* ws = WSP(F);
    const bf16* til = (const bf16*)(ws + WS_TIL);
    bf16* tinv = (bf16*)(ws + WS_TINV);
    int lane = lane_id(); asm volatile("" : "+v"(lane));
    const int r = lane & 31, h = lane >> 5;
    LAS float* Lw = (LAS float*)(F.lds + F.wave * 16384);
#pragma unroll 1
    for (int e = 0; e < 2; ++e) {
        const size_t tok = (size_t)(run * 32 + (e ? 31 - r : r));
        const bf16* rowp = til + (tok * 16 + hd) * TILP + e * 256 + 8 * h;
        f32x16 acc;
#pragma unroll
        for (int i = 0; i < 16; ++i) acc[i] = 0.f;
        bf16x8 bfr[4], afr[4];
#pragma unroll
        for (int ks = 0; ks < 4; ++ks) { afr[ks] = *(const bf16x8*)(rowp + 16 * ks); bfr[ks] = *(const bf16x8*)(rowp + 64 + 16 * ks); }
#pragma unroll
        for (int ks = 0; ks < 4; ++ks) acc = __builtin_amdgcn_mfma_f32_32x32x16_bf16(bfr[ks], afr[ks], acc, 0, 0, 0);
#pragma unroll
        for (int g = 0; g < 4; ++g) { const int j0 = 8 * g + 4 * h; f32x4 v;
#pragma unroll
            for (int q = 0; q < 4; ++q) v[q] = (j0 + q < r) ? acc[4 * g + q] : 0.f;
            *(LAS f32x4*)(Lw + e * 1152 + r * 36 + j0) = v; }
    }
    LDS_WAIT(); asm volatile("" ::: "memory");
    {   const LAS float* Lh = Lw + h * 1152;
        float X[32];
#pragma unroll
        for (int i = 0; i < 32; ++i) {
            float s = (i == r) ? 1.f : 0.f;
#pragma unroll
            for (int jq = 0; jq < (i + 3) / 4; ++jq) { const f32x4 lv = *(const LAS f32x4*)(Lh + i * 36 + 4 * jq);
#pragma unroll
                for (int q = 0; q < 4; ++q) if (4 * jq + q < i) s += lv[q] * X[4 * jq + q]; }
            X[i] = s;
        }
        bf16* o = tinv + (size_t)((run << 5) | (h << 4) | hd) * 1024 + r;
#pragma unroll
        for (int i = 0; i < 32; ++i) o[i * 32] = f2bf(X[i]);
    }
    LDS_WAIT(); asm volatile("" ::: "memory");
}

__device__ __forceinline__ f32x4 exp4(f32x4 x) { return (f32x4){__expf(x[0]), __expf(x[1]), __expf(x[2]), __expf(x[3])}; }
__device__ __forceinline__ f32x4 rcp4(f32x4 x) { return (f32x4){__builtin_amdgcn_rcpf(x[0]), __builtin_amdgcn_rcpf(x[1]), __builtin_amdgcn_rcpf(x[2]), __builtin_amdgcn_rcpf(x[3])}; }
__device__ __forceinline__ void rwkv_prep_phase(const Frame& F, const Args& a, int layer) {
    unsigned char* ws = WSP(F);
    const bf16* proj = (const bf16*)(ws + WS_PROJ);
    const bf16* abuf = (const bf16*)(ws + WS_A);
    const bf16* logw = (const bf16*)(ws + WS_DEC);
    bf16* til = (bf16*)(ws + WS_TIL);
    float* bonus = (float*)(ws + WS_BONUS);
    float* wtb = (float*)(ws + WS_WTB);
    const float* cw = INP(F, I_CW) + (size_t)layer * 3 * 3072; const float* cb = INP(F, I_CB) + (size_t)layer * 3072;
    for (int item = F.wave * F.G + F.bid; item < 2048; item += 8 * F.G) {
        int lane = lane_id(); asm volatile("" : "+v"(lane));
        const int run = item >> 2, tok0 = run * 32, cg = item & 3, c4 = cg * 256 + 4 * lane, head = cg * 4 + (lane >> 4), hl = 4 * (lane & 15);
        const int t0 = tok0 < NPR ? (tok0 & 255) : ((tok0 - NPR) & 2047), L = tok0 < NPR ? L_P : L_S;
        const f32x4 kkw = *(const f32x4*)(INP(F, I_KK) + layer * 1024 + c4), kaw = *(const f32x4*)(INP(F, I_KA) + layer * 1024 + c4), rkw = *(const f32x4*)(INP(F, I_RK) + layer * 1024 + c4);
        f32x4 tot1 = (f32x4){0.f, 0.f, 0.f, 0.f};
        {   u32x2 t[32];
#pragma unroll
            for (int i = 0; i < 32; ++i) t[i] = *(const u32x2*)(logw + ((size_t)(tok0 + i) * 2 + 1) * 1024 + c4);
#pragma unroll
            for (int i = 0; i < 32; ++i) tot1 += unpack4(t[i]); }
        f32x4 pre0 = (f32x4){0.f, 0.f, 0.f, 0.f}, pre1 = pre0, e0prev = (f32x4){1.f, 1.f, 1.f, 1.f};
        const bf16* pbase = proj + (size_t)tok0 * NPROJ + COL_R + c4;
#pragma unroll 1
        for (int ch = 0; ch < 8; ++ch) {
            const float* cwp = cw; const float* cbp = cb; asm volatile("" : "+s"(cwp), "+s"(cbp));
            f32x4 w[3][3], bs[3];
#pragma unroll
            for (int s = 0; s < 3; ++s) { bs[s] = *(const f32x4*)(cbp + s * 1024 + c4);
#pragma unroll
                for (int tp = 0; tp < 3; ++tp) w[s][tp] = *(const f32x4*)(cwp + tp * 3072 + s * 1024 + c4); }
            u32x2 rows[6][3], av[4][2]; f32x4 lw[4][2];
#pragma unroll
            for (int i = 0; i < 6; ++i) { const int tt = ch * 4 + i - 1, t = t0 + tt; const bool ok = (t >= 0) && (t < L);
#pragma unroll
                for (int s = 0; s < 3; ++s) rows[i][s] = ok ? *(const u32x2*)(pbase + (long)tt * NPROJ + s * 1024) : (u32x2){0u, 0u}; }
#pragma unroll
            for (int i = 0; i < 4; ++i) { const size_t tok = (size_t)(tok0 + ch * 4 + i); av[i][0] = *(const u32x2*)(abuf + (tok * 2 + 0) * 1024 + c4); av[i][1] = *(const u32x2*)(abuf + (tok * 2 + 1) * 1024 + c4);
                lw[i][0] = unpack4(*(const u32x2*)(logw + (tok * 2 + 0) * 1024 + c4)); lw[i][1] = unpack4(*(const u32x2*)(logw + (tok * 2 + 1) * 1024 + c4)); }
#pragma unroll
            for (int i = 0; i < 4; ++i) {
                const size_t tok = (size_t)(tok0 + ch * 4 + i);
                f32x4 x[3];
#pragma unroll
                for (int s = 0; s < 3; ++s) x[s] = unpack4(rows[i][s]) * w[s][0] + unpack4(rows[i + 1][s]) * w[s][1] + unpack4(rows[i + 2][s]) * w[s][2] + bs[s];
                const f32x4 rr = x[0], k0 = x[1], vv = x[2];
                f32x4 kk = k0 * kkw;
                const float ssq = row_sum16((kk[0] * kk[0] + kk[1] * kk[1]) + (kk[2] * kk[2] + kk[3] * kk[3]));
                kk = kk * __builtin_amdgcn_rsqf(ssq + 1e-12f);
                const f32x4 a0 = unpack4(av[i][0]), a1 = unpack4(av[i][1]);
                const f32x4 kd0 = k0 * (1.0f + (a0 - 1.0f) * kaw), kd1 = k0 * (1.0f + (a1 - 1.0f) * kaw);
                const f32x4 rk = rr * k0 * rkw;
                const float bsum = row_sum16((rk[0] + rk[1]) + (rk[2] + rk[3]));
                pre0 += lw[i][0];
                const f32x4 e0 = exp4(pre0), ie0 = rcp4(e0);
                const f32x4 l1 = tot1 - pre1; pre1 += lw[i][1];
                const f32x4 e1 = exp4(l1), ie1 = rcp4(e1), e1prev = exp4(l1 - lw[i][1]);
                bf16* o = til + (tok * 16 + head) * TILP + hl;
                *(u32x2*)(o) = pack4(-kk * e0prev); *(u32x2*)(o + 64) = pack4(kk * a0 * ie0); *(u32x2*)(o + 128) = pack4(kd0 * ie0); *(u32x2*)(o + 192) = pack4(rr * e0);
                *(u32x2*)(o + 256) = pack4(-kk * e1prev); *(u32x2*)(o + 320) = pack4(kk * a1 * ie1); *(u32x2*)(o + 384) = pack4(kd1 * ie1); *(u32x2*)(o + 448) = pack4(rr * e1);
                *(u32x2*)(o + 512) = pack4(vv);
                e0prev = e0;
                if ((lane & 15) == 0) bonus[tok * 16 + head] = bsum;
            }
        }
        *(f32x4*)(wtb + (((size_t)run * 2 + 0) * 16 + head) * 64 + hl) = exp4(pre0);
        *(f32x4*)(wtb + (((size_t)run * 2 + 1) * 16 + head) * 64 + hl) = exp4(tot1);
        asm volatile("s_waitcnt vmcnt(0)" ::: "memory");
#pragma unroll 1
        for (int uu = 0; uu < 4; ++uu) rwkv_tinv_pair(F, run, cg * 4 + uu);
    }
}

__device__ __forceinline__ bf16x8 packf(const f32x16& x, int s) {
    u32x4 p; p.x = cvtpk(x[8 * s + 0], x[8 * s + 1]); p.y = cvtpk(x[8 * s + 2], x[8 * s + 3]); p.z = cvtpk(x[8 * s + 4], x[8 * s + 5]); p.w = cvtpk(x[8 * s + 6], x[8 * s + 7]);
    return __builtin_bit_cast(bf16x8, p);
}
#define MFMA32(a, b, c) __builtin_amdgcn_mfma_f32_32x32x16_bf16((a), (b), (c), 0, 0, 0)

__device__ __forceinline__ void glds16(const void* gsrc, unsigned lds_dst) { unsigned keep;
    asm volatile("s_mov_b32 %0, m0\n\ts_mov_b32 m0, %2\n\ts_nop 0\n\tglobal_load_lds_dwordx4 %1, off\n\ts_mov_b32 m0, %0" : "=&s"(keep) : "v"(gsrc), "s"(lds_dst) : "memory"); }
template <int V> struct IC { static constexpr int value = V; };
__device__ __forceinline__ void hyena_post_phase(const Frame& F, const Args& a, int layer, LAS bf16* tl, int gw, int NGW);
constexpr int CS_BUF = 23552, CS_AT = 0, CS_BT = 4096, CS_KT = 8192, CS_RT = 12288, CS_VV = 16384, CS_TI = 20480, CS_WT = 22528;
__device__ __forceinline__ void rwkv_cscan_phase(const Frame& F, const Args& a, int layer) {
    if (F.wave >= 2) {
        if (F.wave == 4 || F.wave == 5) return;
        const int sw = F.wave < 4 ? F.wave - 2 : F.wave - 4;
        {   LAS bf16* sl = (LAS bf16*)(F.lds + 4 * CS_BUF + sw * 8704);
            hyena_post_phase(F, a, layer, sl, F.bid * 4 + sw, F.G * 4); }
        convert_layer(F, layer, nullptr, F.bid * 4 + sw, F.G * 4, 2);
        if (layer + 1 < DEPTH) convert_layer(F, layer + 1, nullptr, F.bid * 4 + sw, F.G * 4, 1);
        return; }
    __builtin_amdgcn_s_setprio(3);
    unsigned char* ws = WSP(F);
    const bf16* til = (const bf16*)(ws + WS_TIL);
    const bf16* tinv = (const bf16*)(ws + WS_TINV);
    const float* wtb = (const float*)(ws + WS_WTB);
    float* Y = (float*)(ws + WS_H);
    const int lane = F.lane, r = lane & 31, h = lane >> 5;
    const int i16 = lane & 15, tq = i16 >> 2, tp = i16 & 3, blk = (lane >> 4) & 1;
    LAS unsigned char* lbase = F.lds + F.wave * (2 * CS_BUF);
    const int slot = F.wave * F.G + F.bid, nslot = 2 * F.G;
    const int nsamp = 256;
    for (int item = slot; item < 2304; item += (slot < nsamp) ? 2304 : (nslot - nsamp)) {
        const bool sample = item < 256; const int hc = sample ? item : item - 256, chain = hc >> 1, vt = hc & 1;
        const int hd = chain & 15, e = (chain >> 4) & 1, b = chain >> 5;
        const int NC = sample ? (L_S / 32) : (L_P / 32), tokb = sample ? NPR + b * L_S : b * L_P;
        f32x16 ST[2];
        if (sample) { const float* s0 = INP(F, I_ST) + ((((size_t)b * 4 + layer) * 2 + e) * 16 + hd) * 4096;
#pragma unroll
            for (int kt = 0; kt < 2; ++kt)
#pragma unroll
                for (int g = 0; g < 4; ++g) { const f32x4 v = *(const f32x4*)(s0 + (32 * vt + r) * 64 + 32 * kt + 8 * g + 4 * h);
                    ST[kt][4 * g] = v[0]; ST[kt][4 * g + 1] = v[1]; ST[kt][4 * g + 2] = v[2]; ST[kt][4 * g + 3] = v[3]; }
        } else {
#pragma unroll
            for (int kt = 0; kt < 2; ++kt)
#pragma unroll
                for (int i = 0; i < 16; ++i) ST[kt][i] = 0.f;
        }
#define CS_DMA(C, BUFP) do { const int run_ = (tokb >> 5) + (e ? NC - 1 - (C) : (C)); int ln_ = lane_id(); asm volatile("" : "+v"(ln_));     \
            const unsigned lb_ = (unsigned)(size_t)(BUFP); \
            _Pragma("unroll") for (int i_ = 0; i_ < 4; ++i_) { const int q_ = ln_ + 64 * i_, p_ = q_ >> 3, cc_ = q_ & 7; \
                const bf16* g_ = til + ((size_t)(run_ * 32 + (e ? 31 - p_ : p_)) * 16 + hd) * TILP + e * 256 + 8 * cc_; \
                glds16(g_, lb_ + CS_AT + i_ * 1024); glds16(g_ + 64, lb_ + CS_BT + i_ * 1024); glds16(g_ + 128, lb_ + CS_KT + i_ * 1024); glds16(g_ + 192, lb_ + CS_RT + i_ * 1024); \
                glds16(g_ - e * 256 + 512, lb_ + CS_VV + i_ * 1024); } \
            const size_t unit_ = ((size_t)run_ * 2 + e) * 16 + hd; \
            _Pragma("unroll") for (int i_ = 0; i_ < 2; ++i_) glds16(tinv + unit_ * 1024 + (ln_ + 64 * i_) * 8, lb_ + CS_TI + i_ * 1024); \
            glds16(wtb + unit_ * 64 + (ln_ & 15) * 4, lb_ + CS_WT); } while (0)
        CS_DMA(0, lbase);
        auto chunk = [&](auto bi_, int c) __attribute__((always_inline)) {
            constexpr int BI = decltype(bi_)::value;
            const LAS unsigned char* B = lbase + BI * CS_BUF;
            if (c == 0) asm volatile("s_waitcnt vmcnt(0)" ::: "memory");
            else asm volatile("s_waitcnt vmcnt(16)" ::: "memory");
            if (c + 1 < NC) CS_DMA(c + 1, lbase + (1 - BI) * CS_BUF);
            bf16x8 nkaF[2], nbrF[2], nkrF[2];
#define CS_NMAT(OUTF, OFFA, OFFB, STRICT) do { f32x16 n_; _Pragma("unroll") for (int i = 0; i < 16; ++i) n_[i] = 0.f; \
                    _Pragma("unroll") for (int ks = 0; ks < 4; ++ks) { const int o = r * 128 + (16 * ks + 8 * h) * 2; \
                        n_ = MFMA32(*(const LAS bf16x8*)(B + (OFFA) + o), *(const LAS bf16x8*)(B + (OFFB) + o), n_); } \
                    _Pragma("unroll") for (int i = 0; i < 16; ++i) { const int row = (i & 3) + 8 * (i >> 2) + 4 * h; n_[i] = ((STRICT) ? (row < r) : (row <= r)) ? n_[i] : 0.f; } \
                    OUTF[0] = packf(n_, 0); OUTF[1] = packf(n_, 1); } while (0)
            CS_NMAT(nkaF, CS_KT, CS_AT, true);
            CS_NMAT(nbrF, CS_BT, CS_RT, false);
            CS_NMAT(nkrF, CS_KT, CS_RT, false);
#undef CS_NMAT
            const unsigned tra = (unsigned)(size_t)(B) + (4 * h + tq) * 128 + (16 * blk + 4 * tp) * 2 + vt * 64;
            const unsigned trk = (unsigned)(size_t)(B) + (4 * h + tq) * 128 + (16 * blk + 4 * tp) * 2;
            bf16x8 vvF[2], btF[2][2], ktF[2][2];
            {   s16x4 t_[20];
                asm volatile("ds_read_b64_tr_b16 %0, %20 offset:%22\n\tds_read_b64_tr_b16 %1, %20 offset:%22+1024\n\tds_read_b64_tr_b16 %2, %20 offset:%22+2048\n\tds_read_b64_tr_b16 %3, %20 offset:%22+3072\n\t"
                             "ds_read_b64_tr_b16 %4, %21 offset:%23\n\tds_read_b64_tr_b16 %5, %21 offset:%23+1024\n\tds_read_b64_tr_b16 %6, %21 offset:%23+2048\n\tds_read_b64_tr_b16 %7, %21 offset:%23+3072\n\t"
                             "ds_read_b64_tr_b16 %8, %21 offset:%23+64\n\tds_read_b64_tr_b16 %9, %21 offset:%23+64+1024\n\tds_read_b64_tr_b16 %10, %21 offset:%23+64+2048\n\tds_read_b64_tr_b16 %11, %21 offset:%23+64+3072\n\t"
                             "ds_read_b64_tr_b16 %12, %21 offset:%24\n\tds_read_b64_tr_b16 %13, %21 offset:%24+1024\n\tds_read_b64_tr_b16 %14, %21 offset:%24+2048\n\tds_read_b64_tr_b16 %15, %21 offset:%24+3072\n\t"
                             "ds_read_b64_tr_b16 %16, %21 offset:%24+64\n\tds_read_b64_tr_b16 %17, %21 offset:%24+64+1024\n\tds_read_b64_tr_b16 %18, %21 offset:%24+64+2048\n\tds_read_b64_tr_b16 %19, %21 offset:%24+64+3072\n\ts_waitcnt lgkmcnt(0)"
                             : "=&v"(t_[0]), "=&v"(t_[1]), "=&v"(t_[2]), "=&v"(t_[3]), "=&v"(t_[4]), "=&v"(t_[5]), "=&v"(t_[6]), "=&v"(t_[7]), "=&v"(t_[8]), "=&v"(t_[9]),
                               "=&v"(t_[10]), "=&v"(t_[11]), "=&v"(t_[12]), "=&v"(t_[13]), "=&v"(t_[14]), "=&v"(t_[15]), "=&v"(t_[16]), "=&v"(t_[17]), "=&v"(t_[18]), "=&v"(t_[19])
                             : "v"(tra), "v"(trk), "n"(CS_VV), "n"(CS_BT), "n"(CS_KT));
#define CS_FR(I) (bf16x8)__builtin_shufflevector(t_[I], t_[I + 1], 0, 1, 2, 3, 4, 5, 6, 7)
                vvF[0] = CS_FR(0); vvF[1] = CS_FR(2); btF[0][0] = CS_FR(4); btF[0][1] = CS_FR(6); btF[1][0] = CS_FR(8); btF[1][1] = CS_FR(10);
                ktF[0][0] = CS_FR(12); ktF[0][1] = CS_FR(14); ktF[1][0] = CS_FR(16); ktF[1][1] = CS_FR(18);
#undef CS_FR
            }
#define CS_APERM(OFF, KT, S) ({ const LAS unsigned char* p_ = B + (OFF) + r * 128 + (32 * (KT) + 16 * (S) + 4 * h) * 2; \
                const u32x2 lo_ = *(const LAS u32x2*)p_, hi_ = *(const LAS u32x2*)(p_ + 16); __builtin_bit_cast(bf16x8, (u32x4){lo_.x, lo_.y, hi_.x, hi_.y}); })
            bf16x8 uF[2];
            f32x16 rhsB, yC, stK[2];
#pragma unroll
            for (int i = 0; i < 16; ++i) { rhsB[i] = 0.f; yC[i] = 0.f; stK[0][i] = 0.f; stK[1][i] = 0.f; }
#pragma unroll
            for (int s = 0; s < 2; ++s) { rhsB = MFMA32(nkaF[s], vvF[s], rhsB); yC = MFMA32(nkrF[s], vvF[s], yC); stK[0] = MFMA32(ktF[0][s], vvF[s], stK[0]); stK[1] = MFMA32(ktF[1][s], vvF[s], stK[1]); }
            {   f32x16 rhs = rhsB;
#pragma unroll
                for (int kt = 0; kt < 2; ++kt)
#pragma unroll
                    for (int s = 0; s < 2; ++s) rhs = MFMA32(CS_APERM(CS_AT, kt, s), packf(ST[kt], s), rhs);
                f32x16 u;
#pragma unroll
                for (int i = 0; i < 16; ++i) u[i] = 0.f;
#pragma unroll
                for (int s = 0; s < 2; ++s) { const LAS unsigned char* p_ = B + CS_TI + r * 64 + (16 * s + 4 * h) * 2;
                    const u32x2 lo_ = *(const LAS u32x2*)p_, hi_ = *(const LAS u32x2*)(p_ + 16);
                    u = MFMA32(__builtin_bit_cast(bf16x8, (u32x4){lo_.x, lo_.y, hi_.x, hi_.y}), packf(rhs, s), u); }
                uF[0] = packf(u, 0); uF[1] = packf(u, 1);
            }
            {   const int run = (tokb >> 5) + (e ? NC - 1 - c : c);
                f32x16 y = yC;
#pragma unroll
                for (int kt = 0; kt < 2; ++kt)
#pragma unroll
                    for (int s = 0; s < 2; ++s) y = MFMA32(CS_APERM(CS_RT, kt, s), packf(ST[kt], s), y);
#pragma unroll
                for (int s = 0; s < 2; ++s) y = MFMA32(nbrF[s], uF[s], y);
#pragma unroll
                for (int i = 0; i < 16; ++i) { const int p = (i & 3) + 8 * (i >> 2) + 4 * h; const size_t tok = (size_t)(run * 32 + (e ? 31 - p : p));
                    Y[((size_t)e * M + tok) * 1024 + hd * 64 + 32 * vt + r] = y[i]; }
            }
#pragma unroll
            for (int kt = 0; kt < 2; ++kt) {
                f32x4 wt[4];
#pragma unroll
                for (int g = 0; g < 4; ++g) wt[g] = *(const LAS f32x4*)(B + CS_WT + (32 * kt + 8 * g + 4 * h) * 4);
#pragma unroll
                for (int s = 0; s < 2; ++s) ST[kt] = MFMA32(btF[kt][s], uF[s], ST[kt]);
#pragma unroll
                for (int i = 0; i < 16; ++i) ST[kt][i] = (ST[kt][i] + stK[kt][i]) * wt[i >> 2][i & 3];
            }
        };
#pragma unroll 1
        for (int c2 = 0; c2 < NC; c2 += 2) { chunk(IC<0>{}, c2); chunk(IC<1>{}, c2 + 1); }
#undef CS_APERM
#undef CS_DMA
        if (!sample) { float* so = OUTP(F) + OUT_ST + ((((size_t)b * 4 + layer) * 2 + e) * 16 + hd) * 4096;
#pragma unroll
            for (int kt = 0; kt < 2; ++kt)
#pragma unroll
                for (int g = 0; g < 4; ++g) *(f32x4*)(so + (32 * vt + r) * 64 + 32 * kt + 8 * g + 4 * h) = (f32x4){ST[kt][4 * g], ST[kt][4 * g + 1], ST[kt][4 * g + 2], ST[kt][4 * g + 3]};
        }
    }
    asm volatile("s_waitcnt vmcnt(0)" ::: "memory");
    __builtin_amdgcn_s_setprio(0);
}

__device__ __forceinline__ void rwkv_post_phase(const Frame& F, const Args& a, int layer) {
    unsigned char* ws = WSP(F);
    const float* Y = (const float*)(ws + WS_H);
    const bf16* til = (const bf16*)(ws + WS_TIL); const bf16* gbuf = (const bf16*)(ws + WS_G); const float* bonus = (const float*)(ws + WS_BONUS);
    bf16* oall = (bf16*)(ws + WS_OALL);
    const int lane = F.lane;
    for (int item = F.wave * F.G + F.bid; item < 2048; item += 8 * F.G) {
        const int tok0 = (item >> 2) * 32, cg = item & 3, c4 = cg * 256 + 4 * lane, head = cg * 4 + (lane >> 4), hl = 4 * (lane & 15);
        const f32x4 gng = *(const f32x4*)(INP(F, I_GNG) + layer * 1024 + c4), gnb = *(const f32x4*)(INP(F, I_GNB) + layer * 1024 + c4);
#pragma unroll 1
        for (int ch = 0; ch < 4; ++ch) {
            f32x4 y0[8], y1[8]; u32x2 vw[8], gw[8]; float bn[8];
#pragma unroll
            for (int i = 0; i < 8; ++i) { const size_t tok = (size_t)(tok0 + ch * 8 + i);
                y0[i] = __builtin_nontemporal_load((const f32x4*)(Y + tok * 1024 + c4)); y1[i] = __builtin_nontemporal_load((const f32x4*)(Y + ((size_t)M + tok) * 1024 + c4));
                vw[i] = *(const u32x2*)(til + (tok * 16 + head) * TILP + 512 + hl); gw[i] = *(const u32x2*)(gbuf + tok * 1024 + c4); bn[i] = bonus[tok * 16 + head]; }
#pragma unroll
            for (int i = 0; i < 8; ++i) { const size_t tok = (size_t)(tok0 + ch * 8 + i);
                const f32x4 y = y0[i] + y1[i];
                const float mu = row_sum16((y[0] + y[1]) + (y[2] + y[3])) * (1.0f / 64.0f);
                const f32x4 dd = y - mu;
                const float var = row_sum16((dd[0] * dd[0] + dd[1] * dd[1]) + (dd[2] * dd[2] + dd[3] * dd[3])) * (1.0f / 64.0f);
                const f32x4 yn = dd * __builtin_amdgcn_rsqf(var + 64e-5f) * gng + gnb;
                const f32x4 o = (yn + bn[i] * unpack4(vw[i])) * unpack4(gw[i]);
                *(u32x2*)(oall + tok * 3072 + 1024 + c4) = pack4(o);
            }
        }
    }
}

__device__ __forceinline__ void hyena_prep_phase(const Frame& F, const Args& a, int layer) {
    unsigned char* ws = WSP(F);
    const bf16* proj = (const bf16*)(ws + WS_PROJ);
    bf16* zT = (bf16*)(ws + WS_ZT);
    const float* cw = INP(F, I_HCW) + (size_t)layer * 3 * 3072; const float* cb = INP(F, I_HCB) + (size_t)layer * 3072;
    const int gw = F.bid * 8 + F.wave, NGW = F.G * 8, lane = F.lane, tsub = lane >> 4, cq = lane & 15;
    LAS bf16* tl = (LAS bf16*)(F.lds + F.wave * 16384);
    for (int it = gw; it < 256 * 16; it += NGW) {
        const int tt0 = (it >> 4) * 64, c0 = (it & 15) * 64, c4 = c0 + 4 * cq;
        const int t0 = tt0 < NPR ? (tt0 & 255) : ((tt0 - NPR) & 2047), L = tt0 < NPR ? L_P : L_S;
        f32x4 w1[3], w2[3];
#pragma unroll
        for (int tp = 0; tp < 3; ++tp) { w1[tp] = *(const f32x4*)(cw + tp * 3072 + 1024 + c4); w2[tp] = *(const f32x4*)(cw + tp * 3072 + 2048 + c4); }
        const f32x4 b1 = *(const f32x4*)(cb + 1024 + c4), b2 = *(const f32x4*)(cb + 2048 + c4);
        const bf16* px = proj + (size_t)tt0 * NPROJ + COL_X1 + c4;
#pragma unroll 1
        for (int hf = 0; hf < 2; ++hf) {
            u32x2 xr[8][3], vr[8][3];
#pragma unroll
            for (int i = 0; i < 8; ++i) { const int tt = 4 * (hf * 8 + i) + tsub;
#pragma unroll
                for (int d = 0; d < 3; ++d) { const int t = t0 + tt + d - 1; const bool ok = (t >= 0) && (t < L); const bf16* p = px + (long)(tt + d - 1) * NPROJ;
                    xr[i][d] = ok ? *(const u32x2*)p : (u32x2){0u, 0u}; vr[i][d] = ok ? *(const u32x2*)(p + 1024) : (u32x2){0u, 0u}; } }
#pragma unroll
            for (int i = 0; i < 8; ++i) { const int tt = 4 * (hf * 8 + i) + tsub;
                const f32x4 x1c = unpack4(xr[i][0]) * w1[0] + unpack4(xr[i][1]) * w1[1] + unpack4(xr[i][2]) * w1[2] + b1;
                const f32x4 vvc = unpack4(vr[i][0]) * w2[0] + unpack4(vr[i][1]) * w2[1] + unpack4(vr[i][2]) * w2[2] + b2;
                *(LAS u32x2*)(tl + tt * 68 + 4 * cq) = pack4(x1c * vvc); }
        }
        LDS_WAIT(); asm volatile("" ::: "memory");
#pragma unroll
        for (int j = 0; j < 8; ++j) { const int id = lane + 64 * j, ch = id >> 3, tg = id & 7; const LAS bf16* s = tl + (8 * tg) * 68 + ch;
            u32x4 o; o.x = (unsigned)s[0] | ((unsigned)s[68] << 16); o.y = (unsigned)s[2 * 68] | ((unsigned)s[3 * 68] << 16); o.z = (unsigned)s[4 * 68] | ((unsigned)s[5 * 68] << 16); o.w = (unsigned)s[6 * 68] | ((unsigned)s[7 * 68] << 16);
            *(u32x4*)(zT + (size_t)(c0 + ch) * M + tt0 + 8 * tg) = o; }
        LDS_WAIT(); asm volatile("" ::: "memory");
    }
}

__device__ __forceinline__ void hyena_conv_phase(const Frame& F, const Args& a, int layer) {
    unsigned char* ws = WSP(F);
    bf16* zT = (bf16*)(ws + WS_ZT);
    const float* FNP = (const float*)(ws + WS_FNP);
    const int lane = F.lane, w = F.wave, r = lane & 31, h = lane >> 5;
    LAS unsigned char* lds = F.lds;
    for (int u = F.bid; u < 2048; u += F.G) {
        const bool sample = u < 1024; const int c = u & 1023;
        const int L = sample ? L_S : L_P, LP = sample ? LPS : LPP, FCS = LP * 2;
        const int ZROW = (L + 448) * 2, ZOFF = 2 * FCS;
        const int NB = sample ? 4 : 32, tokb = sample ? NPR : 0;
        const bf16* fsrc = sample ? (const bf16*)(ws + WS_FS) + ((size_t)layer * 1024 + c) * LPS : (const bf16*)(ws + WS_FP) + ((size_t)layer * 1024 + c) * LPP;
        __syncthreads();
        for (int i = F.tid; i < LP / 8; i += 512) *(LAS u32x4*)(lds + i * 16) = *(const u32x4*)(fsrc + i * 8);
        for (int i = F.tid; i < LP; i += 512) *(LAS bf16*)(lds + FCS + i * 2) = (i + 1 < LP) ? fsrc[i + 1] : (bf16)0;
        { const int cpr = L / 8;
          for (int i = F.tid; i < NB * cpr; i += 512) { const int b = i / cpr, q = i - b * cpr;
              *(LAS u32x4*)(lds + ZOFF + b * ZROW + 448 + q * 16) = *(const u32x4*)(zT + (size_t)c * M + tokb + b * L + q * 8); }
          if (sample) for (int i = F.tid; i < NB * 56; i += 512) { const int b = i / 56, q = i - b * 56;
              *(LAS u32x4*)(lds + ZOFF + b * ZROW + (q < 28 ? q * 16 : 448 + L * 2 + (q - 28) * 16)) = (u32x4){0u, 0u, 0u, 0u}; } }
        __syncthreads();
        const int nbl = sample ? 2 : 5;
        const int I0 = sample ? 8 * w : w;
        const int b = r & (NB - 1), I = I0 + (r >> nbl);
        int dlo = (sample ? I0 - 63 : I0 - 7), dhi = (sample ? I0 + 7 : I0);
        const int dmax = L / 64;
        dlo = dlo < -dmax ? -dmax : dlo; dhi = dhi > dmax ? dmax : dhi;
        f32x16 acc;
#pragma unroll
        for (int i = 0; i < 16; ++i) acc[i] = 0.f;
        const LAS unsigned char* zb = lds + ZOFF + b * ZROW + (224 + 8 * h) * 2;
#pragma unroll 2
        for (int d = dlo; d <= dhi; ++d) {
#pragma unroll
            for (int ks = 0; ks < 2; ++ks) {
                const int st = (L / 2 - 1) - 32 * d - r + 16 * ks + 8 * h + 32;
                const int par = st & 1;
                const LAS unsigned* ap = (const LAS unsigned*)(lds + par * FCS + (st - par) * 2);
                const u32x4 aw = (u32x4){ap[0], ap[1], ap[2], ap[3]};
                const bf16x8 af = __builtin_bit_cast(bf16x8, aw);
                const bf16x8 bfr = *(const LAS bf16x8*)(zb + (32 * (I - d) + 16 * ks) * 2);
                acc = __builtin_amdgcn_mfma_f32_32x32x16_bf16(af, bfr, acc, 0, 0, 0);
            }
        }
        float fsum = 0.f; { const float* fnp = FNP + (((size_t)layer * 2 + (sample ? 0 : 1)) * 1024 + c) * 32; const int np = 32;
#pragma unroll 4
            for (int i = 0; i < np; ++i) fsum += fnp[i]; }
        const float inv = 1.0f / (fsum + 1e-6f);
        const float dco = INP(F, I_HD)[layer * 1024 + c];
        __syncthreads();
#pragma unroll
        for (int g = 0; g < 4; ++g) {
            const int t = 32 * I + 8 * g + 4 * h;
            const LAS bf16* zp = (const LAS bf16*)(lds + ZOFF + b * ZROW + (224 + t) * 2);
            float o[4];
#pragma unroll
            for (int j = 0; j < 4; ++j) o[j] = acc[4 * g + j] * inv + bf2f(zp[j]) * dco;
            *(u32x2*)(zT + (size_t)c * M + tokb + b * L + t) = (u32x2){cvtpk(o[0], o[1]), cvtpk(o[2], o[3])};
        }
    }
    __syncthreads();
}

__device__ __forceinline__ void hyena_post_phase(const Frame& F, const Args& a, int layer, LAS bf16* tl, int gw, int NGW) {
    unsigned char* ws = WSP(F);
    const bf16* proj = (const bf16*)(ws + WS_PROJ);
    const bf16* yT = (const bf16*)(ws + WS_ZT);
    bf16* oall = (bf16*)(ws + WS_OALL);
    const float* cw = INP(F, I_HCW) + (size_t)layer * 3 * 3072; const float* cb = INP(F, I_HCB) + (size_t)layer * 3072;
    const int lane = F.lane, tsub = lane >> 4, cq = lane & 15;
    for (int it = gw; it < 256 * 16; it += NGW) {
        const int tt0 = (it >> 4) * 64, c0 = (it & 15) * 64, c4 = c0 + 4 * cq;
        const int t0 = tt0 < NPR ? (tt0 & 255) : ((tt0 - NPR) & 2047), L = tt0 < NPR ? L_P : L_S;
        {   u32x4 tmp[8];
#pragma unroll
            for (int j = 0; j < 8; ++j) { const int id = lane + 64 * j, ch = id >> 3, tg = id & 7; tmp[j] = *(const u32x4*)(yT + (size_t)(c0 + ch) * M + tt0 + 8 * tg); }
#pragma unroll
            for (int j = 0; j < 8; ++j) { const int id = lane + 64 * j, ch = id >> 3, tg = id & 7; LAS unsigned* d = (LAS unsigned*)(tl + ch * 68 + 8 * tg);
                d[0] = tmp[j].x; d[1] = tmp[j].y; d[2] = tmp[j].z; d[3] = tmp[j].w; } }
        LDS_WAIT(); asm volatile("" ::: "memory");
        f32x4 w0[3];
#pragma unroll
        for (int tp = 0; tp < 3; ++tp) w0[tp] = *(const f32x4*)(cw + tp * 3072 + c4);
        const f32x4 b0 = *(const f32x4*)(cb + c4);
        const bf16* px = proj + (size_t)tt0 * NPROJ + COL_X0 + c4;
#pragma unroll 1
        for (int hf = 0; hf < 2; ++hf) {
            u32x2 xr[8][3];
#pragma unroll
            for (int i = 0; i < 8; ++i) { const int tt = 4 * (hf * 8 + i) + tsub;
#pragma unroll
                for (int d = 0; d < 3; ++d) { const int t = t0 + tt + d - 1; const bool ok = (t >= 0) && (t < L); xr[i][d] = ok ? *(const u32x2*)(px + (long)(tt + d - 1) * NPROJ) : (u32x2){0u, 0u}; } }
#pragma unroll
            for (int i = 0; i < 8; ++i) { const int tt = 4 * (hf * 8 + i) + tsub;
                const f32x4 x0c = unpack4(xr[i][0]) * w0[0] + unpack4(xr[i][1]) * w0[1] + unpack4(xr[i][2]) * w0[2] + b0;
                const f32x4 yv = (f32x4){bf2f(tl[(4 * cq + 0) * 68 + tt]), bf2f(tl[(4 * cq + 1) * 68 + tt]), bf2f(tl[(4 * cq + 2) * 68 + tt]), bf2f(tl[(4 * cq + 3) * 68 + tt])};
                *(u32x2*)(oall + (size_t)(tt0 + tt) * 3072 + 2048 + c4) = pack4(x0c * yv); }
        }
        LDS_WAIT(); asm volatile("" ::: "memory");
    }
}

constexpr int NPL = 11, PH_LAYER0 = 2, PH_FINAL = PH_LAYER0 + DEPTH * NPL, N_PHASES = PH_FINAL + 1;

__global__ void __launch_bounds__(512, 2) mega(Args args) {
    extern __shared__ __attribute__((aligned(16))) unsigned char lds_raw[];
    Frame F;
    F.lds = (LAS unsigned char*)lds_raw;
    F.tid = threadIdx.x; F.lane = F.tid & 63; F.wave = __builtin_amdgcn_readfirstlane(F.tid >> 6);
    F.G = gridDim.x; F.bid = blockIdx.x;
    for (int u = F.tid; u < (LDS_BYTES - LDSCTL_OFF) / 4; u += 512) ((LAS unsigned*)(F.lds + LDSCTL_OFF))[u] = 0u;
    __syncthreads();
    if (F.tid < 48) { const unsigned long long p = F.tid < 46 ? (unsigned long long)args.in[F.tid] : (F.tid == 46 ? (unsigned long long)args.out : (unsigned long long)args.ws);
        ((LAS unsigned*)(F.lds + LDS_ARGT))[2 * F.tid] = (unsigned)p; ((LAS unsigned*)(F.lds + LDS_ARGT))[2 * F.tid + 1] = (unsigned)(p >> 32); }
    __syncthreads();
    unsigned char* ws = WSP(F);
    unsigned* ctl = (unsigned*)(ws + WS_CTL);
    int lo = args.ph_lo, hi = args.ph_hi;
    const bool single = (hi - lo) > 1;
    XcdBarrier bar; bar.bar = ctl + CW_BAR; bar.x = 0; bar.st = (volatile LAS unsigned*)(F.lds + LDSCTL_OFF + 64); bar.wave = F.wave;
    if (single) bar = xcd_barrier_post(ctl + CW_BAR, (volatile LAS unsigned*)(F.lds + LDSCTL_OFF + 64), F.wave);
#ifndef MK_EN
#define MK_EN 0xFFFFFF
#endif
#define IN(k) (lo <= (k) && (k) < hi)
#define EN(b) ((MK_EN >> (b)) & 1)
#define FRESH() do { F.lane = lane_id(); asm volatile("" : "+v"(F.lane), "+s"(F.bid), "+s"(F.wave), "+s"(F.G)); F.tid = F.wave * 64 + F.lane; } while (0)
#define SEAM(k) do { if (IN(k) && IN((k) + 1)) xcd_barrier(bar); } while (0)

    if (EN(20) && IN(0)) { FRESH(); prologue0(F, args); SEAM(0); }
    if (EN(21) && IN(1)) { FRESH(); prologue1(F, args); SEAM(1); }

    bf16* Hb = (bf16*)(ws + WS_H); bf16* proj = (bf16*)(ws + WS_PROJ); bf16* oall = (bf16*)(ws + WS_OALL);
    float* x = OUTP(F); bf16* xb = (bf16*)(ws + WS_X);
#pragma unroll 1
    for (int l = 0; l < DEPTH; ++l) {
        const int pb = PH_LAYER0 + l * NPL;
        asm volatile("" : "+s"(lo), "+s"(hi));
        const float* mod = (const float*)(ws + WS_MOD) + (size_t)l * 5 * 12288;
        if (EN(0) && IN(pb + 0)) { FRESH();
            if (l == 0) norm_phase<true>(F, INP(F, I_XP), INP(F, I_XS), xb, INP(F, I_LN1), mod, 0, 1, Hb);
            else norm_phase<false>(F, xb, nullptr, nullptr, INP(F, I_LN1) + l * D, mod, 0, 1, Hb);
            SEAM(pb + 0);
        }
        if (EN(1) && IN(pb + 1)) { FRESH();
            pg8::Gemm g{Hb, (const bf16*)(ws + WS_WIN) + (size_t)l * NPROJ * D, D, D, D, 0, 0, 0};
            pg8::Order S; S.init(M, NPROJ, F.G, F.bid, 1);
            pg8::EpiProj E{proj, x + OUT_CK, x + OUT_CV, l};
            pg8::gemm_phase(F.lds, g, S, E, F.wave);
            {   constexpr int nwg = (M / 256) * (NPROJ / 256); const int rem = nwg % F.G;
                if (l + 1 < DEPTH) { if (rem != 0) { if (F.bid >= rem) { FRESH(); mod_partials(F, l + 1, l + 2, (F.bid - rem) * 8 + F.wave, (F.G - rem) * 8); } }
                                     else { FRESH(); mod_partials(F, l + 1, l + 2, F.bid * 8 + F.wave, F.G * 8); } } }
            SEAM(pb + 1);
        }
        if (EN(2) && IN(pb + 2)) { FRESH();
            if (l + 1 < DEPTH) { mod_reduce(F, l + 1, l + 2); FRESH(); }
            {   pg8::Gemm g{proj + COL_LW, (const bf16*)(ws + WS_W2T) + (size_t)l * 5120 * 128, NPROJ, 128, 128, 0, 128, 4};
                pg8::Order5 S; S.init(M, F.G, F.bid);
                pg8::EpiLora2 E{(bf16*)(ws + WS_DEC), (bf16*)(ws + WS_A), (bf16*)(ws + WS_G), INP(F, I_W0) + l * 2048, INP(F, I_A0) + l * 2048};
                pg8::gemm_phase(F.lds, g, S, E, F.wave); }
            FRESH(); attention_phase(F, args, l);
            FRESH(); hyena_prep_phase(F, args, l);
            SEAM(pb + 2);
        }
        if (EN(3) && IN(pb + 3)) { FRESH(); rwkv_prep_phase(F, args, l); FRESH(); hyena_conv_phase(F, args, l); SEAM(pb + 3); }
        if (EN(4) && IN(pb + 4)) { FRESH(); rwkv_cscan_phase(F, args, l); SEAM(pb + 4); }
        if (EN(5) && IN(pb + 5)) { FRESH(); rwkv_post_phase(F, args, l); SEAM(pb + 5); }
        if (EN(6) && IN(pb + 6)) { FRESH();
            pg8::Gemm g{oall, (const bf16*)(ws + WS_WP) + (size_t)l * 3 * D * 1024, 3072, 1024, 1024, 1024, 0, 8};
            pg8::Order S; S.init(M, D, F.G, F.bid, 3);
            pg8::EpiMerge E{proj, Hb};
            pg8::gemm_phase(F.lds, g, S, E, F.wave);
            SEAM(pb + 6);
        }
        if (EN(7) && IN(pb + 7)) { FRESH();
            pg8::Gemm g{Hb, (const bf16*)(ws + WS_WOUT) + (size_t)l * D * D, D, D, D, 0, 0, 0};
            pg8::Order S; S.init(M, D, F.G, F.bid, 1);
            pg8::EpiResid E{xb, mod + 2 * D, nullptr};
            pg8::gemm_phase(F.lds, g, S, E, F.wave);
            SEAM(pb + 7);
        }
        if (EN(8) && IN(pb + 8)) { FRESH(); norm_phase<false>(F, xb, nullptr, nullptr, INP(F, I_LN2) + l * D, mod, 3, 4, Hb); SEAM(pb + 8); }
        if (EN(9) && IN(pb + 9)) { FRESH();
            pg8::Gemm g{Hb, (const bf16*)(ws + WS_WFF1) + (size_t)l * D * DFF, D, D, D, 0, 0, 0};
            pg8::Order S; S.init(M, DFF, F.G, F.bid, 1);
            pg8::EpiFF1 E{proj, INP(F, I_BFF1) + l * DFF};
            pg8::gemm_phase(F.lds, g, S, E, F.wave);
            SEAM(pb + 9);
        }
        if (EN(10) && IN(pb + 10)) { FRESH();
            pg8::Gemm g{proj, (const bf16*)(ws + WS_WFF2) + (size_t)l * D * DFF, DFF, DFF, DFF, 0, 0, 0};
            pg8::Order S; S.init(M, D, F.G, F.bid, 1);
            pg8::EpiResid E{xb, mod + 5 * D, INP(F, I_BFF2) + l * D};
            pg8::gemm_phase(F.lds, g, S, E, F.wave);
            SEAM(pb + 10);
        }
    }
    asm volatile("" : "+s"(lo), "+s"(hi));
    if (EN(22) && IN(PH_FINAL)) { FRESH(); final_norm_phase(F, (const bf16*)(WSP(F) + WS_X), OUTP(F), INP(F, I_FING)); }
#undef IN
#undef SEAM
}

extern "C" void kernel_launch(void* const* d_in, const int* in_sizes, int n_in, void* d_out, int out_size, void* d_ws, size_t ws_size, hipStream_t stream) {
    static int grid = 0;
    if (grid == 0) {
        if (n_in != N_INPUTS || (size_t)out_size != OUT_TOTAL || ws_size < WS_END) { fprintf(stderr, "kernel_launch: unexpected shapes: n_in %d out %d ws %zu\n", n_in, out_size, ws_size); grid = -1; return; }
        int dev = 0, cus = 0, per_cu = 0;
        if (hipGetDevice(&dev) != hipSuccess || hipDeviceGetAttribute(&cus, hipDeviceAttributeMultiprocessorCount, dev) != hipSuccess) { grid = -1; return; }
        if (hipFuncSetAttribute((const void*)mega, hipFuncAttributeMaxDynamicSharedMemorySize, LDS_BYTES) != hipSuccess) { fprintf(stderr, "kernel_launch: hipFuncSetAttribute failed\n"); grid = -1; return; }
        if (hipOccupancyMaxActiveBlocksPerMultiprocessor(&per_cu, (const void*)mega, 512, LDS_BYTES) != hipSuccess || per_cu < 1) { fprintf(stderr, "kernel_launch: occupancy query says %d\n", per_cu); }
        (void)hipGetLastError();
        grid = cus;
    }
    if (grid < 0) return;
    (void)hipMemsetAsync((char*)d_ws + WS_CTL, 0, CTL_ZERO_BYTES, stream);
    Args a{};
    for (int i = 0; i < N_INPUTS; ++i) a.in[i] = (const float*)d_in[i];
    a.out = (float*)d_out; a.ws = (unsigned char*)d_ws;
#if MK_MULTI
    for (int ph = 0; ph < N_PHASES; ++ph) { a.ph_lo = ph; a.ph_hi = ph + 1; hipLaunchKernelGGL(mega, dim3(grid), dim3(512), LDS_BYTES, stream, a); }
#else
    a.ph_lo = 0; a.ph_hi = N_PHASES;
    hipLaunchKernelGGL(mega, dim3(grid), dim3(512), LDS_BYTES, stream, a);
#endif
    const hipError_t le = hipPeekAtLastError();
    if (le != hipSuccess) fprintf(stderr, "kernel_launch: launch failed: %s\n", hipGetErrorName(le));
}
```
